# Optimizing an MI355X kernel written in HIP

```python
import jax, jax.numpy as jnp
from jax import lax
import numpy as np

D_MODEL = 1024
BATCH = 32
SEQ = 2048
DEPTH = 1

CHUNK = 64
Q_BLOCK = 128
SB_HEADS = 8
SB_HEAD_DIM = 64
SB_WIDTH = SB_HEADS * SB_HEAD_DIM
RW_HEADS = 8
RW_HEAD_DIM = 64
RW_WIDTH = RW_HEADS * RW_HEAD_DIM
W_LORA = 64
A_LORA = 64
G_LORA = 128
GN_EPS = RW_HEAD_DIM * 1e-5
N_BRANCH = 2
SB_COLS = 3 * SB_WIDTH
RW_COLS = 3 * RW_WIDTH + W_LORA + A_LORA + G_LORA
GATE_COLS = N_BRANCH * D_MODEL
IN_COLS = SB_COLS + RW_COLS + GATE_COLS
D_FF = ((8 * D_MODEL + 3 * 256 - 1) // (3 * 256)) * 256
RMS_EPS = 1e-6

kernel_name = "hybrid_stickbreak_rwkv7_swiglu_sandwich"


def rms_norm(x, g):
    xf = x.astype(jnp.float32)
    y = xf * lax.rsqrt(jnp.mean(xf * xf, axis=-1, keepdims=True) + RMS_EPS)
    return (y * g).astype(x.dtype)


def token_shift(p):
    return jnp.pad(p, ((0, 0), (1, 0), (0, 0)))[:, :-1]


def stick_breaking_attention(q, k, v):
    B, S, H, Dh = q.shape
    scale = Dh ** -0.5
    outs = []
    for i in range(S // Q_BLOCK):
        q0 = i * Q_BLOCK
        kv_len = q0 + Q_BLOCK
        qb = q[:, q0:kv_len]
        kb = k[:, :kv_len]
        vb = v[:, :kv_len]
        z = jnp.einsum('bqhd,bkhd->bhqk', qb, kb).astype(jnp.float32) * scale
        t_idx = q0 + jnp.arange(Q_BLOCK)[:, None]
        s_idx = jnp.arange(kv_len)[None, :]
        strict = s_idx < t_idx
        log_fail = jnp.where(strict, jax.nn.log_sigmoid(-z), 0.0)
        after = lax.cumsum(log_fail, axis=3, reverse=True) - log_fail
        w = jnp.where(strict, jnp.exp(jax.nn.log_sigmoid(z) + after), 0.0)
        outs.append(jnp.einsum('bhqk,bkhd->bqhd', w.astype(vb.dtype), vb))
    return jnp.concatenate(outs, axis=1)


def wkv7_scan(r, decay, k, v, kk, a):
    B, S, H, N = r.shape

    def to_chunks(t):
        return t.astype(jnp.float32).transpose(1, 0, 2, 3).reshape(S // CHUNK, CHUNK, B, H, N)

    def step(state, inp):
        r_t, w_t, k_t, v_t, kk_t, a_t = inp
        sa = jnp.einsum('bhvk,bhk->bhv', state, -kk_t)
        state = (state * w_t[:, :, None, :]
                 + sa[..., None] * (kk_t * a_t)[:, :, None, :]
                 + v_t[..., None] * k_t[:, :, None, :])
        return state, jnp.einsum('bhvk,bhk->bhv', state, r_t)

    def chunk_step(state, chunk_inp):
        return lax.scan(step, state, chunk_inp)

    state0 = jnp.zeros((B, H, N, N), jnp.float32)
    _, y = lax.scan(chunk_step, state0, tuple(to_chunks(t) for t in (r, decay, k, v, kk, a)))
    return y.reshape(S, B, H, N).transpose(1, 0, 2, 3)


def rwkv7_time_mix(p, mu, w0, w_up, a0, a_up, g_up, k_k, k_a, r_k, lnx_w, lnx_b):
    B, S, _ = p.shape
    H, N = RW_HEADS, RW_HEAD_DIM
    p = p + (token_shift(p) - p) * mu
    o1, o2, o3 = RW_WIDTH, 2 * RW_WIDTH, 3 * RW_WIDTH
    r, k, v = p[..., :o1], p[..., o1:o2], p[..., o2:o3]
    xw = p[..., o3:o3 + W_LORA]
    xa = p[..., o3 + W_LORA:o3 + W_LORA + A_LORA]
    xg = p[..., o3 + W_LORA + A_LORA:]
    w_raw = (w0 + jnp.tanh(xw) @ w_up).astype(jnp.float32)
    decay = jnp.exp(-jnp.exp(-jax.nn.softplus(-w_raw) - 0.5))
    a = jax.nn.sigmoid((a0 + xa @ a_up).astype(jnp.float32))
    g = jax.nn.sigmoid(xg) @ g_up
    kk = (k * k_k).astype(jnp.float32).reshape(B, S, H, N)
    kk = kk / jnp.maximum(jnp.linalg.norm(kk, axis=-1, keepdims=True), 1e-12)
    k = k.astype(jnp.float32) * (1.0 + (a - 1.0) * k_a)
    heads = lambda t: t.astype(jnp.float32).reshape(B, S, H, N)
    r_h, k_h, v_h = heads(r), heads(k), heads(v)
    y = wkv7_scan(r_h, heads(decay), k_h, v_h, kk, heads(a))
    mean = jnp.mean(y, axis=-1, keepdims=True)
    var = jnp.mean(jnp.square(y - mean), axis=-1, keepdims=True)
    y = ((y - mean) * lax.rsqrt(var + GN_EPS)).reshape(B, S, RW_WIDTH) * lnx_w + lnx_b
    bonus = (jnp.sum(r_h * k_h * r_k, axis=-1, keepdims=True) * v_h).reshape(B, S, RW_WIDTH)
    return ((y + bonus) * g).astype(p.dtype)


def setup_inputs(seed: int = 0) -> dict:
    key = jax.random.key(seed)
    ks = jax.random.split(key, 24)
    L, D = DEPTH, D_MODEL
    nrm = lambda k_, shape, s: jax.random.normal(k_, shape, jnp.float32) * s
    return {
        "x": nrm(ks[0], (BATCH, SEQ, D), 1.0),
        "norm_mix_pre": 1.0 + nrm(ks[1], (L, D), 0.1),
        "w_in": nrm(ks[2], (L, D, IN_COLS), D ** -0.5),
        "b_gate": nrm(ks[3], (L, GATE_COLS), 0.1),
        "mu_rw": jax.random.uniform(ks[4], (L, RW_COLS), jnp.float32),
        "w0": jax.random.uniform(ks[5], (L, RW_WIDTH), jnp.float32, -6.0, 0.0),
        "w_up": nrm(ks[6], (L, W_LORA, RW_WIDTH), 0.1),
        "a0": nrm(ks[7], (L, RW_WIDTH), 0.1),
        "a_up": nrm(ks[8], (L, A_LORA, RW_WIDTH), 0.5 * A_LORA ** -0.5),
        "g_up": nrm(ks[9], (L, G_LORA, RW_WIDTH), G_LORA ** -0.5),
        "k_k": 0.85 + nrm(ks[10], (L, RW_WIDTH), 0.05),
        "k_a": 1.0 + nrm(ks[11], (L, RW_WIDTH), 0.05),
        "r_k": nrm(ks[12], (L, RW_HEADS, RW_HEAD_DIM), 0.1),
        "lnx_w": 1.0 + nrm(ks[13], (L, RW_WIDTH), 0.1),
        "lnx_b": nrm(ks[14], (L, RW_WIDTH), 0.02),
        "w_sb_out": nrm(ks[15], (L, SB_WIDTH, D), SB_WIDTH ** -0.5),
        "w_rw_out": nrm(ks[16], (L, RW_WIDTH, D), RW_WIDTH ** -0.5),
        "w_o": nrm(ks[17], (L, D, D), D ** -0.5),
        "norm_mix_post": 1.0 + nrm(ks[18], (L, D), 0.1),
        "norm_ffn_pre": 1.0 + nrm(ks[19], (L, D), 0.1),
        "w_ffn_gate": nrm(ks[20], (L, D, D_FF), D ** -0.5),
        "w_ffn_up": nrm(ks[21], (L, D, D_FF), D ** -0.5),
        "w_ffn_down": nrm(ks[22], (L, D_FF, D), D_FF ** -0.5),
        "norm_ffn_post": 1.0 + nrm(ks[23], (L, D), 0.1),
    }


def reference(x, norm_mix_pre, w_in, b_gate, mu_rw, w0, w_up, a0, a_up, g_up, k_k, k_a, r_k,
              lnx_w, lnx_b, w_sb_out, w_rw_out, w_o, norm_mix_post, norm_ffn_pre,
              w_ffn_gate, w_ffn_up, w_ffn_down, norm_ffn_post):
    B, S, D = x.shape
    for l in range(DEPTH):
        h = rms_norm(x, norm_mix_pre[l])
        proj = h @ w_in[l]
        p_sb = proj[..., :SB_COLS]
        p_rw = proj[..., SB_COLS:SB_COLS + RW_COLS]
        gates = jax.nn.sigmoid(proj[..., SB_COLS + RW_COLS:] + b_gate[l])
        q = p_sb[..., :SB_WIDTH].reshape(B, S, SB_HEADS, SB_HEAD_DIM)
        k = p_sb[..., SB_WIDTH:2 * SB_WIDTH].reshape(B, S, SB_HEADS, SB_HEAD_DIM)
        v = p_sb[..., 2 * SB_WIDTH:].reshape(B, S, SB_HEADS, SB_HEAD_DIM)
        o_sb = stick_breaking_attention(q, k, v).reshape(B, S, SB_WIDTH)
        o_rw = rwkv7_time_mix(p_rw, mu_rw[l], w0[l], w_up[l], a0[l], a_up[l], g_up[l],
                              k_k[l], k_a[l], r_k[l], lnx_w[l], lnx_b[l])
        merged = (gates[..., :D] * (o_sb @ w_sb_out[l])
                  + gates[..., D:] * (o_rw @ w_rw_out[l]))
        x = x + rms_norm(merged @ w_o[l], norm_mix_post[l])
        h = rms_norm(x, norm_ffn_pre[l])
        f = (jax.nn.silu(h @ w_ffn_gate[l]) * (h @ w_ffn_up[l])) @ w_ffn_down[l]
        x = x + rms_norm(f, norm_ffn_post[l])
    return x
```

```cpp
#include <hip/hip_runtime.h>
#include <hip/hip_cooperative_groups.h>
#include <cstdio>
#include <cstdint>
namespace cg = cooperative_groups;
#ifndef MK_SPLIT
#define MK_SPLIT 0
#endif
#ifndef MK_DIAG
#define MK_DIAG 0
#endif
#ifndef MK_EARLY_EXIT
#define MK_EARLY_EXIT 0
#endif
namespace pg8 {
#define PG8_LAS __attribute__((address_space(3)))
typedef unsigned short bf16_t;
typedef short bf16x8 __attribute__((ext_vector_type(8)));
typedef float f32x4 __attribute__((ext_vector_type(4)));
typedef unsigned u32x4 __attribute__((ext_vector_type(4)));
constexpr int BM = 256, BK = 64, HALF = 128, HTB = HALF * BK * 2  , STAGE_BYTES = 8 * HTB, NXCD = 8, WGM = 8;

__host__ __device__ __forceinline__ int lds_byte(int r, int c) { const int st = (r >> 4) * 2 + (c >> 5), rr = r & 15, cc = c & 31, ob = rr * 64 + cc * 2; return st * 1024 + (ob ^ (((ob >> 9) & 1) << 5)); }
__host__ __device__ __forceinline__ void stage_rc(int b, int& R, int& C) { const int st = b / 1024, sb = b % 1024, swz = sb ^ (((sb >> 9) & 1) << 5); R = (st >> 1) * 16 + swz / 64; C = (st & 1) * 32 + (swz % 64) / 2; }
__host__ __device__ __forceinline__ int perm32(int rho) { const int n = rho >> 4, i = rho & 15; return 8 * (i >> 2) + 4 * n + (i & 3); }

struct Unit { int pm, pn; };
struct Gemm { const bf16_t* A; const bf16_t* Bt; int M, N, K; };

struct StaticOrder {
    int nM, nN, nwg, G, c;
    __host__ __device__ void init(int M, int N, int G_, int c_) { nM = M / BM; nN = N / BM; nwg = nM * nN; G = G_; c = c_; }
    __host__ __device__ bool next(int i, Unit& u) const {
        const long L = (long)i * G + c; if (L >= nwg) return false;
        int wgid = (int)L; { const int q = nwg / NXCD, r = nwg % NXCD, xcd = wgid % NXCD, off = wgid / NXCD; wgid = (xcd < r ? xcd * (q + 1) : r * (q + 1) + (xcd - r) * q) + off; }
        const int nig = WGM * nN, gid = wgid / nig, fm = gid * WGM, gsz = (nM - fm) < WGM ? (nM - fm) : WGM;
        u.pm = fm + ((wgid % nig) % gsz); u.pn = (wgid % nig) / gsz; return true;
    }
    __device__ __forceinline__ void a_ready(const Unit&) const {}
    __device__ __forceinline__ void done(const Unit&) const {}
};

__device__ __forceinline__ unsigned cvt_pk_bf16(float lo, float hi) { unsigned r; asm volatile("v_cvt_pk_bf16_f32 %0, %1, %2" : "=v"(r) : "v"(lo), "v"(hi)); return r; }
typedef float f32x2 __attribute__((ext_vector_type(2)));

template <class Epi, class Sched, bool STAMP = false>
__device__ __forceinline__ void gemm_phase(PG8_LAS unsigned char* lds, const Gemm g, const Sched& S, const Epi& E, unsigned long long* stamps) {
    int tid_ = threadIdx.x; asm volatile("" : "+v"(tid_)); const int tid = tid_, wid = __builtin_amdgcn_readfirstlane(tid >> 6), lane = tid & 63, wr = wid >> 2, wc = wid & 3, fr = lane & 15, fq = lane >> 4;
    const int K = g.K, nt = K / BK;
    int ts_lo = 0, ts_hi = 0, nts = 0; const unsigned long long rt_entry = STAMP ? (unsigned long long)wall_clock64() : 0ull;
#define PG8_STAMP() do { if (STAMP && wid == 0 && nts < 64) { const unsigned long long _c = (unsigned long long)clock64(); \
        ts_lo = (lane == nts) ? (int)(unsigned)_c : ts_lo; ts_hi = (lane == nts) ? (int)(unsigned)(_c >> 32) : ts_hi; ++nts; } } while (0)
    PG8_STAMP();
    unsigned voffA[2], voffB[2];
#pragma unroll
    for (int i = 0; i < 2; ++i) { int R, C; stage_rc(tid * 16 + i * 8192, R, C); const int Rb = Epi::PERM ? ((R & ~31) + perm32(R & 31)) : R;
        voffA[i] = (unsigned)(R * K + C) * 2u; voffB[i] = (unsigned)(Rb * K + C) * 2u; }
    const size_t kstep = (size_t)(BK * 2);
    const size_t hstep = (size_t)HALF * K * 2;
    const size_t tstep = 2 * hstep;
    const unsigned ldsw = (unsigned)wid * 1024u;
    const int aoff = lds_byte(wr * 64 + fr, fq * 8), boff = lds_byte(wc * 32 + fr, fq * 8);
#define PG8_SA(b, h) (((b) * 2 + (h)) * HTB)
#define PG8_SB(b, h) ((4 + (b) * 2 + (h)) * HTB)
#define PG8_STAGE(bufoff, gbase, voff) do { _Pragma("unroll") for (int _i = 0; _i < 2; ++_i) \
        __builtin_amdgcn_global_load_lds((const unsigned*)((const char*)(gbase) + (voff)[_i]), (PG8_LAS unsigned*)(lds + (bufoff) + ldsw + _i * 8192), 16, 0, 0); } while (0)
#define PG8_LDA(dst, b, h) do { _Pragma("unroll") for (int m = 0; m < 4; ++m) _Pragma("unroll") for (int k = 0; k < 2; ++k) dst[m][k] = *(const PG8_LAS bf16x8*)(lds + PG8_SA(b, h) + aoff + m * 2048 + k * 1024); } while (0)
#define PG8_LDB(dst, b, h) do { _Pragma("unroll") for (int n = 0; n < 2; ++n) _Pragma("unroll") for (int k = 0; k < 2; ++k) dst[n][k] = *(const PG8_LAS bf16x8*)(lds + PG8_SB(b, h) + boff + n * 2048 + k * 1024); } while (0)
#define PG8_MMA(ai, bj, At, Bt) do { __builtin_amdgcn_s_setprio(1); _Pragma("unroll") for (int m = 0; m < 4; ++m) _Pragma("unroll") for (int n = 0; n < 2; ++n) _Pragma("unroll") for (int k = 0; k < 2; ++k) \
        acc[ai][bj][m][n] = __builtin_amdgcn_mfma_f32_16x16x32_bf16(Bt[n][k], At[m][k], acc[ai][bj][m][n], 0, 0, 0); __builtin_amdgcn_s_setprio(0); } while (0)
#define PG8_WAIT_V(n) asm volatile("s_waitcnt vmcnt(" #n ")" ::: "memory")
#define PG8_WAIT_L(n) asm volatile("s_waitcnt lgkmcnt(" #n ")" ::: "memory")
#define PG8_BAR __builtin_amdgcn_s_barrier()
#define PG8_SCHED __builtin_amdgcn_sched_barrier(0)
    Unit cur, nxt; int ui = 0;
    if (!S.next(0, cur)) return;
    f32x4 acc[2][2][4][2];
#pragma unroll
    for (int a = 0; a < 2; ++a)
#pragma unroll
        for (int b = 0; b < 2; ++b)
#pragma unroll
            for (int m = 0; m < 4; ++m)
#pragma unroll
                for (int n = 0; n < 2; ++n) acc[a][b][m][n] = (f32x4){0.f, 0.f, 0.f, 0.f};
    bf16x8 At[4][2], B0[2][2], B1[2][2];
    const char* cA = (const char*)g.A + (size_t)cur.pm * tstep; const char* cB = (const char*)g.Bt + (size_t)cur.pn * tstep;
    S.a_ready(cur);
    PG8_STAGE(PG8_SB(0, 0), cB, voffB); PG8_STAGE(PG8_SA(0, 0), cA, voffA); PG8_STAGE(PG8_SB(0, 1), cB + hstep, voffB); PG8_STAGE(PG8_SA(0, 1), cA + hstep, voffA);
    if (wr == 1) PG8_BAR;
    PG8_WAIT_V(4); PG8_BAR;
    PG8_STAGE(PG8_SB(1, 0), cB + kstep, voffB); PG8_STAGE(PG8_SA(1, 0), cA + kstep, voffA); PG8_STAGE(PG8_SB(1, 1), cB + hstep + kstep, voffB);
    PG8_WAIT_V(6); PG8_BAR;
    PG8_STAMP();
    for (;;) {
        const bool has_next = S.next(ui + 1, nxt);
        const char* nA = has_next ? (const char*)g.A + (size_t)nxt.pm * tstep : cA; const char* nB = has_next ? (const char*)g.Bt + (size_t)nxt.pn * tstep : cB;
        for (int t = 0; t < nt; t += 2) {
            const bool last = (t == nt - 2);
            const char* a1 = cA + (size_t)(t + 1) * kstep;
            const char* a2 = last ? nA : cA + (size_t)(t + 2) * kstep; const char* b2 = last ? nB : cB + (size_t)(t + 2) * kstep;
            const char* a3 = a2 + kstep; const char* b3 = b2 + kstep;
            if (last && has_next) S.a_ready(nxt);
            PG8_LDB(B0, 0, 0); PG8_SCHED; PG8_LDA(At, 0, 0); PG8_STAGE(PG8_SA(1, 1), a1 + hstep, voffA);
            PG8_WAIT_L(8); PG8_BAR; PG8_WAIT_L(0); PG8_MMA(0, 0, At, B0); PG8_BAR; PG8_SCHED;
            PG8_LDB(B1, 0, 1); PG8_STAGE(PG8_SB(0, 0), b2, voffB);
            PG8_BAR; PG8_WAIT_L(0); PG8_MMA(0, 1, At, B1); PG8_BAR;
            PG8_LDA(At, 0, 1); PG8_STAGE(PG8_SA(0, 0), a2, voffA);
            PG8_BAR; PG8_WAIT_L(0); PG8_MMA(1, 0, At, B0); PG8_BAR; PG8_SCHED;
            PG8_STAGE(PG8_SB(0, 1), b2 + hstep, voffB);
            PG8_WAIT_V(6); PG8_BAR; PG8_MMA(1, 1, At, B1); PG8_BAR;
            PG8_LDB(B0, 1, 0); PG8_SCHED; PG8_LDA(At, 1, 0); PG8_STAGE(PG8_SA(0, 1), a2 + hstep, voffA);
            PG8_WAIT_L(8); PG8_BAR; PG8_WAIT_L(0); PG8_MMA(0, 0, At, B0); PG8_BAR; PG8_SCHED;
            PG8_LDB(B1, 1, 1); PG8_STAGE(PG8_SB(1, 0), b3, voffB);
            PG8_BAR; PG8_WAIT_L(0); PG8_MMA(0, 1, At, B1); PG8_BAR;
            PG8_LDA(At, 1, 1); PG8_STAGE(PG8_SA(1, 0), a3, voffA);
            PG8_BAR; PG8_WAIT_L(0); PG8_MMA(1, 0, At, B0); PG8_BAR; PG8_SCHED;
            PG8_STAGE(PG8_SB(1, 1), b3 + hstep, voffB);
            PG8_WAIT_V(6); PG8_BAR; PG8_MMA(1, 1, At, B1); PG8_BAR;
        }
        PG8_STAMP();
        if constexpr (!Epi::AFTER_DRAIN) { E(acc, cur, wr, wc, fr, fq); S.done(cur); }
        PG8_STAMP();
        if (!has_next) break;
#pragma unroll
        for (int a = 0; a < 2; ++a)
#pragma unroll
            for (int b = 0; b < 2; ++b)
#pragma unroll
                for (int m = 0; m < 4; ++m)
#pragma unroll
                    for (int n = 0; n < 2; ++n) acc[a][b][m][n] = (f32x4){0.f, 0.f, 0.f, 0.f};
        cur = nxt; cA = nA; cB = nB; ++ui;
    }
    PG8_WAIT_V(0);
    if (wr == 0) PG8_BAR;
    PG8_BAR;
    if constexpr (Epi::AFTER_DRAIN) { E.fused(acc, cur, wr, wc, fr, fq, lds, wid, lane); S.done(cur); }
    PG8_STAMP();
    if (STAMP && wid == 0) { stamps[lane] = lane < nts ? (((unsigned long long)(unsigned)ts_hi << 32) | (unsigned)ts_lo) : 0ull;
        if (lane == 62) stamps[62] = rt_entry; if (lane == 63) stamps[63] = (unsigned long long)wall_clock64(); }
#undef PG8_STAMP
#undef PG8_SA
#undef PG8_SB
#undef PG8_STAGE
#undef PG8_LDA
#undef PG8_LDB
#undef PG8_MMA
#undef PG8_WAIT_V
#undef PG8_WAIT_L
#undef PG8_BAR
#undef PG8_SCHED
}
}
namespace mk {
using pg8::bf16_t; using pg8::bf16x8; using pg8::f32x4; using pg8::u32x4; using pg8::cvt_pk_bf16;
typedef float f32x16 __attribute__((ext_vector_type(16)));
typedef float f32x2 __attribute__((ext_vector_type(2)));
typedef unsigned u32x2 __attribute__((ext_vector_type(2)));
constexpr int D = 1024, NB = 32, SEQ = 2048, M = NB * SEQ, NH = 8, DH = 64;
constexpr int RWC = 1792, GC = 2048, INC = 5376, DFF = 2816;
constexpr float RMS_EPS = 1e-6f, GN_EPS = 64e-5f;
constexpr size_t MiB = (size_t)1 << 20;
constexpr size_t O_WIN = 0, O_WSB = 11 * MiB, O_WRW = 12 * MiB, O_WO = 13 * MiB, O_WGU = 15 * MiB, O_WDN = 26 * MiB, O_WLU = 32 * MiB  , O_WLA = O_WLU + 65536, O_WLG = O_WLA + 65536;
constexpr size_t O_Q = 34 * MiB, O_K = 98 * MiB, O_VT = 162 * MiB, O_PRW = 226 * MiB, O_H = 450 * MiB, O_SI = 450 * MiB, O_G = 834 * MiB, O_SC = 898 * MiB, O_YR = 906 * MiB;
constexpr size_t O_OSB = 226 * MiB, O_ORW = 290 * MiB, O_T1 = 34 * MiB, O_MRG = 450 * MiB, O_TT = 34 * MiB, O_H2 = 162 * MiB, O_HID = 290 * MiB, O_FF = 34 * MiB;
constexpr size_t WS_NEED = 970 * MiB;
constexpr int LDS_BYTES = pg8::STAGE_BYTES;
constexpr int NPH = 12;

struct Args { const float* in[24]; float* out; unsigned char* ws; int ph_lo, ph_hi; };

__device__ __forceinline__ int my_tid() { int t = threadIdx.x; asm volatile("" : "+v"(t)); return t; }
__device__ __forceinline__ float bf_lo(unsigned u) { return __uint_as_float(u << 16); }
__device__ __forceinline__ float bf_hi(unsigned u) { return __uint_as_float(u & 0xffff0000u); }
__device__ __forceinline__ float fexp(float x) { return __builtin_amdgcn_exp2f(x * 1.44269504089f); }
__device__ __forceinline__ float flog(float x) { return __builtin_amdgcn_logf(x) * 0.69314718056f; }
__device__ __forceinline__ float frcp(float x) { return __builtin_amdgcn_rcpf(x); }
__device__ __forceinline__ float fsigmoid(float x) { return frcp(1.f + fexp(-x)); }
__device__ __forceinline__ unsigned short bf1(float x) { return (unsigned short)(cvt_pk_bf16(x, x) & 0xffffu); }
__device__ __forceinline__ u32x4 pack8(const f32x4 a, const f32x4 b) { u32x4 o; o.x = cvt_pk_bf16(a[0], a[1]); o.y = cvt_pk_bf16(a[2], a[3]); o.z = cvt_pk_bf16(b[0], b[1]); o.w = cvt_pk_bf16(b[2], b[3]); return o; }
__device__ __forceinline__ float red16(float v) {
    v += __shfl_xor(v, 16); v += __shfl_xor(v, 32); return v;
}
__device__ __forceinline__ float wave_sum(float v) {
#pragma unroll
    for (int o = 1; o < 64; o <<= 1) v += __shfl_xor(v, o);
    return v;
}

__device__ __forceinline__ void tr_item(const float* __restrict__ W, int K, int N, bf16_t* WT, float* scr, int item, int lane, int mode) {
    const int nblk = N >> 5, kb = item / nblk, nb = item - kb * nblk, k0 = kb << 6, n0 = nb << 5;
#pragma unroll 8
    for (int i = 0; i < 32; ++i) { const int kk = 2 * i + (lane >> 5); scr[kk * 33 + (lane & 31)] = W[(size_t)(k0 + kk) * N + n0 + (lane & 31)]; }
    asm volatile("s_waitcnt lgkmcnt(0)" ::: "memory"); __builtin_amdgcn_wave_barrier();
    const int c = lane & 7;
#pragma unroll
    for (int j = 0; j < 4; ++j) {
        const int n = (lane >> 3) + 8 * j; const float* s = scr + (8 * c) * 33 + n;
        u32x4 o; o.x = cvt_pk_bf16(s[0 * 33], s[1 * 33]); o.y = cvt_pk_bf16(s[2 * 33], s[3 * 33]); o.z = cvt_pk_bf16(s[4 * 33], s[5 * 33]); o.w = cvt_pk_bf16(s[6 * 33], s[7 * 33]);
        const int nn = n0 + n; int drow = nn;
        if (mode == 1) drow = ((nn >> 7) << 8) + (nn & 127); else if (mode == 2) drow = ((nn >> 7) << 8) + 128 + (nn & 127);
        *(u32x4*)(WT + (size_t)drow * K + k0 + 8 * c) = o;
    }
    asm volatile("s_waitcnt lgkmcnt(0)" ::: "memory"); __builtin_amdgcn_wave_barrier();
}

__device__ __forceinline__ void phase_prep(const Args& a, float* lds_f, int G) {
    const int tid = my_tid(); const int wave = tid >> 6, lane = tid & 63;
    const int gw = blockIdx.x * 8 + wave, NGW = G * 8;
    float* scr = lds_f + wave * (64 * 33 + 16);
    unsigned char* ws = a.ws;
    constexpr int I_IN = 16 * 168, I_SB = 8 * 32, I_O = 16 * 32, I_G = 16 * 88, I_DN = 44 * 32, I_LU = 16, I_LG = 32;
    constexpr int NIT = I_IN + 2 * I_SB + I_O + 2 * I_G + I_DN + 2 * I_LU + I_LG;
    for (int it = gw; it < NIT; it += NGW) {
        int r = it;
        if (r < I_IN) { tr_item(a.in[2], 1024, INC, (bf16_t*)(ws + O_WIN), scr, r, lane, 0); continue; } r -= I_IN;
        if (r < I_SB) { tr_item(a.in[15], 512, 1024, (bf16_t*)(ws + O_WSB), scr, r, lane, 0); continue; } r -= I_SB;
        if (r < I_SB) { tr_item(a.in[16], 512, 1024, (bf16_t*)(ws + O_WRW), scr, r, lane, 0); continue; } r -= I_SB;
        if (r < I_O) { tr_item(a.in[17], 1024, 1024, (bf16_t*)(ws + O_WO), scr, r, lane, 0); continue; } r -= I_O;
        if (r < I_G) { tr_item(a.in[20], 1024, DFF, (bf16_t*)(ws + O_WGU), scr, r, lane, 1); continue; } r -= I_G;
        if (r < I_G) { tr_item(a.in[21], 1024, DFF, (bf16_t*)(ws + O_WGU), scr, r, lane, 2); continue; } r -= I_G;
        if (r < I_DN) { tr_item(a.in[22], DFF, 1024, (bf16_t*)(ws + O_WDN), scr, r, lane, 0); continue; } r -= I_DN;
        if (r < I_LU) { tr_item(a.in[6], 64, 512, (bf16_t*)(ws + O_WLU), scr, r, lane, 0); continue; } r -= I_LU;
        if (r < I_LU) { tr_item(a.in[8], 64, 512, (bf16_t*)(ws + O_WLA), scr, r, lane, 0); continue; } r -= I_LU;
        tr_item(a.in[9], 128, 512, (bf16_t*)(ws + O_WLG), scr, r, lane, 0);
    }
    const float* x = a.in[0]; const float* g = a.in[1]; bf16_t* H = (bf16_t*)(ws + O_H);
    f32x4 gv[4];
#pragma unroll
    for (int j = 0; j < 4; ++j) gv[j] = ((const f32x4*)g)[lane + 64 * j];
    for (int row = gw; row < M; row += NGW) {
        const f32x4* xr = (const f32x4*)(x + (size_t)row * D) + lane;
        f32x4 v[4]; float s = 0.f;
#pragma unroll
        for (int j = 0; j < 4; ++j) { v[j] = xr[64 * j]; s += (v[j][0] * v[j][0] + v[j][1] * v[j][1]) + (v[j][2] * v[j][2] + v[j][3] * v[j][3]); }
        const float rs = rsqrtf(wave_sum(s) * (1.f / D) + RMS_EPS);
        u32x2* o = (u32x2*)(H + (size_t)row * D) + lane;
#pragma unroll
        for (int j = 0; j < 4; ++j) { u32x2 w; w.x = cvt_pk_bf16(v[j][0] * rs * gv[j][0], v[j][1] * rs * gv[j][1]); w.y = cvt_pk_bf16(v[j][2] * rs * gv[j][2], v[j][3] * rs * gv[j][3]); o[64 * j] = w; }
    }
}

struct Epi1 {
    static constexpr bool PERM = true, AFTER_DRAIN = false;
    bf16_t *Q, *Kb, *Vt, *Prw, *Gt; const float* bgate;
    __device__ __forceinline__ void operator()(const f32x4 (&acc)[2][2][4][2], const pg8::Unit& u, int wr, int wc, int fr, int fq) const {
        const int row0 = u.pm * 256 + wr * 64 + fr, pn = u.pn, cl = wc * 32 + 8 * fq;
        if (pn < 4) {
            bf16_t* dst = pn < 2 ? Q : Kb; const float sc = pn < 2 ? 0.125f : 1.f; const int cb = (pn & 1) * 256 + cl;
#pragma unroll
            for (int ai = 0; ai < 2; ++ai)
#pragma unroll
                for (int m = 0; m < 4; ++m) { bf16_t* rp = dst + (size_t)(row0 + ai * 128 + m * 16) * 512 + cb;
#pragma unroll
                    for (int bj = 0; bj < 2; ++bj) *(u32x4*)(rp + bj * 128) = pack8(acc[ai][bj][m][0] * sc, acc[ai][bj][m][1] * sc); }
        } else if (pn < 6) {
#pragma unroll
            for (int ai = 0; ai < 2; ++ai)
#pragma unroll
                for (int m = 0; m < 4; ++m) { const int row = row0 + ai * 128 + m * 16, b = row >> 11, s = row & 2047;
#pragma unroll
                    for (int bj = 0; bj < 2; ++bj)
#pragma unroll
                        for (int n = 0; n < 2; ++n)
#pragma unroll
                            for (int j = 0; j < 4; ++j) { const int c = (pn - 4) * 256 + bj * 128 + cl + 4 * n + j;
                                Vt[((size_t)(b * 512 + c)) * 2048 + s] = bf1(acc[ai][bj][m][n][j]); } }
        } else if (pn < 13) {
            const int cb = (pn - 6) * 256 + cl;
#pragma unroll
            for (int ai = 0; ai < 2; ++ai)
#pragma unroll
                for (int m = 0; m < 4; ++m) { bf16_t* rp = Prw + (size_t)(row0 + ai * 128 + m * 16) * RWC + cb;
#pragma unroll
                    for (int bj = 0; bj < 2; ++bj) *(u32x4*)(rp + bj * 128) = pack8(acc[ai][bj][m][0], acc[ai][bj][m][1]); }
        } else {
            const int cb = (pn - 13) * 256 + cl;
#pragma unroll
            for (int ai = 0; ai < 2; ++ai)
#pragma unroll
                for (int m = 0; m < 4; ++m) { bf16_t* rp = Gt + (size_t)(row0 + ai * 128 + m * 16) * GC + cb;
#pragma unroll
                    for (int bj = 0; bj < 2; ++bj) { f32x4 v0 = acc[ai][bj][m][0] + *(const f32x4*)(bgate + cb + bj * 128), v1 = acc[ai][bj][m][1] + *(const f32x4*)(bgate + cb + bj * 128 + 4);
#pragma unroll
                        for (int j = 0; j < 4; ++j) { v0[j] = fsigmoid(v0[j]); v1[j] = fsigmoid(v1[j]); }
                        *(u32x4*)(rp + bj * 128) = pack8(v0, v1); } }
        }
    }
};
template <int MODE> struct EpiRow {
    static constexpr bool PERM = true, AFTER_DRAIN = false;
    bf16_t* O; const bf16_t* T1; const bf16_t* Gt;
    __device__ __forceinline__ void operator()(const f32x4 (&acc)[2][2][4][2], const pg8::Unit& u, int wr, int wc, int fr, int fq) const {
        const int row0 = u.pm * 256 + wr * 64 + fr, cb = u.pn * 256 + wc * 32 + 8 * fq;
#pragma unroll
        for (int ai = 0; ai < 2; ++ai)
#pragma unroll
            for (int m = 0; m < 4; ++m) { const size_t row = (size_t)(row0 + ai * 128 + m * 16);
#pragma unroll
                for (int bj = 0; bj < 2; ++bj) { f32x4 v0 = acc[ai][bj][m][0], v1 = acc[ai][bj][m][1]; const int c = cb + bj * 128;
                    if (MODE >= 1) { const u32x4 gg = *(const u32x4*)(Gt + row * GC + (MODE == 2 ? 1024 : 0) + c);
                        v0[0] *= bf_lo(gg.x); v0[1] *= bf_hi(gg.x); v0[2] *= bf_lo(gg.y); v0[3] *= bf_hi(gg.y); v1[0] *= bf_lo(gg.z); v1[1] *= bf_hi(gg.z); v1[2] *= bf_lo(gg.w); v1[3] *= bf_hi(gg.w); }
                    if (MODE == 2) { const u32x4 tt = *(const u32x4*)(T1 + row * 1024 + c);
                        v0[0] += bf_lo(tt.x); v0[1] += bf_hi(tt.x); v0[2] += bf_lo(tt.y); v0[3] += bf_hi(tt.y); v1[0] += bf_lo(tt.z); v1[1] += bf_hi(tt.z); v1[2] += bf_lo(tt.w); v1[3] += bf_hi(tt.w); }
                    *(u32x4*)(O + row * 1024 + c) = pack8(v0, v1); } }
    }
};
struct EpiSwiGLU {
    static constexpr bool PERM = true, AFTER_DRAIN = false;
    bf16_t* Hd;
    __device__ __forceinline__ void operator()(const f32x4 (&acc)[2][2][4][2], const pg8::Unit& u, int wr, int wc, int fr, int fq) const {
        const int row0 = u.pm * 256 + wr * 64 + fr, cb = u.pn * 128 + wc * 32 + 8 * fq;
#pragma unroll
        for (int ai = 0; ai < 2; ++ai)
#pragma unroll
            for (int m = 0; m < 4; ++m) { f32x4 v0, v1;
#pragma unroll
                for (int j = 0; j < 4; ++j) { const float g0 = acc[ai][0][m][0][j], g1 = acc[ai][0][m][1][j];
                    v0[j] = g0 * fsigmoid(g0) * acc[ai][1][m][0][j]; v1[j] = g1 * fsigmoid(g1) * acc[ai][1][m][1][j]; }
                *(u32x4*)(Hd + (size_t)(row0 + ai * 128 + m * 16) * DFF + cb) = pack8(v0, v1); }
    }
};
template <class Epi> __device__ __forceinline__ void run_gemm(PG8_LAS unsigned char* lds, const bf16_t* A, const bf16_t* Bt, int N, int K, const Epi& E, int G) {
    pg8::Gemm g; g.A = A; g.Bt = Bt; g.M = M; g.N = N; g.K = K;
    pg8::StaticOrder S; S.init(M, N, G, (int)blockIdx.x);
    pg8::gemm_phase<Epi, pg8::StaticOrder, false>(lds, g, S, E, nullptr);
}
__device__ __forceinline__ void load_mix8(const bf16_t* cur, bool hasprev, const float* mu, float (&o)[8]) {
    const u32x4 c = *(const u32x4*)cur; u32x4 p = {0u, 0u, 0u, 0u};
    if (hasprev) p = *(const u32x4*)(cur - RWC);
    const f32x4 m0 = *(const f32x4*)mu, m1 = *(const f32x4*)(mu + 4);
    const float mm[8] = {m0[0], m0[1], m0[2], m0[3], m1[0], m1[1], m1[2], m1[3]};
#pragma unroll
    for (int i = 0; i < 4; ++i) { const float cl = bf_lo(c[i]), ch = bf_hi(c[i]), pl = bf_lo(p[i]), ph = bf_hi(p[i]);
        o[2 * i] = cl + (pl - cl) * mm[2 * i]; o[2 * i + 1] = ch + (ph - ch) * mm[2 * i + 1]; }
}
__device__ __forceinline__ void load_mix4(const bf16_t* cur, bool hasprev, const float* mu, float (&o)[4]) {
    const u32x2 c = *(const u32x2*)cur; u32x2 p = {0u, 0u};
    if (hasprev) p = *(const u32x2*)(cur - RWC);
    const f32x4 m0 = *(const f32x4*)mu;
#pragma unroll
    for (int i = 0; i < 2; ++i) { const float cl = bf_lo(c[i]), ch = bf_hi(c[i]), pl = bf_lo(p[i]), ph = bf_hi(p[i]);
        o[2 * i] = cl + (pl - cl) * m0[2 * i]; o[2 * i + 1] = ch + (ph - ch) * m0[2 * i + 1]; }
}
__device__ __forceinline__ bf16x8 pack_frag(const float (&v)[8]) {
    u32x4 o; o.x = cvt_pk_bf16(v[0], v[1]); o.y = cvt_pk_bf16(v[2], v[3]); o.z = cvt_pk_bf16(v[4], v[5]); o.w = cvt_pk_bf16(v[6], v[7]);
    return __builtin_bit_cast(bf16x8, o);
}
__device__ __forceinline__ void phase_rwprep(const Args& a, int G) {
    const int tid = my_tid(); const int wave = tid >> 6, lane = tid & 63, fr = lane & 15, fq = lane >> 4;
    const int gw = blockIdx.x * 8 + wave, NGW = G * 8;
    unsigned char* ws = a.ws;
    const bf16_t* PRW = (const bf16_t*)(ws + O_PRW);
    const bf16_t* WLU = (const bf16_t*)(ws + O_WLU); const bf16_t* WLA = (const bf16_t*)(ws + O_WLA); const bf16_t* WLG = (const bf16_t*)(ws + O_WLG);
    unsigned char* SI = ws + O_SI; bf16_t* GB = (bf16_t*)(ws + O_G); float* SC = (float*)(ws + O_SC);
    const float *mu = a.in[4], *w0 = a.in[5], *a0 = a.in[7], *k_k = a.in[10], *k_a = a.in[11], *r_k = a.in[12];
    for (int item = gw; item < M / 16; item += NGW) {
        const int m = item * 16 + fr; const bool hp = (m & (SEQ - 1)) != 0;
        const bf16_t* prow = PRW + (size_t)m * RWC;
        bf16x8 Aw[2], Aa[2], Ag[4];
        float t8[8];
#pragma unroll
        for (int s = 0; s < 2; ++s) { load_mix8(prow + 1536 + 32 * s + 8 * fq, hp, mu + 1536 + 32 * s + 8 * fq, t8);
#pragma unroll
            for (int i = 0; i < 8; ++i) { const float e = fexp(2.f * t8[i]); t8[i] = 1.f - 2.f * frcp(e + 1.f); }
            Aw[s] = pack_frag(t8); }
#pragma unroll
        for (int s = 0; s < 2; ++s) { load_mix8(prow + 1600 + 32 * s + 8 * fq, hp, mu + 1600 + 32 * s + 8 * fq, t8); Aa[s] = pack_frag(t8); }
#pragma unroll
        for (int s = 0; s < 4; ++s) { load_mix8(prow + 1664 + 32 * s + 8 * fq, hp, mu + 1664 + 32 * s + 8 * fq, t8);
#pragma unroll
            for (int i = 0; i < 8; ++i) t8[i] = fsigmoid(t8[i]);
            Ag[s] = pack_frag(t8); }
#pragma unroll 1
        for (int h = 0; h < NH; ++h) {
            float kkr[16], av[16]; unsigned lk[16], rvp[16];
            float ss = 0.f, brs = 0.f, krs = 0.f, rkbs = 0.f;
#pragma unroll
            for (int n = 0; n < 4; ++n) {
                const int cb = 64 * h + 16 * n, c0 = cb + 4 * fq;
                f32x4 aw = {0.f, 0.f, 0.f, 0.f}, aa = aw, ag = aw;
#pragma unroll
                for (int s = 0; s < 2; ++s) {
                    aw = __builtin_amdgcn_mfma_f32_16x16x32_bf16(*(const bf16x8*)(WLU + (size_t)(cb + fr) * 64 + 32 * s + 8 * fq), Aw[s], aw, 0, 0, 0);
                    aa = __builtin_amdgcn_mfma_f32_16x16x32_bf16(*(const bf16x8*)(WLA + (size_t)(cb + fr) * 64 + 32 * s + 8 * fq), Aa[s], aa, 0, 0, 0); }
#pragma unroll
                for (int s = 0; s < 4; ++s)
                    ag = __builtin_amdgcn_mfma_f32_16x16x32_bf16(*(const bf16x8*)(WLG + (size_t)(cb + fr) * 128 + 32 * s + 8 * fq), Ag[s], ag, 0, 0, 0);
                float rr[4], kr4[4], vv[4];
                load_mix4(prow + c0, hp, mu + c0, rr); load_mix4(prow + 512 + c0, hp, mu + 512 + c0, kr4); load_mix4(prow + 1024 + c0, hp, mu + 1024 + c0, vv);
                const f32x4 w0v = *(const f32x4*)(w0 + c0), a0v = *(const f32x4*)(a0 + c0), kkv = *(const f32x4*)(k_k + c0), kav = *(const f32x4*)(k_a + c0), rkv = *(const f32x4*)(r_k + c0);
#pragma unroll
                for (int j = 0; j < 4; ++j) {
                    const float sg = fsigmoid(w0v[j] + aw[j]);
                    const float ldx = -0.60653065971f * 1.44269504089f * sg;
                    const float av_ = fsigmoid(a0v[j] + aa[j]);
                    const float kkraw = kr4[j] * kkv[j];
                    const float k2 = kr4[j] * (1.f + (av_ - 1.f) * kav[j]);
                    ss += kkraw * kkraw; brs += kkraw * av_ * rr[j]; krs += k2 * rr[j]; rkbs += rr[j] * k2 * rkv[j];
                    kkr[4 * n + j] = kkraw; av[4 * n + j] = av_; lk[4 * n + j] = cvt_pk_bf16(ldx, k2); rvp[4 * n + j] = cvt_pk_bf16(rr[j], vv[j]);
                }
                u32x2 gp; gp.x = cvt_pk_bf16(ag[0], ag[1]); gp.y = cvt_pk_bf16(ag[2], ag[3]);
                *(u32x2*)(GB + (size_t)m * 512 + c0) = gp;
            }
            ss = red16(ss); brs = red16(brs); krs = red16(krs); rkbs = red16(rkbs);
            const float inv = 1.f / fmaxf(sqrtf(ss), 1e-12f);
            unsigned char* rec = SI + (((size_t)m * 8 + h) * 64) * 12;
#pragma unroll
            for (int n = 0; n < 4; ++n) {
                unsigned dw[12];
#pragma unroll
                for (int j = 0; j < 4; ++j) { const float kk = kkr[4 * n + j] * inv;
                    const unsigned kp = cvt_pk_bf16(kk * av[4 * n + j], -kk);
                    dw[3 * j] = (lk[4 * n + j] & 0xffffu) | (kp & 0xffff0000u); dw[3 * j + 1] = (kp & 0xffffu) | (lk[4 * n + j] & 0xffff0000u); dw[3 * j + 2] = rvp[4 * n + j]; }
                u32x4* dst = (u32x4*)(rec + (16 * n + 4 * fq) * 12);
                u32x4 s0 = {dw[0], dw[1], dw[2], dw[3]}, s1 = {dw[4], dw[5], dw[6], dw[7]}, s2 = {dw[8], dw[9], dw[10], dw[11]};
                dst[0] = s0; dst[1] = s1; dst[2] = s2;
            }
            if (fq == 0) { f32x4 sc = {brs * inv, krs, rkbs, 0.f}; *(f32x4*)(SC + ((size_t)m * 8 + h) * 4) = sc; }
        }
    }
}

#define MK_FMAC_BC(acc, src, s, n) asm("v_fmac_f32_dpp %0, %1, %2 row_newbcast:" #n " row_mask:0xf bank_mask:0xf" : "+v"(acc) : "v"(src), "v"(s))
#define MK_MUL_BC(dst, src, s, n) asm("v_mul_f32_dpp %0, %1, %2 row_newbcast:" #n " row_mask:0xf bank_mask:0xf" : "=v"(dst) : "v"(src), "v"(s))
#define MK_REP16(X) X(0) X(1) X(2) X(3) X(4) X(5) X(6) X(7) X(8) X(9) X(10) X(11) X(12) X(13) X(14) X(15)
__device__ __forceinline__ float red_rows(float x) {
    float a0 = x, a1 = x;
    asm volatile("s_nop 1\n\tv_permlane16_swap_b32 %0, %1" : "+v"(a0), "+v"(a1));
    float b0 = a0 + a1, b1 = b0;
    asm volatile("s_nop 1\n\tv_permlane32_swap_b32 %0, %1" : "+v"(b0), "+v"(b1));
    return b0 + b1;
}
struct ScanRec { unsigned d0, d1, d2; unsigned short vv; float br, kr; };
__device__ __forceinline__ void scan_load(ScanRec& R, const unsigned char* SI, const float* SC, size_t mh, int lane, int vrow) {
    const unsigned* p = (const unsigned*)(SI + (mh * 64 + lane) * 12);
    R.d0 = p[0]; R.d1 = p[1]; R.d2 = p[2];
    R.vv = *(const unsigned short*)(SI + (mh * 64 + vrow) * 12 + 10);
    const f32x2 s = *(const f32x2*)(SC + mh * 4); R.br = s[0]; R.kr = s[1];
}
__device__ __forceinline__ void scan_wave(const Args& a, int bh, int rb, int lane) {
    const unsigned char* SI = a.ws + O_SI; const float* SC = (const float*)(a.ws + O_SC); bf16_t* YR = (bf16_t*)(a.ws + O_YR);
    const int b = bh >> 3, h = bh & 7, r = lane & 15, vrow = 16 * rb + r;
    const size_t m0 = (size_t)b * SEQ;
    float S0 = 0.f, S1 = 0.f, S2 = 0.f, S3 = 0.f, S4 = 0.f, S5 = 0.f, S6 = 0.f, S7 = 0.f, S8 = 0.f, S9 = 0.f, S10 = 0.f, S11 = 0.f, S12 = 0.f, S13 = 0.f, S14 = 0.f, S15 = 0.f;
    ScanRec cur[8], nxt[8];
#pragma unroll
    for (int i = 0; i < 8; ++i) scan_load(cur[i], SI, SC, (m0 + i) * 8 + h, lane, vrow);
    for (int t0 = 0; t0 < SEQ; t0 += 8) {
        const int tn = (t0 + 8 < SEQ) ? t0 + 8 : t0;
#pragma unroll
        for (int i = 0; i < 8; ++i) scan_load(nxt[i], SI, SC, (m0 + tn + i) * 8 + h, lane, vrow);
#pragma unroll
        for (int i = 0; i < 8; ++i) {
            float nkk = bf_hi(cur[i].d0), kka = bf_lo(cur[i].d1), k2 = bf_hi(cur[i].d1);
            float w = __builtin_amdgcn_exp2f(bf_lo(cur[i].d0));
            float wr = w * bf_lo(cur[i].d2);
            const float v = __uint_as_float((unsigned)cur[i].vv << 16);
            asm volatile("s_nop 1" : "+v"(nkk), "+v"(kka), "+v"(k2), "+v"(w), "+v"(wr));
            float sa0 = 0.f, sa1 = 0.f, yp0 = 0.f, yp1 = 0.f;
#define MK_MV(n) if ((n) & 1) { MK_FMAC_BC(sa1, nkk, S##n, n); MK_FMAC_BC(yp1, wr, S##n, n); } else { MK_FMAC_BC(sa0, nkk, S##n, n); MK_FMAC_BC(yp0, wr, S##n, n); }
            MK_REP16(MK_MV)
#undef MK_MV
            const float sa = red_rows(sa0 + sa1), yp = red_rows(yp0 + yp1);
            float sav = sa, vv2 = v;
#define MK_UP(n) { MK_MUL_BC(S##n, w, S##n, n); MK_FMAC_BC(S##n, kka, sav, n); MK_FMAC_BC(S##n, k2, vv2, n); }
            MK_REP16(MK_UP)
#undef MK_UP
            const float y = yp + sa * cur[i].br + v * cur[i].kr;
            if (lane < 16) YR[(m0 + t0 + i) * 512 + 64 * h + vrow] = bf1(y);
        }
#pragma unroll
        for (int i = 0; i < 8; ++i) cur[i] = nxt[i];
    }
}

struct KV { bf16x8 k[4]; bf16x8 v[2][2]; };
__device__ __forceinline__ void attn_load(KV& T, const bf16_t* Kh, const bf16_t* Vh, int k0, int n, int hf) {
    const bf16_t* kp = Kh + (size_t)(k0 + n) * 512 + 8 * hf;
#pragma unroll
    for (int s = 0; s < 4; ++s) T.k[s] = *(const bf16x8*)(kp + 16 * s);
#pragma unroll
    for (int d = 0; d < 2; ++d)
#pragma unroll
        for (int sg = 0; sg < 2; ++sg) { const bf16_t* vp = Vh + (size_t)(32 * d + n) * SEQ + k0 + 16 * sg + 4 * hf;
            const u32x2 lo = *(const u32x2*)vp, hi = *(const u32x2*)(vp + 8); u32x4 t = {lo.x, lo.y, hi.x, hi.y}; T.v[d][sg] = __builtin_bit_cast(bf16x8, t); }
}
__device__ __forceinline__ void attn_wave(const Args& a, int bh, int w4, int lane) {
    const int b = bh >> 3, h = bh & 7, n = lane & 31, hf = lane >> 5;
    const size_t m0 = (size_t)b * SEQ;
    const bf16_t* Qh = (const bf16_t*)(a.ws + O_Q) + m0 * 512 + 64 * h;
    const bf16_t* Kh = (const bf16_t*)(a.ws + O_K) + m0 * 512 + 64 * h;
    const bf16_t* Vh = (const bf16_t*)(a.ws + O_VT) + (size_t)bh * 64 * SEQ;
    bf16_t* Oh = (bf16_t*)(a.ws + O_OSB) + m0 * 512 + 64 * h;
    for (int qt = 63 - w4; qt >= 0; qt -= 4) {
        const int q0 = 32 * qt;
        bf16x8 qf[4];
#pragma unroll
        for (int s = 0; s < 4; ++s) qf[s] = *(const bf16x8*)(Qh + (size_t)(q0 + n) * 512 + 16 * s + 8 * hf);
        f32x16 o0, o1;
#pragma unroll
        for (int i = 0; i < 16; ++i) { o0[i] = 0.f; o1[i] = 0.f; }
        float carry = 0.f;
        KV cur, nxt;
        attn_load(cur, Kh, Vh, q0, n, hf);
        for (int kt = qt; kt >= 0; --kt) {
            const int ktn = kt > 0 ? kt - 1 : 0;
            attn_load(nxt, Kh, Vh, 32 * ktn, n, hf);
            f32x16 sc;
#pragma unroll
            for (int i = 0; i < 16; ++i) sc[i] = 0.f;
#pragma unroll
            for (int s = 0; s < 4; ++s) sc = __builtin_amdgcn_mfma_f32_32x32x16_bf16(cur.k[s], qf[s], sc, 0, 0, 0);
            const bool diag = (kt == qt);
            float lf[16], G4[4];
#pragma unroll
            for (int g = 0; g < 4; ++g) { G4[g] = 0.f;
#pragma unroll
                for (int i = 0; i < 4; ++i) { const int r = 4 * g + i; const float z = sc[r];
                    const bool valid = !diag || (8 * g + 4 * hf + i < n);
                    const float e = fexp(-fabsf(z));
                    const float sp = fmaxf(z, 0.f) + flog(1.f + e);
                    lf[r] = valid ? -sp : 0.f; G4[g] += lf[r]; } }
            float PG[4], T4[4];
#pragma unroll
            for (int g = 0; g < 4; ++g) { PG[g] = __shfl_xor(G4[g], 32); T4[g] = G4[g] + PG[g]; }
            const float tail3 = 0.f, tail2 = T4[3], tail1 = T4[3] + T4[2], tail0 = tail1 + T4[1], total = tail0 + T4[0];
            const float tails[4] = {tail0, tail1, tail2, tail3};
            f32x16 wv;
#pragma unroll
            for (int g = 0; g < 4; ++g) {
                float af = carry + tails[g] + (hf == 0 ? PG[g] : 0.f);
#pragma unroll
                for (int i = 3; i >= 0; --i) { const int r = 4 * g + i; const float z = sc[r];
                    const bool valid = !diag || (8 * g + 4 * hf + i < n);
                    const float wgt = fexp(lf[r] + z + af);
                    wv[r] = valid ? wgt : 0.f;
                    af += lf[r]; } }
            carry += total;
            bf16x8 wf[2];
#pragma unroll
            for (int sg = 0; sg < 2; ++sg) { u32x4 t; t.x = cvt_pk_bf16(wv[8 * sg + 0], wv[8 * sg + 1]); t.y = cvt_pk_bf16(wv[8 * sg + 2], wv[8 * sg + 3]); t.z = cvt_pk_bf16(wv[8 * sg + 4], wv[8 * sg + 5]); t.w = cvt_pk_bf16(wv[8 * sg + 6], wv[8 * sg + 7]); wf[sg] = __builtin_bit_cast(bf16x8, t); }
#pragma unroll
            for (int sg = 0; sg < 2; ++sg) { o0 = __builtin_amdgcn_mfma_f32_32x32x16_bf16(cur.v[0][sg], wf[sg], o0, 0, 0, 0); o1 = __builtin_amdgcn_mfma_f32_32x32x16_bf16(cur.v[1][sg], wf[sg], o1, 0, 0, 0); }
            cur = nxt;
#if MK_EARLY_EXIT
            if (__all(carry < -104.f)) break;
#endif
        }
        bf16_t* op = Oh + (size_t)(q0 + n) * 512 + 4 * hf;
#pragma unroll
        for (int g = 0; g < 4; ++g) {
            u32x2 t0, t1; t0.x = cvt_pk_bf16(o0[4 * g], o0[4 * g + 1]); t0.y = cvt_pk_bf16(o0[4 * g + 2], o0[4 * g + 3]); t1.x = cvt_pk_bf16(o1[4 * g], o1[4 * g + 1]); t1.y = cvt_pk_bf16(o1[4 * g + 2], o1[4 * g + 3]);
            *(u32x2*)(op + 8 * g) = t0; *(u32x2*)(op + 32 + 8 * g) = t1; }
    }
}
__device__ __forceinline__ void phase_mixer(const Args& a, int G) {
    const int tid = my_tid(); const int wave = __builtin_amdgcn_readfirstlane(tid >> 6), lane = tid & 63;
    for (int bh = blockIdx.x; bh < NB * NH; bh += G) {
        if (wave < 4) scan_wave(a, bh, wave, lane);
        else attn_wave(a, bh, wave - 4, lane);
    }
}

__device__ __forceinline__ void phase_rwpost(const Args& a, int G) {
    const unsigned char* SI = a.ws + O_SI; const float* SC = (const float*)(a.ws + O_SC);
    const bf16_t* YR = (const bf16_t*)(a.ws + O_YR); const bf16_t* GB = (const bf16_t*)(a.ws + O_G); bf16_t* ORW = (bf16_t*)(a.ws + O_ORW);
    const float *lw = a.in[13], *lb = a.in[14];
    const size_t total = (size_t)M * 128, stride = (size_t)G * 512;
    const int tid = my_tid();
    for (size_t idx = (size_t)blockIdx.x * 512 + tid; idx < total; idx += stride) {
        const size_t m = idx >> 7; const int c = ((int)idx & 127) * 4, h = c >> 6, cc = c & 63;
        const u32x2 yb = *(const u32x2*)(YR + m * 512 + c);
        float y[4] = {bf_lo(yb.x), bf_hi(yb.x), bf_lo(yb.y), bf_hi(yb.y)};
        float s = (y[0] + y[1]) + (y[2] + y[3]);
#pragma unroll
        for (int o = 1; o < 16; o <<= 1) s += __shfl_xor(s, o);
        const float mean = s * (1.f / 64.f);
        float q = 0.f;
#pragma unroll
        for (int j = 0; j < 4; ++j) { y[j] -= mean; q += y[j] * y[j]; }
#pragma unroll
        for (int o = 1; o < 16; o <<= 1) q += __shfl_xor(q, o);
        const float rstd = rsqrtf(q * (1.f / 64.f) + GN_EPS);
        const float rkb = SC[(m * 8 + h) * 4 + 2];
        const u32x2 gb = *(const u32x2*)(GB + m * 512 + c);
        const float g4[4] = {bf_lo(gb.x), bf_hi(gb.x), bf_lo(gb.y), bf_hi(gb.y)};
        const f32x4 lwv = *(const f32x4*)(lw + c), lbv = *(const f32x4*)(lb + c);
        float o4[4];
#pragma unroll
        for (int j = 0; j < 4; ++j) { const float v = __uint_as_float((unsigned)(*(const unsigned short*)(SI + ((m * 8 + h) * 64 + cc + j) * 12 + 10)) << 16);
            o4[j] = (y[j] * rstd * lwv[j] + lbv[j] + rkb * v) * g4[j]; }
        u32x2 ob; ob.x = cvt_pk_bf16(o4[0], o4[1]); ob.y = cvt_pk_bf16(o4[2], o4[3]);
        *(u32x2*)(ORW + m * 512 + c) = ob;
    }
}

template <int MODE> __device__ __forceinline__ void phase_rows(const Args& a, int G) {
    const int tid = my_tid(); const int wave = tid >> 6, lane = tid & 63;
    const int gw = blockIdx.x * 8 + wave, NGW = G * 8;
    const bf16_t* T = (const bf16_t*)(a.ws + (MODE == 0 ? O_TT : O_FF));
    const float* xin = MODE == 0 ? a.in[0] : a.out; const float* g1 = MODE == 0 ? a.in[18] : a.in[23]; const float* g2 = a.in[19];
    bf16_t* H2 = (bf16_t*)(a.ws + O_H2);
    f32x4 g1v[4], g2v[4];
#pragma unroll
    for (int j = 0; j < 4; ++j) { g1v[j] = ((const f32x4*)g1)[lane + 64 * j]; g2v[j] = ((const f32x4*)g2)[lane + 64 * j]; }
    for (int row = gw; row < M; row += NGW) {
        const u32x2* tr = (const u32x2*)(T + (size_t)row * D) + lane; const f32x4* xr = (const f32x4*)(xin + (size_t)row * D) + lane;
        f32x4 t[4], x[4]; float s = 0.f;
#pragma unroll
        for (int j = 0; j < 4; ++j) { const u32x2 tb = tr[64 * j]; x[j] = xr[64 * j]; t[j][0] = bf_lo(tb.x); t[j][1] = bf_hi(tb.x); t[j][2] = bf_lo(tb.y); t[j][3] = bf_hi(tb.y);
            s += (t[j][0] * t[j][0] + t[j][1] * t[j][1]) + (t[j][2] * t[j][2] + t[j][3] * t[j][3]); }
        const float rs = rsqrtf(wave_sum(s) * (1.f / D) + RMS_EPS);
        float s2 = 0.f; f32x4* orow = (f32x4*)(a.out + (size_t)row * D) + lane;
#pragma unroll
        for (int j = 0; j < 4; ++j) {
#pragma unroll
            for (int e = 0; e < 4; ++e) { x[j][e] += t[j][e] * rs * g1v[j][e]; s2 += x[j][e] * x[j][e]; }
            orow[64 * j] = x[j]; }
        if (MODE == 0) {
            const float rs2 = rsqrtf(wave_sum(s2) * (1.f / D) + RMS_EPS);
            u32x2* o = (u32x2*)(H2 + (size_t)row * D) + lane;
#pragma unroll
            for (int j = 0; j < 4; ++j) { u32x2 w; w.x = cvt_pk_bf16(x[j][0] * rs2 * g2v[j][0], x[j][1] * rs2 * g2v[j][1]); w.y = cvt_pk_bf16(x[j][2] * rs2 * g2v[j][2], x[j][3] * rs2 * g2v[j][3]); o[64 * j] = w; }
        }
    }
}

__global__ void __launch_bounds__(512, 2) mega(Args a) {
    extern __shared__ __attribute__((aligned(16))) unsigned char shm[];
    PG8_LAS unsigned char* lds = (PG8_LAS unsigned char*)shm;
    const int G = (int)gridDim.x;
    unsigned char* ws = a.ws;
    for (int ph = a.ph_lo; ph < a.ph_hi; ++ph) {
        if (ph > a.ph_lo) cg::this_grid().sync();
        switch (ph) {
        case 0: phase_prep(a, (float*)shm, G); break;
        case 1: { Epi1 E; E.Q = (bf16_t*)(ws + O_Q); E.Kb = (bf16_t*)(ws + O_K); E.Vt = (bf16_t*)(ws + O_VT); E.Prw = (bf16_t*)(ws + O_PRW); E.Gt = (bf16_t*)a.out; E.bgate = a.in[3];
            run_gemm(lds, (const bf16_t*)(ws + O_H), (const bf16_t*)(ws + O_WIN), INC, 1024, E, G); } break;
        case 2: phase_rwprep(a, G); break;
        case 3: phase_mixer(a, G); break;
        case 4: phase_rwpost(a, G); break;
        case 5: { EpiRow<1> E; E.O = (bf16_t*)(ws + O_T1); E.T1 = nullptr; E.Gt = (const bf16_t*)a.out;
            run_gemm(lds, (const bf16_t*)(ws + O_OSB), (const bf16_t*)(ws + O_WSB), 1024, 512, E, G); } break;
        case 6: { EpiRow<2> E; E.O = (bf16_t*)(ws + O_MRG); E.T1 = (const bf16_t*)(ws + O_T1); E.Gt = (const bf16_t*)a.out;
            run_gemm(lds, (const bf16_t*)(ws + O_ORW), (const bf16_t*)(ws + O_WRW), 1024, 512, E, G); } break;
        case 7: { EpiRow<0> E; E.O = (bf16_t*)(ws + O_TT); E.T1 = nullptr; E.Gt = nullptr;
            run_gemm(lds, (const bf16_t*)(ws + O_MRG), (const bf16_t*)(ws + O_WO), 1024, 1024, E, G); } break;
        case 8: phase_rows<0>(a, G); break;
        case 9: { EpiSwiGLU E; E.Hd = (bf16_t*)(ws + O_HID);
            run_gemm(lds, (const bf16_t*)(ws + O_H2), (const bf16_t*)(ws + O_WGU), 2 * DFF, 1024, E, G); } break;
        case 10: { EpiRow<0> E; E.O = (bf16_t*)(ws + O_FF); E.T1 = nullptr; E.Gt = nullptr;
            run_gemm(lds, (const bf16_t*)(ws + O_HID), (const bf16_t*)(ws + O_WDN), 1024, DFF, E, G); } break;
        case 11: phase_rows<1>(a, G); break;
        }
    }
}
}

#if MK_DIAG
namespace dg {
using namespace mk;
constexpr size_t O_ERR = 1000 * MiB;
__device__ __forceinline__ float bfr(float x) { return __uint_as_float(((unsigned)bf1(x)) << 16); }
__device__ __forceinline__ float ldb(const bf16_t* p) { return __uint_as_float(((unsigned)*p) << 16); }
__device__ __forceinline__ void upd(float* err, int i, float got, float ref) {
    atomicMax((unsigned*)err + 2 * i, __float_as_uint(fabsf(got - ref))); atomicMax((unsigned*)err + 2 * i + 1, __float_as_uint(fabsf(ref)));
    if (!(fabsf(got) < 1e30f)) atomicMax((unsigned*)err + 2 * i, __float_as_uint(1e30f));
}
__device__ __forceinline__ unsigned hsh(unsigned x) { x ^= x >> 16; x *= 0x7feb352du; x ^= x >> 15; x *= 0x846ca68bu; x ^= x >> 16; return x; }
__global__ void chk_gemm1(Args a) {
    const int i = blockIdx.x * blockDim.x + threadIdx.x; float* err = (float*)(a.ws + O_ERR);
    const int m = hsh(2 * i + 1) % M; int n = hsh(2 * i + 2) % INC; if ((i & 3) == 0) n = 1024 + (n % 512);
    const float* x = a.in[0] + (size_t)m * D; const float* g = a.in[1]; const float* W = a.in[2];
    float ss = 0.f; for (int k = 0; k < D; ++k) ss += x[k] * x[k];
    const float rs = rsqrtf(ss / D + RMS_EPS); float dot = 0.f;
    for (int k = 0; k < D; ++k) dot += bfr(x[k] * rs * g[k]) * bfr(W[(size_t)k * INC + n]);
    float got, ref;
    if (n < 512) { ref = dot * 0.125f; got = ldb((const bf16_t*)(a.ws + O_Q) + (size_t)m * 512 + n); }
    else if (n < 1024) { ref = dot; got = ldb((const bf16_t*)(a.ws + O_K) + (size_t)m * 512 + n - 512); }
    else if (n < 1536) { ref = dot; const int c = n - 1024, b = m >> 11, s = m & 2047; got = ldb((const bf16_t*)(a.ws + O_VT) + ((size_t)(b * 8 + (c >> 6)) * 64 + (c & 63)) * 2048 + s); }
    else if (n < 3328) { ref = dot; got = ldb((const bf16_t*)(a.ws + O_PRW) + (size_t)m * RWC + n - 1536); }
    else { ref = 1.f / (1.f + expf(-(dot + a.in[3][n - 3328]))); got = ldb((const bf16_t*)a.out + (size_t)m * GC + n - 3328); }
    upd(err, 0, got, ref);
}
__global__ void chk_rwprep(Args a) {
    const int i = blockIdx.x * blockDim.x + threadIdx.x; float* err = (float*)(a.ws + O_ERR);
    int m = hsh(3 * i + 7) % M; if ((i & 7) == 0) m &= ~2047; if ((i & 7) == 1) m = (m & ~15) | ((i >> 3) & 1 ? 0 : 15);
    const int h = hsh(3 * i + 8) % NH;
    const bf16_t* P = (const bf16_t*)(a.ws + O_PRW) + (size_t)m * RWC; const bool hp = (m & 2047) != 0;
    const float *mu = a.in[4], *w0 = a.in[5], *wup = a.in[6], *a0 = a.in[7], *aup = a.in[8], *gup = a.in[9], *k_k = a.in[10], *k_a = a.in[11], *r_k = a.in[12];
    auto mix = [&](int c) { const float cur = ldb(P + c), prv = hp ? ldb(P + c - RWC) : 0.f; return cur + (prv - cur) * mu[c]; };
    float ss = 0.f, br = 0.f, kr = 0.f, rkb = 0.f;
    for (int pass = 0; pass < 2; ++pass) {
        const float inv = 1.f / fmaxf(sqrtf(ss), 1e-12f);
        for (int cc = 0; cc < 64; ++cc) { const int c = 64 * h + cc;
            float wr = w0[c], ar = a0[c], gg = 0.f;
            for (int k = 0; k < 64; ++k) { wr += bfr(tanhf(mix(1536 + k))) * bfr(wup[k * 512 + c]); ar += bfr(mix(1600 + k)) * bfr(aup[k * 512 + c]); }
            for (int k = 0; k < 128; ++k) gg += bfr(1.f / (1.f + expf(-mix(1664 + k)))) * bfr(gup[k * 512 + c]);
            const float r = mix(c), kraw = mix(512 + c), v = mix(1024 + c);
            const float av = 1.f / (1.f + expf(-ar)), sg = 1.f / (1.f + expf(-wr));
            const float kkraw = kraw * k_k[c], k2 = kraw * (1.f + (av - 1.f) * k_a[c]);
            if (pass == 0) { ss += kkraw * kkraw; br += kkraw * av * r; kr += k2 * r; rkb += r * k2 * r_k[c]; }
            else { const float kk = kkraw * inv;
                const unsigned* rec = (const unsigned*)(a.ws + O_SI + (((size_t)m * 8 + h) * 64 + cc) * 12);
                upd(err, 1, bf_lo(rec[0]), -0.60653065971f * 1.44269504089f * sg); upd(err, 2, bf_hi(rec[0]), -kk); upd(err, 2, bf_lo(rec[1]), kk * av); upd(err, 3, bf_hi(rec[1]), k2);
                upd(err, 3, bf_lo(rec[2]), r); upd(err, 3, bf_hi(rec[2]), v); upd(err, 4, ldb((const bf16_t*)(a.ws + O_G) + (size_t)m * 512 + c), gg); }
        }
        if (pass == 1) { const float* sc = (const float*)(a.ws + O_SC) + ((size_t)m * 8 + h) * 4; upd(err, 5, sc[0], br * inv); upd(err, 5, sc[1], kr); upd(err, 5, sc[2], rkb); }
    }
}
__global__ void __launch_bounds__(64) chk_scan(Args a) {
    const int b = blockIdx.x < 8 ? 0 : 31, h = blockIdx.x & 7, lane = threadIdx.x; float* err = (float*)(a.ws + O_ERR);
    float S[64];
#pragma unroll
    for (int k = 0; k < 64; ++k) S[k] = 0.f;
    for (int t = 0; t < SEQ; ++t) { const size_t mh = ((size_t)b * SEQ + t) * 8 + h; const unsigned char* rec = a.ws + O_SI + mh * 64 * 12;
        const float v = bf_hi(*(const unsigned*)(rec + lane * 12 + 8)); float sa = 0.f;
#pragma unroll
        for (int k = 0; k < 64; ++k) sa += S[k] * bf_hi(*(const unsigned*)(rec + k * 12));
        float y = 0.f;
#pragma unroll
        for (int k = 0; k < 64; ++k) { const unsigned d0 = *(const unsigned*)(rec + k * 12), d1 = *(const unsigned*)(rec + k * 12 + 4), d2 = *(const unsigned*)(rec + k * 12 + 8);
            S[k] = S[k] * exp2f(bf_lo(d0)) + sa * bf_lo(d1) + v * bf_hi(d1); y += S[k] * bf_lo(d2); }
        upd(err, 6, ldb((const bf16_t*)(a.ws + O_YR) + ((size_t)b * SEQ + t) * 512 + 64 * h + lane), y); }
}
__global__ void __launch_bounds__(256) chk_attn(Args a) {
    const int i = blockIdx.x * blockDim.x + threadIdx.x; float* err = (float*)(a.ws + O_ERR);
    const int t = (i & 255) * 8 + ((i >> 8) & 7), h = (i >> 8) & 7, b = (i >> 11) ? 31 : 0;
    const bf16_t* Q = (const bf16_t*)(a.ws + O_Q) + ((size_t)b * SEQ + t) * 512 + 64 * h; const bf16_t* Kb = (const bf16_t*)(a.ws + O_K) + (size_t)b * SEQ * 512 + 64 * h;
    const bf16_t* Vt = (const bf16_t*)(a.ws + O_VT) + (size_t)(b * 8 + h) * 64 * SEQ;
    float q[64], o[64];
#pragma unroll
    for (int d = 0; d < 64; ++d) { q[d] = ldb(Q + d); o[d] = 0.f; }
    float after = 0.f;
    for (int s = t - 1; s >= 0 && after > -60.f; --s) { float z = 0.f;
#pragma unroll
        for (int d = 0; d < 64; ++d) z += q[d] * ldb(Kb + (size_t)s * 512 + d);
        const float lsz = z > 0.f ? -log1pf(expf(-z)) : z - log1pf(expf(z)); const float w = bfr(expf(lsz + after));
#pragma unroll
        for (int d = 0; d < 64; ++d) o[d] += w * ldb(Vt + (size_t)d * SEQ + s);
        after += lsz - z; }
    const bf16_t* O = (const bf16_t*)(a.ws + O_OSB) + ((size_t)b * SEQ + t) * 512 + 64 * h;
#pragma unroll
    for (int d = 0; d < 64; ++d) upd(err, 7, ldb(O + d), o[d]);
}
__global__ void chk_rwpost(Args a) {
    const int i = blockIdx.x * blockDim.x + threadIdx.x; float* err = (float*)(a.ws + O_ERR);
    const int m = hsh(5 * i + 1) % M, h = hsh(5 * i + 2) % NH;
    const bf16_t* Y = (const bf16_t*)(a.ws + O_YR) + (size_t)m * 512 + 64 * h; float mean = 0.f, var = 0.f;
    for (int c = 0; c < 64; ++c) mean += ldb(Y + c); mean /= 64.f;
    for (int c = 0; c < 64; ++c) { const float d = ldb(Y + c) - mean; var += d * d; } var /= 64.f;
    const float rkb = ((const float*)(a.ws + O_SC))[((size_t)m * 8 + h) * 4 + 2];
    for (int c = 0; c < 64; ++c) { const float v = bf_hi(*(const unsigned*)(a.ws + O_SI + (((size_t)m * 8 + h) * 64 + c) * 12 + 8));
        const float ref = ((ldb(Y + c) - mean) * rsqrtf(var + GN_EPS) * a.in[13][64 * h + c] + a.in[14][64 * h + c] + rkb * v) * ldb((const bf16_t*)(a.ws + O_G) + (size_t)m * 512 + 64 * h + c);
        upd(err, 8, ldb((const bf16_t*)(a.ws + O_ORW) + (size_t)m * 512 + 64 * h + c), ref); }
}
__global__ void chk_tt(Args a) {
    __shared__ float mrg[1024]; float* err = (float*)(a.ws + O_ERR);
    const int m = hsh(7 * blockIdx.x + 3) % M, tid = threadIdx.x;
    const bf16_t* osb = (const bf16_t*)(a.ws + O_OSB) + (size_t)m * 512; const bf16_t* orw = (const bf16_t*)(a.ws + O_ORW) + (size_t)m * 512; const bf16_t* gt = (const bf16_t*)a.out + (size_t)m * GC;
    for (int j = tid; j < 1024; j += 256) { float s1 = 0.f, s2 = 0.f;
        for (int k = 0; k < 512; ++k) { s1 += ldb(osb + k) * bfr(a.in[15][(size_t)k * 1024 + j]); s2 += ldb(orw + k) * bfr(a.in[16][(size_t)k * 1024 + j]); }
        const float v = bfr(bfr(ldb(gt + j) * s1) + ldb(gt + 1024 + j) * s2); mrg[j] = v;
        upd(err, 9, ldb((const bf16_t*)(a.ws + O_MRG) + (size_t)m * 1024 + j), v); }
    __syncthreads();
    for (int c = tid; c < 1024; c += 256) { float s = 0.f; for (int j = 0; j < 1024; ++j) s += mrg[j] * bfr(a.in[17][(size_t)j * 1024 + c]);
        upd(err, 10, ldb((const bf16_t*)(a.ws + O_TT) + (size_t)m * 1024 + c), s); }
}
__global__ void chk_rows1(Args a) {
    __shared__ float red[256]; __shared__ float x1s[1024]; float* err = (float*)(a.ws + O_ERR);
    const int m = hsh(11 * blockIdx.x + 5) % M, tid = threadIdx.x;
    const bf16_t* T = (const bf16_t*)(a.ws + O_TT) + (size_t)m * 1024; float s = 0.f;
    for (int c = tid; c < 1024; c += 256) s += ldb(T + c) * ldb(T + c);
    red[tid] = s; __syncthreads(); for (int o = 128; o > 0; o >>= 1) { if (tid < o) red[tid] += red[tid + o]; __syncthreads(); }
    const float rs = rsqrtf(red[0] / 1024.f + RMS_EPS); __syncthreads(); float s2 = 0.f;
    for (int c = tid; c < 1024; c += 256) { const float v = a.in[0][(size_t)m * 1024 + c] + ldb(T + c) * rs * a.in[18][c]; x1s[c] = v; s2 += v * v; upd(err, 11, a.out[(size_t)m * 1024 + c], v); }
    red[tid] = s2; __syncthreads(); for (int o = 128; o > 0; o >>= 1) { if (tid < o) red[tid] += red[tid + o]; __syncthreads(); }
    const float rs2 = rsqrtf(red[0] / 1024.f + RMS_EPS);
    for (int c = tid; c < 1024; c += 256) upd(err, 11, ldb((const bf16_t*)(a.ws + O_H2) + (size_t)m * 1024 + c), x1s[c] * rs2 * a.in[19][c]);
}
__global__ void chk_ffn(Args a) {
    __shared__ float hid[DFF]; __shared__ float hh[1024]; float* err = (float*)(a.ws + O_ERR);
    const int m = hsh(13 * blockIdx.x + 9) % M, tid = threadIdx.x;
    for (int c = tid; c < 1024; c += 256) hh[c] = ldb((const bf16_t*)(a.ws + O_H2) + (size_t)m * 1024 + c);
    __syncthreads();
    for (int j = tid; j < DFF; j += 256) { float g = 0.f, u = 0.f;
        for (int k = 0; k < 1024; ++k) { g += hh[k] * bfr(a.in[20][(size_t)k * DFF + j]); u += hh[k] * bfr(a.in[21][(size_t)k * DFF + j]); }
        const float v = bfr(g / (1.f + expf(-g)) * u); hid[j] = v; upd(err, 12, ldb((const bf16_t*)(a.ws + O_HID) + (size_t)m * DFF + j), v); }
    __syncthreads();
    for (int c = tid; c < 1024; c += 256) { float s = 0.f; for (int j = 0; j < DFF; ++j) s += hid[j] * bfr(a.in[22][(size_t)j * 1024 + c]);
        upd(err, 13, ldb((const bf16_t*)(a.ws + O_FF) + (size_t)m * 1024 + c), s); }
}
__global__ void diag_out(Args a, int sel) {
    const float* err = (const float*)(a.ws + O_ERR);
    const int grp[14] = {0, 1, 1, 2, 2, 2, 3, 4, 5, 6, 6, 7, 8, 8};
    int code = 0;
    for (int i = 0; i < 14; ++i) { const float d = err[2 * i], r = err[2 * i + 1]; if (!(d <= 0.04f * r + 1e-3f)) code |= 1 << grp[i]; }
    if (sel == 1) code >>= 5;
    code &= 31;
    const float alpha = 2.f + (float)code;
    for (size_t i = (size_t)blockIdx.x * blockDim.x + threadIdx.x; i < (size_t)M * D; i += (size_t)gridDim.x * blockDim.x) a.out[i] = alpha * a.in[0][i];
}
}
#endif

extern "C" void kernel_launch(void* const* d_in, const int* in_sizes, int n_in, void* d_out, int out_size, void* d_ws, size_t ws_size, hipStream_t stream) {
    static int grid = 0;
    if (grid == 0) {
        if (n_in != 24 || in_sizes[0] != mk::M * mk::D || out_size != mk::M * mk::D || ws_size < mk::WS_NEED) {
            fprintf(stderr, "kernel_launch: unexpected shapes: n_in %d in0 %d out %d ws %zu (need %zu)\n", n_in, n_in > 0 ? in_sizes[0] : -1, out_size, ws_size, (size_t)mk::WS_NEED); grid = -1; return; }
        int dev = 0, cus = 0, per_cu = 0;
        hipGetDevice(&dev); hipDeviceGetAttribute(&cus, hipDeviceAttributeMultiprocessorCount, dev);
        if (hipFuncSetAttribute((const void*)mk::mega, hipFuncAttributeMaxDynamicSharedMemorySize, mk::LDS_BYTES) != hipSuccess) { fprintf(stderr, "kernel_launch: hipFuncSetAttribute failed\n"); grid = -1; return; }
        if (hipOccupancyMaxActiveBlocksPerMultiprocessor(&per_cu, (const void*)mk::mega, 512, mk::LDS_BYTES) != hipSuccess || per_cu < 1) { fprintf(stderr, "kernel_launch: occupancy query failed (%d)\n", per_cu); per_cu = 1; }
        (void)hipGetLastError();
        grid = cus * per_cu;
        fprintf(stderr, "kernel_launch: grid %d (cus %d x %d)\n", grid, cus, per_cu);
    }
    if (grid < 0) return;
    mk::Args a{};
    for (int i = 0; i < 24; ++i) a.in[i] = (const float*)d_in[i];
    a.out = (float*)d_out; a.ws = (unsigned char*)d_ws;
#if MK_SPLIT
#if MK_DIAG
    (void)hipMemsetAsync((char*)d_ws + dg::O_ERR, 0, 256, stream);
#endif
    for (int ph = 0; ph < mk::NPH; ++ph) { a.ph_lo = ph; a.ph_hi = ph + 1; hipLaunchKernelGGL(mk::mega, dim3(grid), dim3(512), mk::LDS_BYTES, stream, a);
#if MK_DIAG
        if (ph == 1) hipLaunchKernelGGL(dg::chk_gemm1, dim3(64), dim3(256), 0, stream, a);
        if (ph == 2) hipLaunchKernelGGL(dg::chk_rwprep, dim3(16), dim3(256), 0, stream, a);
        if (ph == 3) { hipLaunchKernelGGL(dg::chk_scan, dim3(16), dim3(64), 0, stream, a); hipLaunchKernelGGL(dg::chk_attn, dim3(16), dim3(256), 0, stream, a); }
        if (ph == 4) hipLaunchKernelGGL(dg::chk_rwpost, dim3(16), dim3(256), 0, stream, a);
        if (ph == 7) hipLaunchKernelGGL(dg::chk_tt, dim3(64), dim3(256), 0, stream, a);
        if (ph == 8) hipLaunchKernelGGL(dg::chk_rows1, dim3(64), dim3(256), 0, stream, a);
        if (ph == 10) hipLaunchKernelGGL(dg::chk_ffn, dim3(64), dim3(256), 0, stream, a);
#endif
    }
#if MK_DIAG
    hipLaunchKernelGGL(dg::diag_out, dim3(2048), dim3(256), 0, stream, a, MK_DIAG - 1);
#endif
#else
    a.ph_lo = 0; a.ph_hi = mk::NPH;
    void* args[] = {&a};
    hipError_t e = hipLaunchCooperativeKernel((const void*)mk::mega, dim3(grid), dim3(512), args, mk::LDS_BYTES, stream);
    if (e != hipSuccess) fprintf(stderr, "kernel_launch: cooperative launch failed: %s (grid %d)\n", hipGetErrorString(e), grid);
#endif
}
```

```cpp
#include <hip/hip_runtime.h>
#include <hip/hip_cooperative_groups.h>
#include <cstdio>
#include <cstdint>
namespace cg = cooperative_groups;
#ifndef MK_SPLIT
#define MK_SPLIT 0
#endif
#ifndef MK_DIAG
#define MK_DIAG 0
#endif
#ifndef MK_REPMASK
#define MK_REPMASK 0
#endif
#ifndef MK_EARLY_EXIT
#define MK_EARLY_EXIT 1
#endif
namespace pg8 {
#define PG8_LAS __attribute__((address_space(3)))
typedef unsigned short bf16_t;
typedef short bf16x8 __attribute__((ext_vector_type(8)));
typedef float f32x4 __attribute__((ext_vector_type(4)));
typedef unsigned u32x4 __attribute__((ext_vector_type(4)));
constexpr int BM = 256, BK = 64, HALF = 128, HTB = HALF * BK * 2  , STAGE_BYTES = 8 * HTB, NXCD = 8, WGM = 8;

__host__ __device__ __forceinline__ int lds_byte(int r, int c) { const int st = (r >> 4) * 2 + (c >> 5), rr = r & 15, cc = c & 31, ob = rr * 64 + cc * 2; return st * 1024 + (ob ^ (((ob >> 9) & 1) << 5)); }
__host__ __device__ __forceinline__ void stage_rc(int b, int& R, int& C) { const int st = b / 1024, sb = b % 1024, swz = sb ^ (((sb >> 9) & 1) << 5); R = (st >> 1) * 16 + swz / 64; C = (st & 1) * 32 + (swz % 64) / 2; }
__host__ __device__ __forceinline__ int perm32(int rho) { const int n = rho >> 4, i = rho & 15; return 8 * (i >> 2) + 4 * n + (i & 3); }

struct Unit { int pm, pn; };
struct Gemm { const bf16_t* A; const bf16_t* Bt; int M, N, K; };

struct StaticOrder {
    int nM, nN, nwg, G, c;
    __host__ __device__ void init(int M, int N, int G_, int c_) { nM = M / BM; nN = N / BM; nwg = nM * nN; G = G_; c = c_; }
    __host__ __device__ bool next(int i, Unit& u) const {
        const long L = (long)i * G + c; if (L >= nwg) return false;
        int wgid = (int)L; { const int q = nwg / NXCD, r = nwg % NXCD, xcd = wgid % NXCD, off = wgid / NXCD; wgid = (xcd < r ? xcd * (q + 1) : r * (q + 1) + (xcd - r) * q) + off; }
        const int nig = WGM * nN, gid = wgid / nig, fm = gid * WGM, gsz = (nM - fm) < WGM ? (nM - fm) : WGM;
        u.pm = fm + ((wgid % nig) % gsz); u.pn = (wgid % nig) / gsz; return true;
    }
    __device__ __forceinline__ void a_ready(const Unit&) const {}
    __device__ __forceinline__ void done(const Unit&) const {}
};

__device__ __forceinline__ unsigned cvt_pk_bf16(float lo, float hi) { unsigned r; asm volatile("v_cvt_pk_bf16_f32 %0, %1, %2" : "=v"(r) : "v"(lo), "v"(hi)); return r; }
typedef float f32x2 __attribute__((ext_vector_type(2)));

template <class Epi, class Sched, bool STAMP = false>
__device__ __forceinline__ void gemm_phase(PG8_LAS unsigned char* lds, const Gemm g, const Sched& S, const Epi& E, unsigned long long* stamps) {
    int tid_ = threadIdx.x; asm volatile("" : "+v"(tid_)); const int tid = tid_, wid = __builtin_amdgcn_readfirstlane(tid >> 6), lane = tid & 63, wr = wid >> 2, wc = wid & 3, fr = lane & 15, fq = lane >> 4;
    const int K = g.K, nt = K / BK;
    int ts_lo = 0, ts_hi = 0, nts = 0; const unsigned long long rt_entry = STAMP ? (unsigned long long)wall_clock64() : 0ull;
#define PG8_STAMP() do { if (STAMP && wid == 0 && nts < 64) { const unsigned long long _c = (unsigned long long)clock64(); \
        ts_lo = (lane == nts) ? (int)(unsigned)_c : ts_lo; ts_hi = (lane == nts) ? (int)(unsigned)(_c >> 32) : ts_hi; ++nts; } } while (0)
    PG8_STAMP();
    unsigned voffA[2], voffB[2];
#pragma unroll
    for (int i = 0; i < 2; ++i) { int R, C; stage_rc(tid * 16 + i * 8192, R, C); const int Rb = Epi::PERM ? ((R & ~31) + perm32(R & 31)) : R;
        voffA[i] = (unsigned)(R * K + C) * 2u; voffB[i] = (unsigned)(Rb * K + C) * 2u; }
    const size_t kstep = (size_t)(BK * 2);
    const size_t hstep = (size_t)HALF * K * 2;
    const size_t tstep = 2 * hstep;
    const unsigned ldsw = (unsigned)wid * 1024u;
    const int aoff = lds_byte(wr * 64 + fr, fq * 8), boff = lds_byte(wc * 32 + fr, fq * 8);
#define PG8_SA(b, h) (((b) * 2 + (h)) * HTB)
#define PG8_SB(b, h) ((4 + (b) * 2 + (h)) * HTB)
#define PG8_STAGE(bufoff, gbase, voff) do { _Pragma("unroll") for (int _i = 0; _i < 2; ++_i) \
        __builtin_amdgcn_global_load_lds((const unsigned*)((const char*)(gbase) + (voff)[_i]), (PG8_LAS unsigned*)(lds + (bufoff) + ldsw + _i * 8192), 16, 0, 0); } while (0)
#define PG8_LDA(dst, b, h) do { _Pragma("unroll") for (int m = 0; m < 4; ++m) _Pragma("unroll") for (int k = 0; k < 2; ++k) dst[m][k] = *(const PG8_LAS bf16x8*)(lds + PG8_SA(b, h) + aoff + m * 2048 + k * 1024); } while (0)
#define PG8_LDB(dst, b, h) do { _Pragma("unroll") for (int n = 0; n < 2; ++n) _Pragma("unroll") for (int k = 0; k < 2; ++k) dst[n][k] = *(const PG8_LAS bf16x8*)(lds + PG8_SB(b, h) + boff + n * 2048 + k * 1024); } while (0)
#define PG8_MMA(ai, bj, At, Bt) do { __builtin_amdgcn_s_setprio(1); _Pragma("unroll") for (int m = 0; m < 4; ++m) _Pragma("unroll") for (int n = 0; n < 2; ++n) _Pragma("unroll") for (int k = 0; k < 2; ++k) \
        acc[ai][bj][m][n] = __builtin_amdgcn_mfma_f32_16x16x32_bf16(Bt[n][k], At[m][k], acc[ai][bj][m][n], 0, 0, 0); __builtin_amdgcn_s_setprio(0); } while (0)
#define PG8_WAIT_V(n) asm volatile("s_waitcnt vmcnt(" #n ")" ::: "memory")
#define PG8_WAIT_L(n) asm volatile("s_waitcnt lgkmcnt(" #n ")" ::: "memory")
#define PG8_BAR __builtin_amdgcn_s_barrier()
#define PG8_SCHED __builtin_amdgcn_sched_barrier(0)
    Unit cur, nxt; int ui = 0;
    if (!S.next(0, cur)) return;
    f32x4 acc[2][2][4][2];
#pragma unroll
    for (int a = 0; a < 2; ++a)
#pragma unroll
        for (int b = 0; b < 2; ++b)
#pragma unroll
            for (int m = 0; m < 4; ++m)
#pragma unroll
                for (int n = 0; n < 2; ++n) acc[a][b][m][n] = (f32x4){0.f, 0.f, 0.f, 0.f};
    bf16x8 At[4][2], B0[2][2], B1[2][2];
    const char* cA = (const char*)g.A + (size_t)cur.pm * tstep; const char* cB = (const char*)g.Bt + (size_t)cur.pn * tstep;
    S.a_ready(cur);
    PG8_STAGE(PG8_SB(0, 0), cB, voffB); PG8_STAGE(PG8_SA(0, 0), cA, voffA); PG8_STAGE(PG8_SB(0, 1), cB + hstep, voffB); PG8_STAGE(PG8_SA(0, 1), cA + hstep, voffA);
    if (wr == 1) PG8_BAR;
    PG8_WAIT_V(4); PG8_BAR;
    PG8_STAGE(PG8_SB(1, 0), cB + kstep, voffB); PG8_STAGE(PG8_SA(1, 0), cA + kstep, voffA); PG8_STAGE(PG8_SB(1, 1), cB + hstep + kstep, voffB);
    PG8_WAIT_V(6); PG8_BAR;
    PG8_STAMP();
    for (;;) {
        const bool has_next = S.next(ui + 1, nxt);
        const char* nA = has_next ? (const char*)g.A + (size_t)nxt.pm * tstep : cA; const char* nB = has_next ? (const char*)g.Bt + (size_t)nxt.pn * tstep : cB;
        for (int t = 0; t < nt; t += 2) {
            const bool last = (t == nt - 2);
            const char* a1 = cA + (size_t)(t + 1) * kstep;
            const char* a2 = last ? nA : cA + (size_t)(t + 2) * kstep; const char* b2 = last ? nB : cB + (size_t)(t + 2) * kstep;
            const char* a3 = a2 + kstep; const char* b3 = b2 + kstep;
            if (last && has_next) S.a_ready(nxt);
            PG8_LDB(B0, 0, 0); PG8_SCHED; PG8_LDA(At, 0, 0); PG8_STAGE(PG8_SA(1, 1), a1 + hstep, voffA);
            PG8_WAIT_L(8); PG8_BAR; PG8_WAIT_L(0); PG8_MMA(0, 0, At, B0); PG8_BAR; PG8_SCHED;
            PG8_LDB(B1, 0, 1); PG8_STAGE(PG8_SB(0, 0), b2, voffB);
            PG8_BAR; PG8_WAIT_L(0); PG8_MMA(0, 1, At, B1); PG8_BAR;
            PG8_LDA(At, 0, 1); PG8_STAGE(PG8_SA(0, 0), a2, voffA);
            PG8_BAR; PG8_WAIT_L(0); PG8_MMA(1, 0, At, B0); PG8_BAR; PG8_SCHED;
            PG8_STAGE(PG8_SB(0, 1), b2 + hstep, voffB);
            PG8_WAIT_V(6); PG8_BAR; PG8_MMA(1, 1, At, B1); PG8_BAR;
            PG8_LDB(B0, 1, 0); PG8_SCHED; PG8_LDA(At, 1, 0); PG8_STAGE(PG8_SA(0, 1), a2 + hstep, voffA);
            PG8_WAIT_L(8); PG8_BAR; PG8_WAIT_L(0); PG8_MMA(0, 0, At, B0); PG8_BAR; PG8_SCHED;
            PG8_LDB(B1, 1, 1); PG8_STAGE(PG8_SB(1, 0), b3, voffB);
            PG8_BAR; PG8_WAIT_L(0); PG8_MMA(0, 1, At, B1); PG8_BAR;
            PG8_LDA(At, 1, 1); PG8_STAGE(PG8_SA(1, 0), a3, voffA);
            PG8_BAR; PG8_WAIT_L(0); PG8_MMA(1, 0, At, B0); PG8_BAR; PG8_SCHED;
            PG8_STAGE(PG8_SB(1, 1), b3 + hstep, voffB);
            PG8_WAIT_V(6); PG8_BAR; PG8_MMA(1, 1, At, B1); PG8_BAR;
        }
        PG8_STAMP();
        if constexpr (!Epi::AFTER_DRAIN) { E(acc, cur, wr, wc, fr, fq); S.done(cur); }
        PG8_STAMP();
        if (!has_next) break;
#pragma unroll
        for (int a = 0; a < 2; ++a)
#pragma unroll
            for (int b = 0; b < 2; ++b)
#pragma unroll
                for (int m = 0; m < 4; ++m)
#pragma unroll
                    for (int n = 0; n < 2; ++n) acc[a][b][m][n] = (f32x4){0.f, 0.f, 0.f, 0.f};
        cur = nxt; cA = nA; cB = nB; ++ui;
    }
    PG8_WAIT_V(0);
    if (wr == 0) PG8_BAR;
    PG8_BAR;
    if constexpr (Epi::AFTER_DRAIN) { E.fused(acc, cur, wr, wc, fr, fq, lds, wid, lane); S.done(cur); }
    PG8_STAMP();
    if (STAMP && wid == 0) { stamps[lane] = lane < nts ? (((unsigned long long)(unsigned)ts_hi << 32) | (unsigned)ts_lo) : 0ull;
        if (lane == 62) stamps[62] = rt_entry; if (lane == 63) stamps[63] = (unsigned long long)wall_clock64(); }
#undef PG8_STAMP
#undef PG8_SA
#undef PG8_SB
#undef PG8_STAGE
#undef PG8_LDA
#undef PG8_LDB
#undef PG8_MMA
#undef PG8_WAIT_V
#undef PG8_WAIT_L
#undef PG8_BAR
#undef PG8_SCHED
}
}
namespace mk {
using pg8::bf16_t; using pg8::bf16x8; using pg8::f32x4; using pg8::u32x4; using pg8::cvt_pk_bf16;
typedef float f32x16 __attribute__((ext_vector_type(16)));
typedef float f32x2 __attribute__((ext_vector_type(2)));
typedef unsigned u32x2 __attribute__((ext_vector_type(2)));
constexpr int D = 1024, NB = 32, SEQ = 2048, M = NB * SEQ, NH = 8, DH = 64;
constexpr int RWC = 1792, GC = 2048, INC = 5376, DFF = 2816;
constexpr float RMS_EPS = 1e-6f, GN_EPS = 64e-5f;
constexpr size_t MiB = (size_t)1 << 20;
constexpr size_t O_WIN = 0, O_WSB = 11 * MiB, O_WRW = 12 * MiB, O_WO = 13 * MiB, O_WGU = 15 * MiB, O_WDN = 26 * MiB, O_WLU = 32 * MiB  , O_WLA = O_WLU + 65536, O_WLG = O_WLA + 65536;
constexpr size_t O_Q = 34 * MiB, O_K = 98 * MiB, O_VT = 162 * MiB, O_PRW = 226 * MiB, O_H = 450 * MiB, O_SI = 450 * MiB, O_G = 834 * MiB, O_SC = 898 * MiB, O_YR = 906 * MiB;
constexpr size_t O_OSB = 226 * MiB, O_ORW = 290 * MiB, O_T1 = 34 * MiB, O_MRG = 450 * MiB, O_TT = 34 * MiB, O_H2 = 162 * MiB, O_HID = 290 * MiB, O_FF = 34 * MiB;
constexpr size_t WS_NEED = 970 * MiB;
constexpr int LDS_BYTES = pg8::STAGE_BYTES;
constexpr int NPH = 12;

struct Args { const float* in[24]; float* out; unsigned char* ws; int ph_lo, ph_hi; };

__device__ __forceinline__ int my_tid() { int t = threadIdx.x; asm volatile("" : "+v"(t)); return t; }
__device__ __forceinline__ float bf_lo(unsigned u) { return __uint_as_float(u << 16); }
__device__ __forceinline__ float bf_hi(unsigned u) { return __uint_as_float(u & 0xffff0000u); }
__device__ __forceinline__ float fexp(float x) { return __builtin_amdgcn_exp2f(x * 1.44269504089f); }
__device__ __forceinline__ float flog(float x) { return __builtin_amdgcn_logf(x) * 0.69314718056f; }
__device__ __forceinline__ float frcp(float x) { return __builtin_amdgcn_rcpf(x); }
__device__ __forceinline__ float fsigmoid(float x) { return frcp(1.f + fexp(-x)); }
__device__ __forceinline__ unsigned short bf1(float x) { return (unsigned short)(cvt_pk_bf16(x, x) & 0xffffu); }
__device__ __forceinline__ u32x4 pack8(const f32x4 a, const f32x4 b) { u32x4 o; o.x = cvt_pk_bf16(a[0], a[1]); o.y = cvt_pk_bf16(a[2], a[3]); o.z = cvt_pk_bf16(b[0], b[1]); o.w = cvt_pk_bf16(b[2], b[3]); return o; }
__device__ __forceinline__ float red16(float v) {
    v += __shfl_xor(v, 16); v += __shfl_xor(v, 32); return v;
}
__device__ __forceinline__ float wave_sum(float v) {
#pragma unroll
    for (int o = 1; o < 64; o <<= 1) v += __shfl_xor(v, o);
    return v;
}

__device__ __forceinline__ void tr_item(const float* __restrict__ W, int K, int N, bf16_t* WT, float* scr, int item, int lane, int mode) {
    const int nblk = N >> 5, kb = item / nblk, nb = item - kb * nblk, k0 = kb << 6, n0 = nb << 5;
#pragma unroll 8
    for (int i = 0; i < 32; ++i) { const int kk = 2 * i + (lane >> 5); scr[kk * 33 + (lane & 31)] = W[(size_t)(k0 + kk) * N + n0 + (lane & 31)]; }
    asm volatile("s_waitcnt lgkmcnt(0)" ::: "memory"); __builtin_amdgcn_wave_barrier();
    const int c = lane & 7;
#pragma unroll
    for (int j = 0; j < 4; ++j) {
        const int n = (lane >> 3) + 8 * j; const float* s = scr + (8 * c) * 33 + n;
        u32x4 o; o.x = cvt_pk_bf16(s[0 * 33], s[1 * 33]); o.y = cvt_pk_bf16(s[2 * 33], s[3 * 33]); o.z = cvt_pk_bf16(s[4 * 33], s[5 * 33]); o.w = cvt_pk_bf16(s[6 * 33], s[7 * 33]);
        const int nn = n0 + n; int drow = nn;
        if (mode == 1) drow = ((nn >> 7) << 8) + (nn & 127); else if (mode == 2) drow = ((nn >> 7) << 8) + 128 + (nn & 127);
        *(u32x4*)(WT + (size_t)drow * K + k0 + 8 * c) = o;
    }
    asm volatile("s_waitcnt lgkmcnt(0)" ::: "memory"); __builtin_amdgcn_wave_barrier();
}

__device__ __forceinline__ void phase_prep(const Args& a, float* lds_f, int G) {
    const int tid = my_tid(); const int wave = tid >> 6, lane = tid & 63;
    const int gw = blockIdx.x * 8 + wave, NGW = G * 8;
    float* scr = lds_f + wave * (64 * 33 + 16);
    unsigned char* ws = a.ws;
    constexpr int I_IN = 16 * 168, I_SB = 8 * 32, I_O = 16 * 32, I_G = 16 * 88, I_DN = 44 * 32, I_LU = 16, I_LG = 32;
    constexpr int NIT = I_IN + 2 * I_SB + I_O + 2 * I_G + I_DN + 2 * I_LU + I_LG;
    for (int it = gw; it < NIT; it += NGW) {
        int r = it;
        if (r < I_IN) { tr_item(a.in[2], 1024, INC, (bf16_t*)(ws + O_WIN), scr, r, lane, 0); continue; } r -= I_IN;
        if (r < I_SB) { tr_item(a.in[15], 512, 1024, (bf16_t*)(ws + O_WSB), scr, r, lane, 0); continue; } r -= I_SB;
        if (r < I_SB) { tr_item(a.in[16], 512, 1024, (bf16_t*)(ws + O_WRW), scr, r, lane, 0); continue; } r -= I_SB;
        if (r < I_O) { tr_item(a.in[17], 1024, 1024, (bf16_t*)(ws + O_WO), scr, r, lane, 0); continue; } r -= I_O;
        if (r < I_G) { tr_item(a.in[20], 1024, DFF, (bf16_t*)(ws + O_WGU), scr, r, lane, 1); continue; } r -= I_G;
        if (r < I_G) { tr_item(a.in[21], 1024, DFF, (bf16_t*)(ws + O_WGU), scr, r, lane, 2); continue; } r -= I_G;
        if (r < I_DN) { tr_item(a.in[22], DFF, 1024, (bf16_t*)(ws + O_WDN), scr, r, lane, 0); continue; } r -= I_DN;
        if (r < I_LU) { tr_item(a.in[6], 64, 512, (bf16_t*)(ws + O_WLU), scr, r, lane, 0); continue; } r -= I_LU;
        if (r < I_LU) { tr_item(a.in[8], 64, 512, (bf16_t*)(ws + O_WLA), scr, r, lane, 0); continue; } r -= I_LU;
        tr_item(a.in[9], 128, 512, (bf16_t*)(ws + O_WLG), scr, r, lane, 0);
    }
    const float* x = a.in[0]; const float* g = a.in[1]; bf16_t* H = (bf16_t*)(ws + O_H);
    f32x4 gv[4];
#pragma unroll
    for (int j = 0; j < 4; ++j) gv[j] = ((const f32x4*)g)[lane + 64 * j];
    for (int row = gw; row < M; row += NGW) {
        const f32x4* xr = (const f32x4*)(x + (size_t)row * D) + lane;
        f32x4 v[4]; float s = 0.f;
#pragma unroll
        for (int j = 0; j < 4; ++j) { v[j] = xr[64 * j]; s += (v[j][0] * v[j][0] + v[j][1] * v[j][1]) + (v[j][2] * v[j][2] + v[j][3] * v[j][3]); }
        const float rs = rsqrtf(wave_sum(s) * (1.f / D) + RMS_EPS);
        u32x2* o = (u32x2*)(H + (size_t)row * D) + lane;
#pragma unroll
        for (int j = 0; j < 4; ++j) { u32x2 w; w.x = cvt_pk_bf16(v[j][0] * rs * gv[j][0], v[j][1] * rs * gv[j][1]); w.y = cvt_pk_bf16(v[j][2] * rs * gv[j][2], v[j][3] * rs * gv[j][3]); o[64 * j] = w; }
    }
}

struct Epi1 {
    static constexpr bool PERM = true, AFTER_DRAIN = false;
    bf16_t *Q, *Kb, *Vt, *Prw, *Gt; const float* bgate;
    __device__ __forceinline__ void operator()(const f32x4 (&acc)[2][2][4][2], const pg8::Unit& u, int wr, int wc, int fr, int fq) const {
        const int row0 = u.pm * 256 + wr * 64 + fr, pn = u.pn, cl = wc * 32 + 8 * fq;
        if (pn < 4) {
            bf16_t* dst = pn < 2 ? Q : Kb; const float sc = pn < 2 ? 0.125f : 1.f; const int cb = (pn & 1) * 256 + cl;
#pragma unroll
            for (int ai = 0; ai < 2; ++ai)
#pragma unroll
                for (int m = 0; m < 4; ++m) { bf16_t* rp = dst + (size_t)(row0 + ai * 128 + m * 16) * 512 + cb;
#pragma unroll
                    for (int bj = 0; bj < 2; ++bj) *(u32x4*)(rp + bj * 128) = pack8(acc[ai][bj][m][0] * sc, acc[ai][bj][m][1] * sc); }
        } else if (pn < 6) {
#pragma unroll
            for (int ai = 0; ai < 2; ++ai)
#pragma unroll
                for (int m = 0; m < 4; ++m) { const int row = row0 + ai * 128 + m * 16, b = row >> 11, s = row & 2047;
#pragma unroll
                    for (int bj = 0; bj < 2; ++bj)
#pragma unroll
                        for (int n = 0; n < 2; ++n)
#pragma unroll
                            for (int j = 0; j < 4; ++j) { const int c = (pn - 4) * 256 + bj * 128 + cl + 4 * n + j;
                                Vt[((size_t)(b * 512 + c)) * 2048 + s] = bf1(acc[ai][bj][m][n][j]); } }
        } else if (pn < 13) {
            const int cb = (pn - 6) * 256 + cl;
#pragma unroll
            for (int ai = 0; ai < 2; ++ai)
#pragma unroll
                for (int m = 0; m < 4; ++m) { bf16_t* rp = Prw + (size_t)(row0 + ai * 128 + m * 16) * RWC + cb;
#pragma unroll
                    for (int bj = 0; bj < 2; ++bj) *(u32x4*)(rp + bj * 128) = pack8(acc[ai][bj][m][0], acc[ai][bj][m][1]); }
        } else {
            const int cb = (pn - 13) * 256 + cl;
#pragma unroll
            for (int ai = 0; ai < 2; ++ai)
#pragma unroll
                for (int m = 0; m < 4; ++m) { bf16_t* rp = Gt + (size_t)(row0 + ai * 128 + m * 16) * GC + cb;
#pragma unroll
                    for (int bj = 0; bj < 2; ++bj) { f32x4 v0 = acc[ai][bj][m][0] + *(const f32x4*)(bgate + cb + bj * 128), v1 = acc[ai][bj][m][1] + *(const f32x4*)(bgate + cb + bj * 128 + 4);
#pragma unroll
                        for (int j = 0; j < 4; ++j) { v0[j] = fsigmoid(v0[j]); v1[j] = fsigmoid(v1[j]); }
                        *(u32x4*)(rp + bj * 128) = pack8(v0, v1); } }
        }
    }
};
template <int MODE> struct EpiRow {
    static constexpr bool PERM = true, AFTER_DRAIN = false;
    bf16_t* O; const bf16_t* T1; const bf16_t* Gt;
    __device__ __forceinline__ void operator()(const f32x4 (&acc)[2][2][4][2], const pg8::Unit& u, int wr, int wc, int fr, int fq) const {
        const int row0 = u.pm * 256 + wr * 64 + fr, cb = u.pn * 256 + wc * 32 + 8 * fq;
#pragma unroll
        for (int ai = 0; ai < 2; ++ai)
#pragma unroll
            for (int m = 0; m < 4; ++m) { const size_t row = (size_t)(row0 + ai * 128 + m * 16);
#pragma unroll
                for (int bj = 0; bj < 2; ++bj) { f32x4 v0 = acc[ai][bj][m][0], v1 = acc[ai][bj][m][1]; const int c = cb + bj * 128;
                    if (MODE >= 1) { const u32x4 gg = *(const u32x4*)(Gt + row * GC + (MODE == 2 ? 1024 : 0) + c);
                        v0[0] *= bf_lo(gg.x); v0[1] *= bf_hi(gg.x); v0[2] *= bf_lo(gg.y); v0[3] *= bf_hi(gg.y); v1[0] *= bf_lo(gg.z); v1[1] *= bf_hi(gg.z); v1[2] *= bf_lo(gg.w); v1[3] *= bf_hi(gg.w); }
                    if (MODE == 2) { const u32x4 tt = *(const u32x4*)(T1 + row * 1024 + c);
                        v0[0] += bf_lo(tt.x); v0[1] += bf_hi(tt.x); v0[2] += bf_lo(tt.y); v0[3] += bf_hi(tt.y); v1[0] += bf_lo(tt.z); v1[1] += bf_hi(tt.z); v1[2] += bf_lo(tt.w); v1[3] += bf_hi(tt.w); }
                    *(u32x4*)(O + row * 1024 + c) = pack8(v0, v1); } }
    }
};
struct EpiSwiGLU {
    static constexpr bool PERM = true, AFTER_DRAIN = false;
    bf16_t* Hd;
    __device__ __forceinline__ void operator()(const f32x4 (&acc)[2][2][4][2], const pg8::Unit& u, int wr, int wc, int fr, int fq) const {
        const int row0 = u.pm * 256 + wr * 64 + fr, cb = u.pn * 128 + wc * 32 + 8 * fq;
#pragma unroll
        for (int ai = 0; ai < 2; ++ai)
#pragma unroll
            for (int m = 0; m < 4; ++m) { f32x4 v0, v1;
#pragma unroll
                for (int j = 0; j < 4; ++j) { const float g0 = acc[ai][0][m][0][j], g1 = acc[ai][0][m][1][j];
                    v0[j] = g0 * fsigmoid(g0) * acc[ai][1][m][0][j]; v1[j] = g1 * fsigmoid(g1) * acc[ai][1][m][1][j]; }
                *(u32x4*)(Hd + (size_t)(row0 + ai * 128 + m * 16) * DFF + cb) = pack8(v0, v1); }
    }
};
template <class Epi> __device__ __forceinline__ void run_gemm(PG8_LAS unsigned char* lds, const bf16_t* A, const bf16_t* Bt, int N, int K, const Epi& E, int G) {
    pg8::Gemm g; g.A = A; g.Bt = Bt; g.M = M; g.N = N; g.K = K;
    pg8::StaticOrder S; S.init(M, N, G, (int)blockIdx.x);
    pg8::gemm_phase<Epi, pg8::StaticOrder, false>(lds, g, S, E, nullptr);
}
__device__ __forceinline__ void load_mix8(const bf16_t* cur, bool hasprev, const float* mu, float (&o)[8]) {
    const u32x4 c = *(const u32x4*)cur; u32x4 p = {0u, 0u, 0u, 0u};
    if (hasprev) p = *(const u32x4*)(cur - RWC);
    const f32x4 m0 = *(const f32x4*)mu, m1 = *(const f32x4*)(mu + 4);
    const float mm[8] = {m0[0], m0[1], m0[2], m0[3], m1[0], m1[1], m1[2], m1[3]};
#pragma unroll
    for (int i = 0; i < 4; ++i) { const float cl = bf_lo(c[i]), ch = bf_hi(c[i]), pl = bf_lo(p[i]), ph = bf_hi(p[i]);
        o[2 * i] = cl + (pl - cl) * mm[2 * i]; o[2 * i + 1] = ch + (ph - ch) * mm[2 * i + 1]; }
}
__device__ __forceinline__ void load_mix4(const bf16_t* cur, bool hasprev, const float* mu, float (&o)[4]) {
    const u32x2 c = *(const u32x2*)cur; u32x2 p = {0u, 0u};
    if (hasprev) p = *(const u32x2*)(cur - RWC);
    const f32x4 m0 = *(const f32x4*)mu;
#pragma unroll
    for (int i = 0; i < 2; ++i) { const float cl = bf_lo(c[i]), ch = bf_hi(c[i]), pl = bf_lo(p[i]), ph = bf_hi(p[i]);
        o[2 * i] = cl + (pl - cl) * m0[2 * i]; o[2 * i + 1] = ch + (ph - ch) * m0[2 * i + 1]; }
}
__device__ __forceinline__ bf16x8 pack_frag(const float (&v)[8]) {
    u32x4 o; o.x = cvt_pk_bf16(v[0], v[1]); o.y = cvt_pk_bf16(v[2], v[3]); o.z = cvt_pk_bf16(v[4], v[5]); o.w = cvt_pk_bf16(v[6], v[7]);
    return __builtin_bit_cast(bf16x8, o);
}
__device__ __forceinline__ void phase_rwprep(const Args& a, int G) {
    const int tid = my_tid(); const int wave = tid >> 6, lane = tid & 63, fr = lane & 15, fq = lane >> 4;
    const int gw = blockIdx.x * 8 + wave, NGW = G * 8;
    unsigned char* ws = a.ws;
    const bf16_t* PRW = (const bf16_t*)(ws + O_PRW);
    const bf16_t* WLU = (const bf16_t*)(ws + O_WLU); const bf16_t* WLA = (const bf16_t*)(ws + O_WLA); const bf16_t* WLG = (const bf16_t*)(ws + O_WLG);
    unsigned char* SI = ws + O_SI; bf16_t* GB = (bf16_t*)(ws + O_G); float* SC = (float*)(ws + O_SC);
    const float *mu = a.in[4], *w0 = a.in[5], *a0 = a.in[7], *k_k = a.in[10], *k_a = a.in[11], *r_k = a.in[12];
    for (int item = gw; item < M / 16; item += NGW) {
        const int m = item * 16 + fr; const bool hp = (m & (SEQ - 1)) != 0;
        const bf16_t* prow = PRW + (size_t)m * RWC;
        bf16x8 Aw[2], Aa[2], Ag[4];
        float t8[8];
#pragma unroll
        for (int s = 0; s < 2; ++s) { load_mix8(prow + 1536 + 32 * s + 8 * fq, hp, mu + 1536 + 32 * s + 8 * fq, t8);
#pragma unroll
            for (int i = 0; i < 8; ++i) { const float e = fexp(2.f * t8[i]); t8[i] = 1.f - 2.f * frcp(e + 1.f); }
            Aw[s] = pack_frag(t8); }
#pragma unroll
        for (int s = 0; s < 2; ++s) { load_mix8(prow + 1600 + 32 * s + 8 * fq, hp, mu + 1600 + 32 * s + 8 * fq, t8); Aa[s] = pack_frag(t8); }
#pragma unroll
        for (int s = 0; s < 4; ++s) { load_mix8(prow + 1664 + 32 * s + 8 * fq, hp, mu + 1664 + 32 * s + 8 * fq, t8);
#pragma unroll
            for (int i = 0; i < 8; ++i) t8[i] = fsigmoid(t8[i]);
            Ag[s] = pack_frag(t8); }
#pragma unroll 1
        for (int h = 0; h < NH; ++h) {
            float kkr[16], av[16]; unsigned lk[16], rvp[16];
            float ss = 0.f, brs = 0.f, krs = 0.f, rkbs = 0.f;
#pragma unroll
            for (int n = 0; n < 4; ++n) {
                const int cb = 64 * h + 16 * n, c0 = cb + 4 * fq;
                f32x4 aw = {0.f, 0.f, 0.f, 0.f}, aa = aw, ag = aw;
#pragma unroll
                for (int s = 0; s < 2; ++s) {
                    aw = __builtin_amdgcn_mfma_f32_16x16x32_bf16(*(const bf16x8*)(WLU + (size_t)(cb + fr) * 64 + 32 * s + 8 * fq), Aw[s], aw, 0, 0, 0);
                    aa = __builtin_amdgcn_mfma_f32_16x16x32_bf16(*(const bf16x8*)(WLA + (size_t)(cb + fr) * 64 + 32 * s + 8 * fq), Aa[s], aa, 0, 0, 0); }
#pragma unroll
                for (int s = 0; s < 4; ++s)
                    ag = __builtin_amdgcn_mfma_f32_16x16x32_bf16(*(const bf16x8*)(WLG + (size_t)(cb + fr) * 128 + 32 * s + 8 * fq), Ag[s], ag, 0, 0, 0);
                float rr[4], kr4[4], vv[4];
                load_mix4(prow + c0, hp, mu + c0, rr); load_mix4(prow + 512 + c0, hp, mu + 512 + c0, kr4); load_mix4(prow + 1024 + c0, hp, mu + 1024 + c0, vv);
                const f32x4 w0v = *(const f32x4*)(w0 + c0), a0v = *(const f32x4*)(a0 + c0), kkv = *(const f32x4*)(k_k + c0), kav = *(const f32x4*)(k_a + c0), rkv = *(const f32x4*)(r_k + c0);
#pragma unroll
                for (int j = 0; j < 4; ++j) {
                    const float sg = fsigmoid(w0v[j] + aw[j]);
                    const float ldx = -0.60653065971f * 1.44269504089f * sg;
                    const float av_ = fsigmoid(a0v[j] + aa[j]);
                    const float kkraw = kr4[j] * kkv[j];
                    const float k2 = kr4[j] * (1.f + (av_ - 1.f) * kav[j]);
                    ss += kkraw * kkraw; brs += kkraw * av_ * rr[j]; krs += k2 * rr[j]; rkbs += rr[j] * k2 * rkv[j];
                    kkr[4 * n + j] = kkraw; av[4 * n + j] = av_; lk[4 * n + j] = cvt_pk_bf16(ldx, k2); rvp[4 * n + j] = cvt_pk_bf16(rr[j], vv[j]);
                }
                u32x2 gp; gp.x = cvt_pk_bf16(ag[0], ag[1]); gp.y = cvt_pk_bf16(ag[2], ag[3]);
                *(u32x2*)(GB + (size_t)m * 512 + c0) = gp;
            }
            ss = red16(ss); brs = red16(brs); krs = red16(krs); rkbs = red16(rkbs);
            const float inv = 1.f / fmaxf(sqrtf(ss), 1e-12f);
            unsigned char* rec = SI + (((size_t)m * 8 + h) * 64) * 12;
#pragma unroll
            for (int n = 0; n < 4; ++n) {
                unsigned dw[12];
#pragma unroll
                for (int j = 0; j < 4; ++j) { const float kk = kkr[4 * n + j] * inv;
                    const unsigned kp = cvt_pk_bf16(kk * av[4 * n + j], -kk);
                    dw[3 * j] = (lk[4 * n + j] & 0xffffu) | (kp & 0xffff0000u); dw[3 * j + 1] = (kp & 0xffffu) | (lk[4 * n + j] & 0xffff0000u); dw[3 * j + 2] = rvp[4 * n + j]; }
                u32x4* dst = (u32x4*)(rec + (16 * n + 4 * fq) * 12);
                u32x4 s0 = {dw[0], dw[1], dw[2], dw[3]}, s1 = {dw[4], dw[5], dw[6], dw[7]}, s2 = {dw[8], dw[9], dw[10], dw[11]};
                dst[0] = s0; dst[1] = s1; dst[2] = s2;
            }
            if (fq == 0) { f32x4 sc = {brs * inv, krs, rkbs, 0.f}; *(f32x4*)(SC + ((size_t)m * 8 + h) * 4) = sc; }
        }
    }
}

#define MK_FMAC_BC(acc, src, s, n) asm("v_fmac_f32_dpp %0, %1, %2 row_newbcast:" #n " row_mask:0xf bank_mask:0xf" : "+v"(acc) : "v"(src), "v"(s))
#define MK_MUL_BC(dst, src, s, n) asm("v_mul_f32_dpp %0, %1, %2 row_newbcast:" #n " row_mask:0xf bank_mask:0xf" : "=v"(dst) : "v"(src), "v"(s))
#define MK_REP16(X) X(0) X(1) X(2) X(3) X(4) X(5) X(6) X(7) X(8) X(9) X(10) X(11) X(12) X(13) X(14) X(15)
__device__ __forceinline__ float red_rows(float x) {
    float a0 = x, a1 = x;
    asm volatile("s_nop 1\n\tv_permlane16_swap_b32 %0, %1" : "+v"(a0), "+v"(a1));
    float b0 = a0 + a1, b1 = b0;
    asm volatile("s_nop 1\n\tv_permlane32_swap_b32 %0, %1" : "+v"(b0), "+v"(b1));
    return b0 + b1;
}
struct ScanRec { unsigned d0, d1, d2; unsigned short vv; float br, kr; };
__device__ __forceinline__ void scan_load(ScanRec& R, const unsigned char* SI, const float* SC, size_t mh, int lane, int vrow) {
    const unsigned* p = (const unsigned*)(SI + (mh * 64 + lane) * 12);
    R.d0 = p[0]; R.d1 = p[1]; R.d2 = p[2];
    R.vv = *(const unsigned short*)(SI + (mh * 64 + vrow) * 12 + 10);
    const f32x2 s = *(const f32x2*)(SC + mh * 4); R.br = s[0]; R.kr = s[1];
}
__device__ __forceinline__ void scan_wave(const Args& a, int bh, int rb, int lane) {
    const unsigned char* SI = a.ws + O_SI; const float* SC = (const float*)(a.ws + O_SC); bf16_t* YR = (bf16_t*)(a.ws + O_YR);
    const int b = bh >> 3, h = bh & 7, r = lane & 15, vrow = 16 * rb + r;
    const size_t m0 = (size_t)b * SEQ;
    float S0 = 0.f, S1 = 0.f, S2 = 0.f, S3 = 0.f, S4 = 0.f, S5 = 0.f, S6 = 0.f, S7 = 0.f, S8 = 0.f, S9 = 0.f, S10 = 0.f, S11 = 0.f, S12 = 0.f, S13 = 0.f, S14 = 0.f, S15 = 0.f;
    ScanRec cur[8], nxt[8];
#pragma unroll
    for (int i = 0; i < 8; ++i) scan_load(cur[i], SI, SC, (m0 + i) * 8 + h, lane, vrow);
    for (int t0 = 0; t0 < SEQ; t0 += 8) {
        const int tn = (t0 + 8 < SEQ) ? t0 + 8 : t0;
#pragma unroll
        for (int i = 0; i < 8; ++i) scan_load(nxt[i], SI, SC, (m0 + tn + i) * 8 + h, lane, vrow);
#pragma unroll
        for (int i = 0; i < 8; ++i) {
            float nkk = bf_hi(cur[i].d0), kka = bf_lo(cur[i].d1), k2 = bf_hi(cur[i].d1);
            float w = __builtin_amdgcn_exp2f(bf_lo(cur[i].d0));
            float wr = w * bf_lo(cur[i].d2);
            const float v = __uint_as_float((unsigned)cur[i].vv << 16);
            asm volatile("s_nop 1" : "+v"(nkk), "+v"(kka), "+v"(k2), "+v"(w), "+v"(wr));
            float sa0 = 0.f, sa1 = 0.f, yp0 = 0.f, yp1 = 0.f;
#define MK_MV(n) if ((n) & 1) { MK_FMAC_BC(sa1, nkk, S##n, n); MK_FMAC_BC(yp1, wr, S##n, n); } else { MK_FMAC_BC(sa0, nkk, S##n, n); MK_FMAC_BC(yp0, wr, S##n, n); }
            MK_REP16(MK_MV)
#undef MK_MV
            const float sa = red_rows(sa0 + sa1), yp = red_rows(yp0 + yp1);
            float sav = sa, vv2 = v;
#define MK_UP(n) { MK_MUL_BC(S##n, w, S##n, n); MK_FMAC_BC(S##n, kka, sav, n); MK_FMAC_BC(S##n, k2, vv2, n); }
            MK_REP16(MK_UP)
#undef MK_UP
            const float y = yp + sa * cur[i].br + v * cur[i].kr;
            if (lane < 16) YR[(m0 + t0 + i) * 512 + 64 * h + vrow] = bf1(y);
        }
#pragma unroll
        for (int i = 0; i < 8; ++i) cur[i] = nxt[i];
    }
}

struct KV { bf16x8 k[4]; bf16x8 v[2][2]; };
__device__ __forceinline__ void attn_load(KV& T, const bf16_t* Kh, const bf16_t* Vh, int k0, int n, int hf) {
    const bf16_t* kp = Kh + (size_t)(k0 + n) * 512 + 8 * hf;
#pragma unroll
    for (int s = 0; s < 4; ++s) T.k[s] = *(const bf16x8*)(kp + 16 * s);
#pragma unroll
    for (int d = 0; d < 2; ++d)
#pragma unroll
        for (int sg = 0; sg < 2; ++sg) { const bf16_t* vp = Vh + (size_t)(32 * d + n) * SEQ + k0 + 16 * sg + 4 * hf;
            const u32x2 lo = *(const u32x2*)vp, hi = *(const u32x2*)(vp + 8); u32x4 t = {lo.x, lo.y, hi.x, hi.y}; T.v[d][sg] = __builtin_bit_cast(bf16x8, t); }
}
__device__ __forceinline__ void attn_wave(const Args& a, int bh, int w4, int lane) {
    const int b = bh >> 3, h = bh & 7, n = lane & 31, hf = lane >> 5;
    const size_t m0 = (size_t)b * SEQ;
    const bf16_t* Qh = (const bf16_t*)(a.ws + O_Q) + m0 * 512 + 64 * h;
    const bf16_t* Kh = (const bf16_t*)(a.ws + O_K) + m0 * 512 + 64 * h;
    const bf16_t* Vh = (const bf16_t*)(a.ws + O_VT) + (size_t)bh * 64 * SEQ;
    bf16_t* Oh = (bf16_t*)(a.ws + O_OSB) + m0 * 512 + 64 * h;
    for (int qt = 63 - w4; qt >= 0; qt -= 4) {
        const int q0 = 32 * qt;
        bf16x8 qf[4];
#pragma unroll
        for (int s = 0; s < 4; ++s) qf[s] = *(const bf16x8*)(Qh + (size_t)(q0 + n) * 512 + 16 * s + 8 * hf);
        f32x16 o0, o1;
#pragma unroll
        for (int i = 0; i < 16; ++i) { o0[i] = 0.f; o1[i] = 0.f; }
        float carry = 0.f;
        KV cur, nxt;
        attn_load(cur, Kh, Vh, q0, n, hf);
        for (int kt = qt; kt >= 0; --kt) {
            const int ktn = kt > 0 ? kt - 1 : 0;
            attn_load(nxt, Kh, Vh, 32 * ktn, n, hf);
            f32x16 sc;
#pragma unroll
            for (int i = 0; i < 16; ++i) sc[i] = 0.f;
#pragma unroll
            for (int s = 0; s < 4; ++s) sc = __builtin_amdgcn_mfma_f32_32x32x16_bf16(cur.k[s], qf[s], sc, 0, 0, 0);
            const bool diag = (kt == qt);
            float lf[16], G4[4];
#pragma unroll
            for (int g = 0; g < 4; ++g) { G4[g] = 0.f;
#pragma unroll
                for (int i = 0; i < 4; ++i) { const int r = 4 * g + i; const float z = sc[r];
                    const bool valid = !diag || (8 * g + 4 * hf + i < n);
                    const float e = fexp(-fabsf(z));
                    const float sp = fmaxf(z, 0.f) + flog(1.f + e);
                    lf[r] = valid ? -sp : 0.f; G4[g] += lf[r]; } }
            float PG[4], T4[4];
#pragma unroll
            for (int g = 0; g < 4; ++g) { PG[g] = __shfl_xor(G4[g], 32); T4[g] = G4[g] + PG[g]; }
            const float tail3 = 0.f, tail2 = T4[3], tail1 = T4[3] + T4[2], tail0 = tail1 + T4[1], total = tail0 + T4[0];
            const float tails[4] = {tail0, tail1, tail2, tail3};
            f32x16 wv;
#pragma unroll
            for (int g = 0; g < 4; ++g) {
                float af = carry + tails[g] + (hf == 0 ? PG[g] : 0.f);
#pragma unroll
                for (int i = 3; i >= 0; --i) { const int r = 4 * g + i; const float z = sc[r];
                    const bool valid = !diag || (8 * g + 4 * hf + i < n);
                    const float wgt = fexp(lf[r] + z + af);
                    wv[r] = valid ? wgt : 0.f;
                    af += lf[r]; } }
            carry += total;
            bf16x8 wf[2];
#pragma unroll
            for (int sg = 0; sg < 2; ++sg) { u32x4 t; t.x = cvt_pk_bf16(wv[8 * sg + 0], wv[8 * sg + 1]); t.y = cvt_pk_bf16(wv[8 * sg + 2], wv[8 * sg + 3]); t.z = cvt_pk_bf16(wv[8 * sg + 4], wv[8 * sg + 5]); t.w = cvt_pk_bf16(wv[8 * sg + 6], wv[8 * sg + 7]); wf[sg] = __builtin_bit_cast(bf16x8, t); }
#pragma unroll
            for (int sg = 0; sg < 2; ++sg) { o0 = __builtin_amdgcn_mfma_f32_32x32x16_bf16(cur.v[0][sg], wf[sg], o0, 0, 0, 0); o1 = __builtin_amdgcn_mfma_f32_32x32x16_bf16(cur.v[1][sg], wf[sg], o1, 0, 0, 0); }
            cur = nxt;
#if MK_EARLY_EXIT
            if (__all(carry < -104.f)) break;
#endif
        }
        bf16_t* op = Oh + (size_t)(q0 + n) * 512 + 4 * hf;
#pragma unroll
        for (int g = 0; g < 4; ++g) {
            u32x2 t0, t1; t0.x = cvt_pk_bf16(o0[4 * g], o0[4 * g + 1]); t0.y = cvt_pk_bf16(o0[4 * g + 2], o0[4 * g + 3]); t1.x = cvt_pk_bf16(o1[4 * g], o1[4 * g + 1]); t1.y = cvt_pk_bf16(o1[4 * g + 2], o1[4 * g + 3]);
            *(u32x2*)(op + 8 * g) = t0; *(u32x2*)(op + 32 + 8 * g) = t1; }
    }
}
__device__ __forceinline__ void phase_mixer(const Args& a, int G) {
    const int tid = my_tid(); const int wave = __builtin_amdgcn_readfirstlane(tid >> 6), lane = tid & 63;
    for (int bh = blockIdx.x; bh < NB * NH; bh += G) {
        if (wave < 4) scan_wave(a, bh, wave, lane);
        else attn_wave(a, bh, wave - 4, lane);
    }
}

__device__ __forceinline__ void phase_rwpost(const Args& a, int G) {
    const unsigned char* SI = a.ws + O_SI; const float* SC = (const float*)(a.ws + O_SC);
    const bf16_t* YR = (const bf16_t*)(a.ws + O_YR); const bf16_t* GB = (const bf16_t*)(a.ws + O_G); bf16_t* ORW = (bf16_t*)(a.ws + O_ORW);
    const float *lw = a.in[13], *lb = a.in[14];
    const size_t total = (size_t)M * 128, stride = (size_t)G * 512;
    const int tid = my_tid();
    for (size_t idx = (size_t)blockIdx.x * 512 + tid; idx < total; idx += stride) {
        const size_t m = idx >> 7; const int c = ((int)idx & 127) * 4, h = c >> 6, cc = c & 63;
        const u32x2 yb = *(const u32x2*)(YR + m * 512 + c);
        float y[4] = {bf_lo(yb.x), bf_hi(yb.x), bf_lo(yb.y), bf_hi(yb.y)};
        float s = (y[0] + y[1]) + (y[2] + y[3]);
#pragma unroll
        for (int o = 1; o < 16; o <<= 1) s += __shfl_xor(s, o);
        const float mean = s * (1.f / 64.f);
        float q = 0.f;
#pragma unroll
        for (int j = 0; j < 4; ++j) { y[j] -= mean; q += y[j] * y[j]; }
#pragma unroll
        for (int o = 1; o < 16; o <<= 1) q += __shfl_xor(q, o);
        const float rstd = rsqrtf(q * (1.f / 64.f) + GN_EPS);
        const float rkb = SC[(m * 8 + h) * 4 + 2];
        const u32x2 gb = *(const u32x2*)(GB + m * 512 + c);
        const float g4[4] = {bf_lo(gb.x), bf_hi(gb.x), bf_lo(gb.y), bf_hi(gb.y)};
        const f32x4 lwv = *(const f32x4*)(lw + c), lbv = *(const f32x4*)(lb + c);
        float o4[4];
#pragma unroll
        for (int j = 0; j < 4; ++j) { const float v = __uint_as_float((unsigned)(*(const unsigned short*)(SI + ((m * 8 + h) * 64 + cc + j) * 12 + 10)) << 16);
            o4[j] = (y[j] * rstd * lwv[j] + lbv[j] + rkb * v) * g4[j]; }
        u32x2 ob; ob.x = cvt_pk_bf16(o4[0], o4[1]); ob.y = cvt_pk_bf16(o4[2], o4[3]);
        *(u32x2*)(ORW + m * 512 + c) = ob;
    }
}

template <int MODE> __device__ __forceinline__ void phase_rows(const Args& a, int G) {
    const int tid = my_tid(); const int wave = tid >> 6, lane = tid & 63;
    const int gw = blockIdx.x * 8 + wave, NGW = G * 8;
    const bf16_t* T = (const bf16_t*)(a.ws + (MODE == 0 ? O_TT : O_FF));
    const float* xin = MODE == 0 ? a.in[0] : a.out; const float* g1 = MODE == 0 ? a.in[18] : a.in[23]; const float* g2 = a.in[19];
    bf16_t* H2 = (bf16_t*)(a.ws + O_H2);
    f32x4 g1v[4], g2v[4];
#pragma unroll
    for (int j = 0; j < 4; ++j) { g1v[j] = ((const f32x4*)g1)[lane + 64 * j]; g2v[j] = ((const f32x4*)g2)[lane + 64 * j]; }
    for (int row = gw; row < M; row += NGW) {
        const u32x2* tr = (const u32x2*)(T + (size_t)row * D) + lane; const f32x4* xr = (const f32x4*)(xin + (size_t)row * D) + lane;
        f32x4 t[4], x[4]; float s = 0.f;
#pragma unroll
        for (int j = 0; j < 4; ++j) { const u32x2 tb = tr[64 * j]; x[j] = xr[64 * j]; t[j][0] = bf_lo(tb.x); t[j][1] = bf_hi(tb.x); t[j][2] = bf_lo(tb.y); t[j][3] = bf_hi(tb.y);
            s += (t[j][0] * t[j][0] + t[j][1] * t[j][1]) + (t[j][2] * t[j][2] + t[j][3] * t[j][3]); }
        const float rs = rsqrtf(wave_sum(s) * (1.f / D) + RMS_EPS);
        float s2 = 0.f; f32x4* orow = (f32x4*)(a.out + (size_t)row * D) + lane;
#pragma unroll
        for (int j = 0; j < 4; ++j) {
#pragma unroll
            for (int e = 0; e < 4; ++e) { x[j][e] += t[j][e] * rs * g1v[j][e]; s2 += x[j][e] * x[j][e]; }
            orow[64 * j] = x[j]; }
        if (MODE == 0) {
            const float rs2 = rsqrtf(wave_sum(s2) * (1.f / D) + RMS_EPS);
            u32x2* o = (u32x2*)(H2 + (size_t)row * D) + lane;
#pragma unroll
            for (int j = 0; j < 4; ++j) { u32x2 w; w.x = cvt_pk_bf16(x[j][0] * rs2 * g2v[j][0], x[j][1] * rs2 * g2v[j][1]); w.y = cvt_pk_bf16(x[j][2] * rs2 * g2v[j][2], x[j][3] * rs2 * g2v[j][3]); o[64 * j] = w; }
        }
    }
}

__global__ void __launch_bounds__(512, 2) mega(Args a) {
    extern __shared__ __attribute__((aligned(16))) unsigned char shm[];
    PG8_LAS unsigned char* lds = (PG8_LAS unsigned char*)shm;
    const int G = (int)gridDim.x;
    unsigned char* ws = a.ws;
    const int nsteps = (MK_REPMASK != 0) ? 2 * NPH : a.ph_hi;
    for (int st = a.ph_lo; st < nsteps; ++st) {
        int ph = st;
        if (MK_REPMASK != 0) { ph = st >> 1; if ((st & 1) && !((MK_REPMASK >> ph) & 1)) continue; }
        if (st > a.ph_lo) cg::this_grid().sync();
        switch (ph) {
        case 0: phase_prep(a, (float*)shm, G); break;
        case 1: { Epi1 E; E.Q = (bf16_t*)(ws + O_Q); E.Kb = (bf16_t*)(ws + O_K); E.Vt = (bf16_t*)(ws + O_VT); E.Prw = (bf16_t*)(ws + O_PRW); E.Gt = (bf16_t*)a.out; E.bgate = a.in[3];
            run_gemm(lds, (const bf16_t*)(ws + O_H), (const bf16_t*)(ws + O_WIN), INC, 1024, E, G); } break;
        case 2: phase_rwprep(a, G); break;
        case 3: phase_mixer(a, G); break;
        case 4: phase_rwpost(a, G); break;
        case 5: { EpiRow<1> E; E.O = (bf16_t*)(ws + O_T1); E.T1 = nullptr; E.Gt = (const bf16_t*)a.out;
            run_gemm(lds, (const bf16_t*)(ws + O_OSB), (const bf16_t*)(ws + O_WSB), 1024, 512, E, G); } break;
        case 6: { EpiRow<2> E; E.O = (bf16_t*)(ws + O_MRG); E.T1 = (const bf16_t*)(ws + O_T1); E.Gt = (const bf16_t*)a.out;
            run_gemm(lds, (const bf16_t*)(ws + O_ORW), (const bf16_t*)(ws + O_WRW), 1024, 512, E, G); } break;
        case 7: { EpiRow<0> E; E.O = (bf16_t*)(ws + O_TT); E.T1 = nullptr; E.Gt = nullptr;
            run_gemm(lds, (const bf16_t*)(ws + O_MRG), (const bf16_t*)(ws + O_WO), 1024, 1024, E, G); } break;
        case 8: phase_rows<0>(a, G); break;
        case 9: { EpiSwiGLU E; E.Hd = (bf16_t*)(ws + O_HID);
            run_gemm(lds, (const bf16_t*)(ws + O_H2), (const bf16_t*)(ws + O_WGU), 2 * DFF, 1024, E, G); } break;
        case 10: { EpiRow<0> E; E.O = (bf16_t*)(ws + O_FF); E.T1 = nullptr; E.Gt = nullptr;
            run_gemm(lds, (const bf16_t*)(ws + O_HID), (const bf16_t*)(ws + O_WDN), 1024, DFF, E, G); } break;
        case 11: phase_rows<1>(a, G); break;
        }
    }
}
}

#if MK_DIAG
namespace dg {
using namespace mk;
constexpr size_t O_ERR = 1000 * MiB;
__device__ __forceinline__ float bfr(float x) { return __uint_as_float(((unsigned)bf1(x)) << 16); }
__device__ __forceinline__ float ldb(const bf16_t* p) { return __uint_as_float(((unsigned)*p) << 16); }
__device__ __forceinline__ void upd(float* err, int i, float got, float ref) {
    atomicMax((unsigned*)err + 2 * i, __float_as_uint(fabsf(got - ref))); atomicMax((unsigned*)err + 2 * i + 1, __float_as_uint(fabsf(ref)));
    if (!(fabsf(got) < 1e30f)) atomicMax((unsigned*)err + 2 * i, __float_as_uint(1e30f));
}
__device__ __forceinline__ unsigned hsh(unsigned x) { x ^= x >> 16; x *= 0x7feb352du; x ^= x >> 15; x *= 0x846ca68bu; x ^= x >> 16; return x; }
__global__ void chk_gemm1(Args a) {
    const int i = blockIdx.x * blockDim.x + threadIdx.x; float* err = (float*)(a.ws + O_ERR);
    const int m = hsh(2 * i + 1) % M; int n = hsh(2 * i + 2) % INC; if ((i & 3) == 0) n = 1024 + (n % 512);
    const float* x = a.in[0] + (size_t)m * D; const float* g = a.in[1]; const float* W = a.in[2];
    float ss = 0.f; for (int k = 0; k < D; ++k) ss += x[k] * x[k];
    const float rs = rsqrtf(ss / D + RMS_EPS); float dot = 0.f;
    for (int k = 0; k < D; ++k) dot += bfr(x[k] * rs * g[k]) * bfr(W[(size_t)k * INC + n]);
    float got, ref;
    if (n < 512) { ref = dot * 0.125f; got = ldb((const bf16_t*)(a.ws + O_Q) + (size_t)m * 512 + n); }
    else if (n < 1024) { ref = dot; got = ldb((const bf16_t*)(a.ws + O_K) + (size_t)m * 512 + n - 512); }
    else if (n < 1536) { ref = dot; const int c = n - 1024, b = m >> 11, s = m & 2047; got = ldb((const bf16_t*)(a.ws + O_VT) + ((size_t)(b * 8 + (c >> 6)) * 64 + (c & 63)) * 2048 + s); }
    else if (n < 3328) { ref = dot; got = ldb((const bf16_t*)(a.ws + O_PRW) + (size_t)m * RWC + n - 1536); }
    else { ref = 1.f / (1.f + expf(-(dot + a.in[3][n - 3328]))); got = ldb((const bf16_t*)a.out + (size_t)m * GC + n - 3328); }
    upd(err, 0, got, ref);
}
__global__ void chk_rwprep(Args a) {
    const int i = blockIdx.x * blockDim.x + threadIdx.x; float* err = (float*)(a.ws + O_ERR);
    int m = hsh(3 * i + 7) % M; if ((i & 7) == 0) m &= ~2047; if ((i & 7) == 1) m = (m & ~15) | ((i >> 3) & 1 ? 0 : 15);
    const int h = hsh(3 * i + 8) % NH;
    const bf16_t* P = (const bf16_t*)(a.ws + O_PRW) + (size_t)m * RWC; const bool hp = (m & 2047) != 0;
    const float *mu = a.in[4], *w0 = a.in[5], *wup = a.in[6], *a0 = a.in[7], *aup = a.in[8], *gup = a.in[9], *k_k = a.in[10], *k_a = a.in[11], *r_k = a.in[12];
    auto mix = [&](int c) { const float cur = ldb(P + c), prv = hp ? ldb(P + c - RWC) : 0.f; return cur + (prv - cur) * mu[c]; };
    float ss = 0.f, br = 0.f, kr = 0.f, rkb = 0.f;
    for (int pass = 0; pass < 2; ++pass) {
        const float inv = 1.f / fmaxf(sqrtf(ss), 1e-12f);
        for (int cc = 0; cc < 64; ++cc) { const int c = 64 * h + cc;
            float wr = w0[c], ar = a0[c], gg = 0.f;
            for (int k = 0; k < 64; ++k) { wr += bfr(tanhf(mix(1536 + k))) * bfr(wup[k * 512 + c]); ar += bfr(mix(1600 + k)) * bfr(aup[k * 512 + c]); }
            for (int k = 0; k < 128; ++k) gg += bfr(1.f / (1.f + expf(-mix(1664 + k)))) * bfr(gup[k * 512 + c]);
            const float r = mix(c), kraw = mix(512 + c), v = mix(1024 + c);
            const float av = 1.f / (1.f + expf(-ar)), sg = 1.f / (1.f + expf(-wr));
            const float kkraw = kraw * k_k[c], k2 = kraw * (1.f + (av - 1.f) * k_a[c]);
            if (pass == 0) { ss += kkraw * kkraw; br += kkraw * av * r; kr += k2 * r; rkb += r * k2 * r_k[c]; }
            else { const float kk = kkraw * inv;
                const unsigned* rec = (const unsigned*)(a.ws + O_SI + (((size_t)m * 8 + h) * 64 + cc) * 12);
                upd(err, 1, bf_lo(rec[0]), -0.60653065971f * 1.44269504089f * sg); upd(err, 2, bf_hi(rec[0]), -kk); upd(err, 2, bf_lo(rec[1]), kk * av); upd(err, 3, bf_hi(rec[1]), k2);
                upd(err, 3, bf_lo(rec[2]), r); upd(err, 3, bf_hi(rec[2]), v); upd(err, 4, ldb((const bf16_t*)(a.ws + O_G) + (size_t)m * 512 + c), gg); }
        }
        if (pass == 1) { const float* sc = (const float*)(a.ws + O_SC) + ((size_t)m * 8 + h) * 4; upd(err, 5, sc[0], br * inv); upd(err, 5, sc[1], kr); upd(err, 5, sc[2], rkb); }
    }
}
__global__ void __launch_bounds__(64) chk_scan(Args a) {
    const int b = blockIdx.x < 8 ? 0 : 31, h = blockIdx.x & 7, lane = threadIdx.x; float* err = (float*)(a.ws + O_ERR);
    float S[64];
#pragma unroll
    for (int k = 0; k < 64; ++k) S[k] = 0.f;
    for (int t = 0; t < SEQ; ++t) { const size_t mh = ((size_t)b * SEQ + t) * 8 + h; const unsigned char* rec = a.ws + O_SI + mh * 64 * 12;
        const float v = bf_hi(*(const unsigned*)(rec + lane * 12 + 8)); float sa = 0.f;
#pragma unroll
        for (int k = 0; k < 64; ++k) sa += S[k] * bf_hi(*(const unsigned*)(rec + k * 12));
        float y = 0.f;
#pragma unroll
        for (int k = 0; k < 64; ++k) { const unsigned d0 = *(const unsigned*)(rec + k * 12), d1 = *(const unsigned*)(rec + k * 12 + 4), d2 = *(const unsigned*)(rec + k * 12 + 8);
            S[k] = S[k] * exp2f(bf_lo(d0)) + sa * bf_lo(d1) + v * bf_hi(d1); y += S[k] * bf_lo(d2); }
        upd(err, 6, ldb((const bf16_t*)(a.ws + O_YR) + ((size_t)b * SEQ + t) * 512 + 64 * h + lane), y); }
}
__global__ void __launch_bounds__(256) chk_attn(Args a) {
    const int i = blockIdx.x * blockDim.x + threadIdx.x; float* err = (float*)(a.ws + O_ERR);
    const int t = (i & 255) * 8 + ((i >> 8) & 7), h = (i >> 8) & 7, b = (i >> 11) ? 31 : 0;
    const bf16_t* Q = (const bf16_t*)(a.ws + O_Q) + ((size_t)b * SEQ + t) * 512 + 64 * h; const bf16_t* Kb = (const bf16_t*)(a.ws + O_K) + (size_t)b * SEQ * 512 + 64 * h;
    const bf16_t* Vt = (const bf16_t*)(a.ws + O_VT) + (size_t)(b * 8 + h) * 64 * SEQ;
    float q[64], o[64];
#pragma unroll
    for (int d = 0; d < 64; ++d) { q[d] = ldb(Q + d); o[d] = 0.f; }
    float after = 0.f;
    for (int s = t - 1; s >= 0 && after > -60.f; --s) { float z = 0.f;
#pragma unroll
        for (int d = 0; d < 64; ++d) z += q[d] * ldb(Kb + (size_t)s * 512 + d);
        const float lsz = z > 0.f ? -log1pf(expf(-z)) : z - log1pf(expf(z)); const float w = bfr(expf(lsz + after));
#pragma unroll
        for (int d = 0; d < 64; ++d) o[d] += w * ldb(Vt + (size_t)d * SEQ + s);
        after += lsz - z; }
    const bf16_t* O = (const bf16_t*)(a.ws + O_OSB) + ((size_t)b * SEQ + t) * 512 + 64 * h;
#pragma unroll
    for (int d = 0; d < 64; ++d) upd(err, 7, ldb(O + d), o[d]);
}
__global__ void chk_rwpost(Args a) {
    const int i = blockIdx.x * blockDim.x + threadIdx.x; float* err = (float*)(a.ws + O_ERR);
    const int m = hsh(5 * i + 1) % M, h = hsh(5 * i + 2) % NH;
    const bf16_t* Y = (const bf16_t*)(a.ws + O_YR) + (size_t)m * 512 + 64 * h; float mean = 0.f, var = 0.f;
    for (int c = 0; c < 64; ++c) mean += ldb(Y + c); mean /= 64.f;
    for (int c = 0; c < 64; ++c) { const float d = ldb(Y + c) - mean; var += d * d; } var /= 64.f;
    const float rkb = ((const float*)(a.ws + O_SC))[((size_t)m * 8 + h) * 4 + 2];
    for (int c = 0; c < 64; ++c) { const float v = bf_hi(*(const unsigned*)(a.ws + O_SI + (((size_t)m * 8 + h) * 64 + c) * 12 + 8));
        const float ref = ((ldb(Y + c) - mean) * rsqrtf(var + GN_EPS) * a.in[13][64 * h + c] + a.in[14][64 * h + c] + rkb * v) * ldb((const bf16_t*)(a.ws + O_G) + (size_t)m * 512 + 64 * h + c);
        upd(err, 8, ldb((const bf16_t*)(a.ws + O_ORW) + (size_t)m * 512 + 64 * h + c), ref); }
}
__global__ void chk_tt(Args a) {
    __shared__ float mrg[1024]; float* err = (float*)(a.ws + O_ERR);
    const int m = hsh(7 * blockIdx.x + 3) % M, tid = threadIdx.x;
    const bf16_t* osb = (const bf16_t*)(a.ws + O_OSB) + (size_t)m * 512; const bf16_t* orw = (const bf16_t*)(a.ws + O_ORW) + (size_t)m * 512; const bf16_t* gt = (const bf16_t*)a.out + (size_t)m * GC;
    for (int j = tid; j < 1024; j += 256) { float s1 = 0.f, s2 = 0.f;
        for (int k = 0; k < 512; ++k) { s1 += ldb(osb + k) * bfr(a.in[15][(size_t)k * 1024 + j]); s2 += ldb(orw + k) * bfr(a.in[16][(size_t)k * 1024 + j]); }
        const float v = bfr(bfr(ldb(gt + j) * s1) + ldb(gt + 1024 + j) * s2); mrg[j] = v;
        upd(err, 9, ldb((const bf16_t*)(a.ws + O_MRG) + (size_t)m * 1024 + j), v); }
    __syncthreads();
    for (int c = tid; c < 1024; c += 256) { float s = 0.f; for (int j = 0; j < 1024; ++j) s += mrg[j] * bfr(a.in[17][(size_t)j * 1024 + c]);
        upd(err, 10, ldb((const bf16_t*)(a.ws + O_TT) + (size_t)m * 1024 + c), s); }
}
__global__ void chk_rows1(Args a) {
    __shared__ float red[256]; __shared__ float x1s[1024]; float* err = (float*)(a.ws + O_ERR);
    const int m = hsh(11 * blockIdx.x + 5) % M, tid = threadIdx.x;
    const bf16_t* T = (const bf16_t*)(a.ws + O_TT) + (size_t)m * 1024; float s = 0.f;
    for (int c = tid; c < 1024; c += 256) s += ldb(T + c) * ldb(T + c);
    red[tid] = s; __syncthreads(); for (int o = 128; o > 0; o >>= 1) { if (tid < o) red[tid] += red[tid + o]; __syncthreads(); }
    const float rs = rsqrtf(red[0] / 1024.f + RMS_EPS); __syncthreads(); float s2 = 0.f;
    for (int c = tid; c < 1024; c += 256) { const float v = a.in[0][(size_t)m * 1024 + c] + ldb(T + c) * rs * a.in[18][c]; x1s[c] = v; s2 += v * v; upd(err, 11, a.out[(size_t)m * 1024 + c], v); }
    red[tid] = s2; __syncthreads(); for (int o = 128; o > 0; o >>= 1) { if (tid < o) red[tid] += red[tid + o]; __syncthreads(); }
    const float rs2 = rsqrtf(red[0] / 1024.f + RMS_EPS);
    for (int c = tid; c < 1024; c += 256) upd(err, 11, ldb((const bf16_t*)(a.ws + O_H2) + (size_t)m * 1024 + c), x1s[c] * rs2 * a.in[19][c]);
}
__global__ void chk_ffn(Args a) {
    __shared__ float hid[DFF]; __shared__ float hh[1024]; float* err = (float*)(a.ws + O_ERR);
    const int m = hsh(13 * blockIdx.x + 9) % M, tid = threadIdx.x;
    for (int c = tid; c < 1024; c += 256) hh[c] = ldb((const bf16_t*)(a.ws + O_H2) + (size_t)m * 1024 + c);
    __syncthreads();
    for (int j = tid; j < DFF; j += 256) { float g = 0.f, u = 0.f;
        for (int k = 0; k < 1024; ++k) { g += hh[k] * bfr(a.in[20][(size_t)k * DFF + j]); u += hh[k] * bfr(a.in[21][(size_t)k * DFF + j]); }
        const float v = bfr(g / (1.f + expf(-g)) * u); hid[j] = v; upd(err, 12, ldb((const bf16_t*)(a.ws + O_HID) + (size_t)m * DFF + j), v); }
    __syncthreads();
    for (int c = tid; c < 1024; c += 256) { float s = 0.f; for (int j = 0; j < DFF; ++j) s += hid[j] * bfr(a.in[22][(size_t)j * 1024 + c]);
        upd(err, 13, ldb((const bf16_t*)(a.ws + O_FF) + (size_t)m * 1024 + c), s); }
}
__global__ void diag_out(Args a, int sel) {
    const float* err = (const float*)(a.ws + O_ERR);
    const int grp[14] = {0, 1, 1, 2, 2, 2, 3, 4, 5, 6, 6, 7, 8, 8};
    int code = 0;
    for (int i = 0; i < 14; ++i) { const float d = err[2 * i], r = err[2 * i + 1]; if (!(d <= 0.04f * r + 1e-3f)) code |= 1 << grp[i]; }
    if (sel == 1) code >>= 5;
    code &= 31;
    const float alpha = 2.f + (float)code;
    for (size_t i = (size_t)blockIdx.x * blockDim.x + threadIdx.x; i < (size_t)M * D; i += (size_t)gridDim.x * blockDim.x) a.out[i] = alpha * a.in[0][i];
}
}
#endif

extern "C" void kernel_launch(void* const* d_in, const int* in_sizes, int n_in, void* d_out, int out_size, void* d_ws, size_t ws_size, hipStream_t stream) {
    static int grid = 0;
    if (grid == 0) {
        if (n_in != 24 || in_sizes[0] != mk::M * mk::D || out_size != mk::M * mk::D || ws_size < mk::WS_NEED) {
            fprintf(stderr, "kernel_launch: unexpected shapes: n_in %d in0 %d out %d ws %zu (need %zu)\n", n_in, n_in > 0 ? in_sizes[0] : -1, out_size, ws_size, (size_t)mk::WS_NEED); grid = -1; return; }
        int dev = 0, cus = 0, per_cu = 0;
        hipGetDevice(&dev); hipDeviceGetAttribute(&cus, hipDeviceAttributeMultiprocessorCount, dev);
        if (hipFuncSetAttribute((const void*)mk::mega, hipFuncAttributeMaxDynamicSharedMemorySize, mk::LDS_BYTES) != hipSuccess) { fprintf(stderr, "kernel_launch: hipFuncSetAttribute failed\n"); grid = -1; return; }
        if (hipOccupancyMaxActiveBlocksPerMultiprocessor(&per_cu, (const void*)mk::mega, 512, mk::LDS_BYTES) != hipSuccess || per_cu < 1) { fprintf(stderr, "kernel_launch: occupancy query failed (%d)\n", per_cu); per_cu = 1; }
        (void)hipGetLastError();
        grid = cus * per_cu;
        fprintf(stderr, "kernel_launch: grid %d (cus %d x %d)\n", grid, cus, per_cu);
    }
    if (grid < 0) return;
    mk::Args a{};
    for (int i = 0; i < 24; ++i) a.in[i] = (const float*)d_in[i];
    a.out = (float*)d_out; a.ws = (unsigned char*)d_ws;
#if MK_SPLIT
#if MK_DIAG
    (void)hipMemsetAsync((char*)d_ws + dg::O_ERR, 0, 256, stream);
#endif
    for (int ph = 0; ph < mk::NPH; ++ph) { a.ph_lo = ph; a.ph_hi = ph + 1; hipLaunchKernelGGL(mk::mega, dim3(grid), dim3(512), mk::LDS_BYTES, stream, a);
#if MK_DIAG
        if (ph == 1) hipLaunchKernelGGL(dg::chk_gemm1, dim3(64), dim3(256), 0, stream, a);
        if (ph == 2) hipLaunchKernelGGL(dg::chk_rwprep, dim3(16), dim3(256), 0, stream, a);
        if (ph == 3) { hipLaunchKernelGGL(dg::chk_scan, dim3(16), dim3(64), 0, stream, a); hipLaunchKernelGGL(dg::chk_attn, dim3(16), dim3(256), 0, stream, a); }
        if (ph == 4) hipLaunchKernelGGL(dg::chk_rwpost, dim3(16), dim3(256), 0, stream, a);
        if (ph == 7) hipLaunchKernelGGL(dg::chk_tt, dim3(64), dim3(256), 0, stream, a);
        if (ph == 8) hipLaunchKernelGGL(dg::chk_rows1, dim3(64), dim3(256), 0, stream, a);
        if (ph == 10) hipLaunchKernelGGL(dg::chk_ffn, dim3(64), dim3(256), 0, stream, a);
#endif
    }
#if MK_DIAG
    hipLaunchKernelGGL(dg::diag_out, dim3(2048), dim3(256), 0, stream, a, MK_DIAG - 1);
#endif
#else
    a.ph_lo = 0; a.ph_hi = mk::NPH;
    void* args[] = {&a};
    hipError_t e = hipLaunchCooperativeKernel((const void*)mk::mega, dim3(grid), dim3(512), args, mk::LDS_BYTES, stream);
    if (e != hipSuccess) fprintf(stderr, "kernel_launch: cooperative launch failed: %s (grid %d)\n", hipGetErrorString(e), grid);
#endif
}
```

```cpp
#include <hip/hip_runtime.h>
#include <hip/hip_cooperative_groups.h>
#include <cstdio>
#include <cstdint>
namespace cg = cooperative_groups;
#ifndef MK_SPLIT
#define MK_SPLIT 0
#endif
#ifndef MK_DIAG
#define MK_DIAG 0
#endif
#ifndef MK_REPMASK
#define MK_REPMASK 0
#endif
#ifndef MK_EARLY_EXIT
#define MK_EARLY_EXIT 1
#endif
namespace pg8 {
#define PG8_LAS __attribute__((address_space(3)))
typedef unsigned short bf16_t;
typedef short bf16x8 __attribute__((ext_vector_type(8)));
typedef float f32x4 __attribute__((ext_vector_type(4)));
typedef unsigned u32x4 __attribute__((ext_vector_type(4)));
constexpr int BM = 256, BK = 64, HALF = 128, HTB = HALF * BK * 2  , STAGE_BYTES = 8 * HTB, NXCD = 8, WGM = 8;

__host__ __device__ __forceinline__ int lds_byte(int r, int c) { const int st = (r >> 4) * 2 + (c >> 5), rr = r & 15, cc = c & 31, ob = rr * 64 + cc * 2; return st * 1024 + (ob ^ (((ob >> 9) & 1) << 5)); }
__host__ __device__ __forceinline__ void stage_rc(int b, int& R, int& C) { const int st = b / 1024, sb = b % 1024, swz = sb ^ (((sb >> 9) & 1) << 5); R = (st >> 1) * 16 + swz / 64; C = (st & 1) * 32 + (swz % 64) / 2; }
__host__ __device__ __forceinline__ int perm32(int rho) { const int n = rho >> 4, i = rho & 15; return 8 * (i >> 2) + 4 * n + (i & 3); }

struct Unit { int pm, pn; };
struct Gemm { const bf16_t* A; const bf16_t* Bt; int M, N, K; };

struct StaticOrder {
    int nM, nN, nwg, G, c;
    __host__ __device__ void init(int M, int N, int G_, int c_) { nM = M / BM; nN = N / BM; nwg = nM * nN; G = G_; c = c_; }
    __host__ __device__ bool next(int i, Unit& u) const {
        const long L = (long)i * G + c; if (L >= nwg) return false;
        int wgid = (int)L; { const int q = nwg / NXCD, r = nwg % NXCD, xcd = wgid % NXCD, off = wgid / NXCD; wgid = (xcd < r ? xcd * (q + 1) : r * (q + 1) + (xcd - r) * q) + off; }
        const int nig = WGM * nN, gid = wgid / nig, fm = gid * WGM, gsz = (nM - fm) < WGM ? (nM - fm) : WGM;
        u.pm = fm + ((wgid % nig) % gsz); u.pn = (wgid % nig) / gsz; return true;
    }
    __device__ __forceinline__ void a_ready(const Unit&) const {}
    __device__ __forceinline__ void done(const Unit&) const {}
};

__device__ __forceinline__ unsigned cvt_pk_bf16(float lo, float hi) { unsigned r; asm volatile("v_cvt_pk_bf16_f32 %0, %1, %2" : "=v"(r) : "v"(lo), "v"(hi)); return r; }
typedef float f32x2 __attribute__((ext_vector_type(2)));

template <class Epi, class Sched, bool STAMP = false>
__device__ __forceinline__ void gemm_phase(PG8_LAS unsigned char* lds, const Gemm g, const Sched& S, const Epi& E, unsigned long long* stamps) {
    int tid_ = threadIdx.x; asm volatile("" : "+v"(tid_)); const int tid = tid_, wid = __builtin_amdgcn_readfirstlane(tid >> 6), lane = tid & 63, wr = wid >> 2, wc = wid & 3, fr = lane & 15, fq = lane >> 4;
    const int K = g.K, nt = K / BK;
    int ts_lo = 0, ts_hi = 0, nts = 0; const unsigned long long rt_entry = STAMP ? (unsigned long long)wall_clock64() : 0ull;
#define PG8_STAMP() do { if (STAMP && wid == 0 && nts < 64) { const unsigned long long _c = (unsigned long long)clock64(); \
        ts_lo = (lane == nts) ? (int)(unsigned)_c : ts_lo; ts_hi = (lane == nts) ? (int)(unsigned)(_c >> 32) : ts_hi; ++nts; } } while (0)
    PG8_STAMP();
    unsigned voffA[2], voffB[2];
#pragma unroll
    for (int i = 0; i < 2; ++i) { int R, C; stage_rc(tid * 16 + i * 8192, R, C); const int Rb = Epi::PERM ? ((R & ~31) + perm32(R & 31)) : R;
        voffA[i] = (unsigned)(R * K + C) * 2u; voffB[i] = (unsigned)(Rb * K + C) * 2u; }
    const size_t kstep = (size_t)(BK * 2);
    const size_t hstep = (size_t)HALF * K * 2;
    const size_t tstep = 2 * hstep;
    const unsigned ldsw = (unsigned)wid * 1024u;
    const int aoff = lds_byte(wr * 64 + fr, fq * 8), boff = lds_byte(wc * 32 + fr, fq * 8);
#define PG8_SA(b, h) (((b) * 2 + (h)) * HTB)
#define PG8_SB(b, h) ((4 + (b) * 2 + (h)) * HTB)
#define PG8_STAGE(bufoff, gbase, voff) do { _Pragma("unroll") for (int _i = 0; _i < 2; ++_i) \
        __builtin_amdgcn_global_load_lds((const unsigned*)((const char*)(gbase) + (voff)[_i]), (PG8_LAS unsigned*)(lds + (bufoff) + ldsw + _i * 8192), 16, 0, 0); } while (0)
#define PG8_LDA(dst, b, h) do { _Pragma("unroll") for (int m = 0; m < 4; ++m) _Pragma("unroll") for (int k = 0; k < 2; ++k) dst[m][k] = *(const PG8_LAS bf16x8*)(lds + PG8_SA(b, h) + aoff + m * 2048 + k * 1024); } while (0)
#define PG8_LDB(dst, b, h) do { _Pragma("unroll") for (int n = 0; n < 2; ++n) _Pragma("unroll") for (int k = 0; k < 2; ++k) dst[n][k] = *(const PG8_LAS bf16x8*)(lds + PG8_SB(b, h) + boff + n * 2048 + k * 1024); } while (0)
#define PG8_MMA(ai, bj, At, Bt) do { __builtin_amdgcn_s_setprio(1); _Pragma("unroll") for (int m = 0; m < 4; ++m) _Pragma("unroll") for (int n = 0; n < 2; ++n) _Pragma("unroll") for (int k = 0; k < 2; ++k) \
        acc[ai][bj][m][n] = __builtin_amdgcn_mfma_f32_16x16x32_bf16(Bt[n][k], At[m][k], acc[ai][bj][m][n], 0, 0, 0); __builtin_amdgcn_s_setprio(0); } while (0)
#define PG8_WAIT_V(n) asm volatile("s_waitcnt vmcnt(" #n ")" ::: "memory")
#define PG8_WAIT_L(n) asm volatile("s_waitcnt lgkmcnt(" #n ")" ::: "memory")
#define PG8_BAR __builtin_amdgcn_s_barrier()
#define PG8_SCHED __builtin_amdgcn_sched_barrier(0)
    Unit cur, nxt; int ui = 0;
    if (!S.next(0, cur)) return;
    f32x4 acc[2][2][4][2];
#pragma unroll
    for (int a = 0; a < 2; ++a)
#pragma unroll
        for (int b = 0; b < 2; ++b)
#pragma unroll
            for (int m = 0; m < 4; ++m)
#pragma unroll
                for (int n = 0; n < 2; ++n) acc[a][b][m][n] = (f32x4){0.f, 0.f, 0.f, 0.f};
    bf16x8 At[4][2], B0[2][2], B1[2][2];
    const char* cA = (const char*)g.A + (size_t)cur.pm * tstep; const char* cB = (const char*)g.Bt + (size_t)cur.pn * tstep;
    S.a_ready(cur);
    PG8_STAGE(PG8_SB(0, 0), cB, voffB); PG8_STAGE(PG8_SA(0, 0), cA, voffA); PG8_STAGE(PG8_SB(0, 1), cB + hstep, voffB); PG8_STAGE(PG8_SA(0, 1), cA + hstep, voffA);
    if (wr == 1) PG8_BAR;
    PG8_WAIT_V(4); PG8_BAR;
    PG8_STAGE(PG8_SB(1, 0), cB + kstep, voffB); PG8_STAGE(PG8_SA(1, 0), cA + kstep, voffA); PG8_STAGE(PG8_SB(1, 1), cB + hstep + kstep, voffB);
    PG8_WAIT_V(6); PG8_BAR;
    PG8_STAMP();
    for (;;) {
        const bool has_next = S.next(ui + 1, nxt);
        const char* nA = has_next ? (const char*)g.A + (size_t)nxt.pm * tstep : cA; const char* nB = has_next ? (const char*)g.Bt + (size_t)nxt.pn * tstep : cB;
        for (int t = 0; t < nt; t += 2) {
            const bool last = (t == nt - 2);
            const char* a1 = cA + (size_t)(t + 1) * kstep;
            const char* a2 = last ? nA : cA + (size_t)(t + 2) * kstep; const char* b2 = last ? nB : cB + (size_t)(t + 2) * kstep;
            const char* a3 = a2 + kstep; const char* b3 = b2 + kstep;
            if (last && has_next) S.a_ready(nxt);
            PG8_LDB(B0, 0, 0); PG8_SCHED; PG8_LDA(At, 0, 0); PG8_STAGE(PG8_SA(1, 1), a1 + hstep, voffA);
            PG8_WAIT_L(8); PG8_BAR; PG8_WAIT_L(0); PG8_MMA(0, 0, At, B0); PG8_BAR; PG8_SCHED;
            PG8_LDB(B1, 0, 1); PG8_STAGE(PG8_SB(0, 0), b2, voffB);
            PG8_BAR; PG8_WAIT_L(0); PG8_MMA(0, 1, At, B1); PG8_BAR;
            PG8_LDA(At, 0, 1); PG8_STAGE(PG8_SA(0, 0), a2, voffA);
            PG8_BAR; PG8_WAIT_L(0); PG8_MMA(1, 0, At, B0); PG8_BAR; PG8_SCHED;
            PG8_STAGE(PG8_SB(0, 1), b2 + hstep, voffB);
            PG8_WAIT_V(6); PG8_BAR; PG8_MMA(1, 1, At, B1); PG8_BAR;
            PG8_LDB(B0, 1, 0); PG8_SCHED; PG8_LDA(At, 1, 0); PG8_STAGE(PG8_SA(0, 1), a2 + hstep, voffA);
            PG8_WAIT_L(8); PG8_BAR; PG8_WAIT_L(0); PG8_MMA(0, 0, At, B0); PG8_BAR; PG8_SCHED;
            PG8_LDB(B1, 1, 1); PG8_STAGE(PG8_SB(1, 0), b3, voffB);
            PG8_BAR; PG8_WAIT_L(0); PG8_MMA(0, 1, At, B1); PG8_BAR;
            PG8_LDA(At, 1, 1); PG8_STAGE(PG8_SA(1, 0), a3, voffA);
            PG8_BAR; PG8_WAIT_L(0); PG8_MMA(1, 0, At, B0); PG8_BAR; PG8_SCHED;
            PG8_STAGE(PG8_SB(1, 1), b3 + hstep, voffB);
            PG8_WAIT_V(6); PG8_BAR; PG8_MMA(1, 1, At, B1); PG8_BAR;
        }
        PG8_STAMP();
        if constexpr (!Epi::AFTER_DRAIN) { E(acc, cur, wr, wc, fr, fq); S.done(cur); }
        PG8_STAMP();
        if (!has_next) break;
#pragma unroll
        for (int a = 0; a < 2; ++a)
#pragma unroll
            for (int b = 0; b < 2; ++b)
#pragma unroll
                for (int m = 0; m < 4; ++m)
#pragma unroll
                    for (int n = 0; n < 2; ++n) acc[a][b][m][n] = (f32x4){0.f, 0.f, 0.f, 0.f};
        cur = nxt; cA = nA; cB = nB; ++ui;
    }
    PG8_WAIT_V(0);
    if (wr == 0) PG8_BAR;
    PG8_BAR;
    if constexpr (Epi::AFTER_DRAIN) { E.fused(acc, cur, wr, wc, fr, fq, lds, wid, lane); S.done(cur); }
    PG8_STAMP();
    if (STAMP && wid == 0) { stamps[lane] = lane < nts ? (((unsigned long long)(unsigned)ts_hi << 32) | (unsigned)ts_lo) : 0ull;
        if (lane == 62) stamps[62] = rt_entry; if (lane == 63) stamps[63] = (unsigned long long)wall_clock64(); }
#undef PG8_STAMP
#undef PG8_SA
#undef PG8_SB
#undef PG8_STAGE
#undef PG8_LDA
#undef PG8_LDB
#undef PG8_MMA
#undef PG8_WAIT_V
#undef PG8_WAIT_L
#undef PG8_BAR
#undef PG8_SCHED
}
}
namespace mk {
using pg8::bf16_t; using pg8::bf16x8; using pg8::f32x4; using pg8::u32x4; using pg8::cvt_pk_bf16;
typedef float f32x16 __attribute__((ext_vector_type(16)));
typedef float f32x2 __attribute__((ext_vector_type(2)));
typedef unsigned u32x2 __attribute__((ext_vector_type(2)));
constexpr int D = 1024, NB = 32, SEQ = 2048, M = NB * SEQ, NH = 8, DH = 64;
constexpr int RWC = 1792, GC = 2048, INC = 5376, DFF = 2816;
constexpr float RMS_EPS = 1e-6f, GN_EPS = 64e-5f;
constexpr size_t MiB = (size_t)1 << 20;
constexpr size_t O_WIN = 0, O_WSB = 11 * MiB, O_WRW = 12 * MiB, O_WO = 13 * MiB, O_WGU = 15 * MiB, O_WDN = 26 * MiB, O_WLU = 32 * MiB  , O_WLA = O_WLU + 65536, O_WLG = O_WLA + 65536;
constexpr size_t O_Q = 34 * MiB, O_K = 98 * MiB, O_VT = 162 * MiB, O_PRW = 226 * MiB, O_H = 450 * MiB, O_SI = 450 * MiB, O_G = 834 * MiB, O_SC = 898 * MiB, O_YR = 290 * MiB  ;
constexpr size_t O_OSB = 226 * MiB, O_ORW = 34 * MiB, O_T1 = 98 * MiB, O_MRG = 450 * MiB, O_TT = 34 * MiB, O_H2 = 162 * MiB, O_HID = 290 * MiB, O_FF = 34 * MiB;
constexpr size_t WS_NEED = 906 * MiB;
constexpr int LDS_BYTES = pg8::STAGE_BYTES;
constexpr int NPH = 12;

struct Args { const float* in[24]; float* out; unsigned char* ws; int ph_lo, ph_hi; };

__device__ __forceinline__ int my_tid() { int t = threadIdx.x; asm volatile("" : "+v"(t)); return t; }
__device__ __forceinline__ float bf_lo(unsigned u) { return __uint_as_float(u << 16); }
__device__ __forceinline__ float bf_hi(unsigned u) { return __uint_as_float(u & 0xffff0000u); }
__device__ __forceinline__ float fexp(float x) { return __builtin_amdgcn_exp2f(x * 1.44269504089f); }
__device__ __forceinline__ float flog(float x) { return __builtin_amdgcn_logf(x) * 0.69314718056f; }
__device__ __forceinline__ float frcp(float x) { return __builtin_amdgcn_rcpf(x); }
__device__ __forceinline__ float fsigmoid(float x) { return frcp(1.f + fexp(-x)); }
__device__ __forceinline__ unsigned short bf1(float x) { return (unsigned short)(cvt_pk_bf16(x, x) & 0xffffu); }
__device__ __forceinline__ u32x4 pack8(const f32x4 a, const f32x4 b) { u32x4 o; o.x = cvt_pk_bf16(a[0], a[1]); o.y = cvt_pk_bf16(a[2], a[3]); o.z = cvt_pk_bf16(b[0], b[1]); o.w = cvt_pk_bf16(b[2], b[3]); return o; }
__device__ __forceinline__ float red16(float v) {
    v += __shfl_xor(v, 16); v += __shfl_xor(v, 32); return v;
}
__device__ __forceinline__ float wave_sum(float v) {
#pragma unroll
    for (int o = 1; o < 64; o <<= 1) v += __shfl_xor(v, o);
    return v;
}

__device__ __forceinline__ void tr_item(const float* __restrict__ W, int K, int N, bf16_t* WT, float* scr, int item, int lane, int mode) {
    const int nblk = N >> 5, kb = item / nblk, nb = item - kb * nblk, k0 = kb << 6, n0 = nb << 5;
#pragma unroll 8
    for (int i = 0; i < 32; ++i) { const int kk = 2 * i + (lane >> 5); scr[kk * 33 + (lane & 31)] = W[(size_t)(k0 + kk) * N + n0 + (lane & 31)]; }
    asm volatile("s_waitcnt lgkmcnt(0)" ::: "memory"); __builtin_amdgcn_wave_barrier();
    const int c = lane & 7;
#pragma unroll
    for (int j = 0; j < 4; ++j) {
        const int n = (lane >> 3) + 8 * j; const float* s = scr + (8 * c) * 33 + n;
        u32x4 o; o.x = cvt_pk_bf16(s[0 * 33], s[1 * 33]); o.y = cvt_pk_bf16(s[2 * 33], s[3 * 33]); o.z = cvt_pk_bf16(s[4 * 33], s[5 * 33]); o.w = cvt_pk_bf16(s[6 * 33], s[7 * 33]);
        const int nn = n0 + n; int drow = nn;
        if (mode == 1) drow = ((nn >> 7) << 8) + (nn & 127); else if (mode == 2) drow = ((nn >> 7) << 8) + 128 + (nn & 127);
        *(u32x4*)(WT + (size_t)drow * K + k0 + 8 * c) = o;
    }
    asm volatile("s_waitcnt lgkmcnt(0)" ::: "memory"); __builtin_amdgcn_wave_barrier();
}

__device__ __forceinline__ void phase_prep(const Args& a, float* lds_f, int G) {
    const int tid = my_tid(); const int wave = tid >> 6, lane = tid & 63;
    const int gw = blockIdx.x * 8 + wave, NGW = G * 8;
    float* scr = lds_f + wave * (64 * 33 + 16);
    unsigned char* ws = a.ws;
    constexpr int I_IN = 16 * 168, I_SB = 8 * 32, I_O = 16 * 32, I_G = 16 * 88, I_DN = 44 * 32, I_LU = 16, I_LG = 32;
    constexpr int NIT = I_IN + 2 * I_SB + I_O + 2 * I_G + I_DN + 2 * I_LU + I_LG;
    for (int it = gw; it < NIT; it += NGW) {
        int r = it;
        if (r < I_IN) { tr_item(a.in[2], 1024, INC, (bf16_t*)(ws + O_WIN), scr, r, lane, 0); continue; } r -= I_IN;
        if (r < I_SB) { tr_item(a.in[15], 512, 1024, (bf16_t*)(ws + O_WSB), scr, r, lane, 0); continue; } r -= I_SB;
        if (r < I_SB) { tr_item(a.in[16], 512, 1024, (bf16_t*)(ws + O_WRW), scr, r, lane, 0); continue; } r -= I_SB;
        if (r < I_O) { tr_item(a.in[17], 1024, 1024, (bf16_t*)(ws + O_WO), scr, r, lane, 0); continue; } r -= I_O;
        if (r < I_G) { tr_item(a.in[20], 1024, DFF, (bf16_t*)(ws + O_WGU), scr, r, lane, 1); continue; } r -= I_G;
        if (r < I_G) { tr_item(a.in[21], 1024, DFF, (bf16_t*)(ws + O_WGU), scr, r, lane, 2); continue; } r -= I_G;
        if (r < I_DN) { tr_item(a.in[22], DFF, 1024, (bf16_t*)(ws + O_WDN), scr, r, lane, 0); continue; } r -= I_DN;
        if (r < I_LU) { tr_item(a.in[6], 64, 512, (bf16_t*)(ws + O_WLU), scr, r, lane, 0); continue; } r -= I_LU;
        if (r < I_LU) { tr_item(a.in[8], 64, 512, (bf16_t*)(ws + O_WLA), scr, r, lane, 0); continue; } r -= I_LU;
        tr_item(a.in[9], 128, 512, (bf16_t*)(ws + O_WLG), scr, r, lane, 0);
    }
    const float* x = a.in[0]; const float* g = a.in[1]; bf16_t* H = (bf16_t*)(ws + O_H);
    f32x4 gv[4];
#pragma unroll
    for (int j = 0; j < 4; ++j) gv[j] = ((const f32x4*)g)[lane + 64 * j];
    for (int row0 = gw; row0 < M; row0 += 2 * NGW) {
        f32x4 v[2][4];
#pragma unroll
        for (int u = 0; u < 2; ++u) { const int row = (row0 + u * NGW < M) ? row0 + u * NGW : row0; const f32x4* xr = (const f32x4*)(x + (size_t)row * D) + lane;
#pragma unroll
            for (int j = 0; j < 4; ++j) v[u][j] = xr[64 * j]; }
#pragma unroll
        for (int u = 0; u < 2; ++u) { const int row = row0 + u * NGW; float s = 0.f;
#pragma unroll
            for (int j = 0; j < 4; ++j) s += (v[u][j][0] * v[u][j][0] + v[u][j][1] * v[u][j][1]) + (v[u][j][2] * v[u][j][2] + v[u][j][3] * v[u][j][3]);
            const float rs = rsqrtf(wave_sum(s) * (1.f / D) + RMS_EPS);
            if (row < M) { u32x2* o = (u32x2*)(H + (size_t)row * D) + lane;
#pragma unroll
                for (int j = 0; j < 4; ++j) { u32x2 w; w.x = cvt_pk_bf16(v[u][j][0] * rs * gv[j][0], v[u][j][1] * rs * gv[j][1]); w.y = cvt_pk_bf16(v[u][j][2] * rs * gv[j][2], v[u][j][3] * rs * gv[j][3]); o[64 * j] = w; } }
        }
    }
}

struct Epi1 {
    static constexpr bool PERM = true, AFTER_DRAIN = false;
    bf16_t *Q, *Kb, *Vt, *Prw, *Gt; const float* bgate;
    __device__ __forceinline__ void operator()(const f32x4 (&acc)[2][2][4][2], const pg8::Unit& u, int wr, int wc, int fr, int fq) const {
        const int row0 = u.pm * 256 + wr * 64 + fr, pn = u.pn, cl = wc * 32 + 8 * fq;
        if (pn < 4) {
            bf16_t* dst = pn < 2 ? Q : Kb; const float sc = pn < 2 ? 0.125f : 1.f; const int cb = (pn & 1) * 256 + cl;
#pragma unroll
            for (int ai = 0; ai < 2; ++ai)
#pragma unroll
                for (int m = 0; m < 4; ++m) { bf16_t* rp = dst + (size_t)(row0 + ai * 128 + m * 16) * 512 + cb;
#pragma unroll
                    for (int bj = 0; bj < 2; ++bj) *(u32x4*)(rp + bj * 128) = pack8(acc[ai][bj][m][0] * sc, acc[ai][bj][m][1] * sc); }
        } else if (pn < 6) {
#pragma unroll
            for (int ai = 0; ai < 2; ++ai)
#pragma unroll
                for (int m = 0; m < 4; ++m) { const int row = row0 + ai * 128 + m * 16, b = row >> 11, s = row & 2047;
#pragma unroll
                    for (int bj = 0; bj < 2; ++bj)
#pragma unroll
                        for (int n = 0; n < 2; ++n)
#pragma unroll
                            for (int j = 0; j < 4; ++j) { const int c = (pn - 4) * 256 + bj * 128 + cl + 4 * n + j;
                                Vt[((size_t)(b * 512 + c)) * 2048 + s] = bf1(acc[ai][bj][m][n][j]); } }
        } else if (pn < 13) {
            const int cb = (pn - 6) * 256 + cl;
#pragma unroll
            for (int ai = 0; ai < 2; ++ai)
#pragma unroll
                for (int m = 0; m < 4; ++m) { bf16_t* rp = Prw + (size_t)(row0 + ai * 128 + m * 16) * RWC + cb;
#pragma unroll
                    for (int bj = 0; bj < 2; ++bj) *(u32x4*)(rp + bj * 128) = pack8(acc[ai][bj][m][0], acc[ai][bj][m][1]); }
        } else {
            const int cb = (pn - 13) * 256 + cl;
#pragma unroll
            for (int ai = 0; ai < 2; ++ai)
#pragma unroll
                for (int m = 0; m < 4; ++m) { bf16_t* rp = Gt + (size_t)(row0 + ai * 128 + m * 16) * GC + cb;
#pragma unroll
                    for (int bj = 0; bj < 2; ++bj) { f32x4 v0 = acc[ai][bj][m][0] + *(const f32x4*)(bgate + cb + bj * 128), v1 = acc[ai][bj][m][1] + *(const f32x4*)(bgate + cb + bj * 128 + 4);
#pragma unroll
                        for (int j = 0; j < 4; ++j) { v0[j] = fsigmoid(v0[j]); v1[j] = fsigmoid(v1[j]); }
                        *(u32x4*)(rp + bj * 128) = pack8(v0, v1); } }
        }
    }
};
template <int MODE> struct EpiRow {
    static constexpr bool PERM = true, AFTER_DRAIN = false;
    bf16_t* O; const bf16_t* T1; const bf16_t* Gt;
    __device__ __forceinline__ void operator()(const f32x4 (&acc)[2][2][4][2], const pg8::Unit& u, int wr, int wc, int fr, int fq) const {
        const int row0 = u.pm * 256 + wr * 64 + fr, cb = u.pn * 256 + wc * 32 + 8 * fq;
#pragma unroll
        for (int ai = 0; ai < 2; ++ai)
#pragma unroll
            for (int m = 0; m < 4; ++m) { const size_t row = (size_t)(row0 + ai * 128 + m * 16);
#pragma unroll
                for (int bj = 0; bj < 2; ++bj) { f32x4 v0 = acc[ai][bj][m][0], v1 = acc[ai][bj][m][1]; const int c = cb + bj * 128;
                    if (MODE >= 1) { const u32x4 gg = *(const u32x4*)(Gt + row * GC + (MODE == 2 ? 1024 : 0) + c);
                        v0[0] *= bf_lo(gg.x); v0[1] *= bf_hi(gg.x); v0[2] *= bf_lo(gg.y); v0[3] *= bf_hi(gg.y); v1[0] *= bf_lo(gg.z); v1[1] *= bf_hi(gg.z); v1[2] *= bf_lo(gg.w); v1[3] *= bf_hi(gg.w); }
                    if (MODE == 2) { const u32x4 tt = *(const u32x4*)(T1 + row * 1024 + c);
                        v0[0] += bf_lo(tt.x); v0[1] += bf_hi(tt.x); v0[2] += bf_lo(tt.y); v0[3] += bf_hi(tt.y); v1[0] += bf_lo(tt.z); v1[1] += bf_hi(tt.z); v1[2] += bf_lo(tt.w); v1[3] += bf_hi(tt.w); }
                    *(u32x4*)(O + row * 1024 + c) = pack8(v0, v1); } }
    }
};
struct EpiSwiGLU {
    static constexpr bool PERM = true, AFTER_DRAIN = false;
    bf16_t* Hd;
    __device__ __forceinline__ void operator()(const f32x4 (&acc)[2][2][4][2], const pg8::Unit& u, int wr, int wc, int fr, int fq) const {
        const int row0 = u.pm * 256 + wr * 64 + fr, cb = u.pn * 128 + wc * 32 + 8 * fq;
#pragma unroll
        for (int ai = 0; ai < 2; ++ai)
#pragma unroll
            for (int m = 0; m < 4; ++m) { f32x4 v0, v1;
#pragma unroll
                for (int j = 0; j < 4; ++j) { const float g0 = acc[ai][0][m][0][j], g1 = acc[ai][0][m][1][j];
                    v0[j] = g0 * fsigmoid(g0) * acc[ai][1][m][0][j]; v1[j] = g1 * fsigmoid(g1) * acc[ai][1][m][1][j]; }
                *(u32x4*)(Hd + (size_t)(row0 + ai * 128 + m * 16) * DFF + cb) = pack8(v0, v1); }
    }
};
template <class Epi> __device__ __forceinline__ void run_gemm(PG8_LAS unsigned char* lds, const bf16_t* A, const bf16_t* Bt, int N, int K, const Epi& E, int G) {
    pg8::Gemm g; g.A = A; g.Bt = Bt; g.M = M; g.N = N; g.K = K;
    pg8::StaticOrder S; S.init(M, N, G, (int)blockIdx.x);
    pg8::gemm_phase<Epi, pg8::StaticOrder, false>(lds, g, S, E, nullptr);
}
__device__ __forceinline__ void load_mix8(const bf16_t* cur, bool hasprev, const float* mu, float (&o)[8]) {
    const u32x4 c = *(const u32x4*)cur; u32x4 p = {0u, 0u, 0u, 0u};
    if (hasprev) p = *(const u32x4*)(cur - RWC);
    const f32x4 m0 = *(const f32x4*)mu, m1 = *(const f32x4*)(mu + 4);
    const float mm[8] = {m0[0], m0[1], m0[2], m0[3], m1[0], m1[1], m1[2], m1[3]};
#pragma unroll
    for (int i = 0; i < 4; ++i) { const float cl = bf_lo(c[i]), ch = bf_hi(c[i]), pl = bf_lo(p[i]), ph = bf_hi(p[i]);
        o[2 * i] = cl + (pl - cl) * mm[2 * i]; o[2 * i + 1] = ch + (ph - ch) * mm[2 * i + 1]; }
}
__device__ __forceinline__ void load_mix4(const bf16_t* cur, bool hasprev, const float* mu, float (&o)[4]) {
    const u32x2 c = *(const u32x2*)cur; u32x2 p = {0u, 0u};
    if (hasprev) p = *(const u32x2*)(cur - RWC);
    const f32x4 m0 = *(const f32x4*)mu;
#pragma unroll
    for (int i = 0; i < 2; ++i) { const float cl = bf_lo(c[i]), ch = bf_hi(c[i]), pl = bf_lo(p[i]), ph = bf_hi(p[i]);
        o[2 * i] = cl + (pl - cl) * m0[2 * i]; o[2 * i + 1] = ch + (ph - ch) * m0[2 * i + 1]; }
}
__device__ __forceinline__ bf16x8 pack_frag(const float (&v)[8]) {
    u32x4 o; o.x = cvt_pk_bf16(v[0], v[1]); o.y = cvt_pk_bf16(v[2], v[3]); o.z = cvt_pk_bf16(v[4], v[5]); o.w = cvt_pk_bf16(v[6], v[7]);
    return __builtin_bit_cast(bf16x8, o);
}
__device__ __forceinline__ void phase_rwprep(const Args& a, int G) {
    const int tid = my_tid(); const int wave = tid >> 6, lane = tid & 63, fr = lane & 15, fq = lane >> 4;
    const int gw = blockIdx.x * 8 + wave, NGW = G * 8;
    unsigned char* ws = a.ws;
    const bf16_t* PRW = (const bf16_t*)(ws + O_PRW);
    const bf16_t* WLU = (const bf16_t*)(ws + O_WLU); const bf16_t* WLA = (const bf16_t*)(ws + O_WLA); const bf16_t* WLG = (const bf16_t*)(ws + O_WLG);
    unsigned char* SI = ws + O_SI; bf16_t* GB = (bf16_t*)(ws + O_G); float* SC = (float*)(ws + O_SC);
    const float *mu = a.in[4], *w0 = a.in[5], *a0 = a.in[7], *k_k = a.in[10], *k_a = a.in[11], *r_k = a.in[12];
    for (int item = gw; item < M / 16; item += NGW) {
        const int m = item * 16 + fr; const bool hp = (m & (SEQ - 1)) != 0;
        const bf16_t* prow = PRW + (size_t)m * RWC;
        bf16x8 Aw[2], Aa[2], Ag[4];
        float t8[8];
#pragma unroll
        for (int s = 0; s < 2; ++s) { load_mix8(prow + 1536 + 32 * s + 8 * fq, hp, mu + 1536 + 32 * s + 8 * fq, t8);
#pragma unroll
            for (int i = 0; i < 8; ++i) { const float e = fexp(2.f * t8[i]); t8[i] = 1.f - 2.f * frcp(e + 1.f); }
            Aw[s] = pack_frag(t8); }
#pragma unroll
        for (int s = 0; s < 2; ++s) { load_mix8(prow + 1600 + 32 * s + 8 * fq, hp, mu + 1600 + 32 * s + 8 * fq, t8); Aa[s] = pack_frag(t8); }
#pragma unroll
        for (int s = 0; s < 4; ++s) { load_mix8(prow + 1664 + 32 * s + 8 * fq, hp, mu + 1664 + 32 * s + 8 * fq, t8);
#pragma unroll
            for (int i = 0; i < 8; ++i) t8[i] = fsigmoid(t8[i]);
            Ag[s] = pack_frag(t8); }
#pragma unroll 1
        for (int h = 0; h < NH; ++h) {
            float kkr[16], av[16]; unsigned lk[16], rvp[16];
            float ss = 0.f, brs = 0.f, krs = 0.f, rkbs = 0.f;
#pragma unroll
            for (int n = 0; n < 4; ++n) {
                const int cb = 64 * h + 16 * n, c0 = cb + 4 * fq;
                f32x4 aw = {0.f, 0.f, 0.f, 0.f}, aa = aw, ag = aw;
#pragma unroll
                for (int s = 0; s < 2; ++s) {
                    aw = __builtin_amdgcn_mfma_f32_16x16x32_bf16(*(const bf16x8*)(WLU + (size_t)(cb + fr) * 64 + 32 * s + 8 * fq), Aw[s], aw, 0, 0, 0);
                    aa = __builtin_amdgcn_mfma_f32_16x16x32_bf16(*(const bf16x8*)(WLA + (size_t)(cb + fr) * 64 + 32 * s + 8 * fq), Aa[s], aa, 0, 0, 0); }
#pragma unroll
                for (int s = 0; s < 4; ++s)
                    ag = __builtin_amdgcn_mfma_f32_16x16x32_bf16(*(const bf16x8*)(WLG + (size_t)(cb + fr) * 128 + 32 * s + 8 * fq), Ag[s], ag, 0, 0, 0);
                float rr[4], kr4[4], vv[4];
                load_mix4(prow + c0, hp, mu + c0, rr); load_mix4(prow + 512 + c0, hp, mu + 512 + c0, kr4); load_mix4(prow + 1024 + c0, hp, mu + 1024 + c0, vv);
                const f32x4 w0v = *(const f32x4*)(w0 + c0), a0v = *(const f32x4*)(a0 + c0), kkv = *(const f32x4*)(k_k + c0), kav = *(const f32x4*)(k_a + c0), rkv = *(const f32x4*)(r_k + c0);
#pragma unroll
                for (int j = 0; j < 4; ++j) {
                    const float sg = fsigmoid(w0v[j] + aw[j]);
                    const float ldx = -0.60653065971f * 1.44269504089f * sg;
                    const float av_ = fsigmoid(a0v[j] + aa[j]);
                    const float kkraw = kr4[j] * kkv[j];
                    const float k2 = kr4[j] * (1.f + (av_ - 1.f) * kav[j]);
                    ss += kkraw * kkraw; brs += kkraw * av_ * rr[j]; krs += k2 * rr[j]; rkbs += rr[j] * k2 * rkv[j];
                    kkr[4 * n + j] = kkraw; av[4 * n + j] = av_; lk[4 * n + j] = cvt_pk_bf16(ldx, k2); rvp[4 * n + j] = cvt_pk_bf16(rr[j], vv[j]);
                }
                u32x2 gp; gp.x = cvt_pk_bf16(ag[0], ag[1]); gp.y = cvt_pk_bf16(ag[2], ag[3]);
                *(u32x2*)(GB + (size_t)m * 512 + c0) = gp;
            }
            ss = red16(ss); brs = red16(brs); krs = red16(krs); rkbs = red16(rkbs);
            const float inv = 1.f / fmaxf(sqrtf(ss), 1e-12f);
            unsigned char* rec = SI + (((size_t)m * 8 + h) * 64) * 12;
#pragma unroll
            for (int n = 0; n < 4; ++n) {
                unsigned dw[12];
#pragma unroll
                for (int j = 0; j < 4; ++j) { const float kk = kkr[4 * n + j] * inv;
                    const unsigned kp = cvt_pk_bf16(kk * av[4 * n + j], -kk);
                    dw[3 * j] = (lk[4 * n + j] & 0xffffu) | (kp & 0xffff0000u); dw[3 * j + 1] = (kp & 0xffffu) | (lk[4 * n + j] & 0xffff0000u); dw[3 * j + 2] = rvp[4 * n + j]; }
                u32x4* dst = (u32x4*)(rec + (16 * n + 4 * fq) * 12);
                u32x4 s0 = {dw[0], dw[1], dw[2], dw[3]}, s1 = {dw[4], dw[5], dw[6], dw[7]}, s2 = {dw[8], dw[9], dw[10], dw[11]};
                dst[0] = s0; dst[1] = s1; dst[2] = s2;
            }
            if (fq == 0) { f32x4 sc = {brs * inv, krs, rkbs, 0.f}; *(f32x4*)(SC + ((size_t)m * 8 + h) * 4) = sc; }
        }
    }
}

#define MK_FMAC_BC(acc, src, s, n) asm("v_fmac_f32_dpp %0, %1, %2 row_newbcast:" #n " row_mask:0xf bank_mask:0xf" : "+v"(acc) : "v"(src), "v"(s))
#define MK_MUL_BC(dst, src, s, n) asm("v_mul_f32_dpp %0, %1, %2 row_newbcast:" #n " row_mask:0xf bank_mask:0xf" : "=v"(dst) : "v"(src), "v"(s))
#define MK_REP16(X) X(0) X(1) X(2) X(3) X(4) X(5) X(6) X(7) X(8) X(9) X(10) X(11) X(12) X(13) X(14) X(15)
__device__ __forceinline__ float red_rows(float x) {
    float a0 = x, a1 = x;
    asm volatile("s_nop 1\n\tv_permlane16_swap_b32 %0, %1" : "+v"(a0), "+v"(a1));
    float b0 = a0 + a1, b1 = b0;
    asm volatile("s_nop 1\n\tv_permlane32_swap_b32 %0, %1" : "+v"(b0), "+v"(b1));
    return b0 + b1;
}
struct ScanRec { unsigned d0, d1, d2; unsigned short vv; float br, kr; };
__device__ __forceinline__ void scan_load(ScanRec& R, const unsigned char* SI, const float* SC, size_t mh, int lane, int vrow) {
    const unsigned* p = (const unsigned*)(SI + (mh * 64 + lane) * 12);
    R.d0 = p[0]; R.d1 = p[1]; R.d2 = p[2];
    R.vv = *(const unsigned short*)(SI + (mh * 64 + vrow) * 12 + 10);
    const f32x2 s = *(const f32x2*)(SC + mh * 4); R.br = s[0]; R.kr = s[1];
}
__device__ __forceinline__ void scan_wave(const Args& a, int bh, int rb, int lane) {
    const unsigned char* SI = a.ws + O_SI; const float* SC = (const float*)(a.ws + O_SC); unsigned* YR = (unsigned*)(a.ws + O_YR);
    const int b = bh >> 3, h = bh & 7, r = lane & 15, vrow = 16 * rb + r;
    const size_t m0 = (size_t)b * SEQ;
    float S0 = 0.f, S1 = 0.f, S2 = 0.f, S3 = 0.f, S4 = 0.f, S5 = 0.f, S6 = 0.f, S7 = 0.f, S8 = 0.f, S9 = 0.f, S10 = 0.f, S11 = 0.f, S12 = 0.f, S13 = 0.f, S14 = 0.f, S15 = 0.f;
    ScanRec cur[8], nxt[8];
#pragma unroll
    for (int i = 0; i < 8; ++i) scan_load(cur[i], SI, SC, (m0 + i) * 8 + h, lane, vrow);
    for (int t0 = 0; t0 < SEQ; t0 += 8) {
        const int tn = (t0 + 8 < SEQ) ? t0 + 8 : t0;
#pragma unroll
        for (int i = 0; i < 8; ++i) scan_load(nxt[i], SI, SC, (m0 + tn + i) * 8 + h, lane, vrow);
#pragma unroll
        for (int i = 0; i < 8; ++i) {
            float nkk = bf_hi(cur[i].d0), kka = bf_lo(cur[i].d1), k2 = bf_hi(cur[i].d1);
            float w = __builtin_amdgcn_exp2f(bf_lo(cur[i].d0));
            float wr = w * bf_lo(cur[i].d2);
            const float v = __uint_as_float((unsigned)cur[i].vv << 16);
            asm volatile("s_nop 1" : "+v"(nkk), "+v"(kka), "+v"(k2), "+v"(w), "+v"(wr));
            float sa0 = 0.f, sa1 = 0.f, yp0 = 0.f, yp1 = 0.f;
#define MK_MV(n) if ((n) & 1) { MK_FMAC_BC(sa1, nkk, S##n, n); MK_FMAC_BC(yp1, wr, S##n, n); } else { MK_FMAC_BC(sa0, nkk, S##n, n); MK_FMAC_BC(yp0, wr, S##n, n); }
            MK_REP16(MK_MV)
#undef MK_MV
            const float sa = red_rows(sa0 + sa1), yp = red_rows(yp0 + yp1);
            float sav = sa, vv2 = v;
#define MK_UP(n) { MK_MUL_BC(S##n, w, S##n, n); MK_FMAC_BC(S##n, kka, sav, n); MK_FMAC_BC(S##n, k2, vv2, n); }
            MK_REP16(MK_UP)
#undef MK_UP
            const float y = yp + sa * cur[i].br + v * cur[i].kr;
            if (lane < 16) YR[(m0 + t0 + i) * 512 + 64 * h + vrow] = (unsigned)bf1(y) | ((unsigned)cur[i].vv << 16);
        }
#pragma unroll
        for (int i = 0; i < 8; ++i) cur[i] = nxt[i];
    }
}

struct KV { bf16x8 k[4]; bf16x8 v[2][2]; };
__device__ __forceinline__ void attn_load(KV& T, const bf16_t* Kh, const bf16_t* Vh, int k0, int n, int hf) {
    const bf16_t* kp = Kh + (size_t)(k0 + n) * 512 + 8 * hf;
#pragma unroll
    for (int s = 0; s < 4; ++s) T.k[s] = *(const bf16x8*)(kp + 16 * s);
#pragma unroll
    for (int d = 0; d < 2; ++d)
#pragma unroll
        for (int sg = 0; sg < 2; ++sg) { const bf16_t* vp = Vh + (size_t)(32 * d + n) * SEQ + k0 + 16 * sg + 4 * hf;
            const u32x2 lo = *(const u32x2*)vp, hi = *(const u32x2*)(vp + 8); u32x4 t = {lo.x, lo.y, hi.x, hi.y}; T.v[d][sg] = __builtin_bit_cast(bf16x8, t); }
}
__device__ __forceinline__ void attn_wave(const Args& a, int bh, int w4, int lane) {
    const int b = bh >> 3, h = bh & 7, n = lane & 31, hf = lane >> 5;
    const size_t m0 = (size_t)b * SEQ;
    const bf16_t* Qh = (const bf16_t*)(a.ws + O_Q) + m0 * 512 + 64 * h;
    const bf16_t* Kh = (const bf16_t*)(a.ws + O_K) + m0 * 512 + 64 * h;
    const bf16_t* Vh = (const bf16_t*)(a.ws + O_VT) + (size_t)bh * 64 * SEQ;
    bf16_t* Oh = (bf16_t*)(a.ws + O_OSB) + m0 * 512 + 64 * h;
    for (int qt = 63 - w4; qt >= 0; qt -= 4) {
        const int q0 = 32 * qt;
        bf16x8 qf[4];
#pragma unroll
        for (int s = 0; s < 4; ++s) qf[s] = *(const bf16x8*)(Qh + (size_t)(q0 + n) * 512 + 16 * s + 8 * hf);
        f32x16 o0, o1;
#pragma unroll
        for (int i = 0; i < 16; ++i) { o0[i] = 0.f; o1[i] = 0.f; }
        float carry = 0.f;
        KV cur, nxt;
        attn_load(cur, Kh, Vh, q0, n, hf);
        for (int kt = qt; kt >= 0; --kt) {
            const int ktn = kt > 0 ? kt - 1 : 0;
            attn_load(nxt, Kh, Vh, 32 * ktn, n, hf);
            f32x16 sc;
#pragma unroll
            for (int i = 0; i < 16; ++i) sc[i] = 0.f;
#pragma unroll
            for (int s = 0; s < 4; ++s) sc = __builtin_amdgcn_mfma_f32_32x32x16_bf16(cur.k[s], qf[s], sc, 0, 0, 0);
            const bool diag = (kt == qt);
            float lf[16], G4[4];
#pragma unroll
            for (int g = 0; g < 4; ++g) { G4[g] = 0.f;
#pragma unroll
                for (int i = 0; i < 4; ++i) { const int r = 4 * g + i; const float z = sc[r];
                    const bool valid = !diag || (8 * g + 4 * hf + i < n);
                    const float e = fexp(-fabsf(z));
                    const float sp = fmaxf(z, 0.f) + flog(1.f + e);
                    lf[r] = valid ? -sp : 0.f; G4[g] += lf[r]; } }
            float PG[4], T4[4];
#pragma unroll
            for (int g = 0; g < 4; ++g) { PG[g] = __shfl_xor(G4[g], 32); T4[g] = G4[g] + PG[g]; }
            const float tail3 = 0.f, tail2 = T4[3], tail1 = T4[3] + T4[2], tail0 = tail1 + T4[1], total = tail0 + T4[0];
            const float tails[4] = {tail0, tail1, tail2, tail3};
            f32x16 wv;
#pragma unroll
            for (int g = 0; g < 4; ++g) {
                float af = carry + tails[g] + (hf == 0 ? PG[g] : 0.f);
#pragma unroll
                for (int i = 3; i >= 0; --i) { const int r = 4 * g + i; const float z = sc[r];
                    const bool valid = !diag || (8 * g + 4 * hf + i < n);
                    const float wgt = fexp(lf[r] + z + af);
                    wv[r] = valid ? wgt : 0.f;
                    af += lf[r]; } }
            carry += total;
            bf16x8 wf[2];
#pragma unroll
            for (int sg = 0; sg < 2; ++sg) { u32x4 t; t.x = cvt_pk_bf16(wv[8 * sg + 0], wv[8 * sg + 1]); t.y = cvt_pk_bf16(wv[8 * sg + 2], wv[8 * sg + 3]); t.z = cvt_pk_bf16(wv[8 * sg + 4], wv[8 * sg + 5]); t.w = cvt_pk_bf16(wv[8 * sg + 6], wv[8 * sg + 7]); wf[sg] = __builtin_bit_cast(bf16x8, t); }
#pragma unroll
            for (int sg = 0; sg < 2; ++sg) { o0 = __builtin_amdgcn_mfma_f32_32x32x16_bf16(cur.v[0][sg], wf[sg], o0, 0, 0, 0); o1 = __builtin_amdgcn_mfma_f32_32x32x16_bf16(cur.v[1][sg], wf[sg], o1, 0, 0, 0); }
            cur = nxt;
#if MK_EARLY_EXIT
            if (__all(carry < -104.f)) break;
#endif
        }
        bf16_t* op = Oh + (size_t)(q0 + n) * 512 + 4 * hf;
#pragma unroll
        for (int g = 0; g < 4; ++g) {
            u32x2 t0, t1; t0.x = cvt_pk_bf16(o0[4 * g], o0[4 * g + 1]); t0.y = cvt_pk_bf16(o0[4 * g + 2], o0[4 * g + 3]); t1.x = cvt_pk_bf16(o1[4 * g], o1[4 * g + 1]); t1.y = cvt_pk_bf16(o1[4 * g + 2], o1[4 * g + 3]);
            *(u32x2*)(op + 8 * g) = t0; *(u32x2*)(op + 32 + 8 * g) = t1; }
    }
}
__device__ __forceinline__ void phase_mixer(const Args& a, int G) {
    const int tid = my_tid(); const int wave = __builtin_amdgcn_readfirstlane(tid >> 6), lane = tid & 63;
    for (int bh = blockIdx.x; bh < NB * NH; bh += G) {
        if (wave < 4) scan_wave(a, bh, wave, lane);
        else attn_wave(a, bh, wave - 4, lane);
    }
}

__device__ __forceinline__ void phase_rwpost(const Args& a, int G) {
    const float* SC = (const float*)(a.ws + O_SC);
    const unsigned* YR = (const unsigned*)(a.ws + O_YR); const bf16_t* GB = (const bf16_t*)(a.ws + O_G); bf16_t* ORW = (bf16_t*)(a.ws + O_ORW);
    const float *lw = a.in[13], *lb = a.in[14];
    const size_t total = (size_t)M * 128, stride = (size_t)G * 512;
    const int tid = my_tid();
    const int c = (tid & 127) * 4, h = c >> 6;
    const f32x4 lwv = *(const f32x4*)(lw + c), lbv = *(const f32x4*)(lb + c);
    for (size_t idx0 = (size_t)blockIdx.x * 512 + tid; idx0 < total; idx0 += 2 * stride) {
        u32x4 yv[2]; u32x2 gb[2]; float rkb[2]; size_t mm[2];
#pragma unroll
        for (int u = 0; u < 2; ++u) { const size_t idx = idx0 + u * stride; const size_t m = (idx < total ? idx : idx0) >> 7; mm[u] = m;
            yv[u] = *(const u32x4*)(YR + m * 512 + c); gb[u] = *(const u32x2*)(GB + m * 512 + c); rkb[u] = SC[(m * 8 + h) * 4 + 2]; }
#pragma unroll
        for (int u = 0; u < 2; ++u) {
            float y[4] = {bf_lo(yv[u].x), bf_lo(yv[u].y), bf_lo(yv[u].z), bf_lo(yv[u].w)};
            const float v[4] = {bf_hi(yv[u].x), bf_hi(yv[u].y), bf_hi(yv[u].z), bf_hi(yv[u].w)};
            float s = (y[0] + y[1]) + (y[2] + y[3]);
#pragma unroll
            for (int o = 1; o < 16; o <<= 1) s += __shfl_xor(s, o);
            const float mean = s * (1.f / 64.f);
            float q = 0.f;
#pragma unroll
            for (int j = 0; j < 4; ++j) { y[j] -= mean; q += y[j] * y[j]; }
#pragma unroll
            for (int o = 1; o < 16; o <<= 1) q += __shfl_xor(q, o);
            const float rstd = rsqrtf(q * (1.f / 64.f) + GN_EPS);
            const float g4[4] = {bf_lo(gb[u].x), bf_hi(gb[u].x), bf_lo(gb[u].y), bf_hi(gb[u].y)};
            float o4[4];
#pragma unroll
            for (int j = 0; j < 4; ++j) o4[j] = (y[j] * rstd * lwv[j] + lbv[j] + rkb[u] * v[j]) * g4[j];
            u32x2 ob; ob.x = cvt_pk_bf16(o4[0], o4[1]); ob.y = cvt_pk_bf16(o4[2], o4[3]);
            if (idx0 + u * stride < total) *(u32x2*)(ORW + mm[u] * 512 + c) = ob;
        }
    }
}

template <int MODE> __device__ __forceinline__ void phase_rows(const Args& a, int G) {
    const int tid = my_tid(); const int wave = tid >> 6, lane = tid & 63;
    const int gw = blockIdx.x * 8 + wave, NGW = G * 8;
    const bf16_t* T = (const bf16_t*)(a.ws + (MODE == 0 ? O_TT : O_FF));
    const float* xin = MODE == 0 ? a.in[0] : a.out; const float* g1 = MODE == 0 ? a.in[18] : a.in[23]; const float* g2 = a.in[19];
    bf16_t* H2 = (bf16_t*)(a.ws + O_H2);
    f32x4 g1v[4], g2v[4];
#pragma unroll
    for (int j = 0; j < 4; ++j) { g1v[j] = ((const f32x4*)g1)[lane + 64 * j]; g2v[j] = ((const f32x4*)g2)[lane + 64 * j]; }
    for (int row0 = gw; row0 < M; row0 += 2 * NGW) {
        u32x2 tb[2][4]; f32x4 x[2][4];
#pragma unroll
        for (int u = 0; u < 2; ++u) { const int row = (row0 + u * NGW < M) ? row0 + u * NGW : row0;
            const u32x2* tr = (const u32x2*)(T + (size_t)row * D) + lane; const f32x4* xr = (const f32x4*)(xin + (size_t)row * D) + lane;
#pragma unroll
            for (int j = 0; j < 4; ++j) { tb[u][j] = tr[64 * j]; x[u][j] = xr[64 * j]; } }
#pragma unroll
        for (int u = 0; u < 2; ++u) {
            const int row = row0 + u * NGW;
            f32x4 t[4]; float s = 0.f;
#pragma unroll
            for (int j = 0; j < 4; ++j) { t[j][0] = bf_lo(tb[u][j].x); t[j][1] = bf_hi(tb[u][j].x); t[j][2] = bf_lo(tb[u][j].y); t[j][3] = bf_hi(tb[u][j].y);
                s += (t[j][0] * t[j][0] + t[j][1] * t[j][1]) + (t[j][2] * t[j][2] + t[j][3] * t[j][3]); }
            const float rs = rsqrtf(wave_sum(s) * (1.f / D) + RMS_EPS);
            float s2 = 0.f;
#pragma unroll
            for (int j = 0; j < 4; ++j)
#pragma unroll
                for (int e = 0; e < 4; ++e) { x[u][j][e] += t[j][e] * rs * g1v[j][e]; s2 += x[u][j][e] * x[u][j][e]; }
            float rs2 = 0.f;
            if (MODE == 0) rs2 = rsqrtf(wave_sum(s2) * (1.f / D) + RMS_EPS);
            if (row < M) {
                f32x4* orow = (f32x4*)(a.out + (size_t)row * D) + lane;
#pragma unroll
                for (int j = 0; j < 4; ++j) orow[64 * j] = x[u][j];
                if (MODE == 0) {
                    u32x2* o = (u32x2*)(H2 + (size_t)row * D) + lane;
#pragma unroll
                    for (int j = 0; j < 4; ++j) { u32x2 w; w.x = cvt_pk_bf16(x[u][j][0] * rs2 * g2v[j][0], x[u][j][1] * rs2 * g2v[j][1]); w.y = cvt_pk_bf16(x[u][j][2] * rs2 * g2v[j][2], x[u][j][3] * rs2 * g2v[j][3]); o[64 * j] = w; }
                }
            }
        }
    }
}

__global__ void __launch_bounds__(512, 2) mega(Args a) {
    extern __shared__ __attribute__((aligned(16))) unsigned char shm[];
    PG8_LAS unsigned char* lds = (PG8_LAS unsigned char*)shm;
    const int G = (int)gridDim.x;
    unsigned char* ws = a.ws;
    const int nsteps = (MK_REPMASK != 0) ? 2 * NPH : a.ph_hi;
    for (int st = a.ph_lo; st < nsteps; ++st) {
        int ph = st;
        if (MK_REPMASK != 0) { ph = st >> 1; if ((st & 1) && !((MK_REPMASK >> ph) & 1)) continue; }
        if (st > a.ph_lo) cg::this_grid().sync();
        switch (ph) {
        case 0: phase_prep(a, (float*)shm, G); break;
        case 1: { Epi1 E; E.Q = (bf16_t*)(ws + O_Q); E.Kb = (bf16_t*)(ws + O_K); E.Vt = (bf16_t*)(ws + O_VT); E.Prw = (bf16_t*)(ws + O_PRW); E.Gt = (bf16_t*)a.out; E.bgate = a.in[3];
            run_gemm(lds, (const bf16_t*)(ws + O_H), (const bf16_t*)(ws + O_WIN), INC, 1024, E, G); } break;
        case 2: phase_rwprep(a, G); break;
        case 3: phase_mixer(a, G); break;
        case 4: phase_rwpost(a, G); break;
        case 5: { EpiRow<1> E; E.O = (bf16_t*)(ws + O_T1); E.T1 = nullptr; E.Gt = (const bf16_t*)a.out;
            run_gemm(lds, (const bf16_t*)(ws + O_OSB), (const bf16_t*)(ws + O_WSB), 1024, 512, E, G); } break;
        case 6: { EpiRow<2> E; E.O = (bf16_t*)(ws + O_MRG); E.T1 = (const bf16_t*)(ws + O_T1); E.Gt = (const bf16_t*)a.out;
            run_gemm(lds, (const bf16_t*)(ws + O_ORW), (const bf16_t*)(ws + O_WRW), 1024, 512, E, G); } break;
        case 7: { EpiRow<0> E; E.O = (bf16_t*)(ws + O_TT); E.T1 = nullptr; E.Gt = nullptr;
            run_gemm(lds, (const bf16_t*)(ws + O_MRG), (const bf16_t*)(ws + O_WO), 1024, 1024, E, G); } break;
        case 8: phase_rows<0>(a, G); break;
        case 9: { EpiSwiGLU E; E.Hd = (bf16_t*)(ws + O_HID);
            run_gemm(lds, (const bf16_t*)(ws + O_H2), (const bf16_t*)(ws + O_WGU), 2 * DFF, 1024, E, G); } break;
        case 10: { EpiRow<0> E; E.O = (bf16_t*)(ws + O_FF); E.T1 = nullptr; E.Gt = nullptr;
            run_gemm(lds, (const bf16_t*)(ws + O_HID), (const bf16_t*)(ws + O_WDN), 1024, DFF, E, G); } break;
        case 11: phase_rows<1>(a, G); break;
        }
    }
}
}

extern "C" void kernel_launch(void* const* d_in, const int* in_sizes, int n_in, void* d_out, int out_size, void* d_ws, size_t ws_size, hipStream_t stream) {
    static int grid = 0;
    if (grid == 0) {
        if (n_in != 24 || in_sizes[0] != mk::M * mk::D || out_size != mk::M * mk::D || ws_size < mk::WS_NEED) {
            fprintf(stderr, "kernel_launch: unexpected shapes: n_in %d in0 %d out %d ws %zu (need %zu)\n", n_in, n_in > 0 ? in_sizes[0] : -1, out_size, ws_size, (size_t)mk::WS_NEED); grid = -1; return; }
        int dev = 0, cus = 0, per_cu = 0;
        hipGetDevice(&dev); hipDeviceGetAttribute(&cus, hipDeviceAttributeMultiprocessorCount, dev);
        if (hipFuncSetAttribute((const void*)mk::mega, hipFuncAttributeMaxDynamicSharedMemorySize, mk::LDS_BYTES) != hipSuccess) { fprintf(stderr, "kernel_launch: hipFuncSetAttribute failed\n"); grid = -1; return; }
        if (hipOccupancyMaxActiveBlocksPerMultiprocessor(&per_cu, (const void*)mk::mega, 512, mk::LDS_BYTES) != hipSuccess || per_cu < 1) { fprintf(stderr, "kernel_launch: occupancy query failed (%d)\n", per_cu); per_cu = 1; }
        (void)hipGetLastError();
        grid = cus * per_cu;
        fprintf(stderr, "kernel_launch: grid %d (cus %d x %d)\n", grid, cus, per_cu);
    }
    if (grid < 0) return;
    mk::Args a{};
    for (int i = 0; i < 24; ++i) a.in[i] = (const float*)d_in[i];
    a.out = (float*)d_out; a.ws = (unsigned char*)d_ws;
#if MK_SPLIT
    for (int ph = 0; ph < mk::NPH; ++ph) { a.ph_lo = ph; a.ph_hi = ph + 1; hipLaunchKernelGGL(mk::mega, dim3(grid), dim3(512), mk::LDS_BYTES, stream, a);
    }
#else
    a.ph_lo = 0; a.ph_hi = mk::NPH;
    void* args[] = {&a};
    hipError_t e = hipLaunchCooperativeKernel((const void*)mk::mega, dim3(grid), dim3(512), args, mk::LDS_BYTES, stream);
    if (e != hipSuccess) fprintf(stderr, "kernel_launch: cooperative launch failed: %s (grid %d)\n", hipGetErrorString(e), grid);
#endif
}
```

```cpp
#include <hip/hip_runtime.h>
#include <hip/hip_cooperative_groups.h>
#include <cstdio>
#include <cstdint>
namespace cg = cooperative_groups;
#ifndef MK_SPLIT
#define MK_SPLIT 0
#endif
#ifndef MK_DIAG
#define MK_DIAG 0
#endif
#ifndef MK_REPMASK
#define MK_REPMASK 0
#endif
#ifndef MK_EARLY_EXIT
#define MK_EARLY_EXIT 1
#endif
namespace pg8 {
#define PG8_LAS __attribute__((address_space(3)))
typedef unsigned short bf16_t;
typedef short bf16x8 __attribute__((ext_vector_type(8)));
typedef float f32x4 __attribute__((ext_vector_type(4)));
typedef unsigned u32x4 __attribute__((ext_vector_type(4)));
constexpr int BM = 256, BK = 64, HALF = 128, HTB = HALF * BK * 2  , STAGE_BYTES = 8 * HTB, NXCD = 8, WGM = 8;

__host__ __device__ __forceinline__ int lds_byte(int r, int c) { const int st = (r >> 4) * 2 + (c >> 5), rr = r & 15, cc = c & 31, ob = rr * 64 + cc * 2; return st * 1024 + (ob ^ (((ob >> 9) & 1) << 5)); }
__host__ __device__ __forceinline__ void stage_rc(int b, int& R, int& C) { const int st = b / 1024, sb = b % 1024, swz = sb ^ (((sb >> 9) & 1) << 5); R = (st >> 1) * 16 + swz / 64; C = (st & 1) * 32 + (swz % 64) / 2; }
__host__ __device__ __forceinline__ int perm32(int rho) { const int n = rho >> 4, i = rho & 15; return 8 * (i >> 2) + 4 * n + (i & 3); }

struct Unit { int pm, pn; };
struct Gemm { const bf16_t* A; const bf16_t* Bt; int M, N, K; };

struct StaticOrder {
    int nM, nN, nwg, G, c;
    __host__ __device__ void init(int M, int N, int G_, int c_) { nM = M / BM; nN = N / BM; nwg = nM * nN; G = G_; c = c_; }
    __host__ __device__ bool next(int i, Unit& u) const {
        const long L = (long)i * G + c; if (L >= nwg) return false;
        int wgid = (int)L; { const int q = nwg / NXCD, r = nwg % NXCD, xcd = wgid % NXCD, off = wgid / NXCD; wgid = (xcd < r ? xcd * (q + 1) : r * (q + 1) + (xcd - r) * q) + off; }
        const int nig = WGM * nN, gid = wgid / nig, fm = gid * WGM, gsz = (nM - fm) < WGM ? (nM - fm) : WGM;
        u.pm = fm + ((wgid % nig) % gsz); u.pn = (wgid % nig) / gsz; return true;
    }
    __device__ __forceinline__ void a_ready(const Unit&) const {}
    __device__ __forceinline__ void done(const Unit&) const {}
};

__device__ __forceinline__ unsigned cvt_pk_bf16(float lo, float hi) { unsigned r; asm volatile("v_cvt_pk_bf16_f32 %0, %1, %2" : "=v"(r) : "v"(lo), "v"(hi)); return r; }
typedef float f32x2 __attribute__((ext_vector_type(2)));

template <class Epi, class Sched, bool STAMP = false>
__device__ __forceinline__ void gemm_phase(PG8_LAS unsigned char* lds, const Gemm g, const Sched& S, const Epi& E, unsigned long long* stamps) {
    int tid_ = threadIdx.x; asm volatile("" : "+v"(tid_)); const int tid = tid_, wid = __builtin_amdgcn_readfirstlane(tid >> 6), lane = tid & 63, wr = wid >> 2, wc = wid & 3, fr = lane & 15, fq = lane >> 4;
    const int K = g.K, nt = K / BK;
    int ts_lo = 0, ts_hi = 0, nts = 0; const unsigned long long rt_entry = STAMP ? (unsigned long long)wall_clock64() : 0ull;
#define PG8_STAMP() do { if (STAMP && wid == 0 && nts < 64) { const unsigned long long _c = (unsigned long long)clock64(); \
        ts_lo = (lane == nts) ? (int)(unsigned)_c : ts_lo; ts_hi = (lane == nts) ? (int)(unsigned)(_c >> 32) : ts_hi; ++nts; } } while (0)
    PG8_STAMP();
    unsigned voffA[2], voffB[2];
#pragma unroll
    for (int i = 0; i < 2; ++i) { int R, C; stage_rc(tid * 16 + i * 8192, R, C); const int Rb = Epi::PERM ? ((R & ~31) + perm32(R & 31)) : R;
        voffA[i] = (unsigned)(R * K + C) * 2u; voffB[i] = (unsigned)(Rb * K + C) * 2u; }
    const size_t kstep = (size_t)(BK * 2);
    const size_t hstep = (size_t)HALF * K * 2;
    const size_t tstep = 2 * hstep;
    const unsigned ldsw = (unsigned)wid * 1024u;
    const int aoff = lds_byte(wr * 64 + fr, fq * 8), boff = lds_byte(wc * 32 + fr, fq * 8);
#define PG8_SA(b, h) (((b) * 2 + (h)) * HTB)
#define PG8_SB(b, h) ((4 + (b) * 2 + (h)) * HTB)
#define PG8_STAGE(bufoff, gbase, voff) do { _Pragma("unroll") for (int _i = 0; _i < 2; ++_i) \
        __builtin_amdgcn_global_load_lds((const unsigned*)((const char*)(gbase) + (voff)[_i]), (PG8_LAS unsigned*)(lds + (bufoff) + ldsw + _i * 8192), 16, 0, 0); } while (0)
#define PG8_LDA(dst, b, h) do { _Pragma("unroll") for (int m = 0; m < 4; ++m) _Pragma("unroll") for (int k = 0; k < 2; ++k) dst[m][k] = *(const PG8_LAS bf16x8*)(lds + PG8_SA(b, h) + aoff + m * 2048 + k * 1024); } while (0)
#define PG8_LDB(dst, b, h) do { _Pragma("unroll") for (int n = 0; n < 2; ++n) _Pragma("unroll") for (int k = 0; k < 2; ++k) dst[n][k] = *(const PG8_LAS bf16x8*)(lds + PG8_SB(b, h) + boff + n * 2048 + k * 1024); } while (0)
#define PG8_MMA(ai, bj, At, Bt) do { __builtin_amdgcn_s_setprio(1); _Pragma("unroll") for (int m = 0; m < 4; ++m) _Pragma("unroll") for (int n = 0; n < 2; ++n) _Pragma("unroll") for (int k = 0; k < 2; ++k) \
        acc[ai][bj][m][n] = __builtin_amdgcn_mfma_f32_16x16x32_bf16(Bt[n][k], At[m][k], acc[ai][bj][m][n], 0, 0, 0); __builtin_amdgcn_s_setprio(0); } while (0)
#define PG8_WAIT_V(n) asm volatile("s_waitcnt vmcnt(" #n ")" ::: "memory")
#define PG8_WAIT_L(n) asm volatile("s_waitcnt lgkmcnt(" #n ")" ::: "memory")
#define PG8_BAR __builtin_amdgcn_s_barrier()
#define PG8_SCHED __builtin_amdgcn_sched_barrier(0)
    Unit cur, nxt; int ui = 0;
    if (!S.next(0, cur)) return;
    f32x4 acc[2][2][4][2];
#pragma unroll
    for (int a = 0; a < 2; ++a)
#pragma unroll
        for (int b = 0; b < 2; ++b)
#pragma unroll
            for (int m = 0; m < 4; ++m)
#pragma unroll
                for (int n = 0; n < 2; ++n) acc[a][b][m][n] = (f32x4){0.f, 0.f, 0.f, 0.f};
    bf16x8 At[4][2], B0[2][2], B1[2][2];
    const char* cA = (const char*)g.A + (size_t)cur.pm * tstep; const char* cB = (const char*)g.Bt + (size_t)cur.pn * tstep;
    S.a_ready(cur);
    PG8_STAGE(PG8_SB(0, 0), cB, voffB); PG8_STAGE(PG8_SA(0, 0), cA, voffA); PG8_STAGE(PG8_SB(0, 1), cB + hstep, voffB); PG8_STAGE(PG8_SA(0, 1), cA + hstep, voffA);
    if (wr == 1) PG8_BAR;
    PG8_WAIT_V(4); PG8_BAR;
    PG8_STAGE(PG8_SB(1, 0), cB + kstep, voffB); PG8_STAGE(PG8_SA(1, 0), cA + kstep, voffA); PG8_STAGE(PG8_SB(1, 1), cB + hstep + kstep, voffB);
    PG8_WAIT_V(6); PG8_BAR;
    PG8_STAMP();
    for (;;) {
        const bool has_next = S.next(ui + 1, nxt);
        const char* nA = has_next ? (const char*)g.A + (size_t)nxt.pm * tstep : cA; const char* nB = has_next ? (const char*)g.Bt + (size_t)nxt.pn * tstep : cB;
        for (int t = 0; t < nt; t += 2) {
            const bool last = (t == nt - 2);
            const char* a1 = cA + (size_t)(t + 1) * kstep;
            const char* a2 = last ? nA : cA + (size_t)(t + 2) * kstep; const char* b2 = last ? nB : cB + (size_t)(t + 2) * kstep;
            const char* a3 = a2 + kstep; const char* b3 = b2 + kstep;
            if (last && has_next) S.a_ready(nxt);
            PG8_LDB(B0, 0, 0); PG8_SCHED; PG8_LDA(At, 0, 0); PG8_STAGE(PG8_SA(1, 1), a1 + hstep, voffA);
            PG8_WAIT_L(8); PG8_BAR; PG8_WAIT_L(0); PG8_MMA(0, 0, At, B0); PG8_BAR; PG8_SCHED;
            PG8_LDB(B1, 0, 1); PG8_STAGE(PG8_SB(0, 0), b2, voffB);
            PG8_BAR; PG8_WAIT_L(0); PG8_MMA(0, 1, At, B1); PG8_BAR;
            PG8_LDA(At, 0, 1); PG8_STAGE(PG8_SA(0, 0), a2, voffA);
            PG8_BAR; PG8_WAIT_L(0); PG8_MMA(1, 0, At, B0); PG8_BAR; PG8_SCHED;
            PG8_STAGE(PG8_SB(0, 1), b2 + hstep, voffB);
            PG8_WAIT_V(6); PG8_BAR; PG8_MMA(1, 1, At, B1); PG8_BAR;
            PG8_LDB(B0, 1, 0); PG8_SCHED; PG8_LDA(At, 1, 0); PG8_STAGE(PG8_SA(0, 1), a2 + hstep, voffA);
            PG8_WAIT_L(8); PG8_BAR; PG8_WAIT_L(0); PG8_MMA(0, 0, At, B0); PG8_BAR; PG8_SCHED;
            PG8_LDB(B1, 1, 1); PG8_STAGE(PG8_SB(1, 0), b3, voffB);
            PG8_BAR; PG8_WAIT_L(0); PG8_MMA(0, 1, At, B1); PG8_BAR;
            PG8_LDA(At, 1, 1); PG8_STAGE(PG8_SA(1, 0), a3, voffA);
            PG8_BAR; PG8_WAIT_L(0); PG8_MMA(1, 0, At, B0); PG8_BAR; PG8_SCHED;
            PG8_STAGE(PG8_SB(1, 1), b3 + hstep, voffB);
            PG8_WAIT_V(6); PG8_BAR; PG8_MMA(1, 1, At, B1); PG8_BAR;
        }
        PG8_STAMP();
        if constexpr (!Epi::AFTER_DRAIN) { E(acc, cur, wr, wc, fr, fq); S.done(cur); }
        PG8_STAMP();
        if (!has_next) break;
#pragma unroll
        for (int a = 0; a < 2; ++a)
#pragma unroll
            for (int b = 0; b < 2; ++b)
#pragma unroll
                for (int m = 0; m < 4; ++m)
#pragma unroll
                    for (int n = 0; n < 2; ++n) acc[a][b][m][n] = (f32x4){0.f, 0.f, 0.f, 0.f};
        cur = nxt; cA = nA; cB = nB; ++ui;
    }
    PG8_WAIT_V(0);
    if (wr == 0) PG8_BAR;
    PG8_BAR;
    if constexpr (Epi::AFTER_DRAIN) { E.fused(acc, cur, wr, wc, fr, fq, lds, wid, lane); S.done(cur); }
    PG8_STAMP();
    if (STAMP && wid == 0) { stamps[lane] = lane < nts ? (((unsigned long long)(unsigned)ts_hi << 32) | (unsigned)ts_lo) : 0ull;
        if (lane == 62) stamps[62] = rt_entry; if (lane == 63) stamps[63] = (unsigned long long)wall_clock64(); }
#undef PG8_STAMP
#undef PG8_SA
#undef PG8_SB
#undef PG8_STAGE
#undef PG8_LDA
#undef PG8_LDB
#undef PG8_MMA
#undef PG8_WAIT_V
#undef PG8_WAIT_L
#undef PG8_BAR
#undef PG8_SCHED
}
}
namespace mk {
using pg8::bf16_t; using pg8::bf16x8; using pg8::f32x4; using pg8::u32x4; using pg8::cvt_pk_bf16;
typedef float f32x16 __attribute__((ext_vector_type(16)));
typedef float f32x2 __attribute__((ext_vector_type(2)));
typedef unsigned u32x2 __attribute__((ext_vector_type(2)));
constexpr int D = 1024, NB = 32, SEQ = 2048, M = NB * SEQ, NH = 8, DH = 64;
constexpr int RWC = 1792, GC = 2048, INC = 5376, DFF = 2816;
constexpr float RMS_EPS = 1e-6f, GN_EPS = 64e-5f;
constexpr size_t MiB = (size_t)1 << 20;
constexpr size_t O_WIN = 0, O_WSB = 11 * MiB, O_WRW = 12 * MiB, O_WO = 13 * MiB, O_WGU = 15 * MiB, O_WDN = 26 * MiB, O_WLU = 32 * MiB  , O_WLA = O_WLU + 65536, O_WLG = O_WLA + 65536;
constexpr size_t O_Q = 34 * MiB, O_K = 98 * MiB, O_VT = 162 * MiB, O_PRW = 226 * MiB, O_H = 450 * MiB, O_SI = 450 * MiB, O_G = 834 * MiB, O_SC = 898 * MiB, O_YR = 290 * MiB  ;
constexpr size_t O_OSB = 226 * MiB, O_ORW = 34 * MiB, O_T1 = 98 * MiB, O_MRG = 450 * MiB, O_TT = 34 * MiB, O_H2 = 162 * MiB, O_HID = 290 * MiB, O_FF = 34 * MiB;
constexpr size_t WS_NEED = 906 * MiB;
constexpr int LDS_BYTES = pg8::STAGE_BYTES;
constexpr int NPH = 12;

struct Args { const float* in[24]; float* out; unsigned char* ws; int ph_lo, ph_hi; };

__device__ __forceinline__ int my_tid() { int t = threadIdx.x; asm volatile("" : "+v"(t)); return t; }
__device__ __forceinline__ float bf_lo(unsigned u) { return __uint_as_float(u << 16); }
__device__ __forceinline__ float bf_hi(unsigned u) { return __uint_as_float(u & 0xffff0000u); }
__device__ __forceinline__ float fexp(float x) { return __builtin_amdgcn_exp2f(x * 1.44269504089f); }
__device__ __forceinline__ float flog(float x) { return __builtin_amdgcn_logf(x) * 0.69314718056f; }
__device__ __forceinline__ float frcp(float x) { return __builtin_amdgcn_rcpf(x); }
__device__ __forceinline__ float fsigmoid(float x) { return frcp(1.f + fexp(-x)); }
__device__ __forceinline__ unsigned short bf1(float x) { return (unsigned short)(cvt_pk_bf16(x, x) & 0xffffu); }
__device__ __forceinline__ u32x4 pack8(const f32x4 a, const f32x4 b) { u32x4 o; o.x = cvt_pk_bf16(a[0], a[1]); o.y = cvt_pk_bf16(a[2], a[3]); o.z = cvt_pk_bf16(b[0], b[1]); o.w = cvt_pk_bf16(b[2], b[3]); return o; }
__device__ __forceinline__ float red16(float v) {
    v += __shfl_xor(v, 16); v += __shfl_xor(v, 32); return v;
}
__device__ __forceinline__ float wave_sum(float v) {
#pragma unroll
    for (int o = 1; o < 64; o <<= 1) v += __shfl_xor(v, o);
    return v;
}

__device__ __forceinline__ void tr_item(const float* __restrict__ W, int K, int N, bf16_t* WT, float* scr, int item, int lane, int mode) {
    const int nblk = N >> 5, kb = item / nblk, nb = item - kb * nblk, k0 = kb << 6, n0 = nb << 5;
#pragma unroll 8
    for (int i = 0; i < 32; ++i) { const int kk = 2 * i + (lane >> 5); scr[kk * 33 + (lane & 31)] = W[(size_t)(k0 + kk) * N + n0 + (lane & 31)]; }
    asm volatile("s_waitcnt lgkmcnt(0)" ::: "memory"); __builtin_amdgcn_wave_barrier();
    const int c = lane & 7;
#pragma unroll
    for (int j = 0; j < 4; ++j) {
        const int n = (lane >> 3) + 8 * j; const float* s = scr + (8 * c) * 33 + n;
        u32x4 o; o.x = cvt_pk_bf16(s[0 * 33], s[1 * 33]); o.y = cvt_pk_bf16(s[2 * 33], s[3 * 33]); o.z = cvt_pk_bf16(s[4 * 33], s[5 * 33]); o.w = cvt_pk_bf16(s[6 * 33], s[7 * 33]);
        const int nn = n0 + n; int drow = nn;
        if (mode == 1) drow = ((nn >> 7) << 8) + (nn & 127); else if (mode == 2) drow = ((nn >> 7) << 8) + 128 + (nn & 127);
        *(u32x4*)(WT + (size_t)drow * K + k0 + 8 * c) = o;
    }
    asm volatile("s_waitcnt lgkmcnt(0)" ::: "memory"); __builtin_amdgcn_wave_barrier();
}

__device__ __forceinline__ void phase_prep(const Args& a, float* lds_f, int G) {
    const int tid = my_tid(); const int wave = tid >> 6, lane = tid & 63;
    const int gw = blockIdx.x * 8 + wave, NGW = G * 8;
    float* scr = lds_f + wave * (64 * 33 + 16);
    unsigned char* ws = a.ws;
    constexpr int I_IN = 16 * 168, I_SB = 8 * 32, I_O = 16 * 32, I_G = 16 * 88, I_DN = 44 * 32, I_LU = 16, I_LG = 32;
    constexpr int NIT = I_IN + 2 * I_SB + I_O + 2 * I_G + I_DN + 2 * I_LU + I_LG;
    for (int it = gw; it < NIT; it += NGW) {
        int r = it;
        if (r < I_IN) { tr_item(a.in[2], 1024, INC, (bf16_t*)(ws + O_WIN), scr, r, lane, 0); continue; } r -= I_IN;
        if (r < I_SB) { tr_item(a.in[15], 512, 1024, (bf16_t*)(ws + O_WSB), scr, r, lane, 0); continue; } r -= I_SB;
        if (r < I_SB) { tr_item(a.in[16], 512, 1024, (bf16_t*)(ws + O_WRW), scr, r, lane, 0); continue; } r -= I_SB;
        if (r < I_O) { tr_item(a.in[17], 1024, 1024, (bf16_t*)(ws + O_WO), scr, r, lane, 0); continue; } r -= I_O;
        if (r < I_G) { tr_item(a.in[20], 1024, DFF, (bf16_t*)(ws + O_WGU), scr, r, lane, 1); continue; } r -= I_G;
        if (r < I_G) { tr_item(a.in[21], 1024, DFF, (bf16_t*)(ws + O_WGU), scr, r, lane, 2); continue; } r -= I_G;
        if (r < I_DN) { tr_item(a.in[22], DFF, 1024, (bf16_t*)(ws + O_WDN), scr, r, lane, 0); continue; } r -= I_DN;
        if (r < I_LU) { tr_item(a.in[6], 64, 512, (bf16_t*)(ws + O_WLU), scr, r, lane, 0); continue; } r -= I_LU;
        if (r < I_LU) { tr_item(a.in[8], 64, 512, (bf16_t*)(ws + O_WLA), scr, r, lane, 0); continue; } r -= I_LU;
        tr_item(a.in[9], 128, 512, (bf16_t*)(ws + O_WLG), scr, r, lane, 0);
    }
    const float* x = a.in[0]; const float* g = a.in[1]; bf16_t* H = (bf16_t*)(ws + O_H);
    f32x4 gv[4];
#pragma unroll
    for (int j = 0; j < 4; ++j) gv[j] = ((const f32x4*)g)[lane + 64 * j];
    for (int row0 = gw; row0 < M; row0 += 2 * NGW) {
        f32x4 v[2][4];
#pragma unroll
        for (int u = 0; u < 2; ++u) { const int row = (row0 + u * NGW < M) ? row0 + u * NGW : row0; const f32x4* xr = (const f32x4*)(x + (size_t)row * D) + lane;
#pragma unroll
            for (int j = 0; j < 4; ++j) v[u][j] = xr[64 * j]; }
#pragma unroll
        for (int u = 0; u < 2; ++u) { const int row = row0 + u * NGW; float s = 0.f;
#pragma unroll
            for (int j = 0; j < 4; ++j) s += (v[u][j][0] * v[u][j][0] + v[u][j][1] * v[u][j][1]) + (v[u][j][2] * v[u][j][2] + v[u][j][3] * v[u][j][3]);
            const float rs = rsqrtf(wave_sum(s) * (1.f / D) + RMS_EPS);
            if (row < M) { u32x2* o = (u32x2*)(H + (size_t)row * D) + lane;
#pragma unroll
                for (int j = 0; j < 4; ++j) { u32x2 w; w.x = cvt_pk_bf16(v[u][j][0] * rs * gv[j][0], v[u][j][1] * rs * gv[j][1]); w.y = cvt_pk_bf16(v[u][j][2] * rs * gv[j][2], v[u][j][3] * rs * gv[j][3]); o[64 * j] = w; } }
        }
    }
}

struct Epi1 {
    static constexpr bool PERM = true, AFTER_DRAIN = false;
    bf16_t *Q, *Kb, *Vt, *Prw, *Gt; const float* bgate;
    __device__ __forceinline__ void operator()(const f32x4 (&acc)[2][2][4][2], const pg8::Unit& u, int wr, int wc, int fr, int fq) const {
        const int row0 = u.pm * 256 + wr * 64 + fr, pn = u.pn, cl = wc * 32 + 8 * fq;
        if (pn < 4) {
            bf16_t* dst = pn < 2 ? Q : Kb; const float sc = pn < 2 ? 0.125f : 1.f; const int cb = (pn & 1) * 256 + cl;
#pragma unroll
            for (int ai = 0; ai < 2; ++ai)
#pragma unroll
                for (int m = 0; m < 4; ++m) { bf16_t* rp = dst + (size_t)(row0 + ai * 128 + m * 16) * 512 + cb;
#pragma unroll
                    for (int bj = 0; bj < 2; ++bj) *(u32x4*)(rp + bj * 128) = pack8(acc[ai][bj][m][0] * sc, acc[ai][bj][m][1] * sc); }
        } else if (pn < 6) {
#pragma unroll
            for (int ai = 0; ai < 2; ++ai)
#pragma unroll
                for (int m = 0; m < 4; ++m) { const int row = row0 + ai * 128 + m * 16, b = row >> 11, s = row & 2047;
#pragma unroll
                    for (int bj = 0; bj < 2; ++bj)
#pragma unroll
                        for (int n = 0; n < 2; ++n)
#pragma unroll
                            for (int j = 0; j < 4; ++j) { const int c = (pn - 4) * 256 + bj * 128 + cl + 4 * n + j;
                                Vt[((size_t)(b * 512 + c)) * 2048 + s] = bf1(acc[ai][bj][m][n][j]); } }
        } else if (pn < 13) {
            const int cb = (pn - 6) * 256 + cl;
#pragma unroll
            for (int ai = 0; ai < 2; ++ai)
#pragma unroll
                for (int m = 0; m < 4; ++m) { bf16_t* rp = Prw + (size_t)(row0 + ai * 128 + m * 16) * RWC + cb;
#pragma unroll
                    for (int bj = 0; bj < 2; ++bj) *(u32x4*)(rp + bj * 128) = pack8(acc[ai][bj][m][0], acc[ai][bj][m][1]); }
        } else {
            const int cb = (pn - 13) * 256 + cl;
#pragma unroll
            for (int ai = 0; ai < 2; ++ai)
#pragma unroll
                for (int m = 0; m < 4; ++m) { bf16_t* rp = Gt + (size_t)(row0 + ai * 128 + m * 16) * GC + cb;
#pragma unroll
                    for (int bj = 0; bj < 2; ++bj) { f32x4 v0 = acc[ai][bj][m][0] + *(const f32x4*)(bgate + cb + bj * 128), v1 = acc[ai][bj][m][1] + *(const f32x4*)(bgate + cb + bj * 128 + 4);
#pragma unroll
                        for (int j = 0; j < 4; ++j) { v0[j] = fsigmoid(v0[j]); v1[j] = fsigmoid(v1[j]); }
                        *(u32x4*)(rp + bj * 128) = pack8(v0, v1); } }
        }
    }
};
template <int MODE> struct EpiRow {
    static constexpr bool PERM = true, AFTER_DRAIN = false;
    bf16_t* O; const bf16_t* T1; const bf16_t* Gt;
    __device__ __forceinline__ void operator()(const f32x4 (&acc)[2][2][4][2], const pg8::Unit& u, int wr, int wc, int fr, int fq) const {
        const int row0 = u.pm * 256 + wr * 64 + fr, cb = u.pn * 256 + wc * 32 + 8 * fq;
#pragma unroll
        for (int ai = 0; ai < 2; ++ai)
#pragma unroll
            for (int m = 0; m < 4; ++m) { const size_t row = (size_t)(row0 + ai * 128 + m * 16);
#pragma unroll
                for (int bj = 0; bj < 2; ++bj) { f32x4 v0 = acc[ai][bj][m][0], v1 = acc[ai][bj][m][1]; const int c = cb + bj * 128;
                    if (MODE >= 1) { const u32x4 gg = *(const u32x4*)(Gt + row * GC + (MODE == 2 ? 1024 : 0) + c);
                        v0[0] *= bf_lo(gg.x); v0[1] *= bf_hi(gg.x); v0[2] *= bf_lo(gg.y); v0[3] *= bf_hi(gg.y); v1[0] *= bf_lo(gg.z); v1[1] *= bf_hi(gg.z); v1[2] *= bf_lo(gg.w); v1[3] *= bf_hi(gg.w); }
                    if (MODE == 2) { const u32x4 tt = *(const u32x4*)(T1 + row * 1024 + c);
                        v0[0] += bf_lo(tt.x); v0[1] += bf_hi(tt.x); v0[2] += bf_lo(tt.y); v0[3] += bf_hi(tt.y); v1[0] += bf_lo(tt.z); v1[1] += bf_hi(tt.z); v1[2] += bf_lo(tt.w); v1[3] += bf_hi(tt.w); }
                    *(u32x4*)(O + row * 1024 + c) = pack8(v0, v1); } }
    }
};
struct EpiSwiGLU {
    static constexpr bool PERM = true, AFTER_DRAIN = false;
    bf16_t* Hd;
    __device__ __forceinline__ void operator()(const f32x4 (&acc)[2][2][4][2], const pg8::Unit& u, int wr, int wc, int fr, int fq) const {
        const int row0 = u.pm * 256 + wr * 64 + fr, cb = u.pn * 128 + wc * 32 + 8 * fq;
#pragma unroll
        for (int ai = 0; ai < 2; ++ai)
#pragma unroll
            for (int m = 0; m < 4; ++m) { f32x4 v0, v1;
#pragma unroll
                for (int j = 0; j < 4; ++j) { const float g0 = acc[ai][0][m][0][j], g1 = acc[ai][0][m][1][j];
                    v0[j] = g0 * fsigmoid(g0) * acc[ai][1][m][0][j]; v1[j] = g1 * fsigmoid(g1) * acc[ai][1][m][1][j]; }
                *(u32x4*)(Hd + (size_t)(row0 + ai * 128 + m * 16) * DFF + cb) = pack8(v0, v1); }
    }
};
template <class Epi> __device__ __forceinline__ void run_gemm(PG8_LAS unsigned char* lds, const bf16_t* A, const bf16_t* Bt, int N, int K, const Epi& E, int G) {
    pg8::Gemm g; g.A = A; g.Bt = Bt; g.M = M; g.N = N; g.K = K;
    pg8::StaticOrder S; S.init(M, N, G, (int)blockIdx.x);
    pg8::gemm_phase<Epi, pg8::StaticOrder, false>(lds, g, S, E, nullptr);
}
__device__ __forceinline__ void mix8_lds(const unsigned char* cur, const unsigned char* prv, const float* mu, float (&o)[8]) {
    const u32x4 c = *(const u32x4*)cur, p = *(const u32x4*)prv;
    const f32x4 m0 = *(const f32x4*)mu, m1 = *(const f32x4*)(mu + 4);
    const float mm[8] = {m0[0], m0[1], m0[2], m0[3], m1[0], m1[1], m1[2], m1[3]};
#pragma unroll
    for (int i = 0; i < 4; ++i) { const float cl = bf_lo(c[i]), ch = bf_hi(c[i]), pl = bf_lo(p[i]), ph = bf_hi(p[i]);
        o[2 * i] = cl + (pl - cl) * mm[2 * i]; o[2 * i + 1] = ch + (ph - ch) * mm[2 * i + 1]; }
}
__device__ __forceinline__ void mix4_lds(const unsigned char* cur, const unsigned char* prv, const float* mu, float (&o)[4]) {
    const u32x2 c = *(const u32x2*)cur, p = *(const u32x2*)prv;
    const f32x4 m0 = *(const f32x4*)mu;
#pragma unroll
    for (int i = 0; i < 2; ++i) { const float cl = bf_lo(c[i]), ch = bf_hi(c[i]), pl = bf_lo(p[i]), ph = bf_hi(p[i]);
        o[2 * i] = cl + (pl - cl) * m0[2 * i]; o[2 * i + 1] = ch + (ph - ch) * m0[2 * i + 1]; }
}
__device__ __forceinline__ bf16x8 pack_frag(const float (&v)[8]) {
    u32x4 o; o.x = cvt_pk_bf16(v[0], v[1]); o.y = cvt_pk_bf16(v[2], v[3]); o.z = cvt_pk_bf16(v[4], v[5]); o.w = cvt_pk_bf16(v[6], v[7]);
    return __builtin_bit_cast(bf16x8, o);
}
__device__ __forceinline__ void phase_rwprep(const Args& a, unsigned char* lds, int G) {
    constexpr int ROWB = 3600, L_FRAG = 17 * ROWB, L_PAR = L_FRAG + 8192, NCH = 17 * 224, NT = M / 16;
    const int tid = my_tid(); const int wave = __builtin_amdgcn_readfirstlane(tid >> 6), lane = tid & 63, fr = lane & 15, fq = lane >> 4;
    unsigned char* ws = a.ws;
    const unsigned char* PRW = ws + O_PRW;
    const bf16_t* WLU = (const bf16_t*)(ws + O_WLU); const bf16_t* WLA = (const bf16_t*)(ws + O_WLA); const bf16_t* WLG = (const bf16_t*)(ws + O_WLG);
    unsigned char* SI = ws + O_SI; bf16_t* GB = (bf16_t*)(ws + O_G); float* SC = (float*)(ws + O_SC);
    float* par = (float*)(lds + L_PAR);
    for (int i = tid; i < 1792 + 5 * 512; i += 512) {
        float v;
        if (i < 1792) v = a.in[4][i]; else { const int j = i - 1792, w = j >> 9, c = j & 511; v = (w == 0 ? a.in[5] : w == 1 ? a.in[7] : w == 2 ? a.in[10] : w == 3 ? a.in[11] : a.in[12])[c]; }
        par[i] = v;
    }
    for (int tile = blockIdx.x; tile < NT; tile += G) {
        __syncthreads();
        {   u32x4 pre[8];
#pragma unroll
            for (int j = 0; j < 8; ++j) { const int c = tid + 512 * j; pre[j] = (u32x4){0u, 0u, 0u, 0u};
                if (c < NCH) { const int row = c / 224, col = c - row * 224; const bool zero = (row == 0) && (((tile * 16) & (SEQ - 1)) == 0);
                    if (!zero) pre[j] = *(const u32x4*)(PRW + ((size_t)tile * 16 + row - 1) * (RWC * 2) + col * 16); } }
#pragma unroll
            for (int j = 0; j < 8; ++j) { const int c = tid + 512 * j; if (c < NCH) { const int row = c / 224, col = c - row * 224; *(u32x4*)(lds + row * ROWB + col * 16) = pre[j]; } }
        }
        __syncthreads();
        const unsigned char* rcur = lds + (fr + 1) * ROWB; const unsigned char* rprv = lds + fr * ROWB;
        {
            const int colb = wave < 2 ? 1536 + 32 * wave : (wave < 4 ? 1600 + 32 * (wave - 2) : 1664 + 32 * (wave - 4));
            float t8[8]; mix8_lds(rcur + (colb + 8 * fq) * 2, rprv + (colb + 8 * fq) * 2, par + colb + 8 * fq, t8);
            if (wave < 2) {
#pragma unroll
                for (int i = 0; i < 8; ++i) { const float e = fexp(2.f * t8[i]); t8[i] = 1.f - 2.f * frcp(e + 1.f); } }
            else if (wave >= 4) {
#pragma unroll
                for (int i = 0; i < 8; ++i) t8[i] = fsigmoid(t8[i]); }
            *(bf16x8*)(lds + L_FRAG + wave * 1024 + lane * 16) = pack_frag(t8);
        }
        __syncthreads();
        bf16x8 Aw[2], Aa[2], Ag[4];
#pragma unroll
        for (int s = 0; s < 2; ++s) { Aw[s] = *(const bf16x8*)(lds + L_FRAG + s * 1024 + lane * 16); Aa[s] = *(const bf16x8*)(lds + L_FRAG + (2 + s) * 1024 + lane * 16); }
#pragma unroll
        for (int s = 0; s < 4; ++s) Ag[s] = *(const bf16x8*)(lds + L_FRAG + (4 + s) * 1024 + lane * 16);
        const int h = wave; const size_t m = (size_t)tile * 16 + fr;
        float kkr[16], av[16]; unsigned lk[16], rvp[16];
        float ss = 0.f, brs = 0.f, krs = 0.f, rkbs = 0.f;
#pragma unroll
        for (int n = 0; n < 4; ++n) {
            asm volatile("" ::: "memory");
            const int cb = 64 * h + 16 * n, c0 = cb + 4 * fq;
            f32x4 aw = {0.f, 0.f, 0.f, 0.f}, aa = aw, ag = aw;
#pragma unroll
            for (int s = 0; s < 2; ++s) {
                aw = __builtin_amdgcn_mfma_f32_16x16x32_bf16(*(const bf16x8*)(WLU + (size_t)(cb + fr) * 64 + 32 * s + 8 * fq), Aw[s], aw, 0, 0, 0);
                aa = __builtin_amdgcn_mfma_f32_16x16x32_bf16(*(const bf16x8*)(WLA + (size_t)(cb + fr) * 64 + 32 * s + 8 * fq), Aa[s], aa, 0, 0, 0); }
#pragma unroll
            for (int s = 0; s < 4; ++s)
                ag = __builtin_amdgcn_mfma_f32_16x16x32_bf16(*(const bf16x8*)(WLG + (size_t)(cb + fr) * 128 + 32 * s + 8 * fq), Ag[s], ag, 0, 0, 0);
            float rr[4], kr4[4], vv[4];
            mix4_lds(rcur + c0 * 2, rprv + c0 * 2, par + c0, rr); mix4_lds(rcur + (512 + c0) * 2, rprv + (512 + c0) * 2, par + 512 + c0, kr4); mix4_lds(rcur + (1024 + c0) * 2, rprv + (1024 + c0) * 2, par + 1024 + c0, vv);
            const f32x4 w0v = *(const f32x4*)(par + 1792 + c0), a0v = *(const f32x4*)(par + 2304 + c0), kkv = *(const f32x4*)(par + 2816 + c0), kav = *(const f32x4*)(par + 3328 + c0), rkv = *(const f32x4*)(par + 3840 + c0);
#pragma unroll
            for (int j = 0; j < 4; ++j) {
                const float sg = fsigmoid(w0v[j] + aw[j]);
                const float ldx = -0.60653065971f * 1.44269504089f * sg;
                const float av_ = fsigmoid(a0v[j] + aa[j]);
                const float kkraw = kr4[j] * kkv[j];
                const float k2 = kr4[j] * (1.f + (av_ - 1.f) * kav[j]);
                ss += kkraw * kkraw; brs += kkraw * av_ * rr[j]; krs += k2 * rr[j]; rkbs += rr[j] * k2 * rkv[j];
                kkr[4 * n + j] = kkraw; av[4 * n + j] = av_; lk[4 * n + j] = cvt_pk_bf16(ldx, k2); rvp[4 * n + j] = cvt_pk_bf16(rr[j], vv[j]);
            }
            u32x2 gp; gp.x = cvt_pk_bf16(ag[0], ag[1]); gp.y = cvt_pk_bf16(ag[2], ag[3]);
            *(u32x2*)(GB + m * 512 + c0) = gp;
        }
        ss = red16(ss); brs = red16(brs); krs = red16(krs); rkbs = red16(rkbs);
        const float inv = 1.f / fmaxf(sqrtf(ss), 1e-12f);
        unsigned char* rec = SI + ((m * 8 + h) * 64) * 12;
#pragma unroll
        for (int n = 0; n < 4; ++n) {
            unsigned dw[12];
#pragma unroll
            for (int j = 0; j < 4; ++j) { const float kk = kkr[4 * n + j] * inv;
                const unsigned kp = cvt_pk_bf16(kk * av[4 * n + j], -kk);
                dw[3 * j] = (lk[4 * n + j] & 0xffffu) | (kp & 0xffff0000u); dw[3 * j + 1] = (kp & 0xffffu) | (lk[4 * n + j] & 0xffff0000u); dw[3 * j + 2] = rvp[4 * n + j]; }
            u32x4* dst = (u32x4*)(rec + (16 * n + 4 * fq) * 12);
            u32x4 s0 = {dw[0], dw[1], dw[2], dw[3]}, s1 = {dw[4], dw[5], dw[6], dw[7]}, s2 = {dw[8], dw[9], dw[10], dw[11]};
            dst[0] = s0; dst[1] = s1; dst[2] = s2;
        }
        if (fq == 0) { f32x4 scv = {brs * inv, krs, rkbs, 0.f}; *(f32x4*)(SC + (m * 8 + h) * 4) = scv; }
    }
    __syncthreads();
}

#define MK_FMAC_BC(acc, src, s, n) asm("v_fmac_f32_dpp %0, %1, %2 row_newbcast:" #n " row_mask:0xf bank_mask:0xf" : "+v"(acc) : "v"(src), "v"(s))
#define MK_MUL_BC(dst, src, s, n) asm("v_mul_f32_dpp %0, %1, %2 row_newbcast:" #n " row_mask:0xf bank_mask:0xf" : "=v"(dst) : "v"(src), "v"(s))
#define MK_REP16(X) X(0) X(1) X(2) X(3) X(4) X(5) X(6) X(7) X(8) X(9) X(10) X(11) X(12) X(13) X(14) X(15)
__device__ __forceinline__ float red_rows(float x) {
    float a0 = x, a1 = x;
    asm volatile("s_nop 1\n\tv_permlane16_swap_b32 %0, %1" : "+v"(a0), "+v"(a1));
    float b0 = a0 + a1, b1 = b0;
    asm volatile("s_nop 1\n\tv_permlane32_swap_b32 %0, %1" : "+v"(b0), "+v"(b1));
    return b0 + b1;
}
struct ScanRec { unsigned d0, d1, d2; unsigned short vv; float br, kr; };
__device__ __forceinline__ void scan_load(ScanRec& R, const unsigned char* SI, const float* SC, size_t mh, int lane, int vrow) {
    const unsigned* p = (const unsigned*)(SI + (mh * 64 + lane) * 12);
    R.d0 = p[0]; R.d1 = p[1]; R.d2 = p[2];
    R.vv = *(const unsigned short*)(SI + (mh * 64 + vrow) * 12 + 10);
    const f32x2 s = *(const f32x2*)(SC + mh * 4); R.br = s[0]; R.kr = s[1];
}
__device__ __forceinline__ void scan_wave(const Args& a, int bh, int rb, int lane) {
    const unsigned char* SI = a.ws + O_SI; const float* SC = (const float*)(a.ws + O_SC); unsigned* YR = (unsigned*)(a.ws + O_YR);
    const int b = bh >> 3, h = bh & 7, r = lane & 15, vrow = 16 * rb + r;
    const size_t m0 = (size_t)b * SEQ;
    float S0 = 0.f, S1 = 0.f, S2 = 0.f, S3 = 0.f, S4 = 0.f, S5 = 0.f, S6 = 0.f, S7 = 0.f, S8 = 0.f, S9 = 0.f, S10 = 0.f, S11 = 0.f, S12 = 0.f, S13 = 0.f, S14 = 0.f, S15 = 0.f;
    ScanRec cur[8], nxt[8];
#pragma unroll
    for (int i = 0; i < 8; ++i) scan_load(cur[i], SI, SC, (m0 + i) * 8 + h, lane, vrow);
    for (int t0 = 0; t0 < SEQ; t0 += 8) {
        const int tn = (t0 + 8 < SEQ) ? t0 + 8 : t0;
#pragma unroll
        for (int i = 0; i < 8; ++i) scan_load(nxt[i], SI, SC, (m0 + tn + i) * 8 + h, lane, vrow);
#pragma unroll
        for (int i = 0; i < 8; ++i) {
            float nkk = bf_hi(cur[i].d0), kka = bf_lo(cur[i].d1), k2 = bf_hi(cur[i].d1);
            float w = __builtin_amdgcn_exp2f(bf_lo(cur[i].d0));
            float wr = w * bf_lo(cur[i].d2);
            const float v = __uint_as_float((unsigned)cur[i].vv << 16);
            asm volatile("s_nop 1" : "+v"(nkk), "+v"(kka), "+v"(k2), "+v"(w), "+v"(wr));
            float sa0 = 0.f, sa1 = 0.f, yp0 = 0.f, yp1 = 0.f;
#define MK_MV(n) if ((n) & 1) { MK_FMAC_BC(sa1, nkk, S##n, n); MK_FMAC_BC(yp1, wr, S##n, n); } else { MK_FMAC_BC(sa0, nkk, S##n, n); MK_FMAC_BC(yp0, wr, S##n, n); }
            MK_REP16(MK_MV)
#undef MK_MV
            const float sa = red_rows(sa0 + sa1), yp = red_rows(yp0 + yp1);
            float sav = sa, vv2 = v;
#define MK_UP(n) { MK_MUL_BC(S##n, w, S##n, n); MK_FMAC_BC(S##n, kka, sav, n); MK_FMAC_BC(S##n, k2, vv2, n); }
            MK_REP16(MK_UP)
#undef MK_UP
            const float y = yp + sa * cur[i].br + v * cur[i].kr;
            if (lane < 16) YR[(m0 + t0 + i) * 512 + 64 * h + vrow] = (unsigned)bf1(y) | ((unsigned)cur[i].vv << 16);
        }
#pragma unroll
        for (int i = 0; i < 8; ++i) cur[i] = nxt[i];
    }
}

__device__ __forceinline__ void rwpost_local(const Args& a, int bh, int tid) {
    const float* SC = (const float*)(a.ws + O_SC);
    const unsigned* YR = (const unsigned*)(a.ws + O_YR); const bf16_t* GB = (const bf16_t*)(a.ws + O_G); bf16_t* ORW = (bf16_t*)(a.ws + O_ORW);
    const int b = bh >> 3, h = bh & 7, c = 64 * h + (tid & 15) * 4;
    const f32x4 lwv = *(const f32x4*)(a.in[13] + c), lbv = *(const f32x4*)(a.in[14] + c);
    for (int t0 = tid >> 4; t0 < SEQ; t0 += 64) {
        u32x4 yv[2]; u32x2 gb[2]; float rkb[2]; size_t mm[2];
#pragma unroll
        for (int u = 0; u < 2; ++u) { const size_t m = (size_t)b * SEQ + t0 + 32 * u; mm[u] = m;
            yv[u] = *(const u32x4*)(YR + m * 512 + c); gb[u] = *(const u32x2*)(GB + m * 512 + c); rkb[u] = SC[(m * 8 + h) * 4 + 2]; }
#pragma unroll
        for (int u = 0; u < 2; ++u) {
            float y[4] = {bf_lo(yv[u].x), bf_lo(yv[u].y), bf_lo(yv[u].z), bf_lo(yv[u].w)};
            const float v[4] = {bf_hi(yv[u].x), bf_hi(yv[u].y), bf_hi(yv[u].z), bf_hi(yv[u].w)};
            float s = (y[0] + y[1]) + (y[2] + y[3]);
#pragma unroll
            for (int o = 1; o < 16; o <<= 1) s += __shfl_xor(s, o);
            const float mean = s * (1.f / 64.f);
            float q = 0.f;
#pragma unroll
            for (int j = 0; j < 4; ++j) { y[j] -= mean; q += y[j] * y[j]; }
#pragma unroll
            for (int o = 1; o < 16; o <<= 1) q += __shfl_xor(q, o);
            const float rstd = rsqrtf(q * (1.f / 64.f) + GN_EPS);
            const float g4[4] = {bf_lo(gb[u].x), bf_hi(gb[u].x), bf_lo(gb[u].y), bf_hi(gb[u].y)};
            float o4[4];
#pragma unroll
            for (int j = 0; j < 4; ++j) o4[j] = (y[j] * rstd * lwv[j] + lbv[j] + rkb[u] * v[j]) * g4[j];
            u32x2 ob; ob.x = cvt_pk_bf16(o4[0], o4[1]); ob.y = cvt_pk_bf16(o4[2], o4[3]);
            *(u32x2*)(ORW + mm[u] * 512 + c) = ob;
        }
    }
}

struct KV { bf16x8 k[4]; bf16x8 v[2][2]; };
__device__ __forceinline__ void attn_load(KV& T, const bf16_t* Kh, const bf16_t* Vh, int k0, int n, int hf) {
    const bf16_t* kp = Kh + (size_t)(k0 + n) * 512 + 8 * hf;
#pragma unroll
    for (int s = 0; s < 4; ++s) T.k[s] = *(const bf16x8*)(kp + 16 * s);
#pragma unroll
    for (int d = 0; d < 2; ++d)
#pragma unroll
        for (int sg = 0; sg < 2; ++sg) { const bf16_t* vp = Vh + (size_t)(32 * d + n) * SEQ + k0 + 16 * sg + 4 * hf;
            const u32x2 lo = *(const u32x2*)vp, hi = *(const u32x2*)(vp + 8); u32x4 t = {lo.x, lo.y, hi.x, hi.y}; T.v[d][sg] = __builtin_bit_cast(bf16x8, t); }
}
__device__ __forceinline__ void attn_wave(const Args& a, int bh, int w4, int lane) {
    const int b = bh >> 3, h = bh & 7, n = lane & 31, hf = lane >> 5;
    const size_t m0 = (size_t)b * SEQ;
    const bf16_t* Qh = (const bf16_t*)(a.ws + O_Q) + m0 * 512 + 64 * h;
    const bf16_t* Kh = (const bf16_t*)(a.ws + O_K) + m0 * 512 + 64 * h;
    const bf16_t* Vh = (const bf16_t*)(a.ws + O_VT) + (size_t)bh * 64 * SEQ;
    bf16_t* Oh = (bf16_t*)(a.ws + O_OSB) + m0 * 512 + 64 * h;
    for (int qt = 63 - w4; qt >= 0; qt -= 4) {
        const int q0 = 32 * qt;
        bf16x8 qf[4];
#pragma unroll
        for (int s = 0; s < 4; ++s) qf[s] = *(const bf16x8*)(Qh + (size_t)(q0 + n) * 512 + 16 * s + 8 * hf);
        f32x16 o0, o1;
#pragma unroll
        for (int i = 0; i < 16; ++i) { o0[i] = 0.f; o1[i] = 0.f; }
        float carry = 0.f;
        KV cur, nxt;
        attn_load(cur, Kh, Vh, q0, n, hf);
        for (int kt = qt; kt >= 0; --kt) {
            const int ktn = kt > 0 ? kt - 1 : 0;
            attn_load(nxt, Kh, Vh, 32 * ktn, n, hf);
            f32x16 sc;
#pragma unroll
            for (int i = 0; i < 16; ++i) sc[i] = 0.f;
#pragma unroll
            for (int s = 0; s < 4; ++s) sc = __builtin_amdgcn_mfma_f32_32x32x16_bf16(cur.k[s], qf[s], sc, 0, 0, 0);
            const bool diag = (kt == qt);
            float lf[16], G4[4];
#pragma unroll
            for (int g = 0; g < 4; ++g) { G4[g] = 0.f;
#pragma unroll
                for (int i = 0; i < 4; ++i) { const int r = 4 * g + i; const float z = sc[r];
                    const bool valid = !diag || (8 * g + 4 * hf + i < n);
                    const float e = fexp(-fabsf(z));
                    const float sp = fmaxf(z, 0.f) + flog(1.f + e);
                    lf[r] = valid ? -sp : 0.f; G4[g] += lf[r]; } }
            float PG[4], T4[4];
#pragma unroll
            for (int g = 0; g < 4; ++g) { PG[g] = __shfl_xor(G4[g], 32); T4[g] = G4[g] + PG[g]; }
            const float tail3 = 0.f, tail2 = T4[3], tail1 = T4[3] + T4[2], tail0 = tail1 + T4[1], total = tail0 + T4[0];
            const float tails[4] = {tail0, tail1, tail2, tail3};
            f32x16 wv;
#pragma unroll
            for (int g = 0; g < 4; ++g) {
                float af = carry + tails[g] + (hf == 0 ? PG[g] : 0.f);
#pragma unroll
                for (int i = 3; i >= 0; --i) { const int r = 4 * g + i; const float z = sc[r];
                    const bool valid = !diag || (8 * g + 4 * hf + i < n);
                    const float wgt = fexp(lf[r] + z + af);
                    wv[r] = valid ? wgt : 0.f;
                    af += lf[r]; } }
            carry += total;
            bf16x8 wf[2];
#pragma unroll
            for (int sg = 0; sg < 2; ++sg) { u32x4 t; t.x = cvt_pk_bf16(wv[8 * sg + 0], wv[8 * sg + 1]); t.y = cvt_pk_bf16(wv[8 * sg + 2], wv[8 * sg + 3]); t.z = cvt_pk_bf16(wv[8 * sg + 4], wv[8 * sg + 5]); t.w = cvt_pk_bf16(wv[8 * sg + 6], wv[8 * sg + 7]); wf[sg] = __builtin_bit_cast(bf16x8, t); }
#pragma unroll
            for (int sg = 0; sg < 2; ++sg) { o0 = __builtin_amdgcn_mfma_f32_32x32x16_bf16(cur.v[0][sg], wf[sg], o0, 0, 0, 0); o1 = __builtin_amdgcn_mfma_f32_32x32x16_bf16(cur.v[1][sg], wf[sg], o1, 0, 0, 0); }
            cur = nxt;
#if MK_EARLY_EXIT
            if (__all(carry < -104.f)) break;
#endif
        }
        bf16_t* op = Oh + (size_t)(q0 + n) * 512 + 4 * hf;
#pragma unroll
        for (int g = 0; g < 4; ++g) {
            u32x2 t0, t1; t0.x = cvt_pk_bf16(o0[4 * g], o0[4 * g + 1]); t0.y = cvt_pk_bf16(o0[4 * g + 2], o0[4 * g + 3]); t1.x = cvt_pk_bf16(o1[4 * g], o1[4 * g + 1]); t1.y = cvt_pk_bf16(o1[4 * g + 2], o1[4 * g + 3]);
            *(u32x2*)(op + 8 * g) = t0; *(u32x2*)(op + 32 + 8 * g) = t1; }
    }
}
__device__ __forceinline__ void phase_mixer(const Args& a, int G) {
    const int tid = my_tid(); const int wave = __builtin_amdgcn_readfirstlane(tid >> 6), lane = tid & 63;
    for (int bh = blockIdx.x; bh < NB * NH; bh += G) {
        if (wave < 4) scan_wave(a, bh, wave, lane);
        else attn_wave(a, bh, wave - 4, lane);
        __threadfence_block(); __syncthreads();
        rwpost_local(a, bh, my_tid());
    }
}

template <int MODE> __device__ __forceinline__ void phase_rows(const Args& a, int G) {
    const int tid = my_tid(); const int wave = tid >> 6, lane = tid & 63;
    const int gw = blockIdx.x * 8 + wave, NGW = G * 8;
    const bf16_t* T = (const bf16_t*)(a.ws + (MODE == 0 ? O_TT : O_FF));
    const float* xin = MODE == 0 ? a.in[0] : a.out; const float* g1 = MODE == 0 ? a.in[18] : a.in[23]; const float* g2 = a.in[19];
    bf16_t* H2 = (bf16_t*)(a.ws + O_H2);
    f32x4 g1v[4], g2v[4];
#pragma unroll
    for (int j = 0; j < 4; ++j) { g1v[j] = ((const f32x4*)g1)[lane + 64 * j]; g2v[j] = ((const f32x4*)g2)[lane + 64 * j]; }
    for (int row0 = gw; row0 < M; row0 += 2 * NGW) {
        u32x2 tb[2][4]; f32x4 x[2][4];
#pragma unroll
        for (int u = 0; u < 2; ++u) { const int row = (row0 + u * NGW < M) ? row0 + u * NGW : row0;
            const u32x2* tr = (const u32x2*)(T + (size_t)row * D) + lane; const f32x4* xr = (const f32x4*)(xin + (size_t)row * D) + lane;
#pragma unroll
            for (int j = 0; j < 4; ++j) { tb[u][j] = tr[64 * j]; x[u][j] = xr[64 * j]; } }
#pragma unroll
        for (int u = 0; u < 2; ++u) {
            const int row = row0 + u * NGW;
            f32x4 t[4]; float s = 0.f;
#pragma unroll
            for (int j = 0; j < 4; ++j) { t[j][0] = bf_lo(tb[u][j].x); t[j][1] = bf_hi(tb[u][j].x); t[j][2] = bf_lo(tb[u][j].y); t[j][3] = bf_hi(tb[u][j].y);
                s += (t[j][0] * t[j][0] + t[j][1] * t[j][1]) + (t[j][2] * t[j][2] + t[j][3] * t[j][3]); }
            const float rs = rsqrtf(wave_sum(s) * (1.f / D) + RMS_EPS);
            float s2 = 0.f;
#pragma unroll
            for (int j = 0; j < 4; ++j)
#pragma unroll
                for (int e = 0; e < 4; ++e) { x[u][j][e] += t[j][e] * rs * g1v[j][e]; s2 += x[u][j][e] * x[u][j][e]; }
            float rs2 = 0.f;
            if (MODE == 0) rs2 = rsqrtf(wave_sum(s2) * (1.f / D) + RMS_EPS);
            if (row < M) {
                f32x4* orow = (f32x4*)(a.out + (size_t)row * D) + lane;
#pragma unroll
                for (int j = 0; j < 4; ++j) orow[64 * j] = x[u][j];
                if (MODE == 0) {
                    u32x2* o = (u32x2*)(H2 + (size_t)row * D) + lane;
#pragma unroll
                    for (int j = 0; j < 4; ++j) { u32x2 w; w.x = cvt_pk_bf16(x[u][j][0] * rs2 * g2v[j][0], x[u][j][1] * rs2 * g2v[j][1]); w.y = cvt_pk_bf16(x[u][j][2] * rs2 * g2v[j][2], x[u][j][3] * rs2 * g2v[j][3]); o[64 * j] = w; }
                }
            }
        }
    }
}

__global__ void __launch_bounds__(512, 2) mega(Args a) {
    extern __shared__ __attribute__((aligned(16))) unsigned char shm[];
    PG8_LAS unsigned char* lds = (PG8_LAS unsigned char*)shm;
    const int G = (int)gridDim.x;
    unsigned char* ws = a.ws;
    const int nsteps = (MK_REPMASK != 0) ? 2 * NPH : a.ph_hi;
    for (int st = a.ph_lo; st < nsteps; ++st) {
        int ph = st;
        if (MK_REPMASK != 0) { ph = st >> 1; if ((st & 1) && !((MK_REPMASK >> ph) & 1)) continue; }
        if (st > a.ph_lo && ph != 4 && ph != 6) cg::this_grid().sync();
        switch (ph) {
        case 0: phase_prep(a, (float*)shm, G); break;
        case 1: { Epi1 E; E.Q = (bf16_t*)(ws + O_Q); E.Kb = (bf16_t*)(ws + O_K); E.Vt = (bf16_t*)(ws + O_VT); E.Prw = (bf16_t*)(ws + O_PRW); E.Gt = (bf16_t*)a.out; E.bgate = a.in[3];
            run_gemm(lds, (const bf16_t*)(ws + O_H), (const bf16_t*)(ws + O_WIN), INC, 1024, E, G); } break;
        case 2: phase_rwprep(a, shm, G); break;
        case 3: phase_mixer(a, G); break;
        case 4: break;
        case 5: { EpiRow<1> E; E.O = (bf16_t*)(ws + O_T1); E.T1 = nullptr; E.Gt = (const bf16_t*)a.out;
            run_gemm(lds, (const bf16_t*)(ws + O_OSB), (const bf16_t*)(ws + O_WSB), 1024, 512, E, G); } break;
        case 6: { EpiRow<2> E; E.O = (bf16_t*)(ws + O_MRG); E.T1 = (const bf16_t*)(ws + O_T1); E.Gt = (const bf16_t*)a.out;
            run_gemm(lds, (const bf16_t*)(ws + O_ORW), (const bf16_t*)(ws + O_WRW), 1024, 512, E, G); } break;
        case 7: { EpiRow<0> E; E.O = (bf16_t*)(ws + O_TT); E.T1 = nullptr; E.Gt = nullptr;
            run_gemm(lds, (const bf16_t*)(ws + O_MRG), (const bf16_t*)(ws + O_WO), 1024, 1024, E, G); } break;
        case 8: phase_rows<0>(a, G); break;
        case 9: { EpiSwiGLU E; E.Hd = (bf16_t*)(ws + O_HID);
            run_gemm(lds, (const bf16_t*)(ws + O_H2), (const bf16_t*)(ws + O_WGU), 2 * DFF, 1024, E, G); } break;
        case 10: { EpiRow<0> E; E.O = (bf16_t*)(ws + O_FF); E.T1 = nullptr; E.Gt = nullptr;
            run_gemm(lds, (const bf16_t*)(ws + O_HID), (const bf16_t*)(ws + O_WDN), 1024, DFF, E, G); } break;
        case 11: phase_rows<1>(a, G); break;
        }
    }
}
}

extern "C" void kernel_launch(void* const* d_in, const int* in_sizes, int n_in, void* d_out, int out_size, void* d_ws, size_t ws_size, hipStream_t stream) {
    static int grid = 0;
    if (grid == 0) {
        if (n_in != 24 || in_sizes[0] != mk::M * mk::D || out_size != mk::M * mk::D || ws_size < mk::WS_NEED) {
            fprintf(stderr, "kernel_launch: unexpected shapes: n_in %d in0 %d out %d ws %zu (need %zu)\n", n_in, n_in > 0 ? in_sizes[0] : -1, out_size, ws_size, (size_t)mk::WS_NEED); grid = -1; return; }
        int dev = 0, cus = 0, per_cu = 0;
        hipGetDevice(&dev); hipDeviceGetAttribute(&cus, hipDeviceAttributeMultiprocessorCount, dev);
        if (hipFuncSetAttribute((const void*)mk::mega, hipFuncAttributeMaxDynamicSharedMemorySize, mk::LDS_BYTES) != hipSuccess) { fprintf(stderr, "kernel_launch: hipFuncSetAttribute failed\n"); grid = -1; return; }
        if (hipOccupancyMaxActiveBlocksPerMultiprocessor(&per_cu, (const void*)mk::mega, 512, mk::LDS_BYTES) != hipSuccess || per_cu < 1) { fprintf(stderr, "kernel_launch: occupancy query failed (%d)\n", per_cu); per_cu = 1; }
        (void)hipGetLastError();
        grid = cus * per_cu;
        fprintf(stderr, "kernel_launch: grid %d (cus %d x %d)\n", grid, cus, per_cu);
    }
    if (grid < 0) return;
    mk::Args a{};
    for (int i = 0; i < 24; ++i) a.in[i] = (const float*)d_in[i];
    a.out = (float*)d_out; a.ws = (unsigned char*)d_ws;
#if MK_SPLIT
    for (int ph = 0; ph < mk::NPH; ++ph) { a.ph_lo = ph; a.ph_hi = ph + 1; hipLaunchKernelGGL(mk::mega, dim3(grid), dim3(512), mk::LDS_BYTES, stream, a);
    }
#else
    a.ph_lo = 0; a.ph_hi = mk::NPH;
    void* args[] = {&a};
    hipError_t e = hipLaunchCooperativeKernel((const void*)mk::mega, dim3(grid), dim3(512), args, mk::LDS_BYTES, stream);
    if (e != hipSuccess) fprintf(stderr, "kernel_launch: cooperative launch failed: %s (grid %d)\n", hipGetErrorString(e), grid);
#endif
}
```

```cpp
#include <hip/hip_runtime.h>
#include <hip/hip_cooperative_groups.h>
#include <cstdio>
#include <cstdint>
namespace cg = cooperative_groups;
#ifndef MK_SPLIT
#define MK_SPLIT 0
#endif
#ifndef MK_DIAG
#define MK_DIAG 0
#endif
#ifndef MK_REPMASK
#define MK_REPMASK 0
#endif
#ifndef MK_EARLY_EXIT
#define MK_EARLY_EXIT 1
#endif
namespace pg8 {
#define PG8_LAS __attribute__((address_space(3)))
typedef unsigned short bf16_t;
typedef short bf16x8 __attribute__((ext_vector_type(8)));
typedef float f32x4 __attribute__((ext_vector_type(4)));
typedef unsigned u32x4 __attribute__((ext_vector_type(4)));
constexpr int BM = 256, BK = 64, HALF = 128, HTB = HALF * BK * 2  , STAGE_BYTES = 8 * HTB, NXCD = 8, WGM = 8;

__host__ __device__ __forceinline__ int lds_byte(int r, int c) { const int st = (r >> 4) * 2 + (c >> 5), rr = r & 15, cc = c & 31, ob = rr * 64 + cc * 2; return st * 1024 + (ob ^ (((ob >> 9) & 1) << 5)); }
__host__ __device__ __forceinline__ void stage_rc(int b, int& R, int& C) { const int st = b / 1024, sb = b % 1024, swz = sb ^ (((sb >> 9) & 1) << 5); R = (st >> 1) * 16 + swz / 64; C = (st & 1) * 32 + (swz % 64) / 2; }
__host__ __device__ __forceinline__ int perm32(int rho) { const int n = rho >> 4, i = rho & 15; return 8 * (i >> 2) + 4 * n + (i & 3); }

struct Unit { int pm, pn; };
struct Gemm { const bf16_t* A; const bf16_t* Bt; int M, N, K; };

struct StaticOrder {
    int nM, nN, nwg, G, c;
    __host__ __device__ void init(int M, int N, int G_, int c_) { nM = M / BM; nN = N / BM; nwg = nM * nN; G = G_; c = c_; }
    __host__ __device__ bool next(int i, Unit& u) const {
        const long L = (long)i * G + c; if (L >= nwg) return false;
        int wgid = (int)L; { const int q = nwg / NXCD, r = nwg % NXCD, xcd = wgid % NXCD, off = wgid / NXCD; wgid = (xcd < r ? xcd * (q + 1) : r * (q + 1) + (xcd - r) * q) + off; }
        const int nig = WGM * nN, gid = wgid / nig, fm = gid * WGM, gsz = (nM - fm) < WGM ? (nM - fm) : WGM;
        u.pm = fm + ((wgid % nig) % gsz); u.pn = (wgid % nig) / gsz; return true;
    }
    __device__ __forceinline__ void a_ready(const Unit&) const {}
    __device__ __forceinline__ void done(const Unit&) const {}
};

__device__ __forceinline__ unsigned cvt_pk_bf16(float lo, float hi) { unsigned r; asm volatile("v_cvt_pk_bf16_f32 %0, %1, %2" : "=v"(r) : "v"(lo), "v"(hi)); return r; }
typedef float f32x2 __attribute__((ext_vector_type(2)));

template <class Epi, class Sched, bool STAMP = false>
__device__ __forceinline__ void gemm_phase(PG8_LAS unsigned char* lds, const Gemm g, const Sched& S, const Epi& E, unsigned long long* stamps) {
    int tid_ = threadIdx.x; asm volatile("" : "+v"(tid_)); const int tid = tid_, wid = __builtin_amdgcn_readfirstlane(tid >> 6), lane = tid & 63, wr = wid >> 2, wc = wid & 3, fr = lane & 15, fq = lane >> 4;
    const int K = g.K, nt = K / BK;
    int ts_lo = 0, ts_hi = 0, nts = 0; const unsigned long long rt_entry = STAMP ? (unsigned long long)wall_clock64() : 0ull;
#define PG8_STAMP() do { if (STAMP && wid == 0 && nts < 64) { const unsigned long long _c = (unsigned long long)clock64(); \
        ts_lo = (lane == nts) ? (int)(unsigned)_c : ts_lo; ts_hi = (lane == nts) ? (int)(unsigned)(_c >> 32) : ts_hi; ++nts; } } while (0)
    PG8_STAMP();
    unsigned voffA[2], voffB[2];
#pragma unroll
    for (int i = 0; i < 2; ++i) { int R, C; stage_rc(tid * 16 + i * 8192, R, C); const int Rb = Epi::PERM ? ((R & ~31) + perm32(R & 31)) : R;
        voffA[i] = (unsigned)(R * K + C) * 2u; voffB[i] = (unsigned)(Rb * K + C) * 2u; }
    const size_t kstep = (size_t)(BK * 2);
    const size_t hstep = (size_t)HALF * K * 2;
    const size_t tstep = 2 * hstep;
    const unsigned ldsw = (unsigned)wid * 1024u;
    const int aoff = lds_byte(wr * 64 + fr, fq * 8), boff = lds_byte(wc * 32 + fr, fq * 8);
#define PG8_SA(b, h) (((b) * 2 + (h)) * HTB)
#define PG8_SB(b, h) ((4 + (b) * 2 + (h)) * HTB)
#define PG8_STAGE(bufoff, gbase, voff) do { _Pragma("unroll") for (int _i = 0; _i < 2; ++_i) \
        __builtin_amdgcn_global_load_lds((const unsigned*)((const char*)(gbase) + (voff)[_i]), (PG8_LAS unsigned*)(lds + (bufoff) + ldsw + _i * 8192), 16, 0, 0); } while (0)
#define PG8_LDA(dst, b, h) do { _Pragma("unroll") for (int m = 0; m < 4; ++m) _Pragma("unroll") for (int k = 0; k < 2; ++k) dst[m][k] = *(const PG8_LAS bf16x8*)(lds + PG8_SA(b, h) + aoff + m * 2048 + k * 1024); } while (0)
#define PG8_LDB(dst, b, h) do { _Pragma("unroll") for (int n = 0; n < 2; ++n) _Pragma("unroll") for (int k = 0; k < 2; ++k) dst[n][k] = *(const PG8_LAS bf16x8*)(lds + PG8_SB(b, h) + boff + n * 2048 + k * 1024); } while (0)
#define PG8_MMA(ai, bj, At, Bt) do { __builtin_amdgcn_s_setprio(1); _Pragma("unroll") for (int m = 0; m < 4; ++m) _Pragma("unroll") for (int n = 0; n < 2; ++n) _Pragma("unroll") for (int k = 0; k < 2; ++k) \
        acc[ai][bj][m][n] = __builtin_amdgcn_mfma_f32_16x16x32_bf16(Bt[n][k], At[m][k], acc[ai][bj][m][n], 0, 0, 0); __builtin_amdgcn_s_setprio(0); } while (0)
#define PG8_WAIT_V(n) asm volatile("s_waitcnt vmcnt(" #n ")" ::: "memory")
#define PG8_WAIT_L(n) asm volatile("s_waitcnt lgkmcnt(" #n ")" ::: "memory")
#define PG8_BAR __builtin_amdgcn_s_barrier()
#define PG8_SCHED __builtin_amdgcn_sched_barrier(0)
    Unit cur, nxt; int ui = 0;
    if (!S.next(0, cur)) return;
    f32x4 acc[2][2][4][2];
#pragma unroll
    for (int a = 0; a < 2; ++a)
#pragma unroll
        for (int b = 0; b < 2; ++b)
#pragma unroll
            for (int m = 0; m < 4; ++m)
#pragma unroll
                for (int n = 0; n < 2; ++n) acc[a][b][m][n] = (f32x4){0.f, 0.f, 0.f, 0.f};
    bf16x8 At[4][2], B0[2][2], B1[2][2];
    const char* cA = (const char*)g.A + (size_t)cur.pm * tstep; const char* cB = (const char*)g.Bt + (size_t)cur.pn * tstep;
    S.a_ready(cur);
    PG8_STAGE(PG8_SB(0, 0), cB, voffB); PG8_STAGE(PG8_SA(0, 0), cA, voffA); PG8_STAGE(PG8_SB(0, 1), cB + hstep, voffB); PG8_STAGE(PG8_SA(0, 1), cA + hstep, voffA);
    if (wr == 1) PG8_BAR;
    PG8_WAIT_V(4); PG8_BAR;
    PG8_STAGE(PG8_SB(1, 0), cB + kstep, voffB); PG8_STAGE(PG8_SA(1, 0), cA + kstep, voffA); PG8_STAGE(PG8_SB(1, 1), cB + hstep + kstep, voffB);
    PG8_WAIT_V(6); PG8_BAR;
    PG8_STAMP();
    for (;;) {
        const bool has_next = S.next(ui + 1, nxt);
        const char* nA = has_next ? (const char*)g.A + (size_t)nxt.pm * tstep : cA; const char* nB = has_next ? (const char*)g.Bt + (size_t)nxt.pn * tstep : cB;
        for (int t = 0; t < nt; t += 2) {
            const bool last = (t == nt - 2);
            const char* a1 = cA + (size_t)(t + 1) * kstep;
            const char* a2 = last ? nA : cA + (size_t)(t + 2) * kstep; const char* b2 = last ? nB : cB + (size_t)(t + 2) * kstep;
            const char* a3 = a2 + kstep; const char* b3 = b2 + kstep;
            if (last && has_next) S.a_ready(nxt);
            PG8_LDB(B0, 0, 0); PG8_SCHED; PG8_LDA(At, 0, 0); PG8_STAGE(PG8_SA(1, 1), a1 + hstep, voffA);
            PG8_WAIT_L(8); PG8_BAR; PG8_WAIT_L(0); PG8_MMA(0, 0, At, B0); PG8_BAR; PG8_SCHED;
            PG8_LDB(B1, 0, 1); PG8_STAGE(PG8_SB(0, 0), b2, voffB);
            PG8_BAR; PG8_WAIT_L(0); PG8_MMA(0, 1, At, B1); PG8_BAR;
            PG8_LDA(At, 0, 1); PG8_STAGE(PG8_SA(0, 0), a2, voffA);
            PG8_BAR; PG8_WAIT_L(0); PG8_MMA(1, 0, At, B0); PG8_BAR; PG8_SCHED;
            PG8_STAGE(PG8_SB(0, 1), b2 + hstep, voffB);
            PG8_WAIT_V(6); PG8_BAR; PG8_MMA(1, 1, At, B1); PG8_BAR;
            PG8_LDB(B0, 1, 0); PG8_SCHED; PG8_LDA(At, 1, 0); PG8_STAGE(PG8_SA(0, 1), a2 + hstep, voffA);
            PG8_WAIT_L(8); PG8_BAR; PG8_WAIT_L(0); PG8_MMA(0, 0, At, B0); PG8_BAR; PG8_SCHED;
            PG8_LDB(B1, 1, 1); PG8_STAGE(PG8_SB(1, 0), b3, voffB);
            PG8_BAR; PG8_WAIT_L(0); PG8_MMA(0, 1, At, B1); PG8_BAR;
            PG8_LDA(At, 1, 1); PG8_STAGE(PG8_SA(1, 0), a3, voffA);
            PG8_BAR; PG8_WAIT_L(0); PG8_MMA(1, 0, At, B0); PG8_BAR; PG8_SCHED;
            PG8_STAGE(PG8_SB(1, 1), b3 + hstep, voffB);
            PG8_WAIT_V(6); PG8_BAR; PG8_MMA(1, 1, At, B1); PG8_BAR;
        }
        PG8_STAMP();
        if constexpr (!Epi::AFTER_DRAIN) { E(acc, cur, wr, wc, fr, fq); S.done(cur); }
        PG8_STAMP();
        if (!has_next) break;
#pragma unroll
        for (int a = 0; a < 2; ++a)
#pragma unroll
            for (int b = 0; b < 2; ++b)
#pragma unroll
                for (int m = 0; m < 4; ++m)
#pragma unroll
                    for (int n = 0; n < 2; ++n) acc[a][b][m][n] = (f32x4){0.f, 0.f, 0.f, 0.f};
        cur = nxt; cA = nA; cB = nB; ++ui;
    }
    PG8_WAIT_V(0);
    if (wr == 0) PG8_BAR;
    PG8_BAR;
    if constexpr (Epi::AFTER_DRAIN) { E.fused(acc, cur, wr, wc, fr, fq, lds, wid, lane); S.done(cur); }
    PG8_STAMP();
    if (STAMP && wid == 0) { stamps[lane] = lane < nts ? (((unsigned long long)(unsigned)ts_hi << 32) | (unsigned)ts_lo) : 0ull;
        if (lane == 62) stamps[62] = rt_entry; if (lane == 63) stamps[63] = (unsigned long long)wall_clock64(); }
#undef PG8_STAMP
#undef PG8_SA
#undef PG8_SB
#undef PG8_STAGE
#undef PG8_LDA
#undef PG8_LDB
#undef PG8_MMA
#undef PG8_WAIT_V
#undef PG8_WAIT_L
#undef PG8_BAR
#undef PG8_SCHED
}
}
namespace mk {
using pg8::bf16_t; using pg8::bf16x8; using pg8::f32x4; using pg8::u32x4; using pg8::cvt_pk_bf16;
typedef float f32x16 __attribute__((ext_vector_type(16)));
typedef float f32x2 __attribute__((ext_vector_type(2)));
typedef unsigned u32x2 __attribute__((ext_vector_type(2)));
constexpr int D = 1024, NB = 32, SEQ = 2048, M = NB * SEQ, NH = 8, DH = 64;
constexpr int RWC = 1792, GC = 2048, INC = 5376, DFF = 2816;
constexpr float RMS_EPS = 1e-6f, GN_EPS = 64e-5f;
constexpr size_t MiB = (size_t)1 << 20;
constexpr size_t O_WIN = 0, O_WSB = 11 * MiB, O_WRW = 12 * MiB, O_WO = 13 * MiB, O_WGU = 15 * MiB, O_WDN = 26 * MiB, O_WLU = 32 * MiB  , O_WLA = O_WLU + 65536, O_WLG = O_WLA + 65536;
constexpr size_t O_Q = 34 * MiB, O_K = 98 * MiB, O_VT = 162 * MiB, O_PRW = 226 * MiB, O_H = 450 * MiB, O_SI = 450 * MiB, O_G = 834 * MiB, O_SC = 898 * MiB, O_YR = 290 * MiB  ;
constexpr size_t O_OSB = 226 * MiB, O_ORW = 34 * MiB, O_T1 = 98 * MiB, O_MRG = 450 * MiB, O_TT = 34 * MiB, O_H2 = 162 * MiB, O_HID = 290 * MiB, O_FF = 34 * MiB;
constexpr size_t WS_NEED = 906 * MiB;
constexpr int LDS_BYTES = pg8::STAGE_BYTES;
constexpr int NPH = 12;

struct Args { const float* in[24]; float* out; unsigned char* ws; int ph_lo, ph_hi; };

__device__ __forceinline__ int my_tid() { int t = threadIdx.x; asm volatile("" : "+v"(t)); return t; }
__device__ __forceinline__ float bf_lo(unsigned u) { return __uint_as_float(u << 16); }
__device__ __forceinline__ float bf_hi(unsigned u) { return __uint_as_float(u & 0xffff0000u); }
__device__ __forceinline__ float fexp(float x) { return __builtin_amdgcn_exp2f(x * 1.44269504089f); }
__device__ __forceinline__ float flog(float x) { return __builtin_amdgcn_logf(x) * 0.69314718056f; }
__device__ __forceinline__ float frcp(float x) { return __builtin_amdgcn_rcpf(x); }
__device__ __forceinline__ float fsigmoid(float x) { return frcp(1.f + fexp(-x)); }
__device__ __forceinline__ unsigned short bf1(float x) { return (unsigned short)(cvt_pk_bf16(x, x) & 0xffffu); }
__device__ __forceinline__ u32x4 pack8(const f32x4 a, const f32x4 b) { u32x4 o; o.x = cvt_pk_bf16(a[0], a[1]); o.y = cvt_pk_bf16(a[2], a[3]); o.z = cvt_pk_bf16(b[0], b[1]); o.w = cvt_pk_bf16(b[2], b[3]); return o; }
__device__ __forceinline__ float red16(float v) {
    v += __shfl_xor(v, 16); v += __shfl_xor(v, 32); return v;
}
__device__ __forceinline__ float wave_sum(float v) {
#pragma unroll
    for (int o = 1; o < 64; o <<= 1) v += __shfl_xor(v, o);
    return v;
}

__device__ __forceinline__ void tr_item(const float* __restrict__ W, int K, int N, bf16_t* WT, float* scr, int item, int lane, int mode) {
    const int nblk = N >> 5, kb = item / nblk, nb = item - kb * nblk, k0 = kb << 6, n0 = nb << 5;
#pragma unroll 8
    for (int i = 0; i < 32; ++i) { const int kk = 2 * i + (lane >> 5); scr[kk * 33 + (lane & 31)] = W[(size_t)(k0 + kk) * N + n0 + (lane & 31)]; }
    asm volatile("s_waitcnt lgkmcnt(0)" ::: "memory"); __builtin_amdgcn_wave_barrier();
    const int c = lane & 7;
#pragma unroll
    for (int j = 0; j < 4; ++j) {
        const int n = (lane >> 3) + 8 * j; const float* s = scr + (8 * c) * 33 + n;
        u32x4 o; o.x = cvt_pk_bf16(s[0 * 33], s[1 * 33]); o.y = cvt_pk_bf16(s[2 * 33], s[3 * 33]); o.z = cvt_pk_bf16(s[4 * 33], s[5 * 33]); o.w = cvt_pk_bf16(s[6 * 33], s[7 * 33]);
        const int nn = n0 + n; int drow = nn;
        if (mode == 1) drow = ((nn >> 7) << 8) + (nn & 127); else if (mode == 2) drow = ((nn >> 7) << 8) + 128 + (nn & 127);
        *(u32x4*)(WT + (size_t)drow * K + k0 + 8 * c) = o;
    }
    asm volatile("s_waitcnt lgkmcnt(0)" ::: "memory"); __builtin_amdgcn_wave_barrier();
}

__device__ __forceinline__ void phase_prep(const Args& a, float* lds_f, int G) {
    const int tid = my_tid(); const int wave = tid >> 6, lane = tid & 63;
    const int gw = blockIdx.x * 8 + wave, NGW = G * 8;
    float* scr = lds_f + wave * (64 * 33 + 16);
    unsigned char* ws = a.ws;
    constexpr int I_IN = 16 * 168, I_SB = 8 * 32, I_O = 16 * 32, I_G = 16 * 88, I_DN = 44 * 32, I_LU = 16, I_LG = 32;
    constexpr int NIT = I_IN + 2 * I_SB + I_O + 2 * I_G + I_DN + 2 * I_LU + I_LG;
    for (int it = gw; it < NIT; it += NGW) {
        int r = it;
        if (r < I_IN) { tr_item(a.in[2], 1024, INC, (bf16_t*)(ws + O_WIN), scr, r, lane, 0); continue; } r -= I_IN;
        if (r < I_SB) { tr_item(a.in[15], 512, 1024, (bf16_t*)(ws + O_WSB), scr, r, lane, 0); continue; } r -= I_SB;
        if (r < I_SB) { tr_item(a.in[16], 512, 1024, (bf16_t*)(ws + O_WRW), scr, r, lane, 0); continue; } r -= I_SB;
        if (r < I_O) { tr_item(a.in[17], 1024, 1024, (bf16_t*)(ws + O_WO), scr, r, lane, 0); continue; } r -= I_O;
        if (r < I_G) { tr_item(a.in[20], 1024, DFF, (bf16_t*)(ws + O_WGU), scr, r, lane, 1); continue; } r -= I_G;
        if (r < I_G) { tr_item(a.in[21], 1024, DFF, (bf16_t*)(ws + O_WGU), scr, r, lane, 2); continue; } r -= I_G;
        if (r < I_DN) { tr_item(a.in[22], DFF, 1024, (bf16_t*)(ws + O_WDN), scr, r, lane, 0); continue; } r -= I_DN;
        if (r < I_LU) { tr_item(a.in[6], 64, 512, (bf16_t*)(ws + O_WLU), scr, r, lane, 0); continue; } r -= I_LU;
        if (r < I_LU) { tr_item(a.in[8], 64, 512, (bf16_t*)(ws + O_WLA), scr, r, lane, 0); continue; } r -= I_LU;
        tr_item(a.in[9], 128, 512, (bf16_t*)(ws + O_WLG), scr, r, lane, 0);
    }
    const float* x = a.in[0]; const float* g = a.in[1]; bf16_t* H = (bf16_t*)(ws + O_H);
    f32x4 gv[4];
#pragma unroll
    for (int j = 0; j < 4; ++j) gv[j] = ((const f32x4*)g)[lane + 64 * j];
    for (int row0 = gw; row0 < M; row0 += 2 * NGW) {
        f32x4 v[2][4];
#pragma unroll
        for (int u = 0; u < 2; ++u) { const int row = (row0 + u * NGW < M) ? row0 + u * NGW : row0; const f32x4* xr = (const f32x4*)(x + (size_t)row * D) + lane;
#pragma unroll
            for (int j = 0; j < 4; ++j) v[u][j] = xr[64 * j]; }
#pragma unroll
        for (int u = 0; u < 2; ++u) { const int row = row0 + u * NGW; float s = 0.f;
#pragma unroll
            for (int j = 0; j < 4; ++j) s += (v[u][j][0] * v[u][j][0] + v[u][j][1] * v[u][j][1]) + (v[u][j][2] * v[u][j][2] + v[u][j][3] * v[u][j][3]);
            const float rs = rsqrtf(wave_sum(s) * (1.f / D) + RMS_EPS);
            if (row < M) { u32x2* o = (u32x2*)(H + (size_t)row * D) + lane;
#pragma unroll
                for (int j = 0; j < 4; ++j) { u32x2 w; w.x = cvt_pk_bf16(v[u][j][0] * rs * gv[j][0], v[u][j][1] * rs * gv[j][1]); w.y = cvt_pk_bf16(v[u][j][2] * rs * gv[j][2], v[u][j][3] * rs * gv[j][3]); o[64 * j] = w; } }
        }
    }
}

struct Epi1 {
    static constexpr bool PERM = true, AFTER_DRAIN = false;
    bf16_t *Q, *Kb, *Vt, *Prw, *Gt; const float* bgate;
    __device__ __forceinline__ void operator()(const f32x4 (&acc)[2][2][4][2], const pg8::Unit& u, int wr, int wc, int fr, int fq) const {
        const int row0 = u.pm * 256 + wr * 64 + fr, pn = u.pn, cl = wc * 32 + 8 * fq;
        if (pn < 4) {
            bf16_t* dst = pn < 2 ? Q : Kb; const float sc = pn < 2 ? 0.125f : 1.f; const int cb = (pn & 1) * 256 + cl;
#pragma unroll
            for (int ai = 0; ai < 2; ++ai)
#pragma unroll
                for (int m = 0; m < 4; ++m) { bf16_t* rp = dst + (size_t)(row0 + ai * 128 + m * 16) * 512 + cb;
#pragma unroll
                    for (int bj = 0; bj < 2; ++bj) *(u32x4*)(rp + bj * 128) = pack8(acc[ai][bj][m][0] * sc, acc[ai][bj][m][1] * sc); }
        } else if (pn < 6) {
#pragma unroll
            for (int ai = 0; ai < 2; ++ai)
#pragma unroll
                for (int m = 0; m < 4; ++m) { const int row = row0 + ai * 128 + m * 16, b = row >> 11, s = row & 2047;
#pragma unroll
                    for (int bj = 0; bj < 2; ++bj)
#pragma unroll
                        for (int n = 0; n < 2; ++n)
#pragma unroll
                            for (int j = 0; j < 4; ++j) { const int c = (pn - 4) * 256 + bj * 128 + cl + 4 * n + j;
                                Vt[((size_t)(b * 512 + c)) * 2048 + s] = bf1(acc[ai][bj][m][n][j]); } }
        } else if (pn < 13) {
            const int cb = (pn - 6) * 256 + cl;
#pragma unroll
            for (int ai = 0; ai < 2; ++ai)
#pragma unroll
                for (int m = 0; m < 4; ++m) { bf16_t* rp = Prw + (size_t)(row0 + ai * 128 + m * 16) * RWC + cb;
#pragma unroll
                    for (int bj = 0; bj < 2; ++bj) *(u32x4*)(rp + bj * 128) = pack8(acc[ai][bj][m][0], acc[ai][bj][m][1]); }
        } else {
            const int cb = (pn - 13) * 256 + cl;
#pragma unroll
            for (int ai = 0; ai < 2; ++ai)
#pragma unroll
                for (int m = 0; m < 4; ++m) { bf16_t* rp = Gt + (size_t)(row0 + ai * 128 + m * 16) * GC + cb;
#pragma unroll
                    for (int bj = 0; bj < 2; ++bj) { f32x4 v0 = acc[ai][bj][m][0] + *(const f32x4*)(bgate + cb + bj * 128), v1 = acc[ai][bj][m][1] + *(const f32x4*)(bgate + cb + bj * 128 + 4);
#pragma unroll
                        for (int j = 0; j < 4; ++j) { v0[j] = fsigmoid(v0[j]); v1[j] = fsigmoid(v1[j]); }
                        *(u32x4*)(rp + bj * 128) = pack8(v0, v1); } }
        }
    }
};
template <int MODE> struct EpiRow {
    static constexpr bool PERM = true, AFTER_DRAIN = false;
    bf16_t* O; const bf16_t* T1; const bf16_t* Gt;
    __device__ __forceinline__ void operator()(const f32x4 (&acc)[2][2][4][2], const pg8::Unit& u, int wr, int wc, int fr, int fq) const {
        const int row0 = u.pm * 256 + wr * 64 + fr, cb = u.pn * 256 + wc * 32 + 8 * fq;
#pragma unroll
        for (int ai = 0; ai < 2; ++ai)
#pragma unroll
            for (int m = 0; m < 4; ++m) { const size_t row = (size_t)(row0 + ai * 128 + m * 16);
#pragma unroll
                for (int bj = 0; bj < 2; ++bj) { f32x4 v0 = acc[ai][bj][m][0], v1 = acc[ai][bj][m][1]; const int c = cb + bj * 128;
                    if (MODE >= 1) { const u32x4 gg = *(const u32x4*)(Gt + row * GC + (MODE == 2 ? 1024 : 0) + c);
                        v0[0] *= bf_lo(gg.x); v0[1] *= bf_hi(gg.x); v0[2] *= bf_lo(gg.y); v0[3] *= bf_hi(gg.y); v1[0] *= bf_lo(gg.z); v1[1] *= bf_hi(gg.z); v1[2] *= bf_lo(gg.w); v1[3] *= bf_hi(gg.w); }
                    if (MODE == 2) { const u32x4 tt = *(const u32x4*)(T1 + row * 1024 + c);
                        v0[0] += bf_lo(tt.x); v0[1] += bf_hi(tt.x); v0[2] += bf_lo(tt.y); v0[3] += bf_hi(tt.y); v1[0] += bf_lo(tt.z); v1[1] += bf_hi(tt.z); v1[2] += bf_lo(tt.w); v1[3] += bf_hi(tt.w); }
                    *(u32x4*)(O + row * 1024 + c) = pack8(v0, v1); } }
    }
};
struct EpiSwiGLU {
    static constexpr bool PERM = true, AFTER_DRAIN = false;
    bf16_t* Hd;
    __device__ __forceinline__ void operator()(const f32x4 (&acc)[2][2][4][2], const pg8::Unit& u, int wr, int wc, int fr, int fq) const {
        const int row0 = u.pm * 256 + wr * 64 + fr, cb = u.pn * 128 + wc * 32 + 8 * fq;
#pragma unroll
        for (int ai = 0; ai < 2; ++ai)
#pragma unroll
            for (int m = 0; m < 4; ++m) { f32x4 v0, v1;
#pragma unroll
                for (int j = 0; j < 4; ++j) { const float g0 = acc[ai][0][m][0][j], g1 = acc[ai][0][m][1][j];
                    v0[j] = g0 * fsigmoid(g0) * acc[ai][1][m][0][j]; v1[j] = g1 * fsigmoid(g1) * acc[ai][1][m][1][j]; }
                *(u32x4*)(Hd + (size_t)(row0 + ai * 128 + m * 16) * DFF + cb) = pack8(v0, v1); }
    }
};
template <class Epi> __device__ __forceinline__ void run_gemm(PG8_LAS unsigned char* lds, const bf16_t* A, const bf16_t* Bt, int N, int K, const Epi& E, int G) {
    pg8::Gemm g; g.A = A; g.Bt = Bt; g.M = M; g.N = N; g.K = K;
    pg8::StaticOrder S; S.init(M, N, G, (int)blockIdx.x);
    pg8::gemm_phase<Epi, pg8::StaticOrder, false>(lds, g, S, E, nullptr);
}
__device__ __forceinline__ void mix8_lds(const unsigned char* cur, const unsigned char* prv, const float* mu, float (&o)[8]) {
    const u32x4 c = *(const u32x4*)cur, p = *(const u32x4*)prv;
    const f32x4 m0 = *(const f32x4*)mu, m1 = *(const f32x4*)(mu + 4);
    const float mm[8] = {m0[0], m0[1], m0[2], m0[3], m1[0], m1[1], m1[2], m1[3]};
#pragma unroll
    for (int i = 0; i < 4; ++i) { const float cl = bf_lo(c[i]), ch = bf_hi(c[i]), pl = bf_lo(p[i]), ph = bf_hi(p[i]);
        o[2 * i] = cl + (pl - cl) * mm[2 * i]; o[2 * i + 1] = ch + (ph - ch) * mm[2 * i + 1]; }
}
__device__ __forceinline__ void mix4_lds(const unsigned char* cur, const unsigned char* prv, const float* mu, float (&o)[4]) {
    const u32x2 c = *(const u32x2*)cur, p = *(const u32x2*)prv;
    const f32x4 m0 = *(const f32x4*)mu;
#pragma unroll
    for (int i = 0; i < 2; ++i) { const float cl = bf_lo(c[i]), ch = bf_hi(c[i]), pl = bf_lo(p[i]), ph = bf_hi(p[i]);
        o[2 * i] = cl + (pl - cl) * m0[2 * i]; o[2 * i + 1] = ch + (ph - ch) * m0[2 * i + 1]; }
}
__device__ __forceinline__ bf16x8 pack_frag(const float (&v)[8]) {
    u32x4 o; o.x = cvt_pk_bf16(v[0], v[1]); o.y = cvt_pk_bf16(v[2], v[3]); o.z = cvt_pk_bf16(v[4], v[5]); o.w = cvt_pk_bf16(v[6], v[7]);
    return __builtin_bit_cast(bf16x8, o);
}
__device__ __forceinline__ void phase_rwprep(const Args& a, unsigned char* lds, int G) {
    constexpr int ROWB = 3600, L_FRAG = 17 * ROWB, L_PAR = L_FRAG + 8192, NCH = 17 * 224, NT = M / 16;
    const int tid = my_tid(); const int wave = __builtin_amdgcn_readfirstlane(tid >> 6), lane = tid & 63, fr = lane & 15, fq = lane >> 4;
    unsigned char* ws = a.ws;
    const unsigned char* PRW = ws + O_PRW;
    const bf16_t* WLU = (const bf16_t*)(ws + O_WLU); const bf16_t* WLA = (const bf16_t*)(ws + O_WLA); const bf16_t* WLG = (const bf16_t*)(ws + O_WLG);
    unsigned char* SI = ws + O_SI; bf16_t* GB = (bf16_t*)(ws + O_G); float* SC = (float*)(ws + O_SC);
    float* par = (float*)(lds + L_PAR);
    for (int i = tid; i < 1792 + 5 * 512; i += 512) {
        float v;
        if (i < 1792) v = a.in[4][i]; else { const int j = i - 1792, w = j >> 9, c = j & 511; v = (w == 0 ? a.in[5] : w == 1 ? a.in[7] : w == 2 ? a.in[10] : w == 3 ? a.in[11] : a.in[12])[c]; }
        par[i] = v;
    }
    for (int tile = blockIdx.x; tile < NT; tile += G) {
        __syncthreads();
        {   u32x4 pre[8];
#pragma unroll
            for (int j = 0; j < 8; ++j) { const int c = tid + 512 * j; pre[j] = (u32x4){0u, 0u, 0u, 0u};
                if (c < NCH) { const int row = c / 224, col = c - row * 224; const bool zero = (row == 0) && (((tile * 16) & (SEQ - 1)) == 0);
                    if (!zero) pre[j] = *(const u32x4*)(PRW + ((size_t)tile * 16 + row - 1) * (RWC * 2) + col * 16); } }
#pragma unroll
            for (int j = 0; j < 8; ++j) { const int c = tid + 512 * j; if (c < NCH) { const int row = c / 224, col = c - row * 224; *(u32x4*)(lds + row * ROWB + col * 16) = pre[j]; } }
        }
        __syncthreads();
        const unsigned char* rcur = lds + (fr + 1) * ROWB; const unsigned char* rprv = lds + fr * ROWB;
        {
            const int colb = wave < 2 ? 1536 + 32 * wave : (wave < 4 ? 1600 + 32 * (wave - 2) : 1664 + 32 * (wave - 4));
            float t8[8]; mix8_lds(rcur + (colb + 8 * fq) * 2, rprv + (colb + 8 * fq) * 2, par + colb + 8 * fq, t8);
            if (wave < 2) {
#pragma unroll
                for (int i = 0; i < 8; ++i) { const float e = fexp(2.f * t8[i]); t8[i] = 1.f - 2.f * frcp(e + 1.f); } }
            else if (wave >= 4) {
#pragma unroll
                for (int i = 0; i < 8; ++i) t8[i] = fsigmoid(t8[i]); }
            *(bf16x8*)(lds + L_FRAG + wave * 1024 + lane * 16) = pack_frag(t8);
        }
        __syncthreads();
        bf16x8 Aw[2], Aa[2], Ag[4];
#pragma unroll
        for (int s = 0; s < 2; ++s) { Aw[s] = *(const bf16x8*)(lds + L_FRAG + s * 1024 + lane * 16); Aa[s] = *(const bf16x8*)(lds + L_FRAG + (2 + s) * 1024 + lane * 16); }
#pragma unroll
        for (int s = 0; s < 4; ++s) Ag[s] = *(const bf16x8*)(lds + L_FRAG + (4 + s) * 1024 + lane * 16);
        const int h = wave; const size_t m = (size_t)tile * 16 + fr;
        float kkr[16], av[16]; unsigned lk[16], rvp[16];
        float ss = 0.f, brs = 0.f, krs = 0.f, rkbs = 0.f;
#pragma unroll
        for (int n = 0; n < 4; ++n) {
            asm volatile("" ::: "memory");
            const int cb = 64 * h + 16 * n, c0 = cb + 4 * fq;
            f32x4 aw = {0.f, 0.f, 0.f, 0.f}, aa = aw, ag = aw;
#pragma unroll
            for (int s = 0; s < 2; ++s) {
                aw = __builtin_amdgcn_mfma_f32_16x16x32_bf16(*(const bf16x8*)(WLU + (size_t)(cb + fr) * 64 + 32 * s + 8 * fq), Aw[s], aw, 0, 0, 0);
                aa = __builtin_amdgcn_mfma_f32_16x16x32_bf16(*(const bf16x8*)(WLA + (size_t)(cb + fr) * 64 + 32 * s + 8 * fq), Aa[s], aa, 0, 0, 0); }
#pragma unroll
            for (int s = 0; s < 4; ++s)
                ag = __builtin_amdgcn_mfma_f32_16x16x32_bf16(*(const bf16x8*)(WLG + (size_t)(cb + fr) * 128 + 32 * s + 8 * fq), Ag[s], ag, 0, 0, 0);
            float rr[4], kr4[4], vv[4];
            mix4_lds(rcur + c0 * 2, rprv + c0 * 2, par + c0, rr); mix4_lds(rcur + (512 + c0) * 2, rprv + (512 + c0) * 2, par + 512 + c0, kr4); mix4_lds(rcur + (1024 + c0) * 2, rprv + (1024 + c0) * 2, par + 1024 + c0, vv);
            const f32x4 w0v = *(const f32x4*)(par + 1792 + c0), a0v = *(const f32x4*)(par + 2304 + c0), kkv = *(const f32x4*)(par + 2816 + c0), kav = *(const f32x4*)(par + 3328 + c0), rkv = *(const f32x4*)(par + 3840 + c0);
#pragma unroll
            for (int j = 0; j < 4; ++j) {
                const float sg = fsigmoid(w0v[j] + aw[j]);
                const float ldx = -0.60653065971f * 1.44269504089f * sg;
                const float av_ = fsigmoid(a0v[j] + aa[j]);
                const float kkraw = kr4[j] * kkv[j];
                const float k2 = kr4[j] * (1.f + (av_ - 1.f) * kav[j]);
                ss += kkraw * kkraw; brs += kkraw * av_ * rr[j]; krs += k2 * rr[j]; rkbs += rr[j] * k2 * rkv[j];
                kkr[4 * n + j] = kkraw; av[4 * n + j] = av_; lk[4 * n + j] = cvt_pk_bf16(ldx, k2); rvp[4 * n + j] = cvt_pk_bf16(rr[j], vv[j]);
            }
            u32x2 gp; gp.x = cvt_pk_bf16(ag[0], ag[1]); gp.y = cvt_pk_bf16(ag[2], ag[3]);
            *(u32x2*)(GB + m * 512 + c0) = gp;
        }
        ss = red16(ss); brs = red16(brs); krs = red16(krs); rkbs = red16(rkbs);
        const float inv = 1.f / fmaxf(sqrtf(ss), 1e-12f);
        unsigned char* rec = SI + ((m * 8 + h) * 64) * 12;
#pragma unroll
        for (int n = 0; n < 4; ++n) {
            unsigned dw[12];
#pragma unroll
            for (int j = 0; j < 4; ++j) { const float kk = kkr[4 * n + j] * inv;
                const unsigned kp = cvt_pk_bf16(kk * av[4 * n + j], -kk);
                dw[3 * j] = (lk[4 * n + j] & 0xffffu) | (kp & 0xffff0000u); dw[3 * j + 1] = (kp & 0xffffu) | (lk[4 * n + j] & 0xffff0000u); dw[3 * j + 2] = rvp[4 * n + j]; }
            u32x4* dst = (u32x4*)(rec + (16 * n + 4 * fq) * 12);
            u32x4 s0 = {dw[0], dw[1], dw[2], dw[3]}, s1 = {dw[4], dw[5], dw[6], dw[7]}, s2 = {dw[8], dw[9], dw[10], dw[11]};
            dst[0] = s0; dst[1] = s1; dst[2] = s2;
        }
        if (fq == 0) { f32x4 scv = {brs * inv, krs, rkbs, 0.f}; *(f32x4*)(SC + (m * 8 + h) * 4) = scv; }
    }
    __syncthreads();
}

__device__ __forceinline__ float red_rows(float x) {
    float a0 = x, a1 = x;
    asm volatile("s_nop 1\n\tv_permlane16_swap_b32 %0, %1" : "+v"(a0), "+v"(a1));
    float b0 = a0 + a1, b1 = b0;
    asm volatile("s_nop 1\n\tv_permlane32_swap_b32 %0, %1" : "+v"(b0), "+v"(b1));
    return b0 + b1;
}
constexpr int SC_T = 16, SC_ROW = 1552, SC_BUF = SC_T * SC_ROW;
struct ProdRec { unsigned d0, d1, d2; f32x2 sc; };
__device__ __forceinline__ void prod_load(ProdRec (&P)[4], const unsigned char* sb, const float* scp, int chunk, int pl) {
    const int col = pl & 63;
#pragma unroll
    for (int q = 0; q < 4; ++q) { const size_t t = (size_t)chunk * SC_T + (pl >> 6) + 4 * q;
        const unsigned* p = (const unsigned*)(sb + t * 6144 + col * 12); P[q].d0 = p[0]; P[q].d1 = p[1]; P[q].d2 = p[2];
        P[q].sc = (f32x2){0.f, 0.f}; if (col == 0) P[q].sc = *(const f32x2*)(scp + t * 32); }
}
__device__ __forceinline__ void prod_store(const ProdRec (&P)[4], unsigned char* buf, int pl) {
    const int col = pl & 63;
#pragma unroll
    for (int q = 0; q < 4; ++q) { unsigned char* base = buf + ((pl >> 6) + 4 * q) * SC_ROW + col * 4;
        const float w = __builtin_amdgcn_exp2f(bf_lo(P[q].d0));
        *(float*)(base) = bf_hi(P[q].d0); *(float*)(base + 256) = w * bf_lo(P[q].d2); *(float*)(base + 512) = w;
        *(float*)(base + 768) = bf_lo(P[q].d1); *(float*)(base + 1024) = bf_hi(P[q].d1); *(float*)(base + 1280) = bf_hi(P[q].d2);
        if (col == 0) *(f32x2*)(base + 1536) = P[q].sc; }
}
__device__ __forceinline__ void scan_consume(f32x2 (&S)[8], const unsigned char* buf, unsigned* yr, int lane, int rb) {
    const unsigned co = (unsigned)(lane >> 4) * 64u, vo = 1280u + (unsigned)(16 * rb + (lane & 15)) * 4u;
#pragma unroll 2
    for (int st = 0; st < SC_T; ++st) {
        const unsigned char* sb = buf + st * SC_ROW;
        f32x4 n4[4], r4[4], w4[4], a4[4], k4[4];
#pragma unroll
        for (int q = 0; q < 4; ++q) { n4[q] = *(const f32x4*)(sb + co + 16 * q); r4[q] = *(const f32x4*)(sb + 256 + co + 16 * q); w4[q] = *(const f32x4*)(sb + 512 + co + 16 * q);
            a4[q] = *(const f32x4*)(sb + 768 + co + 16 * q); k4[q] = *(const f32x4*)(sb + 1024 + co + 16 * q); }
        const float v = *(const float*)(sb + vo); const f32x2 bk = *(const f32x2*)(sb + 1536);
        f32x2 sacc = {0.f, 0.f}, yacc = {0.f, 0.f};
#pragma unroll
        for (int q = 0; q < 4; ++q) {
            sacc += S[2 * q] * (f32x2){n4[q][0], n4[q][1]}; sacc += S[2 * q + 1] * (f32x2){n4[q][2], n4[q][3]};
            yacc += S[2 * q] * (f32x2){r4[q][0], r4[q][1]}; yacc += S[2 * q + 1] * (f32x2){r4[q][2], r4[q][3]}; }
        const float sa = red_rows(sacc[0] + sacc[1]), yp = red_rows(yacc[0] + yacc[1]);
        const f32x2 sa2 = {sa, sa}, v2 = {v, v};
#pragma unroll
        for (int q = 0; q < 4; ++q) {
            S[2 * q] = S[2 * q] * (f32x2){w4[q][0], w4[q][1]} + (f32x2){a4[q][0], a4[q][1]} * sa2 + (f32x2){k4[q][0], k4[q][1]} * v2;
            S[2 * q + 1] = S[2 * q + 1] * (f32x2){w4[q][2], w4[q][3]} + (f32x2){a4[q][2], a4[q][3]} * sa2 + (f32x2){k4[q][2], k4[q][3]} * v2; }
        const float y = yp + sa * bk[0] + v * bk[1];
        if (lane < 16) yr[(size_t)st * 512 + lane] = (unsigned)bf1(y) | (__float_as_uint(v) & 0xffff0000u);
    }
}

__device__ __forceinline__ void rwpost_local(const Args& a, int bh, int tid) {
    const float* SC = (const float*)(a.ws + O_SC);
    const unsigned* YR = (const unsigned*)(a.ws + O_YR); const bf16_t* GB = (const bf16_t*)(a.ws + O_G); bf16_t* ORW = (bf16_t*)(a.ws + O_ORW);
    const int b = bh >> 3, h = bh & 7, c = 64 * h + (tid & 15) * 4;
    const f32x4 lwv = *(const f32x4*)(a.in[13] + c), lbv = *(const f32x4*)(a.in[14] + c);
    for (int t0 = tid >> 4; t0 < SEQ; t0 += 64) {
        u32x4 yv[2]; u32x2 gb[2]; float rkb[2]; size_t mm[2];
#pragma unroll
        for (int u = 0; u < 2; ++u) { const size_t m = (size_t)b * SEQ + t0 + 32 * u; mm[u] = m;
            yv[u] = *(const u32x4*)(YR + m * 512 + c); gb[u] = *(const u32x2*)(GB + m * 512 + c); rkb[u] = SC[(m * 8 + h) * 4 + 2]; }
#pragma unroll
        for (int u = 0; u < 2; ++u) {
            float y[4] = {bf_lo(yv[u].x), bf_lo(yv[u].y), bf_lo(yv[u].z), bf_lo(yv[u].w)};
            const float v[4] = {bf_hi(yv[u].x), bf_hi(yv[u].y), bf_hi(yv[u].z), bf_hi(yv[u].w)};
            float s = (y[0] + y[1]) + (y[2] + y[3]);
#pragma unroll
            for (int o = 1; o < 16; o <<= 1) s += __shfl_xor(s, o);
            const float mean = s * (1.f / 64.f);
            float q = 0.f;
#pragma unroll
            for (int j = 0; j < 4; ++j) { y[j] -= mean; q += y[j] * y[j]; }
#pragma unroll
            for (int o = 1; o < 16; o <<= 1) q += __shfl_xor(q, o);
            const float rstd = rsqrtf(q * (1.f / 64.f) + GN_EPS);
            const float g4[4] = {bf_lo(gb[u].x), bf_hi(gb[u].x), bf_lo(gb[u].y), bf_hi(gb[u].y)};
            float o4[4];
#pragma unroll
            for (int j = 0; j < 4; ++j) o4[j] = (y[j] * rstd * lwv[j] + lbv[j] + rkb[u] * v[j]) * g4[j];
            u32x2 ob; ob.x = cvt_pk_bf16(o4[0], o4[1]); ob.y = cvt_pk_bf16(o4[2], o4[3]);
            *(u32x2*)(ORW + mm[u] * 512 + c) = ob;
        }
    }
}

struct KV { bf16x8 k[4]; bf16x8 v[2][2]; };
__device__ __forceinline__ void attn_load(KV& T, const bf16_t* Kh, const bf16_t* Vh, int k0, int n, int hf) {
    const bf16_t* kp = Kh + (size_t)(k0 + n) * 512 + 8 * hf;
#pragma unroll
    for (int s = 0; s < 4; ++s) T.k[s] = *(const bf16x8*)(kp + 16 * s);
#pragma unroll
    for (int d = 0; d < 2; ++d)
#pragma unroll
        for (int sg = 0; sg < 2; ++sg) { const bf16_t* vp = Vh + (size_t)(32 * d + n) * SEQ + k0 + 16 * sg + 4 * hf;
            const u32x2 lo = *(const u32x2*)vp, hi = *(const u32x2*)(vp + 8); u32x4 t = {lo.x, lo.y, hi.x, hi.y}; T.v[d][sg] = __builtin_bit_cast(bf16x8, t); }
}
__device__ __forceinline__ void attn_wave(const Args& a, int bh, int w4, int lane) {
    const int b = bh >> 3, h = bh & 7, n = lane & 31, hf = lane >> 5;
    const size_t m0 = (size_t)b * SEQ;
    const bf16_t* Qh = (const bf16_t*)(a.ws + O_Q) + m0 * 512 + 64 * h;
    const bf16_t* Kh = (const bf16_t*)(a.ws + O_K) + m0 * 512 + 64 * h;
    const bf16_t* Vh = (const bf16_t*)(a.ws + O_VT) + (size_t)bh * 64 * SEQ;
    bf16_t* Oh = (bf16_t*)(a.ws + O_OSB) + m0 * 512 + 64 * h;
    for (int qt = 63 - w4; qt >= 0; qt -= 8) {
        const int q0 = 32 * qt;
        bf16x8 qf[4];
#pragma unroll
        for (int s = 0; s < 4; ++s) qf[s] = *(const bf16x8*)(Qh + (size_t)(q0 + n) * 512 + 16 * s + 8 * hf);
        f32x16 o0, o1;
#pragma unroll
        for (int i = 0; i < 16; ++i) { o0[i] = 0.f; o1[i] = 0.f; }
        float carry = 0.f;
        KV cur, nxt;
        attn_load(cur, Kh, Vh, q0, n, hf);
        for (int kt = qt; kt >= 0; --kt) {
            const int ktn = kt > 0 ? kt - 1 : 0;
            attn_load(nxt, Kh, Vh, 32 * ktn, n, hf);
            f32x16 sc;
#pragma unroll
            for (int i = 0; i < 16; ++i) sc[i] = 0.f;
#pragma unroll
            for (int s = 0; s < 4; ++s) sc = __builtin_amdgcn_mfma_f32_32x32x16_bf16(cur.k[s], qf[s], sc, 0, 0, 0);
            const bool diag = (kt == qt);
            float lf[16], G4[4];
#pragma unroll
            for (int g = 0; g < 4; ++g) { G4[g] = 0.f;
#pragma unroll
                for (int i = 0; i < 4; ++i) { const int r = 4 * g + i; const float z = sc[r];
                    const bool valid = !diag || (8 * g + 4 * hf + i < n);
                    const float e = fexp(-fabsf(z));
                    const float sp = fmaxf(z, 0.f) + flog(1.f + e);
                    lf[r] = valid ? -sp : 0.f; G4[g] += lf[r]; } }
            float PG[4], T4[4];
#pragma unroll
            for (int g = 0; g < 4; ++g) { PG[g] = __shfl_xor(G4[g], 32); T4[g] = G4[g] + PG[g]; }
            const float tail3 = 0.f, tail2 = T4[3], tail1 = T4[3] + T4[2], tail0 = tail1 + T4[1], total = tail0 + T4[0];
            const float tails[4] = {tail0, tail1, tail2, tail3};
            f32x16 wv;
#pragma unroll
            for (int g = 0; g < 4; ++g) {
                float af = carry + tails[g] + (hf == 0 ? PG[g] : 0.f);
#pragma unroll
                for (int i = 3; i >= 0; --i) { const int r = 4 * g + i; const float z = sc[r];
                    const bool valid = !diag || (8 * g + 4 * hf + i < n);
                    const float wgt = fexp(lf[r] + z + af);
                    wv[r] = valid ? wgt : 0.f;
                    af += lf[r]; } }
            carry += total;
            bf16x8 wf[2];
#pragma unroll
            for (int sg = 0; sg < 2; ++sg) { u32x4 t; t.x = cvt_pk_bf16(wv[8 * sg + 0], wv[8 * sg + 1]); t.y = cvt_pk_bf16(wv[8 * sg + 2], wv[8 * sg + 3]); t.z = cvt_pk_bf16(wv[8 * sg + 4], wv[8 * sg + 5]); t.w = cvt_pk_bf16(wv[8 * sg + 6], wv[8 * sg + 7]); wf[sg] = __builtin_bit_cast(bf16x8, t); }
#pragma unroll
            for (int sg = 0; sg < 2; ++sg) { o0 = __builtin_amdgcn_mfma_f32_32x32x16_bf16(cur.v[0][sg], wf[sg], o0, 0, 0, 0); o1 = __builtin_amdgcn_mfma_f32_32x32x16_bf16(cur.v[1][sg], wf[sg], o1, 0, 0, 0); }
            cur = nxt;
#if MK_EARLY_EXIT
            if (__all(carry < -104.f)) break;
#endif
        }
        bf16_t* op = Oh + (size_t)(q0 + n) * 512 + 4 * hf;
#pragma unroll
        for (int g = 0; g < 4; ++g) {
            u32x2 t0, t1; t0.x = cvt_pk_bf16(o0[4 * g], o0[4 * g + 1]); t0.y = cvt_pk_bf16(o0[4 * g + 2], o0[4 * g + 3]); t1.x = cvt_pk_bf16(o1[4 * g], o1[4 * g + 1]); t1.y = cvt_pk_bf16(o1[4 * g + 2], o1[4 * g + 3]);
            *(u32x2*)(op + 8 * g) = t0; *(u32x2*)(op + 32 + 8 * g) = t1; }
    }
}
__device__ __forceinline__ void phase_mixer(const Args& a, unsigned char* lds, int G) {
    const int tid = my_tid(); const int wave = __builtin_amdgcn_readfirstlane(tid >> 6), lane = tid & 63;
    for (int bh = blockIdx.x; bh < NB * NH; bh += G) {
        const int b = bh >> 3, h = bh & 7; const size_t m0 = (size_t)b * SEQ;
        const unsigned char* sb = a.ws + O_SI + (m0 * 8 + h) * 768; const float* scp = (const float*)(a.ws + O_SC) + (m0 * 8 + h) * 4;
        unsigned* yrb = (unsigned*)(a.ws + O_YR) + m0 * 512 + 64 * h + 16 * (wave & 3);
        const int pl = tid - 256;
        constexpr int NCH = SEQ / SC_T;
        ProdRec pr[4]; f32x2 S[8];
#pragma unroll
        for (int p = 0; p < 8; ++p) S[p] = (f32x2){0.f, 0.f};
        __syncthreads();
        if (wave >= 4) { prod_load(pr, sb, scp, 0, pl); prod_store(pr, lds, pl); prod_load(pr, sb, scp, 1, pl); }
        __syncthreads();
        for (int ci = 0; ci < NCH; ++ci) {
            if (wave < 4) scan_consume(S, lds + (ci & 1) * SC_BUF, yrb + (size_t)ci * SC_T * 512, lane, wave);
            else if (ci + 1 < NCH) { prod_store(pr, lds + ((ci + 1) & 1) * SC_BUF, pl); prod_load(pr, sb, scp, ci + 2 < NCH ? ci + 2 : ci + 1, pl); }
            __syncthreads();
        }
        attn_wave(a, bh, wave, lane);
        __threadfence_block(); __syncthreads();
        rwpost_local(a, bh, my_tid());
    }
}

template <int MODE> __device__ __forceinline__ void phase_rows(const Args& a, int G) {
    const int tid = my_tid(); const int wave = tid >> 6, lane = tid & 63;
    const int gw = blockIdx.x * 8 + wave, NGW = G * 8;
    const bf16_t* T = (const bf16_t*)(a.ws + (MODE == 0 ? O_TT : O_FF));
    const float* xin = MODE == 0 ? a.in[0] : a.out; const float* g1 = MODE == 0 ? a.in[18] : a.in[23]; const float* g2 = a.in[19];
    bf16_t* H2 = (bf16_t*)(a.ws + O_H2);
    f32x4 g1v[4], g2v[4];
#pragma unroll
    for (int j = 0; j < 4; ++j) { g1v[j] = ((const f32x4*)g1)[lane + 64 * j]; g2v[j] = ((const f32x4*)g2)[lane + 64 * j]; }
    for (int row0 = gw; row0 < M; row0 += 2 * NGW) {
        u32x2 tb[2][4]; f32x4 x[2][4];
#pragma unroll
        for (int u = 0; u < 2; ++u) { const int row = (row0 + u * NGW < M) ? row0 + u * NGW : row0;
            const u32x2* tr = (const u32x2*)(T + (size_t)row * D) + lane; const f32x4* xr = (const f32x4*)(xin + (size_t)row * D) + lane;
#pragma unroll
            for (int j = 0; j < 4; ++j) { tb[u][j] = tr[64 * j]; x[u][j] = xr[64 * j]; } }
#pragma unroll
        for (int u = 0; u < 2; ++u) {
            const int row = row0 + u * NGW;
            f32x4 t[4]; float s = 0.f;
#pragma unroll
            for (int j = 0; j < 4; ++j) { t[j][0] = bf_lo(tb[u][j].x); t[j][1] = bf_hi(tb[u][j].x); t[j][2] = bf_lo(tb[u][j].y); t[j][3] = bf_hi(tb[u][j].y);
                s += (t[j][0] * t[j][0] + t[j][1] * t[j][1]) + (t[j][2] * t[j][2] + t[j][3] * t[j][3]); }
            const float rs = rsqrtf(wave_sum(s) * (1.f / D) + RMS_EPS);
            float s2 = 0.f;
#pragma unroll
            for (int j = 0; j < 4; ++j)
#pragma unroll
                for (int e = 0; e < 4; ++e) { x[u][j][e] += t[j][e] * rs * g1v[j][e]; s2 += x[u][j][e] * x[u][j][e]; }
            float rs2 = 0.f;
            if (MODE == 0) rs2 = rsqrtf(wave_sum(s2) * (1.f / D) + RMS_EPS);
            if (row < M) {
                f32x4* orow = (f32x4*)(a.out + (size_t)row * D) + lane;
#pragma unroll
                for (int j = 0; j < 4; ++j) orow[64 * j] = x[u][j];
                if (MODE == 0) {
                    u32x2* o = (u32x2*)(H2 + (size_t)row * D) + lane;
#pragma unroll
                    for (int j = 0; j < 4; ++j) { u32x2 w; w.x = cvt_pk_bf16(x[u][j][0] * rs2 * g2v[j][0], x[u][j][1] * rs2 * g2v[j][1]); w.y = cvt_pk_bf16(x[u][j][2] * rs2 * g2v[j][2], x[u][j][3] * rs2 * g2v[j][3]); o[64 * j] = w; }
                }
            }
        }
    }
}

__global__ void __launch_bounds__(512, 2) mega(Args a) {
    extern __shared__ __attribute__((aligned(16))) unsigned char shm[];
    PG8_LAS unsigned char* lds = (PG8_LAS unsigned char*)shm;
    const int G = (int)gridDim.x;
    unsigned char* ws = a.ws;
    phase_prep(a, (float*)shm, G);
    cg::this_grid().sync();
    { Epi1 E; E.Q = (bf16_t*)(ws + O_Q); E.Kb = (bf16_t*)(ws + O_K); E.Vt = (bf16_t*)(ws + O_VT); E.Prw = (bf16_t*)(ws + O_PRW); E.Gt = (bf16_t*)a.out; E.bgate = a.in[3];
      run_gemm(lds, (const bf16_t*)(ws + O_H), (const bf16_t*)(ws + O_WIN), INC, 1024, E, G); }
    cg::this_grid().sync();
    phase_rwprep(a, shm, G);
    cg::this_grid().sync();
    phase_mixer(a, shm, G);
    cg::this_grid().sync();
    { EpiRow<1> E; E.O = (bf16_t*)(ws + O_T1); E.T1 = nullptr; E.Gt = (const bf16_t*)a.out;
      run_gemm(lds, (const bf16_t*)(ws + O_OSB), (const bf16_t*)(ws + O_WSB), 1024, 512, E, G); }
    { EpiRow<2> E; E.O = (bf16_t*)(ws + O_MRG); E.T1 = (const bf16_t*)(ws + O_T1); E.Gt = (const bf16_t*)a.out;
      run_gemm(lds, (const bf16_t*)(ws + O_ORW), (const bf16_t*)(ws + O_WRW), 1024, 512, E, G); }
    cg::this_grid().sync();
    { EpiRow<0> E; E.O = (bf16_t*)(ws + O_TT); E.T1 = nullptr; E.Gt = nullptr;
      run_gemm(lds, (const bf16_t*)(ws + O_MRG), (const bf16_t*)(ws + O_WO), 1024, 1024, E, G); }
    cg::this_grid().sync();
    phase_rows<0>(a, G);
    cg::this_grid().sync();
    { EpiSwiGLU E; E.Hd = (bf16_t*)(ws + O_HID);
      run_gemm(lds, (const bf16_t*)(ws + O_H2), (const bf16_t*)(ws + O_WGU), 2 * DFF, 1024, E, G); }
    cg::this_grid().sync();
    { EpiRow<0> E; E.O = (bf16_t*)(ws + O_FF); E.T1 = nullptr; E.Gt = nullptr;
      run_gemm(lds, (const bf16_t*)(ws + O_HID), (const bf16_t*)(ws + O_WDN), 1024, DFF, E, G); }
    cg::this_grid().sync();
    phase_rows<1>(a, G);
}
}

extern "C" void kernel_launch(void* const* d_in, const int* in_sizes, int n_in, void* d_out, int out_size, void* d_ws, size_t ws_size, hipStream_t stream) {
    static int grid = 0;
    if (grid == 0) {
        if (n_in != 24 || in_sizes[0] != mk::M * mk::D || out_size != mk::M * mk::D || ws_size < mk::WS_NEED) {
            fprintf(stderr, "kernel_launch: unexpected shapes: n_in %d in0 %d out %d ws %zu (need %zu)\n", n_in, n_in > 0 ? in_sizes[0] : -1, out_size, ws_size, (size_t)mk::WS_NEED); grid = -1; return; }
        int dev = 0, cus = 0, per_cu = 0;
        hipGetDevice(&dev); hipDeviceGetAttribute(&cus, hipDeviceAttributeMultiprocessorCount, dev);
        if (hipFuncSetAttribute((const void*)mk::mega, hipFuncAttributeMaxDynamicSharedMemorySize, mk::LDS_BYTES) != hipSuccess) { fprintf(stderr, "kernel_launch: hipFuncSetAttribute failed\n"); grid = -1; return; }
        if (hipOccupancyMaxActiveBlocksPerMultiprocessor(&per_cu, (const void*)mk::mega, 512, mk::LDS_BYTES) != hipSuccess || per_cu < 1) { fprintf(stderr, "kernel_launch: occupancy query failed (%d)\n", per_cu); per_cu = 1; }
        (void)hipGetLastError();
        grid = cus * per_cu;
        fprintf(stderr, "kernel_launch: grid %d (cus %d x %d)\n", grid, cus, per_cu);
    }
    if (grid < 0) return;
    mk::Args a{};
    for (int i = 0; i < 24; ++i) a.in[i] = (const float*)d_in[i];
    a.out = (float*)d_out; a.ws = (unsigned char*)d_ws;
    a.ph_lo = 0; a.ph_hi = mk::NPH;
    void* args[] = {&a};
    hipError_t e = hipLaunchCooperativeKernel((const void*)mk::mega, dim3(grid), dim3(512), args, mk::LDS_BYTES, stream);
    if (e != hipSuccess) fprintf(stderr, "kernel_launch: cooperative launch failed: %s (grid %d)\n", hipGetErrorString(e), grid);
}
```

```cpp
#include <hip/hip_runtime.h>
#include <hip/hip_cooperative_groups.h>
#include <cstdio>
#include <cstdint>
namespace cg = cooperative_groups;
#ifndef MK_SPLIT
#define MK_SPLIT 0
#endif
#ifndef MK_DIAG
#define MK_DIAG 0
#endif
#ifndef MK_REPMASK
#define MK_REPMASK 0
#endif
#ifndef MK_EARLY_EXIT
#define MK_EARLY_EXIT 1
#endif
namespace pg8 {
#define PG8_LAS __attribute__((address_space(3)))
typedef unsigned short bf16_t;
typedef short bf16x8 __attribute__((ext_vector_type(8)));
typedef float f32x4 __attribute__((ext_vector_type(4)));
typedef unsigned u32x4 __attribute__((ext_vector_type(4)));
constexpr int BM = 256, BK = 64, HALF = 128, HTB = HALF * BK * 2  , STAGE_BYTES = 8 * HTB, NXCD = 8, WGM = 8;

__host__ __device__ __forceinline__ int lds_byte(int r, int c) { const int st = (r >> 4) * 2 + (c >> 5), rr = r & 15, cc = c & 31, ob = rr * 64 + cc * 2; return st * 1024 + (ob ^ (((ob >> 9) & 1) << 5)); }
__host__ __device__ __forceinline__ void stage_rc(int b, int& R, int& C) { const int st = b / 1024, sb = b % 1024, swz = sb ^ (((sb >> 9) & 1) << 5); R = (st >> 1) * 16 + swz / 64; C = (st & 1) * 32 + (swz % 64) / 2; }
__host__ __device__ __forceinline__ int perm32(int rho) { const int n = rho >> 4, i = rho & 15; return 8 * (i >> 2) + 4 * n + (i & 3); }

struct Unit { int pm, pn; };
struct Gemm { const bf16_t* A; const bf16_t* Bt; int M, N, K; };

struct StaticOrder {
    int nM, nN, nwg, G, c;
    __host__ __device__ void init(int M, int N, int G_, int c_) { nM = M / BM; nN = N / BM; nwg = nM * nN; G = G_; c = c_; }
    __host__ __device__ bool next(int i, Unit& u) const {
        const long L = (long)i * G + c; if (L >= nwg) return false;
        int wgid = (int)L; { const int q = nwg / NXCD, r = nwg % NXCD, xcd = wgid % NXCD, off = wgid / NXCD; wgid = (xcd < r ? xcd * (q + 1) : r * (q + 1) + (xcd - r) * q) + off; }
        const int nig = WGM * nN, gid = wgid / nig, fm = gid * WGM, gsz = (nM - fm) < WGM ? (nM - fm) : WGM;
        u.pm = fm + ((wgid % nig) % gsz); u.pn = (wgid % nig) / gsz; return true;
    }
    __device__ __forceinline__ void a_ready(const Unit&) const {}
    __device__ __forceinline__ void done(const Unit&) const {}
};

__device__ __forceinline__ unsigned cvt_pk_bf16(float lo, float hi) { unsigned r; asm volatile("v_cvt_pk_bf16_f32 %0, %1, %2" : "=v"(r) : "v"(lo), "v"(hi)); return r; }
typedef float f32x2 __attribute__((ext_vector_type(2)));

template <class Epi, class Sched, bool STAMP = false>
__device__ __forceinline__ void gemm_phase(PG8_LAS unsigned char* lds, const Gemm g, const Sched& S, const Epi& E, unsigned long long* stamps) {
    int tid_ = threadIdx.x; asm volatile("" : "+v"(tid_)); const int tid = tid_, wid = __builtin_amdgcn_readfirstlane(tid >> 6), lane = tid & 63, wr = wid >> 2, wc = wid & 3, fr = lane & 15, fq = lane >> 4;
    const int K = g.K, nt = K / BK;
    int ts_lo = 0, ts_hi = 0, nts = 0; const unsigned long long rt_entry = STAMP ? (unsigned long long)wall_clock64() : 0ull;
#define PG8_STAMP() do { if (STAMP && wid == 0 && nts < 64) { const unsigned long long _c = (unsigned long long)clock64(); \
        ts_lo = (lane == nts) ? (int)(unsigned)_c : ts_lo; ts_hi = (lane == nts) ? (int)(unsigned)(_c >> 32) : ts_hi; ++nts; } } while (0)
    PG8_STAMP();
    unsigned voffA[2], voffB[2];
#pragma unroll
    for (int i = 0; i < 2; ++i) { int R, C; stage_rc(tid * 16 + i * 8192, R, C); const int Rb = Epi::PERM ? ((R & ~31) + perm32(R & 31)) : R;
        voffA[i] = (unsigned)(R * K + C) * 2u; voffB[i] = (unsigned)(Rb * K + C) * 2u; }
    const size_t kstep = (size_t)(BK * 2);
    const size_t hstep = (size_t)HALF * K * 2;
    const size_t tstep = 2 * hstep;
    const unsigned ldsw = (unsigned)wid * 1024u;
    const int aoff = lds_byte(wr * 64 + fr, fq * 8), boff = lds_byte(wc * 32 + fr, fq * 8);
#define PG8_SA(b, h) (((b) * 2 + (h)) * HTB)
#define PG8_SB(b, h) ((4 + (b) * 2 + (h)) * HTB)
#define PG8_STAGE(bufoff, gbase, voff) do { _Pragma("unroll") for (int _i = 0; _i < 2; ++_i) \
        __builtin_amdgcn_global_load_lds((const unsigned*)((const char*)(gbase) + (voff)[_i]), (PG8_LAS unsigned*)(lds + (bufoff) + ldsw + _i * 8192), 16, 0, 0); } while (0)
#define PG8_LDA(dst, b, h) do { _Pragma("unroll") for (int m = 0; m < 4; ++m) _Pragma("unroll") for (int k = 0; k < 2; ++k) dst[m][k] = *(const PG8_LAS bf16x8*)(lds + PG8_SA(b, h) + aoff + m * 2048 + k * 1024); } while (0)
#define PG8_LDB(dst, b, h) do { _Pragma("unroll") for (int n = 0; n < 2; ++n) _Pragma("unroll") for (int k = 0; k < 2; ++k) dst[n][k] = *(const PG8_LAS bf16x8*)(lds + PG8_SB(b, h) + boff + n * 2048 + k * 1024); } while (0)
#define PG8_MMA(ai, bj, At, Bt) do { __builtin_amdgcn_s_setprio(1); _Pragma("unroll") for (int m = 0; m < 4; ++m) _Pragma("unroll") for (int n = 0; n < 2; ++n) _Pragma("unroll") for (int k = 0; k < 2; ++k) \
        acc[ai][bj][m][n] = __builtin_amdgcn_mfma_f32_16x16x32_bf16(Bt[n][k], At[m][k], acc[ai][bj][m][n], 0, 0, 0); __builtin_amdgcn_s_setprio(0); } while (0)
#define PG8_WAIT_V(n) asm volatile("s_waitcnt vmcnt(" #n ")" ::: "memory")
#define PG8_WAIT_L(n) asm volatile("s_waitcnt lgkmcnt(" #n ")" ::: "memory")
#define PG8_BAR __builtin_amdgcn_s_barrier()
#define PG8_SCHED __builtin_amdgcn_sched_barrier(0)
    Unit cur, nxt; int ui = 0;
    if (!S.next(0, cur)) return;
    f32x4 acc[2][2][4][2];
#pragma unroll
    for (int a = 0; a < 2; ++a)
#pragma unroll
        for (int b = 0; b < 2; ++b)
#pragma unroll
            for (int m = 0; m < 4; ++m)
#pragma unroll
                for (int n = 0; n < 2; ++n) acc[a][b][m][n] = (f32x4){0.f, 0.f, 0.f, 0.f};
    bf16x8 At[4][2], B0[2][2], B1[2][2];
    const char* cA = (const char*)g.A + (size_t)cur.pm * tstep; const char* cB = (const char*)g.Bt + (size_t)cur.pn * tstep;
    S.a_ready(cur);
    PG8_STAGE(PG8_SB(0, 0), cB, voffB); PG8_STAGE(PG8_SA(0, 0), cA, voffA); PG8_STAGE(PG8_SB(0, 1), cB + hstep, voffB); PG8_STAGE(PG8_SA(0, 1), cA + hstep, voffA);
    if (wr == 1) PG8_BAR;
    PG8_WAIT_V(4); PG8_BAR;
    PG8_STAGE(PG8_SB(1, 0), cB + kstep, voffB); PG8_STAGE(PG8_SA(1, 0), cA + kstep, voffA); PG8_STAGE(PG8_SB(1, 1), cB + hstep + kstep, voffB);
    PG8_WAIT_V(6); PG8_BAR;
    PG8_STAMP();
    for (;;) {
        const bool has_next = S.next(ui + 1, nxt);
        const char* nA = has_next ? (const char*)g.A + (size_t)nxt.pm * tstep : cA; const char* nB = has_next ? (const char*)g.Bt + (size_t)nxt.pn * tstep : cB;
        for (int t = 0; t < nt; t += 2) {
            const bool last = (t == nt - 2);
            const char* a1 = cA + (size_t)(t + 1) * kstep;
            const char* a2 = last ? nA : cA + (size_t)(t + 2) * kstep; const char* b2 = last ? nB : cB + (size_t)(t + 2) * kstep;
            const char* a3 = a2 + kstep; const char* b3 = b2 + kstep;
            if (last && has_next) S.a_ready(nxt);
            PG8_LDB(B0, 0, 0); PG8_SCHED; PG8_LDA(At, 0, 0); PG8_STAGE(PG8_SA(1, 1), a1 + hstep, voffA);
            PG8_WAIT_L(8); PG8_BAR; PG8_WAIT_L(0); PG8_MMA(0, 0, At, B0); PG8_BAR; PG8_SCHED;
            PG8_LDB(B1, 0, 1); PG8_STAGE(PG8_SB(0, 0), b2, voffB);
            PG8_BAR; PG8_WAIT_L(0); PG8_MMA(0, 1, At, B1); PG8_BAR;
            PG8_LDA(At, 0, 1); PG8_STAGE(PG8_SA(0, 0), a2, voffA);
            PG8_BAR; PG8_WAIT_L(0); PG8_MMA(1, 0, At, B0); PG8_BAR; PG8_SCHED;
            PG8_STAGE(PG8_SB(0, 1), b2 + hstep, voffB);
            PG8_WAIT_V(6); PG8_BAR; PG8_MMA(1, 1, At, B1); PG8_BAR;
            PG8_LDB(B0, 1, 0); PG8_SCHED; PG8_LDA(At, 1, 0); PG8_STAGE(PG8_SA(0, 1), a2 + hstep, voffA);
            PG8_WAIT_L(8); PG8_BAR; PG8_WAIT_L(0); PG8_MMA(0, 0, At, B0); PG8_BAR; PG8_SCHED;
            PG8_LDB(B1, 1, 1); PG8_STAGE(PG8_SB(1, 0), b3, voffB);
            PG8_BAR; PG8_WAIT_L(0); PG8_MMA(0, 1, At, B1); PG8_BAR;
            PG8_LDA(At, 1, 1); PG8_STAGE(PG8_SA(1, 0), a3, voffA);
            PG8_BAR; PG8_WAIT_L(0); PG8_MMA(1, 0, At, B0); PG8_BAR; PG8_SCHED;
            PG8_STAGE(PG8_SB(1, 1), b3 + hstep, voffB);
            PG8_WAIT_V(6); PG8_BAR; PG8_MMA(1, 1, At, B1); PG8_BAR;
        }
        PG8_STAMP();
        if constexpr (!Epi::AFTER_DRAIN) { E(acc, cur, wr, wc, fr, fq); S.done(cur); }
        PG8_STAMP();
        if (!has_next) break;
#pragma unroll
        for (int a = 0; a < 2; ++a)
#pragma unroll
            for (int b = 0; b < 2; ++b)
#pragma unroll
                for (int m = 0; m < 4; ++m)
#pragma unroll
                    for (int n = 0; n < 2; ++n) acc[a][b][m][n] = (f32x4){0.f, 0.f, 0.f, 0.f};
        cur = nxt; cA = nA; cB = nB; ++ui;
    }
    PG8_WAIT_V(0);
    if (wr == 0) PG8_BAR;
    PG8_BAR;
    if constexpr (Epi::AFTER_DRAIN) { E.fused(acc, cur, wr, wc, fr, fq, lds, wid, lane); S.done(cur); }
    PG8_STAMP();
    if (STAMP && wid == 0) { stamps[lane] = lane < nts ? (((unsigned long long)(unsigned)ts_hi << 32) | (unsigned)ts_lo) : 0ull;
        if (lane == 62) stamps[62] = rt_entry; if (lane == 63) stamps[63] = (unsigned long long)wall_clock64(); }
#undef PG8_STAMP
#undef PG8_SA
#undef PG8_SB
#undef PG8_STAGE
#undef PG8_LDA
#undef PG8_LDB
#undef PG8_MMA
#undef PG8_WAIT_V
#undef PG8_WAIT_L
#undef PG8_BAR
#undef PG8_SCHED
}
}
namespace mk {
using pg8::bf16_t; using pg8::bf16x8; using pg8::f32x4; using pg8::u32x4; using pg8::cvt_pk_bf16;
typedef float f32x16 __attribute__((ext_vector_type(16)));
typedef float f32x2 __attribute__((ext_vector_type(2)));
typedef unsigned u32x2 __attribute__((ext_vector_type(2)));
constexpr int D = 1024, NB = 32, SEQ = 2048, M = NB * SEQ, NH = 8, DH = 64;
constexpr int RWC = 1792, GC = 2048, INC = 5376, DFF = 2816;
constexpr float RMS_EPS = 1e-6f, GN_EPS = 64e-5f;
constexpr size_t MiB = (size_t)1 << 20;
constexpr size_t O_WIN = 0, O_WSB = 11 * MiB, O_WRW = 12 * MiB, O_WO = 13 * MiB, O_WGU = 15 * MiB, O_WDN = 26 * MiB, O_WLU = 32 * MiB  , O_WLA = O_WLU + 65536, O_WLG = O_WLA + 65536;
constexpr size_t O_Q = 34 * MiB, O_K = 98 * MiB, O_VT = 162 * MiB, O_PRW = 226 * MiB, O_H = 450 * MiB, O_SI = 450 * MiB, O_G = 834 * MiB, O_SC = 898 * MiB, O_YR = 290 * MiB  ;
constexpr size_t O_OSB = 226 * MiB, O_ORW = 34 * MiB, O_T1 = 98 * MiB, O_MRG = 450 * MiB, O_TT = 34 * MiB, O_H2 = 162 * MiB, O_HID = 290 * MiB, O_FF = 34 * MiB;
constexpr size_t WS_NEED = 906 * MiB;
constexpr int LDS_BYTES = pg8::STAGE_BYTES;
constexpr int NPH = 12;

struct Args { const float* in[24]; float* out; unsigned char* ws; int ph_lo, ph_hi; };

__device__ __forceinline__ int my_tid() { int t = threadIdx.x; asm volatile("" : "+v"(t)); return t; }
__device__ __forceinline__ float bf_lo(unsigned u) { return __uint_as_float(u << 16); }
__device__ __forceinline__ float bf_hi(unsigned u) { return __uint_as_float(u & 0xffff0000u); }
__device__ __forceinline__ float fexp(float x) { return __builtin_amdgcn_exp2f(x * 1.44269504089f); }
__device__ __forceinline__ float flog(float x) { return __builtin_amdgcn_logf(x) * 0.69314718056f; }
__device__ __forceinline__ float frcp(float x) { return __builtin_amdgcn_rcpf(x); }
__device__ __forceinline__ float fsigmoid(float x) { return frcp(1.f + fexp(-x)); }
__device__ __forceinline__ unsigned short bf1(float x) { return (unsigned short)(cvt_pk_bf16(x, x) & 0xffffu); }
__device__ __forceinline__ u32x4 pack8(const f32x4 a, const f32x4 b) { u32x4 o; o.x = cvt_pk_bf16(a[0], a[1]); o.y = cvt_pk_bf16(a[2], a[3]); o.z = cvt_pk_bf16(b[0], b[1]); o.w = cvt_pk_bf16(b[2], b[3]); return o; }
__device__ __forceinline__ float red16(float v) {
    v += __shfl_xor(v, 16); v += __shfl_xor(v, 32); return v;
}
__device__ __forceinline__ float wave_sum(float v) {
#pragma unroll
    for (int o = 1; o < 64; o <<= 1) v += __shfl_xor(v, o);
    return v;
}

__device__ __forceinline__ void tr_item(const float* __restrict__ W, int K, int N, bf16_t* WT, float* scr, int item, int lane, int mode) {
    const int nblk = N >> 5, kb = item / nblk, nb = item - kb * nblk, k0 = kb << 6, n0 = nb << 5;
#pragma unroll 8
    for (int i = 0; i < 32; ++i) { const int kk = 2 * i + (lane >> 5); scr[kk * 33 + (lane & 31)] = W[(size_t)(k0 + kk) * N + n0 + (lane & 31)]; }
    asm volatile("s_waitcnt lgkmcnt(0)" ::: "memory"); __builtin_amdgcn_wave_barrier();
    const int c = lane & 7;
#pragma unroll
    for (int j = 0; j < 4; ++j) {
        const int n = (lane >> 3) + 8 * j; const float* s = scr + (8 * c) * 33 + n;
        u32x4 o; o.x = cvt_pk_bf16(s[0 * 33], s[1 * 33]); o.y = cvt_pk_bf16(s[2 * 33], s[3 * 33]); o.z = cvt_pk_bf16(s[4 * 33], s[5 * 33]); o.w = cvt_pk_bf16(s[6 * 33], s[7 * 33]);
        const int nn = n0 + n; int drow = nn;
        if (mode == 1) drow = ((nn >> 7) << 8) + (nn & 127); else if (mode == 2) drow = ((nn >> 7) << 8) + 128 + (nn & 127);
        *(u32x4*)(WT + (size_t)drow * K + k0 + 8 * c) = o;
    }
    asm volatile("s_waitcnt lgkmcnt(0)" ::: "memory"); __builtin_amdgcn_wave_barrier();
}

__device__ __forceinline__ void phase_prep(const Args& a, float* lds_f, int G) {
    const int tid = my_tid(); const int wave = tid >> 6, lane = tid & 63;
    const int gw = blockIdx.x * 8 + wave, NGW = G * 8;
    float* scr = lds_f + wave * (64 * 33 + 16);
    unsigned char* ws = a.ws;
    constexpr int I_IN = 16 * 168, I_SB = 8 * 32, I_O = 16 * 32, I_G = 16 * 88, I_DN = 44 * 32, I_LU = 16, I_LG = 32;
    constexpr int NIT = I_IN + 2 * I_SB + I_O + 2 * I_G + I_DN + 2 * I_LU + I_LG;
    for (int it = gw; it < NIT; it += NGW) {
        int r = it;
        if (r < I_IN) { tr_item(a.in[2], 1024, INC, (bf16_t*)(ws + O_WIN), scr, r, lane, 0); continue; } r -= I_IN;
        if (r < I_SB) { tr_item(a.in[15], 512, 1024, (bf16_t*)(ws + O_WSB), scr, r, lane, 0); continue; } r -= I_SB;
        if (r < I_SB) { tr_item(a.in[16], 512, 1024, (bf16_t*)(ws + O_WRW), scr, r, lane, 0); continue; } r -= I_SB;
        if (r < I_O) { tr_item(a.in[17], 1024, 1024, (bf16_t*)(ws + O_WO), scr, r, lane, 0); continue; } r -= I_O;
        if (r < I_G) { tr_item(a.in[20], 1024, DFF, (bf16_t*)(ws + O_WGU), scr, r, lane, 1); continue; } r -= I_G;
        if (r < I_G) { tr_item(a.in[21], 1024, DFF, (bf16_t*)(ws + O_WGU), scr, r, lane, 2); continue; } r -= I_G;
        if (r < I_DN) { tr_item(a.in[22], DFF, 1024, (bf16_t*)(ws + O_WDN), scr, r, lane, 0); continue; } r -= I_DN;
        if (r < I_LU) { tr_item(a.in[6], 64, 512, (bf16_t*)(ws + O_WLU), scr, r, lane, 0); continue; } r -= I_LU;
        if (r < I_LU) { tr_item(a.in[8], 64, 512, (bf16_t*)(ws + O_WLA), scr, r, lane, 0); continue; } r -= I_LU;
        tr_item(a.in[9], 128, 512, (bf16_t*)(ws + O_WLG), scr, r, lane, 0);
    }
    const float* x = a.in[0]; const float* g = a.in[1]; bf16_t* H = (bf16_t*)(ws + O_H);
    f32x4 gv[4];
#pragma unroll
    for (int j = 0; j < 4; ++j) gv[j] = ((const f32x4*)g)[lane + 64 * j];
    for (int row0 = gw; row0 < M; row0 += 2 * NGW) {
        f32x4 v[2][4];
#pragma unroll
        for (int u = 0; u < 2; ++u) { const int row = (row0 + u * NGW < M) ? row0 + u * NGW : row0; const f32x4* xr = (const f32x4*)(x + (size_t)row * D) + lane;
#pragma unroll
            for (int j = 0; j < 4; ++j) v[u][j] = xr[64 * j]; }
#pragma unroll
        for (int u = 0; u < 2; ++u) { const int row = row0 + u * NGW; float s = 0.f;
#pragma unroll
            for (int j = 0; j < 4; ++j) s += (v[u][j][0] * v[u][j][0] + v[u][j][1] * v[u][j][1]) + (v[u][j][2] * v[u][j][2] + v[u][j][3] * v[u][j][3]);
            const float rs = rsqrtf(wave_sum(s) * (1.f / D) + RMS_EPS);
            if (row < M) { u32x2* o = (u32x2*)(H + (size_t)row * D) + lane;
#pragma unroll
                for (int j = 0; j < 4; ++j) { u32x2 w; w.x = cvt_pk_bf16(v[u][j][0] * rs * gv[j][0], v[u][j][1] * rs * gv[j][1]); w.y = cvt_pk_bf16(v[u][j][2] * rs * gv[j][2], v[u][j][3] * rs * gv[j][3]); o[64 * j] = w; } }
        }
    }
}

struct Epi1 {
    static constexpr bool PERM = true, AFTER_DRAIN = false;
    bf16_t *Q, *Kb, *Vt, *Prw, *Gt; const float* bgate;
    __device__ __forceinline__ void operator()(const f32x4 (&acc)[2][2][4][2], const pg8::Unit& u, int wr, int wc, int fr, int fq) const {
        const int row0 = u.pm * 256 + wr * 64 + fr, pn = u.pn, cl = wc * 32 + 8 * fq;
        if (pn < 4) {
            bf16_t* dst = pn < 2 ? Q : Kb; const float sc = pn < 2 ? 0.125f : 1.f; const int cb = (pn & 1) * 256 + cl;
#pragma unroll
            for (int ai = 0; ai < 2; ++ai)
#pragma unroll
                for (int m = 0; m < 4; ++m) { bf16_t* rp = dst + (size_t)(row0 + ai * 128 + m * 16) * 512 + cb;
#pragma unroll
                    for (int bj = 0; bj < 2; ++bj) *(u32x4*)(rp + bj * 128) = pack8(acc[ai][bj][m][0] * sc, acc[ai][bj][m][1] * sc); }
        } else if (pn < 6) {
#pragma unroll
            for (int ai = 0; ai < 2; ++ai)
#pragma unroll
                for (int m = 0; m < 4; ++m) { const int row = row0 + ai * 128 + m * 16, b = row >> 11, s = row & 2047;
#pragma unroll
                    for (int bj = 0; bj < 2; ++bj)
#pragma unroll
                        for (int n = 0; n < 2; ++n)
#pragma unroll
                            for (int j = 0; j < 4; ++j) { const int c = (pn - 4) * 256 + bj * 128 + cl + 4 * n + j;
                                Vt[((size_t)(b * 512 + c)) * 2048 + s] = bf1(acc[ai][bj][m][n][j]); } }
        } else if (pn < 13) {
            const int cb = (pn - 6) * 256 + cl;
#pragma unroll
            for (int ai = 0; ai < 2; ++ai)
#pragma unroll
                for (int m = 0; m < 4; ++m) { bf16_t* rp = Prw + (size_t)(row0 + ai * 128 + m * 16) * RWC + cb;
#pragma unroll
                    for (int bj = 0; bj < 2; ++bj) *(u32x4*)(rp + bj * 128) = pack8(acc[ai][bj][m][0], acc[ai][bj][m][1]); }
        } else {
            const int cb = (pn - 13) * 256 + cl;
#pragma unroll
            for (int ai = 0; ai < 2; ++ai)
#pragma unroll
                for (int m = 0; m < 4; ++m) { bf16_t* rp = Gt + (size_t)(row0 + ai * 128 + m * 16) * GC + cb;
#pragma unroll
                    for (int bj = 0; bj < 2; ++bj) { f32x4 v0 = acc[ai][bj][m][0] + *(const f32x4*)(bgate + cb + bj * 128), v1 = acc[ai][bj][m][1] + *(const f32x4*)(bgate + cb + bj * 128 + 4);
#pragma unroll
                        for (int j = 0; j < 4; ++j) { v0[j] = fsigmoid(v0[j]); v1[j] = fsigmoid(v1[j]); }
                        *(u32x4*)(rp + bj * 128) = pack8(v0, v1); } }
        }
    }
};
template <int MODE> struct EpiRow {
    static constexpr bool PERM = true, AFTER_DRAIN = false;
    bf16_t* O; const bf16_t* T1; const bf16_t* Gt;
    __device__ __forceinline__ void operator()(const f32x4 (&acc)[2][2][4][2], const pg8::Unit& u, int wr, int wc, int fr, int fq) const {
        const int row0 = u.pm * 256 + wr * 64 + fr, cb = u.pn * 256 + wc * 32 + 8 * fq;
#pragma unroll
        for (int ai = 0; ai < 2; ++ai)
#pragma unroll
            for (int m = 0; m < 4; ++m) { const size_t row = (size_t)(row0 + ai * 128 + m * 16);
#pragma unroll
                for (int bj = 0; bj < 2; ++bj) { f32x4 v0 = acc[ai][bj][m][0], v1 = acc[ai][bj][m][1]; const int c = cb + bj * 128;
                    if (MODE >= 1) { const u32x4 gg = *(const u32x4*)(Gt + row * GC + (MODE == 2 ? 1024 : 0) + c);
                        v0[0] *= bf_lo(gg.x); v0[1] *= bf_hi(gg.x); v0[2] *= bf_lo(gg.y); v0[3] *= bf_hi(gg.y); v1[0] *= bf_lo(gg.z); v1[1] *= bf_hi(gg.z); v1[2] *= bf_lo(gg.w); v1[3] *= bf_hi(gg.w); }
                    if (MODE == 2) { const u32x4 tt = *(const u32x4*)(T1 + row * 1024 + c);
                        v0[0] += bf_lo(tt.x); v0[1] += bf_hi(tt.x); v0[2] += bf_lo(tt.y); v0[3] += bf_hi(tt.y); v1[0] += bf_lo(tt.z); v1[1] += bf_hi(tt.z); v1[2] += bf_lo(tt.w); v1[3] += bf_hi(tt.w); }
                    *(u32x4*)(O + row * 1024 + c) = pack8(v0, v1); } }
    }
};
struct EpiSwiGLU {
    static constexpr bool PERM = true, AFTER_DRAIN = false;
    bf16_t* Hd;
    __device__ __forceinline__ void operator()(const f32x4 (&acc)[2][2][4][2], const pg8::Unit& u, int wr, int wc, int fr, int fq) const {
        const int row0 = u.pm * 256 + wr * 64 + fr, cb = u.pn * 128 + wc * 32 + 8 * fq;
#pragma unroll
        for (int ai = 0; ai < 2; ++ai)
#pragma unroll
            for (int m = 0; m < 4; ++m) { f32x4 v0, v1;
#pragma unroll
                for (int j = 0; j < 4; ++j) { const float g0 = acc[ai][0][m][0][j], g1 = acc[ai][0][m][1][j];
                    v0[j] = g0 * fsigmoid(g0) * acc[ai][1][m][0][j]; v1[j] = g1 * fsigmoid(g1) * acc[ai][1][m][1][j]; }
                *(u32x4*)(Hd + (size_t)(row0 + ai * 128 + m * 16) * DFF + cb) = pack8(v0, v1); }
    }
};
template <class Epi> __device__ __forceinline__ void run_gemm(PG8_LAS unsigned char* lds, const bf16_t* A, const bf16_t* Bt, int N, int K, const Epi& E, int G) {
    pg8::Gemm g; g.A = A; g.Bt = Bt; g.M = M; g.N = N; g.K = K;
    pg8::StaticOrder S; S.init(M, N, G, (int)blockIdx.x);
    pg8::gemm_phase<Epi, pg8::StaticOrder, false>(lds, g, S, E, nullptr);
}
__device__ __forceinline__ void mix8_lds(const unsigned char* cur, const unsigned char* prv, const float* mu, float (&o)[8]) {
    const u32x4 c = *(const u32x4*)cur, p = *(const u32x4*)prv;
    const f32x4 m0 = *(const f32x4*)mu, m1 = *(const f32x4*)(mu + 4);
    const float mm[8] = {m0[0], m0[1], m0[2], m0[3], m1[0], m1[1], m1[2], m1[3]};
#pragma unroll
    for (int i = 0; i < 4; ++i) { const float cl = bf_lo(c[i]), ch = bf_hi(c[i]), pl = bf_lo(p[i]), ph = bf_hi(p[i]);
        o[2 * i] = cl + (pl - cl) * mm[2 * i]; o[2 * i + 1] = ch + (ph - ch) * mm[2 * i + 1]; }
}
__device__ __forceinline__ void mix4_lds(const unsigned char* cur, const unsigned char* prv, const float* mu, float (&o)[4]) {
    const u32x2 c = *(const u32x2*)cur, p = *(const u32x2*)prv;
    const f32x4 m0 = *(const f32x4*)mu;
#pragma unroll
    for (int i = 0; i < 2; ++i) { const float cl = bf_lo(c[i]), ch = bf_hi(c[i]), pl = bf_lo(p[i]), ph = bf_hi(p[i]);
        o[2 * i] = cl + (pl - cl) * m0[2 * i]; o[2 * i + 1] = ch + (ph - ch) * m0[2 * i + 1]; }
}
__device__ __forceinline__ bf16x8 pack_frag(const float (&v)[8]) {
    u32x4 o; o.x = cvt_pk_bf16(v[0], v[1]); o.y = cvt_pk_bf16(v[2], v[3]); o.z = cvt_pk_bf16(v[4], v[5]); o.w = cvt_pk_bf16(v[6], v[7]);
    return __builtin_bit_cast(bf16x8, o);
}
__device__ __forceinline__ void phase_rwprep(const Args& a, unsigned char* lds, int G) {
    constexpr int ROWB = 3600, L_FRAG = 17 * ROWB, L_PAR = L_FRAG + 8192, NCH = 17 * 224, NT = M / 16;
    const int tid = my_tid(); const int wave = __builtin_amdgcn_readfirstlane(tid >> 6), lane = tid & 63, fr = lane & 15, fq = lane >> 4;
    unsigned char* ws = a.ws;
    const unsigned char* PRW = ws + O_PRW;
    const bf16_t* WLU = (const bf16_t*)(ws + O_WLU); const bf16_t* WLA = (const bf16_t*)(ws + O_WLA); const bf16_t* WLG = (const bf16_t*)(ws + O_WLG);
    unsigned char* SI = ws + O_SI; bf16_t* GB = (bf16_t*)(ws + O_G); float* SC = (float*)(ws + O_SC);
    float* par = (float*)(lds + L_PAR);
    for (int i = tid; i < 1792 + 5 * 512; i += 512) {
        float v;
        if (i < 1792) v = a.in[4][i]; else { const int j = i - 1792, w = j >> 9, c = j & 511; v = (w == 0 ? a.in[5] : w == 1 ? a.in[7] : w == 2 ? a.in[10] : w == 3 ? a.in[11] : a.in[12])[c]; }
        par[i] = v;
    }
    for (int tile = blockIdx.x; tile < NT; tile += G) {
        __syncthreads();
        {   u32x4 pre[8];
#pragma unroll
            for (int j = 0; j < 8; ++j) { const int c = tid + 512 * j; pre[j] = (u32x4){0u, 0u, 0u, 0u};
                if (c < NCH) { const int row = c / 224, col = c - row * 224; const bool zero = (row == 0) && (((tile * 16) & (SEQ - 1)) == 0);
                    if (!zero) pre[j] = *(const u32x4*)(PRW + ((size_t)tile * 16 + row - 1) * (RWC * 2) + col * 16); } }
#pragma unroll
            for (int j = 0; j < 8; ++j) { const int c = tid + 512 * j; if (c < NCH) { const int row = c / 224, col = c - row * 224; *(u32x4*)(lds + row * ROWB + col * 16) = pre[j]; } }
        }
        __syncthreads();
        const unsigned char* rcur = lds + (fr + 1) * ROWB; const unsigned char* rprv = lds + fr * ROWB;
        {
            const int colb = wave < 2 ? 1536 + 32 * wave : (wave < 4 ? 1600 + 32 * (wave - 2) : 1664 + 32 * (wave - 4));
            float t8[8]; mix8_lds(rcur + (colb + 8 * fq) * 2, rprv + (colb + 8 * fq) * 2, par + colb + 8 * fq, t8);
            if (wave < 2) {
#pragma unroll
                for (int i = 0; i < 8; ++i) { const float e = fexp(2.f * t8[i]); t8[i] = 1.f - 2.f * frcp(e + 1.f); } }
            else if (wave >= 4) {
#pragma unroll
                for (int i = 0; i < 8; ++i) t8[i] = fsigmoid(t8[i]); }
            *(bf16x8*)(lds + L_FRAG + wave * 1024 + lane * 16) = pack_frag(t8);
        }
        __syncthreads();
        bf16x8 Aw[2], Aa[2], Ag[4];
#pragma unroll
        for (int s = 0; s < 2; ++s) { Aw[s] = *(const bf16x8*)(lds + L_FRAG + s * 1024 + lane * 16); Aa[s] = *(const bf16x8*)(lds + L_FRAG + (2 + s) * 1024 + lane * 16); }
#pragma unroll
        for (int s = 0; s < 4; ++s) Ag[s] = *(const bf16x8*)(lds + L_FRAG + (4 + s) * 1024 + lane * 16);
        const int h = wave; const size_t m = (size_t)tile * 16 + fr;
        float kkr[16], av[16]; unsigned lk[16], rvp[16];
        float ss = 0.f, brs = 0.f, krs = 0.f, rkbs = 0.f;
#pragma unroll
        for (int n = 0; n < 4; ++n) {
            asm volatile("" ::: "memory");
            const int cb = 64 * h + 16 * n, c0 = cb + 4 * fq;
            f32x4 aw = {0.f, 0.f, 0.f, 0.f}, aa = aw, ag = aw;
#pragma unroll
            for (int s = 0; s < 2; ++s) {
                aw = __builtin_amdgcn_mfma_f32_16x16x32_bf16(*(const bf16x8*)(WLU + (size_t)(cb + fr) * 64 + 32 * s + 8 * fq), Aw[s], aw, 0, 0, 0);
                aa = __builtin_amdgcn_mfma_f32_16x16x32_bf16(*(const bf16x8*)(WLA + (size_t)(cb + fr) * 64 + 32 * s + 8 * fq), Aa[s], aa, 0, 0, 0); }
#pragma unroll
            for (int s = 0; s < 4; ++s)
                ag = __builtin_amdgcn_mfma_f32_16x16x32_bf16(*(const bf16x8*)(WLG + (size_t)(cb + fr) * 128 + 32 * s + 8 * fq), Ag[s], ag, 0, 0, 0);
            float rr[4], kr4[4], vv[4];
            mix4_lds(rcur + c0 * 2, rprv + c0 * 2, par + c0, rr); mix4_lds(rcur + (512 + c0) * 2, rprv + (512 + c0) * 2, par + 512 + c0, kr4); mix4_lds(rcur + (1024 + c0) * 2, rprv + (1024 + c0) * 2, par + 1024 + c0, vv);
            const f32x4 w0v = *(const f32x4*)(par + 1792 + c0), a0v = *(const f32x4*)(par + 2304 + c0), kkv = *(const f32x4*)(par + 2816 + c0), kav = *(const f32x4*)(par + 3328 + c0), rkv = *(const f32x4*)(par + 3840 + c0);
#pragma unroll
            for (int j = 0; j < 4; ++j) {
                const float sg = fsigmoid(w0v[j] + aw[j]);
                const float ldx = -0.60653065971f * 1.44269504089f * sg;
                const float av_ = fsigmoid(a0v[j] + aa[j]);
                const float kkraw = kr4[j] * kkv[j];
                const float k2 = kr4[j] * (1.f + (av_ - 1.f) * kav[j]);
                ss += kkraw * kkraw; brs += kkraw * av_ * rr[j]; krs += k2 * rr[j]; rkbs += rr[j] * k2 * rkv[j];
                kkr[4 * n + j] = kkraw; av[4 * n + j] = av_; lk[4 * n + j] = cvt_pk_bf16(ldx, k2); rvp[4 * n + j] = cvt_pk_bf16(rr[j], vv[j]);
            }
            u32x2 gp; gp.x = cvt_pk_bf16(ag[0], ag[1]); gp.y = cvt_pk_bf16(ag[2], ag[3]);
            *(u32x2*)(GB + m * 512 + c0) = gp;
        }
        ss = red16(ss); brs = red16(brs); krs = red16(krs); rkbs = red16(rkbs);
        const float inv = 1.f / fmaxf(sqrtf(ss), 1e-12f);
        unsigned char* rec = SI + ((m * 8 + h) * 64) * 12;
#pragma unroll
        for (int n = 0; n < 4; ++n) {
            unsigned dw[12];
#pragma unroll
            for (int j = 0; j < 4; ++j) { const float kk = kkr[4 * n + j] * inv;
                const unsigned kp = cvt_pk_bf16(kk * av[4 * n + j], -kk);
                dw[3 * j] = (lk[4 * n + j] & 0xffffu) | (kp & 0xffff0000u); dw[3 * j + 1] = (kp & 0xffffu) | (lk[4 * n + j] & 0xffff0000u); dw[3 * j + 2] = rvp[4 * n + j]; }
            u32x4* dst = (u32x4*)(rec + (16 * n + 4 * fq) * 12);
            u32x4 s0 = {dw[0], dw[1], dw[2], dw[3]}, s1 = {dw[4], dw[5], dw[6], dw[7]}, s2 = {dw[8], dw[9], dw[10], dw[11]};
            dst[0] = s0; dst[1] = s1; dst[2] = s2;
        }
        if (fq == 0) { f32x4 scv = {brs * inv, krs, rkbs, 0.f}; *(f32x4*)(SC + (m * 8 + h) * 4) = scv; }
    }
    __syncthreads();
}

__device__ __forceinline__ float red_rows(float x) {
    float a0 = x, a1 = x;
    asm volatile("s_nop 1\n\tv_permlane16_swap_b32 %0, %1" : "+v"(a0), "+v"(a1));
    float b0 = a0 + a1, b1 = b0;
    asm volatile("s_nop 1\n\tv_permlane32_swap_b32 %0, %1" : "+v"(b0), "+v"(b1));
    return b0 + b1;
}
constexpr int SC_T = 16, SC_ROW = 1552, SC_BUF = SC_T * SC_ROW;
struct ProdRec { unsigned d0, d1, d2; f32x2 sc; };
__device__ __forceinline__ void prod_load(ProdRec (&P)[4], const unsigned char* sb, const float* scp, int chunk, int pl) {
    const int col = pl & 63;
#pragma unroll
    for (int q = 0; q < 4; ++q) { const size_t t = (size_t)chunk * SC_T + (pl >> 6) + 4 * q;
        const unsigned* p = (const unsigned*)(sb + t * 6144 + col * 12); P[q].d0 = p[0]; P[q].d1 = p[1]; P[q].d2 = p[2];
        P[q].sc = (f32x2){0.f, 0.f}; if (col == 0) P[q].sc = *(const f32x2*)(scp + t * 32); }
}
__device__ __forceinline__ void prod_store(const ProdRec (&P)[4], unsigned char* buf, int pl) {
    const int col = pl & 63;
#pragma unroll
    for (int q = 0; q < 4; ++q) { unsigned char* base = buf + ((pl >> 6) + 4 * q) * SC_ROW + col * 4;
        const float w = __builtin_amdgcn_exp2f(bf_lo(P[q].d0));
        *(float*)(base) = bf_hi(P[q].d0); *(float*)(base + 256) = w * bf_lo(P[q].d2); *(float*)(base + 512) = w;
        *(float*)(base + 768) = bf_lo(P[q].d1); *(float*)(base + 1024) = bf_hi(P[q].d1); *(float*)(base + 1280) = bf_hi(P[q].d2);
        if (col == 0) *(f32x2*)(base + 1536) = P[q].sc; }
}
#define MK_SWAP32(a, b) asm volatile("s_nop 1\n\tv_permlane32_swap_b32 %0, %1" : "+v"(a), "+v"(b))
#define MK_SWAP16(a, b) asm volatile("s_nop 1\n\tv_permlane16_swap_b32 %0, %1" : "+v"(a), "+v"(b))
__device__ __forceinline__ void red4x8(float& A, float& B, float& C, float& D) {
    MK_SWAP32(A, B); float u = A + B;
    MK_SWAP32(C, D); float w = C + D;
    MK_SWAP16(u, w); float z = u + w;
    float z1;
    asm volatile("s_nop 1\n\tv_add_f32_dpp %0, %1, %1 row_ror:8 row_mask:0xf bank_mask:0xf" : "=&v"(z1) : "v"(z));
    float p = z1, q = z1; MK_SWAP32(p, q);
    float p2 = p; MK_SWAP16(p, p2);
    float q2 = q; MK_SWAP16(q, q2);
    A = p; C = p2; B = q; D = q2;
}
__device__ __forceinline__ void scan_consume(f32x2 (&S)[8], const unsigned char* buf, unsigned* yr, int lane, int rb) {
    const unsigned co = (unsigned)(lane >> 3) * 32u, vo = 1280u + (unsigned)(16 * rb + (lane & 7)) * 4u;
#pragma unroll 2
    for (int st = 0; st < SC_T; ++st) {
        const unsigned char* sb = buf + st * SC_ROW;
        f32x4 n4[2], r4[2], w4[2], a4[2], k4[2];
#pragma unroll
        for (int q = 0; q < 2; ++q) { n4[q] = *(const f32x4*)(sb + co + 16 * q); r4[q] = *(const f32x4*)(sb + 256 + co + 16 * q); w4[q] = *(const f32x4*)(sb + 512 + co + 16 * q);
            a4[q] = *(const f32x4*)(sb + 768 + co + 16 * q); k4[q] = *(const f32x4*)(sb + 1024 + co + 16 * q); }
        const float v0 = *(const float*)(sb + vo), v1 = *(const float*)(sb + vo + 32); const f32x2 bk = *(const f32x2*)(sb + 1536);
        f32x2 sa0v = {0.f, 0.f}, sa1v = sa0v, yp0v = sa0v, yp1v = sa0v;
#pragma unroll
        for (int p = 0; p < 4; ++p) { const f32x2 nn = {n4[p >> 1][2 * (p & 1)], n4[p >> 1][2 * (p & 1) + 1]}, rr2 = {r4[p >> 1][2 * (p & 1)], r4[p >> 1][2 * (p & 1) + 1]};
            sa0v += S[p] * nn; sa1v += S[4 + p] * nn; yp0v += S[p] * rr2; yp1v += S[4 + p] * rr2; }
        float sa0 = sa0v[0] + sa0v[1], sa1 = sa1v[0] + sa1v[1], yp0 = yp0v[0] + yp0v[1], yp1 = yp1v[0] + yp1v[1];
        red4x8(sa0, sa1, yp0, yp1);
        const f32x2 s0 = {sa0, sa0}, s1 = {sa1, sa1}, vv0 = {v0, v0}, vv1 = {v1, v1};
#pragma unroll
        for (int p = 0; p < 4; ++p) { const f32x2 ww = {w4[p >> 1][2 * (p & 1)], w4[p >> 1][2 * (p & 1) + 1]}, aa = {a4[p >> 1][2 * (p & 1)], a4[p >> 1][2 * (p & 1) + 1]}, kk = {k4[p >> 1][2 * (p & 1)], k4[p >> 1][2 * (p & 1) + 1]};
            S[p] = S[p] * ww + aa * s0 + kk * vv0; S[4 + p] = S[4 + p] * ww + aa * s1 + kk * vv1; }
        const float y0 = yp0 + sa0 * bk[0] + v0 * bk[1], y1 = yp1 + sa1 * bk[0] + v1 * bk[1];
        if (lane < 16) { const bool hi = (lane & 8) != 0;
            yr[(size_t)st * 512 + lane] = (unsigned)bf1(hi ? y1 : y0) | (__float_as_uint(hi ? v1 : v0) & 0xffff0000u); }
    }
}

__device__ __forceinline__ void rwpost_local(const Args& a, int bh, int tid) {
    const float* SC = (const float*)(a.ws + O_SC);
    const unsigned* YR = (const unsigned*)(a.ws + O_YR); const bf16_t* GB = (const bf16_t*)(a.ws + O_G); bf16_t* ORW = (bf16_t*)(a.ws + O_ORW);
    const int b = bh >> 3, h = bh & 7, c = 64 * h + (tid & 15) * 4;
    const f32x4 lwv = *(const f32x4*)(a.in[13] + c), lbv = *(const f32x4*)(a.in[14] + c);
    for (int t0 = tid >> 4; t0 < SEQ; t0 += 64) {
        u32x4 yv[2]; u32x2 gb[2]; float rkb[2]; size_t mm[2];
#pragma unroll
        for (int u = 0; u < 2; ++u) { const size_t m = (size_t)b * SEQ + t0 + 32 * u; mm[u] = m;
            yv[u] = *(const u32x4*)(YR + m * 512 + c); gb[u] = *(const u32x2*)(GB + m * 512 + c); rkb[u] = SC[(m * 8 + h) * 4 + 2]; }
#pragma unroll
        for (int u = 0; u < 2; ++u) {
            float y[4] = {bf_lo(yv[u].x), bf_lo(yv[u].y), bf_lo(yv[u].z), bf_lo(yv[u].w)};
            const float v[4] = {bf_hi(yv[u].x), bf_hi(yv[u].y), bf_hi(yv[u].z), bf_hi(yv[u].w)};
            float s = (y[0] + y[1]) + (y[2] + y[3]);
#pragma unroll
            for (int o = 1; o < 16; o <<= 1) s += __shfl_xor(s, o);
            const float mean = s * (1.f / 64.f);
            float q = 0.f;
#pragma unroll
            for (int j = 0; j < 4; ++j) { y[j] -= mean; q += y[j] * y[j]; }
#pragma unroll
            for (int o = 1; o < 16; o <<= 1) q += __shfl_xor(q, o);
            const float rstd = rsqrtf(q * (1.f / 64.f) + GN_EPS);
            const float g4[4] = {bf_lo(gb[u].x), bf_hi(gb[u].x), bf_lo(gb[u].y), bf_hi(gb[u].y)};
            float o4[4];
#pragma unroll
            for (int j = 0; j < 4; ++j) o4[j] = (y[j] * rstd * lwv[j] + lbv[j] + rkb[u] * v[j]) * g4[j];
            u32x2 ob; ob.x = cvt_pk_bf16(o4[0], o4[1]); ob.y = cvt_pk_bf16(o4[2], o4[3]);
            *(u32x2*)(ORW + mm[u] * 512 + c) = ob;
        }
    }
}

struct KV { bf16x8 k[4]; bf16x8 v[2][2]; };
__device__ __forceinline__ void attn_load(KV& T, const bf16_t* Kh, const bf16_t* Vh, int k0, int n, int hf) {
    const bf16_t* kp = Kh + (size_t)(k0 + n) * 512 + 8 * hf;
#pragma unroll
    for (int s = 0; s < 4; ++s) T.k[s] = *(const bf16x8*)(kp + 16 * s);
#pragma unroll
    for (int d = 0; d < 2; ++d)
#pragma unroll
        for (int sg = 0; sg < 2; ++sg) { const bf16_t* vp = Vh + (size_t)(32 * d + n) * SEQ + k0 + 16 * sg + 4 * hf;
            const u32x2 lo = *(const u32x2*)vp, hi = *(const u32x2*)(vp + 8); u32x4 t = {lo.x, lo.y, hi.x, hi.y}; T.v[d][sg] = __builtin_bit_cast(bf16x8, t); }
}
__device__ __forceinline__ void attn_wave(const Args& a, int bh, int w4, int lane) {
    const int b = bh >> 3, h = bh & 7, n = lane & 31, hf = lane >> 5;
    const size_t m0 = (size_t)b * SEQ;
    const bf16_t* Qh = (const bf16_t*)(a.ws + O_Q) + m0 * 512 + 64 * h;
    const bf16_t* Kh = (const bf16_t*)(a.ws + O_K) + m0 * 512 + 64 * h;
    const bf16_t* Vh = (const bf16_t*)(a.ws + O_VT) + (size_t)bh * 64 * SEQ;
    bf16_t* Oh = (bf16_t*)(a.ws + O_OSB) + m0 * 512 + 64 * h;
    for (int qt = 63 - w4; qt >= 0; qt -= 8) {
        const int q0 = 32 * qt;
        bf16x8 qf[4];
#pragma unroll
        for (int s = 0; s < 4; ++s) qf[s] = *(const bf16x8*)(Qh + (size_t)(q0 + n) * 512 + 16 * s + 8 * hf);
        f32x16 o0, o1;
#pragma unroll
        for (int i = 0; i < 16; ++i) { o0[i] = 0.f; o1[i] = 0.f; }
        float carry = 0.f;
        KV cur, nxt;
        attn_load(cur, Kh, Vh, q0, n, hf);
        for (int kt = qt; kt >= 0; --kt) {
            const int ktn = kt > 0 ? kt - 1 : 0;
            attn_load(nxt, Kh, Vh, 32 * ktn, n, hf);
            f32x16 sc;
#pragma unroll
            for (int i = 0; i < 16; ++i) sc[i] = 0.f;
#pragma unroll
            for (int s = 0; s < 4; ++s) sc = __builtin_amdgcn_mfma_f32_32x32x16_bf16(cur.k[s], qf[s], sc, 0, 0, 0);
            const bool diag = (kt == qt);
            float lf[16], G4[4];
#pragma unroll
            for (int g = 0; g < 4; ++g) { G4[g] = 0.f;
#pragma unroll
                for (int i = 0; i < 4; ++i) { const int r = 4 * g + i; const float z = sc[r];
                    const bool valid = !diag || (8 * g + 4 * hf + i < n);
                    const float e = fexp(-fabsf(z));
                    const float sp = fmaxf(z, 0.f) + flog(1.f + e);
                    lf[r] = valid ? -sp : 0.f; G4[g] += lf[r]; } }
            float PG[4], T4[4];
#pragma unroll
            for (int g = 0; g < 4; ++g) { PG[g] = __shfl_xor(G4[g], 32); T4[g] = G4[g] + PG[g]; }
            const float tail3 = 0.f, tail2 = T4[3], tail1 = T4[3] + T4[2], tail0 = tail1 + T4[1], total = tail0 + T4[0];
            const float tails[4] = {tail0, tail1, tail2, tail3};
            f32x16 wv;
#pragma unroll
            for (int g = 0; g < 4; ++g) {
                float af = carry + tails[g] + (hf == 0 ? PG[g] : 0.f);
#pragma unroll
                for (int i = 3; i >= 0; --i) { const int r = 4 * g + i; const float z = sc[r];
                    const bool valid = !diag || (8 * g + 4 * hf + i < n);
                    const float wgt = fexp(lf[r] + z + af);
                    wv[r] = valid ? wgt : 0.f;
                    af += lf[r]; } }
            carry += total;
            bf16x8 wf[2];
#pragma unroll
            for (int sg = 0; sg < 2; ++sg) { u32x4 t; t.x = cvt_pk_bf16(wv[8 * sg + 0], wv[8 * sg + 1]); t.y = cvt_pk_bf16(wv[8 * sg + 2], wv[8 * sg + 3]); t.z = cvt_pk_bf16(wv[8 * sg + 4], wv[8 * sg + 5]); t.w = cvt_pk_bf16(wv[8 * sg + 6], wv[8 * sg + 7]); wf[sg] = __builtin_bit_cast(bf16x8, t); }
#pragma unroll
            for (int sg = 0; sg < 2; ++sg) { o0 = __builtin_amdgcn_mfma_f32_32x32x16_bf16(cur.v[0][sg], wf[sg], o0, 0, 0, 0); o1 = __builtin_amdgcn_mfma_f32_32x32x16_bf16(cur.v[1][sg], wf[sg], o1, 0, 0, 0); }
            cur = nxt;
#if MK_EARLY_EXIT
            if (__all(carry < -104.f)) break;
#endif
        }
        bf16_t* op = Oh + (size_t)(q0 + n) * 512 + 4 * hf;
#pragma unroll
        for (int g = 0; g < 4; ++g) {
            u32x2 t0, t1; t0.x = cvt_pk_bf16(o0[4 * g], o0[4 * g + 1]); t0.y = cvt_pk_bf16(o0[4 * g + 2], o0[4 * g + 3]); t1.x = cvt_pk_bf16(o1[4 * g], o1[4 * g + 1]); t1.y = cvt_pk_bf16(o1[4 * g + 2], o1[4 * g + 3]);
            *(u32x2*)(op + 8 * g) = t0; *(u32x2*)(op + 32 + 8 * g) = t1; }
    }
}
__device__ __forceinline__ void phase_mixer(const Args& a, unsigned char* lds, int G) {
    const int tid = my_tid(); const int wave = __builtin_amdgcn_readfirstlane(tid >> 6), lane = tid & 63;
    for (int bh = blockIdx.x; bh < NB * NH; bh += G) {
        const int b = bh >> 3, h = bh & 7; const size_t m0 = (size_t)b * SEQ;
        const unsigned char* sb = a.ws + O_SI + (m0 * 8 + h) * 768; const float* scp = (const float*)(a.ws + O_SC) + (m0 * 8 + h) * 4;
        unsigned* yrb = (unsigned*)(a.ws + O_YR) + m0 * 512 + 64 * h + 16 * (wave & 3);
        const int pl = tid - 256;
        constexpr int NCH = SEQ / SC_T;
        ProdRec pr[4]; f32x2 S[8];
#pragma unroll
        for (int p = 0; p < 8; ++p) S[p] = (f32x2){0.f, 0.f};
        __syncthreads();
        if (wave >= 4) { prod_load(pr, sb, scp, 0, pl); prod_store(pr, lds, pl); prod_load(pr, sb, scp, 1, pl); }
        __syncthreads();
        for (int ci = 0; ci < NCH; ++ci) {
            if (wave < 4) scan_consume(S, lds + (ci & 1) * SC_BUF, yrb + (size_t)ci * SC_T * 512, lane, wave);
            else if (ci + 1 < NCH) { prod_store(pr, lds + ((ci + 1) & 1) * SC_BUF, pl); prod_load(pr, sb, scp, ci + 2 < NCH ? ci + 2 : ci + 1, pl); }
            __syncthreads();
        }
        attn_wave(a, bh, wave, lane);
        __threadfence_block(); __syncthreads();
        rwpost_local(a, bh, my_tid());
    }
}

template <int MODE> __device__ __forceinline__ void phase_rows(const Args& a, int G) {
    const int tid = my_tid(); const int wave = tid >> 6, lane = tid & 63;
    const int gw = blockIdx.x * 8 + wave, NGW = G * 8;
    const bf16_t* T = (const bf16_t*)(a.ws + (MODE == 0 ? O_TT : O_FF));
    const float* xin = MODE == 0 ? a.in[0] : a.out; const float* g1 = MODE == 0 ? a.in[18] : a.in[23]; const float* g2 = a.in[19];
    bf16_t* H2 = (bf16_t*)(a.ws + O_H2);
    f32x4 g1v[4], g2v[4];
#pragma unroll
    for (int j = 0; j < 4; ++j) { g1v[j] = ((const f32x4*)g1)[lane + 64 * j]; g2v[j] = ((const f32x4*)g2)[lane + 64 * j]; }
    for (int row0 = gw; row0 < M; row0 += 2 * NGW) {
        u32x2 tb[2][4]; f32x4 x[2][4];
#pragma unroll
        for (int u = 0; u < 2; ++u) { const int row = (row0 + u * NGW < M) ? row0 + u * NGW : row0;
            const u32x2* tr = (const u32x2*)(T + (size_t)row * D) + lane; const f32x4* xr = (const f32x4*)(xin + (size_t)row * D) + lane;
#pragma unroll
            for (int j = 0; j < 4; ++j) { tb[u][j] = tr[64 * j]; x[u][j] = xr[64 * j]; } }
#pragma unroll
        for (int u = 0; u < 2; ++u) {
            const int row = row0 + u * NGW;
            f32x4 t[4]; float s = 0.f;
#pragma unroll
            for (int j = 0; j < 4; ++j) { t[j][0] = bf_lo(tb[u][j].x); t[j][1] = bf_hi(tb[u][j].x); t[j][2] = bf_lo(tb[u][j].y); t[j][3] = bf_hi(tb[u][j].y);
                s += (t[j][0] * t[j][0] + t[j][1] * t[j][1]) + (t[j][2] * t[j][2] + t[j][3] * t[j][3]); }
            const float rs = rsqrtf(wave_sum(s) * (1.f / D) + RMS_EPS);
            float s2 = 0.f;
#pragma unroll
            for (int j = 0; j < 4; ++j)
#pragma unroll
                for (int e = 0; e < 4; ++e) { x[u][j][e] += t[j][e] * rs * g1v[j][e]; s2 += x[u][j][e] * x[u][j][e]; }
            float rs2 = 0.f;
            if (MODE == 0) rs2 = rsqrtf(wave_sum(s2) * (1.f / D) + RMS_EPS);
            if (row < M) {
                f32x4* orow = (f32x4*)(a.out + (size_t)row * D) + lane;
#pragma unroll
                for (int j = 0; j < 4; ++j) orow[64 * j] = x[u][j];
                if (MODE == 0) {
                    u32x2* o = (u32x2*)(H2 + (size_t)row * D) + lane;
#pragma unroll
                    for (int j = 0; j < 4; ++j) { u32x2 w; w.x = cvt_pk_bf16(x[u][j][0] * rs2 * g2v[j][0], x[u][j][1] * rs2 * g2v[j][1]); w.y = cvt_pk_bf16(x[u][j][2] * rs2 * g2v[j][2], x[u][j][3] * rs2 * g2v[j][3]); o[64 * j] = w; }
                }
            }
        }
    }
}

__global__ void __launch_bounds__(512, 2) mega(Args a) {
    extern __shared__ __attribute__((aligned(16))) unsigned char shm[];
    PG8_LAS unsigned char* lds = (PG8_LAS unsigned char*)shm;
    const int G = (int)gridDim.x;
    unsigned char* ws = a.ws;
    phase_prep(a, (float*)shm, G);
    cg::this_grid().sync();
    { Epi1 E; E.Q = (bf16_t*)(ws + O_Q); E.Kb = (bf16_t*)(ws + O_K); E.Vt = (bf16_t*)(ws + O_VT); E.Prw = (bf16_t*)(ws + O_PRW); E.Gt = (bf16_t*)a.out; E.bgate = a.in[3];
      run_gemm(lds, (const bf16_t*)(ws + O_H), (const bf16_t*)(ws + O_WIN), INC, 1024, E, G); }
    cg::this_grid().sync();
    phase_rwprep(a, shm, G);
    cg::this_grid().sync();
    phase_mixer(a, shm, G);
    cg::this_grid().sync();
    { EpiRow<1> E; E.O = (bf16_t*)(ws + O_T1); E.T1 = nullptr; E.Gt = (const bf16_t*)a.out;
      run_gemm(lds, (const bf16_t*)(ws + O_OSB), (const bf16_t*)(ws + O_WSB), 1024, 512, E, G); }
    { EpiRow<2> E; E.O = (bf16_t*)(ws + O_MRG); E.T1 = (const bf16_t*)(ws + O_T1); E.Gt = (const bf16_t*)a.out;
      run_gemm(lds, (const bf16_t*)(ws + O_ORW), (const bf16_t*)(ws + O_WRW), 1024, 512, E, G); }
    cg::this_grid().sync();
    { EpiRow<0> E; E.O = (bf16_t*)(ws + O_TT); E.T1 = nullptr; E.Gt = nullptr;
      run_gemm(lds, (const bf16_t*)(ws + O_MRG), (const bf16_t*)(ws + O_WO), 1024, 1024, E, G); }
    cg::this_grid().sync();
    phase_rows<0>(a, G);
    cg::this_grid().sync();
    { EpiSwiGLU E; E.Hd = (bf16_t*)(ws + O_HID);
      run_gemm(lds, (const bf16_t*)(ws + O_H2), (const bf16_t*)(ws + O_WGU), 2 * DFF, 1024, E, G); }
    cg::this_grid().sync();
    { EpiRow<0> E; E.O = (bf16_t*)(ws + O_FF); E.T1 = nullptr; E.Gt = nullptr;
      run_gemm(lds, (const bf16_t*)(ws + O_HID), (const bf16_t*)(ws + O_WDN), 1024, DFF, E, G); }
    cg::this_grid().sync();
    phase_rows<1>(a, G);
}
}

extern "C" void kernel_launch(void* const* d_in, const int* in_sizes, int n_in, void* d_out, int out_size, void* d_ws, size_t ws_size, hipStream_t stream) {
    static int grid = 0;
    if (grid == 0) {
        if (n_in != 24 || in_sizes[0] != mk::M * mk::D || out_size != mk::M * mk::D || ws_size < mk::WS_NEED) {
            fprintf(stderr, "kernel_launch: unexpected shapes: n_in %d in0 %d out %d ws %zu (need %zu)\n", n_in, n_in > 0 ? in_sizes[0] : -1, out_size, ws_size, (size_t)mk::WS_NEED); grid = -1; return; }
        int dev = 0, cus = 0, per_cu = 0;
        hipGetDevice(&dev); hipDeviceGetAttribute(&cus, hipDeviceAttributeMultiprocessorCount, dev);
        if (hipFuncSetAttribute((const void*)mk::mega, hipFuncAttributeMaxDynamicSharedMemorySize, mk::LDS_BYTES) != hipSuccess) { fprintf(stderr, "kernel_launch: hipFuncSetAttribute failed\n"); grid = -1; return; }
        if (hipOccupancyMaxActiveBlocksPerMultiprocessor(&per_cu, (const void*)mk::mega, 512, mk::LDS_BYTES) != hipSuccess || per_cu < 1) { fprintf(stderr, "kernel_launch: occupancy query failed (%d)\n", per_cu); per_cu = 1; }
        (void)hipGetLastError();
        grid = cus * per_cu;
        fprintf(stderr, "kernel_launch: grid %d (cus %d x %d)\n", grid, cus, per_cu);
    }
    if (grid < 0) return;
    mk::Args a{};
    for (int i = 0; i < 24; ++i) a.in[i] = (const float*)d_in[i];
    a.out = (float*)d_out; a.ws = (unsigned char*)d_ws;
    a.ph_lo = 0; a.ph_hi = mk::NPH;
    void* args[] = {&a};
    hipError_t e = hipLaunchCooperativeKernel((const void*)mk::mega, dim3(grid), dim3(512), args, mk::LDS_BYTES, stream);
    if (e != hipSuccess) fprintf(stderr, "kernel_launch: cooperative launch failed: %s (grid %d)\n", hipGetErrorString(e), grid);
}
```

```cpp
#include <hip/hip_runtime.h>
#include <hip/hip_cooperative_groups.h>
#include <cstdio>
#include <cstdint>
namespace cg = cooperative_groups;
#ifndef MK_SPLIT
#define MK_SPLIT 0
#endif
#ifndef MK_DIAG
#define MK_DIAG 0
#endif
#ifndef MK_REPMASK
#define MK_REPMASK 0
#endif
#ifndef MK_EARLY_EXIT
#define MK_EARLY_EXIT 1
#endif
namespace pg8 {
#define PG8_LAS __attribute__((address_space(3)))
typedef unsigned short bf16_t;
typedef short bf16x8 __attribute__((ext_vector_type(8)));
typedef float f32x4 __attribute__((ext_vector_type(4)));
typedef unsigned u32x4 __attribute__((ext_vector_type(4)));
constexpr int BM = 256, BK = 64, HALF = 128, HTB = HALF * BK * 2  , STAGE_BYTES = 8 * HTB, NXCD = 8, WGM = 8;

__host__ __device__ __forceinline__ int lds_byte(int r, int c) { const int st = (r >> 4) * 2 + (c >> 5), rr = r & 15, cc = c & 31, ob = rr * 64 + cc * 2; return st * 1024 + (ob ^ (((ob >> 9) & 1) << 5)); }
__host__ __device__ __forceinline__ void stage_rc(int b, int& R, int& C) { const int st = b / 1024, sb = b % 1024, swz = sb ^ (((sb >> 9) & 1) << 5); R = (st >> 1) * 16 + swz / 64; C = (st & 1) * 32 + (swz % 64) / 2; }
__host__ __device__ __forceinline__ int perm32(int rho) { const int n = rho >> 4, i = rho & 15; return 8 * (i >> 2) + 4 * n + (i & 3); }

struct Unit { int pm, pn; };
struct Gemm { const bf16_t* A; const bf16_t* Bt; int M, N, K; };

struct StaticOrder {
    int nM, nN, nwg, G, c;
    __host__ __device__ void init(int M, int N, int G_, int c_) { nM = M / BM; nN = N / BM; nwg = nM * nN; G = G_; c = c_; }
    __host__ __device__ bool next(int i, Unit& u) const {
        const long L = (long)i * G + c; if (L >= nwg) return false;
        int wgid = (int)L; { const int q = nwg / NXCD, r = nwg % NXCD, xcd = wgid % NXCD, off = wgid / NXCD; wgid = (xcd < r ? xcd * (q + 1) : r * (q + 1) + (xcd - r) * q) + off; }
        const int nig = WGM * nN, gid = wgid / nig, fm = gid * WGM, gsz = (nM - fm) < WGM ? (nM - fm) : WGM;
        u.pm = fm + ((wgid % nig) % gsz); u.pn = (wgid % nig) / gsz; return true;
    }
    __device__ __forceinline__ void a_ready(const Unit&) const {}
    __device__ __forceinline__ void done(const Unit&) const {}
};

__device__ __forceinline__ unsigned cvt_pk_bf16(float lo, float hi) { unsigned r; asm volatile("v_cvt_pk_bf16_f32 %0, %1, %2" : "=v"(r) : "v"(lo), "v"(hi)); return r; }
typedef float f32x2 __attribute__((ext_vector_type(2)));

template <class Epi, class Sched, bool ALIGN_EPI = false, bool SP2 = false>
__device__ __forceinline__ void gemm_phase(PG8_LAS unsigned char* lds, const Gemm g, const Sched& S, const Epi& E) {
    int tid_ = threadIdx.x; asm volatile("" : "+v"(tid_)); const int tid = tid_, wid = __builtin_amdgcn_readfirstlane(tid >> 6), lane = tid & 63, wr = wid >> 2, wc = wid & 3, fr = lane & 15, fq = lane >> 4;
    const int K = g.K, nt = K / BK;
    unsigned voffA[2], voffB[2];
#pragma unroll
    for (int i = 0; i < 2; ++i) { int R, C; stage_rc(tid * 16 + i * 8192, R, C); const int Rb = Epi::PERM ? ((R & ~31) + perm32(R & 31)) : R;
        voffA[i] = (unsigned)(R * K + C) * 2u; voffB[i] = (unsigned)(Rb * K + C) * 2u; }
    const size_t kstep = (size_t)(BK * 2);
    const size_t hstep = (size_t)HALF * K * 2;
    const size_t tstep = 2 * hstep;
    const unsigned ldsw = (unsigned)wid * 1024u;
    const int aoff = lds_byte(wr * 64 + fr, fq * 8), boff = lds_byte(wc * 32 + fr, fq * 8);
#define PG8_SA(b, h) (((b) * 2 + (h)) * HTB)
#define PG8_SB(b, h) ((4 + (b) * 2 + (h)) * HTB)
#define PG8_STAGE(bufoff, gbase, voff) do { _Pragma("unroll") for (int _i = 0; _i < 2; ++_i) \
        __builtin_amdgcn_global_load_lds((const unsigned*)((const char*)(gbase) + (voff)[_i]), (PG8_LAS unsigned*)(lds + (bufoff) + ldsw + _i * 8192), 16, 0, 0); } while (0)
#define PG8_LDA(dst, b, h) do { _Pragma("unroll") for (int m = 0; m < 4; ++m) _Pragma("unroll") for (int k = 0; k < 2; ++k) dst[m][k] = *(const PG8_LAS bf16x8*)(lds + PG8_SA(b, h) + aoff + m * 2048 + k * 1024); } while (0)
#define PG8_LDB(dst, b, h) do { _Pragma("unroll") for (int n = 0; n < 2; ++n) _Pragma("unroll") for (int k = 0; k < 2; ++k) dst[n][k] = *(const PG8_LAS bf16x8*)(lds + PG8_SB(b, h) + boff + n * 2048 + k * 1024); } while (0)
#define PG8_MMA(ai, bj, At, Bt) do { __builtin_amdgcn_s_setprio(1); _Pragma("unroll") for (int m = 0; m < 4; ++m) _Pragma("unroll") for (int n = 0; n < 2; ++n) _Pragma("unroll") for (int k = 0; k < 2; ++k) \
        acc[ai][bj][m][n] = __builtin_amdgcn_mfma_f32_16x16x32_bf16(Bt[n][k], At[m][k], acc[ai][bj][m][n], 0, 0, 0); __builtin_amdgcn_s_setprio(0); } while (0)
#define PG8_WAIT_V(n) asm volatile("s_waitcnt vmcnt(" #n ")" ::: "memory")
#define PG8_WAIT_L(n) asm volatile("s_waitcnt lgkmcnt(" #n ")" ::: "memory")
#define PG8_BAR __builtin_amdgcn_s_barrier()
#define PG8_SCHED __builtin_amdgcn_sched_barrier(0)
    Unit cur, nxt; int ui = 0;
    if (!S.next(0, cur)) return;
    f32x4 acc[2][2][4][2];
#pragma unroll
    for (int a = 0; a < 2; ++a)
#pragma unroll
        for (int b = 0; b < 2; ++b)
#pragma unroll
            for (int m = 0; m < 4; ++m)
#pragma unroll
                for (int n = 0; n < 2; ++n) acc[a][b][m][n] = (f32x4){0.f, 0.f, 0.f, 0.f};
    bf16x8 At[4][2], B0[2][2], B1[2][2];
    const char* cA = (const char*)g.A + (size_t)cur.pm * tstep; const char* cB = (const char*)g.Bt + (size_t)cur.pn * tstep;
    S.a_ready(cur);
    if constexpr (SP2) {
        PG8_STAGE(PG8_SB(0, 0), cB, voffB); PG8_STAGE(PG8_SB(0, 1), cB + hstep, voffB); PG8_STAGE(PG8_SA(0, 0), cA, voffA); PG8_STAGE(PG8_SA(0, 1), cA + hstep, voffA);
        if (wr == 1) PG8_BAR;
        PG8_WAIT_V(2); PG8_BAR;
        PG8_STAGE(PG8_SB(1, 0), cB + kstep, voffB); PG8_STAGE(PG8_SA(1, 0), cA + kstep, voffA); PG8_STAGE(PG8_SB(1, 1), cB + hstep + kstep, voffB);
        PG8_WAIT_V(6); PG8_BAR;
    } else {
        PG8_STAGE(PG8_SB(0, 0), cB, voffB); PG8_STAGE(PG8_SA(0, 0), cA, voffA); PG8_STAGE(PG8_SB(0, 1), cB + hstep, voffB); PG8_STAGE(PG8_SA(0, 1), cA + hstep, voffA);
        if (wr == 1) PG8_BAR;
        PG8_WAIT_V(4); PG8_BAR;
        PG8_STAGE(PG8_SB(1, 0), cB + kstep, voffB); PG8_STAGE(PG8_SA(1, 0), cA + kstep, voffA); PG8_STAGE(PG8_SB(1, 1), cB + hstep + kstep, voffB);
        PG8_WAIT_V(6); PG8_BAR;
    }
    for (;;) {
        const bool has_next = S.next(ui + 1, nxt);
        const char* nA = has_next ? (const char*)g.A + (size_t)nxt.pm * tstep : cA; const char* nB = has_next ? (const char*)g.Bt + (size_t)nxt.pn * tstep : cB;
        for (int t = 0; t < nt; t += 2) {
            const bool last = (t == nt - 2);
            const char* a1 = cA + (size_t)(t + 1) * kstep;
            const char* a2 = last ? nA : cA + (size_t)(t + 2) * kstep; const char* b2 = last ? nB : cB + (size_t)(t + 2) * kstep;
            const char* a3 = a2 + kstep; const char* b3 = b2 + kstep;
            if (last && has_next) S.a_ready(nxt);
            if constexpr (SP2) {
            PG8_LDB(B0, 0, 0); PG8_LDB(B1, 0, 1); PG8_SCHED; PG8_LDA(At, 0, 0); PG8_STAGE(PG8_SA(1, 1), a1 + hstep, voffA);
            PG8_WAIT_V(8); PG8_WAIT_L(0); PG8_BAR; PG8_MMA(0, 0, At, B0); PG8_MMA(0, 1, At, B1); PG8_BAR; PG8_SCHED;
            PG8_LDA(At, 0, 1); PG8_STAGE(PG8_SB(0, 0), b2, voffB); PG8_STAGE(PG8_SB(0, 1), b2 + hstep, voffB); PG8_STAGE(PG8_SA(0, 0), a2, voffA);
            PG8_WAIT_V(8); PG8_WAIT_L(0); PG8_BAR; PG8_MMA(1, 0, At, B0); PG8_MMA(1, 1, At, B1); PG8_BAR; PG8_SCHED;
            PG8_LDB(B0, 1, 0); PG8_LDB(B1, 1, 1); PG8_SCHED; PG8_LDA(At, 1, 0); PG8_STAGE(PG8_SA(0, 1), a2 + hstep, voffA);
            PG8_WAIT_V(8); PG8_WAIT_L(0); PG8_BAR; PG8_MMA(0, 0, At, B0); PG8_MMA(0, 1, At, B1); PG8_BAR; PG8_SCHED;
            PG8_LDA(At, 1, 1); PG8_STAGE(PG8_SB(1, 0), b3, voffB); PG8_STAGE(PG8_SB(1, 1), b3 + hstep, voffB); PG8_STAGE(PG8_SA(1, 0), a3, voffA);
            PG8_WAIT_V(8); PG8_WAIT_L(0); PG8_BAR; PG8_MMA(1, 0, At, B0); PG8_MMA(1, 1, At, B1); PG8_BAR; PG8_SCHED;
            } else {
            PG8_LDB(B0, 0, 0); PG8_SCHED; PG8_LDA(At, 0, 0); PG8_STAGE(PG8_SA(1, 1), a1 + hstep, voffA);
            PG8_WAIT_L(8); PG8_BAR; PG8_WAIT_L(0); PG8_MMA(0, 0, At, B0); PG8_BAR; PG8_SCHED;
            PG8_LDB(B1, 0, 1); PG8_STAGE(PG8_SB(0, 0), b2, voffB);
            PG8_BAR; PG8_WAIT_L(0); PG8_MMA(0, 1, At, B1); PG8_BAR;
            PG8_LDA(At, 0, 1); PG8_STAGE(PG8_SA(0, 0), a2, voffA);
            PG8_BAR; PG8_WAIT_L(0); PG8_MMA(1, 0, At, B0); PG8_BAR; PG8_SCHED;
            PG8_STAGE(PG8_SB(0, 1), b2 + hstep, voffB);
            PG8_WAIT_V(6); PG8_BAR; PG8_MMA(1, 1, At, B1); PG8_BAR;
            PG8_LDB(B0, 1, 0); PG8_SCHED; PG8_LDA(At, 1, 0); PG8_STAGE(PG8_SA(0, 1), a2 + hstep, voffA);
            PG8_WAIT_L(8); PG8_BAR; PG8_WAIT_L(0); PG8_MMA(0, 0, At, B0); PG8_BAR; PG8_SCHED;
            PG8_LDB(B1, 1, 1); PG8_STAGE(PG8_SB(1, 0), b3, voffB);
            PG8_BAR; PG8_WAIT_L(0); PG8_MMA(0, 1, At, B1); PG8_BAR;
            PG8_LDA(At, 1, 1); PG8_STAGE(PG8_SA(1, 0), a3, voffA);
            PG8_BAR; PG8_WAIT_L(0); PG8_MMA(1, 0, At, B0); PG8_BAR; PG8_SCHED;
            PG8_STAGE(PG8_SB(1, 1), b3 + hstep, voffB);
            PG8_WAIT_V(6); PG8_BAR; PG8_MMA(1, 1, At, B1); PG8_BAR;
            }
        }
        if constexpr (ALIGN_EPI) { if (wr == 0) PG8_BAR; }
        if constexpr (!Epi::AFTER_DRAIN) { E(acc, cur, wr, wc, fr, fq); S.done(cur); }
        if (!has_next) break;
#pragma unroll
        for (int a = 0; a < 2; ++a)
#pragma unroll
            for (int b = 0; b < 2; ++b)
#pragma unroll
                for (int m = 0; m < 4; ++m)
#pragma unroll
                    for (int n = 0; n < 2; ++n) acc[a][b][m][n] = (f32x4){0.f, 0.f, 0.f, 0.f};
        cur = nxt; cA = nA; cB = nB; ++ui;
        if constexpr (ALIGN_EPI) { if (wr == 1) PG8_BAR; }
    }
    PG8_WAIT_V(0);
    if constexpr (!ALIGN_EPI) { if (wr == 0) PG8_BAR; }
    PG8_BAR;
    if constexpr (Epi::AFTER_DRAIN) { E.fused(acc, cur, wr, wc, fr, fq, lds, wid, lane); S.done(cur); }
#undef PG8_SA
#undef PG8_SB
#undef PG8_STAGE
#undef PG8_LDA
#undef PG8_LDB
#undef PG8_MMA
#undef PG8_WAIT_V
#undef PG8_WAIT_L
#undef PG8_BAR
#undef PG8_SCHED
}

}
namespace mk {
using pg8::bf16_t; using pg8::bf16x8; using pg8::f32x4; using pg8::u32x4; using pg8::cvt_pk_bf16;
typedef float f32x16 __attribute__((ext_vector_type(16)));
typedef float f32x2 __attribute__((ext_vector_type(2)));
typedef unsigned u32x2 __attribute__((ext_vector_type(2)));
constexpr int D = 1024, NB = 32, SEQ = 2048, M = NB * SEQ, NH = 8, DH = 64;
constexpr int RWC = 1792, GC = 2048, INC = 5376, DFF = 2816;
constexpr float RMS_EPS = 1e-6f, GN_EPS = 64e-5f;
constexpr size_t MiB = (size_t)1 << 20;
constexpr size_t O_WIN = 0, O_WSB = 11 * MiB, O_WRW = 12 * MiB, O_WO = 13 * MiB, O_WGU = 15 * MiB, O_WDN = 26 * MiB, O_WLU = 32 * MiB  , O_WLA = O_WLU + 65536, O_WLG = O_WLA + 65536;
constexpr size_t O_Q = 34 * MiB, O_K = 98 * MiB, O_VT = 162 * MiB, O_PRW = 226 * MiB, O_H = 450 * MiB, O_SI = 450 * MiB, O_G = 834 * MiB, O_SC = 898 * MiB, O_YR = 290 * MiB  ;
constexpr size_t O_OSB = 226 * MiB, O_ORW = 34 * MiB, O_T1 = 98 * MiB, O_MRG = 450 * MiB, O_TT = 34 * MiB, O_H2 = 162 * MiB, O_HID = 290 * MiB, O_FF = 34 * MiB;
constexpr size_t WS_NEED = 906 * MiB;
constexpr int LDS_BYTES = pg8::STAGE_BYTES;
constexpr int NPH = 12;

struct Args { const float* in[24]; float* out; unsigned char* ws; int ph_lo, ph_hi; };

__device__ __forceinline__ int my_tid() { int t = threadIdx.x; asm volatile("" : "+v"(t)); return t; }
__device__ __forceinline__ float bf_lo(unsigned u) { return __uint_as_float(u << 16); }
__device__ __forceinline__ float bf_hi(unsigned u) { return __uint_as_float(u & 0xffff0000u); }
__device__ __forceinline__ float fexp(float x) { return __builtin_amdgcn_exp2f(x * 1.44269504089f); }
__device__ __forceinline__ float flog(float x) { return __builtin_amdgcn_logf(x) * 0.69314718056f; }
__device__ __forceinline__ float frcp(float x) { return __builtin_amdgcn_rcpf(x); }
__device__ __forceinline__ float fsigmoid(float x) { return frcp(1.f + fexp(-x)); }
__device__ __forceinline__ unsigned short bf1(float x) { return (unsigned short)(cvt_pk_bf16(x, x) & 0xffffu); }
__device__ __forceinline__ u32x4 pack8(const f32x4 a, const f32x4 b) { u32x4 o; o.x = cvt_pk_bf16(a[0], a[1]); o.y = cvt_pk_bf16(a[2], a[3]); o.z = cvt_pk_bf16(b[0], b[1]); o.w = cvt_pk_bf16(b[2], b[3]); return o; }
__device__ __forceinline__ float red16(float v) {
    v += __shfl_xor(v, 16); v += __shfl_xor(v, 32); return v;
}
__device__ __forceinline__ float wave_sum(float v) {
#pragma unroll
    for (int o = 1; o < 64; o <<= 1) v += __shfl_xor(v, o);
    return v;
}

__device__ __forceinline__ void tr_item(const float* __restrict__ W, int K, int N, bf16_t* WT, float* scr, int item, int lane, int mode) {
    const int nblk = N >> 5, kb = item / nblk, nb = item - kb * nblk, k0 = kb << 6, n0 = nb << 5;
#pragma unroll 8
    for (int i = 0; i < 32; ++i) { const int kk = 2 * i + (lane >> 5); scr[kk * 33 + (lane & 31)] = W[(size_t)(k0 + kk) * N + n0 + (lane & 31)]; }
    asm volatile("s_waitcnt lgkmcnt(0)" ::: "memory"); __builtin_amdgcn_wave_barrier();
    const int c = lane & 7;
#pragma unroll
    for (int j = 0; j < 4; ++j) {
        const int n = (lane >> 3) + 8 * j; const float* s = scr + (8 * c) * 33 + n;
        u32x4 o; o.x = cvt_pk_bf16(s[0 * 33], s[1 * 33]); o.y = cvt_pk_bf16(s[2 * 33], s[3 * 33]); o.z = cvt_pk_bf16(s[4 * 33], s[5 * 33]); o.w = cvt_pk_bf16(s[6 * 33], s[7 * 33]);
        const int nn = n0 + n; int drow = nn;
        if (mode == 1) drow = ((nn >> 7) << 8) + (nn & 127); else if (mode == 2) drow = ((nn >> 7) << 8) + 128 + (nn & 127);
        *(u32x4*)(WT + (size_t)drow * K + k0 + 8 * c) = o;
    }
    asm volatile("s_waitcnt lgkmcnt(0)" ::: "memory"); __builtin_amdgcn_wave_barrier();
}

__device__ __forceinline__ void phase_prep(const Args& a, float* lds_f, int G) {
    const int tid = my_tid(); const int wave = tid >> 6, lane = tid & 63;
    const int gw = blockIdx.x * 8 + wave, NGW = G * 8;
    float* scr = lds_f + wave * (64 * 33 + 16);
    unsigned char* ws = a.ws;
    constexpr int I_IN = 16 * 168, I_SB = 8 * 32, I_O = 16 * 32, I_G = 16 * 88, I_DN = 44 * 32, I_LU = 16, I_LG = 32;
    constexpr int NIT = I_IN + 2 * I_SB + I_O + 2 * I_G + I_DN + 2 * I_LU + I_LG;
    for (int it = gw; it < NIT; it += NGW) {
        int r = it;
        if (r < I_IN) { tr_item(a.in[2], 1024, INC, (bf16_t*)(ws + O_WIN), scr, r, lane, 0); continue; } r -= I_IN;
        if (r < I_SB) { tr_item(a.in[15], 512, 1024, (bf16_t*)(ws + O_WSB), scr, r, lane, 0); continue; } r -= I_SB;
        if (r < I_SB) { tr_item(a.in[16], 512, 1024, (bf16_t*)(ws + O_WRW), scr, r, lane, 0); continue; } r -= I_SB;
        if (r < I_O) { tr_item(a.in[17], 1024, 1024, (bf16_t*)(ws + O_WO), scr, r, lane, 0); continue; } r -= I_O;
        if (r < I_G) { tr_item(a.in[20], 1024, DFF, (bf16_t*)(ws + O_WGU), scr, r, lane, 1); continue; } r -= I_G;
        if (r < I_G) { tr_item(a.in[21], 1024, DFF, (bf16_t*)(ws + O_WGU), scr, r, lane, 2); continue; } r -= I_G;
        if (r < I_DN) { tr_item(a.in[22], DFF, 1024, (bf16_t*)(ws + O_WDN), scr, r, lane, 0); continue; } r -= I_DN;
        if (r < I_LU) { tr_item(a.in[6], 64, 512, (bf16_t*)(ws + O_WLU), scr, r, lane, 0); continue; } r -= I_LU;
        if (r < I_LU) { tr_item(a.in[8], 64, 512, (bf16_t*)(ws + O_WLA), scr, r, lane, 0); continue; } r -= I_LU;
        tr_item(a.in[9], 128, 512, (bf16_t*)(ws + O_WLG), scr, r, lane, 0);
    }
    const float* x = a.in[0]; const float* g = a.in[1]; bf16_t* H = (bf16_t*)(ws + O_H);
    f32x4 gv[4];
#pragma unroll
    for (int j = 0; j < 4; ++j) gv[j] = ((const f32x4*)g)[lane + 64 * j];
    for (int row0 = gw; row0 < M; row0 += 2 * NGW) {
        f32x4 v[2][4];
#pragma unroll
        for (int u = 0; u < 2; ++u) { const int row = (row0 + u * NGW < M) ? row0 + u * NGW : row0; const f32x4* xr = (const f32x4*)(x + (size_t)row * D) + lane;
#pragma unroll
            for (int j = 0; j < 4; ++j) v[u][j] = xr[64 * j]; }
#pragma unroll
        for (int u = 0; u < 2; ++u) { const int row = row0 + u * NGW; float s = 0.f;
#pragma unroll
            for (int j = 0; j < 4; ++j) s += (v[u][j][0] * v[u][j][0] + v[u][j][1] * v[u][j][1]) + (v[u][j][2] * v[u][j][2] + v[u][j][3] * v[u][j][3]);
            const float rs = rsqrtf(wave_sum(s) * (1.f / D) + RMS_EPS);
            if (row < M) { u32x2* o = (u32x2*)(H + (size_t)row * D) + lane;
#pragma unroll
                for (int j = 0; j < 4; ++j) { u32x2 w; w.x = cvt_pk_bf16(v[u][j][0] * rs * gv[j][0], v[u][j][1] * rs * gv[j][1]); w.y = cvt_pk_bf16(v[u][j][2] * rs * gv[j][2], v[u][j][3] * rs * gv[j][3]); o[64 * j] = w; } }
        }
    }
}

struct Epi1 {
    static constexpr bool PERM = true, AFTER_DRAIN = false;
    bf16_t *Q, *Kb, *Vt, *Prw, *Gt; const float* bgate;
    __device__ __forceinline__ void operator()(const f32x4 (&acc)[2][2][4][2], const pg8::Unit& u, int wr, int wc, int fr, int fq) const {
        const int row0 = u.pm * 256 + wr * 64 + fr, pn = u.pn, cl = wc * 32 + 8 * fq;
        if (pn < 4) {
            bf16_t* dst = pn < 2 ? Q : Kb; const float sc = pn < 2 ? 0.125f : 1.f; const int cb = (pn & 1) * 256 + cl;
#pragma unroll
            for (int ai = 0; ai < 2; ++ai)
#pragma unroll
                for (int m = 0; m < 4; ++m) { bf16_t* rp = dst + (size_t)(row0 + ai * 128 + m * 16) * 512 + cb;
#pragma unroll
                    for (int bj = 0; bj < 2; ++bj) *(u32x4*)(rp + bj * 128) = pack8(acc[ai][bj][m][0] * sc, acc[ai][bj][m][1] * sc); }
        } else if (pn < 6) {
#pragma unroll
            for (int ai = 0; ai < 2; ++ai)
#pragma unroll
                for (int m = 0; m < 4; ++m) { const int row = row0 + ai * 128 + m * 16, b = row >> 11, s = row & 2047;
#pragma unroll
                    for (int bj = 0; bj < 2; ++bj)
#pragma unroll
                        for (int n = 0; n < 2; ++n)
#pragma unroll
                            for (int j = 0; j < 4; ++j) { const int c = (pn - 4) * 256 + bj * 128 + cl + 4 * n + j;
                                Vt[((size_t)(b * 512 + c)) * 2048 + s] = bf1(acc[ai][bj][m][n][j]); } }
        } else if (pn < 13) {
            const int cb = (pn - 6) * 256 + cl;
#pragma unroll
            for (int ai = 0; ai < 2; ++ai)
#pragma unroll
                for (int m = 0; m < 4; ++m) { bf16_t* rp = Prw + (size_t)(row0 + ai * 128 + m * 16) * RWC + cb;
#pragma unroll
                    for (int bj = 0; bj < 2; ++bj) *(u32x4*)(rp + bj * 128) = pack8(acc[ai][bj][m][0], acc[ai][bj][m][1]); }
        } else {
            const int cb = (pn - 13) * 256 + cl;
#pragma unroll
            for (int ai = 0; ai < 2; ++ai)
#pragma unroll
                for (int m = 0; m < 4; ++m) { bf16_t* rp = Gt + (size_t)(row0 + ai * 128 + m * 16) * GC + cb;
#pragma unroll
                    for (int bj = 0; bj < 2; ++bj) { f32x4 v0 = acc[ai][bj][m][0] + *(const f32x4*)(bgate + cb + bj * 128), v1 = acc[ai][bj][m][1] + *(const f32x4*)(bgate + cb + bj * 128 + 4);
#pragma unroll
                        for (int j = 0; j < 4; ++j) { v0[j] = fsigmoid(v0[j]); v1[j] = fsigmoid(v1[j]); }
                        *(u32x4*)(rp + bj * 128) = pack8(v0, v1); } }
        }
    }
};
template <int MODE> struct EpiRow {
    static constexpr bool PERM = true, AFTER_DRAIN = false;
    bf16_t* O; const bf16_t* T1; const bf16_t* Gt;
    __device__ __forceinline__ void operator()(const f32x4 (&acc)[2][2][4][2], const pg8::Unit& u, int wr, int wc, int fr, int fq) const {
        const int row0 = u.pm * 256 + wr * 64 + fr, cb = u.pn * 256 + wc * 32 + 8 * fq;
#pragma unroll
        for (int ai = 0; ai < 2; ++ai)
#pragma unroll
            for (int m = 0; m < 4; ++m) { const size_t row = (size_t)(row0 + ai * 128 + m * 16);
#pragma unroll
                for (int bj = 0; bj < 2; ++bj) { f32x4 v0 = acc[ai][bj][m][0], v1 = acc[ai][bj][m][1]; const int c = cb + bj * 128;
                    if (MODE >= 1) { const u32x4 gg = *(const u32x4*)(Gt + row * GC + (MODE == 2 ? 1024 : 0) + c);
                        v0[0] *= bf_lo(gg.x); v0[1] *= bf_hi(gg.x); v0[2] *= bf_lo(gg.y); v0[3] *= bf_hi(gg.y); v1[0] *= bf_lo(gg.z); v1[1] *= bf_hi(gg.z); v1[2] *= bf_lo(gg.w); v1[3] *= bf_hi(gg.w); }
                    if (MODE == 2) { const u32x4 tt = *(const u32x4*)(T1 + row * 1024 + c);
                        v0[0] += bf_lo(tt.x); v0[1] += bf_hi(tt.x); v0[2] += bf_lo(tt.y); v0[3] += bf_hi(tt.y); v1[0] += bf_lo(tt.z); v1[1] += bf_hi(tt.z); v1[2] += bf_lo(tt.w); v1[3] += bf_hi(tt.w); }
                    *(u32x4*)(O + row * 1024 + c) = pack8(v0, v1); } }
    }
};
struct EpiSwiGLU {
    static constexpr bool PERM = true, AFTER_DRAIN = false;
    bf16_t* Hd;
    __device__ __forceinline__ void operator()(const f32x4 (&acc)[2][2][4][2], const pg8::Unit& u, int wr, int wc, int fr, int fq) const {
        const int row0 = u.pm * 256 + wr * 64 + fr, cb = u.pn * 128 + wc * 32 + 8 * fq;
#pragma unroll
        for (int ai = 0; ai < 2; ++ai)
#pragma unroll
            for (int m = 0; m < 4; ++m) { f32x4 v0, v1;
#pragma unroll
                for (int j = 0; j < 4; ++j) { const float g0 = acc[ai][0][m][0][j], g1 = acc[ai][0][m][1][j];
                    v0[j] = g0 * fsigmoid(g0) * acc[ai][1][m][0][j]; v1[j] = g1 * fsigmoid(g1) * acc[ai][1][m][1][j]; }
                *(u32x4*)(Hd + (size_t)(row0 + ai * 128 + m * 16) * DFF + cb) = pack8(v0, v1); }
    }
};
template <class Epi> __device__ __forceinline__ void run_gemm(PG8_LAS unsigned char* lds, const bf16_t* A, const bf16_t* Bt, int N, int K, const Epi& E, int G) {
    pg8::Gemm g; g.A = A; g.Bt = Bt; g.M = M; g.N = N; g.K = K;
    pg8::StaticOrder S; S.init(M, N, G, (int)blockIdx.x);
    pg8::gemm_phase<Epi, pg8::StaticOrder, true, true>(lds, g, S, E);
}
__device__ __forceinline__ void mix8_lds(const unsigned char* cur, const unsigned char* prv, const float* mu, float (&o)[8]) {
    const u32x4 c = *(const u32x4*)cur, p = *(const u32x4*)prv;
    const f32x4 m0 = *(const f32x4*)mu, m1 = *(const f32x4*)(mu + 4);
    const float mm[8] = {m0[0], m0[1], m0[2], m0[3], m1[0], m1[1], m1[2], m1[3]};
#pragma unroll
    for (int i = 0; i < 4; ++i) { const float cl = bf_lo(c[i]), ch = bf_hi(c[i]), pl = bf_lo(p[i]), ph = bf_hi(p[i]);
        o[2 * i] = cl + (pl - cl) * mm[2 * i]; o[2 * i + 1] = ch + (ph - ch) * mm[2 * i + 1]; }
}
__device__ __forceinline__ void mix4_lds(const unsigned char* cur, const unsigned char* prv, const float* mu, float (&o)[4]) {
    const u32x2 c = *(const u32x2*)cur, p = *(const u32x2*)prv;
    const f32x4 m0 = *(const f32x4*)mu;
#pragma unroll
    for (int i = 0; i < 2; ++i) { const float cl = bf_lo(c[i]), ch = bf_hi(c[i]), pl = bf_lo(p[i]), ph = bf_hi(p[i]);
        o[2 * i] = cl + (pl - cl) * m0[2 * i]; o[2 * i + 1] = ch + (ph - ch) * m0[2 * i + 1]; }
}
__device__ __forceinline__ bf16x8 pack_frag(const float (&v)[8]) {
    u32x4 o; o.x = cvt_pk_bf16(v[0], v[1]); o.y = cvt_pk_bf16(v[2], v[3]); o.z = cvt_pk_bf16(v[4], v[5]); o.w = cvt_pk_bf16(v[6], v[7]);
    return __builtin_bit_cast(bf16x8, o);
}
__device__ __forceinline__ void phase_rwprep(const Args& a, unsigned char* lds, int G) {
    constexpr int ROWB = 3600, L_FRAG = 17 * ROWB, L_PAR = L_FRAG + 8192, NCH = 17 * 224, NT = M / 16;
    const int tid = my_tid(); const int wave = __builtin_amdgcn_readfirstlane(tid >> 6), lane = tid & 63, fr = lane & 15, fq = lane >> 4;
    unsigned char* ws = a.ws;
    const unsigned char* PRW = ws + O_PRW;
    const bf16_t* WLU = (const bf16_t*)(ws + O_WLU); const bf16_t* WLA = (const bf16_t*)(ws + O_WLA); const bf16_t* WLG = (const bf16_t*)(ws + O_WLG);
    unsigned char* SI = ws + O_SI; bf16_t* GB = (bf16_t*)(ws + O_G); float* SC = (float*)(ws + O_SC);
    float* par = (float*)(lds + L_PAR);
    for (int i = tid; i < 1792 + 5 * 512; i += 512) {
        float v;
        if (i < 1792) v = a.in[4][i]; else { const int j = i - 1792, w = j >> 9, c = j & 511; v = (w == 0 ? a.in[5] : w == 1 ? a.in[7] : w == 2 ? a.in[10] : w == 3 ? a.in[11] : a.in[12])[c]; }
        par[i] = v;
    }
    for (int tile = blockIdx.x; tile < NT; tile += G) {
        __syncthreads();
        {   u32x4 pre[8];
#pragma unroll
            for (int j = 0; j < 8; ++j) { const int c = tid + 512 * j; pre[j] = (u32x4){0u, 0u, 0u, 0u};
                if (c < NCH) { const int row = c / 224, col = c - row * 224; const bool zero = (row == 0) && (((tile * 16) & (SEQ - 1)) == 0);
                    if (!zero) pre[j] = *(const u32x4*)(PRW + ((size_t)tile * 16 + row - 1) * (RWC * 2) + col * 16); } }
#pragma unroll
            for (int j = 0; j < 8; ++j) { const int c = tid + 512 * j; if (c < NCH) { const int row = c / 224, col = c - row * 224; *(u32x4*)(lds + row * ROWB + col * 16) = pre[j]; } }
        }
        __syncthreads();
        const unsigned char* rcur = lds + (fr + 1) * ROWB; const unsigned char* rprv = lds + fr * ROWB;
        {
            const int colb = wave < 2 ? 1536 + 32 * wave : (wave < 4 ? 1600 + 32 * (wave - 2) : 1664 + 32 * (wave - 4));
            float t8[8]; mix8_lds(rcur + (colb + 8 * fq) * 2, rprv + (colb + 8 * fq) * 2, par + colb + 8 * fq, t8);
            if (wave < 2) {
#pragma unroll
                for (int i = 0; i < 8; ++i) { const float e = fexp(2.f * t8[i]); t8[i] = 1.f - 2.f * frcp(e + 1.f); } }
            else if (wave >= 4) {
#pragma unroll
                for (int i = 0; i < 8; ++i) t8[i] = fsigmoid(t8[i]); }
            *(bf16x8*)(lds + L_FRAG + wave * 1024 + lane * 16) = pack_frag(t8);
        }
        __syncthreads();
        bf16x8 Aw[2], Aa[2], Ag[4];
#pragma unroll
        for (int s = 0; s < 2; ++s) { Aw[s] = *(const bf16x8*)(lds + L_FRAG + s * 1024 + lane * 16); Aa[s] = *(const bf16x8*)(lds + L_FRAG + (2 + s) * 1024 + lane * 16); }
#pragma unroll
        for (int s = 0; s < 4; ++s) Ag[s] = *(const bf16x8*)(lds + L_FRAG + (4 + s) * 1024 + lane * 16);
        const int h = wave; const size_t m = (size_t)tile * 16 + fr;
        float kkr[16], av[16]; unsigned lk[16], rvp[16];
        float ss = 0.f, brs = 0.f, krs = 0.f, rkbs = 0.f;
#pragma unroll
        for (int n = 0; n < 4; ++n) {
            asm volatile("" ::: "memory");
            const int cb = 64 * h + 16 * n, c0 = cb + 4 * fq;
            f32x4 aw = {0.f, 0.f, 0.f, 0.f}, aa = aw, ag = aw;
#pragma unroll
            for (int s = 0; s < 2; ++s) {
                aw = __builtin_amdgcn_mfma_f32_16x16x32_bf16(*(const bf16x8*)(WLU + (size_t)(cb + fr) * 64 + 32 * s + 8 * fq), Aw[s], aw, 0, 0, 0);
                aa = __builtin_amdgcn_mfma_f32_16x16x32_bf16(*(const bf16x8*)(WLA + (size_t)(cb + fr) * 64 + 32 * s + 8 * fq), Aa[s], aa, 0, 0, 0); }
#pragma unroll
            for (int s = 0; s < 4; ++s)
                ag = __builtin_amdgcn_mfma_f32_16x16x32_bf16(*(const bf16x8*)(WLG + (size_t)(cb + fr) * 128 + 32 * s + 8 * fq), Ag[s], ag, 0, 0, 0);
            float rr[4], kr4[4], vv[4];
            mix4_lds(rcur + c0 * 2, rprv + c0 * 2, par + c0, rr); mix4_lds(rcur + (512 + c0) * 2, rprv + (512 + c0) * 2, par + 512 + c0, kr4); mix4_lds(rcur + (1024 + c0) * 2, rprv + (1024 + c0) * 2, par + 1024 + c0, vv);
            const f32x4 w0v = *(const f32x4*)(par + 1792 + c0), a0v = *(const f32x4*)(par + 2304 + c0), kkv = *(const f32x4*)(par + 2816 + c0), kav = *(const f32x4*)(par + 3328 + c0), rkv = *(const f32x4*)(par + 3840 + c0);
#pragma unroll
            for (int j = 0; j < 4; ++j) {
                const float sg = fsigmoid(w0v[j] + aw[j]);
                const float ldx = -0.60653065971f * 1.44269504089f * sg;
                const float av_ = fsigmoid(a0v[j] + aa[j]);
                const float kkraw = kr4[j] * kkv[j];
                const float k2 = kr4[j] * (1.f + (av_ - 1.f) * kav[j]);
                ss += kkraw * kkraw; brs += kkraw * av_ * rr[j]; krs += k2 * rr[j]; rkbs += rr[j] * k2 * rkv[j];
                kkr[4 * n + j] = kkraw; av[4 * n + j] = av_; lk[4 * n + j] = cvt_pk_bf16(ldx, k2); rvp[4 * n + j] = cvt_pk_bf16(rr[j], vv[j]);
            }
            u32x2 gp; gp.x = cvt_pk_bf16(ag[0], ag[1]); gp.y = cvt_pk_bf16(ag[2], ag[3]);
            *(u32x2*)(GB + m * 512 + c0) = gp;
        }
        ss = red16(ss); brs = red16(brs); krs = red16(krs); rkbs = red16(rkbs);
        const float inv = 1.f / fmaxf(sqrtf(ss), 1e-12f);
        unsigned char* rec = SI + ((m * 8 + h) * 64) * 12;
#pragma unroll
        for (int n = 0; n < 4; ++n) {
            unsigned dw[12];
#pragma unroll
            for (int j = 0; j < 4; ++j) { const float kk = kkr[4 * n + j] * inv;
                const unsigned kp = cvt_pk_bf16(kk * av[4 * n + j], -kk);
                dw[3 * j] = (lk[4 * n + j] & 0xffffu) | (kp & 0xffff0000u); dw[3 * j + 1] = (kp & 0xffffu) | (lk[4 * n + j] & 0xffff0000u); dw[3 * j + 2] = rvp[4 * n + j]; }
            u32x4* dst = (u32x4*)(rec + (16 * n + 4 * fq) * 12);
            u32x4 s0 = {dw[0], dw[1], dw[2], dw[3]}, s1 = {dw[4], dw[5], dw[6], dw[7]}, s2 = {dw[8], dw[9], dw[10], dw[11]};
            dst[0] = s0; dst[1] = s1; dst[2] = s2;
        }
        if (fq == 0) { f32x4 scv = {brs * inv, krs, rkbs, 0.f}; *(f32x4*)(SC + (m * 8 + h) * 4) = scv; }
    }
    __syncthreads();
}

__device__ __forceinline__ float red_rows(float x) {
    float a0 = x, a1 = x;
    asm volatile("s_nop 1\n\tv_permlane16_swap_b32 %0, %1" : "+v"(a0), "+v"(a1));
    float b0 = a0 + a1, b1 = b0;
    asm volatile("s_nop 1\n\tv_permlane32_swap_b32 %0, %1" : "+v"(b0), "+v"(b1));
    return b0 + b1;
}
constexpr int SC_T = 16, SC_ROW = 1552, SC_BUF = SC_T * SC_ROW;
struct ProdRec { unsigned d0, d1, d2; f32x2 sc; };
__device__ __forceinline__ void prod_load(ProdRec (&P)[4], const unsigned char* sb, const float* scp, int chunk, int pl) {
    const int col = pl & 63;
#pragma unroll
    for (int q = 0; q < 4; ++q) { const size_t t = (size_t)chunk * SC_T + (pl >> 6) + 4 * q;
        const unsigned* p = (const unsigned*)(sb + t * 6144 + col * 12); P[q].d0 = p[0]; P[q].d1 = p[1]; P[q].d2 = p[2];
        P[q].sc = (f32x2){0.f, 0.f}; if (col == 0) P[q].sc = *(const f32x2*)(scp + t * 32); }
}
__device__ __forceinline__ void prod_store(const ProdRec (&P)[4], unsigned char* buf, int pl) {
    const int col = pl & 63;
#pragma unroll
    for (int q = 0; q < 4; ++q) { unsigned char* base = buf + ((pl >> 6) + 4 * q) * SC_ROW + col * 4;
        const float w = __builtin_amdgcn_exp2f(bf_lo(P[q].d0));
        *(float*)(base) = bf_hi(P[q].d0); *(float*)(base + 256) = w * bf_lo(P[q].d2); *(float*)(base + 512) = w;
        *(float*)(base + 768) = bf_lo(P[q].d1); *(float*)(base + 1024) = bf_hi(P[q].d1); *(float*)(base + 1280) = bf_hi(P[q].d2);
        if (col == 0) *(f32x2*)(base + 1536) = P[q].sc; }
}
#define MK_SWAP32(a, b) asm volatile("s_nop 1\n\tv_permlane32_swap_b32 %0, %1" : "+v"(a), "+v"(b))
#define MK_SWAP16(a, b) asm volatile("s_nop 1\n\tv_permlane16_swap_b32 %0, %1" : "+v"(a), "+v"(b))
__device__ __forceinline__ void red4x8(float& A, float& B, float& C, float& D) {
    MK_SWAP32(A, B); float u = A + B;
    MK_SWAP32(C, D); float w = C + D;
    MK_SWAP16(u, w); float z = u + w;
    float z1;
    asm volatile("s_nop 1\n\tv_add_f32_dpp %0, %1, %1 row_ror:8 row_mask:0xf bank_mask:0xf" : "=&v"(z1) : "v"(z));
    float p = z1, q = z1; MK_SWAP32(p, q);
    float p2 = p; MK_SWAP16(p, p2);
    float q2 = q; MK_SWAP16(q, q2);
    A = p; C = p2; B = q; D = q2;
}
__device__ __forceinline__ void scan_consume(f32x2 (&S)[8], const unsigned char* buf, unsigned* yr, int lane, int rb) {
    const unsigned co = (unsigned)(lane >> 3) * 32u, vo = 1280u + (unsigned)(16 * rb + (lane & 7)) * 4u;
#pragma unroll 2
    for (int st = 0; st < SC_T; ++st) {
        const unsigned char* sb = buf + st * SC_ROW;
        f32x4 n4[2], r4[2], w4[2], a4[2], k4[2];
#pragma unroll
        for (int q = 0; q < 2; ++q) { n4[q] = *(const f32x4*)(sb + co + 16 * q); r4[q] = *(const f32x4*)(sb + 256 + co + 16 * q); w4[q] = *(const f32x4*)(sb + 512 + co + 16 * q);
            a4[q] = *(const f32x4*)(sb + 768 + co + 16 * q); k4[q] = *(const f32x4*)(sb + 1024 + co + 16 * q); }
        const float v0 = *(const float*)(sb + vo), v1 = *(const float*)(sb + vo + 32); const f32x2 bk = *(const f32x2*)(sb + 1536);
        f32x2 sa0v = {0.f, 0.f}, sa1v = sa0v, yp0v = sa0v, yp1v = sa0v;
#pragma unroll
        for (int p = 0; p < 4; ++p) { const f32x2 nn = {n4[p >> 1][2 * (p & 1)], n4[p >> 1][2 * (p & 1) + 1]}, rr2 = {r4[p >> 1][2 * (p & 1)], r4[p >> 1][2 * (p & 1) + 1]};
            sa0v += S[p] * nn; sa1v += S[4 + p] * nn; yp0v += S[p] * rr2; yp1v += S[4 + p] * rr2; }
        float sa0 = sa0v[0] + sa0v[1], sa1 = sa1v[0] + sa1v[1], yp0 = yp0v[0] + yp0v[1], yp1 = yp1v[0] + yp1v[1];
        red4x8(sa0, sa1, yp0, yp1);
        const f32x2 s0 = {sa0, sa0}, s1 = {sa1, sa1}, vv0 = {v0, v0}, vv1 = {v1, v1};
#pragma unroll
        for (int p = 0; p < 4; ++p) { const f32x2 ww = {w4[p >> 1][2 * (p & 1)], w4[p >> 1][2 * (p & 1) + 1]}, aa = {a4[p >> 1][2 * (p & 1)], a4[p >> 1][2 * (p & 1) + 1]}, kk = {k4[p >> 1][2 * (p & 1)], k4[p >> 1][2 * (p & 1) + 1]};
            S[p] = S[p] * ww + aa * s0 + kk * vv0; S[4 + p] = S[4 + p] * ww + aa * s1 + kk * vv1; }
        const float y0 = yp0 + sa0 * bk[0] + v0 * bk[1], y1 = yp1 + sa1 * bk[0] + v1 * bk[1];
        if (lane < 16) { const bool hi = (lane & 8) != 0;
            yr[(size_t)st * 512 + lane] = (unsigned)bf1(hi ? y1 : y0) | (__float_as_uint(hi ? v1 : v0) & 0xffff0000u); }
    }
}

__device__ __forceinline__ void rwpost_local(const Args& a, int bh, int tid) {
    const float* SC = (const float*)(a.ws + O_SC);
    const unsigned* YR = (const unsigned*)(a.ws + O_YR); const bf16_t* GB = (const bf16_t*)(a.ws + O_G); bf16_t* ORW = (bf16_t*)(a.ws + O_ORW);
    const int b = bh >> 3, h = bh & 7, c = 64 * h + (tid & 15) * 4;
    const f32x4 lwv = *(const f32x4*)(a.in[13] + c), lbv = *(const f32x4*)(a.in[14] + c);
    for (int t0 = tid >> 4; t0 < SEQ; t0 += 64) {
        u32x4 yv[2]; u32x2 gb[2]; float rkb[2]; size_t mm[2];
#pragma unroll
        for (int u = 0; u < 2; ++u) { const size_t m = (size_t)b * SEQ + t0 + 32 * u; mm[u] = m;
            yv[u] = *(const u32x4*)(YR + m * 512 + c); gb[u] = *(const u32x2*)(GB + m * 512 + c); rkb[u] = SC[(m * 8 + h) * 4 + 2]; }
#pragma unroll
        for (int u = 0; u < 2; ++u) {
            float y[4] = {bf_lo(yv[u].x), bf_lo(yv[u].y), bf_lo(yv[u].z), bf_lo(yv[u].w)};
            const float v[4] = {bf_hi(yv[u].x), bf_hi(yv[u].y), bf_hi(yv[u].z), bf_hi(yv[u].w)};
            float s = (y[0] + y[1]) + (y[2] + y[3]);
#pragma unroll
            for (int o = 1; o < 16; o <<= 1) s += __shfl_xor(s, o);
            const float mean = s * (1.f / 64.f);
            float q = 0.f;
#pragma unroll
            for (int j = 0; j < 4; ++j) { y[j] -= mean; q += y[j] * y[j]; }
#pragma unroll
            for (int o = 1; o < 16; o <<= 1) q += __shfl_xor(q, o);
            const float rstd = rsqrtf(q * (1.f / 64.f) + GN_EPS);
            const float g4[4] = {bf_lo(gb[u].x), bf_hi(gb[u].x), bf_lo(gb[u].y), bf_hi(gb[u].y)};
            float o4[4];
#pragma unroll
            for (int j = 0; j < 4; ++j) o4[j] = (y[j] * rstd * lwv[j] + lbv[j] + rkb[u] * v[j]) * g4[j];
            u32x2 ob; ob.x = cvt_pk_bf16(o4[0], o4[1]); ob.y = cvt_pk_bf16(o4[2], o4[3]);
            *(u32x2*)(ORW + mm[u] * 512 + c) = ob;
        }
    }
}

struct KV { bf16x8 k[4]; bf16x8 v[2][2]; };
__device__ __forceinline__ void attn_load(KV& T, const bf16_t* Kh, const bf16_t* Vh, int k0, int n, int hf) {
    const bf16_t* kp = Kh + (size_t)(k0 + n) * 512 + 8 * hf;
#pragma unroll
    for (int s = 0; s < 4; ++s) T.k[s] = *(const bf16x8*)(kp + 16 * s);
#pragma unroll
    for (int d = 0; d < 2; ++d)
#pragma unroll
        for (int sg = 0; sg < 2; ++sg) { const bf16_t* vp = Vh + (size_t)(32 * d + n) * SEQ + k0 + 16 * sg + 4 * hf;
            const u32x2 lo = *(const u32x2*)vp, hi = *(const u32x2*)(vp + 8); u32x4 t = {lo.x, lo.y, hi.x, hi.y}; T.v[d][sg] = __builtin_bit_cast(bf16x8, t); }
}
__device__ __forceinline__ void attn_wave(const Args& a, int bh, int w4, int lane) {
    const int b = bh >> 3, h = bh & 7, n = lane & 31, hf = lane >> 5;
    const size_t m0 = (size_t)b * SEQ;
    const bf16_t* Qh = (const bf16_t*)(a.ws + O_Q) + m0 * 512 + 64 * h;
    const bf16_t* Kh = (const bf16_t*)(a.ws + O_K) + m0 * 512 + 64 * h;
    const bf16_t* Vh = (const bf16_t*)(a.ws + O_VT) + (size_t)bh * 64 * SEQ;
    bf16_t* Oh = (bf16_t*)(a.ws + O_OSB) + m0 * 512 + 64 * h;
    for (int qt = 63 - w4; qt >= 0; qt -= 8) {
        const int q0 = 32 * qt;
        bf16x8 qf[4];
#pragma unroll
        for (int s = 0; s < 4; ++s) qf[s] = *(const bf16x8*)(Qh + (size_t)(q0 + n) * 512 + 16 * s + 8 * hf);
        f32x16 o0, o1;
#pragma unroll
        for (int i = 0; i < 16; ++i) { o0[i] = 0.f; o1[i] = 0.f; }
        float carry = 0.f;
        KV cur, nxt;
        attn_load(cur, Kh, Vh, q0, n, hf);
        for (int kt = qt; kt >= 0; --kt) {
            const int ktn = kt > 0 ? kt - 1 : 0;
            attn_load(nxt, Kh, Vh, 32 * ktn, n, hf);
            f32x16 sc;
#pragma unroll
            for (int i = 0; i < 16; ++i) sc[i] = 0.f;
#pragma unroll
            for (int s = 0; s < 4; ++s) sc = __builtin_amdgcn_mfma_f32_32x32x16_bf16(cur.k[s], qf[s], sc, 0, 0, 0);
            const bool diag = (kt == qt);
            float lf[16], G4[4];
#pragma unroll
            for (int g = 0; g < 4; ++g) { G4[g] = 0.f;
#pragma unroll
                for (int i = 0; i < 4; ++i) { const int r = 4 * g + i; const float z = sc[r];
                    const bool valid = !diag || (8 * g + 4 * hf + i < n);
                    const float e = fexp(-fabsf(z));
                    const float sp = fmaxf(z, 0.f) + flog(1.f + e);
                    lf[r] = valid ? -sp : 0.f; G4[g] += lf[r]; } }
            float PG[4], T4[4];
#pragma unroll
            for (int g = 0; g < 4; ++g) { PG[g] = __shfl_xor(G4[g], 32); T4[g] = G4[g] + PG[g]; }
            const float tail3 = 0.f, tail2 = T4[3], tail1 = T4[3] + T4[2], tail0 = tail1 + T4[1], total = tail0 + T4[0];
            const float tails[4] = {tail0, tail1, tail2, tail3};
            f32x16 wv;
#pragma unroll
            for (int g = 0; g < 4; ++g) {
                float af = carry + tails[g] + (hf == 0 ? PG[g] : 0.f);
#pragma unroll
                for (int i = 3; i >= 0; --i) { const int r = 4 * g + i; const float z = sc[r];
                    const bool valid = !diag || (8 * g + 4 * hf + i < n);
                    const float wgt = fexp(lf[r] + z + af);
                    wv[r] = valid ? wgt : 0.f;
                    af += lf[r]; } }
            carry += total;
            bf16x8 wf[2];
#pragma unroll
            for (int sg = 0; sg < 2; ++sg) { u32x4 t; t.x = cvt_pk_bf16(wv[8 * sg + 0], wv[8 * sg + 1]); t.y = cvt_pk_bf16(wv[8 * sg + 2], wv[8 * sg + 3]); t.z = cvt_pk_bf16(wv[8 * sg + 4], wv[8 * sg + 5]); t.w = cvt_pk_bf16(wv[8 * sg + 6], wv[8 * sg + 7]); wf[sg] = __builtin_bit_cast(bf16x8, t); }
#pragma unroll
            for (int sg = 0; sg < 2; ++sg) { o0 = __builtin_amdgcn_mfma_f32_32x32x16_bf16(cur.v[0][sg], wf[sg], o0, 0, 0, 0); o1 = __builtin_amdgcn_mfma_f32_32x32x16_bf16(cur.v[1][sg], wf[sg], o1, 0, 0, 0); }
            cur = nxt;
#if MK_EARLY_EXIT
            if (__all(carry < -104.f)) break;
#endif
        }
        bf16_t* op = Oh + (size_t)(q0 + n) * 512 + 4 * hf;
#pragma unroll
        for (int g = 0; g < 4; ++g) {
            u32x2 t0, t1; t0.x = cvt_pk_bf16(o0[4 * g], o0[4 * g + 1]); t0.y = cvt_pk_bf16(o0[4 * g + 2], o0[4 * g + 3]); t1.x = cvt_pk_bf16(o1[4 * g], o1[4 * g + 1]); t1.y = cvt_pk_bf16(o1[4 * g + 2], o1[4 * g + 3]);
            *(u32x2*)(op + 8 * g) = t0; *(u32x2*)(op + 32 + 8 * g) = t1; }
    }
}
__device__ __forceinline__ void phase_mixer(const Args& a, unsigned char* lds, int G) {
    const int tid = my_tid(); const int wave = __builtin_amdgcn_readfirstlane(tid >> 6), lane = tid & 63;
    for (int bh = blockIdx.x; bh < NB * NH; bh += G) {
        const int b = bh >> 3, h = bh & 7; const size_t m0 = (size_t)b * SEQ;
        const unsigned char* sb = a.ws + O_SI + (m0 * 8 + h) * 768; const float* scp = (const float*)(a.ws + O_SC) + (m0 * 8 + h) * 4;
        unsigned* yrb = (unsigned*)(a.ws + O_YR) + m0 * 512 + 64 * h + 16 * (wave & 3);
        const int pl = tid - 256;
        constexpr int NCH = SEQ / SC_T;
        ProdRec pr[4]; f32x2 S[8];
#pragma unroll
        for (int p = 0; p < 8; ++p) S[p] = (f32x2){0.f, 0.f};
        __syncthreads();
        if (wave >= 4) { prod_load(pr, sb, scp, 0, pl); prod_store(pr, lds, pl); prod_load(pr, sb, scp, 1, pl); }
        __syncthreads();
        for (int ci = 0; ci < NCH; ++ci) {
            if (wave < 4) scan_consume(S, lds + (ci & 1) * SC_BUF, yrb + (size_t)ci * SC_T * 512, lane, wave);
            else if (ci + 1 < NCH) { prod_store(pr, lds + ((ci + 1) & 1) * SC_BUF, pl); prod_load(pr, sb, scp, ci + 2 < NCH ? ci + 2 : ci + 1, pl); }
            __syncthreads();
        }
        attn_wave(a, bh, wave, lane);
        __threadfence_block(); __syncthreads();
        rwpost_local(a, bh, my_tid());
    }
}

template <int MODE> __device__ __forceinline__ void phase_rows(const Args& a, int G) {
    const int tid = my_tid(); const int wave = tid >> 6, lane = tid & 63;
    const int gw = blockIdx.x * 8 + wave, NGW = G * 8;
    const bf16_t* T = (const bf16_t*)(a.ws + (MODE == 0 ? O_TT : O_FF));
    const float* xin = MODE == 0 ? a.in[0] : a.out; const float* g1 = MODE == 0 ? a.in[18] : a.in[23]; const float* g2 = a.in[19];
    bf16_t* H2 = (bf16_t*)(a.ws + O_H2);
    f32x4 g1v[4], g2v[4];
#pragma unroll
    for (int j = 0; j < 4; ++j) { g1v[j] = ((const f32x4*)g1)[lane + 64 * j]; g2v[j] = ((const f32x4*)g2)[lane + 64 * j]; }
    for (int row0 = gw; row0 < M; row0 += 2 * NGW) {
        u32x2 tb[2][4]; f32x4 x[2][4];
#pragma unroll
        for (int u = 0; u < 2; ++u) { const int row = (row0 + u * NGW < M) ? row0 + u * NGW : row0;
            const u32x2* tr = (const u32x2*)(T + (size_t)row * D) + lane; const f32x4* xr = (const f32x4*)(xin + (size_t)row * D) + lane;
#pragma unroll
            for (int j = 0; j < 4; ++j) { tb[u][j] = tr[64 * j]; x[u][j] = xr[64 * j]; } }
#pragma unroll
        for (int u = 0; u < 2; ++u) {
            const int row = row0 + u * NGW;
            f32x4 t[4]; float s = 0.f;
#pragma unroll
            for (int j = 0; j < 4; ++j) { t[j][0] = bf_lo(tb[u][j].x); t[j][1] = bf_hi(tb[u][j].x); t[j][2] = bf_lo(tb[u][j].y); t[j][3] = bf_hi(tb[u][j].y);
                s += (t[j][0] * t[j][0] + t[j][1] * t[j][1]) + (t[j][2] * t[j][2] + t[j][3] * t[j][3]); }
            const float rs = rsqrtf(wave_sum(s) * (1.f / D) + RMS_EPS);
            float s2 = 0.f;
#pragma unroll
            for (int j = 0; j < 4; ++j)
#pragma unroll
                for (int e = 0; e < 4; ++e) { x[u][j][e] += t[j][e] * rs * g1v[j][e]; s2 += x[u][j][e] * x[u][j][e]; }
            float rs2 = 0.f;
            if (MODE == 0) rs2 = rsqrtf(wave_sum(s2) * (1.f / D) + RMS_EPS);
            if (row < M) {
                f32x4* orow = (f32x4*)(a.out + (size_t)row * D) + lane;
#pragma unroll
                for (int j = 0; j < 4; ++j) orow[64 * j] = x[u][j];
                if (MODE == 0) {
                    u32x2* o = (u32x2*)(H2 + (size_t)row * D) + lane;
#pragma unroll
                    for (int j = 0; j < 4; ++j) { u32x2 w; w.x = cvt_pk_bf16(x[u][j][0] * rs2 * g2v[j][0], x[u][j][1] * rs2 * g2v[j][1]); w.y = cvt_pk_bf16(x[u][j][2] * rs2 * g2v[j][2], x[u][j][3] * rs2 * g2v[j][3]); o[64 * j] = w; }
                }
            }
        }
    }
}

__global__ void __launch_bounds__(512, 2) mega(Args a) {
    extern __shared__ __attribute__((aligned(16))) unsigned char shm[];
    PG8_LAS unsigned char* lds = (PG8_LAS unsigned char*)shm;
    const int G = (int)gridDim.x;
    unsigned char* ws = a.ws;
    phase_prep(a, (float*)shm, G);
    cg::this_grid().sync();
    { Epi1 E; E.Q = (bf16_t*)(ws + O_Q); E.Kb = (bf16_t*)(ws + O_K); E.Vt = (bf16_t*)(ws + O_VT); E.Prw = (bf16_t*)(ws + O_PRW); E.Gt = (bf16_t*)a.out; E.bgate = a.in[3];
      run_gemm(lds, (const bf16_t*)(ws + O_H), (const bf16_t*)(ws + O_WIN), INC, 1024, E, G); }
    cg::this_grid().sync();
    phase_rwprep(a, shm, G);
    cg::this_grid().sync();
    phase_mixer(a, shm, G);
    cg::this_grid().sync();
    { EpiRow<1> E; E.O = (bf16_t*)(ws + O_T1); E.T1 = nullptr; E.Gt = (const bf16_t*)a.out;
      run_gemm(lds, (const bf16_t*)(ws + O_OSB), (const bf16_t*)(ws + O_WSB), 1024, 512, E, G); }
    { EpiRow<2> E; E.O = (bf16_t*)(ws + O_MRG); E.T1 = (const bf16_t*)(ws + O_T1); E.Gt = (const bf16_t*)a.out;
      run_gemm(lds, (const bf16_t*)(ws + O_ORW), (const bf16_t*)(ws + O_WRW), 1024, 512, E, G); }
    cg::this_grid().sync();
    { EpiRow<0> E; E.O = (bf16_t*)(ws + O_TT); E.T1 = nullptr; E.Gt = nullptr;
      run_gemm(lds, (const bf16_t*)(ws + O_MRG), (const bf16_t*)(ws + O_WO), 1024, 1024, E, G); }
    cg::this_grid().sync();
    phase_rows<0>(a, G);
    cg::this_grid().sync();
    { EpiSwiGLU E; E.Hd = (bf16_t*)(ws + O_HID);
      run_gemm(lds, (const bf16_t*)(ws + O_H2), (const bf16_t*)(ws + O_WGU), 2 * DFF, 1024, E, G); }
    cg::this_grid().sync();
    { EpiRow<0> E; E.O = (bf16_t*)(ws + O_FF); E.T1 = nullptr; E.Gt = nullptr;
      run_gemm(lds, (const bf16_t*)(ws + O_HID), (const bf16_t*)(ws + O_WDN), 1024, DFF, E, G); }
    cg::this_grid().sync();
    phase_rows<1>(a, G);
}
}

extern "C" void kernel_launch(void* const* d_in, const int* in_sizes, int n_in, void* d_out, int out_size, void* d_ws, size_t ws_size, hipStream_t stream) {
    static int grid = 0;
    if (grid == 0) {
        if (n_in != 24 || in_sizes[0] != mk::M * mk::D || out_size != mk::M * mk::D || ws_size < mk::WS_NEED) {
            fprintf(stderr, "kernel_launch: unexpected shapes: n_in %d in0 %d out %d ws %zu (need %zu)\n", n_in, n_in > 0 ? in_sizes[0] : -1, out_size, ws_size, (size_t)mk::WS_NEED); grid = -1; return; }
        int dev = 0, cus = 0, per_cu = 0;
        hipGetDevice(&dev); hipDeviceGetAttribute(&cus, hipDeviceAttributeMultiprocessorCount, dev);
        if (hipFuncSetAttribute((const void*)mk::mega, hipFuncAttributeMaxDynamicSharedMemorySize, mk::LDS_BYTES) != hipSuccess) { fprintf(stderr, "kernel_launch: hipFuncSetAttribute failed\n"); grid = -1; return; }
        if (hipOccupancyMaxActiveBlocksPerMultiprocessor(&per_cu, (const void*)mk::mega, 512, mk::LDS_BYTES) != hipSuccess || per_cu < 1) { fprintf(stderr, "kernel_launch: occupancy query failed (%d)\n", per_cu); per_cu = 1; }
        (void)hipGetLastError();
        grid = cus * per_cu;
        fprintf(stderr, "kernel_launch: grid %d (cus %d x %d)\n", grid, cus, per_cu);
    }
    if (grid < 0) return;
    mk::Args a{};
    for (int i = 0; i < 24; ++i) a.in[i] = (const float*)d_in[i];
    a.out = (float*)d_out; a.ws = (unsigned char*)d_ws;
    a.ph_lo = 0; a.ph_hi = mk::NPH;
    void* args[] = {&a};
    hipError_t e = hipLaunchCooperativeKernel((const void*)mk::mega, dim3(grid), dim3(512), args, mk::LDS_BYTES, stream);
    if (e != hipSuccess) fprintf(stderr, "kernel_launch: cooperative launch failed: %s (grid %d)\n", hipGetErrorString(e), grid);
}
```

```cpp
#include <hip/hip_runtime.h>
#include <hip/hip_cooperative_groups.h>
#include <cstdio>
#include <cstdint>
namespace cg = cooperative_groups;
#ifndef MK_SPLIT
#define MK_SPLIT 0
#endif
#ifndef MK_DIAG
#define MK_DIAG 0
#endif
#ifndef MK_REPMASK
#define MK_REPMASK 0
#endif
#ifndef MK_EARLY_EXIT
#define MK_EARLY_EXIT 1
#endif
namespace pg8 {
#define PG8_LAS __attribute__((address_space(3)))
typedef unsigned short bf16_t;
typedef short bf16x8 __attribute__((ext_vector_type(8)));
typedef float f32x4 __attribute__((ext_vector_type(4)));
typedef unsigned u32x4 __attribute__((ext_vector_type(4)));
constexpr int BM = 256, BK = 64, HALF = 128, HTB = HALF * BK * 2  , STAGE_BYTES = 8 * HTB, NXCD = 8, WGM = 8;

__host__ __device__ __forceinline__ int lds_byte(int r, int c) { const int st = (r >> 4) * 2 + (c >> 5), rr = r & 15, cc = c & 31, ob = rr * 64 + cc * 2; return st * 1024 + (ob ^ (((ob >> 9) & 1) << 5)); }
__host__ __device__ __forceinline__ void stage_rc(int b, int& R, int& C) { const int st = b / 1024, sb = b % 1024, swz = sb ^ (((sb >> 9) & 1) << 5); R = (st >> 1) * 16 + swz / 64; C = (st & 1) * 32 + (swz % 64) / 2; }
__host__ __device__ __forceinline__ int perm32(int rho) { const int n = rho >> 4, i = rho & 15; return 8 * (i >> 2) + 4 * n + (i & 3); }

struct Unit { int pm, pn; };
struct Gemm { const bf16_t* A; const bf16_t* Bt; int M, N, K; };

struct StaticOrder {
    int nM, nN, nwg, G, c;
    __host__ __device__ void init(int M, int N, int G_, int c_) { nM = M / BM; nN = N / BM; nwg = nM * nN; G = G_; c = c_; }
    __host__ __device__ bool next(int i, Unit& u) const {
        const long L = (long)i * G + c; if (L >= nwg) return false;
        int wgid = (int)L; { const int q = nwg / NXCD, r = nwg % NXCD, xcd = wgid % NXCD, off = wgid / NXCD; wgid = (xcd < r ? xcd * (q + 1) : r * (q + 1) + (xcd - r) * q) + off; }
        const int nig = WGM * nN, gid = wgid / nig, fm = gid * WGM, gsz = (nM - fm) < WGM ? (nM - fm) : WGM;
        u.pm = fm + ((wgid % nig) % gsz); u.pn = (wgid % nig) / gsz; return true;
    }
    __device__ __forceinline__ void a_ready(const Unit&) const {}
    __device__ __forceinline__ void done(const Unit&) const {}
};

__device__ __forceinline__ unsigned cvt_pk_bf16(float lo, float hi) { unsigned r; asm volatile("v_cvt_pk_bf16_f32 %0, %1, %2" : "=v"(r) : "v"(lo), "v"(hi)); return r; }
typedef float f32x2 __attribute__((ext_vector_type(2)));

template <class Epi, class Sched, bool ALIGN_EPI = false, bool SP2 = false>
__device__ __forceinline__ void gemm_phase(PG8_LAS unsigned char* lds, const Gemm g, const Sched& S, const Epi& E) {
    int tid_ = threadIdx.x; asm volatile("" : "+v"(tid_)); const int tid = tid_, wid = __builtin_amdgcn_readfirstlane(tid >> 6), lane = tid & 63, wr = wid >> 2, wc = wid & 3, fr = lane & 15, fq = lane >> 4;
    const int K = g.K, nt = K / BK;
    unsigned voffA[2], voffB[2];
#pragma unroll
    for (int i = 0; i < 2; ++i) { int R, C; stage_rc(tid * 16 + i * 8192, R, C); const int Rb = Epi::PERM ? ((R & ~31) + perm32(R & 31)) : R;
        voffA[i] = (unsigned)(R * K + C) * 2u; voffB[i] = (unsigned)(Rb * K + C) * 2u; }
    const size_t kstep = (size_t)(BK * 2);
    const size_t hstep = (size_t)HALF * K * 2;
    const size_t tstep = 2 * hstep;
    const unsigned ldsw = (unsigned)wid * 1024u;
    const int aoff = lds_byte(wr * 64 + fr, fq * 8), boff = lds_byte(wc * 32 + fr, fq * 8);
#define PG8_SA(b, h) (((b) * 2 + (h)) * HTB)
#define PG8_SB(b, h) ((4 + (b) * 2 + (h)) * HTB)
#define PG8_STAGE(bufoff, gbase, voff) do { _Pragma("unroll") for (int _i = 0; _i < 2; ++_i) \
        __builtin_amdgcn_global_load_lds((const unsigned*)((const char*)(gbase) + (voff)[_i]), (PG8_LAS unsigned*)(lds + (bufoff) + ldsw + _i * 8192), 16, 0, 0); } while (0)
#define PG8_LDA(dst, b, h) do { _Pragma("unroll") for (int m = 0; m < 4; ++m) _Pragma("unroll") for (int k = 0; k < 2; ++k) dst[m][k] = *(const PG8_LAS bf16x8*)(lds + PG8_SA(b, h) + aoff + m * 2048 + k * 1024); } while (0)
#define PG8_LDB(dst, b, h) do { _Pragma("unroll") for (int n = 0; n < 2; ++n) _Pragma("unroll") for (int k = 0; k < 2; ++k) dst[n][k] = *(const PG8_LAS bf16x8*)(lds + PG8_SB(b, h) + boff + n * 2048 + k * 1024); } while (0)
#define PG8_MMA(ai, bj, At, Bt) do { __builtin_amdgcn_s_setprio(1); _Pragma("unroll") for (int m = 0; m < 4; ++m) _Pragma("unroll") for (int n = 0; n < 2; ++n) _Pragma("unroll") for (int k = 0; k < 2; ++k) \
        acc[ai][bj][m][n] = __builtin_amdgcn_mfma_f32_16x16x32_bf16(Bt[n][k], At[m][k], acc[ai][bj][m][n], 0, 0, 0); __builtin_amdgcn_s_setprio(0); } while (0)
#define PG8_WAIT_V(n) asm volatile("s_waitcnt vmcnt(" #n ")" ::: "memory")
#define PG8_WAIT_L(n) asm volatile("s_waitcnt lgkmcnt(" #n ")" ::: "memory")
#define PG8_BAR __builtin_amdgcn_s_barrier()
#define PG8_SCHED __builtin_amdgcn_sched_barrier(0)
    Unit cur, nxt; int ui = 0;
    if (!S.next(0, cur)) return;
    f32x4 acc[2][2][4][2];
#pragma unroll
    for (int a = 0; a < 2; ++a)
#pragma unroll
        for (int b = 0; b < 2; ++b)
#pragma unroll
            for (int m = 0; m < 4; ++m)
#pragma unroll
                for (int n = 0; n < 2; ++n) acc[a][b][m][n] = (f32x4){0.f, 0.f, 0.f, 0.f};
    bf16x8 At[4][2], B0[2][2], B1[2][2];
    const char* cA = (const char*)g.A + (size_t)cur.pm * tstep; const char* cB = (const char*)g.Bt + (size_t)cur.pn * tstep;
    S.a_ready(cur);
    if constexpr (SP2) {
        PG8_STAGE(PG8_SB(0, 0), cB, voffB); PG8_STAGE(PG8_SB(0, 1), cB + hstep, voffB); PG8_STAGE(PG8_SA(0, 0), cA, voffA); PG8_STAGE(PG8_SA(0, 1), cA + hstep, voffA);
        if (wr == 1) PG8_BAR;
        PG8_WAIT_V(2); PG8_BAR;
        PG8_STAGE(PG8_SB(1, 0), cB + kstep, voffB); PG8_STAGE(PG8_SA(1, 0), cA + kstep, voffA); PG8_STAGE(PG8_SB(1, 1), cB + hstep + kstep, voffB);
        PG8_WAIT_V(6); PG8_BAR;
    } else {
        PG8_STAGE(PG8_SB(0, 0), cB, voffB); PG8_STAGE(PG8_SA(0, 0), cA, voffA); PG8_STAGE(PG8_SB(0, 1), cB + hstep, voffB); PG8_STAGE(PG8_SA(0, 1), cA + hstep, voffA);
        if (wr == 1) PG8_BAR;
        PG8_WAIT_V(4); PG8_BAR;
        PG8_STAGE(PG8_SB(1, 0), cB + kstep, voffB); PG8_STAGE(PG8_SA(1, 0), cA + kstep, voffA); PG8_STAGE(PG8_SB(1, 1), cB + hstep + kstep, voffB);
        PG8_WAIT_V(6); PG8_BAR;
    }
    for (;;) {
        const bool has_next = S.next(ui + 1, nxt);
        const char* nA = has_next ? (const char*)g.A + (size_t)nxt.pm * tstep : cA; const char* nB = has_next ? (const char*)g.Bt + (size_t)nxt.pn * tstep : cB;
        for (int t = 0; t < nt; t += 2) {
            const bool last = (t == nt - 2);
            const char* a1 = cA + (size_t)(t + 1) * kstep;
            const char* a2 = last ? nA : cA + (size_t)(t + 2) * kstep; const char* b2 = last ? nB : cB + (size_t)(t + 2) * kstep;
            const char* a3 = a2 + kstep; const char* b3 = b2 + kstep;
            if (last && has_next) S.a_ready(nxt);
            if constexpr (SP2) {
            PG8_LDB(B0, 0, 0); PG8_LDB(B1, 0, 1); PG8_SCHED; PG8_LDA(At, 0, 0); PG8_STAGE(PG8_SA(1, 1), a1 + hstep, voffA);
            PG8_WAIT_V(8); PG8_WAIT_L(0); PG8_BAR; PG8_MMA(0, 0, At, B0); PG8_MMA(0, 1, At, B1); PG8_BAR; PG8_SCHED;
            PG8_LDA(At, 0, 1); PG8_STAGE(PG8_SB(0, 0), b2, voffB); PG8_STAGE(PG8_SB(0, 1), b2 + hstep, voffB); PG8_STAGE(PG8_SA(0, 0), a2, voffA);
            PG8_WAIT_V(8); PG8_WAIT_L(0); PG8_BAR; PG8_MMA(1, 0, At, B0); PG8_MMA(1, 1, At, B1); PG8_BAR; PG8_SCHED;
            PG8_LDB(B0, 1, 0); PG8_LDB(B1, 1, 1); PG8_SCHED; PG8_LDA(At, 1, 0); PG8_STAGE(PG8_SA(0, 1), a2 + hstep, voffA);
            PG8_WAIT_V(8); PG8_WAIT_L(0); PG8_BAR; PG8_MMA(0, 0, At, B0); PG8_MMA(0, 1, At, B1); PG8_BAR; PG8_SCHED;
            PG8_LDA(At, 1, 1); PG8_STAGE(PG8_SB(1, 0), b3, voffB); PG8_STAGE(PG8_SB(1, 1), b3 + hstep, voffB); PG8_STAGE(PG8_SA(1, 0), a3, voffA);
            PG8_WAIT_V(8); PG8_WAIT_L(0); PG8_BAR; PG8_MMA(1, 0, At, B0); PG8_MMA(1, 1, At, B1); PG8_BAR; PG8_SCHED;
            } else {
            PG8_LDB(B0, 0, 0); PG8_SCHED; PG8_LDA(At, 0, 0); PG8_STAGE(PG8_SA(1, 1), a1 + hstep, voffA);
            PG8_WAIT_L(8); PG8_BAR; PG8_WAIT_L(0); PG8_MMA(0, 0, At, B0); PG8_BAR; PG8_SCHED;
            PG8_LDB(B1, 0, 1); PG8_STAGE(PG8_SB(0, 0), b2, voffB);
            PG8_BAR; PG8_WAIT_L(0); PG8_MMA(0, 1, At, B1); PG8_BAR;
            PG8_LDA(At, 0, 1); PG8_STAGE(PG8_SA(0, 0), a2, voffA);
            PG8_BAR; PG8_WAIT_L(0); PG8_MMA(1, 0, At, B0); PG8_BAR; PG8_SCHED;
            PG8_STAGE(PG8_SB(0, 1), b2 + hstep, voffB);
            PG8_WAIT_V(6); PG8_BAR; PG8_MMA(1, 1, At, B1); PG8_BAR;
            PG8_LDB(B0, 1, 0); PG8_SCHED; PG8_LDA(At, 1, 0); PG8_STAGE(PG8_SA(0, 1), a2 + hstep, voffA);
            PG8_WAIT_L(8); PG8_BAR; PG8_WAIT_L(0); PG8_MMA(0, 0, At, B0); PG8_BAR; PG8_SCHED;
            PG8_LDB(B1, 1, 1); PG8_STAGE(PG8_SB(1, 0), b3, voffB);
            PG8_BAR; PG8_WAIT_L(0); PG8_MMA(0, 1, At, B1); PG8_BAR;
            PG8_LDA(At, 1, 1); PG8_STAGE(PG8_SA(1, 0), a3, voffA);
            PG8_BAR; PG8_WAIT_L(0); PG8_MMA(1, 0, At, B0); PG8_BAR; PG8_SCHED;
            PG8_STAGE(PG8_SB(1, 1), b3 + hstep, voffB);
            PG8_WAIT_V(6); PG8_BAR; PG8_MMA(1, 1, At, B1); PG8_BAR;
            }
        }
        if constexpr (ALIGN_EPI) { if (wr == 0) PG8_BAR; }
        if constexpr (!Epi::AFTER_DRAIN) { E(acc, cur, wr, wc, fr, fq); S.done(cur); }
        if (!has_next) break;
#pragma unroll
        for (int a = 0; a < 2; ++a)
#pragma unroll
            for (int b = 0; b < 2; ++b)
#pragma unroll
                for (int m = 0; m < 4; ++m)
#pragma unroll
                    for (int n = 0; n < 2; ++n) acc[a][b][m][n] = (f32x4){0.f, 0.f, 0.f, 0.f};
        cur = nxt; cA = nA; cB = nB; ++ui;
        if constexpr (ALIGN_EPI) { if (wr == 1) PG8_BAR; }
    }
    PG8_WAIT_V(0);
    if constexpr (!ALIGN_EPI) { if (wr == 0) PG8_BAR; }
    PG8_BAR;
    if constexpr (Epi::AFTER_DRAIN) { E.fused(acc, cur, wr, wc, fr, fq, lds, wid, lane); S.done(cur); }
#undef PG8_SA
#undef PG8_SB
#undef PG8_STAGE
#undef PG8_LDA
#undef PG8_LDB
#undef PG8_MMA
#undef PG8_WAIT_V
#undef PG8_WAIT_L
#undef PG8_BAR
#undef PG8_SCHED
}

}
namespace mk {
using pg8::bf16_t; using pg8::bf16x8; using pg8::f32x4; using pg8::u32x4; using pg8::cvt_pk_bf16;
typedef float f32x16 __attribute__((ext_vector_type(16)));
typedef float f32x2 __attribute__((ext_vector_type(2)));
typedef unsigned u32x2 __attribute__((ext_vector_type(2)));
constexpr int D = 1024, NB = 32, SEQ = 2048, M = NB * SEQ, NH = 8, DH = 64;
constexpr int RWC = 1792, GC = 2048, INC = 5376, DFF = 2816;
constexpr float RMS_EPS = 1e-6f, GN_EPS = 64e-5f;
constexpr size_t MiB = (size_t)1 << 20;
constexpr size_t O_WIN = 0, O_WSB = 11 * MiB, O_WRW = 12 * MiB, O_WO = 13 * MiB, O_WGU = 15 * MiB, O_WDN = 26 * MiB, O_WLU = 32 * MiB  , O_WLA = O_WLU + 65536, O_WLG = O_WLA + 65536;
constexpr size_t O_Q = 34 * MiB, O_K = 98 * MiB, O_VT = 162 * MiB, O_PRW = 226 * MiB, O_H = 450 * MiB, O_SI = 450 * MiB, O_G = 834 * MiB, O_SC = 898 * MiB, O_YR = 290 * MiB  ;
constexpr size_t O_OSB = 226 * MiB, O_ORW = 34 * MiB, O_T1 = 98 * MiB, O_MRG = 450 * MiB, O_TT = 34 * MiB, O_H2 = 162 * MiB, O_HID = 290 * MiB, O_FF = 34 * MiB;
constexpr size_t WS_NEED = 1009 * MiB;
constexpr int LDS_BYTES = pg8::STAGE_BYTES + 64;
constexpr size_t O_CTL = 1008 * MiB, CTL_BYTES = 65536;
constexpr int NPH = 12;

struct Args { const float* in[24]; float* out; unsigned char* ws; int ph_lo, ph_hi; };

__device__ __forceinline__ int my_tid() { int t = threadIdx.x; asm volatile("" : "+v"(t)); return t; }
__device__ __forceinline__ float bf_lo(unsigned u) { return __uint_as_float(u << 16); }
__device__ __forceinline__ float bf_hi(unsigned u) { return __uint_as_float(u & 0xffff0000u); }
__device__ __forceinline__ float fexp(float x) { return __builtin_amdgcn_exp2f(x * 1.44269504089f); }
__device__ __forceinline__ float flog(float x) { return __builtin_amdgcn_logf(x) * 0.69314718056f; }
__device__ __forceinline__ float frcp(float x) { return __builtin_amdgcn_rcpf(x); }
__device__ __forceinline__ float fsigmoid(float x) { return frcp(1.f + fexp(-x)); }
__device__ __forceinline__ unsigned short bf1(float x) { return (unsigned short)(cvt_pk_bf16(x, x) & 0xffffu); }
__device__ __forceinline__ u32x4 pack8(const f32x4 a, const f32x4 b) { u32x4 o; o.x = cvt_pk_bf16(a[0], a[1]); o.y = cvt_pk_bf16(a[2], a[3]); o.z = cvt_pk_bf16(b[0], b[1]); o.w = cvt_pk_bf16(b[2], b[3]); return o; }
__device__ __forceinline__ float red16(float v) {
    v += __shfl_xor(v, 16); v += __shfl_xor(v, 32); return v;
}
__device__ __forceinline__ float wave_sum(float v) {
#pragma unroll
    for (int o = 1; o < 64; o <<= 1) v += __shfl_xor(v, o);
    return v;
}

__device__ __forceinline__ void tr_item(const float* __restrict__ W, int K, int N, bf16_t* WT, float* scr, int item, int lane, int mode) {
    const int nblk = N >> 5, kb = item / nblk, nb = item - kb * nblk, k0 = kb << 6, n0 = nb << 5;
#pragma unroll 8
    for (int i = 0; i < 32; ++i) { const int kk = 2 * i + (lane >> 5); scr[kk * 33 + (lane & 31)] = W[(size_t)(k0 + kk) * N + n0 + (lane & 31)]; }
    asm volatile("s_waitcnt lgkmcnt(0)" ::: "memory"); __builtin_amdgcn_wave_barrier();
    const int c = lane & 7;
#pragma unroll
    for (int j = 0; j < 4; ++j) {
        const int n = (lane >> 3) + 8 * j; const float* s = scr + (8 * c) * 33 + n;
        u32x4 o; o.x = cvt_pk_bf16(s[0 * 33], s[1 * 33]); o.y = cvt_pk_bf16(s[2 * 33], s[3 * 33]); o.z = cvt_pk_bf16(s[4 * 33], s[5 * 33]); o.w = cvt_pk_bf16(s[6 * 33], s[7 * 33]);
        const int nn = n0 + n; int drow = nn;
        if (mode == 1) drow = ((nn >> 7) << 8) + (nn & 127); else if (mode == 2) drow = ((nn >> 7) << 8) + 128 + (nn & 127);
        *(u32x4*)(WT + (size_t)drow * K + k0 + 8 * c) = o;
    }
    asm volatile("s_waitcnt lgkmcnt(0)" ::: "memory"); __builtin_amdgcn_wave_barrier();
}

__device__ __forceinline__ void phase_prep(const Args& a, float* lds_f, int G) {
    const int tid = my_tid(); const int wave = tid >> 6, lane = tid & 63;
    const int gw = blockIdx.x * 8 + wave, NGW = G * 8;
    float* scr = lds_f + wave * (64 * 33 + 16);
    unsigned char* ws = a.ws;
    constexpr int I_IN = 16 * 168, I_SB = 8 * 32, I_O = 16 * 32, I_G = 16 * 88, I_DN = 44 * 32, I_LU = 16, I_LG = 32;
    constexpr int NIT = I_IN + 2 * I_SB + I_O + 2 * I_G + I_DN + 2 * I_LU + I_LG;
    for (int it = gw; it < NIT; it += NGW) {
        int r = it;
        if (r < I_IN) { tr_item(a.in[2], 1024, INC, (bf16_t*)(ws + O_WIN), scr, r, lane, 0); continue; } r -= I_IN;
        if (r < I_SB) { tr_item(a.in[15], 512, 1024, (bf16_t*)(ws + O_WSB), scr, r, lane, 0); continue; } r -= I_SB;
        if (r < I_SB) { tr_item(a.in[16], 512, 1024, (bf16_t*)(ws + O_WRW), scr, r, lane, 0); continue; } r -= I_SB;
        if (r < I_O) { tr_item(a.in[17], 1024, 1024, (bf16_t*)(ws + O_WO), scr, r, lane, 0); continue; } r -= I_O;
        if (r < I_G) { tr_item(a.in[20], 1024, DFF, (bf16_t*)(ws + O_WGU), scr, r, lane, 1); continue; } r -= I_G;
        if (r < I_G) { tr_item(a.in[21], 1024, DFF, (bf16_t*)(ws + O_WGU), scr, r, lane, 2); continue; } r -= I_G;
        if (r < I_DN) { tr_item(a.in[22], DFF, 1024, (bf16_t*)(ws + O_WDN), scr, r, lane, 0); continue; } r -= I_DN;
        if (r < I_LU) { tr_item(a.in[6], 64, 512, (bf16_t*)(ws + O_WLU), scr, r, lane, 0); continue; } r -= I_LU;
        if (r < I_LU) { tr_item(a.in[8], 64, 512, (bf16_t*)(ws + O_WLA), scr, r, lane, 0); continue; } r -= I_LU;
        tr_item(a.in[9], 128, 512, (bf16_t*)(ws + O_WLG), scr, r, lane, 0);
    }
    const float* x = a.in[0]; const float* g = a.in[1]; bf16_t* H = (bf16_t*)(ws + O_H);
    f32x4 gv[4];
#pragma unroll
    for (int j = 0; j < 4; ++j) gv[j] = ((const f32x4*)g)[lane + 64 * j];
    for (int row0 = gw; row0 < M; row0 += 2 * NGW) {
        f32x4 v[2][4];
#pragma unroll
        for (int u = 0; u < 2; ++u) { const int row = (row0 + u * NGW < M) ? row0 + u * NGW : row0; const f32x4* xr = (const f32x4*)(x + (size_t)row * D) + lane;
#pragma unroll
            for (int j = 0; j < 4; ++j) v[u][j] = xr[64 * j]; }
#pragma unroll
        for (int u = 0; u < 2; ++u) { const int row = row0 + u * NGW; float s = 0.f;
#pragma unroll
            for (int j = 0; j < 4; ++j) s += (v[u][j][0] * v[u][j][0] + v[u][j][1] * v[u][j][1]) + (v[u][j][2] * v[u][j][2] + v[u][j][3] * v[u][j][3]);
            const float rs = rsqrtf(wave_sum(s) * (1.f / D) + RMS_EPS);
            if (row < M) { u32x2* o = (u32x2*)(H + (size_t)row * D) + lane;
#pragma unroll
                for (int j = 0; j < 4; ++j) { u32x2 w; w.x = cvt_pk_bf16(v[u][j][0] * rs * gv[j][0], v[u][j][1] * rs * gv[j][1]); w.y = cvt_pk_bf16(v[u][j][2] * rs * gv[j][2], v[u][j][3] * rs * gv[j][3]); o[64 * j] = w; } }
        }
    }
}

struct Epi1 {
    static constexpr bool PERM = true, AFTER_DRAIN = false;
    bf16_t *Q, *Kb, *Vt, *Prw, *Gt; const float* bgate;
    __device__ __forceinline__ void operator()(const f32x4 (&acc)[2][2][4][2], const pg8::Unit& u, int wr, int wc, int fr, int fq) const {
        const int row0 = u.pm * 256 + wr * 64 + fr, pn = u.pn, cl = wc * 32 + 8 * fq;
        if (pn < 4) {
            bf16_t* dst = pn < 2 ? Q : Kb; const float sc = pn < 2 ? 0.125f : 1.f; const int cb = (pn & 1) * 256 + cl;
#pragma unroll
            for (int ai = 0; ai < 2; ++ai)
#pragma unroll
                for (int m = 0; m < 4; ++m) { bf16_t* rp = dst + (size_t)(row0 + ai * 128 + m * 16) * 512 + cb;
#pragma unroll
                    for (int bj = 0; bj < 2; ++bj) *(u32x4*)(rp + bj * 128) = pack8(acc[ai][bj][m][0] * sc, acc[ai][bj][m][1] * sc); }
        } else if (pn < 6) {
#pragma unroll
            for (int ai = 0; ai < 2; ++ai)
#pragma unroll
                for (int m = 0; m < 4; ++m) { const int row = row0 + ai * 128 + m * 16, b = row >> 11, s = row & 2047;
#pragma unroll
                    for (int bj = 0; bj < 2; ++bj)
#pragma unroll
                        for (int n = 0; n < 2; ++n)
#pragma unroll
                            for (int j = 0; j < 4; ++j) { const int c = (pn - 4) * 256 + bj * 128 + cl + 4 * n + j;
                                Vt[((size_t)(b * 512 + c)) * 2048 + s] = bf1(acc[ai][bj][m][n][j]); } }
        } else if (pn < 13) {
            const int cb = (pn - 6) * 256 + cl;
#pragma unroll
            for (int ai = 0; ai < 2; ++ai)
#pragma unroll
                for (int m = 0; m < 4; ++m) { bf16_t* rp = Prw + (size_t)(row0 + ai * 128 + m * 16) * RWC + cb;
#pragma unroll
                    for (int bj = 0; bj < 2; ++bj) *(u32x4*)(rp + bj * 128) = pack8(acc[ai][bj][m][0], acc[ai][bj][m][1]); }
        } else {
            const int cb = (pn - 13) * 256 + cl;
#pragma unroll
            for (int ai = 0; ai < 2; ++ai)
#pragma unroll
                for (int m = 0; m < 4; ++m) { bf16_t* rp = Gt + (size_t)(row0 + ai * 128 + m * 16) * GC + cb;
#pragma unroll
                    for (int bj = 0; bj < 2; ++bj) { f32x4 v0 = acc[ai][bj][m][0] + *(const f32x4*)(bgate + cb + bj * 128), v1 = acc[ai][bj][m][1] + *(const f32x4*)(bgate + cb + bj * 128 + 4);
#pragma unroll
                        for (int j = 0; j < 4; ++j) { v0[j] = fsigmoid(v0[j]); v1[j] = fsigmoid(v1[j]); }
                        *(u32x4*)(rp + bj * 128) = pack8(v0, v1); } }
        }
    }
};
template <int MODE> struct EpiRow {
    static constexpr bool PERM = true, AFTER_DRAIN = false;
    bf16_t* O; const bf16_t* T1; const bf16_t* Gt;
    __device__ __forceinline__ void operator()(const f32x4 (&acc)[2][2][4][2], const pg8::Unit& u, int wr, int wc, int fr, int fq) const {
        const int row0 = u.pm * 256 + wr * 64 + fr, cb = u.pn * 256 + wc * 32 + 8 * fq;
#pragma unroll
        for (int ai = 0; ai < 2; ++ai)
#pragma unroll
            for (int m = 0; m < 4; ++m) { const size_t row = (size_t)(row0 + ai * 128 + m * 16);
#pragma unroll
                for (int bj = 0; bj < 2; ++bj) { f32x4 v0 = acc[ai][bj][m][0], v1 = acc[ai][bj][m][1]; const int c = cb + bj * 128;
                    if (MODE >= 1) { const u32x4 gg = *(const u32x4*)(Gt + row * GC + (MODE == 2 ? 1024 : 0) + c);
                        v0[0] *= bf_lo(gg.x); v0[1] *= bf_hi(gg.x); v0[2] *= bf_lo(gg.y); v0[3] *= bf_hi(gg.y); v1[0] *= bf_lo(gg.z); v1[1] *= bf_hi(gg.z); v1[2] *= bf_lo(gg.w); v1[3] *= bf_hi(gg.w); }
                    if (MODE == 2) { const u32x4 tt = *(const u32x4*)(T1 + row * 1024 + c);
                        v0[0] += bf_lo(tt.x); v0[1] += bf_hi(tt.x); v0[2] += bf_lo(tt.y); v0[3] += bf_hi(tt.y); v1[0] += bf_lo(tt.z); v1[1] += bf_hi(tt.z); v1[2] += bf_lo(tt.w); v1[3] += bf_hi(tt.w); }
                    *(u32x4*)(O + row * 1024 + c) = pack8(v0, v1); } }
    }
};
struct EpiSwiGLU {
    static constexpr bool PERM = true, AFTER_DRAIN = false;
    bf16_t* Hd;
    __device__ __forceinline__ void operator()(const f32x4 (&acc)[2][2][4][2], const pg8::Unit& u, int wr, int wc, int fr, int fq) const {
        const int row0 = u.pm * 256 + wr * 64 + fr, cb = u.pn * 128 + wc * 32 + 8 * fq;
#pragma unroll
        for (int ai = 0; ai < 2; ++ai)
#pragma unroll
            for (int m = 0; m < 4; ++m) { f32x4 v0, v1;
#pragma unroll
                for (int j = 0; j < 4; ++j) { const float g0 = acc[ai][0][m][0][j], g1 = acc[ai][0][m][1][j];
                    v0[j] = g0 * fsigmoid(g0) * acc[ai][1][m][0][j]; v1[j] = g1 * fsigmoid(g1) * acc[ai][1][m][1][j]; }
                *(u32x4*)(Hd + (size_t)(row0 + ai * 128 + m * 16) * DFF + cb) = pack8(v0, v1); }
    }
};
template <class Epi> __device__ __forceinline__ void run_gemm(PG8_LAS unsigned char* lds, const bf16_t* A, const bf16_t* Bt, int N, int K, const Epi& E, int G) {
    pg8::Gemm g; g.A = A; g.Bt = Bt; g.M = M; g.N = N; g.K = K;
    pg8::StaticOrder S; S.init(M, N, G, (int)blockIdx.x);
    pg8::gemm_phase<Epi, pg8::StaticOrder, true, true>(lds, g, S, E);
}
__device__ __forceinline__ void mix8_lds(const unsigned char* cur, const unsigned char* prv, const float* mu, float (&o)[8]) {
    const u32x4 c = *(const u32x4*)cur, p = *(const u32x4*)prv;
    const f32x4 m0 = *(const f32x4*)mu, m1 = *(const f32x4*)(mu + 4);
    const float mm[8] = {m0[0], m0[1], m0[2], m0[3], m1[0], m1[1], m1[2], m1[3]};
#pragma unroll
    for (int i = 0; i < 4; ++i) { const float cl = bf_lo(c[i]), ch = bf_hi(c[i]), pl = bf_lo(p[i]), ph = bf_hi(p[i]);
        o[2 * i] = cl + (pl - cl) * mm[2 * i]; o[2 * i + 1] = ch + (ph - ch) * mm[2 * i + 1]; }
}
__device__ __forceinline__ void mix4_lds(const unsigned char* cur, const unsigned char* prv, const float* mu, float (&o)[4]) {
    const u32x2 c = *(const u32x2*)cur, p = *(const u32x2*)prv;
    const f32x4 m0 = *(const f32x4*)mu;
#pragma unroll
    for (int i = 0; i < 2; ++i) { const float cl = bf_lo(c[i]), ch = bf_hi(c[i]), pl = bf_lo(p[i]), ph = bf_hi(p[i]);
        o[2 * i] = cl + (pl - cl) * m0[2 * i]; o[2 * i + 1] = ch + (ph - ch) * m0[2 * i + 1]; }
}
__device__ __forceinline__ bf16x8 pack_frag(const float (&v)[8]) {
    u32x4 o; o.x = cvt_pk_bf16(v[0], v[1]); o.y = cvt_pk_bf16(v[2], v[3]); o.z = cvt_pk_bf16(v[4], v[5]); o.w = cvt_pk_bf16(v[6], v[7]);
    return __builtin_bit_cast(bf16x8, o);
}
__device__ __forceinline__ void phase_rwprep(const Args& a, unsigned char* lds, int G) {
    constexpr int ROWB = 3600, L_FRAG = 17 * ROWB, L_PAR = L_FRAG + 8192, NCH = 17 * 224, NT = M / 16;
    const int tid = my_tid(); const int wave = __builtin_amdgcn_readfirstlane(tid >> 6), lane = tid & 63, fr = lane & 15, fq = lane >> 4;
    unsigned char* ws = a.ws;
    const unsigned char* PRW = ws + O_PRW;
    const bf16_t* WLU = (const bf16_t*)(ws + O_WLU); const bf16_t* WLA = (const bf16_t*)(ws + O_WLA); const bf16_t* WLG = (const bf16_t*)(ws + O_WLG);
    unsigned char* SI = ws + O_SI; bf16_t* GB = (bf16_t*)(ws + O_G); float* SC = (float*)(ws + O_SC);
    float* par = (float*)(lds + L_PAR);
    for (int i = tid; i < 1792 + 5 * 512; i += 512) {
        float v;
        if (i < 1792) v = a.in[4][i]; else { const int j = i - 1792, w = j >> 9, c = j & 511; v = (w == 0 ? a.in[5] : w == 1 ? a.in[7] : w == 2 ? a.in[10] : w == 3 ? a.in[11] : a.in[12])[c]; }
        par[i] = v;
    }
    for (int tile = blockIdx.x; tile < NT; tile += G) {
        __syncthreads();
        {   u32x4 pre[8];
#pragma unroll
            for (int j = 0; j < 8; ++j) { const int c = tid + 512 * j; pre[j] = (u32x4){0u, 0u, 0u, 0u};
                if (c < NCH) { const int row = c / 224, col = c - row * 224; const bool zero = (row == 0) && (((tile * 16) & (SEQ - 1)) == 0);
                    if (!zero) pre[j] = *(const u32x4*)(PRW + ((size_t)tile * 16 + row - 1) * (RWC * 2) + col * 16); } }
#pragma unroll
            for (int j = 0; j < 8; ++j) { const int c = tid + 512 * j; if (c < NCH) { const int row = c / 224, col = c - row * 224; *(u32x4*)(lds + row * ROWB + col * 16) = pre[j]; } }
        }
        __syncthreads();
        const unsigned char* rcur = lds + (fr + 1) * ROWB; const unsigned char* rprv = lds + fr * ROWB;
        {
            const int colb = wave < 2 ? 1536 + 32 * wave : (wave < 4 ? 1600 + 32 * (wave - 2) : 1664 + 32 * (wave - 4));
            float t8[8]; mix8_lds(rcur + (colb + 8 * fq) * 2, rprv + (colb + 8 * fq) * 2, par + colb + 8 * fq, t8);
            if (wave < 2) {
#pragma unroll
                for (int i = 0; i < 8; ++i) { const float e = fexp(2.f * t8[i]); t8[i] = 1.f - 2.f * frcp(e + 1.f); } }
            else if (wave >= 4) {
#pragma unroll
                for (int i = 0; i < 8; ++i) t8[i] = fsigmoid(t8[i]); }
            *(bf16x8*)(lds + L_FRAG + wave * 1024 + lane * 16) = pack_frag(t8);
        }
        __syncthreads();
        bf16x8 Aw[2], Aa[2], Ag[4];
#pragma unroll
        for (int s = 0; s < 2; ++s) { Aw[s] = *(const bf16x8*)(lds + L_FRAG + s * 1024 + lane * 16); Aa[s] = *(const bf16x8*)(lds + L_FRAG + (2 + s) * 1024 + lane * 16); }
#pragma unroll
        for (int s = 0; s < 4; ++s) Ag[s] = *(const bf16x8*)(lds + L_FRAG + (4 + s) * 1024 + lane * 16);
        const int h = wave; const size_t m = (size_t)tile * 16 + fr;
        float kkr[16], av[16]; unsigned lk[16], rvp[16];
        float ss = 0.f, brs = 0.f, krs = 0.f, rkbs = 0.f;
#pragma unroll
        for (int n = 0; n < 4; ++n) {
            asm volatile("" ::: "memory");
            const int cb = 64 * h + 16 * n, c0 = cb + 4 * fq;
            f32x4 aw = {0.f, 0.f, 0.f, 0.f}, aa = aw, ag = aw;
#pragma unroll
            for (int s = 0; s < 2; ++s) {
                aw = __builtin_amdgcn_mfma_f32_16x16x32_bf16(*(const bf16x8*)(WLU + (size_t)(cb + fr) * 64 + 32 * s + 8 * fq), Aw[s], aw, 0, 0, 0);
                aa = __builtin_amdgcn_mfma_f32_16x16x32_bf16(*(const bf16x8*)(WLA + (size_t)(cb + fr) * 64 + 32 * s + 8 * fq), Aa[s], aa, 0, 0, 0); }
#pragma unroll
            for (int s = 0; s < 4; ++s)
                ag = __builtin_amdgcn_mfma_f32_16x16x32_bf16(*(const bf16x8*)(WLG + (size_t)(cb + fr) * 128 + 32 * s + 8 * fq), Ag[s], ag, 0, 0, 0);
            float rr[4], kr4[4], vv[4];
            mix4_lds(rcur + c0 * 2, rprv + c0 * 2, par + c0, rr); mix4_lds(rcur + (512 + c0) * 2, rprv + (512 + c0) * 2, par + 512 + c0, kr4); mix4_lds(rcur + (1024 + c0) * 2, rprv + (1024 + c0) * 2, par + 1024 + c0, vv);
            const f32x4 w0v = *(const f32x4*)(par + 1792 + c0), a0v = *(const f32x4*)(par + 2304 + c0), kkv = *(const f32x4*)(par + 2816 + c0), kav = *(const f32x4*)(par + 3328 + c0), rkv = *(const f32x4*)(par + 3840 + c0);
#pragma unroll
            for (int j = 0; j < 4; ++j) {
                const float sg = fsigmoid(w0v[j] + aw[j]);
                const float ldx = -0.60653065971f * 1.44269504089f * sg;
                const float av_ = fsigmoid(a0v[j] + aa[j]);
                const float kkraw = kr4[j] * kkv[j];
                const float k2 = kr4[j] * (1.f + (av_ - 1.f) * kav[j]);
                ss += kkraw * kkraw; brs += kkraw * av_ * rr[j]; krs += k2 * rr[j]; rkbs += rr[j] * k2 * rkv[j];
                kkr[4 * n + j] = kkraw; av[4 * n + j] = av_; lk[4 * n + j] = cvt_pk_bf16(ldx, k2); rvp[4 * n + j] = cvt_pk_bf16(rr[j], vv[j]);
            }
            u32x2 gp; gp.x = cvt_pk_bf16(ag[0], ag[1]); gp.y = cvt_pk_bf16(ag[2], ag[3]);
            *(u32x2*)(GB + m * 512 + c0) = gp;
        }
        ss = red16(ss); brs = red16(brs); krs = red16(krs); rkbs = red16(rkbs);
        const float inv = 1.f / fmaxf(sqrtf(ss), 1e-12f);
        unsigned char* rec = SI + ((m * 8 + h) * 64) * 12;
#pragma unroll
        for (int n = 0; n < 4; ++n) {
            unsigned dw[12];
#pragma unroll
            for (int j = 0; j < 4; ++j) { const float kk = kkr[4 * n + j] * inv;
                const unsigned kp = cvt_pk_bf16(kk * av[4 * n + j], -kk);
                dw[3 * j] = (lk[4 * n + j] & 0xffffu) | (kp & 0xffff0000u); dw[3 * j + 1] = (kp & 0xffffu) | (lk[4 * n + j] & 0xffff0000u); dw[3 * j + 2] = rvp[4 * n + j]; }
            u32x4* dst = (u32x4*)(rec + (16 * n + 4 * fq) * 12);
            u32x4 s0 = {dw[0], dw[1], dw[2], dw[3]}, s1 = {dw[4], dw[5], dw[6], dw[7]}, s2 = {dw[8], dw[9], dw[10], dw[11]};
            dst[0] = s0; dst[1] = s1; dst[2] = s2;
        }
        if (fq == 0) { f32x4 scv = {brs * inv, krs, rkbs, 0.f}; *(f32x4*)(SC + (m * 8 + h) * 4) = scv; }
    }
    __syncthreads();
}

__device__ __forceinline__ float red_rows(float x) {
    float a0 = x, a1 = x;
    asm volatile("s_nop 1\n\tv_permlane16_swap_b32 %0, %1" : "+v"(a0), "+v"(a1));
    float b0 = a0 + a1, b1 = b0;
    asm volatile("s_nop 1\n\tv_permlane32_swap_b32 %0, %1" : "+v"(b0), "+v"(b1));
    return b0 + b1;
}
constexpr int SC_T = 16, SC_ROW = 1552, SC_BUF = SC_T * SC_ROW;
struct ProdRec { unsigned d0, d1, d2; f32x2 sc; };
__device__ __forceinline__ void prod_load(ProdRec (&P)[4], const unsigned char* sb, const float* scp, int chunk, int pl) {
    const int col = pl & 63;
#pragma unroll
    for (int q = 0; q < 4; ++q) { const size_t t = (size_t)chunk * SC_T + (pl >> 6) + 4 * q;
        const unsigned* p = (const unsigned*)(sb + t * 6144 + col * 12); P[q].d0 = p[0]; P[q].d1 = p[1]; P[q].d2 = p[2];
        P[q].sc = (f32x2){0.f, 0.f}; if (col == 0) P[q].sc = *(const f32x2*)(scp + t * 32); }
}
__device__ __forceinline__ void prod_store(const ProdRec (&P)[4], unsigned char* buf, int pl) {
    const int col = pl & 63;
#pragma unroll
    for (int q = 0; q < 4; ++q) { unsigned char* base = buf + ((pl >> 6) + 4 * q) * SC_ROW + col * 4;
        const float w = __builtin_amdgcn_exp2f(bf_lo(P[q].d0));
        *(float*)(base) = bf_hi(P[q].d0); *(float*)(base + 256) = w * bf_lo(P[q].d2); *(float*)(base + 512) = w;
        *(float*)(base + 768) = bf_lo(P[q].d1); *(float*)(base + 1024) = bf_hi(P[q].d1); *(float*)(base + 1280) = bf_hi(P[q].d2);
        if (col == 0) *(f32x2*)(base + 1536) = P[q].sc; }
}
#define MK_SWAP32(a, b) asm volatile("s_nop 1\n\tv_permlane32_swap_b32 %0, %1" : "+v"(a), "+v"(b))
#define MK_SWAP16(a, b) asm volatile("s_nop 1\n\tv_permlane16_swap_b32 %0, %1" : "+v"(a), "+v"(b))
__device__ __forceinline__ void red4x8(float& A, float& B, float& C, float& D) {
    MK_SWAP32(A, B); float u = A + B;
    MK_SWAP32(C, D); float w = C + D;
    MK_SWAP16(u, w); float z = u + w;
    float z1;
    asm volatile("s_nop 1\n\tv_add_f32_dpp %0, %1, %1 row_ror:8 row_mask:0xf bank_mask:0xf" : "=&v"(z1) : "v"(z));
    float p = z1, q = z1; MK_SWAP32(p, q);
    float p2 = p; MK_SWAP16(p, p2);
    float q2 = q; MK_SWAP16(q, q2);
    A = p; C = p2; B = q; D = q2;
}
__device__ __forceinline__ void scan_consume(f32x2 (&S)[8], const unsigned char* buf, unsigned* yr, int lane, int rb) {
    const unsigned co = (unsigned)(lane >> 3) * 32u, vo = 1280u + (unsigned)(16 * rb + (lane & 7)) * 4u;
#pragma unroll 2
    for (int st = 0; st < SC_T; ++st) {
        const unsigned char* sb = buf + st * SC_ROW;
        f32x4 n4[2], r4[2], w4[2], a4[2], k4[2];
#pragma unroll
        for (int q = 0; q < 2; ++q) { n4[q] = *(const f32x4*)(sb + co + 16 * q); r4[q] = *(const f32x4*)(sb + 256 + co + 16 * q); w4[q] = *(const f32x4*)(sb + 512 + co + 16 * q);
            a4[q] = *(const f32x4*)(sb + 768 + co + 16 * q); k4[q] = *(const f32x4*)(sb + 1024 + co + 16 * q); }
        const float v0 = *(const float*)(sb + vo), v1 = *(const float*)(sb + vo + 32); const f32x2 bk = *(const f32x2*)(sb + 1536);
        f32x2 sa0v = {0.f, 0.f}, sa1v = sa0v, yp0v = sa0v, yp1v = sa0v;
#pragma unroll
        for (int p = 0; p < 4; ++p) { const f32x2 nn = {n4[p >> 1][2 * (p & 1)], n4[p >> 1][2 * (p & 1) + 1]}, rr2 = {r4[p >> 1][2 * (p & 1)], r4[p >> 1][2 * (p & 1) + 1]};
            sa0v += S[p] * nn; sa1v += S[4 + p] * nn; yp0v += S[p] * rr2; yp1v += S[4 + p] * rr2; }
        float sa0 = sa0v[0] + sa0v[1], sa1 = sa1v[0] + sa1v[1], yp0 = yp0v[0] + yp0v[1], yp1 = yp1v[0] + yp1v[1];
        red4x8(sa0, sa1, yp0, yp1);
        const f32x2 s0 = {sa0, sa0}, s1 = {sa1, sa1}, vv0 = {v0, v0}, vv1 = {v1, v1};
#pragma unroll
        for (int p = 0; p < 4; ++p) { const f32x2 ww = {w4[p >> 1][2 * (p & 1)], w4[p >> 1][2 * (p & 1) + 1]}, aa = {a4[p >> 1][2 * (p & 1)], a4[p >> 1][2 * (p & 1) + 1]}, kk = {k4[p >> 1][2 * (p & 1)], k4[p >> 1][2 * (p & 1) + 1]};
            S[p] = S[p] * ww + aa * s0 + kk * vv0; S[4 + p] = S[4 + p] * ww + aa * s1 + kk * vv1; }
        const float y0 = yp0 + sa0 * bk[0] + v0 * bk[1], y1 = yp1 + sa1 * bk[0] + v1 * bk[1];
        if (lane < 16) { const bool hi = (lane & 8) != 0;
            yr[(size_t)st * 512 + lane] = (unsigned)bf1(hi ? y1 : y0) | (__float_as_uint(hi ? v1 : v0) & 0xffff0000u); }
    }
}

__device__ __forceinline__ void rwpost_local(const Args& a, int bh, int tid) {
    const float* SC = (const float*)(a.ws + O_SC);
    const unsigned* YR = (const unsigned*)(a.ws + O_YR); const bf16_t* GB = (const bf16_t*)(a.ws + O_G); bf16_t* ORW = (bf16_t*)(a.ws + O_ORW);
    const int b = bh >> 3, h = bh & 7, c = 64 * h + (tid & 15) * 4;
    const f32x4 lwv = *(const f32x4*)(a.in[13] + c), lbv = *(const f32x4*)(a.in[14] + c);
    for (int t0 = tid >> 4; t0 < SEQ; t0 += 64) {
        u32x4 yv[2]; u32x2 gb[2]; float rkb[2]; size_t mm[2];
#pragma unroll
        for (int u = 0; u < 2; ++u) { const size_t m = (size_t)b * SEQ + t0 + 32 * u; mm[u] = m;
            yv[u] = *(const u32x4*)(YR + m * 512 + c); gb[u] = *(const u32x2*)(GB + m * 512 + c); rkb[u] = SC[(m * 8 + h) * 4 + 2]; }
#pragma unroll
        for (int u = 0; u < 2; ++u) {
            float y[4] = {bf_lo(yv[u].x), bf_lo(yv[u].y), bf_lo(yv[u].z), bf_lo(yv[u].w)};
            const float v[4] = {bf_hi(yv[u].x), bf_hi(yv[u].y), bf_hi(yv[u].z), bf_hi(yv[u].w)};
            float s = (y[0] + y[1]) + (y[2] + y[3]);
#pragma unroll
            for (int o = 1; o < 16; o <<= 1) s += __shfl_xor(s, o);
            const float mean = s * (1.f / 64.f);
            float q = 0.f;
#pragma unroll
            for (int j = 0; j < 4; ++j) { y[j] -= mean; q += y[j] * y[j]; }
#pragma unroll
            for (int o = 1; o < 16; o <<= 1) q += __shfl_xor(q, o);
            const float rstd = rsqrtf(q * (1.f / 64.f) + GN_EPS);
            const float g4[4] = {bf_lo(gb[u].x), bf_hi(gb[u].x), bf_lo(gb[u].y), bf_hi(gb[u].y)};
            float o4[4];
#pragma unroll
            for (int j = 0; j < 4; ++j) o4[j] = (y[j] * rstd * lwv[j] + lbv[j] + rkb[u] * v[j]) * g4[j];
            u32x2 ob; ob.x = cvt_pk_bf16(o4[0], o4[1]); ob.y = cvt_pk_bf16(o4[2], o4[3]);
            *(u32x2*)(ORW + mm[u] * 512 + c) = ob;
        }
    }
}

struct KV { bf16x8 k[4]; bf16x8 v[2][2]; };
__device__ __forceinline__ void attn_load(KV& T, const bf16_t* Kh, const bf16_t* Vh, int k0, int n, int hf) {
    const bf16_t* kp = Kh + (size_t)(k0 + n) * 512 + 8 * hf;
#pragma unroll
    for (int s = 0; s < 4; ++s) T.k[s] = *(const bf16x8*)(kp + 16 * s);
#pragma unroll
    for (int d = 0; d < 2; ++d)
#pragma unroll
        for (int sg = 0; sg < 2; ++sg) { const bf16_t* vp = Vh + (size_t)(32 * d + n) * SEQ + k0 + 16 * sg + 4 * hf;
            const u32x2 lo = *(const u32x2*)vp, hi = *(const u32x2*)(vp + 8); u32x4 t = {lo.x, lo.y, hi.x, hi.y}; T.v[d][sg] = __builtin_bit_cast(bf16x8, t); }
}
__device__ __forceinline__ void attn_wave(const Args& a, int bh, int w4, int lane) {
    const int b = bh >> 3, h = bh & 7, n = lane & 31, hf = lane >> 5;
    const size_t m0 = (size_t)b * SEQ;
    const bf16_t* Qh = (const bf16_t*)(a.ws + O_Q) + m0 * 512 + 64 * h;
    const bf16_t* Kh = (const bf16_t*)(a.ws + O_K) + m0 * 512 + 64 * h;
    const bf16_t* Vh = (const bf16_t*)(a.ws + O_VT) + (size_t)bh * 64 * SEQ;
    bf16_t* Oh = (bf16_t*)(a.ws + O_OSB) + m0 * 512 + 64 * h;
    for (int qt = 63 - w4; qt >= 0; qt -= 8) {
        const int q0 = 32 * qt;
        bf16x8 qf[4];
#pragma unroll
        for (int s = 0; s < 4; ++s) qf[s] = *(const bf16x8*)(Qh + (size_t)(q0 + n) * 512 + 16 * s + 8 * hf);
        f32x16 o0, o1;
#pragma unroll
        for (int i = 0; i < 16; ++i) { o0[i] = 0.f; o1[i] = 0.f; }
        float carry = 0.f;
        KV cur, nxt;
        attn_load(cur, Kh, Vh, q0, n, hf);
        for (int kt = qt; kt >= 0; --kt) {
            const int ktn = kt > 0 ? kt - 1 : 0;
            attn_load(nxt, Kh, Vh, 32 * ktn, n, hf);
            f32x16 sc;
#pragma unroll
            for (int i = 0; i < 16; ++i) sc[i] = 0.f;
#pragma unroll
            for (int s = 0; s < 4; ++s) sc = __builtin_amdgcn_mfma_f32_32x32x16_bf16(cur.k[s], qf[s], sc, 0, 0, 0);
            const bool diag = (kt == qt);
            float lf[16], G4[4];
#pragma unroll
            for (int g = 0; g < 4; ++g) { G4[g] = 0.f;
#pragma unroll
                for (int i = 0; i < 4; ++i) { const int r = 4 * g + i; const float z = sc[r];
                    const bool valid = !diag || (8 * g + 4 * hf + i < n);
                    const float e = fexp(-fabsf(z));
                    const float sp = fmaxf(z, 0.f) + flog(1.f + e);
                    lf[r] = valid ? -sp : 0.f; G4[g] += lf[r]; } }
            float PG[4], T4[4];
#pragma unroll
            for (int g = 0; g < 4; ++g) { PG[g] = __shfl_xor(G4[g], 32); T4[g] = G4[g] + PG[g]; }
            const float tail3 = 0.f, tail2 = T4[3], tail1 = T4[3] + T4[2], tail0 = tail1 + T4[1], total = tail0 + T4[0];
            const float tails[4] = {tail0, tail1, tail2, tail3};
            f32x16 wv;
#pragma unroll
            for (int g = 0; g < 4; ++g) {
                float af = carry + tails[g] + (hf == 0 ? PG[g] : 0.f);
#pragma unroll
                for (int i = 3; i >= 0; --i) { const int r = 4 * g + i; const float z = sc[r];
                    const bool valid = !diag || (8 * g + 4 * hf + i < n);
                    const float wgt = fexp(lf[r] + z + af);
                    wv[r] = valid ? wgt : 0.f;
                    af += lf[r]; } }
            carry += total;
            bf16x8 wf[2];
#pragma unroll
            for (int sg = 0; sg < 2; ++sg) { u32x4 t; t.x = cvt_pk_bf16(wv[8 * sg + 0], wv[8 * sg + 1]); t.y = cvt_pk_bf16(wv[8 * sg + 2], wv[8 * sg + 3]); t.z = cvt_pk_bf16(wv[8 * sg + 4], wv[8 * sg + 5]); t.w = cvt_pk_bf16(wv[8 * sg + 6], wv[8 * sg + 7]); wf[sg] = __builtin_bit_cast(bf16x8, t); }
#pragma unroll
            for (int sg = 0; sg < 2; ++sg) { o0 = __builtin_amdgcn_mfma_f32_32x32x16_bf16(cur.v[0][sg], wf[sg], o0, 0, 0, 0); o1 = __builtin_amdgcn_mfma_f32_32x32x16_bf16(cur.v[1][sg], wf[sg], o1, 0, 0, 0); }
            cur = nxt;
#if MK_EARLY_EXIT
            if (__all(carry < -104.f)) break;
#endif
        }
        bf16_t* op = Oh + (size_t)(q0 + n) * 512 + 4 * hf;
#pragma unroll
        for (int g = 0; g < 4; ++g) {
            u32x2 t0, t1; t0.x = cvt_pk_bf16(o0[4 * g], o0[4 * g + 1]); t0.y = cvt_pk_bf16(o0[4 * g + 2], o0[4 * g + 3]); t1.x = cvt_pk_bf16(o1[4 * g], o1[4 * g + 1]); t1.y = cvt_pk_bf16(o1[4 * g + 2], o1[4 * g + 3]);
            *(u32x2*)(op + 8 * g) = t0; *(u32x2*)(op + 32 + 8 * g) = t1; }
    }
}
__device__ __forceinline__ void phase_mixer(const Args& a, unsigned char* lds, int G) {
    const int tid = my_tid(); const int wave = __builtin_amdgcn_readfirstlane(tid >> 6), lane = tid & 63;
    for (int bh = blockIdx.x; bh < NB * NH; bh += G) {
        const int b = bh >> 3, h = bh & 7; const size_t m0 = (size_t)b * SEQ;
        const unsigned char* sb = a.ws + O_SI + (m0 * 8 + h) * 768; const float* scp = (const float*)(a.ws + O_SC) + (m0 * 8 + h) * 4;
        unsigned* yrb = (unsigned*)(a.ws + O_YR) + m0 * 512 + 64 * h + 16 * (wave & 3);
        const int pl = tid - 256;
        constexpr int NCH = SEQ / SC_T;
        ProdRec pr[4]; f32x2 S[8];
#pragma unroll
        for (int p = 0; p < 8; ++p) S[p] = (f32x2){0.f, 0.f};
        __syncthreads();
        if (wave >= 4) { prod_load(pr, sb, scp, 0, pl); prod_store(pr, lds, pl); prod_load(pr, sb, scp, 1, pl); }
        __syncthreads();
        for (int ci = 0; ci < NCH; ++ci) {
            if (wave < 4) scan_consume(S, lds + (ci & 1) * SC_BUF, yrb + (size_t)ci * SC_T * 512, lane, wave);
            else if (ci + 1 < NCH) { prod_store(pr, lds + ((ci + 1) & 1) * SC_BUF, pl); prod_load(pr, sb, scp, ci + 2 < NCH ? ci + 2 : ci + 1, pl); }
            __syncthreads();
        }
        attn_wave(a, bh, wave, lane);
        __threadfence_block(); __syncthreads();
        rwpost_local(a, bh, my_tid());
    }
}

template <int MODE> __device__ __forceinline__ void phase_rows(const Args& a, int G) {
    const int tid = my_tid(); const int wave = tid >> 6, lane = tid & 63;
    const int gw = blockIdx.x * 8 + wave, NGW = G * 8;
    const bf16_t* T = (const bf16_t*)(a.ws + (MODE == 0 ? O_TT : O_FF));
    const float* xin = MODE == 0 ? a.in[0] : a.out; const float* g1 = MODE == 0 ? a.in[18] : a.in[23]; const float* g2 = a.in[19];
    bf16_t* H2 = (bf16_t*)(a.ws + O_H2);
    f32x4 g1v[4], g2v[4];
#pragma unroll
    for (int j = 0; j < 4; ++j) { g1v[j] = ((const f32x4*)g1)[lane + 64 * j]; g2v[j] = ((const f32x4*)g2)[lane + 64 * j]; }
    for (int row0 = gw; row0 < M; row0 += 2 * NGW) {
        u32x2 tb[2][4]; f32x4 x[2][4];
#pragma unroll
        for (int u = 0; u < 2; ++u) { const int row = (row0 + u * NGW < M) ? row0 + u * NGW : row0;
            const u32x2* tr = (const u32x2*)(T + (size_t)row * D) + lane; const f32x4* xr = (const f32x4*)(xin + (size_t)row * D) + lane;
#pragma unroll
            for (int j = 0; j < 4; ++j) { tb[u][j] = tr[64 * j]; x[u][j] = xr[64 * j]; } }
#pragma unroll
        for (int u = 0; u < 2; ++u) {
            const int row = row0 + u * NGW;
            f32x4 t[4]; float s = 0.f;
#pragma unroll
            for (int j = 0; j < 4; ++j) { t[j][0] = bf_lo(tb[u][j].x); t[j][1] = bf_hi(tb[u][j].x); t[j][2] = bf_lo(tb[u][j].y); t[j][3] = bf_hi(tb[u][j].y);
                s += (t[j][0] * t[j][0] + t[j][1] * t[j][1]) + (t[j][2] * t[j][2] + t[j][3] * t[j][3]); }
            const float rs = rsqrtf(wave_sum(s) * (1.f / D) + RMS_EPS);
            float s2 = 0.f;
#pragma unroll
            for (int j = 0; j < 4; ++j)
#pragma unroll
                for (int e = 0; e < 4; ++e) { x[u][j][e] += t[j][e] * rs * g1v[j][e]; s2 += x[u][j][e] * x[u][j][e]; }
            float rs2 = 0.f;
            if (MODE == 0) rs2 = rsqrtf(wave_sum(s2) * (1.f / D) + RMS_EPS);
            if (row < M) {
                f32x4* orow = (f32x4*)(a.out + (size_t)row * D) + lane;
#pragma unroll
                for (int j = 0; j < 4; ++j) orow[64 * j] = x[u][j];
                if (MODE == 0) {
                    u32x2* o = (u32x2*)(H2 + (size_t)row * D) + lane;
#pragma unroll
                    for (int j = 0; j < 4; ++j) { u32x2 w; w.x = cvt_pk_bf16(x[u][j][0] * rs2 * g2v[j][0], x[u][j][1] * rs2 * g2v[j][1]); w.y = cvt_pk_bf16(x[u][j][2] * rs2 * g2v[j][2], x[u][j][3] * rs2 * g2v[j][3]); o[64 * j] = w; }
                }
            }
        }
    }
}

#define XB_TMO      128
#define XB_XCNT(j)  (256  + 64 * (j))
#define XB_XSUB(j)  (1280 + 64 * (j))
#define XB_XGEN(j)  (2304 + 64 * (j))
#define XB_TOP      3328
#define XB_TOPGEN   3392
#define XCD_BAR_WORDS 3456
#define XB_SPIN_CAP (1u << 18)

__device__ __forceinline__ unsigned xb_ld(unsigned* p)              { return __hip_atomic_load(p, __ATOMIC_RELAXED, __HIP_MEMORY_SCOPE_AGENT); }
__device__ __forceinline__ unsigned xb_add(unsigned* p, unsigned v) { return __hip_atomic_fetch_add(p, v, __ATOMIC_RELAXED, __HIP_MEMORY_SCOPE_AGENT); }
__device__ __forceinline__ unsigned xb_xcc_id() { return (unsigned)__builtin_amdgcn_s_getreg((3 << 11) | 20) & 0xFu; }
#define XB_SPIN(cond, bar) do { unsigned _sp = 0; while (cond) { __builtin_amdgcn_s_sleep(1); \
    if ((++_sp & 255u) == 0u) { if (xb_ld(&(bar)[XB_TMO])) break; if (_sp > XB_SPIN_CAP) { atomicAdd(&(bar)[XB_TMO], 1u); break; } } } } while (0)

struct XcdBarrier {
    unsigned* bar; unsigned x;
    volatile __attribute__((address_space(3))) unsigned* st;
};

__device__ __forceinline__ XcdBarrier xcd_barrier_post(unsigned* bar, volatile __attribute__((address_space(3))) unsigned* st) {
    XcdBarrier b; b.bar = bar; b.x = xb_xcc_id(); b.st = st;
    if (threadIdx.x == 0) (void)xb_add(&bar[XB_XCNT(b.x)], 1u);
    return b;
}
__device__ __forceinline__ void xcd_barrier_complete(unsigned* bar, unsigned x, unsigned& nloc, unsigned& nx) {
    const unsigned G = gridDim.x * gridDim.y * gridDim.z;
    unsigned sum, cnt, mine, sp = 0u;
    for (;;) {
        sum = 0u; cnt = 0u; mine = 0u;
#pragma unroll
        for (unsigned j = 0; j < 16; ++j) { const unsigned c = xb_ld(&bar[XB_XCNT(j)]); sum += c; cnt += (c > 0u) ? 1u : 0u; mine = (j == x) ? c : mine; }
        if (sum == G) break;
        __builtin_amdgcn_s_sleep(1);
        if ((++sp & 255u) == 0u) { if (xb_ld(&bar[XB_TMO])) break; if (sp > XB_SPIN_CAP) { atomicAdd(&bar[XB_TMO], 1u); break; } }
    }
    nloc = mine > 0u ? mine : 1u; nx = cnt > 0u ? cnt : 1u;
}

__device__ __forceinline__ void xcd_barrier(const XcdBarrier& b) {
    asm volatile("s_waitcnt vmcnt(0)" ::: "memory");
    __syncthreads();
    if (threadIdx.x == 0) {
        unsigned* bar = b.bar;
        __builtin_amdgcn_s_waitcnt(0);
        unsigned nloc = b.st[0], nx = b.st[1];
        if (nloc == 0u) { xcd_barrier_complete(bar, b.x, nloc, nx); b.st[0] = nloc; b.st[1] = nx; }
        const unsigned old = xb_add(&bar[XB_XSUB(b.x)], 1u);
        const unsigned gen = old / nloc;
        if (old + 1u == (gen + 1u) * nloc) {
            __builtin_amdgcn_fence(__ATOMIC_RELEASE, "agent");
            asm volatile("s_waitcnt vmcnt(0)" ::: "memory");
            const unsigned og = xb_add(&bar[XB_TOP], 1u);
            const unsigned tg = og / nx;
            if (og + 1u == (tg + 1u) * nx) xb_add(&bar[XB_TOPGEN], 1u);
            else XB_SPIN(xb_ld(&bar[XB_TOPGEN]) == tg, bar);
            __builtin_amdgcn_fence(__ATOMIC_ACQUIRE, "agent");
            xb_add(&bar[XB_XGEN(b.x)], 1u);
            asm volatile("s_waitcnt vmcnt(0)" ::: "memory");
        } else {
            XB_SPIN(xb_ld(&bar[XB_XGEN(b.x)]) == gen, bar);
            __builtin_amdgcn_fence(__ATOMIC_ACQUIRE, "agent");
            asm volatile("s_waitcnt vmcnt(0)" ::: "memory");
        }
    }
    __syncthreads();
}

__global__ void __launch_bounds__(512, 2) mega(Args a) {
    extern __shared__ __attribute__((aligned(16))) unsigned char shm[];
    PG8_LAS unsigned char* lds = (PG8_LAS unsigned char*)shm;
    const int G = (int)gridDim.x;
    unsigned char* ws = a.ws;
    volatile __attribute__((address_space(3))) unsigned* bst = (volatile __attribute__((address_space(3))) unsigned*)(lds + pg8::STAGE_BYTES);
    if (threadIdx.x == 0) { bst[0] = 0u; bst[1] = 0u; }
    __syncthreads();
    const XcdBarrier bar = xcd_barrier_post((unsigned*)(ws + O_CTL), bst);
    phase_prep(a, (float*)shm, G);
    cg::this_grid().sync();
    { Epi1 E; E.Q = (bf16_t*)(ws + O_Q); E.Kb = (bf16_t*)(ws + O_K); E.Vt = (bf16_t*)(ws + O_VT); E.Prw = (bf16_t*)(ws + O_PRW); E.Gt = (bf16_t*)a.out; E.bgate = a.in[3];
      run_gemm(lds, (const bf16_t*)(ws + O_H), (const bf16_t*)(ws + O_WIN), INC, 1024, E, G); }
    xcd_barrier(bar);
    phase_rwprep(a, shm, G);
    xcd_barrier(bar);
    phase_mixer(a, shm, G);
    xcd_barrier(bar);
    { EpiRow<1> E; E.O = (bf16_t*)(ws + O_T1); E.T1 = nullptr; E.Gt = (const bf16_t*)a.out;
      run_gemm(lds, (const bf16_t*)(ws + O_OSB), (const bf16_t*)(ws + O_WSB), 1024, 512, E, G); }
    { EpiRow<2> E; E.O = (bf16_t*)(ws + O_MRG); E.T1 = (const bf16_t*)(ws + O_T1); E.Gt = (const bf16_t*)a.out;
      run_gemm(lds, (const bf16_t*)(ws + O_ORW), (const bf16_t*)(ws + O_WRW), 1024, 512, E, G); }
    xcd_barrier(bar);
    { EpiRow<0> E; E.O = (bf16_t*)(ws + O_TT); E.T1 = nullptr; E.Gt = nullptr;
      run_gemm(lds, (const bf16_t*)(ws + O_MRG), (const bf16_t*)(ws + O_WO), 1024, 1024, E, G); }
    xcd_barrier(bar);
    phase_rows<0>(a, G);
    xcd_barrier(bar);
    { EpiSwiGLU E; E.Hd = (bf16_t*)(ws + O_HID);
      run_gemm(lds, (const bf16_t*)(ws + O_H2), (const bf16_t*)(ws + O_WGU), 2 * DFF, 1024, E, G); }
    xcd_barrier(bar);
    { EpiRow<0> E; E.O = (bf16_t*)(ws + O_FF); E.T1 = nullptr; E.Gt = nullptr;
      run_gemm(lds, (const bf16_t*)(ws + O_HID), (const bf16_t*)(ws + O_WDN), 1024, DFF, E, G); }
    xcd_barrier(bar);
    phase_rows<1>(a, G);
}
}

extern "C" void kernel_launch(void* const* d_in, const int* in_sizes, int n_in, void* d_out, int out_size, void* d_ws, size_t ws_size, hipStream_t stream) {
    static int grid = 0;
    if (grid == 0) {
        if (n_in != 24 || in_sizes[0] != mk::M * mk::D || out_size != mk::M * mk::D || ws_size < mk::WS_NEED) {
            fprintf(stderr, "kernel_launch: unexpected shapes: n_in %d in0 %d out %d ws %zu (need %zu)\n", n_in, n_in > 0 ? in_sizes[0] : -1, out_size, ws_size, (size_t)mk::WS_NEED); grid = -1; return; }
        int dev = 0, cus = 0, per_cu = 0;
        hipGetDevice(&dev); hipDeviceGetAttribute(&cus, hipDeviceAttributeMultiprocessorCount, dev);
        if (hipFuncSetAttribute((const void*)mk::mega, hipFuncAttributeMaxDynamicSharedMemorySize, mk::LDS_BYTES) != hipSuccess) { fprintf(stderr, "kernel_launch: hipFuncSetAttribute failed\n"); grid = -1; return; }
        if (hipOccupancyMaxActiveBlocksPerMultiprocessor(&per_cu, (const void*)mk::mega, 512, mk::LDS_BYTES) != hipSuccess || per_cu < 1) { fprintf(stderr, "kernel_launch: occupancy query failed (%d)\n", per_cu); per_cu = 1; }
        (void)hipGetLastError();
        grid = cus * per_cu;
        fprintf(stderr, "kernel_launch: grid %d (cus %d x %d)\n", grid, cus, per_cu);
    }
    if (grid < 0) return;
    mk::Args a{};
    for (int i = 0; i < 24; ++i) a.in[i] = (const float*)d_in[i];
    a.out = (float*)d_out; a.ws = (unsigned char*)d_ws;
    a.ph_lo = 0; a.ph_hi = mk::NPH;
    if (hipMemsetAsync((char*)d_ws + mk::O_CTL, 0, mk::CTL_BYTES, stream) != hipSuccess) { fprintf(stderr, "kernel_launch: hipMemsetAsync failed\n"); return; }
    void* args[] = {&a};
    hipError_t e = hipLaunchCooperativeKernel((const void*)mk::mega, dim3(grid), dim3(512), args, mk::LDS_BYTES, stream);
    if (e != hipSuccess) fprintf(stderr, "kernel_launch: cooperative launch failed: %s (grid %d)\n", hipGetErrorString(e), grid);
}
```

```cpp
#include <hip/hip_runtime.h>
#include <hip/hip_cooperative_groups.h>
#include <cstdio>
#include <cstdint>
namespace cg = cooperative_groups;
#ifndef MK_SPLIT
#define MK_SPLIT 0
#endif
#ifndef MK_DIAG
#define MK_DIAG 0
#endif
#ifndef MK_REPMASK
#define MK_REPMASK 0
#endif
#ifndef MK_EARLY_EXIT
#define MK_EARLY_EXIT 1
#endif
namespace pg8 {
#define PG8_LAS __attribute__((address_space(3)))
typedef unsigned short bf16_t;
typedef short bf16x8 __attribute__((ext_vector_type(8)));
typedef float f32x4 __attribute__((ext_vector_type(4)));
typedef unsigned u32x4 __attribute__((ext_vector_type(4)));
constexpr int BM = 256, BK = 64, HALF = 128, HTB = HALF * BK * 2  , STAGE_BYTES = 8 * HTB, NXCD = 8, WGM = 8;

__host__ __device__ __forceinline__ int lds_byte(int r, int c) { const int st = (r >> 4) * 2 + (c >> 5), rr = r & 15, cc = c & 31, ob = rr * 64 + cc * 2; return st * 1024 + (ob ^ (((ob >> 9) & 1) << 5)); }
__host__ __device__ __forceinline__ void stage_rc(int b, int& R, int& C) { const int st = b / 1024, sb = b % 1024, swz = sb ^ (((sb >> 9) & 1) << 5); R = (st >> 1) * 16 + swz / 64; C = (st & 1) * 32 + (swz % 64) / 2; }
__host__ __device__ __forceinline__ int perm32(int rho) { const int n = rho >> 4, i = rho & 15; return 8 * (i >> 2) + 4 * n + (i & 3); }

struct Unit { int pm, pn; };
struct Gemm { const bf16_t* A; const bf16_t* Bt; int M, N, K; };

struct StaticOrder {
    int nM, nN, nwg, G, c;
    __host__ __device__ void init(int M, int N, int G_, int c_) { nM = M / BM; nN = N / BM; nwg = nM * nN; G = G_; c = c_; }
    __host__ __device__ bool next(int i, Unit& u) const {
        const long L = (long)i * G + c; if (L >= nwg) return false;
        int wgid = (int)L; { const int q = nwg / NXCD, r = nwg % NXCD, xcd = wgid % NXCD, off = wgid / NXCD; wgid = (xcd < r ? xcd * (q + 1) : r * (q + 1) + (xcd - r) * q) + off; }
        const int nig = WGM * nN, gid = wgid / nig, fm = gid * WGM, gsz = (nM - fm) < WGM ? (nM - fm) : WGM;
        u.pm = fm + ((wgid % nig) % gsz); u.pn = (wgid % nig) / gsz; return true;
    }
    __device__ __forceinline__ void a_ready(const Unit&) const {}
    __device__ __forceinline__ void done(const Unit&) const {}
};

__device__ __forceinline__ unsigned cvt_pk_bf16(float lo, float hi) { unsigned r; asm volatile("v_cvt_pk_bf16_f32 %0, %1, %2" : "=v"(r) : "v"(lo), "v"(hi)); return r; }
typedef float f32x2 __attribute__((ext_vector_type(2)));

template <class Epi, class Sched, bool ALIGN_EPI = false, bool SP2 = false>
__device__ __forceinline__ void gemm_phase(PG8_LAS unsigned char* lds, const Gemm g, const Sched& S, const Epi& E) {
    int tid_ = threadIdx.x; asm volatile("" : "+v"(tid_)); const int tid = tid_, wid = __builtin_amdgcn_readfirstlane(tid >> 6), lane = tid & 63, wr = wid >> 2, wc = wid & 3, fr = lane & 15, fq = lane >> 4;
    const int K = g.K, nt = K / BK;
    unsigned voffA[2], voffB[2];
#pragma unroll
    for (int i = 0; i < 2; ++i) { int R, C; stage_rc(tid * 16 + i * 8192, R, C); const int Rb = Epi::PERM ? ((R & ~31) + perm32(R & 31)) : R;
        voffA[i] = (unsigned)(R * K + C) * 2u; voffB[i] = (unsigned)(Rb * K + C) * 2u; }
    const size_t kstep = (size_t)(BK * 2);
    const size_t hstep = (size_t)HALF * K * 2;
    const size_t tstep = 2 * hstep;
    const unsigned ldsw = (unsigned)wid * 1024u;
    const int aoff = lds_byte(wr * 64 + fr, fq * 8), boff = lds_byte(wc * 32 + fr, fq * 8);
#define PG8_SA(b, h) (((b) * 2 + (h)) * HTB)
#define PG8_SB(b, h) ((4 + (b) * 2 + (h)) * HTB)
#define PG8_STAGE(bufoff, gbase, voff) do { _Pragma("unroll") for (int _i = 0; _i < 2; ++_i) \
        __builtin_amdgcn_global_load_lds((const unsigned*)((const char*)(gbase) + (voff)[_i]), (PG8_LAS unsigned*)(lds + (bufoff) + ldsw + _i * 8192), 16, 0, 0); } while (0)
#define PG8_LDA(dst, b, h) do { _Pragma("unroll") for (int m = 0; m < 4; ++m) _Pragma("unroll") for (int k = 0; k < 2; ++k) dst[m][k] = *(const PG8_LAS bf16x8*)(lds + PG8_SA(b, h) + aoff + m * 2048 + k * 1024); } while (0)
#define PG8_LDB(dst, b, h) do { _Pragma("unroll") for (int n = 0; n < 2; ++n) _Pragma("unroll") for (int k = 0; k < 2; ++k) dst[n][k] = *(const PG8_LAS bf16x8*)(lds + PG8_SB(b, h) + boff + n * 2048 + k * 1024); } while (0)
#define PG8_MMA(ai, bj, At, Bt) do { __builtin_amdgcn_s_setprio(1); _Pragma("unroll") for (int m = 0; m < 4; ++m) _Pragma("unroll") for (int n = 0; n < 2; ++n) _Pragma("unroll") for (int k = 0; k < 2; ++k) \
        acc[ai][bj][m][n] = __builtin_amdgcn_mfma_f32_16x16x32_bf16(Bt[n][k], At[m][k], acc[ai][bj][m][n], 0, 0, 0); __builtin_amdgcn_s_setprio(0); } while (0)
#define PG8_WAIT_V(n) asm volatile("s_waitcnt vmcnt(" #n ")" ::: "memory")
#define PG8_WAIT_L(n) asm volatile("s_waitcnt lgkmcnt(" #n ")" ::: "memory")
#define PG8_BAR __builtin_amdgcn_s_barrier()
#define PG8_SCHED __builtin_amdgcn_sched_barrier(0)
    Unit cur, nxt; int ui = 0;
    if (!S.next(0, cur)) return;
    f32x4 acc[2][2][4][2];
#pragma unroll
    for (int a = 0; a < 2; ++a)
#pragma unroll
        for (int b = 0; b < 2; ++b)
#pragma unroll
            for (int m = 0; m < 4; ++m)
#pragma unroll
                for (int n = 0; n < 2; ++n) acc[a][b][m][n] = (f32x4){0.f, 0.f, 0.f, 0.f};
    bf16x8 At[4][2], B0[2][2], B1[2][2];
    const char* cA = (const char*)g.A + (size_t)cur.pm * tstep; const char* cB = (const char*)g.Bt + (size_t)cur.pn * tstep;
    S.a_ready(cur);
    if constexpr (SP2) {
        PG8_STAGE(PG8_SB(0, 0), cB, voffB); PG8_STAGE(PG8_SB(0, 1), cB + hstep, voffB); PG8_STAGE(PG8_SA(0, 0), cA, voffA); PG8_STAGE(PG8_SA(0, 1), cA + hstep, voffA);
        if (wr == 1) PG8_BAR;
        PG8_WAIT_V(2); PG8_BAR;
        PG8_STAGE(PG8_SB(1, 0), cB + kstep, voffB); PG8_STAGE(PG8_SA(1, 0), cA + kstep, voffA); PG8_STAGE(PG8_SB(1, 1), cB + hstep + kstep, voffB);
        PG8_WAIT_V(6); PG8_BAR;
    } else {
        PG8_STAGE(PG8_SB(0, 0), cB, voffB); PG8_STAGE(PG8_SA(0, 0), cA, voffA); PG8_STAGE(PG8_SB(0, 1), cB + hstep, voffB); PG8_STAGE(PG8_SA(0, 1), cA + hstep, voffA);
        if (wr == 1) PG8_BAR;
        PG8_WAIT_V(4); PG8_BAR;
        PG8_STAGE(PG8_SB(1, 0), cB + kstep, voffB); PG8_STAGE(PG8_SA(1, 0), cA + kstep, voffA); PG8_STAGE(PG8_SB(1, 1), cB + hstep + kstep, voffB);
        PG8_WAIT_V(6); PG8_BAR;
    }
    for (;;) {
        const bool has_next = S.next(ui + 1, nxt);
        const char* nA = has_next ? (const char*)g.A + (size_t)nxt.pm * tstep : cA; const char* nB = has_next ? (const char*)g.Bt + (size_t)nxt.pn * tstep : cB;
        for (int t = 0; t < nt; t += 2) {
            const bool last = (t == nt - 2);
            const char* a1 = cA + (size_t)(t + 1) * kstep;
            const char* a2 = last ? nA : cA + (size_t)(t + 2) * kstep; const char* b2 = last ? nB : cB + (size_t)(t + 2) * kstep;
            const char* a3 = a2 + kstep; const char* b3 = b2 + kstep;
            if (last && has_next) S.a_ready(nxt);
            if constexpr (SP2) {
            PG8_LDB(B0, 0, 0); PG8_LDB(B1, 0, 1); PG8_SCHED; PG8_LDA(At, 0, 0); PG8_STAGE(PG8_SA(1, 1), a1 + hstep, voffA);
            PG8_WAIT_V(8); PG8_WAIT_L(0); PG8_BAR; PG8_MMA(0, 0, At, B0); PG8_MMA(0, 1, At, B1); PG8_BAR; PG8_SCHED;
            PG8_LDA(At, 0, 1); PG8_STAGE(PG8_SB(0, 0), b2, voffB); PG8_STAGE(PG8_SB(0, 1), b2 + hstep, voffB); PG8_STAGE(PG8_SA(0, 0), a2, voffA);
            PG8_WAIT_V(8); PG8_WAIT_L(0); PG8_BAR; PG8_MMA(1, 0, At, B0); PG8_MMA(1, 1, At, B1); PG8_BAR; PG8_SCHED;
            PG8_LDB(B0, 1, 0); PG8_LDB(B1, 1, 1); PG8_SCHED; PG8_LDA(At, 1, 0); PG8_STAGE(PG8_SA(0, 1), a2 + hstep, voffA);
            PG8_WAIT_V(8); PG8_WAIT_L(0); PG8_BAR; PG8_MMA(0, 0, At, B0); PG8_MMA(0, 1, At, B1); PG8_BAR; PG8_SCHED;
            PG8_LDA(At, 1, 1); PG8_STAGE(PG8_SB(1, 0), b3, voffB); PG8_STAGE(PG8_SB(1, 1), b3 + hstep, voffB); PG8_STAGE(PG8_SA(1, 0), a3, voffA);
            PG8_WAIT_V(8); PG8_WAIT_L(0); PG8_BAR; PG8_MMA(1, 0, At, B0); PG8_MMA(1, 1, At, B1); PG8_BAR; PG8_SCHED;
            } else {
            PG8_LDB(B0, 0, 0); PG8_SCHED; PG8_LDA(At, 0, 0); PG8_STAGE(PG8_SA(1, 1), a1 + hstep, voffA);
            PG8_WAIT_L(8); PG8_BAR; PG8_WAIT_L(0); PG8_MMA(0, 0, At, B0); PG8_BAR; PG8_SCHED;
            PG8_LDB(B1, 0, 1); PG8_STAGE(PG8_SB(0, 0), b2, voffB);
            PG8_BAR; PG8_WAIT_L(0); PG8_MMA(0, 1, At, B1); PG8_BAR;
            PG8_LDA(At, 0, 1); PG8_STAGE(PG8_SA(0, 0), a2, voffA);
            PG8_BAR; PG8_WAIT_L(0); PG8_MMA(1, 0, At, B0); PG8_BAR; PG8_SCHED;
            PG8_STAGE(PG8_SB(0, 1), b2 + hstep, voffB);
            PG8_WAIT_V(6); PG8_BAR; PG8_MMA(1, 1, At, B1); PG8_BAR;
            PG8_LDB(B0, 1, 0); PG8_SCHED; PG8_LDA(At, 1, 0); PG8_STAGE(PG8_SA(0, 1), a2 + hstep, voffA);
            PG8_WAIT_L(8); PG8_BAR; PG8_WAIT_L(0); PG8_MMA(0, 0, At, B0); PG8_BAR; PG8_SCHED;
            PG8_LDB(B1, 1, 1); PG8_STAGE(PG8_SB(1, 0), b3, voffB);
            PG8_BAR; PG8_WAIT_L(0); PG8_MMA(0, 1, At, B1); PG8_BAR;
            PG8_LDA(At, 1, 1); PG8_STAGE(PG8_SA(1, 0), a3, voffA);
            PG8_BAR; PG8_WAIT_L(0); PG8_MMA(1, 0, At, B0); PG8_BAR; PG8_SCHED;
            PG8_STAGE(PG8_SB(1, 1), b3 + hstep, voffB);
            PG8_WAIT_V(6); PG8_BAR; PG8_MMA(1, 1, At, B1); PG8_BAR;
            }
        }
        if constexpr (ALIGN_EPI) { if (wr == 0) PG8_BAR; }
        if constexpr (!Epi::AFTER_DRAIN) { E(acc, cur, wr, wc, fr, fq); S.done(cur); }
        if (!has_next) break;
#pragma unroll
        for (int a = 0; a < 2; ++a)
#pragma unroll
            for (int b = 0; b < 2; ++b)
#pragma unroll
                for (int m = 0; m < 4; ++m)
#pragma unroll
                    for (int n = 0; n < 2; ++n) acc[a][b][m][n] = (f32x4){0.f, 0.f, 0.f, 0.f};
        cur = nxt; cA = nA; cB = nB; ++ui;
        if constexpr (ALIGN_EPI) { if (wr == 1) PG8_BAR; }
    }
    PG8_WAIT_V(0);
    if constexpr (!ALIGN_EPI) { if (wr == 0) PG8_BAR; }
    PG8_BAR;
    if constexpr (Epi::AFTER_DRAIN) { E.fused(acc, cur, wr, wc, fr, fq, lds, wid, lane); S.done(cur); }
#undef PG8_SA
#undef PG8_SB
#undef PG8_STAGE
#undef PG8_LDA
#undef PG8_LDB
#undef PG8_MMA
#undef PG8_WAIT_V
#undef PG8_WAIT_L
#undef PG8_BAR
#undef PG8_SCHED
}

}
namespace mk {
using pg8::bf16_t; using pg8::bf16x8; using pg8::f32x4; using pg8::u32x4; using pg8::cvt_pk_bf16;
typedef float f32x16 __attribute__((ext_vector_type(16)));
typedef float f32x2 __attribute__((ext_vector_type(2)));
typedef unsigned u32x2 __attribute__((ext_vector_type(2)));
constexpr int D = 1024, NB = 32, SEQ = 2048, M = NB * SEQ, NH = 8, DH = 64;
constexpr int RWC = 1792, GC = 2048, INC = 5376, DFF = 2816;
constexpr float RMS_EPS = 1e-6f, GN_EPS = 64e-5f;
constexpr size_t MiB = (size_t)1 << 20;
constexpr size_t O_WIN = 0, O_WSB = 11 * MiB, O_WRW = 12 * MiB, O_WO = 13 * MiB, O_WGU = 15 * MiB, O_WDN = 26 * MiB, O_WLU = 32 * MiB  , O_WLA = O_WLU + 65536, O_WLG = O_WLA + 65536;
constexpr size_t O_Q = 34 * MiB, O_K = 98 * MiB, O_VT = 162 * MiB, O_PRW = 226 * MiB, O_H = 450 * MiB, O_SI = 450 * MiB, O_G = 834 * MiB, O_SC = 898 * MiB, O_YR = 290 * MiB  ;
constexpr size_t O_OSB = 226 * MiB, O_ORW = 34 * MiB, O_T1 = 98 * MiB, O_MRG = 450 * MiB, O_TT = 34 * MiB, O_H2 = 162 * MiB, O_HID = 290 * MiB, O_FF = 34 * MiB;
constexpr size_t WS_NEED = 1009 * MiB;
constexpr int LDS_BYTES = pg8::STAGE_BYTES + 64;
constexpr size_t O_CTL = 1008 * MiB, CTL_BYTES = 65536;
constexpr int NPH = 12;

struct Args { const float* in[24]; float* out; unsigned char* ws; int ph_lo, ph_hi; };

__device__ __forceinline__ int my_tid() { int t = threadIdx.x; asm volatile("" : "+v"(t)); return t; }
__device__ __forceinline__ float bf_lo(unsigned u) { return __uint_as_float(u << 16); }
__device__ __forceinline__ float bf_hi(unsigned u) { return __uint_as_float(u & 0xffff0000u); }
__device__ __forceinline__ float fexp(float x) { return __builtin_amdgcn_exp2f(x * 1.44269504089f); }
__device__ __forceinline__ float flog(float x) { return __builtin_amdgcn_logf(x) * 0.69314718056f; }
__device__ __forceinline__ float frcp(float x) { return __builtin_amdgcn_rcpf(x); }
__device__ __forceinline__ float fsigmoid(float x) { return frcp(1.f + fexp(-x)); }
__device__ __forceinline__ unsigned short bf1(float x) { return (unsigned short)(cvt_pk_bf16(x, x) & 0xffffu); }
__device__ __forceinline__ u32x4 pack8(const f32x4 a, const f32x4 b) { u32x4 o; o.x = cvt_pk_bf16(a[0], a[1]); o.y = cvt_pk_bf16(a[2], a[3]); o.z = cvt_pk_bf16(b[0], b[1]); o.w = cvt_pk_bf16(b[2], b[3]); return o; }
__device__ __forceinline__ float red16(float v) {
    v += __shfl_xor(v, 16); v += __shfl_xor(v, 32); return v;
}
__device__ __forceinline__ float wave_sum(float v) {
#pragma unroll
    for (int o = 1; o < 64; o <<= 1) v += __shfl_xor(v, o);
    return v;
}

__device__ __forceinline__ void tr_item(const float* __restrict__ W, int K, int N, bf16_t* WT, float* scr, int item, int lane, int mode) {
    const int nblk = N >> 5, kb = item / nblk, nb = item - kb * nblk, k0 = kb << 6, n0 = nb << 5;
#pragma unroll 8
    for (int i = 0; i < 32; ++i) { const int kk = 2 * i + (lane >> 5); scr[kk * 33 + (lane & 31)] = W[(size_t)(k0 + kk) * N + n0 + (lane & 31)]; }
    asm volatile("s_waitcnt lgkmcnt(0)" ::: "memory"); __builtin_amdgcn_wave_barrier();
    const int c = lane & 7;
#pragma unroll
    for (int j = 0; j < 4; ++j) {
        const int n = (lane >> 3) + 8 * j; const float* s = scr + (8 * c) * 33 + n;
        u32x4 o; o.x = cvt_pk_bf16(s[0 * 33], s[1 * 33]); o.y = cvt_pk_bf16(s[2 * 33], s[3 * 33]); o.z = cvt_pk_bf16(s[4 * 33], s[5 * 33]); o.w = cvt_pk_bf16(s[6 * 33], s[7 * 33]);
        const int nn = n0 + n; int drow = nn;
        if (mode == 1) drow = ((nn >> 7) << 8) + (nn & 127); else if (mode == 2) drow = ((nn >> 7) << 8) + 128 + (nn & 127);
        *(u32x4*)(WT + (size_t)drow * K + k0 + 8 * c) = o;
    }
    asm volatile("s_waitcnt lgkmcnt(0)" ::: "memory"); __builtin_amdgcn_wave_barrier();
}

__device__ __forceinline__ void phase_prep(const Args& a, float* lds_f, int G) {
    const int tid = my_tid(); const int wave = tid >> 6, lane = tid & 63;
    const int gw = blockIdx.x * 8 + wave, NGW = G * 8;
    float* scr = lds_f + wave * (64 * 33 + 16);
    unsigned char* ws = a.ws;
    constexpr int I_IN = 16 * 168, I_SB = 8 * 32, I_O = 16 * 32, I_G = 16 * 88, I_DN = 44 * 32, I_LU = 16, I_LG = 32;
    constexpr int NIT = I_IN + 2 * I_SB + I_O + 2 * I_G + I_DN + 2 * I_LU + I_LG;
    for (int it = gw; it < NIT; it += NGW) {
        int r = it;
        if (r < I_IN) { tr_item(a.in[2], 1024, INC, (bf16_t*)(ws + O_WIN), scr, r, lane, 0); continue; } r -= I_IN;
        if (r < I_SB) { tr_item(a.in[15], 512, 1024, (bf16_t*)(ws + O_WSB), scr, r, lane, 0); continue; } r -= I_SB;
        if (r < I_SB) { tr_item(a.in[16], 512, 1024, (bf16_t*)(ws + O_WRW), scr, r, lane, 0); continue; } r -= I_SB;
        if (r < I_O) { tr_item(a.in[17], 1024, 1024, (bf16_t*)(ws + O_WO), scr, r, lane, 0); continue; } r -= I_O;
        if (r < I_G) { tr_item(a.in[20], 1024, DFF, (bf16_t*)(ws + O_WGU), scr, r, lane, 1); continue; } r -= I_G;
        if (r < I_G) { tr_item(a.in[21], 1024, DFF, (bf16_t*)(ws + O_WGU), scr, r, lane, 2); continue; } r -= I_G;
        if (r < I_DN) { tr_item(a.in[22], DFF, 1024, (bf16_t*)(ws + O_WDN), scr, r, lane, 0); continue; } r -= I_DN;
        if (r < I_LU) { tr_item(a.in[6], 64, 512, (bf16_t*)(ws + O_WLU), scr, r, lane, 0); continue; } r -= I_LU;
        if (r < I_LU) { tr_item(a.in[8], 64, 512, (bf16_t*)(ws + O_WLA), scr, r, lane, 0); continue; } r -= I_LU;
        tr_item(a.in[9], 128, 512, (bf16_t*)(ws + O_WLG), scr, r, lane, 0);
    }
    const float* x = a.in[0]; const float* g = a.in[1]; bf16_t* H = (bf16_t*)(ws + O_H);
    f32x4 gv[4];
#pragma unroll
    for (int j = 0; j < 4; ++j) gv[j] = ((const f32x4*)g)[lane + 64 * j];
    for (int row0 = gw; row0 < M; row0 += 2 * NGW) {
        f32x4 v[2][4];
#pragma unroll
        for (int u = 0; u < 2; ++u) { const int row = (row0 + u * NGW < M) ? row0 + u * NGW : row0; const f32x4* xr = (const f32x4*)(x + (size_t)row * D) + lane;
#pragma unroll
            for (int j = 0; j < 4; ++j) v[u][j] = xr[64 * j]; }
#pragma unroll
        for (int u = 0; u < 2; ++u) { const int row = row0 + u * NGW; float s = 0.f;
#pragma unroll
            for (int j = 0; j < 4; ++j) s += (v[u][j][0] * v[u][j][0] + v[u][j][1] * v[u][j][1]) + (v[u][j][2] * v[u][j][2] + v[u][j][3] * v[u][j][3]);
            const float rs = rsqrtf(wave_sum(s) * (1.f / D) + RMS_EPS);
            if (row < M) { u32x2* o = (u32x2*)(H + (size_t)row * D) + lane;
#pragma unroll
                for (int j = 0; j < 4; ++j) { u32x2 w; w.x = cvt_pk_bf16(v[u][j][0] * rs * gv[j][0], v[u][j][1] * rs * gv[j][1]); w.y = cvt_pk_bf16(v[u][j][2] * rs * gv[j][2], v[u][j][3] * rs * gv[j][3]); o[64 * j] = w; } }
        }
    }
}

struct Epi1 {
    static constexpr bool PERM = true, AFTER_DRAIN = false;
    bf16_t *Q, *Kb, *Vt, *Prw, *Gt; const float* bgate;
    __device__ __forceinline__ void operator()(const f32x4 (&acc)[2][2][4][2], const pg8::Unit& u, int wr, int wc, int fr, int fq) const {
        const int row0 = u.pm * 256 + wr * 64 + fr, pn = u.pn, cl = wc * 32 + 8 * fq;
        if (pn < 4) {
            bf16_t* dst = pn < 2 ? Q : Kb; const float sc = pn < 2 ? 0.125f : 1.f; const int cb = (pn & 1) * 256 + cl;
#pragma unroll
            for (int ai = 0; ai < 2; ++ai)
#pragma unroll
                for (int m = 0; m < 4; ++m) { bf16_t* rp = dst + (size_t)(row0 + ai * 128 + m * 16) * 512 + cb;
#pragma unroll
                    for (int bj = 0; bj < 2; ++bj) *(u32x4*)(rp + bj * 128) = pack8(acc[ai][bj][m][0] * sc, acc[ai][bj][m][1] * sc); }
        } else if (pn < 6) {
#pragma unroll
            for (int ai = 0; ai < 2; ++ai)
#pragma unroll
                for (int m = 0; m < 4; ++m) { const int row = row0 + ai * 128 + m * 16, b = row >> 11, s = row & 2047;
#pragma unroll
                    for (int bj = 0; bj < 2; ++bj)
#pragma unroll
                        for (int n = 0; n < 2; ++n)
#pragma unroll
                            for (int j = 0; j < 4; ++j) { const int c = (pn - 4) * 256 + bj * 128 + cl + 4 * n + j;
                                Vt[((size_t)(b * 512 + c)) * 2048 + s] = bf1(acc[ai][bj][m][n][j]); } }
        } else if (pn < 13) {
            const int cb = (pn - 6) * 256 + cl;
#pragma unroll
            for (int ai = 0; ai < 2; ++ai)
#pragma unroll
                for (int m = 0; m < 4; ++m) { bf16_t* rp = Prw + (size_t)(row0 + ai * 128 + m * 16) * RWC + cb;
#pragma unroll
                    for (int bj = 0; bj < 2; ++bj) *(u32x4*)(rp + bj * 128) = pack8(acc[ai][bj][m][0], acc[ai][bj][m][1]); }
        } else {
            const int cb = (pn - 13) * 256 + cl;
#pragma unroll
            for (int ai = 0; ai < 2; ++ai)
#pragma unroll
                for (int m = 0; m < 4; ++m) { bf16_t* rp = Gt + (size_t)(row0 + ai * 128 + m * 16) * GC + cb;
#pragma unroll
                    for (int bj = 0; bj < 2; ++bj) { f32x4 v0 = acc[ai][bj][m][0] + *(const f32x4*)(bgate + cb + bj * 128), v1 = acc[ai][bj][m][1] + *(const f32x4*)(bgate + cb + bj * 128 + 4);
#pragma unroll
                        for (int j = 0; j < 4; ++j) { v0[j] = fsigmoid(v0[j]); v1[j] = fsigmoid(v1[j]); }
                        *(u32x4*)(rp + bj * 128) = pack8(v0, v1); } }
        }
    }
};
template <int MODE> struct EpiRow {
    static constexpr bool PERM = true, AFTER_DRAIN = false;
    bf16_t* O; const bf16_t* T1; const bf16_t* Gt;
    __device__ __forceinline__ void operator()(const f32x4 (&acc)[2][2][4][2], const pg8::Unit& u, int wr, int wc, int fr, int fq) const {
        const int row0 = u.pm * 256 + wr * 64 + fr, cb = u.pn * 256 + wc * 32 + 8 * fq;
#pragma unroll
        for (int ai = 0; ai < 2; ++ai)
#pragma unroll
            for (int m = 0; m < 4; ++m) { const size_t row = (size_t)(row0 + ai * 128 + m * 16);
#pragma unroll
                for (int bj = 0; bj < 2; ++bj) { f32x4 v0 = acc[ai][bj][m][0], v1 = acc[ai][bj][m][1]; const int c = cb + bj * 128;
                    if (MODE >= 1) { const u32x4 gg = *(const u32x4*)(Gt + row * GC + (MODE == 2 ? 1024 : 0) + c);
                        v0[0] *= bf_lo(gg.x); v0[1] *= bf_hi(gg.x); v0[2] *= bf_lo(gg.y); v0[3] *= bf_hi(gg.y); v1[0] *= bf_lo(gg.z); v1[1] *= bf_hi(gg.z); v1[2] *= bf_lo(gg.w); v1[3] *= bf_hi(gg.w); }
                    if (MODE == 2) { const u32x4 tt = *(const u32x4*)(T1 + row * 1024 + c);
                        v0[0] += bf_lo(tt.x); v0[1] += bf_hi(tt.x); v0[2] += bf_lo(tt.y); v0[3] += bf_hi(tt.y); v1[0] += bf_lo(tt.z); v1[1] += bf_hi(tt.z); v1[2] += bf_lo(tt.w); v1[3] += bf_hi(tt.w); }
                    *(u32x4*)(O + row * 1024 + c) = pack8(v0, v1); } }
    }
};
struct EpiSwiGLU {
    static constexpr bool PERM = true, AFTER_DRAIN = false;
    bf16_t* Hd;
    __device__ __forceinline__ void operator()(const f32x4 (&acc)[2][2][4][2], const pg8::Unit& u, int wr, int wc, int fr, int fq) const {
        const int row0 = u.pm * 256 + wr * 64 + fr, cb = u.pn * 128 + wc * 32 + 8 * fq;
#pragma unroll
        for (int ai = 0; ai < 2; ++ai)
#pragma unroll
            for (int m = 0; m < 4; ++m) { f32x4 v0, v1;
#pragma unroll
                for (int j = 0; j < 4; ++j) { const float g0 = acc[ai][0][m][0][j], g1 = acc[ai][0][m][1][j];
                    v0[j] = g0 * fsigmoid(g0) * acc[ai][1][m][0][j]; v1[j] = g1 * fsigmoid(g1) * acc[ai][1][m][1][j]; }
                *(u32x4*)(Hd + (size_t)(row0 + ai * 128 + m * 16) * DFF + cb) = pack8(v0, v1); }
    }
};
template <class Epi> __device__ __forceinline__ void run_gemm(PG8_LAS unsigned char* lds, const bf16_t* A, const bf16_t* Bt, int N, int K, const Epi& E, int G) {
    pg8::Gemm g; g.A = A; g.Bt = Bt; g.M = M; g.N = N; g.K = K;
    pg8::StaticOrder S; S.init(M, N, G, (int)blockIdx.x);
    pg8::gemm_phase<Epi, pg8::StaticOrder, true, true>(lds, g, S, E);
}
__device__ __forceinline__ void mix8_lds(const unsigned char* cur, const unsigned char* prv, const float* mu, float (&o)[8]) {
    const u32x4 c = *(const u32x4*)cur, p = *(const u32x4*)prv;
    const f32x4 m0 = *(const f32x4*)mu, m1 = *(const f32x4*)(mu + 4);
    const float mm[8] = {m0[0], m0[1], m0[2], m0[3], m1[0], m1[1], m1[2], m1[3]};
#pragma unroll
    for (int i = 0; i < 4; ++i) { const float cl = bf_lo(c[i]), ch = bf_hi(c[i]), pl = bf_lo(p[i]), ph = bf_hi(p[i]);
        o[2 * i] = cl + (pl - cl) * mm[2 * i]; o[2 * i + 1] = ch + (ph - ch) * mm[2 * i + 1]; }
}
__device__ __forceinline__ void mix4_lds(const unsigned char* cur, const unsigned char* prv, const float* mu, float (&o)[4]) {
    const u32x2 c = *(const u32x2*)cur, p = *(const u32x2*)prv;
    const f32x4 m0 = *(const f32x4*)mu;
#pragma unroll
    for (int i = 0; i < 2; ++i) { const float cl = bf_lo(c[i]), ch = bf_hi(c[i]), pl = bf_lo(p[i]), ph = bf_hi(p[i]);
        o[2 * i] = cl + (pl - cl) * m0[2 * i]; o[2 * i + 1] = ch + (ph - ch) * m0[2 * i + 1]; }
}
__device__ __forceinline__ bf16x8 pack_frag(const float (&v)[8]) {
    u32x4 o; o.x = cvt_pk_bf16(v[0], v[1]); o.y = cvt_pk_bf16(v[2], v[3]); o.z = cvt_pk_bf16(v[4], v[5]); o.w = cvt_pk_bf16(v[6], v[7]);
    return __builtin_bit_cast(bf16x8, o);
}
__device__ __forceinline__ void phase_rwprep(const Args& a, unsigned char* lds, int G) {
    constexpr int ROWB = 3600, L_FRAG = 17 * ROWB, L_PAR = L_FRAG + 8192, NCH = 17 * 224, NT = M / 16;
    const int tid = my_tid(); const int wave = __builtin_amdgcn_readfirstlane(tid >> 6), lane = tid & 63, fr = lane & 15, fq = lane >> 4;
    unsigned char* ws = a.ws;
    const unsigned char* PRW = ws + O_PRW;
    const bf16_t* WLU = (const bf16_t*)(ws + O_WLU); const bf16_t* WLA = (const bf16_t*)(ws + O_WLA); const bf16_t* WLG = (const bf16_t*)(ws + O_WLG);
    unsigned char* SI = ws + O_SI; bf16_t* GB = (bf16_t*)(ws + O_G); float* SC = (float*)(ws + O_SC);
    float* par = (float*)(lds + L_PAR);
    for (int i = tid; i < 1792 + 5 * 512; i += 512) {
        float v;
        if (i < 1792) v = a.in[4][i]; else { const int j = i - 1792, w = j >> 9, c = j & 511; v = (w == 0 ? a.in[5] : w == 1 ? a.in[7] : w == 2 ? a.in[10] : w == 3 ? a.in[11] : a.in[12])[c]; }
        par[i] = v;
    }
    for (int tile = blockIdx.x; tile < NT; tile += G) {
        __syncthreads();
        {   u32x4 pre[8];
#pragma unroll
            for (int j = 0; j < 8; ++j) { const int c = tid + 512 * j; pre[j] = (u32x4){0u, 0u, 0u, 0u};
                if (c < NCH) { const int row = c / 224, col = c - row * 224; const bool zero = (row == 0) && (((tile * 16) & (SEQ - 1)) == 0);
                    if (!zero) pre[j] = *(const u32x4*)(PRW + ((size_t)tile * 16 + row - 1) * (RWC * 2) + col * 16); } }
#pragma unroll
            for (int j = 0; j < 8; ++j) { const int c = tid + 512 * j; if (c < NCH) { const int row = c / 224, col = c - row * 224; *(u32x4*)(lds + row * ROWB + col * 16) = pre[j]; } }
        }
        __syncthreads();
        const unsigned char* rcur = lds + (fr + 1) * ROWB; const unsigned char* rprv = lds + fr * ROWB;
        {
            const int colb = wave < 2 ? 1536 + 32 * wave : (wave < 4 ? 1600 + 32 * (wave - 2) : 1664 + 32 * (wave - 4));
            float t8[8]; mix8_lds(rcur + (colb + 8 * fq) * 2, rprv + (colb + 8 * fq) * 2, par + colb + 8 * fq, t8);
            if (wave < 2) {
#pragma unroll
                for (int i = 0; i < 8; ++i) { const float e = fexp(2.f * t8[i]); t8[i] = 1.f - 2.f * frcp(e + 1.f); } }
            else if (wave >= 4) {
#pragma unroll
                for (int i = 0; i < 8; ++i) t8[i] = fsigmoid(t8[i]); }
            *(bf16x8*)(lds + L_FRAG + wave * 1024 + lane * 16) = pack_frag(t8);
        }
        __syncthreads();
        bf16x8 Aw[2], Aa[2], Ag[4];
#pragma unroll
        for (int s = 0; s < 2; ++s) { Aw[s] = *(const bf16x8*)(lds + L_FRAG + s * 1024 + lane * 16); Aa[s] = *(const bf16x8*)(lds + L_FRAG + (2 + s) * 1024 + lane * 16); }
#pragma unroll
        for (int s = 0; s < 4; ++s) Ag[s] = *(const bf16x8*)(lds + L_FRAG + (4 + s) * 1024 + lane * 16);
        const int h = wave; const size_t m = (size_t)tile * 16 + fr;
        float kkr[16], av[16]; unsigned lk[16], rvp[16];
        float ss = 0.f, brs = 0.f, krs = 0.f, rkbs = 0.f;
#pragma unroll
        for (int n = 0; n < 4; ++n) {
            asm volatile("" ::: "memory");
            const int cb = 64 * h + 16 * n, c0 = cb + 4 * fq;
            f32x4 aw = {0.f, 0.f, 0.f, 0.f}, aa = aw, ag = aw;
#pragma unroll
            for (int s = 0; s < 2; ++s) {
                aw = __builtin_amdgcn_mfma_f32_16x16x32_bf16(*(const bf16x8*)(WLU + (size_t)(cb + fr) * 64 + 32 * s + 8 * fq), Aw[s], aw, 0, 0, 0);
                aa = __builtin_amdgcn_mfma_f32_16x16x32_bf16(*(const bf16x8*)(WLA + (size_t)(cb + fr) * 64 + 32 * s + 8 * fq), Aa[s], aa, 0, 0, 0); }
#pragma unroll
            for (int s = 0; s < 4; ++s)
                ag = __builtin_amdgcn_mfma_f32_16x16x32_bf16(*(const bf16x8*)(WLG + (size_t)(cb + fr) * 128 + 32 * s + 8 * fq), Ag[s], ag, 0, 0, 0);
            float rr[4], kr4[4], vv[4];
            mix4_lds(rcur + c0 * 2, rprv + c0 * 2, par + c0, rr); mix4_lds(rcur + (512 + c0) * 2, rprv + (512 + c0) * 2, par + 512 + c0, kr4); mix4_lds(rcur + (1024 + c0) * 2, rprv + (1024 + c0) * 2, par + 1024 + c0, vv);
            const f32x4 w0v = *(const f32x4*)(par + 1792 + c0), a0v = *(const f32x4*)(par + 2304 + c0), kkv = *(const f32x4*)(par + 2816 + c0), kav = *(const f32x4*)(par + 3328 + c0), rkv = *(const f32x4*)(par + 3840 + c0);
#pragma unroll
            for (int j = 0; j < 4; ++j) {
                const float sg = fsigmoid(w0v[j] + aw[j]);
                const float ldx = -0.60653065971f * 1.44269504089f * sg;
                const float av_ = fsigmoid(a0v[j] + aa[j]);
                const float kkraw = kr4[j] * kkv[j];
                const float k2 = kr4[j] * (1.f + (av_ - 1.f) * kav[j]);
                ss += kkraw * kkraw; brs += kkraw * av_ * rr[j]; krs += k2 * rr[j]; rkbs += rr[j] * k2 * rkv[j];
                kkr[4 * n + j] = kkraw; av[4 * n + j] = av_; lk[4 * n + j] = cvt_pk_bf16(ldx, k2); rvp[4 * n + j] = cvt_pk_bf16(rr[j], vv[j]);
            }
            u32x2 gp; gp.x = cvt_pk_bf16(ag[0], ag[1]); gp.y = cvt_pk_bf16(ag[2], ag[3]);
            *(u32x2*)(GB + m * 512 + c0) = gp;
        }
        ss = red16(ss); brs = red16(brs); krs = red16(krs); rkbs = red16(rkbs);
        const float inv = 1.f / fmaxf(sqrtf(ss), 1e-12f);
        unsigned char* rec = SI + ((m * 8 + h) * 64) * 12;
#pragma unroll
        for (int n = 0; n < 4; ++n) {
            unsigned dw[12];
#pragma unroll
            for (int j = 0; j < 4; ++j) { const float kk = kkr[4 * n + j] * inv;
                const unsigned kp = cvt_pk_bf16(kk * av[4 * n + j], -kk);
                dw[3 * j] = (lk[4 * n + j] & 0xffffu) | (kp & 0xffff0000u); dw[3 * j + 1] = (kp & 0xffffu) | (lk[4 * n + j] & 0xffff0000u); dw[3 * j + 2] = rvp[4 * n + j]; }
            u32x4* dst = (u32x4*)(rec + (16 * n + 4 * fq) * 12);
            u32x4 s0 = {dw[0], dw[1], dw[2], dw[3]}, s1 = {dw[4], dw[5], dw[6], dw[7]}, s2 = {dw[8], dw[9], dw[10], dw[11]};
            dst[0] = s0; dst[1] = s1; dst[2] = s2;
        }
        if (fq == 0) { f32x4 scv = {brs * inv, krs, rkbs, 0.f}; *(f32x4*)(SC + (m * 8 + h) * 4) = scv; }
    }
    __syncthreads();
}

__device__ __forceinline__ float red_rows(float x) {
    float a0 = x, a1 = x;
    asm volatile("s_nop 1\n\tv_permlane16_swap_b32 %0, %1" : "+v"(a0), "+v"(a1));
    float b0 = a0 + a1, b1 = b0;
    asm volatile("s_nop 1\n\tv_permlane32_swap_b32 %0, %1" : "+v"(b0), "+v"(b1));
    return b0 + b1;
}
constexpr int SC_T = 16, SC_ROW = 1552, SC_BUF = SC_T * SC_ROW;
struct ProdRec { unsigned d0, d1, d2; f32x2 sc; };
__device__ __forceinline__ void prod_load(ProdRec (&P)[4], const unsigned char* sb, const float* scp, int chunk, int pl) {
    const int col = pl & 63;
#pragma unroll
    for (int q = 0; q < 4; ++q) { const size_t t = (size_t)chunk * SC_T + (pl >> 6) + 4 * q;
        const unsigned* p = (const unsigned*)(sb + t * 6144 + col * 12); P[q].d0 = p[0]; P[q].d1 = p[1]; P[q].d2 = p[2];
        P[q].sc = (f32x2){0.f, 0.f}; if (col == 0) P[q].sc = *(const f32x2*)(scp + t * 32); }
}
__device__ __forceinline__ void prod_store(const ProdRec (&P)[4], unsigned char* buf, int pl) {
    const int col = pl & 63;
#pragma unroll
    for (int q = 0; q < 4; ++q) { unsigned char* base = buf + ((pl >> 6) + 4 * q) * SC_ROW + col * 4;
        const float w = __builtin_amdgcn_exp2f(bf_lo(P[q].d0));
        *(float*)(base) = bf_hi(P[q].d0); *(float*)(base + 256) = w * bf_lo(P[q].d2); *(float*)(base + 512) = w;
        *(float*)(base + 768) = bf_lo(P[q].d1); *(float*)(base + 1024) = bf_hi(P[q].d1); *(float*)(base + 1280) = bf_hi(P[q].d2);
        if (col == 0) *(f32x2*)(base + 1536) = P[q].sc; }
}
#define MK_SWAP32(a, b) asm volatile("s_nop 1\n\tv_permlane32_swap_b32 %0, %1" : "+v"(a), "+v"(b))
#define MK_SWAP16(a, b) asm volatile("s_nop 1\n\tv_permlane16_swap_b32 %0, %1" : "+v"(a), "+v"(b))
__device__ __forceinline__ void red4x8(float& A, float& B, float& C, float& D) {
    MK_SWAP32(A, B); float u = A + B;
    MK_SWAP32(C, D); float w = C + D;
    MK_SWAP16(u, w); float z = u + w;
    float z1;
    asm volatile("s_nop 1\n\tv_add_f32_dpp %0, %1, %1 row_ror:8 row_mask:0xf bank_mask:0xf" : "=&v"(z1) : "v"(z));
    float p = z1, q = z1; MK_SWAP32(p, q);
    float p2 = p; MK_SWAP16(p, p2);
    float q2 = q; MK_SWAP16(q, q2);
    A = p; C = p2; B = q; D = q2;
}
__device__ __forceinline__ void scan_consume(f32x2 (&S)[8], const unsigned char* buf, unsigned* yr, int lane, int rb) {
    const unsigned co = (unsigned)(lane >> 3) * 32u, vo = 1280u + (unsigned)(16 * rb + (lane & 7)) * 4u;
#pragma unroll 2
    for (int st = 0; st < SC_T; ++st) {
        const unsigned char* sb = buf + st * SC_ROW;
        f32x4 n4[2], r4[2], w4[2], a4[2], k4[2];
#pragma unroll
        for (int q = 0; q < 2; ++q) { n4[q] = *(const f32x4*)(sb + co + 16 * q); r4[q] = *(const f32x4*)(sb + 256 + co + 16 * q); w4[q] = *(const f32x4*)(sb + 512 + co + 16 * q);
            a4[q] = *(const f32x4*)(sb + 768 + co + 16 * q); k4[q] = *(const f32x4*)(sb + 1024 + co + 16 * q); }
        const float v0 = *(const float*)(sb + vo), v1 = *(const float*)(sb + vo + 32); const f32x2 bk = *(const f32x2*)(sb + 1536);
        f32x2 sa0v = {0.f, 0.f}, sa1v = sa0v, yp0v = sa0v, yp1v = sa0v;
#pragma unroll
        for (int p = 0; p < 4; ++p) { const f32x2 nn = {n4[p >> 1][2 * (p & 1)], n4[p >> 1][2 * (p & 1) + 1]}, rr2 = {r4[p >> 1][2 * (p & 1)], r4[p >> 1][2 * (p & 1) + 1]};
            sa0v += S[p] * nn; sa1v += S[4 + p] * nn; yp0v += S[p] * rr2; yp1v += S[4 + p] * rr2; }
        float sa0 = sa0v[0] + sa0v[1], sa1 = sa1v[0] + sa1v[1], yp0 = yp0v[0] + yp0v[1], yp1 = yp1v[0] + yp1v[1];
        red4x8(sa0, sa1, yp0, yp1);
        const f32x2 s0 = {sa0, sa0}, s1 = {sa1, sa1}, vv0 = {v0, v0}, vv1 = {v1, v1};
#pragma unroll
        for (int p = 0; p < 4; ++p) { const f32x2 ww = {w4[p >> 1][2 * (p & 1)], w4[p >> 1][2 * (p & 1) + 1]}; S[p] = S[p] * ww; S[4 + p] = S[4 + p] * ww; }
        asm volatile("" ::: "memory");
#pragma unroll
        for (int p = 0; p < 4; ++p) { const f32x2 aa = {a4[p >> 1][2 * (p & 1)], a4[p >> 1][2 * (p & 1) + 1]}; S[p] = __builtin_elementwise_fma(aa, s0, S[p]); S[4 + p] = __builtin_elementwise_fma(aa, s1, S[4 + p]); }
        asm volatile("" ::: "memory");
#pragma unroll
        for (int p = 0; p < 4; ++p) { const f32x2 kk = {k4[p >> 1][2 * (p & 1)], k4[p >> 1][2 * (p & 1) + 1]}; S[p] = __builtin_elementwise_fma(kk, vv0, S[p]); S[4 + p] = __builtin_elementwise_fma(kk, vv1, S[4 + p]); }
        const float y0 = yp0 + sa0 * bk[0] + v0 * bk[1], y1 = yp1 + sa1 * bk[0] + v1 * bk[1];
        if (lane < 16) { const bool hi = (lane & 8) != 0;
            yr[(size_t)st * 512 + lane] = (unsigned)bf1(hi ? y1 : y0) | (__float_as_uint(hi ? v1 : v0) & 0xffff0000u); }
    }
}

__device__ __forceinline__ void rwpost_local(const Args& a, int bh, int tid) {
    const float* SC = (const float*)(a.ws + O_SC);
    const unsigned* YR = (const unsigned*)(a.ws + O_YR); const bf16_t* GB = (const bf16_t*)(a.ws + O_G); bf16_t* ORW = (bf16_t*)(a.ws + O_ORW);
    const int b = bh >> 3, h = bh & 7, c = 64 * h + (tid & 15) * 4;
    const f32x4 lwv = *(const f32x4*)(a.in[13] + c), lbv = *(const f32x4*)(a.in[14] + c);
    for (int t0 = tid >> 4; t0 < SEQ; t0 += 64) {
        u32x4 yv[2]; u32x2 gb[2]; float rkb[2]; size_t mm[2];
#pragma unroll
        for (int u = 0; u < 2; ++u) { const size_t m = (size_t)b * SEQ + t0 + 32 * u; mm[u] = m;
            yv[u] = *(const u32x4*)(YR + m * 512 + c); gb[u] = *(const u32x2*)(GB + m * 512 + c); rkb[u] = SC[(m * 8 + h) * 4 + 2]; }
#pragma unroll
        for (int u = 0; u < 2; ++u) {
            float y[4] = {bf_lo(yv[u].x), bf_lo(yv[u].y), bf_lo(yv[u].z), bf_lo(yv[u].w)};
            const float v[4] = {bf_hi(yv[u].x), bf_hi(yv[u].y), bf_hi(yv[u].z), bf_hi(yv[u].w)};
            float s = (y[0] + y[1]) + (y[2] + y[3]);
#pragma unroll
            for (int o = 1; o < 16; o <<= 1) s += __shfl_xor(s, o);
            const float mean = s * (1.f / 64.f);
            float q = 0.f;
#pragma unroll
            for (int j = 0; j < 4; ++j) { y[j] -= mean; q += y[j] * y[j]; }
#pragma unroll
            for (int o = 1; o < 16; o <<= 1) q += __shfl_xor(q, o);
            const float rstd = rsqrtf(q * (1.f / 64.f) + GN_EPS);
            const float g4[4] = {bf_lo(gb[u].x), bf_hi(gb[u].x), bf_lo(gb[u].y), bf_hi(gb[u].y)};
            float o4[4];
#pragma unroll
            for (int j = 0; j < 4; ++j) o4[j] = (y[j] * rstd * lwv[j] + lbv[j] + rkb[u] * v[j]) * g4[j];
            u32x2 ob; ob.x = cvt_pk_bf16(o4[0], o4[1]); ob.y = cvt_pk_bf16(o4[2], o4[3]);
            *(u32x2*)(ORW + mm[u] * 512 + c) = ob;
        }
    }
}

struct KV { bf16x8 k[4]; bf16x8 v[2][2]; };
__device__ __forceinline__ void attn_load(KV& T, const bf16_t* Kh, const bf16_t* Vh, int k0, int n, int hf) {
    const bf16_t* kp = Kh + (size_t)(k0 + n) * 512 + 8 * hf;
#pragma unroll
    for (int s = 0; s < 4; ++s) T.k[s] = *(const bf16x8*)(kp + 16 * s);
#pragma unroll
    for (int d = 0; d < 2; ++d)
#pragma unroll
        for (int sg = 0; sg < 2; ++sg) { const bf16_t* vp = Vh + (size_t)(32 * d + n) * SEQ + k0 + 16 * sg + 4 * hf;
            const u32x2 lo = *(const u32x2*)vp, hi = *(const u32x2*)(vp + 8); u32x4 t = {lo.x, lo.y, hi.x, hi.y}; T.v[d][sg] = __builtin_bit_cast(bf16x8, t); }
}
__device__ __forceinline__ void attn_wave(const Args& a, int bh, int w4, int lane) {
    const int b = bh >> 3, h = bh & 7, n = lane & 31, hf = lane >> 5;
    const size_t m0 = (size_t)b * SEQ;
    const bf16_t* Qh = (const bf16_t*)(a.ws + O_Q) + m0 * 512 + 64 * h;
    const bf16_t* Kh = (const bf16_t*)(a.ws + O_K) + m0 * 512 + 64 * h;
    const bf16_t* Vh = (const bf16_t*)(a.ws + O_VT) + (size_t)bh * 64 * SEQ;
    bf16_t* Oh = (bf16_t*)(a.ws + O_OSB) + m0 * 512 + 64 * h;
    for (int qt = 63 - w4; qt >= 0; qt -= 8) {
        const int q0 = 32 * qt;
        bf16x8 qf[4];
#pragma unroll
        for (int s = 0; s < 4; ++s) qf[s] = *(const bf16x8*)(Qh + (size_t)(q0 + n) * 512 + 16 * s + 8 * hf);
        f32x16 o0, o1;
#pragma unroll
        for (int i = 0; i < 16; ++i) { o0[i] = 0.f; o1[i] = 0.f; }
        float carry = 0.f;
        KV cur, nxt;
        attn_load(cur, Kh, Vh, q0, n, hf);
        for (int kt = qt; kt >= 0; --kt) {
            const int ktn = kt > 0 ? kt - 1 : 0;
            attn_load(nxt, Kh, Vh, 32 * ktn, n, hf);
            f32x16 sc;
#pragma unroll
            for (int i = 0; i < 16; ++i) sc[i] = 0.f;
#pragma unroll
            for (int s = 0; s < 4; ++s) sc = __builtin_amdgcn_mfma_f32_32x32x16_bf16(cur.k[s], qf[s], sc, 0, 0, 0);
            const bool diag = (kt == qt);
            float lf[16], G4[4];
#pragma unroll
            for (int g = 0; g < 4; ++g) { G4[g] = 0.f;
#pragma unroll
                for (int i = 0; i < 4; ++i) { const int r = 4 * g + i; const float z = sc[r];
                    const bool valid = !diag || (8 * g + 4 * hf + i < n);
                    const float e = fexp(-fabsf(z));
                    const float sp = fmaxf(z, 0.f) + flog(1.f + e);
                    lf[r] = valid ? -sp : 0.f; G4[g] += lf[r]; } }
            float PG[4], T4[4];
#pragma unroll
            for (int g = 0; g < 4; ++g) { PG[g] = __shfl_xor(G4[g], 32); T4[g] = G4[g] + PG[g]; }
            const float tail3 = 0.f, tail2 = T4[3], tail1 = T4[3] + T4[2], tail0 = tail1 + T4[1], total = tail0 + T4[0];
            const float tails[4] = {tail0, tail1, tail2, tail3};
            f32x16 wv;
#pragma unroll
            for (int g = 0; g < 4; ++g) {
                float af = carry + tails[g] + (hf == 0 ? PG[g] : 0.f);
#pragma unroll
                for (int i = 3; i >= 0; --i) { const int r = 4 * g + i; const float z = sc[r];
                    const bool valid = !diag || (8 * g + 4 * hf + i < n);
                    const float wgt = fexp(lf[r] + z + af);
                    wv[r] = valid ? wgt : 0.f;
                    af += lf[r]; } }
            carry += total;
            bf16x8 wf[2];
#pragma unroll
            for (int sg = 0; sg < 2; ++sg) { u32x4 t; t.x = cvt_pk_bf16(wv[8 * sg + 0], wv[8 * sg + 1]); t.y = cvt_pk_bf16(wv[8 * sg + 2], wv[8 * sg + 3]); t.z = cvt_pk_bf16(wv[8 * sg + 4], wv[8 * sg + 5]); t.w = cvt_pk_bf16(wv[8 * sg + 6], wv[8 * sg + 7]); wf[sg] = __builtin_bit_cast(bf16x8, t); }
#pragma unroll
            for (int sg = 0; sg < 2; ++sg) { o0 = __builtin_amdgcn_mfma_f32_32x32x16_bf16(cur.v[0][sg], wf[sg], o0, 0, 0, 0); o1 = __builtin_amdgcn_mfma_f32_32x32x16_bf16(cur.v[1][sg], wf[sg], o1, 0, 0, 0); }
            cur = nxt;
#if MK_EARLY_EXIT
            if (__all(carry < -104.f)) break;
#endif
        }
        bf16_t* op = Oh + (size_t)(q0 + n) * 512 + 4 * hf;
#pragma unroll
        for (int g = 0; g < 4; ++g) {
            u32x2 t0, t1; t0.x = cvt_pk_bf16(o0[4 * g], o0[4 * g + 1]); t0.y = cvt_pk_bf16(o0[4 * g + 2], o0[4 * g + 3]); t1.x = cvt_pk_bf16(o1[4 * g], o1[4 * g + 1]); t1.y = cvt_pk_bf16(o1[4 * g + 2], o1[4 * g + 3]);
            *(u32x2*)(op + 8 * g) = t0; *(u32x2*)(op + 32 + 8 * g) = t1; }
    }
}
__device__ __forceinline__ void phase_mixer(const Args& a, unsigned char* lds, int G) {
    const int tid = my_tid(); const int wave = __builtin_amdgcn_readfirstlane(tid >> 6), lane = tid & 63;
    for (int bh = blockIdx.x; bh < NB * NH; bh += G) {
        const int b = bh >> 3, h = bh & 7; const size_t m0 = (size_t)b * SEQ;
        const unsigned char* sb = a.ws + O_SI + (m0 * 8 + h) * 768; const float* scp = (const float*)(a.ws + O_SC) + (m0 * 8 + h) * 4;
        unsigned* yrb = (unsigned*)(a.ws + O_YR) + m0 * 512 + 64 * h + 16 * (wave & 3);
        const int pl = tid - 256;
        constexpr int NCH = SEQ / SC_T;
        ProdRec pr[4]; f32x2 S[8];
#pragma unroll
        for (int p = 0; p < 8; ++p) S[p] = (f32x2){0.f, 0.f};
        __syncthreads();
        if (wave >= 4) { prod_load(pr, sb, scp, 0, pl); prod_store(pr, lds, pl); prod_load(pr, sb, scp, 1, pl); }
        __syncthreads();
        for (int ci = 0; ci < NCH; ++ci) {
            if (wave < 4) scan_consume(S, lds + (ci & 1) * SC_BUF, yrb + (size_t)ci * SC_T * 512, lane, wave);
            else if (ci + 1 < NCH) { prod_store(pr, lds + ((ci + 1) & 1) * SC_BUF, pl); prod_load(pr, sb, scp, ci + 2 < NCH ? ci + 2 : ci + 1, pl); }
            __syncthreads();
        }
        attn_wave(a, bh, wave, lane);
        __threadfence_block(); __syncthreads();
        rwpost_local(a, bh, my_tid());
    }
}

template <int MODE> __device__ __forceinline__ void phase_rows(const Args& a, int G) {
    const int tid = my_tid(); const int wave = tid >> 6, lane = tid & 63;
    const int gw = blockIdx.x * 8 + wave, NGW = G * 8;
    const bf16_t* T = (const bf16_t*)(a.ws + (MODE == 0 ? O_TT : O_FF));
    const float* xin = MODE == 0 ? a.in[0] : a.out; const float* g1 = MODE == 0 ? a.in[18] : a.in[23]; const float* g2 = a.in[19];
    bf16_t* H2 = (bf16_t*)(a.ws + O_H2);
    f32x4 g1v[4], g2v[4];
#pragma unroll
    for (int j = 0; j < 4; ++j) { g1v[j] = ((const f32x4*)g1)[lane + 64 * j]; g2v[j] = ((const f32x4*)g2)[lane + 64 * j]; }
    for (int row0 = gw; row0 < M; row0 += 2 * NGW) {
        u32x2 tb[2][4]; f32x4 x[2][4];
#pragma unroll
        for (int u = 0; u < 2; ++u) { const int row = (row0 + u * NGW < M) ? row0 + u * NGW : row0;
            const u32x2* tr = (const u32x2*)(T + (size_t)row * D) + lane; const f32x4* xr = (const f32x4*)(xin + (size_t)row * D) + lane;
#pragma unroll
            for (int j = 0; j < 4; ++j) { tb[u][j] = tr[64 * j]; x[u][j] = xr[64 * j]; } }
#pragma unroll
        for (int u = 0; u < 2; ++u) {
            const int row = row0 + u * NGW;
            f32x4 t[4]; float s = 0.f;
#pragma unroll
            for (int j = 0; j < 4; ++j) { t[j][0] = bf_lo(tb[u][j].x); t[j][1] = bf_hi(tb[u][j].x); t[j][2] = bf_lo(tb[u][j].y); t[j][3] = bf_hi(tb[u][j].y);
                s += (t[j][0] * t[j][0] + t[j][1] * t[j][1]) + (t[j][2] * t[j][2] + t[j][3] * t[j][3]); }
            const float rs = rsqrtf(wave_sum(s) * (1.f / D) + RMS_EPS);
            float s2 = 0.f;
#pragma unroll
            for (int j = 0; j < 4; ++j)
#pragma unroll
                for (int e = 0; e < 4; ++e) { x[u][j][e] += t[j][e] * rs * g1v[j][e]; s2 += x[u][j][e] * x[u][j][e]; }
            float rs2 = 0.f;
            if (MODE == 0) rs2 = rsqrtf(wave_sum(s2) * (1.f / D) + RMS_EPS);
            if (row < M) {
                f32x4* orow = (f32x4*)(a.out + (size_t)row * D) + lane;
#pragma unroll
                for (int j = 0; j < 4; ++j) orow[64 * j] = x[u][j];
                if (MODE == 0) {
                    u32x2* o = (u32x2*)(H2 + (size_t)row * D) + lane;
#pragma unroll
                    for (int j = 0; j < 4; ++j) { u32x2 w; w.x = cvt_pk_bf16(x[u][j][0] * rs2 * g2v[j][0], x[u][j][1] * rs2 * g2v[j][1]); w.y = cvt_pk_bf16(x[u][j][2] * rs2 * g2v[j][2], x[u][j][3] * rs2 * g2v[j][3]); o[64 * j] = w; }
                }
            }
        }
    }
}

#define XB_TMO      128
#define XB_XCNT(j)  (256  + 64 * (j))
#define XB_XSUB(j)  (1280 + 64 * (j))
#define XB_XGEN(j)  (2304 + 64 * (j))
#define XB_TOP      3328
#define XB_TOPGEN   3392
#define XCD_BAR_WORDS 3456
#define XB_SPIN_CAP (1u << 18)

__device__ __forceinline__ unsigned xb_ld(unsigned* p)              { return __hip_atomic_load(p, __ATOMIC_RELAXED, __HIP_MEMORY_SCOPE_AGENT); }
__device__ __forceinline__ unsigned xb_add(unsigned* p, unsigned v) { return __hip_atomic_fetch_add(p, v, __ATOMIC_RELAXED, __HIP_MEMORY_SCOPE_AGENT); }
__device__ __forceinline__ unsigned xb_xcc_id() { return (unsigned)__builtin_amdgcn_s_getreg((3 << 11) | 20) & 0xFu; }
#define XB_SPIN(cond, bar) do { unsigned _sp = 0; while (cond) { __builtin_amdgcn_s_sleep(1); \
    if ((++_sp & 255u) == 0u) { if (xb_ld(&(bar)[XB_TMO])) break; if (_sp > XB_SPIN_CAP) { atomicAdd(&(bar)[XB_TMO], 1u); break; } } } } while (0)

struct XcdBarrier {
    unsigned* bar; unsigned x;
    volatile __attribute__((address_space(3))) unsigned* st;
};

__device__ __forceinline__ XcdBarrier xcd_barrier_post(unsigned* bar, volatile __attribute__((address_space(3))) unsigned* st) {
    XcdBarrier b; b.bar = bar; b.x = xb_xcc_id(); b.st = st;
    if (threadIdx.x == 0) (void)xb_add(&bar[XB_XCNT(b.x)], 1u);
    return b;
}
__device__ __forceinline__ void xcd_barrier_complete(unsigned* bar, unsigned x, unsigned& nloc, unsigned& nx) {
    const unsigned G = gridDim.x * gridDim.y * gridDim.z;
    unsigned sum, cnt, mine, sp = 0u;
    for (;;) {
        sum = 0u; cnt = 0u; mine = 0u;
#pragma unroll
        for (unsigned j = 0; j < 16; ++j) { const unsigned c = xb_ld(&bar[XB_XCNT(j)]); sum += c; cnt += (c > 0u) ? 1u : 0u; mine = (j == x) ? c : mine; }
        if (sum == G) break;
        __builtin_amdgcn_s_sleep(1);
        if ((++sp & 255u) == 0u) { if (xb_ld(&bar[XB_TMO])) break; if (sp > XB_SPIN_CAP) { atomicAdd(&bar[XB_TMO], 1u); break; } }
    }
    nloc = mine > 0u ? mine : 1u; nx = cnt > 0u ? cnt : 1u;
}

__device__ __forceinline__ void xcd_barrier(const XcdBarrier& b) {
    asm volatile("s_waitcnt vmcnt(0)" ::: "memory");
    __syncthreads();
    if (threadIdx.x == 0) {
        unsigned* bar = b.bar;
        __builtin_amdgcn_s_waitcnt(0);
        unsigned nloc = b.st[0], nx = b.st[1];
        if (nloc == 0u) { xcd_barrier_complete(bar, b.x, nloc, nx); b.st[0] = nloc; b.st[1] = nx; }
        const unsigned old = xb_add(&bar[XB_XSUB(b.x)], 1u);
        const unsigned gen = old / nloc;
        if (old + 1u == (gen + 1u) * nloc) {
            __builtin_amdgcn_fence(__ATOMIC_RELEASE, "agent");
            asm volatile("s_waitcnt vmcnt(0)" ::: "memory");
            const unsigned og = xb_add(&bar[XB_TOP], 1u);
            const unsigned tg = og / nx;
            if (og + 1u == (tg + 1u) * nx) xb_add(&bar[XB_TOPGEN], 1u);
            else XB_SPIN(xb_ld(&bar[XB_TOPGEN]) == tg, bar);
            __builtin_amdgcn_fence(__ATOMIC_ACQUIRE, "agent");
            xb_add(&bar[XB_XGEN(b.x)], 1u);
            asm volatile("s_waitcnt vmcnt(0)" ::: "memory");
        } else {
            XB_SPIN(xb_ld(&bar[XB_XGEN(b.x)]) == gen, bar);
            __builtin_amdgcn_fence(__ATOMIC_ACQUIRE, "agent");
            asm volatile("s_waitcnt vmcnt(0)" ::: "memory");
        }
    }
    __syncthreads();
}

__global__ void __launch_bounds__(512, 2) mega(Args a) {
    extern __shared__ __attribute__((aligned(16))) unsigned char shm[];
    PG8_LAS unsigned char* lds = (PG8_LAS unsigned char*)shm;
    const int G = (int)gridDim.x;
    unsigned char* ws = a.ws;
    volatile __attribute__((address_space(3))) unsigned* bst = (volatile __attribute__((address_space(3))) unsigned*)(lds + pg8::STAGE_BYTES);
    if (threadIdx.x == 0) { bst[0] = 0u; bst[1] = 0u; }
    __syncthreads();
    const XcdBarrier bar = xcd_barrier_post((unsigned*)(ws + O_CTL), bst);
    phase_prep(a, (float*)shm, G);
    cg::this_grid().sync();
    { Epi1 E; E.Q = (bf16_t*)(ws + O_Q); E.Kb = (bf16_t*)(ws + O_K); E.Vt = (bf16_t*)(ws + O_VT); E.Prw = (bf16_t*)(ws + O_PRW); E.Gt = (bf16_t*)a.out; E.bgate = a.in[3];
      run_gemm(lds, (const bf16_t*)(ws + O_H), (const bf16_t*)(ws + O_WIN), INC, 1024, E, G); }
    xcd_barrier(bar);
    phase_rwprep(a, shm, G);
    xcd_barrier(bar);
    phase_mixer(a, shm, G);
    xcd_barrier(bar);
    { EpiRow<1> E; E.O = (bf16_t*)(ws + O_T1); E.T1 = nullptr; E.Gt = (const bf16_t*)a.out;
      run_gemm(lds, (const bf16_t*)(ws + O_OSB), (const bf16_t*)(ws + O_WSB), 1024, 512, E, G); }
    { EpiRow<2> E; E.O = (bf16_t*)(ws + O_MRG); E.T1 = (const bf16_t*)(ws + O_T1); E.Gt = (const bf16_t*)a.out;
      run_gemm(lds, (const bf16_t*)(ws + O_ORW), (const bf16_t*)(ws + O_WRW), 1024, 512, E, G); }
    xcd_barrier(bar);
    { EpiRow<0> E; E.O = (bf16_t*)(ws + O_TT); E.T1 = nullptr; E.Gt = nullptr;
      run_gemm(lds, (const bf16_t*)(ws + O_MRG), (const bf16_t*)(ws + O_WO), 1024, 1024, E, G); }
    xcd_barrier(bar);
    phase_rows<0>(a, G);
    xcd_barrier(bar);
    { EpiSwiGLU E; E.Hd = (bf16_t*)(ws + O_HID);
      run_gemm(lds, (const bf16_t*)(ws + O_H2), (const bf16_t*)(ws + O_WGU), 2 * DFF, 1024, E, G); }
    xcd_barrier(bar);
    { EpiRow<0> E; E.O = (bf16_t*)(ws + O_FF); E.T1 = nullptr; E.Gt = nullptr;
      run_gemm(lds, (const bf16_t*)(ws + O_HID), (const bf16_t*)(ws + O_WDN), 1024, DFF, E, G); }
    xcd_barrier(bar);
    phase_rows<1>(a, G);
}
}

extern "C" void kernel_launch(void* const* d_in, const int* in_sizes, int n_in, void* d_out, int out_size, void* d_ws, size_t ws_size, hipStream_t stream) {
    static int grid = 0;
    if (grid == 0) {
        if (n_in != 24 || in_sizes[0] != mk::M * mk::D || out_size != mk::M * mk::D || ws_size < mk::WS_NEED) {
            fprintf(stderr, "kernel_launch: unexpected shapes: n_in %d in0 %d out %d ws %zu (need %zu)\n", n_in, n_in > 0 ? in_sizes[0] : -1, out_size, ws_size, (size_t)mk::WS_NEED); grid = -1; return; }
        int dev = 0, cus = 0, per_cu = 0;
        hipGetDevice(&dev); hipDeviceGetAttribute(&cus, hipDeviceAttributeMultiprocessorCount, dev);
        if (hipFuncSetAttribute((const void*)mk::mega, hipFuncAttributeMaxDynamicSharedMemorySize, mk::LDS_BYTES) != hipSuccess) { fprintf(stderr, "kernel_launch: hipFuncSetAttribute failed\n"); grid = -1; return; }
        if (hipOccupancyMaxActiveBlocksPerMultiprocessor(&per_cu, (const void*)mk::mega, 512, mk::LDS_BYTES) != hipSuccess || per_cu < 1) { fprintf(stderr, "kernel_launch: occupancy query failed (%d)\n", per_cu); per_cu = 1; }
        (void)hipGetLastError();
        grid = cus * per_cu;
        fprintf(stderr, "kernel_launch: grid %d (cus %d x %d)\n", grid, cus, per_cu);
    }
    if (grid < 0) return;
    mk::Args a{};
    for (int i = 0; i < 24; ++i) a.in[i] = (const float*)d_in[i];
    a.out = (float*)d_out; a.ws = (unsigned char*)d_ws;
    a.ph_lo = 0; a.ph_hi = mk::NPH;
    if (hipMemsetAsync((char*)d_ws + mk::O_CTL, 0, mk::CTL_BYTES, stream) != hipSuccess) { fprintf(stderr, "kernel_launch: hipMemsetAsync failed\n"); return; }
    void* args[] = {&a};
    hipError_t e = hipLaunchCooperativeKernel((const void*)mk::mega, dim3(grid), dim3(512), args, mk::LDS_BYTES, stream);
    if (e != hipSuccess) fprintf(stderr, "kernel_launch: cooperative launch failed: %s (grid %d)\n", hipGetErrorString(e), grid);
}
```

```cpp
#include <hip/hip_runtime.h>
#include <hip/hip_cooperative_groups.h>
#include <cstdio>
#include <cstdint>
namespace cg = cooperative_groups;
#ifndef MK_SPLIT
#define MK_SPLIT 0
#endif
#ifndef MK_DIAG
#define MK_DIAG 0
#endif
#ifndef MK_REPMASK
#define MK_REPMASK 0
#endif
#ifndef MK_EARLY_EXIT
#define MK_EARLY_EXIT 1
#endif
namespace pg8 {
#define PG8_LAS __attribute__((address_space(3)))
typedef unsigned short bf16_t;
typedef short bf16x8 __attribute__((ext_vector_type(8)));
typedef float f32x4 __attribute__((ext_vector_type(4)));
typedef unsigned u32x4 __attribute__((ext_vector_type(4)));
constexpr int BM = 256, BK = 64, HALF = 128, HTB = HALF * BK * 2  , STAGE_BYTES = 8 * HTB, NXCD = 8, WGM = 8;

__host__ __device__ __forceinline__ int lds_byte(int r, int c) { const int st = (r >> 4) * 2 + (c >> 5), rr = r & 15, cc = c & 31, ob = rr * 64 + cc * 2; return st * 1024 + (ob ^ (((ob >> 9) & 1) << 5)); }
__host__ __device__ __forceinline__ void stage_rc(int b, int& R, int& C) { const int st = b / 1024, sb = b % 1024, swz = sb ^ (((sb >> 9) & 1) << 5); R = (st >> 1) * 16 + swz / 64; C = (st & 1) * 32 + (swz % 64) / 2; }
__host__ __device__ __forceinline__ int perm32(int rho) { const int n = rho >> 4, i = rho & 15; return 8 * (i >> 2) + 4 * n + (i & 3); }

struct Unit { int pm, pn; };
struct Gemm { const bf16_t* A; const bf16_t* Bt; int M, N, K; };

struct StaticOrder {
    int nM, nN, nwg, G, c;
    __host__ __device__ void init(int M, int N, int G_, int c_) { nM = M / BM; nN = N / BM; nwg = nM * nN; G = G_; c = c_; }
    __host__ __device__ bool next(int i, Unit& u) const {
        const long L = (long)i * G + c; if (L >= nwg) return false;
        int wgid = (int)L; { const int q = nwg / NXCD, r = nwg % NXCD, xcd = wgid % NXCD, off = wgid / NXCD; wgid = (xcd < r ? xcd * (q + 1) : r * (q + 1) + (xcd - r) * q) + off; }
        const int nig = WGM * nN, gid = wgid / nig, fm = gid * WGM, gsz = (nM - fm) < WGM ? (nM - fm) : WGM;
        u.pm = fm + ((wgid % nig) % gsz); u.pn = (wgid % nig) / gsz; return true;
    }
    __device__ __forceinline__ void a_ready(const Unit&) const {}
    __device__ __forceinline__ void done(const Unit&) const {}
};

__device__ __forceinline__ unsigned cvt_pk_bf16(float lo, float hi) { unsigned r; asm volatile("v_cvt_pk_bf16_f32 %0, %1, %2" : "=v"(r) : "v"(lo), "v"(hi)); return r; }
typedef float f32x2 __attribute__((ext_vector_type(2)));

template <class Epi, class Sched, bool ALIGN_EPI = false, bool SP2 = false>
__device__ __forceinline__ void gemm_phase(PG8_LAS unsigned char* lds, const Gemm g, const Sched& S, const Epi& E) {
    int tid_ = threadIdx.x; asm volatile("" : "+v"(tid_)); const int tid = tid_, wid = __builtin_amdgcn_readfirstlane(tid >> 6), lane = tid & 63, wr = wid >> 2, wc = wid & 3, fr = lane & 15, fq = lane >> 4;
    const int K = g.K, nt = K / BK;
    unsigned voffA[2], voffB[2];
#pragma unroll
    for (int i = 0; i < 2; ++i) { int R, C; stage_rc(tid * 16 + i * 8192, R, C); const int Rb = Epi::PERM ? ((R & ~31) + perm32(R & 31)) : R;
        voffA[i] = (unsigned)(R * K + C) * 2u; voffB[i] = (unsigned)(Rb * K + C) * 2u; }
    const size_t kstep = (size_t)(BK * 2);
    const size_t hstep = (size_t)HALF * K * 2;
    const size_t tstep = 2 * hstep;
    const unsigned ldsw = (unsigned)wid * 1024u;
    const int aoff = lds_byte(wr * 64 + fr, fq * 8), boff = lds_byte(wc * 32 + fr, fq * 8);
#define PG8_SA(b, h) (((b) * 2 + (h)) * HTB)
#define PG8_SB(b, h) ((4 + (b) * 2 + (h)) * HTB)
#define PG8_STAGE(bufoff, gbase, voff) do { _Pragma("unroll") for (int _i = 0; _i < 2; ++_i) \
        __builtin_amdgcn_global_load_lds((const unsigned*)((const char*)(gbase) + (voff)[_i]), (PG8_LAS unsigned*)(lds + (bufoff) + ldsw + _i * 8192), 16, 0, 0); } while (0)
#define PG8_LDA(dst, b, h) do { _Pragma("unroll") for (int m = 0; m < 4; ++m) _Pragma("unroll") for (int k = 0; k < 2; ++k) dst[m][k] = *(const PG8_LAS bf16x8*)(lds + PG8_SA(b, h) + aoff + m * 2048 + k * 1024); } while (0)
#define PG8_LDB(dst, b, h) do { _Pragma("unroll") for (int n = 0; n < 2; ++n) _Pragma("unroll") for (int k = 0; k < 2; ++k) dst[n][k] = *(const PG8_LAS bf16x8*)(lds + PG8_SB(b, h) + boff + n * 2048 + k * 1024); } while (0)
#define PG8_MMA(ai, bj, At, Bt) do { __builtin_amdgcn_s_setprio(1); _Pragma("unroll") for (int m = 0; m < 4; ++m) _Pragma("unroll") for (int n = 0; n < 2; ++n) _Pragma("unroll") for (int k = 0; k < 2; ++k) \
        acc[ai][bj][m][n] = __builtin_amdgcn_mfma_f32_16x16x32_bf16(Bt[n][k], At[m][k], acc[ai][bj][m][n], 0, 0, 0); __builtin_amdgcn_s_setprio(0); } while (0)
#define PG8_WAIT_V(n) asm volatile("s_waitcnt vmcnt(" #n ")" ::: "memory")
#define PG8_WAIT_L(n) asm volatile("s_waitcnt lgkmcnt(" #n ")" ::: "memory")
#define PG8_BAR __builtin_amdgcn_s_barrier()
#define PG8_SCHED __builtin_amdgcn_sched_barrier(0)
    Unit cur, nxt; int ui = 0;
    if (!S.next(0, cur)) return;
    f32x4 acc[2][2][4][2];
#pragma unroll
    for (int a = 0; a < 2; ++a)
#pragma unroll
        for (int b = 0; b < 2; ++b)
#pragma unroll
            for (int m = 0; m < 4; ++m)
#pragma unroll
                for (int n = 0; n < 2; ++n) acc[a][b][m][n] = (f32x4){0.f, 0.f, 0.f, 0.f};
    bf16x8 At[4][2], B0[2][2], B1[2][2];
    const char* cA = (const char*)g.A + (size_t)cur.pm * tstep; const char* cB = (const char*)g.Bt + (size_t)cur.pn * tstep;
    S.a_ready(cur);
    if constexpr (SP2) {
        PG8_STAGE(PG8_SB(0, 0), cB, voffB); PG8_STAGE(PG8_SB(0, 1), cB + hstep, voffB); PG8_STAGE(PG8_SA(0, 0), cA, voffA); PG8_STAGE(PG8_SA(0, 1), cA + hstep, voffA);
        if (wr == 1) PG8_BAR;
        PG8_WAIT_V(2); PG8_BAR;
        PG8_STAGE(PG8_SB(1, 0), cB + kstep, voffB); PG8_STAGE(PG8_SA(1, 0), cA + kstep, voffA); PG8_STAGE(PG8_SB(1, 1), cB + hstep + kstep, voffB);
        PG8_WAIT_V(6); PG8_BAR;
    } else {
        PG8_STAGE(PG8_SB(0, 0), cB, voffB); PG8_STAGE(PG8_SA(0, 0), cA, voffA); PG8_STAGE(PG8_SB(0, 1), cB + hstep, voffB); PG8_STAGE(PG8_SA(0, 1), cA + hstep, voffA);
        if (wr == 1) PG8_BAR;
        PG8_WAIT_V(4); PG8_BAR;
        PG8_STAGE(PG8_SB(1, 0), cB + kstep, voffB); PG8_STAGE(PG8_SA(1, 0), cA + kstep, voffA); PG8_STAGE(PG8_SB(1, 1), cB + hstep + kstep, voffB);
        PG8_WAIT_V(6); PG8_BAR;
    }
    for (;;) {
        const bool has_next = S.next(ui + 1, nxt);
        const char* nA = has_next ? (const char*)g.A + (size_t)nxt.pm * tstep : cA; const char* nB = has_next ? (const char*)g.Bt + (size_t)nxt.pn * tstep : cB;
        for (int t = 0; t < nt; t += 2) {
            const bool last = (t == nt - 2);
            const char* a1 = cA + (size_t)(t + 1) * kstep;
            const char* a2 = last ? nA : cA + (size_t)(t + 2) * kstep; const char* b2 = last ? nB : cB + (size_t)(t + 2) * kstep;
            const char* a3 = a2 + kstep; const char* b3 = b2 + kstep;
            if (last && has_next) S.a_ready(nxt);
            if constexpr (SP2) {
            PG8_LDB(B0, 0, 0); PG8_LDB(B1, 0, 1); PG8_SCHED; PG8_LDA(At, 0, 0); PG8_STAGE(PG8_SA(1, 1), a1 + hstep, voffA);
            PG8_WAIT_V(8); PG8_WAIT_L(0); PG8_BAR; PG8_MMA(0, 0, At, B0); PG8_MMA(0, 1, At, B1); PG8_BAR; PG8_SCHED;
            PG8_LDA(At, 0, 1); PG8_STAGE(PG8_SB(0, 0), b2, voffB); PG8_STAGE(PG8_SB(0, 1), b2 + hstep, voffB); PG8_STAGE(PG8_SA(0, 0), a2, voffA);
            PG8_WAIT_V(8); PG8_WAIT_L(0); PG8_BAR; PG8_MMA(1, 0, At, B0); PG8_MMA(1, 1, At, B1); PG8_BAR; PG8_SCHED;
            PG8_LDB(B0, 1, 0); PG8_LDB(B1, 1, 1); PG8_SCHED; PG8_LDA(At, 1, 0); PG8_STAGE(PG8_SA(0, 1), a2 + hstep, voffA);
            PG8_WAIT_V(8); PG8_WAIT_L(0); PG8_BAR; PG8_MMA(0, 0, At, B0); PG8_MMA(0, 1, At, B1); PG8_BAR; PG8_SCHED;
            PG8_LDA(At, 1, 1); PG8_STAGE(PG8_SB(1, 0), b3, voffB); PG8_STAGE(PG8_SB(1, 1), b3 + hstep, voffB); PG8_STAGE(PG8_SA(1, 0), a3, voffA);
            PG8_WAIT_V(8); PG8_WAIT_L(0); PG8_BAR; PG8_MMA(1, 0, At, B0); PG8_MMA(1, 1, At, B1); PG8_BAR; PG8_SCHED;
            } else {
            PG8_LDB(B0, 0, 0); PG8_SCHED; PG8_LDA(At, 0, 0); PG8_STAGE(PG8_SA(1, 1), a1 + hstep, voffA);
            PG8_WAIT_L(8); PG8_BAR; PG8_WAIT_L(0); PG8_MMA(0, 0, At, B0); PG8_BAR; PG8_SCHED;
            PG8_LDB(B1, 0, 1); PG8_STAGE(PG8_SB(0, 0), b2, voffB);
            PG8_BAR; PG8_WAIT_L(0); PG8_MMA(0, 1, At, B1); PG8_BAR;
            PG8_LDA(At, 0, 1); PG8_STAGE(PG8_SA(0, 0), a2, voffA);
            PG8_BAR; PG8_WAIT_L(0); PG8_MMA(1, 0, At, B0); PG8_BAR; PG8_SCHED;
            PG8_STAGE(PG8_SB(0, 1), b2 + hstep, voffB);
            PG8_WAIT_V(6); PG8_BAR; PG8_MMA(1, 1, At, B1); PG8_BAR;
            PG8_LDB(B0, 1, 0); PG8_SCHED; PG8_LDA(At, 1, 0); PG8_STAGE(PG8_SA(0, 1), a2 + hstep, voffA);
            PG8_WAIT_L(8); PG8_BAR; PG8_WAIT_L(0); PG8_MMA(0, 0, At, B0); PG8_BAR; PG8_SCHED;
            PG8_LDB(B1, 1, 1); PG8_STAGE(PG8_SB(1, 0), b3, voffB);
            PG8_BAR; PG8_WAIT_L(0); PG8_MMA(0, 1, At, B1); PG8_BAR;
            PG8_LDA(At, 1, 1); PG8_STAGE(PG8_SA(1, 0), a3, voffA);
            PG8_BAR; PG8_WAIT_L(0); PG8_MMA(1, 0, At, B0); PG8_BAR; PG8_SCHED;
            PG8_STAGE(PG8_SB(1, 1), b3 + hstep, voffB);
            PG8_WAIT_V(6); PG8_BAR; PG8_MMA(1, 1, At, B1); PG8_BAR;
            }
        }
        if constexpr (ALIGN_EPI) { if (wr == 0) PG8_BAR; }
        if constexpr (!Epi::AFTER_DRAIN) { E(acc, cur, wr, wc, fr, fq); S.done(cur); }
        if (!has_next) break;
#pragma unroll
        for (int a = 0; a < 2; ++a)
#pragma unroll
            for (int b = 0; b < 2; ++b)
#pragma unroll
                for (int m = 0; m < 4; ++m)
#pragma unroll
                    for (int n = 0; n < 2; ++n) acc[a][b][m][n] = (f32x4){0.f, 0.f, 0.f, 0.f};
        cur = nxt; cA = nA; cB = nB; ++ui;
        if constexpr (ALIGN_EPI) { if (wr == 1) PG8_BAR; }
    }
    PG8_WAIT_V(0);
    if constexpr (!ALIGN_EPI) { if (wr == 0) PG8_BAR; }
    PG8_BAR;
    if constexpr (Epi::AFTER_DRAIN) { E.fused(acc, cur, wr, wc, fr, fq, lds, wid, lane); S.done(cur); }
#undef PG8_SA
#undef PG8_SB
#undef PG8_STAGE
#undef PG8_LDA
#undef PG8_LDB
#undef PG8_MMA
#undef PG8_WAIT_V
#undef PG8_WAIT_L
#undef PG8_BAR
#undef PG8_SCHED
}

}
namespace mk {
using pg8::bf16_t; using pg8::bf16x8; using pg8::f32x4; using pg8::u32x4; using pg8::cvt_pk_bf16;
typedef float f32x16 __attribute__((ext_vector_type(16)));
typedef float f32x2 __attribute__((ext_vector_type(2)));
typedef unsigned u32x2 __attribute__((ext_vector_type(2)));
constexpr int D = 1024, NB = 32, SEQ = 2048, M = NB * SEQ, NH = 8, DH = 64;
constexpr int RWC = 1792, GC = 2048, INC = 5376, DFF = 2816;
constexpr float RMS_EPS = 1e-6f, GN_EPS = 64e-5f;
constexpr size_t MiB = (size_t)1 << 20;
constexpr size_t O_WIN = 0, O_WSB = 11 * MiB, O_WRW = 12 * MiB, O_WO = 13 * MiB, O_WGU = 15 * MiB, O_WDN = 26 * MiB, O_WLU = 32 * MiB  , O_WLA = O_WLU + 65536, O_WLG = O_WLA + 65536;
constexpr size_t O_Q = 34 * MiB, O_K = 98 * MiB, O_VT = 162 * MiB, O_PRW = 226 * MiB, O_H = 450 * MiB, O_SI = 450 * MiB, O_G = 834 * MiB, O_SC = 898 * MiB, O_YR = 290 * MiB  ;
constexpr size_t O_OSB = 226 * MiB, O_ORW = 34 * MiB, O_T1 = 98 * MiB, O_MRG = 450 * MiB, O_TT = 34 * MiB, O_H2 = 162 * MiB, O_HID = 290 * MiB, O_FF = 34 * MiB;
constexpr size_t O_X1B = 706 * MiB;
constexpr size_t WS_NEED = 1009 * MiB;
constexpr int LDS_BYTES = pg8::STAGE_BYTES + 64;
constexpr size_t O_CTL = 1008 * MiB, CTL_BYTES = 65536;
constexpr int NPH = 12;

struct Args { const float* in[24]; float* out; unsigned char* ws; int ph_lo, ph_hi; };

__device__ __forceinline__ int my_tid() { int t = threadIdx.x; asm volatile("" : "+v"(t)); return t; }
__device__ __forceinline__ float bf_lo(unsigned u) { return __uint_as_float(u << 16); }
__device__ __forceinline__ float bf_hi(unsigned u) { return __uint_as_float(u & 0xffff0000u); }
__device__ __forceinline__ float fexp(float x) { return __builtin_amdgcn_exp2f(x * 1.44269504089f); }
__device__ __forceinline__ float flog(float x) { return __builtin_amdgcn_logf(x) * 0.69314718056f; }
__device__ __forceinline__ float frcp(float x) { return __builtin_amdgcn_rcpf(x); }
__device__ __forceinline__ float fsigmoid(float x) { return frcp(1.f + fexp(-x)); }
__device__ __forceinline__ unsigned short bf1(float x) { return (unsigned short)(cvt_pk_bf16(x, x) & 0xffffu); }
__device__ __forceinline__ u32x4 pack8(const f32x4 a, const f32x4 b) { u32x4 o; o.x = cvt_pk_bf16(a[0], a[1]); o.y = cvt_pk_bf16(a[2], a[3]); o.z = cvt_pk_bf16(b[0], b[1]); o.w = cvt_pk_bf16(b[2], b[3]); return o; }
__device__ __forceinline__ float red16(float v) {
    v += __shfl_xor(v, 16); v += __shfl_xor(v, 32); return v;
}
__device__ __forceinline__ float wave_sum(float v) {
#pragma unroll
    for (int o = 1; o < 64; o <<= 1) v += __shfl_xor(v, o);
    return v;
}

__device__ __forceinline__ void tr_item(const float* __restrict__ W, int K, int N, bf16_t* WT, float* scr, int item, int lane, int mode) {
    const int nblk = N >> 5, kb = item / nblk, nb = item - kb * nblk, k0 = kb << 6, n0 = nb << 5;
#pragma unroll 8
    for (int i = 0; i < 32; ++i) { const int kk = 2 * i + (lane >> 5); scr[kk * 33 + (lane & 31)] = W[(size_t)(k0 + kk) * N + n0 + (lane & 31)]; }
    asm volatile("s_waitcnt lgkmcnt(0)" ::: "memory"); __builtin_amdgcn_wave_barrier();
    const int c = lane & 7;
#pragma unroll
    for (int j = 0; j < 4; ++j) {
        const int n = (lane >> 3) + 8 * j; const float* s = scr + (8 * c) * 33 + n;
        u32x4 o; o.x = cvt_pk_bf16(s[0 * 33], s[1 * 33]); o.y = cvt_pk_bf16(s[2 * 33], s[3 * 33]); o.z = cvt_pk_bf16(s[4 * 33], s[5 * 33]); o.w = cvt_pk_bf16(s[6 * 33], s[7 * 33]);
        const int nn = n0 + n; int drow = nn;
        if (mode == 1) drow = ((nn >> 7) << 8) + (nn & 127); else if (mode == 2) drow = ((nn >> 7) << 8) + 128 + (nn & 127);
        *(u32x4*)(WT + (size_t)drow * K + k0 + 8 * c) = o;
    }
    asm volatile("s_waitcnt lgkmcnt(0)" ::: "memory"); __builtin_amdgcn_wave_barrier();
}

__device__ __forceinline__ void phase_prep(const Args& a, float* lds_f, int G) {
    const int tid = my_tid(); const int wave = tid >> 6, lane = tid & 63;
    const int gw = blockIdx.x * 8 + wave, NGW = G * 8;
    float* scr = lds_f + wave * (64 * 33 + 16);
    unsigned char* ws = a.ws;
    constexpr int I_IN = 16 * 168, I_SB = 8 * 32, I_O = 16 * 32, I_G = 16 * 88, I_DN = 44 * 32, I_LU = 16, I_LG = 32;
    constexpr int NIT = I_IN + 2 * I_SB + I_O + 2 * I_G + I_DN + 2 * I_LU + I_LG;
    for (int it = gw; it < NIT; it += NGW) {
        int r = it;
        if (r < I_IN) { tr_item(a.in[2], 1024, INC, (bf16_t*)(ws + O_WIN), scr, r, lane, 0); continue; } r -= I_IN;
        if (r < I_SB) { tr_item(a.in[15], 512, 1024, (bf16_t*)(ws + O_WSB), scr, r, lane, 0); continue; } r -= I_SB;
        if (r < I_SB) { tr_item(a.in[16], 512, 1024, (bf16_t*)(ws + O_WRW), scr, r, lane, 0); continue; } r -= I_SB;
        if (r < I_O) { tr_item(a.in[17], 1024, 1024, (bf16_t*)(ws + O_WO), scr, r, lane, 0); continue; } r -= I_O;
        if (r < I_G) { tr_item(a.in[20], 1024, DFF, (bf16_t*)(ws + O_WGU), scr, r, lane, 1); continue; } r -= I_G;
        if (r < I_G) { tr_item(a.in[21], 1024, DFF, (bf16_t*)(ws + O_WGU), scr, r, lane, 2); continue; } r -= I_G;
        if (r < I_DN) { tr_item(a.in[22], DFF, 1024, (bf16_t*)(ws + O_WDN), scr, r, lane, 0); continue; } r -= I_DN;
        if (r < I_LU) { tr_item(a.in[6], 64, 512, (bf16_t*)(ws + O_WLU), scr, r, lane, 0); continue; } r -= I_LU;
        if (r < I_LU) { tr_item(a.in[8], 64, 512, (bf16_t*)(ws + O_WLA), scr, r, lane, 0); continue; } r -= I_LU;
        tr_item(a.in[9], 128, 512, (bf16_t*)(ws + O_WLG), scr, r, lane, 0);
    }
    const float* x = a.in[0]; const float* g = a.in[1]; bf16_t* H = (bf16_t*)(ws + O_H);
    f32x4 gv[4];
#pragma unroll
    for (int j = 0; j < 4; ++j) gv[j] = ((const f32x4*)g)[lane + 64 * j];
    for (int row0 = gw; row0 < M; row0 += 2 * NGW) {
        f32x4 v[2][4];
#pragma unroll
        for (int u = 0; u < 2; ++u) { const int row = (row0 + u * NGW < M) ? row0 + u * NGW : row0; const f32x4* xr = (const f32x4*)(x + (size_t)row * D) + lane;
#pragma unroll
            for (int j = 0; j < 4; ++j) v[u][j] = xr[64 * j]; }
#pragma unroll
        for (int u = 0; u < 2; ++u) { const int row = row0 + u * NGW; float s = 0.f;
#pragma unroll
            for (int j = 0; j < 4; ++j) s += (v[u][j][0] * v[u][j][0] + v[u][j][1] * v[u][j][1]) + (v[u][j][2] * v[u][j][2] + v[u][j][3] * v[u][j][3]);
            const float rs = rsqrtf(wave_sum(s) * (1.f / D) + RMS_EPS);
            if (row < M) { u32x2* o = (u32x2*)(H + (size_t)row * D) + lane;
#pragma unroll
                for (int j = 0; j < 4; ++j) { u32x2 w; w.x = cvt_pk_bf16(v[u][j][0] * rs * gv[j][0], v[u][j][1] * rs * gv[j][1]); w.y = cvt_pk_bf16(v[u][j][2] * rs * gv[j][2], v[u][j][3] * rs * gv[j][3]); o[64 * j] = w; } }
        }
    }
}

struct Epi1 {
    static constexpr bool PERM = true, AFTER_DRAIN = false;
    bf16_t *Q, *Kb, *Vt, *Prw, *Gt; const float* bgate;
    __device__ __forceinline__ void operator()(const f32x4 (&acc)[2][2][4][2], const pg8::Unit& u, int wr, int wc, int fr, int fq) const {
        const int row0 = u.pm * 256 + wr * 64 + fr, pn = u.pn, cl = wc * 32 + 8 * fq;
        if (pn < 4) {
            bf16_t* dst = pn < 2 ? Q : Kb; const float sc = pn < 2 ? 0.125f : 1.f; const int cb = (pn & 1) * 256 + cl;
#pragma unroll
            for (int ai = 0; ai < 2; ++ai)
#pragma unroll
                for (int m = 0; m < 4; ++m) { bf16_t* rp = dst + (size_t)(row0 + ai * 128 + m * 16) * 512 + cb;
#pragma unroll
                    for (int bj = 0; bj < 2; ++bj) *(u32x4*)(rp + bj * 128) = pack8(acc[ai][bj][m][0] * sc, acc[ai][bj][m][1] * sc); }
        } else if (pn < 6) {
#pragma unroll
            for (int ai = 0; ai < 2; ++ai)
#pragma unroll
                for (int m = 0; m < 4; ++m) { const int row = row0 + ai * 128 + m * 16, b = row >> 11, s = row & 2047;
#pragma unroll
                    for (int bj = 0; bj < 2; ++bj)
#pragma unroll
                        for (int n = 0; n < 2; ++n)
#pragma unroll
                            for (int j = 0; j < 4; ++j) { const int c = (pn - 4) * 256 + bj * 128 + cl + 4 * n + j;
                                Vt[((size_t)(b * 512 + c)) * 2048 + s] = bf1(acc[ai][bj][m][n][j]); } }
        } else if (pn < 13) {
            const int cb = (pn - 6) * 256 + cl;
#pragma unroll
            for (int ai = 0; ai < 2; ++ai)
#pragma unroll
                for (int m = 0; m < 4; ++m) { bf16_t* rp = Prw + (size_t)(row0 + ai * 128 + m * 16) * RWC + cb;
#pragma unroll
                    for (int bj = 0; bj < 2; ++bj) *(u32x4*)(rp + bj * 128) = pack8(acc[ai][bj][m][0], acc[ai][bj][m][1]); }
        } else {
            const int cb = (pn - 13) * 256 + cl;
#pragma unroll
            for (int ai = 0; ai < 2; ++ai)
#pragma unroll
                for (int m = 0; m < 4; ++m) { bf16_t* rp = Gt + (size_t)(row0 + ai * 128 + m * 16) * GC + cb;
#pragma unroll
                    for (int bj = 0; bj < 2; ++bj) { f32x4 v0 = acc[ai][bj][m][0] + *(const f32x4*)(bgate + cb + bj * 128), v1 = acc[ai][bj][m][1] + *(const f32x4*)(bgate + cb + bj * 128 + 4);
#pragma unroll
                        for (int j = 0; j < 4; ++j) { v0[j] = fsigmoid(v0[j]); v1[j] = fsigmoid(v1[j]); }
                        *(u32x4*)(rp + bj * 128) = pack8(v0, v1); } }
        }
    }
};
template <int MODE> struct EpiRow {
    static constexpr bool PERM = true, AFTER_DRAIN = false;
    bf16_t* O; const bf16_t* T1; const bf16_t* Gt;
    __device__ __forceinline__ void operator()(const f32x4 (&acc)[2][2][4][2], const pg8::Unit& u, int wr, int wc, int fr, int fq) const {
        const int row0 = u.pm * 256 + wr * 64 + fr, cb = u.pn * 256 + wc * 32 + 8 * fq;
#pragma unroll
        for (int ai = 0; ai < 2; ++ai)
#pragma unroll
            for (int m = 0; m < 4; ++m) { const size_t row = (size_t)(row0 + ai * 128 + m * 16);
#pragma unroll
                for (int bj = 0; bj < 2; ++bj) { f32x4 v0 = acc[ai][bj][m][0], v1 = acc[ai][bj][m][1]; const int c = cb + bj * 128;
                    if (MODE >= 1) { const u32x4 gg = *(const u32x4*)(Gt + row * GC + (MODE == 2 ? 1024 : 0) + c);
                        v0[0] *= bf_lo(gg.x); v0[1] *= bf_hi(gg.x); v0[2] *= bf_lo(gg.y); v0[3] *= bf_hi(gg.y); v1[0] *= bf_lo(gg.z); v1[1] *= bf_hi(gg.z); v1[2] *= bf_lo(gg.w); v1[3] *= bf_hi(gg.w); }
                    if (MODE == 2) { const u32x4 tt = *(const u32x4*)(T1 + row * 1024 + c);
                        v0[0] += bf_lo(tt.x); v0[1] += bf_hi(tt.x); v0[2] += bf_lo(tt.y); v0[3] += bf_hi(tt.y); v1[0] += bf_lo(tt.z); v1[1] += bf_hi(tt.z); v1[2] += bf_lo(tt.w); v1[3] += bf_hi(tt.w); }
                    *(u32x4*)(O + row * 1024 + c) = pack8(v0, v1); } }
    }
};
struct EpiSwiGLU {
    static constexpr bool PERM = true, AFTER_DRAIN = false;
    bf16_t* Hd;
    __device__ __forceinline__ void operator()(const f32x4 (&acc)[2][2][4][2], const pg8::Unit& u, int wr, int wc, int fr, int fq) const {
        const int row0 = u.pm * 256 + wr * 64 + fr, cb = u.pn * 128 + wc * 32 + 8 * fq;
#pragma unroll
        for (int ai = 0; ai < 2; ++ai)
#pragma unroll
            for (int m = 0; m < 4; ++m) { f32x4 v0, v1;
#pragma unroll
                for (int j = 0; j < 4; ++j) { const float g0 = acc[ai][0][m][0][j], g1 = acc[ai][0][m][1][j];
                    v0[j] = g0 * fsigmoid(g0) * acc[ai][1][m][0][j]; v1[j] = g1 * fsigmoid(g1) * acc[ai][1][m][1][j]; }
                *(u32x4*)(Hd + (size_t)(row0 + ai * 128 + m * 16) * DFF + cb) = pack8(v0, v1); }
    }
};
template <class Epi> __device__ __forceinline__ void run_gemm(PG8_LAS unsigned char* lds, const bf16_t* A, const bf16_t* Bt, int N, int K, const Epi& E, int G) {
    pg8::Gemm g; g.A = A; g.Bt = Bt; g.M = M; g.N = N; g.K = K;
    pg8::StaticOrder S; S.init(M, N, G, (int)blockIdx.x);
    pg8::gemm_phase<Epi, pg8::StaticOrder, true, true>(lds, g, S, E);
}
__device__ __forceinline__ void mix8_lds(const unsigned char* cur, const unsigned char* prv, const float* mu, float (&o)[8]) {
    const u32x4 c = *(const u32x4*)cur, p = *(const u32x4*)prv;
    const f32x4 m0 = *(const f32x4*)mu, m1 = *(const f32x4*)(mu + 4);
    const float mm[8] = {m0[0], m0[1], m0[2], m0[3], m1[0], m1[1], m1[2], m1[3]};
#pragma unroll
    for (int i = 0; i < 4; ++i) { const float cl = bf_lo(c[i]), ch = bf_hi(c[i]), pl = bf_lo(p[i]), ph = bf_hi(p[i]);
        o[2 * i] = cl + (pl - cl) * mm[2 * i]; o[2 * i + 1] = ch + (ph - ch) * mm[2 * i + 1]; }
}
__device__ __forceinline__ void mix4_lds(const unsigned char* cur, const unsigned char* prv, const float* mu, float (&o)[4]) {
    const u32x2 c = *(const u32x2*)cur, p = *(const u32x2*)prv;
    const f32x4 m0 = *(const f32x4*)mu;
#pragma unroll
    for (int i = 0; i < 2; ++i) { const float cl = bf_lo(c[i]), ch = bf_hi(c[i]), pl = bf_lo(p[i]), ph = bf_hi(p[i]);
        o[2 * i] = cl + (pl - cl) * m0[2 * i]; o[2 * i + 1] = ch + (ph - ch) * m0[2 * i + 1]; }
}
__device__ __forceinline__ bf16x8 pack_frag(const float (&v)[8]) {
    u32x4 o; o.x = cvt_pk_bf16(v[0], v[1]); o.y = cvt_pk_bf16(v[2], v[3]); o.z = cvt_pk_bf16(v[4], v[5]); o.w = cvt_pk_bf16(v[6], v[7]);
    return __builtin_bit_cast(bf16x8, o);
}
__device__ __forceinline__ void phase_rwprep(const Args& a, unsigned char* lds, int G) {
    constexpr int ROWB = 3600, L_FRAG = 17 * ROWB, L_PAR = L_FRAG + 8192, NCH = 17 * 224, NT = M / 16;
    const int tid = my_tid(); const int wave = __builtin_amdgcn_readfirstlane(tid >> 6), lane = tid & 63, fr = lane & 15, fq = lane >> 4;
    unsigned char* ws = a.ws;
    const unsigned char* PRW = ws + O_PRW;
    const bf16_t* WLU = (const bf16_t*)(ws + O_WLU); const bf16_t* WLA = (const bf16_t*)(ws + O_WLA); const bf16_t* WLG = (const bf16_t*)(ws + O_WLG);
    unsigned char* SI = ws + O_SI; bf16_t* GB = (bf16_t*)(ws + O_G); float* SC = (float*)(ws + O_SC);
    float* par = (float*)(lds + L_PAR);
    for (int i = tid; i < 1792 + 5 * 512; i += 512) {
        float v;
        if (i < 1792) v = a.in[4][i]; else { const int j = i - 1792, w = j >> 9, c = j & 511; v = (w == 0 ? a.in[5] : w == 1 ? a.in[7] : w == 2 ? a.in[10] : w == 3 ? a.in[11] : a.in[12])[c]; }
        par[i] = v;
    }
    for (int tile = blockIdx.x; tile < NT; tile += G) {
        __syncthreads();
        {   u32x4 pre[8];
#pragma unroll
            for (int j = 0; j < 8; ++j) { const int c = tid + 512 * j; pre[j] = (u32x4){0u, 0u, 0u, 0u};
                if (c < NCH) { const int row = c / 224, col = c - row * 224; const bool zero = (row == 0) && (((tile * 16) & (SEQ - 1)) == 0);
                    if (!zero) pre[j] = *(const u32x4*)(PRW + ((size_t)tile * 16 + row - 1) * (RWC * 2) + col * 16); } }
#pragma unroll
            for (int j = 0; j < 8; ++j) { const int c = tid + 512 * j; if (c < NCH) { const int row = c / 224, col = c - row * 224; *(u32x4*)(lds + row * ROWB + col * 16) = pre[j]; } }
        }
        __syncthreads();
        const unsigned char* rcur = lds + (fr + 1) * ROWB; const unsigned char* rprv = lds + fr * ROWB;
        {
            const int colb = wave < 2 ? 1536 + 32 * wave : (wave < 4 ? 1600 + 32 * (wave - 2) : 1664 + 32 * (wave - 4));
            float t8[8]; mix8_lds(rcur + (colb + 8 * fq) * 2, rprv + (colb + 8 * fq) * 2, par + colb + 8 * fq, t8);
            if (wave < 2) {
#pragma unroll
                for (int i = 0; i < 8; ++i) { const float e = fexp(2.f * t8[i]); t8[i] = 1.f - 2.f * frcp(e + 1.f); } }
            else if (wave >= 4) {
#pragma unroll
                for (int i = 0; i < 8; ++i) t8[i] = fsigmoid(t8[i]); }
            *(bf16x8*)(lds + L_FRAG + wave * 1024 + lane * 16) = pack_frag(t8);
        }
        __syncthreads();
        bf16x8 Aw[2], Aa[2], Ag[4];
#pragma unroll
        for (int s = 0; s < 2; ++s) { Aw[s] = *(const bf16x8*)(lds + L_FRAG + s * 1024 + lane * 16); Aa[s] = *(const bf16x8*)(lds + L_FRAG + (2 + s) * 1024 + lane * 16); }
#pragma unroll
        for (int s = 0; s < 4; ++s) Ag[s] = *(const bf16x8*)(lds + L_FRAG + (4 + s) * 1024 + lane * 16);
        const int h = wave; const size_t m = (size_t)tile * 16 + fr;
        float kkr[16], av[16]; unsigned lk[16], rvp[16];
        float ss = 0.f, brs = 0.f, krs = 0.f, rkbs = 0.f;
#pragma unroll
        for (int n = 0; n < 4; ++n) {
            asm volatile("" ::: "memory");
            const int cb = 64 * h + 16 * n, c0 = cb + 4 * fq;
            f32x4 aw = {0.f, 0.f, 0.f, 0.f}, aa = aw, ag = aw;
#pragma unroll
            for (int s = 0; s < 2; ++s) {
                aw = __builtin_amdgcn_mfma_f32_16x16x32_bf16(*(const bf16x8*)(WLU + (size_t)(cb + fr) * 64 + 32 * s + 8 * fq), Aw[s], aw, 0, 0, 0);
                aa = __builtin_amdgcn_mfma_f32_16x16x32_bf16(*(const bf16x8*)(WLA + (size_t)(cb + fr) * 64 + 32 * s + 8 * fq), Aa[s], aa, 0, 0, 0); }
#pragma unroll
            for (int s = 0; s < 4; ++s)
                ag = __builtin_amdgcn_mfma_f32_16x16x32_bf16(*(const bf16x8*)(WLG + (size_t)(cb + fr) * 128 + 32 * s + 8 * fq), Ag[s], ag, 0, 0, 0);
            float rr[4], kr4[4], vv[4];
            mix4_lds(rcur + c0 * 2, rprv + c0 * 2, par + c0, rr); mix4_lds(rcur + (512 + c0) * 2, rprv + (512 + c0) * 2, par + 512 + c0, kr4); mix4_lds(rcur + (1024 + c0) * 2, rprv + (1024 + c0) * 2, par + 1024 + c0, vv);
            const f32x4 w0v = *(const f32x4*)(par + 1792 + c0), a0v = *(const f32x4*)(par + 2304 + c0), kkv = *(const f32x4*)(par + 2816 + c0), kav = *(const f32x4*)(par + 3328 + c0), rkv = *(const f32x4*)(par + 3840 + c0);
#pragma unroll
            for (int j = 0; j < 4; ++j) {
                const float sg = fsigmoid(w0v[j] + aw[j]);
                const float ldx = -0.60653065971f * 1.44269504089f * sg;
                const float av_ = fsigmoid(a0v[j] + aa[j]);
                const float kkraw = kr4[j] * kkv[j];
                const float k2 = kr4[j] * (1.f + (av_ - 1.f) * kav[j]);
                ss += kkraw * kkraw; brs += kkraw * av_ * rr[j]; krs += k2 * rr[j]; rkbs += rr[j] * k2 * rkv[j];
                kkr[4 * n + j] = kkraw; av[4 * n + j] = av_; lk[4 * n + j] = cvt_pk_bf16(ldx, k2); rvp[4 * n + j] = cvt_pk_bf16(rr[j], vv[j]);
            }
            u32x2 gp; gp.x = cvt_pk_bf16(ag[0], ag[1]); gp.y = cvt_pk_bf16(ag[2], ag[3]);
            *(u32x2*)(GB + m * 512 + c0) = gp;
        }
        ss = red16(ss); brs = red16(brs); krs = red16(krs); rkbs = red16(rkbs);
        const float inv = 1.f / fmaxf(sqrtf(ss), 1e-12f);
        unsigned char* rec = SI + ((m * 8 + h) * 64) * 12;
#pragma unroll
        for (int n = 0; n < 4; ++n) {
            unsigned dw[12];
#pragma unroll
            for (int j = 0; j < 4; ++j) { const float kk = kkr[4 * n + j] * inv;
                const unsigned kp = cvt_pk_bf16(kk * av[4 * n + j], -kk);
                dw[3 * j] = (lk[4 * n + j] & 0xffffu) | (kp & 0xffff0000u); dw[3 * j + 1] = (kp & 0xffffu) | (lk[4 * n + j] & 0xffff0000u); dw[3 * j + 2] = rvp[4 * n + j]; }
            u32x4* dst = (u32x4*)(rec + (16 * n + 4 * fq) * 12);
            u32x4 s0 = {dw[0], dw[1], dw[2], dw[3]}, s1 = {dw[4], dw[5], dw[6], dw[7]}, s2 = {dw[8], dw[9], dw[10], dw[11]};
            dst[0] = s0; dst[1] = s1; dst[2] = s2;
        }
        if (fq == 0) { f32x4 scv = {brs * inv, krs, rkbs, 0.f}; *(f32x4*)(SC + (m * 8 + h) * 4) = scv; }
    }
    __syncthreads();
}

__device__ __forceinline__ float red_rows(float x) {
    float a0 = x, a1 = x;
    asm volatile("s_nop 1\n\tv_permlane16_swap_b32 %0, %1" : "+v"(a0), "+v"(a1));
    float b0 = a0 + a1, b1 = b0;
    asm volatile("s_nop 1\n\tv_permlane32_swap_b32 %0, %1" : "+v"(b0), "+v"(b1));
    return b0 + b1;
}
constexpr int SC_T = 16, SC_ROW = 1552, SC_BUF = SC_T * SC_ROW;
struct ProdRec { unsigned d0, d1, d2; f32x2 sc; };
__device__ __forceinline__ void prod_load(ProdRec (&P)[4], const unsigned char* sb, const float* scp, int chunk, int pl) {
    const int col = pl & 63;
#pragma unroll
    for (int q = 0; q < 4; ++q) { const size_t t = (size_t)chunk * SC_T + (pl >> 6) + 4 * q;
        const unsigned* p = (const unsigned*)(sb + t * 6144 + col * 12); P[q].d0 = p[0]; P[q].d1 = p[1]; P[q].d2 = p[2];
        P[q].sc = (f32x2){0.f, 0.f}; if (col == 0) P[q].sc = *(const f32x2*)(scp + t * 32); }
}
__device__ __forceinline__ void prod_store(const ProdRec (&P)[4], unsigned char* buf, int pl) {
    const int col = pl & 63;
#pragma unroll
    for (int q = 0; q < 4; ++q) { unsigned char* base = buf + ((pl >> 6) + 4 * q) * SC_ROW + col * 4;
        const float w = __builtin_amdgcn_exp2f(bf_lo(P[q].d0));
        *(float*)(base) = bf_hi(P[q].d0); *(float*)(base + 256) = w * bf_lo(P[q].d2); *(float*)(base + 512) = w;
        *(float*)(base + 768) = bf_lo(P[q].d1); *(float*)(base + 1024) = bf_hi(P[q].d1); *(float*)(base + 1280) = bf_hi(P[q].d2);
        if (col == 0) *(f32x2*)(base + 1536) = P[q].sc; }
}
#define MK_SWAP32(a, b) asm volatile("s_nop 1\n\tv_permlane32_swap_b32 %0, %1" : "+v"(a), "+v"(b))
#define MK_SWAP16(a, b) asm volatile("s_nop 1\n\tv_permlane16_swap_b32 %0, %1" : "+v"(a), "+v"(b))
__device__ __forceinline__ void red4x8(float& A, float& B, float& C, float& D) {
    MK_SWAP32(A, B); float u = A + B;
    MK_SWAP32(C, D); float w = C + D;
    MK_SWAP16(u, w); float z = u + w;
    float z1;
    asm volatile("s_nop 1\n\tv_add_f32_dpp %0, %1, %1 row_ror:8 row_mask:0xf bank_mask:0xf" : "=&v"(z1) : "v"(z));
    float p = z1, q = z1; MK_SWAP32(p, q);
    float p2 = p; MK_SWAP16(p, p2);
    float q2 = q; MK_SWAP16(q, q2);
    A = p; C = p2; B = q; D = q2;
}
__device__ __forceinline__ void scan_consume(f32x2 (&S)[8], const unsigned char* buf, unsigned* yr, int lane, int rb) {
    const unsigned co = (unsigned)(lane >> 3) * 32u, vo = 1280u + (unsigned)(16 * rb + (lane & 7)) * 4u;
#pragma unroll 2
    for (int st = 0; st < SC_T; ++st) {
        const unsigned char* sb = buf + st * SC_ROW;
        f32x4 n4[2], r4[2], w4[2], a4[2], k4[2];
#pragma unroll
        for (int q = 0; q < 2; ++q) { n4[q] = *(const f32x4*)(sb + co + 16 * q); r4[q] = *(const f32x4*)(sb + 256 + co + 16 * q); w4[q] = *(const f32x4*)(sb + 512 + co + 16 * q);
            a4[q] = *(const f32x4*)(sb + 768 + co + 16 * q); k4[q] = *(const f32x4*)(sb + 1024 + co + 16 * q); }
        const float v0 = *(const float*)(sb + vo), v1 = *(const float*)(sb + vo + 32); const f32x2 bk = *(const f32x2*)(sb + 1536);
        f32x2 sa0v = {0.f, 0.f}, sa1v = sa0v, yp0v = sa0v, yp1v = sa0v;
#pragma unroll
        for (int p = 0; p < 4; ++p) { const f32x2 nn = {n4[p >> 1][2 * (p & 1)], n4[p >> 1][2 * (p & 1) + 1]}, rr2 = {r4[p >> 1][2 * (p & 1)], r4[p >> 1][2 * (p & 1) + 1]};
            sa0v += S[p] * nn; sa1v += S[4 + p] * nn; yp0v += S[p] * rr2; yp1v += S[4 + p] * rr2; }
        float sa0 = sa0v[0] + sa0v[1], sa1 = sa1v[0] + sa1v[1], yp0 = yp0v[0] + yp0v[1], yp1 = yp1v[0] + yp1v[1];
        red4x8(sa0, sa1, yp0, yp1);
        const f32x2 s0 = {sa0, sa0}, s1 = {sa1, sa1}, vv0 = {v0, v0}, vv1 = {v1, v1};
#pragma unroll
        for (int p = 0; p < 4; ++p) { const f32x2 ww = {w4[p >> 1][2 * (p & 1)], w4[p >> 1][2 * (p & 1) + 1]}; S[p] = S[p] * ww; S[4 + p] = S[4 + p] * ww; }
        asm volatile("" ::: "memory");
#pragma unroll
        for (int p = 0; p < 4; ++p) { const f32x2 aa = {a4[p >> 1][2 * (p & 1)], a4[p >> 1][2 * (p & 1) + 1]}; S[p] = __builtin_elementwise_fma(aa, s0, S[p]); S[4 + p] = __builtin_elementwise_fma(aa, s1, S[4 + p]); }
        asm volatile("" ::: "memory");
#pragma unroll
        for (int p = 0; p < 4; ++p) { const f32x2 kk = {k4[p >> 1][2 * (p & 1)], k4[p >> 1][2 * (p & 1) + 1]}; S[p] = __builtin_elementwise_fma(kk, vv0, S[p]); S[4 + p] = __builtin_elementwise_fma(kk, vv1, S[4 + p]); }
        const float y0 = yp0 + sa0 * bk[0] + v0 * bk[1], y1 = yp1 + sa1 * bk[0] + v1 * bk[1];
        if (lane < 16) { const bool hi = (lane & 8) != 0;
            yr[(size_t)st * 512 + lane] = (unsigned)bf1(hi ? y1 : y0) | (__float_as_uint(hi ? v1 : v0) & 0xffff0000u); }
    }
}

__device__ __forceinline__ void rwpost_local(const Args& a, int bh, int tid) {
    const float* SC = (const float*)(a.ws + O_SC);
    const unsigned* YR = (const unsigned*)(a.ws + O_YR); const bf16_t* GB = (const bf16_t*)(a.ws + O_G); bf16_t* ORW = (bf16_t*)(a.ws + O_ORW);
    const int b = bh >> 3, h = bh & 7, c = 64 * h + (tid & 15) * 4;
    const f32x4 lwv = *(const f32x4*)(a.in[13] + c), lbv = *(const f32x4*)(a.in[14] + c);
    for (int t0 = tid >> 4; t0 < SEQ; t0 += 64) {
        u32x4 yv[2]; u32x2 gb[2]; float rkb[2]; size_t mm[2];
#pragma unroll
        for (int u = 0; u < 2; ++u) { const size_t m = (size_t)b * SEQ + t0 + 32 * u; mm[u] = m;
            yv[u] = *(const u32x4*)(YR + m * 512 + c); gb[u] = *(const u32x2*)(GB + m * 512 + c); rkb[u] = SC[(m * 8 + h) * 4 + 2]; }
#pragma unroll
        for (int u = 0; u < 2; ++u) {
            float y[4] = {bf_lo(yv[u].x), bf_lo(yv[u].y), bf_lo(yv[u].z), bf_lo(yv[u].w)};
            const float v[4] = {bf_hi(yv[u].x), bf_hi(yv[u].y), bf_hi(yv[u].z), bf_hi(yv[u].w)};
            float s = (y[0] + y[1]) + (y[2] + y[3]);
#pragma unroll
            for (int o = 1; o < 16; o <<= 1) s += __shfl_xor(s, o);
            const float mean = s * (1.f / 64.f);
            float q = 0.f;
#pragma unroll
            for (int j = 0; j < 4; ++j) { y[j] -= mean; q += y[j] * y[j]; }
#pragma unroll
            for (int o = 1; o < 16; o <<= 1) q += __shfl_xor(q, o);
            const float rstd = rsqrtf(q * (1.f / 64.f) + GN_EPS);
            const float g4[4] = {bf_lo(gb[u].x), bf_hi(gb[u].x), bf_lo(gb[u].y), bf_hi(gb[u].y)};
            float o4[4];
#pragma unroll
            for (int j = 0; j < 4; ++j) o4[j] = (y[j] * rstd * lwv[j] + lbv[j] + rkb[u] * v[j]) * g4[j];
            u32x2 ob; ob.x = cvt_pk_bf16(o4[0], o4[1]); ob.y = cvt_pk_bf16(o4[2], o4[3]);
            *(u32x2*)(ORW + mm[u] * 512 + c) = ob;
        }
    }
}

struct KV { bf16x8 k[4]; bf16x8 v[2][2]; };
__device__ __forceinline__ void attn_load(KV& T, const bf16_t* Kh, const bf16_t* Vh, int k0, int n, int hf) {
    const bf16_t* kp = Kh + (size_t)(k0 + n) * 512 + 8 * hf;
#pragma unroll
    for (int s = 0; s < 4; ++s) T.k[s] = *(const bf16x8*)(kp + 16 * s);
#pragma unroll
    for (int d = 0; d < 2; ++d)
#pragma unroll
        for (int sg = 0; sg < 2; ++sg) { const bf16_t* vp = Vh + (size_t)(32 * d + n) * SEQ + k0 + 16 * sg + 4 * hf;
            const u32x2 lo = *(const u32x2*)vp, hi = *(const u32x2*)(vp + 8); u32x4 t = {lo.x, lo.y, hi.x, hi.y}; T.v[d][sg] = __builtin_bit_cast(bf16x8, t); }
}
__device__ __forceinline__ void attn_wave(const Args& a, int bh, int w4, int lane) {
    const int b = bh >> 3, h = bh & 7, n = lane & 31, hf = lane >> 5;
    const size_t m0 = (size_t)b * SEQ;
    const bf16_t* Qh = (const bf16_t*)(a.ws + O_Q) + m0 * 512 + 64 * h;
    const bf16_t* Kh = (const bf16_t*)(a.ws + O_K) + m0 * 512 + 64 * h;
    const bf16_t* Vh = (const bf16_t*)(a.ws + O_VT) + (size_t)bh * 64 * SEQ;
    bf16_t* Oh = (bf16_t*)(a.ws + O_OSB) + m0 * 512 + 64 * h;
    for (int qt = 63 - w4; qt >= 0; qt -= 8) {
        const int q0 = 32 * qt;
        bf16x8 qf[4];
#pragma unroll
        for (int s = 0; s < 4; ++s) qf[s] = *(const bf16x8*)(Qh + (size_t)(q0 + n) * 512 + 16 * s + 8 * hf);
        f32x16 o0, o1;
#pragma unroll
        for (int i = 0; i < 16; ++i) { o0[i] = 0.f; o1[i] = 0.f; }
        float carry = 0.f;
        KV cur, nxt;
        attn_load(cur, Kh, Vh, q0, n, hf);
        for (int kt = qt; kt >= 0; --kt) {
            const int ktn = kt > 0 ? kt - 1 : 0;
            attn_load(nxt, Kh, Vh, 32 * ktn, n, hf);
            f32x16 sc;
#pragma unroll
            for (int i = 0; i < 16; ++i) sc[i] = 0.f;
#pragma unroll
            for (int s = 0; s < 4; ++s) sc = __builtin_amdgcn_mfma_f32_32x32x16_bf16(cur.k[s], qf[s], sc, 0, 0, 0);
            const bool diag = (kt == qt);
            float lf[16], G4[4];
#pragma unroll
            for (int g = 0; g < 4; ++g) { G4[g] = 0.f;
#pragma unroll
                for (int i = 0; i < 4; ++i) { const int r = 4 * g + i; const float z = sc[r];
                    const bool valid = !diag || (8 * g + 4 * hf + i < n);
                    const float e = fexp(-fabsf(z));
                    const float sp = fmaxf(z, 0.f) + flog(1.f + e);
                    lf[r] = valid ? -sp : 0.f; G4[g] += lf[r]; } }
            float PG[4], T4[4];
#pragma unroll
            for (int g = 0; g < 4; ++g) { PG[g] = __shfl_xor(G4[g], 32); T4[g] = G4[g] + PG[g]; }
            const float tail3 = 0.f, tail2 = T4[3], tail1 = T4[3] + T4[2], tail0 = tail1 + T4[1], total = tail0 + T4[0];
            const float tails[4] = {tail0, tail1, tail2, tail3};
            f32x16 wv;
#pragma unroll
            for (int g = 0; g < 4; ++g) {
                float af = carry + tails[g] + (hf == 0 ? PG[g] : 0.f);
#pragma unroll
                for (int i = 3; i >= 0; --i) { const int r = 4 * g + i; const float z = sc[r];
                    const bool valid = !diag || (8 * g + 4 * hf + i < n);
                    const float wgt = fexp(lf[r] + z + af);
                    wv[r] = valid ? wgt : 0.f;
                    af += lf[r]; } }
            carry += total;
            bf16x8 wf[2];
#pragma unroll
            for (int sg = 0; sg < 2; ++sg) { u32x4 t; t.x = cvt_pk_bf16(wv[8 * sg + 0], wv[8 * sg + 1]); t.y = cvt_pk_bf16(wv[8 * sg + 2], wv[8 * sg + 3]); t.z = cvt_pk_bf16(wv[8 * sg + 4], wv[8 * sg + 5]); t.w = cvt_pk_bf16(wv[8 * sg + 6], wv[8 * sg + 7]); wf[sg] = __builtin_bit_cast(bf16x8, t); }
#pragma unroll
            for (int sg = 0; sg < 2; ++sg) { o0 = __builtin_amdgcn_mfma_f32_32x32x16_bf16(cur.v[0][sg], wf[sg], o0, 0, 0, 0); o1 = __builtin_amdgcn_mfma_f32_32x32x16_bf16(cur.v[1][sg], wf[sg], o1, 0, 0, 0); }
            cur = nxt;
#if MK_EARLY_EXIT
            if (__all(carry < -104.f)) break;
#endif
        }
        bf16_t* op = Oh + (size_t)(q0 + n) * 512 + 4 * hf;
#pragma unroll
        for (int g = 0; g < 4; ++g) {
            u32x2 t0, t1; t0.x = cvt_pk_bf16(o0[4 * g], o0[4 * g + 1]); t0.y = cvt_pk_bf16(o0[4 * g + 2], o0[4 * g + 3]); t1.x = cvt_pk_bf16(o1[4 * g], o1[4 * g + 1]); t1.y = cvt_pk_bf16(o1[4 * g + 2], o1[4 * g + 3]);
            *(u32x2*)(op + 8 * g) = t0; *(u32x2*)(op + 32 + 8 * g) = t1; }
    }
}
__device__ __forceinline__ void phase_mixer(const Args& a, unsigned char* lds, int G) {
    const int tid = my_tid(); const int wave = __builtin_amdgcn_readfirstlane(tid >> 6), lane = tid & 63;
    for (int bh = blockIdx.x; bh < NB * NH; bh += G) {
        const int b = bh >> 3, h = bh & 7; const size_t m0 = (size_t)b * SEQ;
        const unsigned char* sb = a.ws + O_SI + (m0 * 8 + h) * 768; const float* scp = (const float*)(a.ws + O_SC) + (m0 * 8 + h) * 4;
        unsigned* yrb = (unsigned*)(a.ws + O_YR) + m0 * 512 + 64 * h + 16 * (wave & 3);
        const int pl = tid - 256;
        constexpr int NCH = SEQ / SC_T;
        ProdRec pr[4]; f32x2 S[8];
#pragma unroll
        for (int p = 0; p < 8; ++p) S[p] = (f32x2){0.f, 0.f};
        __syncthreads();
        if (wave >= 4) { prod_load(pr, sb, scp, 0, pl); prod_store(pr, lds, pl); prod_load(pr, sb, scp, 1, pl); }
        __syncthreads();
        for (int ci = 0; ci < NCH; ++ci) {
            if (wave < 4) scan_consume(S, lds + (ci & 1) * SC_BUF, yrb + (size_t)ci * SC_T * 512, lane, wave);
            else if (ci + 1 < NCH) { prod_store(pr, lds + ((ci + 1) & 1) * SC_BUF, pl); prod_load(pr, sb, scp, ci + 2 < NCH ? ci + 2 : ci + 1, pl); }
            __syncthreads();
        }
        attn_wave(a, bh, wave, lane);
        __threadfence_block(); __syncthreads();
        rwpost_local(a, bh, my_tid());
    }
}

template <int MODE> __device__ __forceinline__ void phase_rows(const Args& a, int G) {
    const int tid = my_tid(); const int wave = tid >> 6, lane = tid & 63;
    const int gw = blockIdx.x * 8 + wave, NGW = G * 8;
    const bf16_t* T = (const bf16_t*)(a.ws + (MODE == 0 ? O_TT : O_FF));
    const float* g1 = MODE == 0 ? a.in[18] : a.in[23]; const float* g2 = a.in[19];
    bf16_t* H2 = (bf16_t*)(a.ws + O_H2); bf16_t* X1B = (bf16_t*)(a.ws + O_X1B);
    f32x4 g1v[4], g2v[4];
#pragma unroll
    for (int j = 0; j < 4; ++j) { g1v[j] = ((const f32x4*)g1)[lane + 64 * j]; g2v[j] = ((const f32x4*)g2)[lane + 64 * j]; }
    for (int row0 = gw; row0 < M; row0 += 2 * NGW) {
        u32x2 tb[2][4]; f32x4 x[2][4];
#pragma unroll
        for (int u = 0; u < 2; ++u) { const int row = (row0 + u * NGW < M) ? row0 + u * NGW : row0;
            const u32x2* tr = (const u32x2*)(T + (size_t)row * D) + lane;
#pragma unroll
            for (int j = 0; j < 4; ++j) tb[u][j] = tr[64 * j];
            if (MODE == 0) { const f32x4* xr = (const f32x4*)(a.in[0] + (size_t)row * D) + lane;
#pragma unroll
                for (int j = 0; j < 4; ++j) x[u][j] = xr[64 * j]; }
            else { const u32x2* xr = (const u32x2*)(X1B + (size_t)row * D) + lane;
#pragma unroll
                for (int j = 0; j < 4; ++j) { const u32x2 xb = xr[64 * j]; x[u][j][0] = bf_lo(xb.x); x[u][j][1] = bf_hi(xb.x); x[u][j][2] = bf_lo(xb.y); x[u][j][3] = bf_hi(xb.y); } } }
#pragma unroll
        for (int u = 0; u < 2; ++u) {
            const int row = row0 + u * NGW;
            f32x4 t[4]; float s = 0.f;
#pragma unroll
            for (int j = 0; j < 4; ++j) { t[j][0] = bf_lo(tb[u][j].x); t[j][1] = bf_hi(tb[u][j].x); t[j][2] = bf_lo(tb[u][j].y); t[j][3] = bf_hi(tb[u][j].y);
                s += (t[j][0] * t[j][0] + t[j][1] * t[j][1]) + (t[j][2] * t[j][2] + t[j][3] * t[j][3]); }
            const float rs = rsqrtf(wave_sum(s) * (1.f / D) + RMS_EPS);
            float s2 = 0.f;
#pragma unroll
            for (int j = 0; j < 4; ++j)
#pragma unroll
                for (int e = 0; e < 4; ++e) { x[u][j][e] += t[j][e] * rs * g1v[j][e]; s2 += x[u][j][e] * x[u][j][e]; }
            float rs2 = 0.f;
            if (MODE == 0) rs2 = rsqrtf(wave_sum(s2) * (1.f / D) + RMS_EPS);
            if (row < M) {
                if (MODE == 0) {
                    u32x2* xo = (u32x2*)(X1B + (size_t)row * D) + lane; u32x2* o = (u32x2*)(H2 + (size_t)row * D) + lane;
#pragma unroll
                    for (int j = 0; j < 4; ++j) { u32x2 w; w.x = cvt_pk_bf16(x[u][j][0], x[u][j][1]); w.y = cvt_pk_bf16(x[u][j][2], x[u][j][3]); xo[64 * j] = w; }
#pragma unroll
                    for (int j = 0; j < 4; ++j) { u32x2 w; w.x = cvt_pk_bf16(x[u][j][0] * rs2 * g2v[j][0], x[u][j][1] * rs2 * g2v[j][1]); w.y = cvt_pk_bf16(x[u][j][2] * rs2 * g2v[j][2], x[u][j][3] * rs2 * g2v[j][3]); o[64 * j] = w; }
                } else {
                    f32x4* orow = (f32x4*)(a.out + (size_t)row * D) + lane;
#pragma unroll
                    for (int j = 0; j < 4; ++j) orow[64 * j] = x[u][j];
                }
            }
        }
    }
}

#define XB_TMO      128
#define XB_XCNT(j)  (256  + 64 * (j))
#define XB_XSUB(j)  (1280 + 64 * (j))
#define XB_XGEN(j)  (2304 + 64 * (j))
#define XB_TOP      3328
#define XB_TOPGEN   3392
#define XCD_BAR_WORDS 3456
#define XB_SPIN_CAP (1u << 18)

__device__ __forceinline__ unsigned xb_ld(unsigned* p)              { return __hip_atomic_load(p, __ATOMIC_RELAXED, __HIP_MEMORY_SCOPE_AGENT); }
__device__ __forceinline__ unsigned xb_add(unsigned* p, unsigned v) { return __hip_atomic_fetch_add(p, v, __ATOMIC_RELAXED, __HIP_MEMORY_SCOPE_AGENT); }
__device__ __forceinline__ unsigned xb_xcc_id() { return (unsigned)__builtin_amdgcn_s_getreg((3 << 11) | 20) & 0xFu; }
#define XB_SPIN(cond, bar) do { unsigned _sp = 0; while (cond) { __builtin_amdgcn_s_sleep(1); \
    if ((++_sp & 255u) == 0u) { if (xb_ld(&(bar)[XB_TMO])) break; if (_sp > XB_SPIN_CAP) { atomicAdd(&(bar)[XB_TMO], 1u); break; } } } } while (0)

struct XcdBarrier {
    unsigned* bar; unsigned x;
    volatile __attribute__((address_space(3))) unsigned* st;
};

__device__ __forceinline__ XcdBarrier xcd_barrier_post(unsigned* bar, volatile __attribute__((address_space(3))) unsigned* st) {
    XcdBarrier b; b.bar = bar; b.x = xb_xcc_id(); b.st = st;
    if (threadIdx.x == 0) (void)xb_add(&bar[XB_XCNT(b.x)], 1u);
    return b;
}
__device__ __forceinline__ void xcd_barrier_complete(unsigned* bar, unsigned x, unsigned& nloc, unsigned& nx) {
    const unsigned G = gridDim.x * gridDim.y * gridDim.z;
    unsigned sum, cnt, mine, sp = 0u;
    for (;;) {
        sum = 0u; cnt = 0u; mine = 0u;
#pragma unroll
        for (unsigned j = 0; j < 16; ++j) { const unsigned c = xb_ld(&bar[XB_XCNT(j)]); sum += c; cnt += (c > 0u) ? 1u : 0u; mine = (j == x) ? c : mine; }
        if (sum == G) break;
        __builtin_amdgcn_s_sleep(1);
        if ((++sp & 255u) == 0u) { if (xb_ld(&bar[XB_TMO])) break; if (sp > XB_SPIN_CAP) { atomicAdd(&bar[XB_TMO], 1u); break; } }
    }
    nloc = mine > 0u ? mine : 1u; nx = cnt > 0u ? cnt : 1u;
}

__device__ __forceinline__ void xcd_barrier(const XcdBarrier& b) {
    asm volatile("s_waitcnt vmcnt(0)" ::: "memory");
    __syncthreads();
    if (threadIdx.x == 0) {
        unsigned* bar = b.bar;
        __builtin_amdgcn_s_waitcnt(0);
        unsigned nloc = b.st[0], nx = b.st[1];
        if (nloc == 0u) { xcd_barrier_complete(bar, b.x, nloc, nx); b.st[0] = nloc; b.st[1] = nx; }
        const unsigned old = xb_add(&bar[XB_XSUB(b.x)], 1u);
        const unsigned gen = old / nloc;
        if (old + 1u == (gen + 1u) * nloc) {
            __builtin_amdgcn_fence(__ATOMIC_RELEASE, "agent");
            asm volatile("s_waitcnt vmcnt(0)" ::: "memory");
            const unsigned og = xb_add(&bar[XB_TOP], 1u);
            const unsigned tg = og / nx;
            if (og + 1u == (tg + 1u) * nx) xb_add(&bar[XB_TOPGEN], 1u);
            else XB_SPIN(xb_ld(&bar[XB_TOPGEN]) == tg, bar);
            __builtin_amdgcn_fence(__ATOMIC_ACQUIRE, "agent");
            xb_add(&bar[XB_XGEN(b.x)], 1u);
            asm volatile("s_waitcnt vmcnt(0)" ::: "memory");
        } else {
            XB_SPIN(xb_ld(&bar[XB_XGEN(b.x)]) == gen, bar);
            __builtin_amdgcn_fence(__ATOMIC_ACQUIRE, "agent");
            asm volatile("s_waitcnt vmcnt(0)" ::: "memory");
        }
    }
    __syncthreads();
}

__global__ void __launch_bounds__(512, 2) mega(Args a) {
    extern __shared__ __attribute__((aligned(16))) unsigned char shm[];
    PG8_LAS unsigned char* lds = (PG8_LAS unsigned char*)shm;
    const int G = (int)gridDim.x;
    unsigned char* ws = a.ws;
    volatile __attribute__((address_space(3))) unsigned* bst = (volatile __attribute__((address_space(3))) unsigned*)(lds + pg8::STAGE_BYTES);
    if (threadIdx.x == 0) { bst[0] = 0u; bst[1] = 0u; }
    __syncthreads();
    const XcdBarrier bar = xcd_barrier_post((unsigned*)(ws + O_CTL), bst);
    phase_prep(a, (float*)shm, G);
    cg::this_grid().sync();
    { Epi1 E; E.Q = (bf16_t*)(ws + O_Q); E.Kb = (bf16_t*)(ws + O_K); E.Vt = (bf16_t*)(ws + O_VT); E.Prw = (bf16_t*)(ws + O_PRW); E.Gt = (bf16_t*)a.out; E.bgate = a.in[3];
      run_gemm(lds, (const bf16_t*)(ws + O_H), (const bf16_t*)(ws + O_WIN), INC, 1024, E, G); }
    xcd_barrier(bar);
    phase_rwprep(a, shm, G);
    xcd_barrier(bar);
    phase_mixer(a, shm, G);
    xcd_barrier(bar);
    { EpiRow<1> E; E.O = (bf16_t*)(ws + O_T1); E.T1 = nullptr; E.Gt = (const bf16_t*)a.out;
      run_gemm(lds, (const bf16_t*)(ws + O_OSB), (const bf16_t*)(ws + O_WSB), 1024, 512, E, G); }
    { EpiRow<2> E; E.O = (bf16_t*)(ws + O_MRG); E.T1 = (const bf16_t*)(ws + O_T1); E.Gt = (const bf16_t*)a.out;
      run_gemm(lds, (const bf16_t*)(ws + O_ORW), (const bf16_t*)(ws + O_WRW), 1024, 512, E, G); }
    xcd_barrier(bar);
    { EpiRow<0> E; E.O = (bf16_t*)(ws + O_TT); E.T1 = nullptr; E.Gt = nullptr;
      run_gemm(lds, (const bf16_t*)(ws + O_MRG), (const bf16_t*)(ws + O_WO), 1024, 1024, E, G); }
    xcd_barrier(bar);
    phase_rows<0>(a, G);
    xcd_barrier(bar);
    { EpiSwiGLU E; E.Hd = (bf16_t*)(ws + O_HID);
      run_gemm(lds, (const bf16_t*)(ws + O_H2), (const bf16_t*)(ws + O_WGU), 2 * DFF, 1024, E, G); }
    xcd_barrier(bar);
    { EpiRow<0> E; E.O = (bf16_t*)(ws + O_FF); E.T1 = nullptr; E.Gt = nullptr;
      run_gemm(lds, (const bf16_t*)(ws + O_HID), (const bf16_t*)(ws + O_WDN), 1024, DFF, E, G); }
    xcd_barrier(bar);
    phase_rows<1>(a, G);
}
}

extern "C" void kernel_launch(void* const* d_in, const int* in_sizes, int n_in, void* d_out, int out_size, void* d_ws, size_t ws_size, hipStream_t stream) {
    static int grid = 0;
    if (grid == 0) {
        if (n_in != 24 || in_sizes[0] != mk::M * mk::D || out_size != mk::M * mk::D || ws_size < mk::WS_NEED) {
            fprintf(stderr, "kernel_launch: unexpected shapes: n_in %d in0 %d out %d ws %zu (need %zu)\n", n_in, n_in > 0 ? in_sizes[0] : -1, out_size, ws_size, (size_t)mk::WS_NEED); grid = -1; return; }
        int dev = 0, cus = 0, per_cu = 0;
        hipGetDevice(&dev); hipDeviceGetAttribute(&cus, hipDeviceAttributeMultiprocessorCount, dev);
        if (hipFuncSetAttribute((const void*)mk::mega, hipFuncAttributeMaxDynamicSharedMemorySize, mk::LDS_BYTES) != hipSuccess) { fprintf(stderr, "kernel_launch: hipFuncSetAttribute failed\n"); grid = -1; return; }
        if (hipOccupancyMaxActiveBlocksPerMultiprocessor(&per_cu, (const void*)mk::mega, 512, mk::LDS_BYTES) != hipSuccess || per_cu < 1) { fprintf(stderr, "kernel_launch: occupancy query failed (%d)\n", per_cu); per_cu = 1; }
        (void)hipGetLastError();
        grid = cus * per_cu;
        fprintf(stderr, "kernel_launch: grid %d (cus %d x %d)\n", grid, cus, per_cu);
    }
    if (grid < 0) return;
    mk::Args a{};
    for (int i = 0; i < 24; ++i) a.in[i] = (const float*)d_in[i];
    a.out = (float*)d_out; a.ws = (unsigned char*)d_ws;
    a.ph_lo = 0; a.ph_hi = mk::NPH;
    if (hipMemsetAsync((char*)d_ws + mk::O_CTL, 0, mk::CTL_BYTES, stream) != hipSuccess) { fprintf(stderr, "kernel_launch: hipMemsetAsync failed\n"); return; }
    void* args[] = {&a};
    hipError_t e = hipLaunchCooperativeKernel((const void*)mk::mega, dim3(grid), dim3(512), args, mk::LDS_BYTES, stream);
    if (e != hipSuccess) fprintf(stderr, "kernel_launch: cooperative launch failed: %s (grid %d)\n", hipGetErrorString(e), grid);
}
```

```cpp
#include <hip/hip_runtime.h>
#include <hip/hip_cooperative_groups.h>
#include <cstdio>
#include <cstdint>
namespace cg = cooperative_groups;
#ifndef MK_SPLIT
#define MK_SPLIT 0
#endif
#ifndef MK_DIAG
#define MK_DIAG 0
#endif
#ifndef MK_REPMASK
#define MK_REPMASK 0
#endif
#ifndef MK_EARLY_EXIT
#define MK_EARLY_EXIT 1
#endif
namespace pg8 {
#define PG8_LAS __attribute__((address_space(3)))
typedef unsigned short bf16_t;
typedef short bf16x8 __attribute__((ext_vector_type(8)));
typedef float f32x4 __attribute__((ext_vector_type(4)));
typedef unsigned u32x4 __attribute__((ext_vector_type(4)));
constexpr int BM = 256, BK = 64, HALF = 128, HTB = HALF * BK * 2  , STAGE_BYTES = 8 * HTB, NXCD = 8, WGM = 8;

__host__ __device__ __forceinline__ int lds_byte(int r, int c) { const int st = (r >> 4) * 2 + (c >> 5), rr = r & 15, cc = c & 31, ob = rr * 64 + cc * 2; return st * 1024 + (ob ^ (((ob >> 9) & 1) << 5)); }
__host__ __device__ __forceinline__ void stage_rc(int b, int& R, int& C) { const int st = b / 1024, sb = b % 1024, swz = sb ^ (((sb >> 9) & 1) << 5); R = (st >> 1) * 16 + swz / 64; C = (st & 1) * 32 + (swz % 64) / 2; }
__host__ __device__ __forceinline__ int perm32(int rho) { const int n = rho >> 4, i = rho & 15; return 8 * (i >> 2) + 4 * n + (i & 3); }

struct Unit { int pm, pn; };
struct Gemm { const bf16_t* A; const bf16_t* Bt; int M, N, K; };

struct StaticOrder {
    int nM, nN, nwg, G, c;
    __host__ __device__ void init(int M, int N, int G_, int c_) { nM = M / BM; nN = N / BM; nwg = nM * nN; G = G_; c = c_; }
    __host__ __device__ bool next(int i, Unit& u) const {
        const long L = (long)i * G + c; if (L >= nwg) return false;
        int wgid = (int)L; { const int q = nwg / NXCD, r = nwg % NXCD, xcd = wgid % NXCD, off = wgid / NXCD; wgid = (xcd < r ? xcd * (q + 1) : r * (q + 1) + (xcd - r) * q) + off; }
        const int nig = WGM * nN, gid = wgid / nig, fm = gid * WGM, gsz = (nM - fm) < WGM ? (nM - fm) : WGM;
        u.pm = fm + ((wgid % nig) % gsz); u.pn = (wgid % nig) / gsz; return true;
    }
    __device__ __forceinline__ void a_ready(const Unit&) const {}
    __device__ __forceinline__ void done(const Unit&) const {}
};

__device__ __forceinline__ unsigned cvt_pk_bf16(float lo, float hi) { unsigned r; asm volatile("v_cvt_pk_bf16_f32 %0, %1, %2" : "=v"(r) : "v"(lo), "v"(hi)); return r; }
typedef float f32x2 __attribute__((ext_vector_type(2)));

template <class Epi, class Sched, bool ALIGN_EPI = false, bool SP2 = false>
__device__ __forceinline__ void gemm_phase(PG8_LAS unsigned char* lds, const Gemm g, const Sched& S, const Epi& E) {
    int tid_ = threadIdx.x; asm volatile("" : "+v"(tid_)); const int tid = tid_, wid = __builtin_amdgcn_readfirstlane(tid >> 6), lane = tid & 63, wr = wid >> 2, wc = wid & 3, fr = lane & 15, fq = lane >> 4;
    const int K = g.K, nt = K / BK;
    unsigned voffA[2], voffB[2];
#pragma unroll
    for (int i = 0; i < 2; ++i) { int R, C; stage_rc(tid * 16 + i * 8192, R, C); const int Rb = Epi::PERM ? ((R & ~31) + perm32(R & 31)) : R;
        voffA[i] = (unsigned)(R * K + C) * 2u; voffB[i] = (unsigned)(Rb * K + C) * 2u; }
    const size_t kstep = (size_t)(BK * 2);
    const size_t hstep = (size_t)HALF * K * 2;
    const size_t tstep = 2 * hstep;
    const unsigned ldsw = (unsigned)wid * 1024u;
    const int aoff = lds_byte(wr * 64 + fr, fq * 8), boff = lds_byte(wc * 32 + fr, fq * 8);
#define PG8_SA(b, h) (((b) * 2 + (h)) * HTB)
#define PG8_SB(b, h) ((4 + (b) * 2 + (h)) * HTB)
#define PG8_STAGE(bufoff, gbase, voff) do { _Pragma("unroll") for (int _i = 0; _i < 2; ++_i) \
        __builtin_amdgcn_global_load_lds((const unsigned*)((const char*)(gbase) + (voff)[_i]), (PG8_LAS unsigned*)(lds + (bufoff) + ldsw + _i * 8192), 16, 0, 0); } while (0)
#define PG8_LDA(dst, b, h) do { _Pragma("unroll") for (int m = 0; m < 4; ++m) _Pragma("unroll") for (int k = 0; k < 2; ++k) dst[m][k] = *(const PG8_LAS bf16x8*)(lds + PG8_SA(b, h) + aoff + m * 2048 + k * 1024); } while (0)
#define PG8_LDB(dst, b, h) do { _Pragma("unroll") for (int n = 0; n < 2; ++n) _Pragma("unroll") for (int k = 0; k < 2; ++k) dst[n][k] = *(const PG8_LAS bf16x8*)(lds + PG8_SB(b, h) + boff + n * 2048 + k * 1024); } while (0)
#define PG8_MMA(ai, bj, At, Bt) do { __builtin_amdgcn_s_setprio(1); _Pragma("unroll") for (int m = 0; m < 4; ++m) _Pragma("unroll") for (int n = 0; n < 2; ++n) _Pragma("unroll") for (int k = 0; k < 2; ++k) \
        acc[ai][bj][m][n] = __builtin_amdgcn_mfma_f32_16x16x32_bf16(Bt[n][k], At[m][k], acc[ai][bj][m][n], 0, 0, 0); __builtin_amdgcn_s_setprio(0); } while (0)
#define PG8_WAIT_V(n) asm volatile("s_waitcnt vmcnt(" #n ")" ::: "memory")
#define PG8_WAIT_L(n) asm volatile("s_waitcnt lgkmcnt(" #n ")" ::: "memory")
#define PG8_BAR __builtin_amdgcn_s_barrier()
#define PG8_SCHED __builtin_amdgcn_sched_barrier(0)
    Unit cur, nxt; int ui = 0;
    if (!S.next(0, cur)) return;
    f32x4 acc[2][2][4][2];
#pragma unroll
    for (int a = 0; a < 2; ++a)
#pragma unroll
        for (int b = 0; b < 2; ++b)
#pragma unroll
            for (int m = 0; m < 4; ++m)
#pragma unroll
                for (int n = 0; n < 2; ++n) acc[a][b][m][n] = (f32x4){0.f, 0.f, 0.f, 0.f};
    bf16x8 At[4][2], B0[2][2], B1[2][2];
    const char* cA = (const char*)g.A + (size_t)cur.pm * tstep; const char* cB = (const char*)g.Bt + (size_t)cur.pn * tstep;
    S.a_ready(cur);
    if constexpr (SP2) {
        PG8_STAGE(PG8_SB(0, 0), cB, voffB); PG8_STAGE(PG8_SB(0, 1), cB + hstep, voffB); PG8_STAGE(PG8_SA(0, 0), cA, voffA); PG8_STAGE(PG8_SA(0, 1), cA + hstep, voffA);
        if (wr == 1) PG8_BAR;
        PG8_WAIT_V(2); PG8_BAR;
        PG8_STAGE(PG8_SB(1, 0), cB + kstep, voffB); PG8_STAGE(PG8_SA(1, 0), cA + kstep, voffA); PG8_STAGE(PG8_SB(1, 1), cB + hstep + kstep, voffB);
        PG8_WAIT_V(6); PG8_BAR;
    } else {
        PG8_STAGE(PG8_SB(0, 0), cB, voffB); PG8_STAGE(PG8_SA(0, 0), cA, voffA); PG8_STAGE(PG8_SB(0, 1), cB + hstep, voffB); PG8_STAGE(PG8_SA(0, 1), cA + hstep, voffA);
        if (wr == 1) PG8_BAR;
        PG8_WAIT_V(4); PG8_BAR;
        PG8_STAGE(PG8_SB(1, 0), cB + kstep, voffB); PG8_STAGE(PG8_SA(1, 0), cA + kstep, voffA); PG8_STAGE(PG8_SB(1, 1), cB + hstep + kstep, voffB);
        PG8_WAIT_V(6); PG8_BAR;
    }
    for (;;) {
        const bool has_next = S.next(ui + 1, nxt);
        const char* nA = has_next ? (const char*)g.A + (size_t)nxt.pm * tstep : cA; const char* nB = has_next ? (const char*)g.Bt + (size_t)nxt.pn * tstep : cB;
        for (int t = 0; t < nt; t += 2) {
            const bool last = (t == nt - 2);
            const char* a1 = cA + (size_t)(t + 1) * kstep;
            const char* a2 = last ? nA : cA + (size_t)(t + 2) * kstep; const char* b2 = last ? nB : cB + (size_t)(t + 2) * kstep;
            const char* a3 = a2 + kstep; const char* b3 = b2 + kstep;
            if (last && has_next) S.a_ready(nxt);
            if constexpr (SP2) {
            PG8_LDB(B0, 0, 0); PG8_LDB(B1, 0, 1); PG8_SCHED; PG8_LDA(At, 0, 0); PG8_STAGE(PG8_SA(1, 1), a1 + hstep, voffA);
            PG8_WAIT_V(8); PG8_WAIT_L(0); PG8_BAR; PG8_MMA(0, 0, At, B0); PG8_MMA(0, 1, At, B1); PG8_BAR; PG8_SCHED;
            PG8_LDA(At, 0, 1); PG8_STAGE(PG8_SB(0, 0), b2, voffB); PG8_STAGE(PG8_SB(0, 1), b2 + hstep, voffB); PG8_STAGE(PG8_SA(0, 0), a2, voffA);
            PG8_WAIT_V(8); PG8_WAIT_L(0); PG8_BAR; PG8_MMA(1, 0, At, B0); PG8_MMA(1, 1, At, B1); PG8_BAR; PG8_SCHED;
            PG8_LDB(B0, 1, 0); PG8_LDB(B1, 1, 1); PG8_SCHED; PG8_LDA(At, 1, 0); PG8_STAGE(PG8_SA(0, 1), a2 + hstep, voffA);
            PG8_WAIT_V(8); PG8_WAIT_L(0); PG8_BAR; PG8_MMA(0, 0, At, B0); PG8_MMA(0, 1, At, B1); PG8_BAR; PG8_SCHED;
            PG8_LDA(At, 1, 1); PG8_STAGE(PG8_SB(1, 0), b3, voffB); PG8_STAGE(PG8_SB(1, 1), b3 + hstep, voffB); PG8_STAGE(PG8_SA(1, 0), a3, voffA);
            PG8_WAIT_V(8); PG8_WAIT_L(0); PG8_BAR; PG8_MMA(1, 0, At, B0); PG8_MMA(1, 1, At, B1); PG8_BAR; PG8_SCHED;
            } else {
            PG8_LDB(B0, 0, 0); PG8_SCHED; PG8_LDA(At, 0, 0); PG8_STAGE(PG8_SA(1, 1), a1 + hstep, voffA);
            PG8_WAIT_L(8); PG8_BAR; PG8_WAIT_L(0); PG8_MMA(0, 0, At, B0); PG8_BAR; PG8_SCHED;
            PG8_LDB(B1, 0, 1); PG8_STAGE(PG8_SB(0, 0), b2, voffB);
            PG8_BAR; PG8_WAIT_L(0); PG8_MMA(0, 1, At, B1); PG8_BAR;
            PG8_LDA(At, 0, 1); PG8_STAGE(PG8_SA(0, 0), a2, voffA);
            PG8_BAR; PG8_WAIT_L(0); PG8_MMA(1, 0, At, B0); PG8_BAR; PG8_SCHED;
            PG8_STAGE(PG8_SB(0, 1), b2 + hstep, voffB);
            PG8_WAIT_V(6); PG8_BAR; PG8_MMA(1, 1, At, B1); PG8_BAR;
            PG8_LDB(B0, 1, 0); PG8_SCHED; PG8_LDA(At, 1, 0); PG8_STAGE(PG8_SA(0, 1), a2 + hstep, voffA);
            PG8_WAIT_L(8); PG8_BAR; PG8_WAIT_L(0); PG8_MMA(0, 0, At, B0); PG8_BAR; PG8_SCHED;
            PG8_LDB(B1, 1, 1); PG8_STAGE(PG8_SB(1, 0), b3, voffB);
            PG8_BAR; PG8_WAIT_L(0); PG8_MMA(0, 1, At, B1); PG8_BAR;
            PG8_LDA(At, 1, 1); PG8_STAGE(PG8_SA(1, 0), a3, voffA);
            PG8_BAR; PG8_WAIT_L(0); PG8_MMA(1, 0, At, B0); PG8_BAR; PG8_SCHED;
            PG8_STAGE(PG8_SB(1, 1), b3 + hstep, voffB);
            PG8_WAIT_V(6); PG8_BAR; PG8_MMA(1, 1, At, B1); PG8_BAR;
            }
        }
        if constexpr (ALIGN_EPI) { if (wr == 0) PG8_BAR; }
        if constexpr (!Epi::AFTER_DRAIN) { E(acc, cur, wr, wc, fr, fq); S.done(cur); }
        if (!has_next) break;
#pragma unroll
        for (int a = 0; a < 2; ++a)
#pragma unroll
            for (int b = 0; b < 2; ++b)
#pragma unroll
                for (int m = 0; m < 4; ++m)
#pragma unroll
                    for (int n = 0; n < 2; ++n) acc[a][b][m][n] = (f32x4){0.f, 0.f, 0.f, 0.f};
        cur = nxt; cA = nA; cB = nB; ++ui;
        if constexpr (ALIGN_EPI) { if (wr == 1) PG8_BAR; }
    }
    PG8_WAIT_V(0);
    if constexpr (!ALIGN_EPI) { if (wr == 0) PG8_BAR; }
    PG8_BAR;
    if constexpr (Epi::AFTER_DRAIN) { E.fused(acc, cur, wr, wc, fr, fq, lds, wid, lane); S.done(cur); }
#undef PG8_SA
#undef PG8_SB
#undef PG8_STAGE
#undef PG8_LDA
#undef PG8_LDB
#undef PG8_MMA
#undef PG8_WAIT_V
#undef PG8_WAIT_L
#undef PG8_BAR
#undef PG8_SCHED
}

}
namespace mk {
using pg8::bf16_t; using pg8::bf16x8; using pg8::f32x4; using pg8::u32x4; using pg8::cvt_pk_bf16;
typedef float f32x16 __attribute__((ext_vector_type(16)));
typedef float f32x2 __attribute__((ext_vector_type(2)));
typedef unsigned u32x2 __attribute__((ext_vector_type(2)));
constexpr int D = 1024, NB = 32, SEQ = 2048, M = NB * SEQ, NH = 8, DH = 64;
constexpr int RWC = 1792, GC = 2048, INC = 5376, DFF = 2816;
constexpr float RMS_EPS = 1e-6f, GN_EPS = 64e-5f;
constexpr size_t MiB = (size_t)1 << 20;
constexpr size_t O_WIN = 0, O_WSB = 11 * MiB, O_WRW = 12 * MiB, O_WO = 13 * MiB, O_WGU = 15 * MiB, O_WDN = 26 * MiB, O_WLU = 32 * MiB  , O_WLA = O_WLU + 65536, O_WLG = O_WLA + 65536;
constexpr size_t O_Q = 34 * MiB, O_K = 98 * MiB, O_VT = 162 * MiB, O_PRW = 226 * MiB, O_H = 450 * MiB, O_SI = 450 * MiB, O_G = 834 * MiB, O_SC = 898 * MiB, O_YR = 290 * MiB  ;
constexpr size_t O_OSB = 226 * MiB, O_ORW = 34 * MiB, O_T1 = 98 * MiB, O_MRG = 450 * MiB, O_TT = 34 * MiB, O_H2 = 162 * MiB, O_HID = 290 * MiB, O_FF = 34 * MiB;
constexpr size_t O_X1B = 706 * MiB;
constexpr size_t WS_NEED = 1009 * MiB;
constexpr int LDS_BYTES = pg8::STAGE_BYTES + 64;
constexpr size_t O_CTL = 1008 * MiB, CTL_BYTES = 65536;
constexpr int NPH = 12;

struct Args { const float* in[24]; float* out; unsigned char* ws; int ph_lo, ph_hi; };

__device__ __forceinline__ int my_tid() { int t = threadIdx.x; asm volatile("" : "+v"(t)); return t; }
__device__ __forceinline__ float bf_lo(unsigned u) { return __uint_as_float(u << 16); }
__device__ __forceinline__ float bf_hi(unsigned u) { return __uint_as_float(u & 0xffff0000u); }
__device__ __forceinline__ float fexp(float x) { return __builtin_amdgcn_exp2f(x * 1.44269504089f); }
__device__ __forceinline__ float flog(float x) { return __builtin_amdgcn_logf(x) * 0.69314718056f; }
__device__ __forceinline__ float frcp(float x) { return __builtin_amdgcn_rcpf(x); }
__device__ __forceinline__ float fsigmoid(float x) { return frcp(1.f + fexp(-x)); }
__device__ __forceinline__ unsigned short bf1(float x) { return (unsigned short)(cvt_pk_bf16(x, x) & 0xffffu); }
__device__ __forceinline__ u32x4 pack8(const f32x4 a, const f32x4 b) { u32x4 o; o.x = cvt_pk_bf16(a[0], a[1]); o.y = cvt_pk_bf16(a[2], a[3]); o.z = cvt_pk_bf16(b[0], b[1]); o.w = cvt_pk_bf16(b[2], b[3]); return o; }
__device__ __forceinline__ float red16(float v) {
    v += __shfl_xor(v, 16); v += __shfl_xor(v, 32); return v;
}
__device__ __forceinline__ float wave_sum(float v) {
#pragma unroll
    for (int o = 1; o < 64; o <<= 1) v += __shfl_xor(v, o);
    return v;
}

__device__ __forceinline__ void tr_item(const float* __restrict__ W, int K, int N, bf16_t* WT, float* scr, int item, int lane, int mode) {
    const int nblk = N >> 5, kb = item / nblk, nb = item - kb * nblk, k0 = kb << 6, n0 = nb << 5;
#pragma unroll 8
    for (int i = 0; i < 32; ++i) { const int kk = 2 * i + (lane >> 5); scr[kk * 33 + (lane & 31)] = W[(size_t)(k0 + kk) * N + n0 + (lane & 31)]; }
    asm volatile("s_waitcnt lgkmcnt(0)" ::: "memory"); __builtin_amdgcn_wave_barrier();
    const int c = lane & 7;
#pragma unroll
    for (int j = 0; j < 4; ++j) {
        const int n = (lane >> 3) + 8 * j; const float* s = scr + (8 * c) * 33 + n;
        u32x4 o; o.x = cvt_pk_bf16(s[0 * 33], s[1 * 33]); o.y = cvt_pk_bf16(s[2 * 33], s[3 * 33]); o.z = cvt_pk_bf16(s[4 * 33], s[5 * 33]); o.w = cvt_pk_bf16(s[6 * 33], s[7 * 33]);
        const int nn = n0 + n; int drow = nn;
        if (mode == 1) drow = ((nn >> 7) << 8) + (nn & 127); else if (mode == 2) drow = ((nn >> 7) << 8) + 128 + (nn & 127);
        *(u32x4*)(WT + (size_t)drow * K + k0 + 8 * c) = o;
    }
    asm volatile("s_waitcnt lgkmcnt(0)" ::: "memory"); __builtin_amdgcn_wave_barrier();
}

__device__ __forceinline__ void phase_prep(const Args& a, float* lds_f, int G) {
    const int tid = my_tid(); const int wave = tid >> 6, lane = tid & 63;
    const int gw = blockIdx.x * 8 + wave, NGW = G * 8;
    float* scr = lds_f + wave * (64 * 33 + 16);
    unsigned char* ws = a.ws;
    constexpr int I_IN = 16 * 168, I_SB = 8 * 32, I_O = 16 * 32, I_G = 16 * 88, I_DN = 44 * 32, I_LU = 16, I_LG = 32;
    constexpr int NIT = I_IN + 2 * I_SB + I_O + 2 * I_G + I_DN + 2 * I_LU + I_LG;
    for (int it = gw; it < NIT; it += NGW) {
        int r = it;
        if (r < I_IN) { tr_item(a.in[2], 1024, INC, (bf16_t*)(ws + O_WIN), scr, r, lane, 0); continue; } r -= I_IN;
        if (r < I_SB) { tr_item(a.in[15], 512, 1024, (bf16_t*)(ws + O_WSB), scr, r, lane, 0); continue; } r -= I_SB;
        if (r < I_SB) { tr_item(a.in[16], 512, 1024, (bf16_t*)(ws + O_WRW), scr, r, lane, 0); continue; } r -= I_SB;
        if (r < I_O) { tr_item(a.in[17], 1024, 1024, (bf16_t*)(ws + O_WO), scr, r, lane, 0); continue; } r -= I_O;
        if (r < I_G) { tr_item(a.in[20], 1024, DFF, (bf16_t*)(ws + O_WGU), scr, r, lane, 1); continue; } r -= I_G;
        if (r < I_G) { tr_item(a.in[21], 1024, DFF, (bf16_t*)(ws + O_WGU), scr, r, lane, 2); continue; } r -= I_G;
        if (r < I_DN) { tr_item(a.in[22], DFF, 1024, (bf16_t*)(ws + O_WDN), scr, r, lane, 0); continue; } r -= I_DN;
        if (r < I_LU) { tr_item(a.in[6], 64, 512, (bf16_t*)(ws + O_WLU), scr, r, lane, 0); continue; } r -= I_LU;
        if (r < I_LU) { tr_item(a.in[8], 64, 512, (bf16_t*)(ws + O_WLA), scr, r, lane, 0); continue; } r -= I_LU;
        tr_item(a.in[9], 128, 512, (bf16_t*)(ws + O_WLG), scr, r, lane, 0);
    }
    const float* x = a.in[0]; const float* g = a.in[1]; bf16_t* H = (bf16_t*)(ws + O_H);
    f32x4 gv[4];
#pragma unroll
    for (int j = 0; j < 4; ++j) gv[j] = ((const f32x4*)g)[lane + 64 * j];
    for (int row0 = gw; row0 < M; row0 += 2 * NGW) {
        f32x4 v[2][4];
#pragma unroll
        for (int u = 0; u < 2; ++u) { const int row = (row0 + u * NGW < M) ? row0 + u * NGW : row0; const f32x4* xr = (const f32x4*)(x + (size_t)row * D) + lane;
#pragma unroll
            for (int j = 0; j < 4; ++j) v[u][j] = xr[64 * j]; }
#pragma unroll
        for (int u = 0; u < 2; ++u) { const int row = row0 + u * NGW; float s = 0.f;
#pragma unroll
            for (int j = 0; j < 4; ++j) s += (v[u][j][0] * v[u][j][0] + v[u][j][1] * v[u][j][1]) + (v[u][j][2] * v[u][j][2] + v[u][j][3] * v[u][j][3]);
            const float rs = rsqrtf(wave_sum(s) * (1.f / D) + RMS_EPS);
            if (row < M) { u32x2* o = (u32x2*)(H + (size_t)row * D) + lane;
#pragma unroll
                for (int j = 0; j < 4; ++j) { u32x2 w; w.x = cvt_pk_bf16(v[u][j][0] * rs * gv[j][0], v[u][j][1] * rs * gv[j][1]); w.y = cvt_pk_bf16(v[u][j][2] * rs * gv[j][2], v[u][j][3] * rs * gv[j][3]); o[64 * j] = w; } }
        }
    }
}

struct Epi1 {
    static constexpr bool PERM = true, AFTER_DRAIN = false;
    bf16_t *Q, *Kb, *Vt, *Prw, *Gt; const float* bgate;
    __device__ __forceinline__ void operator()(const f32x4 (&acc)[2][2][4][2], const pg8::Unit& u, int wr, int wc, int fr, int fq) const {
        const int row0 = u.pm * 256 + wr * 64 + fr, pn = u.pn, cl = wc * 32 + 8 * fq;
        if (pn < 4) {
            bf16_t* dst = pn < 2 ? Q : Kb; const float sc = pn < 2 ? 0.125f : 1.f; const int cb = (pn & 1) * 256 + cl;
#pragma unroll
            for (int ai = 0; ai < 2; ++ai)
#pragma unroll
                for (int m = 0; m < 4; ++m) { bf16_t* rp = dst + (size_t)(row0 + ai * 128 + m * 16) * 512 + cb;
#pragma unroll
                    for (int bj = 0; bj < 2; ++bj) *(u32x4*)(rp + bj * 128) = pack8(acc[ai][bj][m][0] * sc, acc[ai][bj][m][1] * sc); }
        } else if (pn < 6) {
#pragma unroll
            for (int ai = 0; ai < 2; ++ai)
#pragma unroll
                for (int m = 0; m < 4; ++m) { const int row = row0 + ai * 128 + m * 16, b = row >> 11, s = row & 2047;
#pragma unroll
                    for (int bj = 0; bj < 2; ++bj)
#pragma unroll
                        for (int n = 0; n < 2; ++n)
#pragma unroll
                            for (int j = 0; j < 4; ++j) { const int c = (pn - 4) * 256 + bj * 128 + cl + 4 * n + j;
                                Vt[((size_t)(b * 512 + c)) * 2048 + s] = bf1(acc[ai][bj][m][n][j]); } }
        } else if (pn < 13) {
            const int cb = (pn - 6) * 256 + cl;
#pragma unroll
            for (int ai = 0; ai < 2; ++ai)
#pragma unroll
                for (int m = 0; m < 4; ++m) { bf16_t* rp = Prw + (size_t)(row0 + ai * 128 + m * 16) * RWC + cb;
#pragma unroll
                    for (int bj = 0; bj < 2; ++bj) *(u32x4*)(rp + bj * 128) = pack8(acc[ai][bj][m][0], acc[ai][bj][m][1]); }
        } else {
            const int cb = (pn - 13) * 256 + cl;
#pragma unroll
            for (int ai = 0; ai < 2; ++ai)
#pragma unroll
                for (int m = 0; m < 4; ++m) { bf16_t* rp = Gt + (size_t)(row0 + ai * 128 + m * 16) * GC + cb;
#pragma unroll
                    for (int bj = 0; bj < 2; ++bj) { f32x4 v0 = acc[ai][bj][m][0] + *(const f32x4*)(bgate + cb + bj * 128), v1 = acc[ai][bj][m][1] + *(const f32x4*)(bgate + cb + bj * 128 + 4);
#pragma unroll
                        for (int j = 0; j < 4; ++j) { v0[j] = fsigmoid(v0[j]); v1[j] = fsigmoid(v1[j]); }
                        *(u32x4*)(rp + bj * 128) = pack8(v0, v1); } }
        }
    }
};
template <int MODE> struct EpiRow {
    static constexpr bool PERM = true, AFTER_DRAIN = false;
    bf16_t* O; const bf16_t* T1; const bf16_t* Gt;
    __device__ __forceinline__ void operator()(const f32x4 (&acc)[2][2][4][2], const pg8::Unit& u, int wr, int wc, int fr, int fq) const {
        const int row0 = u.pm * 256 + wr * 64 + fr, cb = u.pn * 256 + wc * 32 + 8 * fq;
#pragma unroll
        for (int ai = 0; ai < 2; ++ai)
#pragma unroll
            for (int m = 0; m < 4; ++m) { const size_t row = (size_t)(row0 + ai * 128 + m * 16);
#pragma unroll
                for (int bj = 0; bj < 2; ++bj) { f32x4 v0 = acc[ai][bj][m][0], v1 = acc[ai][bj][m][1]; const int c = cb + bj * 128;
                    if (MODE >= 1) { const u32x4 gg = *(const u32x4*)(Gt + row * GC + (MODE == 2 ? 1024 : 0) + c);
                        v0[0] *= bf_lo(gg.x); v0[1] *= bf_hi(gg.x); v0[2] *= bf_lo(gg.y); v0[3] *= bf_hi(gg.y); v1[0] *= bf_lo(gg.z); v1[1] *= bf_hi(gg.z); v1[2] *= bf_lo(gg.w); v1[3] *= bf_hi(gg.w); }
                    if (MODE == 2) { const u32x4 tt = *(const u32x4*)(T1 + row * 1024 + c);
                        v0[0] += bf_lo(tt.x); v0[1] += bf_hi(tt.x); v0[2] += bf_lo(tt.y); v0[3] += bf_hi(tt.y); v1[0] += bf_lo(tt.z); v1[1] += bf_hi(tt.z); v1[2] += bf_lo(tt.w); v1[3] += bf_hi(tt.w); }
                    *(u32x4*)(O + row * 1024 + c) = pack8(v0, v1); } }
    }
};
struct EpiSwiGLU {
    static constexpr bool PERM = true, AFTER_DRAIN = false;
    bf16_t* Hd;
    __device__ __forceinline__ void operator()(const f32x4 (&acc)[2][2][4][2], const pg8::Unit& u, int wr, int wc, int fr, int fq) const {
        const int row0 = u.pm * 256 + wr * 64 + fr, cb = u.pn * 128 + wc * 32 + 8 * fq;
#pragma unroll
        for (int ai = 0; ai < 2; ++ai)
#pragma unroll
            for (int m = 0; m < 4; ++m) { f32x4 v0, v1;
#pragma unroll
                for (int j = 0; j < 4; ++j) { const float g0 = acc[ai][0][m][0][j], g1 = acc[ai][0][m][1][j];
                    v0[j] = g0 * fsigmoid(g0) * acc[ai][1][m][0][j]; v1[j] = g1 * fsigmoid(g1) * acc[ai][1][m][1][j]; }
                *(u32x4*)(Hd + (size_t)(row0 + ai * 128 + m * 16) * DFF + cb) = pack8(v0, v1); }
    }
};
template <class Epi> __device__ __forceinline__ void run_gemm(PG8_LAS unsigned char* lds, const bf16_t* A, const bf16_t* Bt, int N, int K, const Epi& E, int G) {
    pg8::Gemm g; g.A = A; g.Bt = Bt; g.M = M; g.N = N; g.K = K;
    pg8::StaticOrder S; S.init(M, N, G, (int)blockIdx.x);
    pg8::gemm_phase<Epi, pg8::StaticOrder, true, true>(lds, g, S, E);
}
__device__ __forceinline__ void mix8_lds(const unsigned char* cur, const unsigned char* prv, const float* mu, float (&o)[8]) {
    const u32x4 c = *(const u32x4*)cur, p = *(const u32x4*)prv;
    const f32x4 m0 = *(const f32x4*)mu, m1 = *(const f32x4*)(mu + 4);
    const float mm[8] = {m0[0], m0[1], m0[2], m0[3], m1[0], m1[1], m1[2], m1[3]};
#pragma unroll
    for (int i = 0; i < 4; ++i) { const float cl = bf_lo(c[i]), ch = bf_hi(c[i]), pl = bf_lo(p[i]), ph = bf_hi(p[i]);
        o[2 * i] = cl + (pl - cl) * mm[2 * i]; o[2 * i + 1] = ch + (ph - ch) * mm[2 * i + 1]; }
}
__device__ __forceinline__ void mix4_lds(const unsigned char* cur, const unsigned char* prv, const float* mu, float (&o)[4]) {
    const u32x2 c = *(const u32x2*)cur, p = *(const u32x2*)prv;
    const f32x4 m0 = *(const f32x4*)mu;
#pragma unroll
    for (int i = 0; i < 2; ++i) { const float cl = bf_lo(c[i]), ch = bf_hi(c[i]), pl = bf_lo(p[i]), ph = bf_hi(p[i]);
        o[2 * i] = cl + (pl - cl) * m0[2 * i]; o[2 * i + 1] = ch + (ph - ch) * m0[2 * i + 1]; }
}
__device__ __forceinline__ bf16x8 pack_frag(const float (&v)[8]) {
    u32x4 o; o.x = cvt_pk_bf16(v[0], v[1]); o.y = cvt_pk_bf16(v[2], v[3]); o.z = cvt_pk_bf16(v[4], v[5]); o.w = cvt_pk_bf16(v[6], v[7]);
    return __builtin_bit_cast(bf16x8, o);
}
__device__ __forceinline__ void phase_rwprep(const Args& a, unsigned char* lds, int G) {
    constexpr int ROWB = 3600, L_FRAG = 17 * ROWB, L_PAR = L_FRAG + 8192, NCH = 17 * 224, NT = M / 16;
    const int tid = my_tid(); const int wave = __builtin_amdgcn_readfirstlane(tid >> 6), lane = tid & 63, fr = lane & 15, fq = lane >> 4;
    unsigned char* ws = a.ws;
    const unsigned char* PRW = ws + O_PRW;
    const bf16_t* WLU = (const bf16_t*)(ws + O_WLU); const bf16_t* WLA = (const bf16_t*)(ws + O_WLA); const bf16_t* WLG = (const bf16_t*)(ws + O_WLG);
    unsigned char* SI = ws + O_SI; bf16_t* GB = (bf16_t*)(ws + O_G); float* SC = (float*)(ws + O_SC);
    float* par = (float*)(lds + L_PAR);
    for (int i = tid; i < 1792 + 5 * 512; i += 512) {
        float v;
        if (i < 1792) v = a.in[4][i]; else { const int j = i - 1792, w = j >> 9, c = j & 511; v = (w == 0 ? a.in[5] : w == 1 ? a.in[7] : w == 2 ? a.in[10] : w == 3 ? a.in[11] : a.in[12])[c]; }
        par[i] = v;
    }
    for (int tile = blockIdx.x; tile < NT; tile += G) {
        __syncthreads();
        {   u32x4 pre[8];
#pragma unroll
            for (int j = 0; j < 8; ++j) { const int c = tid + 512 * j; pre[j] = (u32x4){0u, 0u, 0u, 0u};
                if (c < NCH) { const int row = c / 224, col = c - row * 224; const bool zero = (row == 0) && (((tile * 16) & (SEQ - 1)) == 0);
                    if (!zero) pre[j] = *(const u32x4*)(PRW + ((size_t)tile * 16 + row - 1) * (RWC * 2) + col * 16); } }
#pragma unroll
            for (int j = 0; j < 8; ++j) { const int c = tid + 512 * j; if (c < NCH) { const int row = c / 224, col = c - row * 224; *(u32x4*)(lds + row * ROWB + col * 16) = pre[j]; } }
        }
        __syncthreads();
        const unsigned char* rcur = lds + (fr + 1) * ROWB; const unsigned char* rprv = lds + fr * ROWB;
        {
            const int colb = wave < 2 ? 1536 + 32 * wave : (wave < 4 ? 1600 + 32 * (wave - 2) : 1664 + 32 * (wave - 4));
            float t8[8]; mix8_lds(rcur + (colb + 8 * fq) * 2, rprv + (colb + 8 * fq) * 2, par + colb + 8 * fq, t8);
            if (wave < 2) {
#pragma unroll
                for (int i = 0; i < 8; ++i) { const float e = fexp(2.f * t8[i]); t8[i] = 1.f - 2.f * frcp(e + 1.f); } }
            else if (wave >= 4) {
#pragma unroll
                for (int i = 0; i < 8; ++i) t8[i] = fsigmoid(t8[i]); }
            *(bf16x8*)(lds + L_FRAG + wave * 1024 + lane * 16) = pack_frag(t8);
        }
        __syncthreads();
        bf16x8 Aw[2], Aa[2], Ag[4];
#pragma unroll
        for (int s = 0; s < 2; ++s) { Aw[s] = *(const bf16x8*)(lds + L_FRAG + s * 1024 + lane * 16); Aa[s] = *(const bf16x8*)(lds + L_FRAG + (2 + s) * 1024 + lane * 16); }
#pragma unroll
        for (int s = 0; s < 4; ++s) Ag[s] = *(const bf16x8*)(lds + L_FRAG + (4 + s) * 1024 + lane * 16);
        const int h = wave; const size_t m = (size_t)tile * 16 + fr;
        float kkr[16], av[16]; unsigned lk[16], rvp[16];
        float ss = 0.f, brs = 0.f, krs = 0.f, rkbs = 0.f;
#pragma unroll
        for (int n = 0; n < 4; ++n) {
            asm volatile("" ::: "memory");
            const int cb = 64 * h + 16 * n, c0 = cb + 4 * fq;
            f32x4 aw = {0.f, 0.f, 0.f, 0.f}, aa = aw, ag = aw;
#pragma unroll
            for (int s = 0; s < 2; ++s) {
                aw = __builtin_amdgcn_mfma_f32_16x16x32_bf16(*(const bf16x8*)(WLU + (size_t)(cb + fr) * 64 + 32 * s + 8 * fq), Aw[s], aw, 0, 0, 0);
                aa = __builtin_amdgcn_mfma_f32_16x16x32_bf16(*(const bf16x8*)(WLA + (size_t)(cb + fr) * 64 + 32 * s + 8 * fq), Aa[s], aa, 0, 0, 0); }
#pragma unroll
            for (int s = 0; s < 4; ++s)
                ag = __builtin_amdgcn_mfma_f32_16x16x32_bf16(*(const bf16x8*)(WLG + (size_t)(cb + fr) * 128 + 32 * s + 8 * fq), Ag[s], ag, 0, 0, 0);
            float rr[4], kr4[4], vv[4];
            mix4_lds(rcur + c0 * 2, rprv + c0 * 2, par + c0, rr); mix4_lds(rcur + (512 + c0) * 2, rprv + (512 + c0) * 2, par + 512 + c0, kr4); mix4_lds(rcur + (1024 + c0) * 2, rprv + (1024 + c0) * 2, par + 1024 + c0, vv);
            const f32x4 w0v = *(const f32x4*)(par + 1792 + c0), a0v = *(const f32x4*)(par + 2304 + c0), kkv = *(const f32x4*)(par + 2816 + c0), kav = *(const f32x4*)(par + 3328 + c0), rkv = *(const f32x4*)(par + 3840 + c0);
#pragma unroll
            for (int j = 0; j < 4; ++j) {
                const float sg = fsigmoid(w0v[j] + aw[j]);
                const float ldx = -0.60653065971f * 1.44269504089f * sg;
                const float av_ = fsigmoid(a0v[j] + aa[j]);
                const float kkraw = kr4[j] * kkv[j];
                const float k2 = kr4[j] * (1.f + (av_ - 1.f) * kav[j]);
                ss += kkraw * kkraw; brs += kkraw * av_ * rr[j]; krs += k2 * rr[j]; rkbs += rr[j] * k2 * rkv[j];
                kkr[4 * n + j] = kkraw; av[4 * n + j] = av_; lk[4 * n + j] = cvt_pk_bf16(ldx, k2); rvp[4 * n + j] = cvt_pk_bf16(rr[j], vv[j]);
            }
            u32x2 gp; gp.x = cvt_pk_bf16(ag[0], ag[1]); gp.y = cvt_pk_bf16(ag[2], ag[3]);
            *(u32x2*)(GB + m * 512 + c0) = gp;
        }
        ss = red16(ss); brs = red16(brs); krs = red16(krs); rkbs = red16(rkbs);
        const float inv = 1.f / fmaxf(sqrtf(ss), 1e-12f);
        unsigned char* rec = SI + ((m * 8 + h) * 64) * 12;
#pragma unroll
        for (int n = 0; n < 4; ++n) {
            unsigned dw[12];
#pragma unroll
            for (int j = 0; j < 4; ++j) { const float kk = kkr[4 * n + j] * inv;
                const unsigned kp = cvt_pk_bf16(kk * av[4 * n + j], -kk);
                dw[3 * j] = (lk[4 * n + j] & 0xffffu) | (kp & 0xffff0000u); dw[3 * j + 1] = (kp & 0xffffu) | (lk[4 * n + j] & 0xffff0000u); dw[3 * j + 2] = rvp[4 * n + j]; }
            u32x4* dst = (u32x4*)(rec + (16 * n + 4 * fq) * 12);
            u32x4 s0 = {dw[0], dw[1], dw[2], dw[3]}, s1 = {dw[4], dw[5], dw[6], dw[7]}, s2 = {dw[8], dw[9], dw[10], dw[11]};
            dst[0] = s0; dst[1] = s1; dst[2] = s2;
        }
        if (fq == 0) { f32x4 scv = {brs * inv, krs, rkbs, 0.f}; *(f32x4*)(SC + (m * 8 + h) * 4) = scv; }
    }
    __syncthreads();
}

__device__ __forceinline__ float red_rows(float x) {
    float a0 = x, a1 = x;
    asm volatile("s_nop 1\n\tv_permlane16_swap_b32 %0, %1" : "+v"(a0), "+v"(a1));
    float b0 = a0 + a1, b1 = b0;
    asm volatile("s_nop 1\n\tv_permlane32_swap_b32 %0, %1" : "+v"(b0), "+v"(b1));
    return b0 + b1;
}
constexpr int SC_T = 16, SC_ROW = 1552, SC_BUF = SC_T * SC_ROW;
struct ProdRec { unsigned d0, d1, d2; f32x2 sc; };
__device__ __forceinline__ void prod_load(ProdRec (&P)[4], const unsigned char* sb, const float* scp, int chunk, int pl) {
    const int col = pl & 63;
#pragma unroll
    for (int q = 0; q < 4; ++q) { const size_t t = (size_t)chunk * SC_T + (pl >> 6) + 4 * q;
        const unsigned* p = (const unsigned*)(sb + t * 6144 + col * 12); P[q].d0 = p[0]; P[q].d1 = p[1]; P[q].d2 = p[2];
        P[q].sc = (f32x2){0.f, 0.f}; if (col == 0) P[q].sc = *(const f32x2*)(scp + t * 32); }
}
__device__ __forceinline__ void prod_store(const ProdRec (&P)[4], unsigned char* buf, int pl) {
    const int col = pl & 63;
#pragma unroll
    for (int q = 0; q < 4; ++q) { unsigned char* base = buf + ((pl >> 6) + 4 * q) * SC_ROW + col * 4;
        const float w = __builtin_amdgcn_exp2f(bf_lo(P[q].d0));
        *(float*)(base) = bf_hi(P[q].d0); *(float*)(base + 256) = w * bf_lo(P[q].d2); *(float*)(base + 512) = w;
        *(float*)(base + 768) = bf_lo(P[q].d1); *(float*)(base + 1024) = bf_hi(P[q].d1); *(float*)(base + 1280) = bf_hi(P[q].d2);
        if (col == 0) *(f32x2*)(base + 1536) = P[q].sc; }
}
#define MK_SWAP32(a, b) asm volatile("s_nop 1\n\tv_permlane32_swap_b32 %0, %1" : "+v"(a), "+v"(b))
#define MK_SWAP16(a, b) asm volatile("s_nop 1\n\tv_permlane16_swap_b32 %0, %1" : "+v"(a), "+v"(b))
__device__ __forceinline__ void red4x8(float& A, float& B, float& C, float& D) {
    MK_SWAP32(A, B); float u = A + B;
    MK_SWAP32(C, D); float w = C + D;
    MK_SWAP16(u, w); float z = u + w;
    float z1;
    asm volatile("s_nop 1\n\tv_add_f32_dpp %0, %1, %1 row_ror:8 row_mask:0xf bank_mask:0xf" : "=&v"(z1) : "v"(z));
    float p = z1, q = z1; MK_SWAP32(p, q);
    float p2 = p; MK_SWAP16(p, p2);
    float q2 = q; MK_SWAP16(q, q2);
    A = p; C = p2; B = q; D = q2;
}
__device__ __forceinline__ void scan_consume(f32x2 (&S)[8], const unsigned char* buf, unsigned* yr, int lane, int rb) {
    const unsigned co = (unsigned)(lane >> 3) * 32u, vo = 1280u + (unsigned)(16 * rb + (lane & 7)) * 4u;
#pragma unroll 4
    for (int st = 0; st < SC_T; ++st) {
        const unsigned char* sb = buf + st * SC_ROW;
        f32x4 n4[2], r4[2], w4[2], a4[2], k4[2];
#pragma unroll
        for (int q = 0; q < 2; ++q) { n4[q] = *(const f32x4*)(sb + co + 16 * q); r4[q] = *(const f32x4*)(sb + 256 + co + 16 * q); w4[q] = *(const f32x4*)(sb + 512 + co + 16 * q);
            a4[q] = *(const f32x4*)(sb + 768 + co + 16 * q); k4[q] = *(const f32x4*)(sb + 1024 + co + 16 * q); }
        const float v0 = *(const float*)(sb + vo), v1 = *(const float*)(sb + vo + 32); const f32x2 bk = *(const f32x2*)(sb + 1536);
        f32x2 sa0v = {0.f, 0.f}, sa1v = sa0v, yp0v = sa0v, yp1v = sa0v;
#pragma unroll
        for (int p = 0; p < 4; ++p) { const f32x2 nn = {n4[p >> 1][2 * (p & 1)], n4[p >> 1][2 * (p & 1) + 1]}, rr2 = {r4[p >> 1][2 * (p & 1)], r4[p >> 1][2 * (p & 1) + 1]};
            sa0v += S[p] * nn; sa1v += S[4 + p] * nn; yp0v += S[p] * rr2; yp1v += S[4 + p] * rr2; }
        float sa0 = sa0v[0] + sa0v[1], sa1 = sa1v[0] + sa1v[1], yp0 = yp0v[0] + yp0v[1], yp1 = yp1v[0] + yp1v[1];
        red4x8(sa0, sa1, yp0, yp1);
        const f32x2 s0 = {sa0, sa0}, s1 = {sa1, sa1}, vv0 = {v0, v0}, vv1 = {v1, v1};
#pragma unroll
        for (int p = 0; p < 4; ++p) { const f32x2 ww = {w4[p >> 1][2 * (p & 1)], w4[p >> 1][2 * (p & 1) + 1]}; S[p] = S[p] * ww; S[4 + p] = S[4 + p] * ww; }
        asm volatile("" ::: "memory");
#pragma unroll
        for (int p = 0; p < 4; ++p) { const f32x2 aa = {a4[p >> 1][2 * (p & 1)], a4[p >> 1][2 * (p & 1) + 1]}; S[p] = __builtin_elementwise_fma(aa, s0, S[p]); S[4 + p] = __builtin_elementwise_fma(aa, s1, S[4 + p]); }
        asm volatile("" ::: "memory");
#pragma unroll
        for (int p = 0; p < 4; ++p) { const f32x2 kk = {k4[p >> 1][2 * (p & 1)], k4[p >> 1][2 * (p & 1) + 1]}; S[p] = __builtin_elementwise_fma(kk, vv0, S[p]); S[4 + p] = __builtin_elementwise_fma(kk, vv1, S[4 + p]); }
        const float y0 = yp0 + sa0 * bk[0] + v0 * bk[1], y1 = yp1 + sa1 * bk[0] + v1 * bk[1];
        if (lane < 16) { const bool hi = (lane & 8) != 0;
            yr[(size_t)st * 512 + lane] = (unsigned)bf1(hi ? y1 : y0) | (__float_as_uint(hi ? v1 : v0) & 0xffff0000u); }
    }
}

__device__ __forceinline__ void rwpost_local(const Args& a, int bh, int tid) {
    const float* SC = (const float*)(a.ws + O_SC);
    const unsigned* YR = (const unsigned*)(a.ws + O_YR); const bf16_t* GB = (const bf16_t*)(a.ws + O_G); bf16_t* ORW = (bf16_t*)(a.ws + O_ORW);
    const int b = bh >> 3, h = bh & 7, c = 64 * h + (tid & 15) * 4;
    const f32x4 lwv = *(const f32x4*)(a.in[13] + c), lbv = *(const f32x4*)(a.in[14] + c);
    for (int t0 = tid >> 4; t0 < SEQ; t0 += 64) {
        u32x4 yv[2]; u32x2 gb[2]; float rkb[2]; size_t mm[2];
#pragma unroll
        for (int u = 0; u < 2; ++u) { const size_t m = (size_t)b * SEQ + t0 + 32 * u; mm[u] = m;
            yv[u] = *(const u32x4*)(YR + m * 512 + c); gb[u] = *(const u32x2*)(GB + m * 512 + c); rkb[u] = SC[(m * 8 + h) * 4 + 2]; }
#pragma unroll
        for (int u = 0; u < 2; ++u) {
            float y[4] = {bf_lo(yv[u].x), bf_lo(yv[u].y), bf_lo(yv[u].z), bf_lo(yv[u].w)};
            const float v[4] = {bf_hi(yv[u].x), bf_hi(yv[u].y), bf_hi(yv[u].z), bf_hi(yv[u].w)};
            float s = (y[0] + y[1]) + (y[2] + y[3]);
#pragma unroll
            for (int o = 1; o < 16; o <<= 1) s += __shfl_xor(s, o);
            const float mean = s * (1.f / 64.f);
            float q = 0.f;
#pragma unroll
            for (int j = 0; j < 4; ++j) { y[j] -= mean; q += y[j] * y[j]; }
#pragma unroll
            for (int o = 1; o < 16; o <<= 1) q += __shfl_xor(q, o);
            const float rstd = rsqrtf(q * (1.f / 64.f) + GN_EPS);
            const float g4[4] = {bf_lo(gb[u].x), bf_hi(gb[u].x), bf_lo(gb[u].y), bf_hi(gb[u].y)};
            float o4[4];
#pragma unroll
            for (int j = 0; j < 4; ++j) o4[j] = (y[j] * rstd * lwv[j] + lbv[j] + rkb[u] * v[j]) * g4[j];
            u32x2 ob; ob.x = cvt_pk_bf16(o4[0], o4[1]); ob.y = cvt_pk_bf16(o4[2], o4[3]);
            *(u32x2*)(ORW + mm[u] * 512 + c) = ob;
        }
    }
}

struct KV { bf16x8 k[4]; bf16x8 v[2][2]; };
__device__ __forceinline__ void attn_load(KV& T, const bf16_t* Kh, const bf16_t* Vh, int k0, int n, int hf) {
    const bf16_t* kp = Kh + (size_t)(k0 + n) * 512 + 8 * hf;
#pragma unroll
    for (int s = 0; s < 4; ++s) T.k[s] = *(const bf16x8*)(kp + 16 * s);
#pragma unroll
    for (int d = 0; d < 2; ++d)
#pragma unroll
        for (int sg = 0; sg < 2; ++sg) { const bf16_t* vp = Vh + (size_t)(32 * d + n) * SEQ + k0 + 16 * sg + 4 * hf;
            const u32x2 lo = *(const u32x2*)vp, hi = *(const u32x2*)(vp + 8); u32x4 t = {lo.x, lo.y, hi.x, hi.y}; T.v[d][sg] = __builtin_bit_cast(bf16x8, t); }
}
__device__ __forceinline__ void attn_wave(const Args& a, int bh, int w4, int lane) {
    const int b = bh >> 3, h = bh & 7, n = lane & 31, hf = lane >> 5;
    const size_t m0 = (size_t)b * SEQ;
    const bf16_t* Qh = (const bf16_t*)(a.ws + O_Q) + m0 * 512 + 64 * h;
    const bf16_t* Kh = (const bf16_t*)(a.ws + O_K) + m0 * 512 + 64 * h;
    const bf16_t* Vh = (const bf16_t*)(a.ws + O_VT) + (size_t)bh * 64 * SEQ;
    bf16_t* Oh = (bf16_t*)(a.ws + O_OSB) + m0 * 512 + 64 * h;
    for (int qt = 63 - w4; qt >= 0; qt -= 8) {
        const int q0 = 32 * qt;
        bf16x8 qf[4];
#pragma unroll
        for (int s = 0; s < 4; ++s) qf[s] = *(const bf16x8*)(Qh + (size_t)(q0 + n) * 512 + 16 * s + 8 * hf);
        f32x16 o0, o1;
#pragma unroll
        for (int i = 0; i < 16; ++i) { o0[i] = 0.f; o1[i] = 0.f; }
        float carry = 0.f;
        KV cur, nxt;
        attn_load(cur, Kh, Vh, q0, n, hf);
        for (int kt = qt; kt >= 0; --kt) {
            const int ktn = kt > 0 ? kt - 1 : 0;
            attn_load(nxt, Kh, Vh, 32 * ktn, n, hf);
            f32x16 sc;
#pragma unroll
            for (int i = 0; i < 16; ++i) sc[i] = 0.f;
#pragma unroll
            for (int s = 0; s < 4; ++s) sc = __builtin_amdgcn_mfma_f32_32x32x16_bf16(cur.k[s], qf[s], sc, 0, 0, 0);
            const bool diag = (kt == qt);
            float lf[16], G4[4];
#pragma unroll
            for (int g = 0; g < 4; ++g) { G4[g] = 0.f;
#pragma unroll
                for (int i = 0; i < 4; ++i) { const int r = 4 * g + i; const float z = sc[r];
                    const bool valid = !diag || (8 * g + 4 * hf + i < n);
                    const float e = fexp(-fabsf(z));
                    const float sp = fmaxf(z, 0.f) + flog(1.f + e);
                    lf[r] = valid ? -sp : 0.f; G4[g] += lf[r]; } }
            float PG[4], T4[4];
#pragma unroll
            for (int g = 0; g < 4; ++g) { PG[g] = __shfl_xor(G4[g], 32); T4[g] = G4[g] + PG[g]; }
            const float tail3 = 0.f, tail2 = T4[3], tail1 = T4[3] + T4[2], tail0 = tail1 + T4[1], total = tail0 + T4[0];
            const float tails[4] = {tail0, tail1, tail2, tail3};
            f32x16 wv;
#pragma unroll
            for (int g = 0; g < 4; ++g) {
                float af = carry + tails[g] + (hf == 0 ? PG[g] : 0.f);
#pragma unroll
                for (int i = 3; i >= 0; --i) { const int r = 4 * g + i; const float z = sc[r];
                    const bool valid = !diag || (8 * g + 4 * hf + i < n);
                    const float wgt = fexp(lf[r] + z + af);
                    wv[r] = valid ? wgt : 0.f;
                    af += lf[r]; } }
            carry += total;
            bf16x8 wf[2];
#pragma unroll
            for (int sg = 0; sg < 2; ++sg) { u32x4 t; t.x = cvt_pk_bf16(wv[8 * sg + 0], wv[8 * sg + 1]); t.y = cvt_pk_bf16(wv[8 * sg + 2], wv[8 * sg + 3]); t.z = cvt_pk_bf16(wv[8 * sg + 4], wv[8 * sg + 5]); t.w = cvt_pk_bf16(wv[8 * sg + 6], wv[8 * sg + 7]); wf[sg] = __builtin_bit_cast(bf16x8, t); }
#pragma unroll
            for (int sg = 0; sg < 2; ++sg) { o0 = __builtin_amdgcn_mfma_f32_32x32x16_bf16(cur.v[0][sg], wf[sg], o0, 0, 0, 0); o1 = __builtin_amdgcn_mfma_f32_32x32x16_bf16(cur.v[1][sg], wf[sg], o1, 0, 0, 0); }
            cur = nxt;
#if MK_EARLY_EXIT
            if (__all(carry < -104.f)) break;
#endif
        }
        bf16_t* op = Oh + (size_t)(q0 + n) * 512 + 4 * hf;
#pragma unroll
        for (int g = 0; g < 4; ++g) {
            u32x2 t0, t1; t0.x = cvt_pk_bf16(o0[4 * g], o0[4 * g + 1]); t0.y = cvt_pk_bf16(o0[4 * g + 2], o0[4 * g + 3]); t1.x = cvt_pk_bf16(o1[4 * g], o1[4 * g + 1]); t1.y = cvt_pk_bf16(o1[4 * g + 2], o1[4 * g + 3]);
            *(u32x2*)(op + 8 * g) = t0; *(u32x2*)(op + 32 + 8 * g) = t1; }
    }
}
__device__ __forceinline__ void phase_mixer(const Args& a, unsigned char* lds, int G) {
    const int tid = my_tid(); const int wave = __builtin_amdgcn_readfirstlane(tid >> 6), lane = tid & 63;
    for (int bh = blockIdx.x; bh < NB * NH; bh += G) {
        const int b = bh >> 3, h = bh & 7; const size_t m0 = (size_t)b * SEQ;
        const unsigned char* sb = a.ws + O_SI + (m0 * 8 + h) * 768; const float* scp = (const float*)(a.ws + O_SC) + (m0 * 8 + h) * 4;
        unsigned* yrb = (unsigned*)(a.ws + O_YR) + m0 * 512 + 64 * h + 16 * (wave & 3);
        const int pl = tid - 256;
        constexpr int NCH = SEQ / SC_T;
        ProdRec pr[4]; f32x2 S[8];
#pragma unroll
        for (int p = 0; p < 8; ++p) S[p] = (f32x2){0.f, 0.f};
        __syncthreads();
        if (wave >= 4) { prod_load(pr, sb, scp, 0, pl); prod_store(pr, lds, pl); prod_load(pr, sb, scp, 1, pl); }
        __syncthreads();
        for (int ci = 0; ci < NCH; ++ci) {
            if (wave < 4) scan_consume(S, lds + (ci & 1) * SC_BUF, yrb + (size_t)ci * SC_T * 512, lane, wave);
            else if (ci + 1 < NCH) { prod_store(pr, lds + ((ci + 1) & 1) * SC_BUF, pl); prod_load(pr, sb, scp, ci + 2 < NCH ? ci + 2 : ci + 1, pl); }
            __syncthreads();
        }
        attn_wave(a, bh, wave, lane);
        __threadfence_block(); __syncthreads();
        rwpost_local(a, bh, my_tid());
    }
}

template <int MODE> __device__ __forceinline__ void phase_rows(const Args& a, int G) {
    const int tid = my_tid(); const int wave = tid >> 6, lane = tid & 63;
    const int gw = blockIdx.x * 8 + wave, NGW = G * 8;
    const bf16_t* T = (const bf16_t*)(a.ws + (MODE == 0 ? O_TT : O_FF));
    const float* g1 = MODE == 0 ? a.in[18] : a.in[23]; const float* g2 = a.in[19];
    bf16_t* H2 = (bf16_t*)(a.ws + O_H2); bf16_t* X1B = (bf16_t*)(a.ws + O_X1B);
    f32x4 g1v[4], g2v[4];
#pragma unroll
    for (int j = 0; j < 4; ++j) { g1v[j] = ((const f32x4*)g1)[lane + 64 * j]; g2v[j] = ((const f32x4*)g2)[lane + 64 * j]; }
    for (int row0 = gw; row0 < M; row0 += 2 * NGW) {
        u32x2 tb[2][4]; f32x4 x[2][4];
#pragma unroll
        for (int u = 0; u < 2; ++u) { const int row = (row0 + u * NGW < M) ? row0 + u * NGW : row0;
            const u32x2* tr = (const u32x2*)(T + (size_t)row * D) + lane;
#pragma unroll
            for (int j = 0; j < 4; ++j) tb[u][j] = tr[64 * j];
            if (MODE == 0) { const f32x4* xr = (const f32x4*)(a.in[0] + (size_t)row * D) + lane;
#pragma unroll
                for (int j = 0; j < 4; ++j) x[u][j] = xr[64 * j]; }
            else { const u32x2* xr = (const u32x2*)(X1B + (size_t)row * D) + lane;
#pragma unroll
                for (int j = 0; j < 4; ++j) { const u32x2 xb = xr[64 * j]; x[u][j][0] = bf_lo(xb.x); x[u][j][1] = bf_hi(xb.x); x[u][j][2] = bf_lo(xb.y); x[u][j][3] = bf_hi(xb.y); } } }
#pragma unroll
        for (int u = 0; u < 2; ++u) {
            const int row = row0 + u * NGW;
            f32x4 t[4]; float s = 0.f;
#pragma unroll
            for (int j = 0; j < 4; ++j) { t[j][0] = bf_lo(tb[u][j].x); t[j][1] = bf_hi(tb[u][j].x); t[j][2] = bf_lo(tb[u][j].y); t[j][3] = bf_hi(tb[u][j].y);
                s += (t[j][0] * t[j][0] + t[j][1] * t[j][1]) + (t[j][2] * t[j][2] + t[j][3] * t[j][3]); }
            const float rs = rsqrtf(wave_sum(s) * (1.f / D) + RMS_EPS);
            float s2 = 0.f;
#pragma unroll
            for (int j = 0; j < 4; ++j)
#pragma unroll
                for (int e = 0; e < 4; ++e) { x[u][j][e] += t[j][e] * rs * g1v[j][e]; s2 += x[u][j][e] * x[u][j][e]; }
            float rs2 = 0.f;
            if (MODE == 0) rs2 = rsqrtf(wave_sum(s2) * (1.f / D) + RMS_EPS);
            if (row < M) {
                if (MODE == 0) {
                    u32x2* xo = (u32x2*)(X1B + (size_t)row * D) + lane; u32x2* o = (u32x2*)(H2 + (size_t)row * D) + lane;
#pragma unroll
                    for (int j = 0; j < 4; ++j) { u32x2 w; w.x = cvt_pk_bf16(x[u][j][0], x[u][j][1]); w.y = cvt_pk_bf16(x[u][j][2], x[u][j][3]); xo[64 * j] = w; }
#pragma unroll
                    for (int j = 0; j < 4; ++j) { u32x2 w; w.x = cvt_pk_bf16(x[u][j][0] * rs2 * g2v[j][0], x[u][j][1] * rs2 * g2v[j][1]); w.y = cvt_pk_bf16(x[u][j][2] * rs2 * g2v[j][2], x[u][j][3] * rs2 * g2v[j][3]); o[64 * j] = w; }
                } else {
                    f32x4* orow = (f32x4*)(a.out + (size_t)row * D) + lane;
#pragma unroll
                    for (int j = 0; j < 4; ++j) orow[64 * j] = x[u][j];
                }
            }
        }
    }
}

#define XB_TMO      128
#define XB_XCNT(j)  (256  + 64 * (j))
#define XB_XSUB(j)  (1280 + 64 * (j))
#define XB_XGEN(j)  (2304 + 64 * (j))
#define XB_TOP      3328
#define XB_TOPGEN   3392
#define XCD_BAR_WORDS 3456
#define XB_SPIN_CAP (1u << 18)

__device__ __forceinline__ unsigned xb_ld(unsigned* p)              { return __hip_atomic_load(p, __ATOMIC_RELAXED, __HIP_MEMORY_SCOPE_AGENT); }
__device__ __forceinline__ unsigned xb_add(unsigned* p, unsigned v) { return __hip_atomic_fetch_add(p, v, __ATOMIC_RELAXED, __HIP_MEMORY_SCOPE_AGENT); }
__device__ __forceinline__ unsigned xb_xcc_id() { return (unsigned)__builtin_amdgcn_s_getreg((3 << 11) | 20) & 0xFu; }
#define XB_SPIN(cond, bar) do { unsigned _sp = 0; while (cond) { __builtin_amdgcn_s_sleep(1); \
    if ((++_sp & 255u) == 0u) { if (xb_ld(&(bar)[XB_TMO])) break; if (_sp > XB_SPIN_CAP) { atomicAdd(&(bar)[XB_TMO], 1u); break; } } } } while (0)

struct XcdBarrier {
    unsigned* bar; unsigned x;
    volatile __attribute__((address_space(3))) unsigned* st;
};

__device__ __forceinline__ XcdBarrier xcd_barrier_post(unsigned* bar, volatile __attribute__((address_space(3))) unsigned* st) {
    XcdBarrier b; b.bar = bar; b.x = xb_xcc_id(); b.st = st;
    if (threadIdx.x == 0) (void)xb_add(&bar[XB_XCNT(b.x)], 1u);
    return b;
}
__device__ __forceinline__ void xcd_barrier_complete(unsigned* bar, unsigned x, unsigned& nloc, unsigned& nx) {
    const unsigned G = gridDim.x * gridDim.y * gridDim.z;
    unsigned sum, cnt, mine, sp = 0u;
    for (;;) {
        sum = 0u; cnt = 0u; mine = 0u;
#pragma unroll
        for (unsigned j = 0; j < 16; ++j) { const unsigned c = xb_ld(&bar[XB_XCNT(j)]); sum += c; cnt += (c > 0u) ? 1u : 0u; mine = (j == x) ? c : mine; }
        if (sum == G) break;
        __builtin_amdgcn_s_sleep(1);
        if ((++sp & 255u) == 0u) { if (xb_ld(&bar[XB_TMO])) break; if (sp > XB_SPIN_CAP) { atomicAdd(&bar[XB_TMO], 1u); break; } }
    }
    nloc = mine > 0u ? mine : 1u; nx = cnt > 0u ? cnt : 1u;
}

__device__ __forceinline__ void xcd_barrier(const XcdBarrier& b) {
    asm volatile("s_waitcnt vmcnt(0)" ::: "memory");
    __syncthreads();
    if (threadIdx.x == 0) {
        unsigned* bar = b.bar;
        __builtin_amdgcn_s_waitcnt(0);
        unsigned nloc = b.st[0], nx = b.st[1];
        if (nloc == 0u) { xcd_barrier_complete(bar, b.x, nloc, nx); b.st[0] = nloc; b.st[1] = nx; }
        const unsigned old = xb_add(&bar[XB_XSUB(b.x)], 1u);
        const unsigned gen = old / nloc;
        if (old + 1u == (gen + 1u) * nloc) {
            __builtin_amdgcn_fence(__ATOMIC_RELEASE, "agent");
            asm volatile("s_waitcnt vmcnt(0)" ::: "memory");
            const unsigned og = xb_add(&bar[XB_TOP], 1u);
            const unsigned tg = og / nx;
            if (og + 1u == (tg + 1u) * nx) xb_add(&bar[XB_TOPGEN], 1u);
            else XB_SPIN(xb_ld(&bar[XB_TOPGEN]) == tg, bar);
            __builtin_amdgcn_fence(__ATOMIC_ACQUIRE, "agent");
            xb_add(&bar[XB_XGEN(b.x)], 1u);
            asm volatile("s_waitcnt vmcnt(0)" ::: "memory");
        } else {
            XB_SPIN(xb_ld(&bar[XB_XGEN(b.x)]) == gen, bar);
            __builtin_amdgcn_fence(__ATOMIC_ACQUIRE, "agent");
            asm volatile("s_waitcnt vmcnt(0)" ::: "memory");
        }
    }
    __syncthreads();
}

__global__ void __launch_bounds__(512, 2) mega(Args a) {
    extern __shared__ __attribute__((aligned(16))) unsigned char shm[];
    PG8_LAS unsigned char* lds = (PG8_LAS unsigned char*)shm;
    const int G = (int)gridDim.x;
    unsigned char* ws = a.ws;
    volatile __attribute__((address_space(3))) unsigned* bst = (volatile __attribute__((address_space(3))) unsigned*)(lds + pg8::STAGE_BYTES);
    if (threadIdx.x == 0) { bst[0] = 0u; bst[1] = 0u; }
    __syncthreads();
    const XcdBarrier bar = xcd_barrier_post((unsigned*)(ws + O_CTL), bst);
    phase_prep(a, (float*)shm, G);
    cg::this_grid().sync();
    { Epi1 E; E.Q = (bf16_t*)(ws + O_Q); E.Kb = (bf16_t*)(ws + O_K); E.Vt = (bf16_t*)(ws + O_VT); E.Prw = (bf16_t*)(ws + O_PRW); E.Gt = (bf16_t*)a.out; E.bgate = a.in[3];
      run_gemm(lds, (const bf16_t*)(ws + O_H), (const bf16_t*)(ws + O_WIN), INC, 1024, E, G); }
    xcd_barrier(bar);
    phase_rwprep(a, shm, G);
    xcd_barrier(bar);
    phase_mixer(a, shm, G);
    xcd_barrier(bar);
    { EpiRow<1> E; E.O = (bf16_t*)(ws + O_T1); E.T1 = nullptr; E.Gt = (const bf16_t*)a.out;
      run_gemm(lds, (const bf16_t*)(ws + O_OSB), (const bf16_t*)(ws + O_WSB), 1024, 512, E, G); }
    { EpiRow<2> E; E.O = (bf16_t*)(ws + O_MRG); E.T1 = (const bf16_t*)(ws + O_T1); E.Gt = (const bf16_t*)a.out;
      run_gemm(lds, (const bf16_t*)(ws + O_ORW), (const bf16_t*)(ws + O_WRW), 1024, 512, E, G); }
    xcd_barrier(bar);
    { EpiRow<0> E; E.O = (bf16_t*)(ws + O_TT); E.T1 = nullptr; E.Gt = nullptr;
      run_gemm(lds, (const bf16_t*)(ws + O_MRG), (const bf16_t*)(ws + O_WO), 1024, 1024, E, G); }
    xcd_barrier(bar);
    phase_rows<0>(a, G);
    xcd_barrier(bar);
    { EpiSwiGLU E; E.Hd = (bf16_t*)(ws + O_HID);
      run_gemm(lds, (const bf16_t*)(ws + O_H2), (const bf16_t*)(ws + O_WGU), 2 * DFF, 1024, E, G); }
    xcd_barrier(bar);
    { EpiRow<0> E; E.O = (bf16_t*)(ws + O_FF); E.T1 = nullptr; E.Gt = nullptr;
      run_gemm(lds, (const bf16_t*)(ws + O_HID), (const bf16_t*)(ws + O_WDN), 1024, DFF, E, G); }
    xcd_barrier(bar);
    phase_rows<1>(a, G);
}
}

extern "C" void kernel_launch(void* const* d_in, const int* in_sizes, int n_in, void* d_out, int out_size, void* d_ws, size_t ws_size, hipStream_t stream) {
    static int grid = 0;
    if (grid == 0) {
        if (n_in != 24 || in_sizes[0] != mk::M * mk::D || out_size != mk::M * mk::D || ws_size < mk::WS_NEED) {
            fprintf(stderr, "kernel_launch: unexpected shapes: n_in %d in0 %d out %d ws %zu (need %zu)\n", n_in, n_in > 0 ? in_sizes[0] : -1, out_size, ws_size, (size_t)mk::WS_NEED); grid = -1; return; }
        int dev = 0, cus = 0, per_cu = 0;
        hipGetDevice(&dev); hipDeviceGetAttribute(&cus, hipDeviceAttributeMultiprocessorCount, dev);
        if (hipFuncSetAttribute((const void*)mk::mega, hipFuncAttributeMaxDynamicSharedMemorySize, mk::LDS_BYTES) != hipSuccess) { fprintf(stderr, "kernel_launch: hipFuncSetAttribute failed\n"); grid = -1; return; }
        if (hipOccupancyMaxActiveBlocksPerMultiprocessor(&per_cu, (const void*)mk::mega, 512, mk::LDS_BYTES) != hipSuccess || per_cu < 1) { fprintf(stderr, "kernel_launch: occupancy query failed (%d)\n", per_cu); per_cu = 1; }
        (void)hipGetLastError();
        grid = cus * per_cu;
        fprintf(stderr, "kernel_launch: grid %d (cus %d x %d)\n", grid, cus, per_cu);
    }
    if (grid < 0) return;
    mk::Args a{};
    for (int i = 0; i < 24; ++i) a.in[i] = (const float*)d_in[i];
    a.out = (float*)d_out; a.ws = (unsigned char*)d_ws;
    a.ph_lo = 0; a.ph_hi = mk::NPH;
    if (hipMemsetAsync((char*)d_ws + mk::O_CTL, 0, mk::CTL_BYTES, stream) != hipSuccess) { fprintf(stderr, "kernel_launch: hipMemsetAsync failed\n"); return; }
    void* args[] = {&a};
    hipError_t e = hipLaunchCooperativeKernel((const void*)mk::mega, dim3(grid), dim3(512), args, mk::LDS_BYTES, stream);
    if (e != hipSuccess) fprintf(stderr, "kernel_launch: cooperative launch failed: %s (grid %d)\n", hipGetErrorString(e), grid);
}
```

```cpp
#include <hip/hip_runtime.h>
#include <hip/hip_cooperative_groups.h>
#include <cstdio>
#include <cstdint>
namespace cg = cooperative_groups;
#ifndef MK_SPLIT
#define MK_SPLIT 0
#endif
#ifndef MK_DIAG
#define MK_DIAG 0
#endif
#ifndef MK_REPMASK
#define MK_REPMASK 0
#endif
#ifndef MK_EARLY_EXIT
#define MK_EARLY_EXIT 1
#endif
namespace pg8 {
#define PG8_LAS __attribute__((address_space(3)))
typedef unsigned short bf16_t;
typedef short bf16x8 __attribute__((ext_vector_type(8)));
typedef float f32x4 __attribute__((ext_vector_type(4)));
typedef unsigned u32x4 __attribute__((ext_vector_type(4)));
constexpr int BM = 256, BK = 64, HALF = 128, HTB = HALF * BK * 2  , STAGE_BYTES = 8 * HTB, NXCD = 8, WGM = 8;

__host__ __device__ __forceinline__ int lds_byte(int r, int c) { const int st = (r >> 4) * 2 + (c >> 5), rr = r & 15, cc = c & 31, ob = rr * 64 + cc * 2; return st * 1024 + (ob ^ (((ob >> 9) & 1) << 5)); }
__host__ __device__ __forceinline__ void stage_rc(int b, int& R, int& C) { const int st = b / 1024, sb = b % 1024, swz = sb ^ (((sb >> 9) & 1) << 5); R = (st >> 1) * 16 + swz / 64; C = (st & 1) * 32 + (swz % 64) / 2; }
__host__ __device__ __forceinline__ int perm32(int rho) { const int n = rho >> 4, i = rho & 15; return 8 * (i >> 2) + 4 * n + (i & 3); }

struct Unit { int pm, pn; };
struct Gemm { const bf16_t* A; const bf16_t* Bt; int M, N, K; };

struct StaticOrder {
    int nM, nN, nwg, G, c;
    __host__ __device__ void init(int M, int N, int G_, int c_) { nM = M / BM; nN = N / BM; nwg = nM * nN; G = G_; c = c_; }
    __host__ __device__ bool next(int i, Unit& u) const {
        const long L = (long)i * G + c; if (L >= nwg) return false;
        int wgid = (int)L; { const int q = nwg / NXCD, r = nwg % NXCD, xcd = wgid % NXCD, off = wgid / NXCD; wgid = (xcd < r ? xcd * (q + 1) : r * (q + 1) + (xcd - r) * q) + off; }
        const int nig = WGM * nN, gid = wgid / nig, fm = gid * WGM, gsz = (nM - fm) < WGM ? (nM - fm) : WGM;
        u.pm = fm + ((wgid % nig) % gsz); u.pn = (wgid % nig) / gsz; return true;
    }
    __device__ __forceinline__ void a_ready(const Unit&) const {}
    __device__ __forceinline__ void done(const Unit&) const {}
};

__device__ __forceinline__ unsigned cvt_pk_bf16(float lo, float hi) { unsigned r; asm volatile("v_cvt_pk_bf16_f32 %0, %1, %2" : "=v"(r) : "v"(lo), "v"(hi)); return r; }
typedef float f32x2 __attribute__((ext_vector_type(2)));

template <class Epi, class Sched, bool ALIGN_EPI = false, bool SP2 = false>
__device__ __forceinline__ void gemm_phase(PG8_LAS unsigned char* lds, const Gemm g, const Sched& S, const Epi& E) {
    int tid_ = threadIdx.x; asm volatile("" : "+v"(tid_)); const int tid = tid_, wid = __builtin_amdgcn_readfirstlane(tid >> 6), lane = tid & 63, wr = wid >> 2, wc = wid & 3, fr = lane & 15, fq = lane >> 4;
    const int K = g.K, nt = K / BK;
    unsigned voffA[2], voffB[2];
#pragma unroll
    for (int i = 0; i < 2; ++i) { int R, C; stage_rc(tid * 16 + i * 8192, R, C); const int Rb = Epi::PERM ? ((R & ~31) + perm32(R & 31)) : R;
        voffA[i] = (unsigned)(R * K + C) * 2u; voffB[i] = (unsigned)(Rb * K + C) * 2u; }
    const size_t kstep = (size_t)(BK * 2);
    const size_t hstep = (size_t)HALF * K * 2;
    const size_t tstep = 2 * hstep;
    const unsigned ldsw = (unsigned)wid * 1024u;
    const int aoff = lds_byte(wr * 64 + fr, fq * 8), boff = lds_byte(wc * 32 + fr, fq * 8);
#define PG8_SA(b, h) (((b) * 2 + (h)) * HTB)
#define PG8_SB(b, h) ((4 + (b) * 2 + (h)) * HTB)
#define PG8_STAGE(bufoff, gbase, voff) do { _Pragma("unroll") for (int _i = 0; _i < 2; ++_i) \
        __builtin_amdgcn_global_load_lds((const unsigned*)((const char*)(gbase) + (voff)[_i]), (PG8_LAS unsigned*)(lds + (bufoff) + ldsw + _i * 8192), 16, 0, 0); } while (0)
#define PG8_LDA(dst, b, h) do { _Pragma("unroll") for (int m = 0; m < 4; ++m) _Pragma("unroll") for (int k = 0; k < 2; ++k) dst[m][k] = *(const PG8_LAS bf16x8*)(lds + PG8_SA(b, h) + aoff + m * 2048 + k * 1024); } while (0)
#define PG8_LDB(dst, b, h) do { _Pragma("unroll") for (int n = 0; n < 2; ++n) _Pragma("unroll") for (int k = 0; k < 2; ++k) dst[n][k] = *(const PG8_LAS bf16x8*)(lds + PG8_SB(b, h) + boff + n * 2048 + k * 1024); } while (0)
#define PG8_MMA(ai, bj, At, Bt) do { __builtin_amdgcn_s_setprio(1); _Pragma("unroll") for (int m = 0; m < 4; ++m) _Pragma("unroll") for (int n = 0; n < 2; ++n) _Pragma("unroll") for (int k = 0; k < 2; ++k) \
        acc[ai][bj][m][n] = __builtin_amdgcn_mfma_f32_16x16x32_bf16(Bt[n][k], At[m][k], acc[ai][bj][m][n], 0, 0, 0); __builtin_amdgcn_s_setprio(0); } while (0)
#define PG8_WAIT_V(n) asm volatile("s_waitcnt vmcnt(" #n ")" ::: "memory")
#define PG8_WAIT_L(n) asm volatile("s_waitcnt lgkmcnt(" #n ")" ::: "memory")
#define PG8_BAR __builtin_amdgcn_s_barrier()
#define PG8_SCHED __builtin_amdgcn_sched_barrier(0)
    Unit cur, nxt; int ui = 0;
    if (!S.next(0, cur)) return;
    f32x4 acc[2][2][4][2];
#pragma unroll
    for (int a = 0; a < 2; ++a)
#pragma unroll
        for (int b = 0; b < 2; ++b)
#pragma unroll
            for (int m = 0; m < 4; ++m)
#pragma unroll
                for (int n = 0; n < 2; ++n) acc[a][b][m][n] = (f32x4){0.f, 0.f, 0.f, 0.f};
    bf16x8 At[4][2], B0[2][2], B1[2][2];
    const char* cA = (const char*)g.A + (size_t)cur.pm * tstep; const char* cB = (const char*)g.Bt + (size_t)cur.pn * tstep;
    S.a_ready(cur);
    if constexpr (SP2) {
        PG8_STAGE(PG8_SB(0, 0), cB, voffB); PG8_STAGE(PG8_SB(0, 1), cB + hstep, voffB); PG8_STAGE(PG8_SA(0, 0), cA, voffA); PG8_STAGE(PG8_SA(0, 1), cA + hstep, voffA);
        if (wr == 1) PG8_BAR;
        PG8_WAIT_V(2); PG8_BAR;
        PG8_STAGE(PG8_SB(1, 0), cB + kstep, voffB); PG8_STAGE(PG8_SA(1, 0), cA + kstep, voffA); PG8_STAGE(PG8_SB(1, 1), cB + hstep + kstep, voffB);
        PG8_WAIT_V(6); PG8_BAR;
    } else {
        PG8_STAGE(PG8_SB(0, 0), cB, voffB); PG8_STAGE(PG8_SA(0, 0), cA, voffA); PG8_STAGE(PG8_SB(0, 1), cB + hstep, voffB); PG8_STAGE(PG8_SA(0, 1), cA + hstep, voffA);
        if (wr == 1) PG8_BAR;
        PG8_WAIT_V(4); PG8_BAR;
        PG8_STAGE(PG8_SB(1, 0), cB + kstep, voffB); PG8_STAGE(PG8_SA(1, 0), cA + kstep, voffA); PG8_STAGE(PG8_SB(1, 1), cB + hstep + kstep, voffB);
        PG8_WAIT_V(6); PG8_BAR;
    }
    for (;;) {
        const bool has_next = S.next(ui + 1, nxt);
        const char* nA = has_next ? (const char*)g.A + (size_t)nxt.pm * tstep : cA; const char* nB = has_next ? (const char*)g.Bt + (size_t)nxt.pn * tstep : cB;
        for (int t = 0; t < nt; t += 2) {
            const bool last = (t == nt - 2);
            const char* a1 = cA + (size_t)(t + 1) * kstep;
            const char* a2 = last ? nA : cA + (size_t)(t + 2) * kstep; const char* b2 = last ? nB : cB + (size_t)(t + 2) * kstep;
            const char* a3 = a2 + kstep; const char* b3 = b2 + kstep;
            if (last && has_next) S.a_ready(nxt);
            if constexpr (SP2) {
            PG8_LDB(B0, 0, 0); PG8_LDB(B1, 0, 1); PG8_SCHED; PG8_LDA(At, 0, 0); PG8_STAGE(PG8_SA(1, 1), a1 + hstep, voffA);
            PG8_WAIT_V(8); PG8_WAIT_L(0); PG8_BAR; PG8_MMA(0, 0, At, B0); PG8_MMA(0, 1, At, B1); PG8_BAR; PG8_SCHED;
            PG8_LDA(At, 0, 1); PG8_STAGE(PG8_SB(0, 0), b2, voffB); PG8_STAGE(PG8_SB(0, 1), b2 + hstep, voffB); PG8_STAGE(PG8_SA(0, 0), a2, voffA);
            PG8_WAIT_V(8); PG8_WAIT_L(0); PG8_BAR; PG8_MMA(1, 0, At, B0); PG8_MMA(1, 1, At, B1); PG8_BAR; PG8_SCHED;
            PG8_LDB(B0, 1, 0); PG8_LDB(B1, 1, 1); PG8_SCHED; PG8_LDA(At, 1, 0); PG8_STAGE(PG8_SA(0, 1), a2 + hstep, voffA);
            PG8_WAIT_V(8); PG8_WAIT_L(0); PG8_BAR; PG8_MMA(0, 0, At, B0); PG8_MMA(0, 1, At, B1); PG8_BAR; PG8_SCHED;
            PG8_LDA(At, 1, 1); PG8_STAGE(PG8_SB(1, 0), b3, voffB); PG8_STAGE(PG8_SB(1, 1), b3 + hstep, voffB); PG8_STAGE(PG8_SA(1, 0), a3, voffA);
            PG8_WAIT_V(8); PG8_WAIT_L(0); PG8_BAR; PG8_MMA(1, 0, At, B0); PG8_MMA(1, 1, At, B1); PG8_BAR; PG8_SCHED;
            } else {
            PG8_LDB(B0, 0, 0); PG8_SCHED; PG8_LDA(At, 0, 0); PG8_STAGE(PG8_SA(1, 1), a1 + hstep, voffA);
            PG8_WAIT_L(8); PG8_BAR; PG8_WAIT_L(0); PG8_MMA(0, 0, At, B0); PG8_BAR; PG8_SCHED;
            PG8_LDB(B1, 0, 1); PG8_STAGE(PG8_SB(0, 0), b2, voffB);
            PG8_BAR; PG8_WAIT_L(0); PG8_MMA(0, 1, At, B1); PG8_BAR;
            PG8_LDA(At, 0, 1); PG8_STAGE(PG8_SA(0, 0), a2, voffA);
            PG8_BAR; PG8_WAIT_L(0); PG8_MMA(1, 0, At, B0); PG8_BAR; PG8_SCHED;
            PG8_STAGE(PG8_SB(0, 1), b2 + hstep, voffB);
            PG8_WAIT_V(6); PG8_BAR; PG8_MMA(1, 1, At, B1); PG8_BAR;
            PG8_LDB(B0, 1, 0); PG8_SCHED; PG8_LDA(At, 1, 0); PG8_STAGE(PG8_SA(0, 1), a2 + hstep, voffA);
            PG8_WAIT_L(8); PG8_BAR; PG8_WAIT_L(0); PG8_MMA(0, 0, At, B0); PG8_BAR; PG8_SCHED;
            PG8_LDB(B1, 1, 1); PG8_STAGE(PG8_SB(1, 0), b3, voffB);
            PG8_BAR; PG8_WAIT_L(0); PG8_MMA(0, 1, At, B1); PG8_BAR;
            PG8_LDA(At, 1, 1); PG8_STAGE(PG8_SA(1, 0), a3, voffA);
            PG8_BAR; PG8_WAIT_L(0); PG8_MMA(1, 0, At, B0); PG8_BAR; PG8_SCHED;
            PG8_STAGE(PG8_SB(1, 1), b3 + hstep, voffB);
            PG8_WAIT_V(6); PG8_BAR; PG8_MMA(1, 1, At, B1); PG8_BAR;
            }
        }
        if constexpr (ALIGN_EPI) { if (wr == 0) PG8_BAR; }
        if constexpr (!Epi::AFTER_DRAIN) { E(acc, cur, wr, wc, fr, fq); S.done(cur); }
        if (!has_next) break;
#pragma unroll
        for (int a = 0; a < 2; ++a)
#pragma unroll
            for (int b = 0; b < 2; ++b)
#pragma unroll
                for (int m = 0; m < 4; ++m)
#pragma unroll
                    for (int n = 0; n < 2; ++n) acc[a][b][m][n] = (f32x4){0.f, 0.f, 0.f, 0.f};
        cur = nxt; cA = nA; cB = nB; ++ui;
        if constexpr (ALIGN_EPI) { if (wr == 1) PG8_BAR; }
    }
    PG8_WAIT_V(0);
    if constexpr (!ALIGN_EPI) { if (wr == 0) PG8_BAR; }
    PG8_BAR;
    if constexpr (Epi::AFTER_DRAIN) { E.fused(acc, cur, wr, wc, fr, fq, lds, wid, lane); S.done(cur); }
#undef PG8_SA
#undef PG8_SB
#undef PG8_STAGE
#undef PG8_LDA
#undef PG8_LDB
#undef PG8_MMA
#undef PG8_WAIT_V
#undef PG8_WAIT_L
#undef PG8_BAR
#undef PG8_SCHED
}

}
namespace mk {
using pg8::bf16_t; using pg8::bf16x8; using pg8::f32x4; using pg8::u32x4; using pg8::cvt_pk_bf16;
typedef float f32x16 __attribute__((ext_vector_type(16)));
typedef float f32x2 __attribute__((ext_vector_type(2)));
typedef unsigned u32x2 __attribute__((ext_vector_type(2)));
constexpr int D = 1024, NB = 32, SEQ = 2048, M = NB * SEQ, NH = 8, DH = 64;
constexpr int RWC = 1792, GC = 2048, INC = 5376, DFF = 2816;
constexpr float RMS_EPS = 1e-6f, GN_EPS = 64e-5f;
constexpr size_t MiB = (size_t)1 << 20;
constexpr size_t O_WIN = 0, O_WSB = 11 * MiB, O_WRW = 12 * MiB, O_WO = 13 * MiB, O_WGU = 15 * MiB, O_WDN = 26 * MiB, O_WLU = 32 * MiB  , O_WLA = O_WLU + 65536, O_WLG = O_WLA + 65536;
constexpr size_t O_Q = 34 * MiB, O_K = 98 * MiB, O_VT = 162 * MiB, O_PRW = 226 * MiB, O_H = 450 * MiB, O_SI = 450 * MiB, O_G = 834 * MiB, O_SC = 898 * MiB, O_YR = 290 * MiB  ;
constexpr size_t O_OSB = 226 * MiB, O_ORW = 34 * MiB, O_T1 = 98 * MiB, O_MRG = 450 * MiB, O_TT = 34 * MiB, O_H2 = 162 * MiB, O_HID = 290 * MiB, O_FF = 34 * MiB;
constexpr size_t O_X1B = 706 * MiB;
constexpr size_t WS_NEED = 1009 * MiB;
constexpr int LDS_BYTES = pg8::STAGE_BYTES + 64;
constexpr size_t O_CTL = 1008 * MiB, CTL_BYTES = 65536;
constexpr int NPH = 12;

struct Args { const float* in[24]; float* out; unsigned char* ws; int ph_lo, ph_hi; };

__device__ __forceinline__ int my_tid() { int t = threadIdx.x; asm volatile("" : "+v"(t)); return t; }
__device__ __forceinline__ float bf_lo(unsigned u) { return __uint_as_float(u << 16); }
__device__ __forceinline__ float bf_hi(unsigned u) { return __uint_as_float(u & 0xffff0000u); }
__device__ __forceinline__ float fexp(float x) { return __builtin_amdgcn_exp2f(x * 1.44269504089f); }
__device__ __forceinline__ float flog(float x) { return __builtin_amdgcn_logf(x) * 0.69314718056f; }
__device__ __forceinline__ float frcp(float x) { return __builtin_amdgcn_rcpf(x); }
__device__ __forceinline__ float fsigmoid(float x) { return frcp(1.f + fexp(-x)); }
__device__ __forceinline__ unsigned short bf1(float x) { return (unsigned short)(cvt_pk_bf16(x, x) & 0xffffu); }
__device__ __forceinline__ u32x4 pack8(const f32x4 a, const f32x4 b) { u32x4 o; o.x = cvt_pk_bf16(a[0], a[1]); o.y = cvt_pk_bf16(a[2], a[3]); o.z = cvt_pk_bf16(b[0], b[1]); o.w = cvt_pk_bf16(b[2], b[3]); return o; }
__device__ __forceinline__ float red16(float v) {
    v += __shfl_xor(v, 16); v += __shfl_xor(v, 32); return v;
}
__device__ __forceinline__ float wave_sum(float v) {
#pragma unroll
    for (int o = 1; o < 64; o <<= 1) v += __shfl_xor(v, o);
    return v;
}

__device__ __forceinline__ void tr_item(const float* __restrict__ W, int K, int N, bf16_t* WT, float* scr, int item, int lane, int mode) {
    const int nblk = N >> 5, kb = item / nblk, nb = item - kb * nblk, k0 = kb << 6, n0 = nb << 5;
#pragma unroll 8
    for (int i = 0; i < 32; ++i) { const int kk = 2 * i + (lane >> 5); scr[kk * 33 + (lane & 31)] = W[(size_t)(k0 + kk) * N + n0 + (lane & 31)]; }
    asm volatile("s_waitcnt lgkmcnt(0)" ::: "memory"); __builtin_amdgcn_wave_barrier();
    const int c = lane & 7;
#pragma unroll
    for (int j = 0; j < 4; ++j) {
        const int n = (lane >> 3) + 8 * j; const float* s = scr + (8 * c) * 33 + n;
        u32x4 o; o.x = cvt_pk_bf16(s[0 * 33], s[1 * 33]); o.y = cvt_pk_bf16(s[2 * 33], s[3 * 33]); o.z = cvt_pk_bf16(s[4 * 33], s[5 * 33]); o.w = cvt_pk_bf16(s[6 * 33], s[7 * 33]);
        const int nn = n0 + n; int drow = nn;
        if (mode == 1) drow = ((nn >> 7) << 8) + (nn & 127); else if (mode == 2) drow = ((nn >> 7) << 8) + 128 + (nn & 127);
        *(u32x4*)(WT + (size_t)drow * K + k0 + 8 * c) = o;
    }
    asm volatile("s_waitcnt lgkmcnt(0)" ::: "memory"); __builtin_amdgcn_wave_barrier();
}

__device__ __forceinline__ void phase_prep(const Args& a, float* lds_f, int G) {
    const int tid = my_tid(); const int wave = tid >> 6, lane = tid & 63;
    const int gw = blockIdx.x * 8 + wave, NGW = G * 8;
    float* scr = lds_f + wave * (64 * 33 + 16);
    unsigned char* ws = a.ws;
    constexpr int I_IN = 16 * 168, I_SB = 8 * 32, I_O = 16 * 32, I_G = 16 * 88, I_DN = 44 * 32, I_LU = 16, I_LG = 32;
    constexpr int NIT = I_IN + 2 * I_SB + I_O + 2 * I_G + I_DN + 2 * I_LU + I_LG;
    for (int it = gw; it < NIT; it += NGW) {
        int r = it;
        if (r < I_IN) { tr_item(a.in[2], 1024, INC, (bf16_t*)(ws + O_WIN), scr, r, lane, 0); continue; } r -= I_IN;
        if (r < I_SB) { tr_item(a.in[15], 512, 1024, (bf16_t*)(ws + O_WSB), scr, r, lane, 0); continue; } r -= I_SB;
        if (r < I_SB) { tr_item(a.in[16], 512, 1024, (bf16_t*)(ws + O_WRW), scr, r, lane, 0); continue; } r -= I_SB;
        if (r < I_O) { tr_item(a.in[17], 1024, 1024, (bf16_t*)(ws + O_WO), scr, r, lane, 0); continue; } r -= I_O;
        if (r < I_G) { tr_item(a.in[20], 1024, DFF, (bf16_t*)(ws + O_WGU), scr, r, lane, 1); continue; } r -= I_G;
        if (r < I_G) { tr_item(a.in[21], 1024, DFF, (bf16_t*)(ws + O_WGU), scr, r, lane, 2); continue; } r -= I_G;
        if (r < I_DN) { tr_item(a.in[22], DFF, 1024, (bf16_t*)(ws + O_WDN), scr, r, lane, 0); continue; } r -= I_DN;
        if (r < I_LU) { tr_item(a.in[6], 64, 512, (bf16_t*)(ws + O_WLU), scr, r, lane, 0); continue; } r -= I_LU;
        if (r < I_LU) { tr_item(a.in[8], 64, 512, (bf16_t*)(ws + O_WLA), scr, r, lane, 0); continue; } r -= I_LU;
        tr_item(a.in[9], 128, 512, (bf16_t*)(ws + O_WLG), scr, r, lane, 0);
    }
    const float* x = a.in[0]; const float* g = a.in[1]; bf16_t* H = (bf16_t*)(ws + O_H);
    f32x4 gv[4];
#pragma unroll
    for (int j = 0; j < 4; ++j) gv[j] = ((const f32x4*)g)[lane + 64 * j];
    for (int row0 = gw; row0 < M; row0 += 2 * NGW) {
        f32x4 v[2][4];
#pragma unroll
        for (int u = 0; u < 2; ++u) { const int row = (row0 + u * NGW < M) ? row0 + u * NGW : row0; const f32x4* xr = (const f32x4*)(x + (size_t)row * D) + lane;
#pragma unroll
            for (int j = 0; j < 4; ++j) v[u][j] = xr[64 * j]; }
#pragma unroll
        for (int u = 0; u < 2; ++u) { const int row = row0 + u * NGW; float s = 0.f;
#pragma unroll
            for (int j = 0; j < 4; ++j) s += (v[u][j][0] * v[u][j][0] + v[u][j][1] * v[u][j][1]) + (v[u][j][2] * v[u][j][2] + v[u][j][3] * v[u][j][3]);
            const float rs = rsqrtf(wave_sum(s) * (1.f / D) + RMS_EPS);
            if (row < M) { u32x2* o = (u32x2*)(H + (size_t)row * D) + lane;
#pragma unroll
                for (int j = 0; j < 4; ++j) { u32x2 w; w.x = cvt_pk_bf16(v[u][j][0] * rs * gv[j][0], v[u][j][1] * rs * gv[j][1]); w.y = cvt_pk_bf16(v[u][j][2] * rs * gv[j][2], v[u][j][3] * rs * gv[j][3]); o[64 * j] = w; } }
        }
    }
}

struct Epi1 {
    static constexpr bool PERM = true, AFTER_DRAIN = false;
    bf16_t *Q, *Kb, *Vt, *Prw, *Gt; const float* bgate;
    __device__ __forceinline__ void operator()(const f32x4 (&acc)[2][2][4][2], const pg8::Unit& u, int wr, int wc, int fr, int fq) const {
        const int row0 = u.pm * 256 + wr * 64 + fr, pn = u.pn, cl = wc * 32 + 8 * fq;
        if (pn < 4) {
            bf16_t* dst = pn < 2 ? Q : Kb; const float sc = pn < 2 ? 0.125f : 1.f; const int cb = (pn & 1) * 256 + cl;
#pragma unroll
            for (int ai = 0; ai < 2; ++ai)
#pragma unroll
                for (int m = 0; m < 4; ++m) { bf16_t* rp = dst + (size_t)(row0 + ai * 128 + m * 16) * 512 + cb;
#pragma unroll
                    for (int bj = 0; bj < 2; ++bj) *(u32x4*)(rp + bj * 128) = pack8(acc[ai][bj][m][0] * sc, acc[ai][bj][m][1] * sc); }
        } else if (pn < 6) {
#pragma unroll
            for (int ai = 0; ai < 2; ++ai)
#pragma unroll
                for (int m = 0; m < 4; ++m) { const int row = row0 + ai * 128 + m * 16, b = row >> 11, s = row & 2047;
#pragma unroll
                    for (int bj = 0; bj < 2; ++bj)
#pragma unroll
                        for (int n = 0; n < 2; ++n)
#pragma unroll
                            for (int j = 0; j < 4; ++j) { const int c = (pn - 4) * 256 + bj * 128 + cl + 4 * n + j;
                                Vt[((size_t)(b * 512 + c)) * 2048 + s] = bf1(acc[ai][bj][m][n][j]); } }
        } else if (pn < 13) {
            const int cb = (pn - 6) * 256 + cl;
#pragma unroll
            for (int ai = 0; ai < 2; ++ai)
#pragma unroll
                for (int m = 0; m < 4; ++m) { bf16_t* rp = Prw + (size_t)(row0 + ai * 128 + m * 16) * RWC + cb;
#pragma unroll
                    for (int bj = 0; bj < 2; ++bj) *(u32x4*)(rp + bj * 128) = pack8(acc[ai][bj][m][0], acc[ai][bj][m][1]); }
        } else {
            const int cb = (pn - 13) * 256 + cl;
#pragma unroll
            for (int ai = 0; ai < 2; ++ai)
#pragma unroll
                for (int m = 0; m < 4; ++m) { bf16_t* rp = Gt + (size_t)(row0 + ai * 128 + m * 16) * GC + cb;
#pragma unroll
                    for (int bj = 0; bj < 2; ++bj) { f32x4 v0 = acc[ai][bj][m][0] + *(const f32x4*)(bgate + cb + bj * 128), v1 = acc[ai][bj][m][1] + *(const f32x4*)(bgate + cb + bj * 128 + 4);
#pragma unroll
                        for (int j = 0; j < 4; ++j) { v0[j] = fsigmoid(v0[j]); v1[j] = fsigmoid(v1[j]); }
                        *(u32x4*)(rp + bj * 128) = pack8(v0, v1); } }
        }
    }
};
template <int MODE> struct EpiRow {
    static constexpr bool PERM = true, AFTER_DRAIN = false;
    bf16_t* O; const bf16_t* T1; const bf16_t* Gt;
    __device__ __forceinline__ void operator()(const f32x4 (&acc)[2][2][4][2], const pg8::Unit& u, int wr, int wc, int fr, int fq) const {
        const int row0 = u.pm * 256 + wr * 64 + fr, cb = u.pn * 256 + wc * 32 + 8 * fq;
#pragma unroll
        for (int ai = 0; ai < 2; ++ai)
#pragma unroll
            for (int m = 0; m < 4; ++m) { const size_t row = (size_t)(row0 + ai * 128 + m * 16);
#pragma unroll
                for (int bj = 0; bj < 2; ++bj) { f32x4 v0 = acc[ai][bj][m][0], v1 = acc[ai][bj][m][1]; const int c = cb + bj * 128;
                    if (MODE >= 1) { const u32x4 gg = *(const u32x4*)(Gt + row * GC + (MODE == 2 ? 1024 : 0) + c);
                        v0[0] *= bf_lo(gg.x); v0[1] *= bf_hi(gg.x); v0[2] *= bf_lo(gg.y); v0[3] *= bf_hi(gg.y); v1[0] *= bf_lo(gg.z); v1[1] *= bf_hi(gg.z); v1[2] *= bf_lo(gg.w); v1[3] *= bf_hi(gg.w); }
                    if (MODE == 2) { const u32x4 tt = *(const u32x4*)(T1 + row * 1024 + c);
                        v0[0] += bf_lo(tt.x); v0[1] += bf_hi(tt.x); v0[2] += bf_lo(tt.y); v0[3] += bf_hi(tt.y); v1[0] += bf_lo(tt.z); v1[1] += bf_hi(tt.z); v1[2] += bf_lo(tt.w); v1[3] += bf_hi(tt.w); }
                    *(u32x4*)(O + row * 1024 + c) = pack8(v0, v1); } }
    }
};
struct EpiSwiGLU {
    static constexpr bool PERM = true, AFTER_DRAIN = false;
    bf16_t* Hd;
    __device__ __forceinline__ void operator()(const f32x4 (&acc)[2][2][4][2], const pg8::Unit& u, int wr, int wc, int fr, int fq) const {
        const int row0 = u.pm * 256 + wr * 64 + fr, cb = u.pn * 128 + wc * 32 + 8 * fq;
#pragma unroll
        for (int ai = 0; ai < 2; ++ai)
#pragma unroll
            for (int m = 0; m < 4; ++m) { f32x4 v0, v1;
#pragma unroll
                for (int j = 0; j < 4; ++j) { const float g0 = acc[ai][0][m][0][j], g1 = acc[ai][0][m][1][j];
                    v0[j] = g0 * fsigmoid(g0) * acc[ai][1][m][0][j]; v1[j] = g1 * fsigmoid(g1) * acc[ai][1][m][1][j]; }
                *(u32x4*)(Hd + (size_t)(row0 + ai * 128 + m * 16) * DFF + cb) = pack8(v0, v1); }
    }
};
template <class Epi> __device__ __forceinline__ void run_gemm(PG8_LAS unsigned char* lds, const bf16_t* A, const bf16_t* Bt, int N, int K, const Epi& E, int G) {
    pg8::Gemm g; g.A = A; g.Bt = Bt; g.M = M; g.N = N; g.K = K;
    pg8::StaticOrder S; S.init(M, N, G, (int)blockIdx.x);
    pg8::gemm_phase<Epi, pg8::StaticOrder, true, true>(lds, g, S, E);
}
__device__ __forceinline__ void mix8_lds(const unsigned char* cur, const unsigned char* prv, const float* mu, float (&o)[8]) {
    const u32x4 c = *(const u32x4*)cur, p = *(const u32x4*)prv;
    const f32x4 m0 = *(const f32x4*)mu, m1 = *(const f32x4*)(mu + 4);
    const float mm[8] = {m0[0], m0[1], m0[2], m0[3], m1[0], m1[1], m1[2], m1[3]};
#pragma unroll
    for (int i = 0; i < 4; ++i) { const float cl = bf_lo(c[i]), ch = bf_hi(c[i]), pl = bf_lo(p[i]), ph = bf_hi(p[i]);
        o[2 * i] = cl + (pl - cl) * mm[2 * i]; o[2 * i + 1] = ch + (ph - ch) * mm[2 * i + 1]; }
}
__device__ __forceinline__ void mix4_lds(const unsigned char* cur, const unsigned char* prv, const float* mu, float (&o)[4]) {
    const u32x2 c = *(const u32x2*)cur, p = *(const u32x2*)prv;
    const f32x4 m0 = *(const f32x4*)mu;
#pragma unroll
    for (int i = 0; i < 2; ++i) { const float cl = bf_lo(c[i]), ch = bf_hi(c[i]), pl = bf_lo(p[i]), ph = bf_hi(p[i]);
        o[2 * i] = cl + (pl - cl) * m0[2 * i]; o[2 * i + 1] = ch + (ph - ch) * m0[2 * i + 1]; }
}
__device__ __forceinline__ bf16x8 pack_frag(const float (&v)[8]) {
    u32x4 o; o.x = cvt_pk_bf16(v[0], v[1]); o.y = cvt_pk_bf16(v[2], v[3]); o.z = cvt_pk_bf16(v[4], v[5]); o.w = cvt_pk_bf16(v[6], v[7]);
    return __builtin_bit_cast(bf16x8, o);
}
__device__ __forceinline__ void phase_rwprep(const Args& a, unsigned char* lds, int G) {
    constexpr int ROWB = 3600, L_FRAG = 17 * ROWB, L_PAR = L_FRAG + 8192, NCH = 17 * 224, NT = M / 16;
    const int tid = my_tid(); const int wave = __builtin_amdgcn_readfirstlane(tid >> 6), lane = tid & 63, fr = lane & 15, fq = lane >> 4;
    unsigned char* ws = a.ws;
    const unsigned char* PRW = ws + O_PRW;
    const bf16_t* WLU = (const bf16_t*)(ws + O_WLU); const bf16_t* WLA = (const bf16_t*)(ws + O_WLA); const bf16_t* WLG = (const bf16_t*)(ws + O_WLG);
    unsigned char* SI = ws + O_SI; bf16_t* GB = (bf16_t*)(ws + O_G); float* SC = (float*)(ws + O_SC);
    float* par = (float*)(lds + L_PAR);
    for (int i = tid; i < 1792 + 5 * 512; i += 512) {
        float v;
        if (i < 1792) v = a.in[4][i]; else { const int j = i - 1792, w = j >> 9, c = j & 511; v = (w == 0 ? a.in[5] : w == 1 ? a.in[7] : w == 2 ? a.in[10] : w == 3 ? a.in[11] : a.in[12])[c]; }
        par[i] = v;
    }
    for (int tile = blockIdx.x; tile < NT; tile += G) {
        __syncthreads();
        {   u32x4 pre[8];
#pragma unroll
            for (int j = 0; j < 8; ++j) { const int c = tid + 512 * j; pre[j] = (u32x4){0u, 0u, 0u, 0u};
                if (c < NCH) { const int row = c / 224, col = c - row * 224; const bool zero = (row == 0) && (((tile * 16) & (SEQ - 1)) == 0);
                    if (!zero) pre[j] = *(const u32x4*)(PRW + ((size_t)tile * 16 + row - 1) * (RWC * 2) + col * 16); } }
#pragma unroll
            for (int j = 0; j < 8; ++j) { const int c = tid + 512 * j; if (c < NCH) { const int row = c / 224, col = c - row * 224; *(u32x4*)(lds + row * ROWB + col * 16) = pre[j]; } }
        }
        __syncthreads();
        const unsigned char* rcur = lds + (fr + 1) * ROWB; const unsigned char* rprv = lds + fr * ROWB;
        {
            const int colb = wave < 2 ? 1536 + 32 * wave : (wave < 4 ? 1600 + 32 * (wave - 2) : 1664 + 32 * (wave - 4));
            float t8[8]; mix8_lds(rcur + (colb + 8 * fq) * 2, rprv + (colb + 8 * fq) * 2, par + colb + 8 * fq, t8);
            if (wave < 2) {
#pragma unroll
                for (int i = 0; i < 8; ++i) { const float e = fexp(2.f * t8[i]); t8[i] = 1.f - 2.f * frcp(e + 1.f); } }
            else if (wave >= 4) {
#pragma unroll
                for (int i = 0; i < 8; ++i) t8[i] = fsigmoid(t8[i]); }
            *(bf16x8*)(lds + L_FRAG + wave * 1024 + lane * 16) = pack_frag(t8);
        }
        __syncthreads();
        bf16x8 Aw[2], Aa[2], Ag[4];
#pragma unroll
        for (int s = 0; s < 2; ++s) { Aw[s] = *(const bf16x8*)(lds + L_FRAG + s * 1024 + lane * 16); Aa[s] = *(const bf16x8*)(lds + L_FRAG + (2 + s) * 1024 + lane * 16); }
#pragma unroll
        for (int s = 0; s < 4; ++s) Ag[s] = *(const bf16x8*)(lds + L_FRAG + (4 + s) * 1024 + lane * 16);
        const int h = wave; const size_t m = (size_t)tile * 16 + fr;
        float kkr[16], av[16]; unsigned lk[16], rvp[16];
        float ss = 0.f, brs = 0.f, krs = 0.f, rkbs = 0.f;
#pragma unroll
        for (int n = 0; n < 4; ++n) {
            asm volatile("" ::: "memory");
            const int cb = 64 * h + 16 * n, c0 = cb + 4 * fq;
            f32x4 aw = {0.f, 0.f, 0.f, 0.f}, aa = aw, ag = aw;
#pragma unroll
            for (int s = 0; s < 2; ++s) {
                aw = __builtin_amdgcn_mfma_f32_16x16x32_bf16(*(const bf16x8*)(WLU + (size_t)(cb + fr) * 64 + 32 * s + 8 * fq), Aw[s], aw, 0, 0, 0);
                aa = __builtin_amdgcn_mfma_f32_16x16x32_bf16(*(const bf16x8*)(WLA + (size_t)(cb + fr) * 64 + 32 * s + 8 * fq), Aa[s], aa, 0, 0, 0); }
#pragma unroll
            for (int s = 0; s < 4; ++s)
                ag = __builtin_amdgcn_mfma_f32_16x16x32_bf16(*(const bf16x8*)(WLG + (size_t)(cb + fr) * 128 + 32 * s + 8 * fq), Ag[s], ag, 0, 0, 0);
            float rr[4], kr4[4], vv[4];
            mix4_lds(rcur + c0 * 2, rprv + c0 * 2, par + c0, rr); mix4_lds(rcur + (512 + c0) * 2, rprv + (512 + c0) * 2, par + 512 + c0, kr4); mix4_lds(rcur + (1024 + c0) * 2, rprv + (1024 + c0) * 2, par + 1024 + c0, vv);
            const f32x4 w0v = *(const f32x4*)(par + 1792 + c0), a0v = *(const f32x4*)(par + 2304 + c0), kkv = *(const f32x4*)(par + 2816 + c0), kav = *(const f32x4*)(par + 3328 + c0), rkv = *(const f32x4*)(par + 3840 + c0);
#pragma unroll
            for (int j = 0; j < 4; ++j) {
                const float sg = fsigmoid(w0v[j] + aw[j]);
                const float ldx = -0.60653065971f * 1.44269504089f * sg;
                const float av_ = fsigmoid(a0v[j] + aa[j]);
                const float kkraw = kr4[j] * kkv[j];
                const float k2 = kr4[j] * (1.f + (av_ - 1.f) * kav[j]);
                ss += kkraw * kkraw; brs += kkraw * av_ * rr[j]; krs += k2 * rr[j]; rkbs += rr[j] * k2 * rkv[j];
                kkr[4 * n + j] = kkraw; av[4 * n + j] = av_; lk[4 * n + j] = cvt_pk_bf16(ldx, k2); rvp[4 * n + j] = cvt_pk_bf16(rr[j], vv[j]);
            }
            u32x2 gp; gp.x = cvt_pk_bf16(ag[0], ag[1]); gp.y = cvt_pk_bf16(ag[2], ag[3]);
            *(u32x2*)(GB + m * 512 + c0) = gp;
        }
        ss = red16(ss); brs = red16(brs); krs = red16(krs); rkbs = red16(rkbs);
        const float inv = 1.f / fmaxf(sqrtf(ss), 1e-12f);
        unsigned char* rec = SI + ((m * 8 + h) * 64) * 12;
#pragma unroll
        for (int n = 0; n < 4; ++n) {
            unsigned dw[12];
#pragma unroll
            for (int j = 0; j < 4; ++j) { const float kk = kkr[4 * n + j] * inv;
                const unsigned kp = cvt_pk_bf16(kk * av[4 * n + j], -kk);
                dw[3 * j] = (lk[4 * n + j] & 0xffffu) | (kp & 0xffff0000u); dw[3 * j + 1] = (kp & 0xffffu) | (lk[4 * n + j] & 0xffff0000u); dw[3 * j + 2] = rvp[4 * n + j]; }
            u32x4* dst = (u32x4*)(rec + (16 * n + 4 * fq) * 12);
            u32x4 s0 = {dw[0], dw[1], dw[2], dw[3]}, s1 = {dw[4], dw[5], dw[6], dw[7]}, s2 = {dw[8], dw[9], dw[10], dw[11]};
            dst[0] = s0; dst[1] = s1; dst[2] = s2;
        }
        if (fq == 0) { f32x4 scv = {brs * inv, krs, rkbs, 0.f}; *(f32x4*)(SC + (m * 8 + h) * 4) = scv; }
    }
    __syncthreads();
}

__device__ __forceinline__ float red_rows(float x) {
    float a0 = x, a1 = x;
    asm volatile("s_nop 1\n\tv_permlane16_swap_b32 %0, %1" : "+v"(a0), "+v"(a1));
    float b0 = a0 + a1, b1 = b0;
    asm volatile("s_nop 1\n\tv_permlane32_swap_b32 %0, %1" : "+v"(b0), "+v"(b1));
    return b0 + b1;
}
constexpr int SC_T = 16, SC_ROW = 1552, SC_BUF = SC_T * SC_ROW;
struct ProdRec { unsigned d0, d1, d2; f32x2 sc; };
__device__ __forceinline__ void prod_load(ProdRec (&P)[4], const unsigned char* sb, const float* scp, int chunk, int pl) {
    const int col = pl & 63;
#pragma unroll
    for (int q = 0; q < 4; ++q) { const size_t t = (size_t)chunk * SC_T + (pl >> 6) + 4 * q;
        const unsigned* p = (const unsigned*)(sb + t * 6144 + col * 12); P[q].d0 = p[0]; P[q].d1 = p[1]; P[q].d2 = p[2];
        P[q].sc = (f32x2){0.f, 0.f}; if (col == 0) P[q].sc = *(const f32x2*)(scp + t * 32); }
}
__device__ __forceinline__ void prod_store(const ProdRec (&P)[4], unsigned char* buf, int pl) {
    const int col = pl & 63;
#pragma unroll
    for (int q = 0; q < 4; ++q) { unsigned char* base = buf + ((pl >> 6) + 4 * q) * SC_ROW + col * 4;
        const float w = __builtin_amdgcn_exp2f(bf_lo(P[q].d0));
        *(float*)(base) = bf_hi(P[q].d0); *(float*)(base + 256) = w * bf_lo(P[q].d2); *(float*)(base + 512) = w;
        *(float*)(base + 768) = bf_lo(P[q].d1); *(float*)(base + 1024) = bf_hi(P[q].d1); *(float*)(base + 1280) = bf_hi(P[q].d2);
        if (col == 0) *(f32x2*)(base + 1536) = P[q].sc; }
}
#define MK_SWAP32(a, b) asm volatile("s_nop 1\n\tv_permlane32_swap_b32 %0, %1" : "+v"(a), "+v"(b))
#define MK_SWAP16(a, b) asm volatile("s_nop 1\n\tv_permlane16_swap_b32 %0, %1" : "+v"(a), "+v"(b))
__device__ __forceinline__ void red4x8(float& A, float& B, float& C, float& D) {
    MK_SWAP32(A, B); float u = A + B;
    MK_SWAP32(C, D); float w = C + D;
    MK_SWAP16(u, w); float z = u + w;
    float z1;
    asm volatile("s_nop 1\n\tv_add_f32_dpp %0, %1, %1 row_ror:8 row_mask:0xf bank_mask:0xf" : "=&v"(z1) : "v"(z));
    float p = z1, q = z1; MK_SWAP32(p, q);
    float p2 = p; MK_SWAP16(p, p2);
    float q2 = q; MK_SWAP16(q, q2);
    A = p; C = p2; B = q; D = q2;
}
__device__ __forceinline__ void scan_consume(f32x2 (&S)[8], const unsigned char* buf, unsigned* yr, int lane, int rb) {
    const unsigned co = (unsigned)(lane >> 3) * 32u, vo = 1280u + (unsigned)(16 * rb + (lane & 7)) * 4u;
#pragma unroll 4
    for (int st = 0; st < SC_T; ++st) {
        const unsigned char* sb = buf + st * SC_ROW;
        f32x4 n4[2], r4[2], w4[2], a4[2], k4[2];
#pragma unroll
        for (int q = 0; q < 2; ++q) { n4[q] = *(const f32x4*)(sb + co + 16 * q); r4[q] = *(const f32x4*)(sb + 256 + co + 16 * q); w4[q] = *(const f32x4*)(sb + 512 + co + 16 * q);
            a4[q] = *(const f32x4*)(sb + 768 + co + 16 * q); k4[q] = *(const f32x4*)(sb + 1024 + co + 16 * q); }
        const float v0 = *(const float*)(sb + vo), v1 = *(const float*)(sb + vo + 32); const f32x2 bk = *(const f32x2*)(sb + 1536);
        f32x2 sa0v = {0.f, 0.f}, sa1v = sa0v, yp0v = sa0v, yp1v = sa0v;
#pragma unroll
        for (int p = 0; p < 4; ++p) { const f32x2 nn = {n4[p >> 1][2 * (p & 1)], n4[p >> 1][2 * (p & 1) + 1]}, rr2 = {r4[p >> 1][2 * (p & 1)], r4[p >> 1][2 * (p & 1) + 1]};
            sa0v += S[p] * nn; sa1v += S[4 + p] * nn; yp0v += S[p] * rr2; yp1v += S[4 + p] * rr2; }
        float sa0 = sa0v[0] + sa0v[1], sa1 = sa1v[0] + sa1v[1], yp0 = yp0v[0] + yp0v[1], yp1 = yp1v[0] + yp1v[1];
        red4x8(sa0, sa1, yp0, yp1);
        const f32x2 s0 = {sa0, sa0}, s1 = {sa1, sa1}, vv0 = {v0, v0}, vv1 = {v1, v1};
#pragma unroll
        for (int p = 0; p < 4; ++p) { const f32x2 ww = {w4[p >> 1][2 * (p & 1)], w4[p >> 1][2 * (p & 1) + 1]}; S[p] = S[p] * ww; S[4 + p] = S[4 + p] * ww; }
        asm volatile("" ::: "memory");
#pragma unroll
        for (int p = 0; p < 4; ++p) { const f32x2 aa = {a4[p >> 1][2 * (p & 1)], a4[p >> 1][2 * (p & 1) + 1]}; S[p] = __builtin_elementwise_fma(aa, s0, S[p]); S[4 + p] = __builtin_elementwise_fma(aa, s1, S[4 + p]); }
        asm volatile("" ::: "memory");
#pragma unroll
        for (int p = 0; p < 4; ++p) { const f32x2 kk = {k4[p >> 1][2 * (p & 1)], k4[p >> 1][2 * (p & 1) + 1]}; S[p] = __builtin_elementwise_fma(kk, vv0, S[p]); S[4 + p] = __builtin_elementwise_fma(kk, vv1, S[4 + p]); }
        const float y0 = yp0 + sa0 * bk[0] + v0 * bk[1], y1 = yp1 + sa1 * bk[0] + v1 * bk[1];
        if (lane < 16) { const bool hi = (lane & 8) != 0;
            yr[(size_t)st * 512 + lane] = (unsigned)bf1(hi ? y1 : y0) | (__float_as_uint(hi ? v1 : v0) & 0xffff0000u); }
    }
}

__device__ __forceinline__ void rwpost_local(const Args& a, int bh, int tid) {
    const float* SC = (const float*)(a.ws + O_SC);
    const unsigned* YR = (const unsigned*)(a.ws + O_YR); const bf16_t* GB = (const bf16_t*)(a.ws + O_G); bf16_t* ORW = (bf16_t*)(a.ws + O_ORW);
    const int b = bh >> 3, h = bh & 7, c = 64 * h + (tid & 15) * 4;
    const f32x4 lwv = *(const f32x4*)(a.in[13] + c), lbv = *(const f32x4*)(a.in[14] + c);
    for (int t0 = tid >> 4; t0 < SEQ; t0 += 64) {
        u32x4 yv[2]; u32x2 gb[2]; float rkb[2]; size_t mm[2];
#pragma unroll
        for (int u = 0; u < 2; ++u) { const size_t m = (size_t)b * SEQ + t0 + 32 * u; mm[u] = m;
            yv[u] = *(const u32x4*)(YR + m * 512 + c); gb[u] = *(const u32x2*)(GB + m * 512 + c); rkb[u] = SC[(m * 8 + h) * 4 + 2]; }
#pragma unroll
        for (int u = 0; u < 2; ++u) {
            float y[4] = {bf_lo(yv[u].x), bf_lo(yv[u].y), bf_lo(yv[u].z), bf_lo(yv[u].w)};
            const float v[4] = {bf_hi(yv[u].x), bf_hi(yv[u].y), bf_hi(yv[u].z), bf_hi(yv[u].w)};
            float s = (y[0] + y[1]) + (y[2] + y[3]);
#pragma unroll
            for (int o = 1; o < 16; o <<= 1) s += __shfl_xor(s, o);
            const float mean = s * (1.f / 64.f);
            float q = 0.f;
#pragma unroll
            for (int j = 0; j < 4; ++j) { y[j] -= mean; q += y[j] * y[j]; }
#pragma unroll
            for (int o = 1; o < 16; o <<= 1) q += __shfl_xor(q, o);
            const float rstd = rsqrtf(q * (1.f / 64.f) + GN_EPS);
            const float g4[4] = {bf_lo(gb[u].x), bf_hi(gb[u].x), bf_lo(gb[u].y), bf_hi(gb[u].y)};
            float o4[4];
#pragma unroll
            for (int j = 0; j < 4; ++j) o4[j] = (y[j] * rstd * lwv[j] + lbv[j] + rkb[u] * v[j]) * g4[j];
            u32x2 ob; ob.x = cvt_pk_bf16(o4[0], o4[1]); ob.y = cvt_pk_bf16(o4[2], o4[3]);
            *(u32x2*)(ORW + mm[u] * 512 + c) = ob;
        }
    }
}

struct KV { bf16x8 k[4]; bf16x8 v[2][2]; };
__device__ __forceinline__ void attn_load(KV& T, const bf16_t* Kh, const bf16_t* Vh, int k0, int n, int hf) {
    const bf16_t* kp = Kh + (size_t)(k0 + n) * 512 + 8 * hf;
#pragma unroll
    for (int s = 0; s < 4; ++s) T.k[s] = *(const bf16x8*)(kp + 16 * s);
#pragma unroll
    for (int d = 0; d < 2; ++d)
#pragma unroll
        for (int sg = 0; sg < 2; ++sg) { const bf16_t* vp = Vh + (size_t)(32 * d + n) * SEQ + k0 + 16 * sg + 4 * hf;
            const u32x2 lo = *(const u32x2*)vp, hi = *(const u32x2*)(vp + 8); u32x4 t = {lo.x, lo.y, hi.x, hi.y}; T.v[d][sg] = __builtin_bit_cast(bf16x8, t); }
}
__device__ __forceinline__ void attn_wave(const Args& a, int bh, int w4, int lane) {
    const int b = bh >> 3, h = bh & 7, n = lane & 31, hf = lane >> 5;
    const size_t m0 = (size_t)b * SEQ;
    const bf16_t* Qh = (const bf16_t*)(a.ws + O_Q) + m0 * 512 + 64 * h;
    const bf16_t* Kh = (const bf16_t*)(a.ws + O_K) + m0 * 512 + 64 * h;
    const bf16_t* Vh = (const bf16_t*)(a.ws + O_VT) + (size_t)bh * 64 * SEQ;
    bf16_t* Oh = (bf16_t*)(a.ws + O_OSB) + m0 * 512 + 64 * h;
    for (int qt = 63 - w4; qt >= 0; qt -= 8) {
        const int q0 = 32 * qt;
        bf16x8 qf[4];
#pragma unroll
        for (int s = 0; s < 4; ++s) qf[s] = *(const bf16x8*)(Qh + (size_t)(q0 + n) * 512 + 16 * s + 8 * hf);
        f32x16 o0, o1;
#pragma unroll
        for (int i = 0; i < 16; ++i) { o0[i] = 0.f; o1[i] = 0.f; }
        float carry = 0.f;
        KV cur, nxt;
        attn_load(cur, Kh, Vh, q0, n, hf);
        for (int kt = qt; kt >= 0; --kt) {
            const int ktn = kt > 0 ? kt - 1 : 0;
            attn_load(nxt, Kh, Vh, 32 * ktn, n, hf);
            f32x16 sc;
#pragma unroll
            for (int i = 0; i < 16; ++i) sc[i] = 0.f;
#pragma unroll
            for (int s = 0; s < 4; ++s) sc = __builtin_amdgcn_mfma_f32_32x32x16_bf16(cur.k[s], qf[s], sc, 0, 0, 0);
            const bool diag = (kt == qt);
            float lf[16], G4[4];
#pragma unroll
            for (int g = 0; g < 4; ++g) { G4[g] = 0.f;
#pragma unroll
                for (int i = 0; i < 4; ++i) { const int r = 4 * g + i; const float z = sc[r];
                    const bool valid = !diag || (8 * g + 4 * hf + i < n);
                    const float e = fexp(-fabsf(z));
                    const float sp = fmaxf(z, 0.f) + flog(1.f + e);
                    lf[r] = valid ? -sp : 0.f; G4[g] += lf[r]; } }
            float PG[4], T4[4];
#pragma unroll
            for (int g = 0; g < 4; ++g) { PG[g] = __shfl_xor(G4[g], 32); T4[g] = G4[g] + PG[g]; }
            const float tail3 = 0.f, tail2 = T4[3], tail1 = T4[3] + T4[2], tail0 = tail1 + T4[1], total = tail0 + T4[0];
            const float tails[4] = {tail0, tail1, tail2, tail3};
            f32x16 wv;
#pragma unroll
            for (int g = 0; g < 4; ++g) {
                float af = carry + tails[g] + (hf == 0 ? PG[g] : 0.f);
#pragma unroll
                for (int i = 3; i >= 0; --i) { const int r = 4 * g + i; const float z = sc[r];
                    const bool valid = !diag || (8 * g + 4 * hf + i < n);
                    const float wgt = fexp(lf[r] + z + af);
                    wv[r] = valid ? wgt : 0.f;
                    af += lf[r]; } }
            carry += total;
            bf16x8 wf[2];
#pragma unroll
            for (int sg = 0; sg < 2; ++sg) { u32x4 t; t.x = cvt_pk_bf16(wv[8 * sg + 0], wv[8 * sg + 1]); t.y = cvt_pk_bf16(wv[8 * sg + 2], wv[8 * sg + 3]); t.z = cvt_pk_bf16(wv[8 * sg + 4], wv[8 * sg + 5]); t.w = cvt_pk_bf16(wv[8 * sg + 6], wv[8 * sg + 7]); wf[sg] = __builtin_bit_cast(bf16x8, t); }
#pragma unroll
            for (int sg = 0; sg < 2; ++sg) { o0 = __builtin_amdgcn_mfma_f32_32x32x16_bf16(cur.v[0][sg], wf[sg], o0, 0, 0, 0); o1 = __builtin_amdgcn_mfma_f32_32x32x16_bf16(cur.v[1][sg], wf[sg], o1, 0, 0, 0); }
            cur = nxt;
#if MK_EARLY_EXIT
            if (__all(carry < -104.f)) break;
#endif
        }
        bf16_t* op = Oh + (size_t)(q0 + n) * 512 + 4 * hf;
#pragma unroll
        for (int g = 0; g < 4; ++g) {
            u32x2 t0, t1; t0.x = cvt_pk_bf16(o0[4 * g], o0[4 * g + 1]); t0.y = cvt_pk_bf16(o0[4 * g + 2], o0[4 * g + 3]); t1.x = cvt_pk_bf16(o1[4 * g], o1[4 * g + 1]); t1.y = cvt_pk_bf16(o1[4 * g + 2], o1[4 * g + 3]);
            *(u32x2*)(op + 8 * g) = t0; *(u32x2*)(op + 32 + 8 * g) = t1; }
    }
}
__device__ __forceinline__ void phase_mixer(const Args& a, unsigned char* lds, int G) {
    const int tid = my_tid(); const int wave = __builtin_amdgcn_readfirstlane(tid >> 6), lane = tid & 63;
    for (int bh = blockIdx.x; bh < NB * NH; bh += G) {
        const int b = bh >> 3, h = bh & 7; const size_t m0 = (size_t)b * SEQ;
        const unsigned char* sb = a.ws + O_SI + (m0 * 8 + h) * 768; const float* scp = (const float*)(a.ws + O_SC) + (m0 * 8 + h) * 4;
        unsigned* yrb = (unsigned*)(a.ws + O_YR) + m0 * 512 + 64 * h + 16 * (wave & 3);
        const int pl = tid - 256;
        constexpr int NCH = SEQ / SC_T;
        ProdRec pr[4]; f32x2 S[8];
#pragma unroll
        for (int p = 0; p < 8; ++p) S[p] = (f32x2){0.f, 0.f};
        __syncthreads();
        if (wave >= 4) { prod_load(pr, sb, scp, 0, pl); prod_store(pr, lds, pl); prod_load(pr, sb, scp, 1, pl); }
        __syncthreads();
        for (int ci = 0; ci < NCH; ++ci) {
            if (wave < 4) scan_consume(S, lds + (ci & 1) * SC_BUF, yrb + (size_t)ci * SC_T * 512, lane, wave);
            else if (ci + 1 < NCH) { prod_store(pr, lds + ((ci + 1) & 1) * SC_BUF, pl); prod_load(pr, sb, scp, ci + 2 < NCH ? ci + 2 : ci + 1, pl); }
            __syncthreads();
        }
        attn_wave(a, bh, wave, lane);
        __threadfence_block(); __syncthreads();
        rwpost_local(a, bh, my_tid());
    }
}

template <int MODE> __device__ __forceinline__ void phase_rows(const Args& a, int G) {
    const int tid = my_tid(); const int wave = tid >> 6, lane = tid & 63;
    const int gw = blockIdx.x * 8 + wave, NGW = G * 8;
    const bf16_t* T = (const bf16_t*)(a.ws + (MODE == 0 ? O_TT : O_FF));
    const float* g1 = MODE == 0 ? a.in[18] : a.in[23]; const float* g2 = a.in[19];
    bf16_t* H2 = (bf16_t*)(a.ws + O_H2); bf16_t* X1B = (bf16_t*)(a.ws + O_X1B);
    f32x4 g1v[4], g2v[4];
#pragma unroll
    for (int j = 0; j < 4; ++j) { g1v[j] = ((const f32x4*)g1)[lane + 64 * j]; g2v[j] = ((const f32x4*)g2)[lane + 64 * j]; }
    for (int row0 = gw; row0 < M; row0 += 2 * NGW) {
        u32x2 tb[2][4]; f32x4 x[2][4];
#pragma unroll
        for (int u = 0; u < 2; ++u) { const int row = (row0 + u * NGW < M) ? row0 + u * NGW : row0;
            const u32x2* tr = (const u32x2*)(T + (size_t)row * D) + lane;
#pragma unroll
            for (int j = 0; j < 4; ++j) tb[u][j] = tr[64 * j];
            if (MODE == 0) { const f32x4* xr = (const f32x4*)(a.in[0] + (size_t)row * D) + lane;
#pragma unroll
                for (int j = 0; j < 4; ++j) x[u][j] = xr[64 * j]; }
            else { const u32x2* xr = (const u32x2*)(X1B + (size_t)row * D) + lane;
#pragma unroll
                for (int j = 0; j < 4; ++j) { const u32x2 xb = xr[64 * j]; x[u][j][0] = bf_lo(xb.x); x[u][j][1] = bf_hi(xb.x); x[u][j][2] = bf_lo(xb.y); x[u][j][3] = bf_hi(xb.y); } } }
#pragma unroll
        for (int u = 0; u < 2; ++u) {
            const int row = row0 + u * NGW;
            f32x4 t[4]; float s = 0.f;
#pragma unroll
            for (int j = 0; j < 4; ++j) { t[j][0] = bf_lo(tb[u][j].x); t[j][1] = bf_hi(tb[u][j].x); t[j][2] = bf_lo(tb[u][j].y); t[j][3] = bf_hi(tb[u][j].y);
                s += (t[j][0] * t[j][0] + t[j][1] * t[j][1]) + (t[j][2] * t[j][2] + t[j][3] * t[j][3]); }
            const float rs = rsqrtf(wave_sum(s) * (1.f / D) + RMS_EPS);
            float s2 = 0.f;
#pragma unroll
            for (int j = 0; j < 4; ++j)
#pragma unroll
                for (int e = 0; e < 4; ++e) { x[u][j][e] += t[j][e] * rs * g1v[j][e]; s2 += x[u][j][e] * x[u][j][e]; }
            float rs2 = 0.f;
            if (MODE == 0) rs2 = rsqrtf(wave_sum(s2) * (1.f / D) + RMS_EPS);
            if (row < M) {
                if (MODE == 0) {
                    u32x2* xo = (u32x2*)(X1B + (size_t)row * D) + lane; u32x2* o = (u32x2*)(H2 + (size_t)row * D) + lane;
#pragma unroll
                    for (int j = 0; j < 4; ++j) { u32x2 w; w.x = cvt_pk_bf16(x[u][j][0], x[u][j][1]); w.y = cvt_pk_bf16(x[u][j][2], x[u][j][3]); xo[64 * j] = w; }
#pragma unroll
                    for (int j = 0; j < 4; ++j) { u32x2 w; w.x = cvt_pk_bf16(x[u][j][0] * rs2 * g2v[j][0], x[u][j][1] * rs2 * g2v[j][1]); w.y = cvt_pk_bf16(x[u][j][2] * rs2 * g2v[j][2], x[u][j][3] * rs2 * g2v[j][3]); o[64 * j] = w; }
                } else {
                    f32x4* orow = (f32x4*)(a.out + (size_t)row * D) + lane;
#pragma unroll
                    for (int j = 0; j < 4; ++j) orow[64 * j] = x[u][j];
                }
            }
        }
    }
}

#define XB_TMO      128
#define XB_XCNT(j)  (256  + 64 * (j))
#define XB_XSUB(j)  (1280 + 64 * (j))
#define XB_XGEN(j)  (2304 + 64 * (j))
#define XB_TOP      3328
#define XB_TOPGEN   3392
#define XCD_BAR_WORDS 3456
#define XB_SPIN_CAP (1u << 18)

__device__ __forceinline__ unsigned xb_ld(unsigned* p)              { return __hip_atomic_load(p, __ATOMIC_RELAXED, __HIP_MEMORY_SCOPE_AGENT); }
__device__ __forceinline__ unsigned xb_add(unsigned* p, unsigned v) { return __hip_atomic_fetch_add(p, v, __ATOMIC_RELAXED, __HIP_MEMORY_SCOPE_AGENT); }
__device__ __forceinline__ unsigned xb_xcc_id() { return (unsigned)__builtin_amdgcn_s_getreg((3 << 11) | 20) & 0xFu; }
#define XB_SPIN(cond, bar) do { unsigned _sp = 0; while (cond) { __builtin_amdgcn_s_sleep(1); \
    if ((++_sp & 255u) == 0u) { if (xb_ld(&(bar)[XB_TMO])) break; if (_sp > XB_SPIN_CAP) { atomicAdd(&(bar)[XB_TMO], 1u); break; } } } } while (0)

struct XcdBarrier {
    unsigned* bar; unsigned x;
    volatile __attribute__((address_space(3))) unsigned* st;
};

__device__ __forceinline__ XcdBarrier xcd_barrier_post(unsigned* bar, volatile __attribute__((address_space(3))) unsigned* st) {
    XcdBarrier b; b.bar = bar; b.x = xb_xcc_id(); b.st = st;
    if (threadIdx.x == 0) (void)xb_add(&bar[XB_XCNT(b.x)], 1u);
    return b;
}
__device__ __forceinline__ void xcd_barrier_complete(unsigned* bar, unsigned x, unsigned& nloc, unsigned& nx) {
    const unsigned G = gridDim.x * gridDim.y * gridDim.z;
    unsigned sum, cnt, mine, sp = 0u;
    for (;;) {
        sum = 0u; cnt = 0u; mine = 0u;
#pragma unroll
        for (unsigned j = 0; j < 16; ++j) { const unsigned c = xb_ld(&bar[XB_XCNT(j)]); sum += c; cnt += (c > 0u) ? 1u : 0u; mine = (j == x) ? c : mine; }
        if (sum == G) break;
        __builtin_amdgcn_s_sleep(1);
        if ((++sp & 255u) == 0u) { if (xb_ld(&bar[XB_TMO])) break; if (sp > XB_SPIN_CAP) { atomicAdd(&bar[XB_TMO], 1u); break; } }
    }
    nloc = mine > 0u ? mine : 1u; nx = cnt > 0u ? cnt : 1u;
}

__device__ __forceinline__ void xcd_barrier(const XcdBarrier& b) {
    asm volatile("s_waitcnt vmcnt(0)" ::: "memory");
    __syncthreads();
    if (threadIdx.x == 0) {
        unsigned* bar = b.bar;
        __builtin_amdgcn_s_waitcnt(0);
        unsigned nloc = b.st[0], nx = b.st[1];
        if (nloc == 0u) { xcd_barrier_complete(bar, b.x, nloc, nx); b.st[0] = nloc; b.st[1] = nx; }
        const unsigned old = xb_add(&bar[XB_XSUB(b.x)], 1u);
        const unsigned gen = old / nloc;
        if (old + 1u == (gen + 1u) * nloc) {
            __builtin_amdgcn_fence(__ATOMIC_RELEASE, "agent");
            asm volatile("s_waitcnt vmcnt(0)" ::: "memory");
            const unsigned og = xb_add(&bar[XB_TOP], 1u);
            const unsigned tg = og / nx;
            if (og + 1u == (tg + 1u) * nx) xb_add(&bar[XB_TOPGEN], 1u);
            else XB_SPIN(xb_ld(&bar[XB_TOPGEN]) == tg, bar);
            __builtin_amdgcn_fence(__ATOMIC_ACQUIRE, "agent");
            xb_add(&bar[XB_XGEN(b.x)], 1u);
            asm volatile("s_waitcnt vmcnt(0)" ::: "memory");
        } else {
            XB_SPIN(xb_ld(&bar[XB_XGEN(b.x)]) == gen, bar);
            __builtin_amdgcn_fence(__ATOMIC_ACQUIRE, "agent");
            asm volatile("s_waitcnt vmcnt(0)" ::: "memory");
        }
    }
    __syncthreads();
}

__global__ void __launch_bounds__(512, 2) mega(Args a) {
    extern __shared__ __attribute__((aligned(16))) unsigned char shm[];
    PG8_LAS unsigned char* lds = (PG8_LAS unsigned char*)shm;
    const int G = (int)gridDim.x;
    unsigned char* ws = a.ws;
    volatile __attribute__((address_space(3))) unsigned* bst = (volatile __attribute__((address_space(3))) unsigned*)(lds + pg8::STAGE_BYTES);
    if (threadIdx.x == 0) { bst[0] = 0u; bst[1] = 0u; }
    __syncthreads();
    const XcdBarrier bar = xcd_barrier_post((unsigned*)(ws + O_CTL), bst);
    cg::this_grid().sync();
    phase_prep(a, (float*)shm, G);
    xcd_barrier(bar);
    { Epi1 E; E.Q = (bf16_t*)(ws + O_Q); E.Kb = (bf16_t*)(ws + O_K); E.Vt = (bf16_t*)(ws + O_VT); E.Prw = (bf16_t*)(ws + O_PRW); E.Gt = (bf16_t*)a.out; E.bgate = a.in[3];
      run_gemm(lds, (const bf16_t*)(ws + O_H), (const bf16_t*)(ws + O_WIN), INC, 1024, E, G); }
    xcd_barrier(bar);
    phase_rwprep(a, shm, G);
    xcd_barrier(bar);
    phase_mixer(a, shm, G);
    xcd_barrier(bar);
    { EpiRow<1> E; E.O = (bf16_t*)(ws + O_T1); E.T1 = nullptr; E.Gt = (const bf16_t*)a.out;
      run_gemm(lds, (const bf16_t*)(ws + O_OSB), (const bf16_t*)(ws + O_WSB), 1024, 512, E, G); }
    { EpiRow<2> E; E.O = (bf16_t*)(ws + O_MRG); E.T1 = (const bf16_t*)(ws + O_T1); E.Gt = (const bf16_t*)a.out;
      run_gemm(lds, (const bf16_t*)(ws + O_ORW), (const bf16_t*)(ws + O_WRW), 1024, 512, E, G); }
    xcd_barrier(bar);
    { EpiRow<0> E; E.O = (bf16_t*)(ws + O_TT); E.T1 = nullptr; E.Gt = nullptr;
      run_gemm(lds, (const bf16_t*)(ws + O_MRG), (const bf16_t*)(ws + O_WO), 1024, 1024, E, G); }
    xcd_barrier(bar);
    phase_rows<0>(a, G);
    xcd_barrier(bar);
    { EpiSwiGLU E; E.Hd = (bf16_t*)(ws + O_HID);
      run_gemm(lds, (const bf16_t*)(ws + O_H2), (const bf16_t*)(ws + O_WGU), 2 * DFF, 1024, E, G); }
    xcd_barrier(bar);
    { EpiRow<0> E; E.O = (bf16_t*)(ws + O_FF); E.T1 = nullptr; E.Gt = nullptr;
      run_gemm(lds, (const bf16_t*)(ws + O_HID), (const bf16_t*)(ws + O_WDN), 1024, DFF, E, G); }
    xcd_barrier(bar);
    phase_rows<1>(a, G);
}
}

extern "C" void kernel_launch(void* const* d_in, const int* in_sizes, int n_in, void* d_out, int out_size, void* d_ws, size_t ws_size, hipStream_t stream) {
    static int grid = 0;
    if (grid == 0) {
        if (n_in != 24 || in_sizes[0] != mk::M * mk::D || out_size != mk::M * mk::D || ws_size < mk::WS_NEED) {
            fprintf(stderr, "kernel_launch: unexpected shapes: n_in %d in0 %d out %d ws %zu (need %zu)\n", n_in, n_in > 0 ? in_sizes[0] : -1, out_size, ws_size, (size_t)mk::WS_NEED); grid = -1; return; }
        int dev = 0, cus = 0, per_cu = 0;
        hipGetDevice(&dev); hipDeviceGetAttribute(&cus, hipDeviceAttributeMultiprocessorCount, dev);
        if (hipFuncSetAttribute((const void*)mk::mega, hipFuncAttributeMaxDynamicSharedMemorySize, mk::LDS_BYTES) != hipSuccess) { fprintf(stderr, "kernel_launch: hipFuncSetAttribute failed\n"); grid = -1; return; }
        if (hipOccupancyMaxActiveBlocksPerMultiprocessor(&per_cu, (const void*)mk::mega, 512, mk::LDS_BYTES) != hipSuccess || per_cu < 1) { fprintf(stderr, "kernel_launch: occupancy query failed (%d)\n", per_cu); per_cu = 1; }
        (void)hipGetLastError();
        grid = cus * per_cu;
        fprintf(stderr, "kernel_launch: grid %d (cus %d x %d)\n", grid, cus, per_cu);
    }
    if (grid < 0) return;
    mk::Args a{};
    for (int i = 0; i < 24; ++i) a.in[i] = (const float*)d_in[i];
    a.out = (float*)d_out; a.ws = (unsigned char*)d_ws;
    a.ph_lo = 0; a.ph_hi = mk::NPH;
    if (hipMemsetAsync((char*)d_ws + mk::O_CTL, 0, mk::CTL_BYTES, stream) != hipSuccess) { fprintf(stderr, "kernel_launch: hipMemsetAsync failed\n"); return; }
    void* args[] = {&a};
    hipError_t e = hipLaunchCooperativeKernel((const void*)mk::mega, dim3(grid), dim3(512), args, mk::LDS_BYTES, stream);
    if (e != hipSuccess) fprintf(stderr, "kernel_launch: cooperative launch failed: %s (grid %d)\n", hipGetErrorString(e), grid);
}
```

```cpp
#include <hip/hip_runtime.h>
#include <hip/hip_cooperative_groups.h>
#include <cstdio>
#include <cstdint>
namespace cg = cooperative_groups;
#ifndef MK_SPLIT
#define MK_SPLIT 0
#endif
#ifndef MK_DIAG
#define MK_DIAG 0
#endif
#ifndef MK_REPMASK
#define MK_REPMASK 0
#endif
#ifndef MK_EARLY_EXIT
#define MK_EARLY_EXIT 1
#endif
namespace pg8 {
#define PG8_LAS __attribute__((address_space(3)))
typedef unsigned short bf16_t;
typedef short bf16x8 __attribute__((ext_vector_type(8)));
typedef float f32x4 __attribute__((ext_vector_type(4)));
typedef unsigned u32x4 __attribute__((ext_vector_type(4)));
constexpr int BM = 256, BK = 64, HALF = 128, HTB = HALF * BK * 2  , STAGE_BYTES = 8 * HTB, NXCD = 8, WGM = 8;

__host__ __device__ __forceinline__ int lds_byte(int r, int c) { const int st = (r >> 4) * 2 + (c >> 5), rr = r & 15, cc = c & 31, ob = rr * 64 + cc * 2; return st * 1024 + (ob ^ (((ob >> 9) & 1) << 5)); }
__host__ __device__ __forceinline__ void stage_rc(int b, int& R, int& C) { const int st = b / 1024, sb = b % 1024, swz = sb ^ (((sb >> 9) & 1) << 5); R = (st >> 1) * 16 + swz / 64; C = (st & 1) * 32 + (swz % 64) / 2; }
__host__ __device__ __forceinline__ int perm32(int rho) { const int n = rho >> 4, i = rho & 15; return 8 * (i >> 2) + 4 * n + (i & 3); }

struct Unit { int pm, pn; };
struct Gemm { const bf16_t* A; const bf16_t* Bt; int M, N, K; };

struct StaticOrder {
    int nM, nN, nwg, G, c;
    __host__ __device__ void init(int M, int N, int G_, int c_) { nM = M / BM; nN = N / BM; nwg = nM * nN; G = G_; c = c_; }
    __host__ __device__ bool next(int i, Unit& u) const {
        const long L = (long)i * G + c; if (L >= nwg) return false;
        int wgid = (int)L; { const int q = nwg / NXCD, r = nwg % NXCD, xcd = wgid % NXCD, off = wgid / NXCD; wgid = (xcd < r ? xcd * (q + 1) : r * (q + 1) + (xcd - r) * q) + off; }
        const int nig = WGM * nN, gid = wgid / nig, fm = gid * WGM, gsz = (nM - fm) < WGM ? (nM - fm) : WGM;
        u.pm = fm + ((wgid % nig) % gsz); u.pn = (wgid % nig) / gsz; return true;
    }
    __device__ __forceinline__ void a_ready(const Unit&) const {}
    __device__ __forceinline__ void done(const Unit&) const {}
};

__device__ __forceinline__ unsigned cvt_pk_bf16(float lo, float hi) { unsigned r; asm volatile("v_cvt_pk_bf16_f32 %0, %1, %2" : "=v"(r) : "v"(lo), "v"(hi)); return r; }
typedef float f32x2 __attribute__((ext_vector_type(2)));

template <class Epi, class Sched, bool ALIGN_EPI = false, bool SP2 = false>
__device__ __forceinline__ void gemm_phase(PG8_LAS unsigned char* lds, const Gemm g, const Sched& S, const Epi& E) {
    int tid_ = threadIdx.x; asm volatile("" : "+v"(tid_)); const int tid = tid_, wid = __builtin_amdgcn_readfirstlane(tid >> 6), lane = tid & 63, wr = wid >> 2, wc = wid & 3, fr = lane & 15, fq = lane >> 4;
    const int K = g.K, nt = K / BK;
    unsigned voffA[2], voffB[2];
#pragma unroll
    for (int i = 0; i < 2; ++i) { int R, C; stage_rc(tid * 16 + i * 8192, R, C); const int Rb = Epi::PERM ? ((R & ~31) + perm32(R & 31)) : R;
        voffA[i] = (unsigned)(R * K + C) * 2u; voffB[i] = (unsigned)(Rb * K + C) * 2u; }
    const size_t kstep = (size_t)(BK * 2);
    const size_t hstep = (size_t)HALF * K * 2;
    const size_t tstep = 2 * hstep;
    const unsigned ldsw = (unsigned)wid * 1024u;
    const int aoff = lds_byte(wr * 64 + fr, fq * 8), boff = lds_byte(wc * 32 + fr, fq * 8);
#define PG8_SA(b, h) (((b) * 2 + (h)) * HTB)
#define PG8_SB(b, h) ((4 + (b) * 2 + (h)) * HTB)
#define PG8_STAGE(bufoff, gbase, voff) do { _Pragma("unroll") for (int _i = 0; _i < 2; ++_i) \
        __builtin_amdgcn_global_load_lds((const unsigned*)((const char*)(gbase) + (voff)[_i]), (PG8_LAS unsigned*)(lds + (bufoff) + ldsw + _i * 8192), 16, 0, 0); } while (0)
#define PG8_LDA(dst, b, h) do { _Pragma("unroll") for (int m = 0; m < 4; ++m) _Pragma("unroll") for (int k = 0; k < 2; ++k) dst[m][k] = *(const PG8_LAS bf16x8*)(lds + PG8_SA(b, h) + aoff + m * 2048 + k * 1024); } while (0)
#define PG8_LDB(dst, b, h) do { _Pragma("unroll") for (int n = 0; n < 2; ++n) _Pragma("unroll") for (int k = 0; k < 2; ++k) dst[n][k] = *(const PG8_LAS bf16x8*)(lds + PG8_SB(b, h) + boff + n * 2048 + k * 1024); } while (0)
#define PG8_MMA(ai, bj, At, Bt) do { __builtin_amdgcn_s_setprio(1); _Pragma("unroll") for (int m = 0; m < 4; ++m) _Pragma("unroll") for (int n = 0; n < 2; ++n) _Pragma("unroll") for (int k = 0; k < 2; ++k) \
        acc[ai][bj][m][n] = __builtin_amdgcn_mfma_f32_16x16x32_bf16(Bt[n][k], At[m][k], acc[ai][bj][m][n], 0, 0, 0); __builtin_amdgcn_s_setprio(0); } while (0)
#define PG8_WAIT_V(n) asm volatile("s_waitcnt vmcnt(" #n ")" ::: "memory")
#define PG8_WAIT_L(n) asm volatile("s_waitcnt lgkmcnt(" #n ")" ::: "memory")
#define PG8_BAR __builtin_amdgcn_s_barrier()
#define PG8_SCHED __builtin_amdgcn_sched_barrier(0)
    Unit cur, nxt; int ui = 0;
    if (!S.next(0, cur)) return;
    f32x4 acc[2][2][4][2];
#pragma unroll
    for (int a = 0; a < 2; ++a)
#pragma unroll
        for (int b = 0; b < 2; ++b)
#pragma unroll
            for (int m = 0; m < 4; ++m)
#pragma unroll
                for (int n = 0; n < 2; ++n) acc[a][b][m][n] = (f32x4){0.f, 0.f, 0.f, 0.f};
    bf16x8 At[4][2], B0[2][2], B1[2][2];
    const char* cA = (const char*)g.A + (size_t)cur.pm * tstep; const char* cB = (const char*)g.Bt + (size_t)cur.pn * tstep;
    S.a_ready(cur);
    if constexpr (SP2) {
        PG8_STAGE(PG8_SB(0, 0), cB, voffB); PG8_STAGE(PG8_SB(0, 1), cB + hstep, voffB); PG8_STAGE(PG8_SA(0, 0), cA, voffA); PG8_STAGE(PG8_SA(0, 1), cA + hstep, voffA);
        if (wr == 1) PG8_BAR;
        PG8_WAIT_V(2); PG8_BAR;
        PG8_STAGE(PG8_SB(1, 0), cB + kstep, voffB); PG8_STAGE(PG8_SA(1, 0), cA + kstep, voffA); PG8_STAGE(PG8_SB(1, 1), cB + hstep + kstep, voffB);
        PG8_WAIT_V(6); PG8_BAR;
    } else {
        PG8_STAGE(PG8_SB(0, 0), cB, voffB); PG8_STAGE(PG8_SA(0, 0), cA, voffA); PG8_STAGE(PG8_SB(0, 1), cB + hstep, voffB); PG8_STAGE(PG8_SA(0, 1), cA + hstep, voffA);
        if (wr == 1) PG8_BAR;
        PG8_WAIT_V(4); PG8_BAR;
        PG8_STAGE(PG8_SB(1, 0), cB + kstep, voffB); PG8_STAGE(PG8_SA(1, 0), cA + kstep, voffA); PG8_STAGE(PG8_SB(1, 1), cB + hstep + kstep, voffB);
        PG8_WAIT_V(6); PG8_BAR;
    }
    for (;;) {
        const bool has_next = S.next(ui + 1, nxt);
        const char* nA = has_next ? (const char*)g.A + (size_t)nxt.pm * tstep : cA; const char* nB = has_next ? (const char*)g.Bt + (size_t)nxt.pn * tstep : cB;
        for (int t = 0; t < nt; t += 2) {
            const bool last = (t == nt - 2);
            const char* a1 = cA + (size_t)(t + 1) * kstep;
            const char* a2 = last ? nA : cA + (size_t)(t + 2) * kstep; const char* b2 = last ? nB : cB + (size_t)(t + 2) * kstep;
            const char* a3 = a2 + kstep; const char* b3 = b2 + kstep;
            if (last && has_next) S.a_ready(nxt);
            if constexpr (SP2) {
            PG8_LDB(B0, 0, 0); PG8_LDB(B1, 0, 1); PG8_SCHED; PG8_LDA(At, 0, 0); PG8_STAGE(PG8_SA(1, 1), a1 + hstep, voffA);
            PG8_WAIT_V(8); PG8_WAIT_L(0); PG8_BAR; PG8_MMA(0, 0, At, B0); PG8_MMA(0, 1, At, B1); PG8_BAR; PG8_SCHED;
            PG8_LDA(At, 0, 1); PG8_STAGE(PG8_SB(0, 0), b2, voffB); PG8_STAGE(PG8_SB(0, 1), b2 + hstep, voffB); PG8_STAGE(PG8_SA(0, 0), a2, voffA);
            PG8_WAIT_V(8); PG8_WAIT_L(0); PG8_BAR; PG8_MMA(1, 0, At, B0); PG8_MMA(1, 1, At, B1); PG8_BAR; PG8_SCHED;
            PG8_LDB(B0, 1, 0); PG8_LDB(B1, 1, 1); PG8_SCHED; PG8_LDA(At, 1, 0); PG8_STAGE(PG8_SA(0, 1), a2 + hstep, voffA);
            PG8_WAIT_V(8); PG8_WAIT_L(0); PG8_BAR; PG8_MMA(0, 0, At, B0); PG8_MMA(0, 1, At, B1); PG8_BAR; PG8_SCHED;
            PG8_LDA(At, 1, 1); PG8_STAGE(PG8_SB(1, 0), b3, voffB); PG8_STAGE(PG8_SB(1, 1), b3 + hstep, voffB); PG8_STAGE(PG8_SA(1, 0), a3, voffA);
            PG8_WAIT_V(8); PG8_WAIT_L(0); PG8_BAR; PG8_MMA(1, 0, At, B0); PG8_MMA(1, 1, At, B1); PG8_BAR; PG8_SCHED;
            } else {
            PG8_LDB(B0, 0, 0); PG8_SCHED; PG8_LDA(At, 0, 0); PG8_STAGE(PG8_SA(1, 1), a1 + hstep, voffA);
            PG8_WAIT_L(8); PG8_BAR; PG8_WAIT_L(0); PG8_MMA(0, 0, At, B0); PG8_BAR; PG8_SCHED;
            PG8_LDB(B1, 0, 1); PG8_STAGE(PG8_SB(0, 0), b2, voffB);
            PG8_BAR; PG8_WAIT_L(0); PG8_MMA(0, 1, At, B1); PG8_BAR;
            PG8_LDA(At, 0, 1); PG8_STAGE(PG8_SA(0, 0), a2, voffA);
            PG8_BAR; PG8_WAIT_L(0); PG8_MMA(1, 0, At, B0); PG8_BAR; PG8_SCHED;
            PG8_STAGE(PG8_SB(0, 1), b2 + hstep, voffB);
            PG8_WAIT_V(6); PG8_BAR; PG8_MMA(1, 1, At, B1); PG8_BAR;
            PG8_LDB(B0, 1, 0); PG8_SCHED; PG8_LDA(At, 1, 0); PG8_STAGE(PG8_SA(0, 1), a2 + hstep, voffA);
            PG8_WAIT_L(8); PG8_BAR; PG8_WAIT_L(0); PG8_MMA(0, 0, At, B0); PG8_BAR; PG8_SCHED;
            PG8_LDB(B1, 1, 1); PG8_STAGE(PG8_SB(1, 0), b3, voffB);
            PG8_BAR; PG8_WAIT_L(0); PG8_MMA(0, 1, At, B1); PG8_BAR;
            PG8_LDA(At, 1, 1); PG8_STAGE(PG8_SA(1, 0), a3, voffA);
            PG8_BAR; PG8_WAIT_L(0); PG8_MMA(1, 0, At, B0); PG8_BAR; PG8_SCHED;
            PG8_STAGE(PG8_SB(1, 1), b3 + hstep, voffB);
            PG8_WAIT_V(6); PG8_BAR; PG8_MMA(1, 1, At, B1); PG8_BAR;
            }
        }
        if constexpr (ALIGN_EPI) { if (wr == 0) PG8_BAR; }
        if constexpr (!Epi::AFTER_DRAIN) { E(acc, cur, wr, wc, fr, fq); S.done(cur); }
        if (!has_next) break;
#pragma unroll
        for (int a = 0; a < 2; ++a)
#pragma unroll
            for (int b = 0; b < 2; ++b)
#pragma unroll
                for (int m = 0; m < 4; ++m)
#pragma unroll
                    for (int n = 0; n < 2; ++n) acc[a][b][m][n] = (f32x4){0.f, 0.f, 0.f, 0.f};
        cur = nxt; cA = nA; cB = nB; ++ui;
        if constexpr (ALIGN_EPI) { if (wr == 1) PG8_BAR; }
    }
    PG8_WAIT_V(0);
    if constexpr (!ALIGN_EPI) { if (wr == 0) PG8_BAR; }
    PG8_BAR;
    if constexpr (Epi::AFTER_DRAIN) { E.fused(acc, cur, wr, wc, fr, fq, lds, wid, lane); S.done(cur); }
#undef PG8_SA
#undef PG8_SB
#undef PG8_STAGE
#undef PG8_LDA
#undef PG8_LDB
#undef PG8_MMA
#undef PG8_WAIT_V
#undef PG8_WAIT_L
#undef PG8_BAR
#undef PG8_SCHED
}

}
namespace mk {
using pg8::bf16_t; using pg8::bf16x8; using pg8::f32x4; using pg8::u32x4; using pg8::cvt_pk_bf16;
typedef float f32x16 __attribute__((ext_vector_type(16)));
typedef float f32x2 __attribute__((ext_vector_type(2)));
typedef unsigned u32x2 __attribute__((ext_vector_type(2)));
constexpr int D = 1024, NB = 32, SEQ = 2048, M = NB * SEQ, NH = 8, DH = 64;
constexpr int RWC = 1792, GC = 2048, INC = 5376, DFF = 2816;
constexpr float RMS_EPS = 1e-6f, GN_EPS = 64e-5f;
constexpr size_t MiB = (size_t)1 << 20;
constexpr size_t O_WIN = 0, O_WSB = 11 * MiB, O_WRW = 12 * MiB, O_WO = 13 * MiB, O_WGU = 15 * MiB, O_WDN = 26 * MiB, O_WLU = 32 * MiB  , O_WLA = O_WLU + 65536, O_WLG = O_WLA + 65536;
constexpr size_t O_Q = 34 * MiB, O_K = 98 * MiB, O_VT = 162 * MiB, O_PRW = 226 * MiB, O_H = 450 * MiB, O_SI = 450 * MiB, O_G = 834 * MiB, O_SC = 898 * MiB, O_YR = 290 * MiB  ;
constexpr size_t O_OSB = 226 * MiB, O_ORW = 34 * MiB, O_T1 = 98 * MiB, O_MRG = 450 * MiB, O_TT = 34 * MiB, O_H2 = 162 * MiB, O_HID = 290 * MiB, O_FF = 34 * MiB;
constexpr size_t O_X1B = 706 * MiB;
constexpr size_t WS_NEED = 1009 * MiB;
constexpr int LDS_BYTES = pg8::STAGE_BYTES + 64;
constexpr size_t O_CTL = 1008 * MiB, CTL_BYTES = 65536;
constexpr int NPH = 12;

struct Args { const float* in[24]; float* out; unsigned char* ws; int ph_lo, ph_hi; };

__device__ __forceinline__ int my_tid() { int t = threadIdx.x; asm volatile("" : "+v"(t)); return t; }
__device__ __forceinline__ float bf_lo(unsigned u) { return __uint_as_float(u << 16); }
__device__ __forceinline__ float bf_hi(unsigned u) { return __uint_as_float(u & 0xffff0000u); }
__device__ __forceinline__ float fexp(float x) { return __builtin_amdgcn_exp2f(x * 1.44269504089f); }
__device__ __forceinline__ float flog(float x) { return __builtin_amdgcn_logf(x) * 0.69314718056f; }
__device__ __forceinline__ float frcp(float x) { return __builtin_amdgcn_rcpf(x); }
__device__ __forceinline__ float fsigmoid(float x) { return frcp(1.f + fexp(-x)); }
__device__ __forceinline__ unsigned short bf1(float x) { return (unsigned short)(cvt_pk_bf16(x, x) & 0xffffu); }
__device__ __forceinline__ u32x4 pack8(const f32x4 a, const f32x4 b) { u32x4 o; o.x = cvt_pk_bf16(a[0], a[1]); o.y = cvt_pk_bf16(a[2], a[3]); o.z = cvt_pk_bf16(b[0], b[1]); o.w = cvt_pk_bf16(b[2], b[3]); return o; }
__device__ __forceinline__ float red16(float v) {
    v += __shfl_xor(v, 16); v += __shfl_xor(v, 32); return v;
}
__device__ __forceinline__ float wave_sum(float v) {
#pragma unroll
    for (int o = 1; o < 64; o <<= 1) v += __shfl_xor(v, o);
    return v;
}

__device__ __forceinline__ void tr_item(const float* __restrict__ W, int K, int N, bf16_t* WT, float* scr, int item, int lane, int mode) {
    const int nblk = N >> 5, kb = item / nblk, nb = item - kb * nblk, k0 = kb << 6, n0 = nb << 5;
#pragma unroll 8
    for (int i = 0; i < 32; ++i) { const int kk = 2 * i + (lane >> 5); scr[kk * 33 + (lane & 31)] = W[(size_t)(k0 + kk) * N + n0 + (lane & 31)]; }
    asm volatile("s_waitcnt lgkmcnt(0)" ::: "memory"); __builtin_amdgcn_wave_barrier();
    const int c = lane & 7;
#pragma unroll
    for (int j = 0; j < 4; ++j) {
        const int n = (lane >> 3) + 8 * j; const float* s = scr + (8 * c) * 33 + n;
        u32x4 o; o.x = cvt_pk_bf16(s[0 * 33], s[1 * 33]); o.y = cvt_pk_bf16(s[2 * 33], s[3 * 33]); o.z = cvt_pk_bf16(s[4 * 33], s[5 * 33]); o.w = cvt_pk_bf16(s[6 * 33], s[7 * 33]);
        const int nn = n0 + n; int drow = nn;
        if (mode == 1) drow = ((nn >> 7) << 8) + (nn & 127); else if (mode == 2) drow = ((nn >> 7) << 8) + 128 + (nn & 127);
        *(u32x4*)(WT + (size_t)drow * K + k0 + 8 * c) = o;
    }
    asm volatile("s_waitcnt lgkmcnt(0)" ::: "memory"); __builtin_amdgcn_wave_barrier();
}

__device__ __forceinline__ void phase_prep(const Args& a, float* lds_f, int G) {
    const int tid = my_tid(); const int wave = tid >> 6, lane = tid & 63;
    const int gw = blockIdx.x * 8 + wave, NGW = G * 8;
    float* scr = lds_f + wave * (64 * 33 + 16);
    unsigned char* ws = a.ws;
    constexpr int I_IN = 16 * 168, I_SB = 8 * 32, I_O = 16 * 32, I_G = 16 * 88, I_DN = 44 * 32, I_LU = 16, I_LG = 32;
    constexpr int NIT = I_IN + 2 * I_SB + I_O + 2 * I_G + I_DN + 2 * I_LU + I_LG;
    for (int it = gw; it < NIT; it += NGW) {
        int r = it;
        if (r < I_IN) { tr_item(a.in[2], 1024, INC, (bf16_t*)(ws + O_WIN), scr, r, lane, 0); continue; } r -= I_IN;
        if (r < I_SB) { tr_item(a.in[15], 512, 1024, (bf16_t*)(ws + O_WSB), scr, r, lane, 0); continue; } r -= I_SB;
        if (r < I_SB) { tr_item(a.in[16], 512, 1024, (bf16_t*)(ws + O_WRW), scr, r, lane, 0); continue; } r -= I_SB;
        if (r < I_O) { tr_item(a.in[17], 1024, 1024, (bf16_t*)(ws + O_WO), scr, r, lane, 0); continue; } r -= I_O;
        if (r < I_G) { tr_item(a.in[20], 1024, DFF, (bf16_t*)(ws + O_WGU), scr, r, lane, 1); continue; } r -= I_G;
        if (r < I_G) { tr_item(a.in[21], 1024, DFF, (bf16_t*)(ws + O_WGU), scr, r, lane, 2); continue; } r -= I_G;
        if (r < I_DN) { tr_item(a.in[22], DFF, 1024, (bf16_t*)(ws + O_WDN), scr, r, lane, 0); continue; } r -= I_DN;
        if (r < I_LU) { tr_item(a.in[6], 64, 512, (bf16_t*)(ws + O_WLU), scr, r, lane, 0); continue; } r -= I_LU;
        if (r < I_LU) { tr_item(a.in[8], 64, 512, (bf16_t*)(ws + O_WLA), scr, r, lane, 0); continue; } r -= I_LU;
        tr_item(a.in[9], 128, 512, (bf16_t*)(ws + O_WLG), scr, r, lane, 0);
    }
    const float* x = a.in[0]; const float* g = a.in[1]; bf16_t* H = (bf16_t*)(ws + O_H);
    f32x4 gv[4];
#pragma unroll
    for (int j = 0; j < 4; ++j) gv[j] = ((const f32x4*)g)[lane + 64 * j];
    for (int row0 = gw; row0 < M; row0 += 2 * NGW) {
        f32x4 v[2][4];
#pragma unroll
        for (int u = 0; u < 2; ++u) { const int row = (row0 + u * NGW < M) ? row0 + u * NGW : row0; const f32x4* xr = (const f32x4*)(x + (size_t)row * D) + lane;
#pragma unroll
            for (int j = 0; j < 4; ++j) v[u][j] = xr[64 * j]; }
#pragma unroll
        for (int u = 0; u < 2; ++u) { const int row = row0 + u * NGW; float s = 0.f;
#pragma unroll
            for (int j = 0; j < 4; ++j) s += (v[u][j][0] * v[u][j][0] + v[u][j][1] * v[u][j][1]) + (v[u][j][2] * v[u][j][2] + v[u][j][3] * v[u][j][3]);
            const float rs = rsqrtf(wave_sum(s) * (1.f / D) + RMS_EPS);
            if (row < M) { u32x2* o = (u32x2*)(H + (size_t)row * D) + lane;
#pragma unroll
                for (int j = 0; j < 4; ++j) { u32x2 w; w.x = cvt_pk_bf16(v[u][j][0] * rs * gv[j][0], v[u][j][1] * rs * gv[j][1]); w.y = cvt_pk_bf16(v[u][j][2] * rs * gv[j][2], v[u][j][3] * rs * gv[j][3]); o[64 * j] = w; } }
        }
    }
}

struct Epi1 {
    static constexpr bool PERM = true, AFTER_DRAIN = false;
    bf16_t *Q, *Kb, *Vt, *Prw, *Gt; const float* bgate;
    __device__ __forceinline__ void operator()(const f32x4 (&acc)[2][2][4][2], const pg8::Unit& u, int wr, int wc, int fr, int fq) const {
        const int row0 = u.pm * 256 + wr * 64 + fr, pn = u.pn, cl = wc * 32 + 8 * fq;
        if (pn < 4) {
            bf16_t* dst = pn < 2 ? Q : Kb; const float sc = pn < 2 ? 0.125f : 1.f; const int cb = (pn & 1) * 256 + cl;
#pragma unroll
            for (int ai = 0; ai < 2; ++ai)
#pragma unroll
                for (int m = 0; m < 4; ++m) { bf16_t* rp = dst + (size_t)(row0 + ai * 128 + m * 16) * 512 + cb;
#pragma unroll
                    for (int bj = 0; bj < 2; ++bj) *(u32x4*)(rp + bj * 128) = pack8(acc[ai][bj][m][0] * sc, acc[ai][bj][m][1] * sc); }
        } else if (pn < 6) {
#pragma unroll
            for (int ai = 0; ai < 2; ++ai)
#pragma unroll
                for (int m = 0; m < 4; ++m) { const int row = row0 + ai * 128 + m * 16, b = row >> 11, s = row & 2047;
#pragma unroll
                    for (int bj = 0; bj < 2; ++bj)
#pragma unroll
                        for (int n = 0; n < 2; ++n)
#pragma unroll
                            for (int j = 0; j < 4; ++j) { const int c = (pn - 4) * 256 + bj * 128 + cl + 4 * n + j;
                                Vt[((size_t)(b * 512 + c)) * 2048 + s] = bf1(acc[ai][bj][m][n][j]); } }
        } else if (pn < 13) {
            const int cb = (pn - 6) * 256 + cl;
#pragma unroll
            for (int ai = 0; ai < 2; ++ai)
#pragma unroll
                for (int m = 0; m < 4; ++m) { bf16_t* rp = Prw + (size_t)(row0 + ai * 128 + m * 16) * RWC + cb;
#pragma unroll
                    for (int bj = 0; bj < 2; ++bj) *(u32x4*)(rp + bj * 128) = pack8(acc[ai][bj][m][0], acc[ai][bj][m][1]); }
        } else {
            const int cb = (pn - 13) * 256 + cl;
#pragma unroll
            for (int ai = 0; ai < 2; ++ai)
#pragma unroll
                for (int m = 0; m < 4; ++m) { bf16_t* rp = Gt + (size_t)(row0 + ai * 128 + m * 16) * GC + cb;
#pragma unroll
                    for (int bj = 0; bj < 2; ++bj) { f32x4 v0 = acc[ai][bj][m][0] + *(const f32x4*)(bgate + cb + bj * 128), v1 = acc[ai][bj][m][1] + *(const f32x4*)(bgate + cb + bj * 128 + 4);
#pragma unroll
                        for (int j = 0; j < 4; ++j) { v0[j] = fsigmoid(v0[j]); v1[j] = fsigmoid(v1[j]); }
                        *(u32x4*)(rp + bj * 128) = pack8(v0, v1); } }
        }
    }
};
template <int MODE> struct EpiRow {
    static constexpr bool PERM = true, AFTER_DRAIN = false;
    bf16_t* O; const bf16_t* T1; const bf16_t* Gt;
    __device__ __forceinline__ void operator()(const f32x4 (&acc)[2][2][4][2], const pg8::Unit& u, int wr, int wc, int fr, int fq) const {
        const int row0 = u.pm * 256 + wr * 64 + fr, cb = u.pn * 256 + wc * 32 + 8 * fq;
#pragma unroll
        for (int ai = 0; ai < 2; ++ai)
#pragma unroll
            for (int m = 0; m < 4; ++m) { const size_t row = (size_t)(row0 + ai * 128 + m * 16);
#pragma unroll
                for (int bj = 0; bj < 2; ++bj) { f32x4 v0 = acc[ai][bj][m][0], v1 = acc[ai][bj][m][1]; const int c = cb + bj * 128;
                    if (MODE >= 1) { const u32x4 gg = *(const u32x4*)(Gt + row * GC + (MODE == 2 ? 1024 : 0) + c);
                        v0[0] *= bf_lo(gg.x); v0[1] *= bf_hi(gg.x); v0[2] *= bf_lo(gg.y); v0[3] *= bf_hi(gg.y); v1[0] *= bf_lo(gg.z); v1[1] *= bf_hi(gg.z); v1[2] *= bf_lo(gg.w); v1[3] *= bf_hi(gg.w); }
                    if (MODE == 2) { const u32x4 tt = *(const u32x4*)(T1 + row * 1024 + c);
                        v0[0] += bf_lo(tt.x); v0[1] += bf_hi(tt.x); v0[2] += bf_lo(tt.y); v0[3] += bf_hi(tt.y); v1[0] += bf_lo(tt.z); v1[1] += bf_hi(tt.z); v1[2] += bf_lo(tt.w); v1[3] += bf_hi(tt.w); }
                    *(u32x4*)(O + row * 1024 + c) = pack8(v0, v1); } }
    }
};
struct EpiSwiGLU {
    static constexpr bool PERM = true, AFTER_DRAIN = false;
    bf16_t* Hd;
    __device__ __forceinline__ void operator()(const f32x4 (&acc)[2][2][4][2], const pg8::Unit& u, int wr, int wc, int fr, int fq) const {
        const int row0 = u.pm * 256 + wr * 64 + fr, cb = u.pn * 128 + wc * 32 + 8 * fq;
#pragma unroll
        for (int ai = 0; ai < 2; ++ai)
#pragma unroll
            for (int m = 0; m < 4; ++m) { f32x4 v0, v1;
#pragma unroll
                for (int j = 0; j < 4; ++j) { const float g0 = acc[ai][0][m][0][j], g1 = acc[ai][0][m][1][j];
                    v0[j] = g0 * fsigmoid(g0) * acc[ai][1][m][0][j]; v1[j] = g1 * fsigmoid(g1) * acc[ai][1][m][1][j]; }
                *(u32x4*)(Hd + (size_t)(row0 + ai * 128 + m * 16) * DFF + cb) = pack8(v0, v1); }
    }
};
template <class Epi> __device__ __forceinline__ void run_gemm(PG8_LAS unsigned char* lds, const bf16_t* A, const bf16_t* Bt, int N, int K, const Epi& E, int G) {
    pg8::Gemm g; g.A = A; g.Bt = Bt; g.M = M; g.N = N; g.K = K;
    pg8::StaticOrder S; S.init(M, N, G, (int)blockIdx.x);
    pg8::gemm_phase<Epi, pg8::StaticOrder, true, true>(lds, g, S, E);
}
__device__ __forceinline__ void mix8_lds(const unsigned char* cur, const unsigned char* prv, const float* mu, float (&o)[8]) {
    const u32x4 c = *(const u32x4*)cur, p = *(const u32x4*)prv;
    const f32x4 m0 = *(const f32x4*)mu, m1 = *(const f32x4*)(mu + 4);
    const float mm[8] = {m0[0], m0[1], m0[2], m0[3], m1[0], m1[1], m1[2], m1[3]};
#pragma unroll
    for (int i = 0; i < 4; ++i) { const float cl = bf_lo(c[i]), ch = bf_hi(c[i]), pl = bf_lo(p[i]), ph = bf_hi(p[i]);
        o[2 * i] = cl + (pl - cl) * mm[2 * i]; o[2 * i + 1] = ch + (ph - ch) * mm[2 * i + 1]; }
}
__device__ __forceinline__ void mix4_lds(const unsigned char* cur, const unsigned char* prv, const float* mu, float (&o)[4]) {
    const u32x2 c = *(const u32x2*)cur, p = *(const u32x2*)prv;
    const f32x4 m0 = *(const f32x4*)mu;
#pragma unroll
    for (int i = 0; i < 2; ++i) { const float cl = bf_lo(c[i]), ch = bf_hi(c[i]), pl = bf_lo(p[i]), ph = bf_hi(p[i]);
        o[2 * i] = cl + (pl - cl) * m0[2 * i]; o[2 * i + 1] = ch + (ph - ch) * m0[2 * i + 1]; }
}
__device__ __forceinline__ bf16x8 pack_frag(const float (&v)[8]) {
    u32x4 o; o.x = cvt_pk_bf16(v[0], v[1]); o.y = cvt_pk_bf16(v[2], v[3]); o.z = cvt_pk_bf16(v[4], v[5]); o.w = cvt_pk_bf16(v[6], v[7]);
    return __builtin_bit_cast(bf16x8, o);
}
__device__ __forceinline__ void phase_rwprep(const Args& a, unsigned char* lds, int G) {
    constexpr int ROWB = 3600, L_FRAG = 17 * ROWB, L_PAR = L_FRAG + 8192, NCH = 17 * 224, NT = M / 16;
    const int tid = my_tid(); const int wave = __builtin_amdgcn_readfirstlane(tid >> 6), lane = tid & 63, fr = lane & 15, fq = lane >> 4;
    unsigned char* ws = a.ws;
    const unsigned char* PRW = ws + O_PRW;
    const bf16_t* WLU = (const bf16_t*)(ws + O_WLU); const bf16_t* WLA = (const bf16_t*)(ws + O_WLA); const bf16_t* WLG = (const bf16_t*)(ws + O_WLG);
    unsigned char* SI = ws + O_SI; bf16_t* GB = (bf16_t*)(ws + O_G); float* SC = (float*)(ws + O_SC);
    float* par = (float*)(lds + L_PAR);
    for (int i = tid; i < 1792 + 5 * 512; i += 512) {
        float v;
        if (i < 1792) v = a.in[4][i]; else { const int j = i - 1792, w = j >> 9, c = j & 511; v = (w == 0 ? a.in[5] : w == 1 ? a.in[7] : w == 2 ? a.in[10] : w == 3 ? a.in[11] : a.in[12])[c]; }
        par[i] = v;
    }
    for (int tile = blockIdx.x; tile < NT; tile += G) {
        __syncthreads();
        {   u32x4 pre[8];
#pragma unroll
            for (int j = 0; j < 8; ++j) { const int c = tid + 512 * j; pre[j] = (u32x4){0u, 0u, 0u, 0u};
                if (c < NCH) { const int row = c / 224, col = c - row * 224; const bool zero = (row == 0) && (((tile * 16) & (SEQ - 1)) == 0);
                    if (!zero) pre[j] = *(const u32x4*)(PRW + ((size_t)tile * 16 + row - 1) * (RWC * 2) + col * 16); } }
#pragma unroll
            for (int j = 0; j < 8; ++j) { const int c = tid + 512 * j; if (c < NCH) { const int row = c / 224, col = c - row * 224; *(u32x4*)(lds + row * ROWB + col * 16) = pre[j]; } }
        }
        __syncthreads();
        const unsigned char* rcur = lds + (fr + 1) * ROWB; const unsigned char* rprv = lds + fr * ROWB;
        {
            const int colb = wave < 2 ? 1536 + 32 * wave : (wave < 4 ? 1600 + 32 * (wave - 2) : 1664 + 32 * (wave - 4));
            float t8[8]; mix8_lds(rcur + (colb + 8 * fq) * 2, rprv + (colb + 8 * fq) * 2, par + colb + 8 * fq, t8);
            if (wave < 2) {
#pragma unroll
                for (int i = 0; i < 8; ++i) { const float e = fexp(2.f * t8[i]); t8[i] = 1.f - 2.f * frcp(e + 1.f); } }
            else if (wave >= 4) {
#pragma unroll
                for (int i = 0; i < 8; ++i) t8[i] = fsigmoid(t8[i]); }
            *(bf16x8*)(lds + L_FRAG + wave * 1024 + lane * 16) = pack_frag(t8);
        }
        __syncthreads();
        bf16x8 Aw[2], Aa[2], Ag[4];
#pragma unroll
        for (int s = 0; s < 2; ++s) { Aw[s] = *(const bf16x8*)(lds + L_FRAG + s * 1024 + lane * 16); Aa[s] = *(const bf16x8*)(lds + L_FRAG + (2 + s) * 1024 + lane * 16); }
#pragma unroll
        for (int s = 0; s < 4; ++s) Ag[s] = *(const bf16x8*)(lds + L_FRAG + (4 + s) * 1024 + lane * 16);
        const int h = wave; const size_t m = (size_t)tile * 16 + fr;
        float kkr[16], av[16]; unsigned lk[16], rvp[16];
        float ss = 0.f, brs = 0.f, krs = 0.f, rkbs = 0.f;
#pragma unroll
        for (int n = 0; n < 4; ++n) {
            asm volatile("" ::: "memory");
            const int cb = 64 * h + 16 * n, c0 = cb + 4 * fq;
            f32x4 aw = {0.f, 0.f, 0.f, 0.f}, aa = aw, ag = aw;
#pragma unroll
            for (int s = 0; s < 2; ++s) {
                aw = __builtin_amdgcn_mfma_f32_16x16x32_bf16(*(const bf16x8*)(WLU + (size_t)(cb + fr) * 64 + 32 * s + 8 * fq), Aw[s], aw, 0, 0, 0);
                aa = __builtin_amdgcn_mfma_f32_16x16x32_bf16(*(const bf16x8*)(WLA + (size_t)(cb + fr) * 64 + 32 * s + 8 * fq), Aa[s], aa, 0, 0, 0); }
#pragma unroll
            for (int s = 0; s < 4; ++s)
                ag = __builtin_amdgcn_mfma_f32_16x16x32_bf16(*(const bf16x8*)(WLG + (size_t)(cb + fr) * 128 + 32 * s + 8 * fq), Ag[s], ag, 0, 0, 0);
            float rr[4], kr4[4], vv[4];
            mix4_lds(rcur + c0 * 2, rprv + c0 * 2, par + c0, rr); mix4_lds(rcur + (512 + c0) * 2, rprv + (512 + c0) * 2, par + 512 + c0, kr4); mix4_lds(rcur + (1024 + c0) * 2, rprv + (1024 + c0) * 2, par + 1024 + c0, vv);
            const f32x4 w0v = *(const f32x4*)(par + 1792 + c0), a0v = *(const f32x4*)(par + 2304 + c0), kkv = *(const f32x4*)(par + 2816 + c0), kav = *(const f32x4*)(par + 3328 + c0), rkv = *(const f32x4*)(par + 3840 + c0);
#pragma unroll
            for (int j = 0; j < 4; ++j) {
                const float sg = fsigmoid(w0v[j] + aw[j]);
                const float ldx = -0.60653065971f * 1.44269504089f * sg;
                const float av_ = fsigmoid(a0v[j] + aa[j]);
                const float kkraw = kr4[j] * kkv[j];
                const float k2 = kr4[j] * (1.f + (av_ - 1.f) * kav[j]);
                ss += kkraw * kkraw; brs += kkraw * av_ * rr[j]; krs += k2 * rr[j]; rkbs += rr[j] * k2 * rkv[j];
                kkr[4 * n + j] = kkraw; av[4 * n + j] = av_; lk[4 * n + j] = cvt_pk_bf16(ldx, k2); rvp[4 * n + j] = cvt_pk_bf16(rr[j], vv[j]);
            }
            u32x2 gp; gp.x = cvt_pk_bf16(ag[0], ag[1]); gp.y = cvt_pk_bf16(ag[2], ag[3]);
            *(u32x2*)(GB + m * 512 + c0) = gp;
        }
        ss = red16(ss); brs = red16(brs); krs = red16(krs); rkbs = red16(rkbs);
        const float inv = 1.f / fmaxf(sqrtf(ss), 1e-12f);
        unsigned char* rec = SI + ((m * 8 + h) * 64) * 12;
#pragma unroll
        for (int n = 0; n < 4; ++n) {
            unsigned dw[12];
#pragma unroll
            for (int j = 0; j < 4; ++j) { const float kk = kkr[4 * n + j] * inv;
                const unsigned kp = cvt_pk_bf16(kk * av[4 * n + j], -kk);
                dw[3 * j] = (lk[4 * n + j] & 0xffffu) | (kp & 0xffff0000u); dw[3 * j + 1] = (kp & 0xffffu) | (lk[4 * n + j] & 0xffff0000u); dw[3 * j + 2] = rvp[4 * n + j]; }
            u32x4* dst = (u32x4*)(rec + (16 * n + 4 * fq) * 12);
            u32x4 s0 = {dw[0], dw[1], dw[2], dw[3]}, s1 = {dw[4], dw[5], dw[6], dw[7]}, s2 = {dw[8], dw[9], dw[10], dw[11]};
            dst[0] = s0; dst[1] = s1; dst[2] = s2;
        }
        if (fq == 0) { f32x4 scv = {brs * inv, krs, rkbs, 0.f}; *(f32x4*)(SC + (m * 8 + h) * 4) = scv; }
    }
    __syncthreads();
}

__device__ __forceinline__ float red_rows(float x) {
    float a0 = x, a1 = x;
    asm volatile("s_nop 1\n\tv_permlane16_swap_b32 %0, %1" : "+v"(a0), "+v"(a1));
    float b0 = a0 + a1, b1 = b0;
    asm volatile("s_nop 1\n\tv_permlane32_swap_b32 %0, %1" : "+v"(b0), "+v"(b1));
    return b0 + b1;
}
constexpr int SC_T = 16, SC_ROW = 1552, SC_BUF = SC_T * SC_ROW;
struct ProdRec { unsigned d0, d1, d2; f32x2 sc; };
__device__ __forceinline__ void prod_load(ProdRec (&P)[4], const unsigned char* sb, const float* scp, int chunk, int pl) {
    const int col = pl & 63;
#pragma unroll
    for (int q = 0; q < 4; ++q) { const size_t t = (size_t)chunk * SC_T + (pl >> 6) + 4 * q;
        const unsigned* p = (const unsigned*)(sb + t * 6144 + col * 12); P[q].d0 = p[0]; P[q].d1 = p[1]; P[q].d2 = p[2];
        P[q].sc = (f32x2){0.f, 0.f}; if (col == 0) P[q].sc = *(const f32x2*)(scp + t * 32); }
}
__device__ __forceinline__ void prod_store(const ProdRec (&P)[4], unsigned char* buf, int pl) {
    const int col = pl & 63;
#pragma unroll
    for (int q = 0; q < 4; ++q) { unsigned char* base = buf + ((pl >> 6) + 4 * q) * SC_ROW + col * 4;
        const float w = __builtin_amdgcn_exp2f(bf_lo(P[q].d0));
        *(float*)(base) = bf_hi(P[q].d0); *(float*)(base + 256) = w * bf_lo(P[q].d2); *(float*)(base + 512) = w;
        *(float*)(base + 768) = bf_lo(P[q].d1); *(float*)(base + 1024) = bf_hi(P[q].d1); *(float*)(base + 1280) = bf_hi(P[q].d2);
        if (col == 0) *(f32x2*)(base + 1536) = P[q].sc; }
}
#define MK_SWAP32(a, b) asm volatile("s_nop 1\n\tv_permlane32_swap_b32 %0, %1" : "+v"(a), "+v"(b))
#define MK_SWAP16(a, b) asm volatile("s_nop 1\n\tv_permlane16_swap_b32 %0, %1" : "+v"(a), "+v"(b))
__device__ __forceinline__ void red4x8(float& A, float& B, float& C, float& D) {
    MK_SWAP32(A, B); float u = A + B;
    MK_SWAP32(C, D); float w = C + D;
    MK_SWAP16(u, w); float z = u + w;
    float z1;
    asm volatile("s_nop 1\n\tv_add_f32_dpp %0, %1, %1 row_ror:8 row_mask:0xf bank_mask:0xf" : "=&v"(z1) : "v"(z));
    float p = z1, q = z1; MK_SWAP32(p, q);
    float p2 = p; MK_SWAP16(p, p2);
    float q2 = q; MK_SWAP16(q, q2);
    A = p; C = p2; B = q; D = q2;
}
__device__ __forceinline__ void scan_consume(f32x2 (&S)[8], const unsigned char* buf, unsigned char* ybuf, int lane, int rb) {
    const unsigned co = (unsigned)(lane >> 3) * 32u, vo = 1280u + (unsigned)(16 * rb + (lane & 7)) * 4u;
#pragma unroll 4
    for (int st = 0; st < SC_T; ++st) {
        const unsigned char* sb = buf + st * SC_ROW;
        f32x4 n4[2], r4[2], w4[2], a4[2], k4[2];
#pragma unroll
        for (int q = 0; q < 2; ++q) { n4[q] = *(const f32x4*)(sb + co + 16 * q); r4[q] = *(const f32x4*)(sb + 256 + co + 16 * q); w4[q] = *(const f32x4*)(sb + 512 + co + 16 * q);
            a4[q] = *(const f32x4*)(sb + 768 + co + 16 * q); k4[q] = *(const f32x4*)(sb + 1024 + co + 16 * q); }
        const float v0 = *(const float*)(sb + vo), v1 = *(const float*)(sb + vo + 32);
        f32x2 sa0v = {0.f, 0.f}, sa1v = sa0v, yp0v = sa0v, yp1v = sa0v;
#pragma unroll
        for (int p = 0; p < 4; ++p) { const f32x2 nn = {n4[p >> 1][2 * (p & 1)], n4[p >> 1][2 * (p & 1) + 1]}, rr2 = {r4[p >> 1][2 * (p & 1)], r4[p >> 1][2 * (p & 1) + 1]};
            sa0v += S[p] * nn; sa1v += S[4 + p] * nn; yp0v += S[p] * rr2; yp1v += S[4 + p] * rr2; }
        float sa0 = sa0v[0] + sa0v[1], sa1 = sa1v[0] + sa1v[1], yp0 = yp0v[0] + yp0v[1], yp1 = yp1v[0] + yp1v[1];
        red4x8(sa0, sa1, yp0, yp1);
        const f32x2 s0 = {sa0, sa0}, s1 = {sa1, sa1}, vv0 = {v0, v0}, vv1 = {v1, v1};
#pragma unroll
        for (int p = 0; p < 4; ++p) { const f32x2 ww = {w4[p >> 1][2 * (p & 1)], w4[p >> 1][2 * (p & 1) + 1]}; S[p] = S[p] * ww; S[4 + p] = S[4 + p] * ww; }
        asm volatile("" ::: "memory");
#pragma unroll
        for (int p = 0; p < 4; ++p) { const f32x2 aa = {a4[p >> 1][2 * (p & 1)], a4[p >> 1][2 * (p & 1) + 1]}; S[p] = __builtin_elementwise_fma(aa, s0, S[p]); S[4 + p] = __builtin_elementwise_fma(aa, s1, S[4 + p]); }
        asm volatile("" ::: "memory");
#pragma unroll
        for (int p = 0; p < 4; ++p) { const f32x2 kk = {k4[p >> 1][2 * (p & 1)], k4[p >> 1][2 * (p & 1) + 1]}; S[p] = __builtin_elementwise_fma(kk, vv0, S[p]); S[4 + p] = __builtin_elementwise_fma(kk, vv1, S[4 + p]); }
        if (lane < 8) { f32x4 o = {yp0, sa0, yp1, sa1}; *(f32x4*)(ybuf + st * 1024 + rb * 256 + lane * 16) = o; }
    }
}
__device__ __forceinline__ void prod_finish(const unsigned char* sb, const float* scp, const unsigned char* ybuf, unsigned* yr, int chunk, int pw, int lane) {
#pragma unroll
    for (int q = 0; q < SC_T / 4; ++q) { const int st = (lane >> 4) + 4 * q, row16 = lane & 15, e = row16 >> 3, rr = row16 & 7; const size_t t = (size_t)chunk * SC_T + st;
        const f32x2 ys = *(const f32x2*)(ybuf + st * 1024 + pw * 256 + rr * 16 + e * 8);
        const unsigned vb = *(const unsigned short*)(sb + t * 6144 + (16 * pw + row16) * 12 + 10); const f32x2 bk = *(const f32x2*)(scp + t * 32);
        const float v = __uint_as_float(vb << 16), y = ys[0] + ys[1] * bk[0] + v * bk[1];
        yr[(size_t)st * 512 + row16] = (unsigned)bf1(y) | (vb << 16); }
}

__device__ __forceinline__ void rwpost_local(const Args& a, int bh, int tid) {
    const float* SC = (const float*)(a.ws + O_SC);
    const unsigned* YR = (const unsigned*)(a.ws + O_YR); const bf16_t* GB = (const bf16_t*)(a.ws + O_G); bf16_t* ORW = (bf16_t*)(a.ws + O_ORW);
    const int b = bh >> 3, h = bh & 7, c = 64 * h + (tid & 15) * 4;
    const f32x4 lwv = *(const f32x4*)(a.in[13] + c), lbv = *(const f32x4*)(a.in[14] + c);
    for (int t0 = tid >> 4; t0 < SEQ; t0 += 64) {
        u32x4 yv[2]; u32x2 gb[2]; float rkb[2]; size_t mm[2];
#pragma unroll
        for (int u = 0; u < 2; ++u) { const size_t m = (size_t)b * SEQ + t0 + 32 * u; mm[u] = m;
            yv[u] = *(const u32x4*)(YR + m * 512 + c); gb[u] = *(const u32x2*)(GB + m * 512 + c); rkb[u] = SC[(m * 8 + h) * 4 + 2]; }
#pragma unroll
        for (int u = 0; u < 2; ++u) {
            float y[4] = {bf_lo(yv[u].x), bf_lo(yv[u].y), bf_lo(yv[u].z), bf_lo(yv[u].w)};
            const float v[4] = {bf_hi(yv[u].x), bf_hi(yv[u].y), bf_hi(yv[u].z), bf_hi(yv[u].w)};
            float s = (y[0] + y[1]) + (y[2] + y[3]);
#pragma unroll
            for (int o = 1; o < 16; o <<= 1) s += __shfl_xor(s, o);
            const float mean = s * (1.f / 64.f);
            float q = 0.f;
#pragma unroll
            for (int j = 0; j < 4; ++j) { y[j] -= mean; q += y[j] * y[j]; }
#pragma unroll
            for (int o = 1; o < 16; o <<= 1) q += __shfl_xor(q, o);
            const float rstd = rsqrtf(q * (1.f / 64.f) + GN_EPS);
            const float g4[4] = {bf_lo(gb[u].x), bf_hi(gb[u].x), bf_lo(gb[u].y), bf_hi(gb[u].y)};
            float o4[4];
#pragma unroll
            for (int j = 0; j < 4; ++j) o4[j] = (y[j] * rstd * lwv[j] + lbv[j] + rkb[u] * v[j]) * g4[j];
            u32x2 ob; ob.x = cvt_pk_bf16(o4[0], o4[1]); ob.y = cvt_pk_bf16(o4[2], o4[3]);
            *(u32x2*)(ORW + mm[u] * 512 + c) = ob;
        }
    }
}

struct KV { bf16x8 k[4]; bf16x8 v[2][2]; };
__device__ __forceinline__ void attn_load(KV& T, const bf16_t* Kh, const bf16_t* Vh, int k0, int n, int hf) {
    const bf16_t* kp = Kh + (size_t)(k0 + n) * 512 + 8 * hf;
#pragma unroll
    for (int s = 0; s < 4; ++s) T.k[s] = *(const bf16x8*)(kp + 16 * s);
#pragma unroll
    for (int d = 0; d < 2; ++d)
#pragma unroll
        for (int sg = 0; sg < 2; ++sg) { const bf16_t* vp = Vh + (size_t)(32 * d + n) * SEQ + k0 + 16 * sg + 4 * hf;
            const u32x2 lo = *(const u32x2*)vp, hi = *(const u32x2*)(vp + 8); u32x4 t = {lo.x, lo.y, hi.x, hi.y}; T.v[d][sg] = __builtin_bit_cast(bf16x8, t); }
}
__device__ __forceinline__ void attn_wave(const Args& a, int bh, int w4, int lane) {
    const int b = bh >> 3, h = bh & 7, n = lane & 31, hf = lane >> 5;
    const size_t m0 = (size_t)b * SEQ;
    const bf16_t* Qh = (const bf16_t*)(a.ws + O_Q) + m0 * 512 + 64 * h;
    const bf16_t* Kh = (const bf16_t*)(a.ws + O_K) + m0 * 512 + 64 * h;
    const bf16_t* Vh = (const bf16_t*)(a.ws + O_VT) + (size_t)bh * 64 * SEQ;
    bf16_t* Oh = (bf16_t*)(a.ws + O_OSB) + m0 * 512 + 64 * h;
    for (int qt = 63 - w4; qt >= 0; qt -= 8) {
        const int q0 = 32 * qt;
        bf16x8 qf[4];
#pragma unroll
        for (int s = 0; s < 4; ++s) qf[s] = *(const bf16x8*)(Qh + (size_t)(q0 + n) * 512 + 16 * s + 8 * hf);
        f32x16 o0, o1;
#pragma unroll
        for (int i = 0; i < 16; ++i) { o0[i] = 0.f; o1[i] = 0.f; }
        float carry = 0.f;
        KV cur, nxt;
        attn_load(cur, Kh, Vh, q0, n, hf);
        for (int kt = qt; kt >= 0; --kt) {
            const int ktn = kt > 0 ? kt - 1 : 0;
            attn_load(nxt, Kh, Vh, 32 * ktn, n, hf);
            f32x16 sc;
#pragma unroll
            for (int i = 0; i < 16; ++i) sc[i] = 0.f;
#pragma unroll
            for (int s = 0; s < 4; ++s) sc = __builtin_amdgcn_mfma_f32_32x32x16_bf16(cur.k[s], qf[s], sc, 0, 0, 0);
            const bool diag = (kt == qt);
            float lf[16], G4[4];
#pragma unroll
            for (int g = 0; g < 4; ++g) { G4[g] = 0.f;
#pragma unroll
                for (int i = 0; i < 4; ++i) { const int r = 4 * g + i; const float z = sc[r];
                    const bool valid = !diag || (8 * g + 4 * hf + i < n);
                    const float e = fexp(-fabsf(z));
                    const float sp = fmaxf(z, 0.f) + flog(1.f + e);
                    lf[r] = valid ? -sp : 0.f; G4[g] += lf[r]; } }
            float PG[4], T4[4];
#pragma unroll
            for (int g = 0; g < 4; ++g) { PG[g] = __shfl_xor(G4[g], 32); T4[g] = G4[g] + PG[g]; }
            const float tail3 = 0.f, tail2 = T4[3], tail1 = T4[3] + T4[2], tail0 = tail1 + T4[1], total = tail0 + T4[0];
            const float tails[4] = {tail0, tail1, tail2, tail3};
            f32x16 wv;
#pragma unroll
            for (int g = 0; g < 4; ++g) {
                float af = carry + tails[g] + (hf == 0 ? PG[g] : 0.f);
#pragma unroll
                for (int i = 3; i >= 0; --i) { const int r = 4 * g + i; const float z = sc[r];
                    const bool valid = !diag || (8 * g + 4 * hf + i < n);
                    const float wgt = fexp(lf[r] + z + af);
                    wv[r] = valid ? wgt : 0.f;
                    af += lf[r]; } }
            carry += total;
            bf16x8 wf[2];
#pragma unroll
            for (int sg = 0; sg < 2; ++sg) { u32x4 t; t.x = cvt_pk_bf16(wv[8 * sg + 0], wv[8 * sg + 1]); t.y = cvt_pk_bf16(wv[8 * sg + 2], wv[8 * sg + 3]); t.z = cvt_pk_bf16(wv[8 * sg + 4], wv[8 * sg + 5]); t.w = cvt_pk_bf16(wv[8 * sg + 6], wv[8 * sg + 7]); wf[sg] = __builtin_bit_cast(bf16x8, t); }
#pragma unroll
            for (int sg = 0; sg < 2; ++sg) { o0 = __builtin_amdgcn_mfma_f32_32x32x16_bf16(cur.v[0][sg], wf[sg], o0, 0, 0, 0); o1 = __builtin_amdgcn_mfma_f32_32x32x16_bf16(cur.v[1][sg], wf[sg], o1, 0, 0, 0); }
            cur = nxt;
#if MK_EARLY_EXIT
            if (__all(carry < -104.f)) break;
#endif
        }
        bf16_t* op = Oh + (size_t)(q0 + n) * 512 + 4 * hf;
#pragma unroll
        for (int g = 0; g < 4; ++g) {
            u32x2 t0, t1; t0.x = cvt_pk_bf16(o0[4 * g], o0[4 * g + 1]); t0.y = cvt_pk_bf16(o0[4 * g + 2], o0[4 * g + 3]); t1.x = cvt_pk_bf16(o1[4 * g], o1[4 * g + 1]); t1.y = cvt_pk_bf16(o1[4 * g + 2], o1[4 * g + 3]);
            *(u32x2*)(op + 8 * g) = t0; *(u32x2*)(op + 32 + 8 * g) = t1; }
    }
}
__device__ __forceinline__ void phase_mixer(const Args& a, unsigned char* lds, int G) {
    const int tid = my_tid(); const int wave = __builtin_amdgcn_readfirstlane(tid >> 6), lane = tid & 63;
    for (int bh = blockIdx.x; bh < NB * NH; bh += G) {
        const int b = bh >> 3, h = bh & 7; const size_t m0 = (size_t)b * SEQ;
        const unsigned char* sb = a.ws + O_SI + (m0 * 8 + h) * 768; const float* scp = (const float*)(a.ws + O_SC) + (m0 * 8 + h) * 4;
        unsigned* yrb = (unsigned*)(a.ws + O_YR) + m0 * 512 + 64 * h + 16 * (wave & 3);
        const int pl = tid - 256;
        constexpr int NCH = SEQ / SC_T;
        ProdRec pr[4]; f32x2 S[8];
#pragma unroll
        for (int p = 0; p < 8; ++p) S[p] = (f32x2){0.f, 0.f};
        __syncthreads();
        if (wave >= 4) { prod_load(pr, sb, scp, 0, pl); prod_store(pr, lds, pl); prod_load(pr, sb, scp, 1, pl); }
        __syncthreads();
        unsigned char* yring = lds + 2 * SC_BUF;
        for (int ci = 0; ci < NCH; ++ci) {
            if (wave < 4) scan_consume(S, lds + (ci & 1) * SC_BUF, yring + (ci & 1) * (SC_T * 1024), lane, wave);
            else {
                if (ci > 0) prod_finish(sb, scp, yring + ((ci - 1) & 1) * (SC_T * 1024), yrb + (size_t)(ci - 1) * SC_T * 512, ci - 1, wave & 3, lane);
                if (ci + 1 < NCH) { prod_store(pr, lds + ((ci + 1) & 1) * SC_BUF, pl); prod_load(pr, sb, scp, ci + 2 < NCH ? ci + 2 : ci + 1, pl); }
            }
            __syncthreads();
        }
        if (wave >= 4) prod_finish(sb, scp, yring + ((NCH - 1) & 1) * (SC_T * 1024), yrb + (size_t)(NCH - 1) * SC_T * 512, NCH - 1, wave & 3, lane);
        attn_wave(a, bh, wave, lane);
        __threadfence_block(); __syncthreads();
        rwpost_local(a, bh, my_tid());
    }
}

template <int MODE> __device__ __forceinline__ void phase_rows(const Args& a, int G) {
    const int tid = my_tid(); const int wave = tid >> 6, lane = tid & 63;
    const int gw = blockIdx.x * 8 + wave, NGW = G * 8;
    const bf16_t* T = (const bf16_t*)(a.ws + (MODE == 0 ? O_TT : O_FF));
    const float* g1 = MODE == 0 ? a.in[18] : a.in[23]; const float* g2 = a.in[19];
    bf16_t* H2 = (bf16_t*)(a.ws + O_H2); bf16_t* X1B = (bf16_t*)(a.ws + O_X1B);
    f32x4 g1v[4], g2v[4];
#pragma unroll
    for (int j = 0; j < 4; ++j) { g1v[j] = ((const f32x4*)g1)[lane + 64 * j]; g2v[j] = ((const f32x4*)g2)[lane + 64 * j]; }
    for (int row0 = gw; row0 < M; row0 += 2 * NGW) {
        u32x2 tb[2][4]; f32x4 x[2][4];
#pragma unroll
        for (int u = 0; u < 2; ++u) { const int row = (row0 + u * NGW < M) ? row0 + u * NGW : row0;
            const u32x2* tr = (const u32x2*)(T + (size_t)row * D) + lane;
#pragma unroll
            for (int j = 0; j < 4; ++j) tb[u][j] = tr[64 * j];
            if (MODE == 0) { const f32x4* xr = (const f32x4*)(a.in[0] + (size_t)row * D) + lane;
#pragma unroll
                for (int j = 0; j < 4; ++j) x[u][j] = xr[64 * j]; }
            else { const u32x2* xr = (const u32x2*)(X1B + (size_t)row * D) + lane;
#pragma unroll
                for (int j = 0; j < 4; ++j) { const u32x2 xb = xr[64 * j]; x[u][j][0] = bf_lo(xb.x); x[u][j][1] = bf_hi(xb.x); x[u][j][2] = bf_lo(xb.y); x[u][j][3] = bf_hi(xb.y); } } }
#pragma unroll
        for (int u = 0; u < 2; ++u) {
            const int row = row0 + u * NGW;
            f32x4 t[4]; float s = 0.f;
#pragma unroll
            for (int j = 0; j < 4; ++j) { t[j][0] = bf_lo(tb[u][j].x); t[j][1] = bf_hi(tb[u][j].x); t[j][2] = bf_lo(tb[u][j].y); t[j][3] = bf_hi(tb[u][j].y);
                s += (t[j][0] * t[j][0] + t[j][1] * t[j][1]) + (t[j][2] * t[j][2] + t[j][3] * t[j][3]); }
            const float rs = rsqrtf(wave_sum(s) * (1.f / D) + RMS_EPS);
            float s2 = 0.f;
#pragma unroll
            for (int j = 0; j < 4; ++j)
#pragma unroll
                for (int e = 0; e < 4; ++e) { x[u][j][e] += t[j][e] * rs * g1v[j][e]; s2 += x[u][j][e] * x[u][j][e]; }
            float rs2 = 0.f;
            if (MODE == 0) rs2 = rsqrtf(wave_sum(s2) * (1.f / D) + RMS_EPS);
            if (row < M) {
                if (MODE == 0) {
                    u32x2* xo = (u32x2*)(X1B + (size_t)row * D) + lane; u32x2* o = (u32x2*)(H2 + (size_t)row * D) + lane;
#pragma unroll
                    for (int j = 0; j < 4; ++j) { u32x2 w; w.x = cvt_pk_bf16(x[u][j][0], x[u][j][1]); w.y = cvt_pk_bf16(x[u][j][2], x[u][j][3]); xo[64 * j] = w; }
#pragma unroll
                    for (int j = 0; j < 4; ++j) { u32x2 w; w.x = cvt_pk_bf16(x[u][j][0] * rs2 * g2v[j][0], x[u][j][1] * rs2 * g2v[j][1]); w.y = cvt_pk_bf16(x[u][j][2] * rs2 * g2v[j][2], x[u][j][3] * rs2 * g2v[j][3]); o[64 * j] = w; }
                } else {
                    f32x4* orow = (f32x4*)(a.out + (size_t)row * D) + lane;
#pragma unroll
                    for (int j = 0; j < 4; ++j) orow[64 * j] = x[u][j];
                }
            }
        }
    }
}

#define XB_TMO      128
#define XB_XCNT(j)  (256  + 64 * (j))
#define XB_XSUB(j)  (1280 + 64 * (j))
#define XB_XGEN(j)  (2304 + 64 * (j))
#define XB_TOP      3328
#define XB_TOPGEN   3392
#define XCD_BAR_WORDS 3456
#define XB_SPIN_CAP (1u << 18)

__device__ __forceinline__ unsigned xb_ld(unsigned* p)              { return __hip_atomic_load(p, __ATOMIC_RELAXED, __HIP_MEMORY_SCOPE_AGENT); }
__device__ __forceinline__ unsigned xb_add(unsigned* p, unsigned v) { return __hip_atomic_fetch_add(p, v, __ATOMIC_RELAXED, __HIP_MEMORY_SCOPE_AGENT); }
__device__ __forceinline__ unsigned xb_xcc_id() { return (unsigned)__builtin_amdgcn_s_getreg((3 << 11) | 20) & 0xFu; }
#define XB_SPIN(cond, bar) do { unsigned _sp = 0; while (cond) { __builtin_amdgcn_s_sleep(1); \
    if ((++_sp & 255u) == 0u) { if (xb_ld(&(bar)[XB_TMO])) break; if (_sp > XB_SPIN_CAP) { atomicAdd(&(bar)[XB_TMO], 1u); break; } } } } while (0)

struct XcdBarrier {
    unsigned* bar; unsigned x;
    volatile __attribute__((address_space(3))) unsigned* st;
};

__device__ __forceinline__ XcdBarrier xcd_barrier_post(unsigned* bar, volatile __attribute__((address_space(3))) unsigned* st) {
    XcdBarrier b; b.bar = bar; b.x = xb_xcc_id(); b.st = st;
    if (threadIdx.x == 0) (void)xb_add(&bar[XB_XCNT(b.x)], 1u);
    return b;
}
__device__ __forceinline__ void xcd_barrier_complete(unsigned* bar, unsigned x, unsigned& nloc, unsigned& nx) {
    const unsigned G = gridDim.x * gridDim.y * gridDim.z;
    unsigned sum, cnt, mine, sp = 0u;
    for (;;) {
        sum = 0u; cnt = 0u; mine = 0u;
#pragma unroll
        for (unsigned j = 0; j < 16; ++j) { const unsigned c = xb_ld(&bar[XB_XCNT(j)]); sum += c; cnt += (c > 0u) ? 1u : 0u; mine = (j == x) ? c : mine; }
        if (sum == G) break;
        __builtin_amdgcn_s_sleep(1);
        if ((++sp & 255u) == 0u) { if (xb_ld(&bar[XB_TMO])) break; if (sp > XB_SPIN_CAP) { atomicAdd(&bar[XB_TMO], 1u); break; } }
    }
    nloc = mine > 0u ? mine : 1u; nx = cnt > 0u ? cnt : 1u;
}

__device__ __forceinline__ void xcd_barrier(const XcdBarrier& b) {
    asm volatile("s_waitcnt vmcnt(0)" ::: "memory");
    __syncthreads();
    if (threadIdx.x == 0) {
        unsigned* bar = b.bar;
        __builtin_amdgcn_s_waitcnt(0);
        unsigned nloc = b.st[0], nx = b.st[1];
        if (nloc == 0u) { xcd_barrier_complete(bar, b.x, nloc, nx); b.st[0] = nloc; b.st[1] = nx; }
        const unsigned old = xb_add(&bar[XB_XSUB(b.x)], 1u);
        const unsigned gen = old / nloc;
        if (old + 1u == (gen + 1u) * nloc) {
            __builtin_amdgcn_fence(__ATOMIC_RELEASE, "agent");
            asm volatile("s_waitcnt vmcnt(0)" ::: "memory");
            const unsigned og = xb_add(&bar[XB_TOP], 1u);
            const unsigned tg = og / nx;
            if (og + 1u == (tg + 1u) * nx) xb_add(&bar[XB_TOPGEN], 1u);
            else XB_SPIN(xb_ld(&bar[XB_TOPGEN]) == tg, bar);
            __builtin_amdgcn_fence(__ATOMIC_ACQUIRE, "agent");
            xb_add(&bar[XB_XGEN(b.x)], 1u);
            asm volatile("s_waitcnt vmcnt(0)" ::: "memory");
        } else {
            XB_SPIN(xb_ld(&bar[XB_XGEN(b.x)]) == gen, bar);
            __builtin_amdgcn_fence(__ATOMIC_ACQUIRE, "agent");
            asm volatile("s_waitcnt vmcnt(0)" ::: "memory");
        }
    }
    __syncthreads();
}

__global__ void __launch_bounds__(512, 2) mega(Args a) {
    extern __shared__ __attribute__((aligned(16))) unsigned char shm[];
    PG8_LAS unsigned char* lds = (PG8_LAS unsigned char*)shm;
    const int G = (int)gridDim.x;
    unsigned char* ws = a.ws;
    volatile __attribute__((address_space(3))) unsigned* bst = (volatile __attribute__((address_space(3))) unsigned*)(lds + pg8::STAGE_BYTES);
    if (threadIdx.x == 0) { bst[0] = 0u; bst[1] = 0u; }
    __syncthreads();
    const XcdBarrier bar = xcd_barrier_post((unsigned*)(ws + O_CTL), bst);
    cg::this_grid().sync();
    phase_prep(a, (float*)shm, G);
    xcd_barrier(bar);
    { Epi1 E; E.Q = (bf16_t*)(ws + O_Q); E.Kb = (bf16_t*)(ws + O_K); E.Vt = (bf16_t*)(ws + O_VT); E.Prw = (bf16_t*)(ws + O_PRW); E.Gt = (bf16_t*)a.out; E.bgate = a.in[3];
      run_gemm(lds, (const bf16_t*)(ws + O_H), (const bf16_t*)(ws + O_WIN), INC, 1024, E, G); }
    xcd_barrier(bar);
    phase_rwprep(a, shm, G);
    xcd_barrier(bar);
    phase_mixer(a, shm, G);
    xcd_barrier(bar);
    { EpiRow<1> E; E.O = (bf16_t*)(ws + O_T1); E.T1 = nullptr; E.Gt = (const bf16_t*)a.out;
      run_gemm(lds, (const bf16_t*)(ws + O_OSB), (const bf16_t*)(ws + O_WSB), 1024, 512, E, G); }
    { EpiRow<2> E; E.O = (bf16_t*)(ws + O_MRG); E.T1 = (const bf16_t*)(ws + O_T1); E.Gt = (const bf16_t*)a.out;
      run_gemm(lds, (const bf16_t*)(ws + O_ORW), (const bf16_t*)(ws + O_WRW), 1024, 512, E, G); }
    xcd_barrier(bar);
    { EpiRow<0> E; E.O = (bf16_t*)(ws + O_TT); E.T1 = nullptr; E.Gt = nullptr;
      run_gemm(lds, (const bf16_t*)(ws + O_MRG), (const bf16_t*)(ws + O_WO), 1024, 1024, E, G); }
    xcd_barrier(bar);
    phase_rows<0>(a, G);
    xcd_barrier(bar);
    { EpiSwiGLU E; E.Hd = (bf16_t*)(ws + O_HID);
      run_gemm(lds, (const bf16_t*)(ws + O_H2), (const bf16_t*)(ws + O_WGU), 2 * DFF, 1024, E, G); }
    xcd_barrier(bar);
    { EpiRow<0> E; E.O = (bf16_t*)(ws + O_FF); E.T1 = nullptr; E.Gt = nullptr;
      run_gemm(lds, (const bf16_t*)(ws + O_HID), (const bf16_t*)(ws + O_WDN), 1024, DFF, E, G); }
    xcd_barrier(bar);
    phase_rows<1>(a, G);
}
}

extern "C" void kernel_launch(void* const* d_in, const int* in_sizes, int n_in, void* d_out, int out_size, void* d_ws, size_t ws_size, hipStream_t stream) {
    static int grid = 0;
    if (grid == 0) {
        if (n_in != 24 || in_sizes[0] != mk::M * mk::D || out_size != mk::M * mk::D || ws_size < mk::WS_NEED) {
            fprintf(stderr, "kernel_launch: unexpected shapes: n_in %d in0 %d out %d ws %zu (need %zu)\n", n_in, n_in > 0 ? in_sizes[0] : -1, out_size, ws_size, (size_t)mk::WS_NEED); grid = -1; return; }
        int dev = 0, cus = 0, per_cu = 0;
        hipGetDevice(&dev); hipDeviceGetAttribute(&cus, hipDeviceAttributeMultiprocessorCount, dev);
        if (hipFuncSetAttribute((const void*)mk::mega, hipFuncAttributeMaxDynamicSharedMemorySize, mk::LDS_BYTES) != hipSuccess) { fprintf(stderr, "kernel_launch: hipFuncSetAttribute failed\n"); grid = -1; return; }
        if (hipOccupancyMaxActiveBlocksPerMultiprocessor(&per_cu, (const void*)mk::mega, 512, mk::LDS_BYTES) != hipSuccess || per_cu < 1) { fprintf(stderr, "kernel_launch: occupancy query failed (%d)\n", per_cu); per_cu = 1; }
        (void)hipGetLastError();
        grid = cus * per_cu;
        fprintf(stderr, "kernel_launch: grid %d (cus %d x %d)\n", grid, cus, per_cu);
    }
    if (grid < 0) return;
    mk::Args a{};
    for (int i = 0; i < 24; ++i) a.in[i] = (const float*)d_in[i];
    a.out = (float*)d_out; a.ws = (unsigned char*)d_ws;
    a.ph_lo = 0; a.ph_hi = mk::NPH;
    if (hipMemsetAsync((char*)d_ws + mk::O_CTL, 0, mk::CTL_BYTES, stream) != hipSuccess) { fprintf(stderr, "kernel_launch: hipMemsetAsync failed\n"); return; }
    void* args[] = {&a};
    hipError_t e = hipLaunchCooperativeKernel((const void*)mk::mega, dim3(grid), dim3(512), args, mk::LDS_BYTES, stream);
    if (e != hipSuccess) fprintf(stderr, "kernel_launch: cooperative launch failed: %s (grid %d)\n", hipGetErrorString(e), grid);
}
```

```cpp
#include <hip/hip_runtime.h>
#include <hip/hip_cooperative_groups.h>
#include <cstdio>
#include <cstdint>
namespace cg = cooperative_groups;
#ifndef MK_SPLIT
#define MK_SPLIT 0
#endif
#ifndef MK_DIAG
#define MK_DIAG 0
#endif
#ifndef MK_REPMASK
#define MK_REPMASK 0
#endif
#ifndef MK_EARLY_EXIT
#define MK_EARLY_EXIT 1
#endif
namespace pg8 {
#define PG8_LAS __attribute__((address_space(3)))
typedef unsigned short bf16_t;
typedef short bf16x8 __attribute__((ext_vector_type(8)));
typedef float f32x4 __attribute__((ext_vector_type(4)));
typedef unsigned u32x4 __attribute__((ext_vector_type(4)));
constexpr int BM = 256, BK = 64, HALF = 128, HTB = HALF * BK * 2  , STAGE_BYTES = 8 * HTB, NXCD = 8, WGM = 8;

__host__ __device__ __forceinline__ int lds_byte(int r, int c) { const int st = (r >> 4) * 2 + (c >> 5), rr = r & 15, cc = c & 31, ob = rr * 64 + cc * 2; return st * 1024 + (ob ^ (((ob >> 9) & 1) << 5)); }
__host__ __device__ __forceinline__ void stage_rc(int b, int& R, int& C) { const int st = b / 1024, sb = b % 1024, swz = sb ^ (((sb >> 9) & 1) << 5); R = (st >> 1) * 16 + swz / 64; C = (st & 1) * 32 + (swz % 64) / 2; }
__host__ __device__ __forceinline__ int perm32(int rho) { const int n = rho >> 4, i = rho & 15; return 8 * (i >> 2) + 4 * n + (i & 3); }

struct Unit { int pm, pn; };
struct Gemm { const bf16_t* A; const bf16_t* Bt; int M, N, K; };

struct StaticOrder {
    int nM, nN, nwg, G, c;
    __host__ __device__ void init(int M, int N, int G_, int c_) { nM = M / BM; nN = N / BM; nwg = nM * nN; G = G_; c = c_; }
    __host__ __device__ bool next(int i, Unit& u) const {
        const long L = (long)i * G + c; if (L >= nwg) return false;
        int wgid = (int)L; { const int q = nwg / NXCD, r = nwg % NXCD, xcd = wgid % NXCD, off = wgid / NXCD; wgid = (xcd < r ? xcd * (q + 1) : r * (q + 1) + (xcd - r) * q) + off; }
        const int nig = WGM * nN, gid = wgid / nig, fm = gid * WGM, gsz = (nM - fm) < WGM ? (nM - fm) : WGM;
        u.pm = fm + ((wgid % nig) % gsz); u.pn = (wgid % nig) / gsz; return true;
    }
    __device__ __forceinline__ void a_ready(const Unit&) const {}
    __device__ __forceinline__ void done(const Unit&) const {}
};

typedef float cvt_f32x2 __attribute__((ext_vector_type(2)));
typedef __bf16 cvt_bf16x2 __attribute__((ext_vector_type(2)));
__device__ __forceinline__ unsigned cvt_pk_bf16(float lo, float hi) { const cvt_f32x2 v = {lo, hi}; return __builtin_bit_cast(unsigned, __builtin_convertvector(v, cvt_bf16x2)); }
typedef float f32x2 __attribute__((ext_vector_type(2)));

template <class Epi, class Sched, bool ALIGN_EPI = false, bool SP2 = false>
__device__ __forceinline__ void gemm_phase(PG8_LAS unsigned char* lds, const Gemm g, const Sched& S, const Epi& E) {
    int tid_ = threadIdx.x; asm volatile("" : "+v"(tid_)); const int tid = tid_, wid = __builtin_amdgcn_readfirstlane(tid >> 6), lane = tid & 63, wr = wid >> 2, wc = wid & 3, fr = lane & 15, fq = lane >> 4;
    const int K = g.K, nt = K / BK;
    unsigned voffA[2], voffB[2];
#pragma unroll
    for (int i = 0; i < 2; ++i) { int R, C; stage_rc(tid * 16 + i * 8192, R, C); const int Rb = Epi::PERM ? ((R & ~31) + perm32(R & 31)) : R;
        voffA[i] = (unsigned)(R * K + C) * 2u; voffB[i] = (unsigned)(Rb * K + C) * 2u; }
    const size_t kstep = (size_t)(BK * 2);
    const size_t hstep = (size_t)HALF * K * 2;
    const size_t tstep = 2 * hstep;
    const unsigned ldsw = (unsigned)wid * 1024u;
    const int aoff = lds_byte(wr * 64 + fr, fq * 8), boff = lds_byte(wc * 32 + fr, fq * 8);
#define PG8_SA(b, h) (((b) * 2 + (h)) * HTB)
#define PG8_SB(b, h) ((4 + (b) * 2 + (h)) * HTB)
#define PG8_STAGE(bufoff, gbase, voff) do { _Pragma("unroll") for (int _i = 0; _i < 2; ++_i) \
        __builtin_amdgcn_global_load_lds((const unsigned*)((const char*)(gbase) + (voff)[_i]), (PG8_LAS unsigned*)(lds + (bufoff) + ldsw + _i * 8192), 16, 0, 0); } while (0)
#define PG8_LDA(dst, b, h) do { _Pragma("unroll") for (int m = 0; m < 4; ++m) _Pragma("unroll") for (int k = 0; k < 2; ++k) dst[m][k] = *(const PG8_LAS bf16x8*)(lds + PG8_SA(b, h) + aoff + m * 2048 + k * 1024); } while (0)
#define PG8_LDB(dst, b, h) do { _Pragma("unroll") for (int n = 0; n < 2; ++n) _Pragma("unroll") for (int k = 0; k < 2; ++k) dst[n][k] = *(const PG8_LAS bf16x8*)(lds + PG8_SB(b, h) + boff + n * 2048 + k * 1024); } while (0)
#define PG8_MMA(ai, bj, At, Bt) do { __builtin_amdgcn_s_setprio(1); _Pragma("unroll") for (int m = 0; m < 4; ++m) _Pragma("unroll") for (int n = 0; n < 2; ++n) _Pragma("unroll") for (int k = 0; k < 2; ++k) \
        acc[ai][bj][m][n] = __builtin_amdgcn_mfma_f32_16x16x32_bf16(Bt[n][k], At[m][k], acc[ai][bj][m][n], 0, 0, 0); __builtin_amdgcn_s_setprio(0); } while (0)
#define PG8_WAIT_V(n) asm volatile("s_waitcnt vmcnt(" #n ")" ::: "memory")
#define PG8_WAIT_L(n) asm volatile("s_waitcnt lgkmcnt(" #n ")" ::: "memory")
#define PG8_BAR __builtin_amdgcn_s_barrier()
#define PG8_SCHED __builtin_amdgcn_sched_barrier(0)
    Unit cur, nxt; int ui = 0;
    if (!S.next(0, cur)) return;
    f32x4 acc[2][2][4][2];
#pragma unroll
    for (int a = 0; a < 2; ++a)
#pragma unroll
        for (int b = 0; b < 2; ++b)
#pragma unroll
            for (int m = 0; m < 4; ++m)
#pragma unroll
                for (int n = 0; n < 2; ++n) acc[a][b][m][n] = (f32x4){0.f, 0.f, 0.f, 0.f};
    bf16x8 At[4][2], B0[2][2], B1[2][2];
    const char* cA = (const char*)g.A + (size_t)cur.pm * tstep; const char* cB = (const char*)g.Bt + (size_t)cur.pn * tstep;
    S.a_ready(cur);
    if constexpr (SP2) {
        PG8_STAGE(PG8_SB(0, 0), cB, voffB); PG8_STAGE(PG8_SB(0, 1), cB + hstep, voffB); PG8_STAGE(PG8_SA(0, 0), cA, voffA); PG8_STAGE(PG8_SA(0, 1), cA + hstep, voffA);
        if (wr == 1) PG8_BAR;
        PG8_WAIT_V(2); PG8_BAR;
        PG8_STAGE(PG8_SB(1, 0), cB + kstep, voffB); PG8_STAGE(PG8_SA(1, 0), cA + kstep, voffA); PG8_STAGE(PG8_SB(1, 1), cB + hstep + kstep, voffB);
        PG8_WAIT_V(6); PG8_BAR;
    } else {
        PG8_STAGE(PG8_SB(0, 0), cB, voffB); PG8_STAGE(PG8_SA(0, 0), cA, voffA); PG8_STAGE(PG8_SB(0, 1), cB + hstep, voffB); PG8_STAGE(PG8_SA(0, 1), cA + hstep, voffA);
        if (wr == 1) PG8_BAR;
        PG8_WAIT_V(4); PG8_BAR;
        PG8_STAGE(PG8_SB(1, 0), cB + kstep, voffB); PG8_STAGE(PG8_SA(1, 0), cA + kstep, voffA); PG8_STAGE(PG8_SB(1, 1), cB + hstep + kstep, voffB);
        PG8_WAIT_V(6); PG8_BAR;
    }
    for (;;) {
        const bool has_next = S.next(ui + 1, nxt);
        const char* nA = has_next ? (const char*)g.A + (size_t)nxt.pm * tstep : cA; const char* nB = has_next ? (const char*)g.Bt + (size_t)nxt.pn * tstep : cB;
        for (int t = 0; t < nt; t += 2) {
            const bool last = (t == nt - 2);
            const char* a1 = cA + (size_t)(t + 1) * kstep;
            const char* a2 = last ? nA : cA + (size_t)(t + 2) * kstep; const char* b2 = last ? nB : cB + (size_t)(t + 2) * kstep;
            const char* a3 = a2 + kstep; const char* b3 = b2 + kstep;
            if (last && has_next) S.a_ready(nxt);
            if constexpr (SP2) {
            PG8_LDB(B0, 0, 0); PG8_LDB(B1, 0, 1); PG8_SCHED; PG8_LDA(At, 0, 0); PG8_STAGE(PG8_SA(1, 1), a1 + hstep, voffA);
            PG8_WAIT_V(8); PG8_WAIT_L(0); PG8_BAR; PG8_MMA(0, 0, At, B0); PG8_MMA(0, 1, At, B1); PG8_BAR; PG8_SCHED;
            PG8_LDA(At, 0, 1); PG8_STAGE(PG8_SB(0, 0), b2, voffB); PG8_STAGE(PG8_SB(0, 1), b2 + hstep, voffB); PG8_STAGE(PG8_SA(0, 0), a2, voffA);
            PG8_WAIT_V(8); PG8_WAIT_L(0); PG8_BAR; PG8_MMA(1, 0, At, B0); PG8_MMA(1, 1, At, B1); PG8_BAR; PG8_SCHED;
            PG8_LDB(B0, 1, 0); PG8_LDB(B1, 1, 1); PG8_SCHED; PG8_LDA(At, 1, 0); PG8_STAGE(PG8_SA(0, 1), a2 + hstep, voffA);
            PG8_WAIT_V(8); PG8_WAIT_L(0); PG8_BAR; PG8_MMA(0, 0, At, B0); PG8_MMA(0, 1, At, B1); PG8_BAR; PG8_SCHED;
            PG8_LDA(At, 1, 1); PG8_STAGE(PG8_SB(1, 0), b3, voffB); PG8_STAGE(PG8_SB(1, 1), b3 + hstep, voffB); PG8_STAGE(PG8_SA(1, 0), a3, voffA);
            PG8_WAIT_V(8); PG8_WAIT_L(0); PG8_BAR; PG8_MMA(1, 0, At, B0); PG8_MMA(1, 1, At, B1); PG8_BAR; PG8_SCHED;
            } else {
            PG8_LDB(B0, 0, 0); PG8_SCHED; PG8_LDA(At, 0, 0); PG8_STAGE(PG8_SA(1, 1), a1 + hstep, voffA);
            PG8_WAIT_L(8); PG8_BAR; PG8_WAIT_L(0); PG8_MMA(0, 0, At, B0); PG8_BAR; PG8_SCHED;
            PG8_LDB(B1, 0, 1); PG8_STAGE(PG8_SB(0, 0), b2, voffB);
            PG8_BAR; PG8_WAIT_L(0); PG8_MMA(0, 1, At, B1); PG8_BAR;
            PG8_LDA(At, 0, 1); PG8_STAGE(PG8_SA(0, 0), a2, voffA);
            PG8_BAR; PG8_WAIT_L(0); PG8_MMA(1, 0, At, B0); PG8_BAR; PG8_SCHED;
            PG8_STAGE(PG8_SB(0, 1), b2 + hstep, voffB);
            PG8_WAIT_V(6); PG8_BAR; PG8_MMA(1, 1, At, B1); PG8_BAR;
            PG8_LDB(B0, 1, 0); PG8_SCHED; PG8_LDA(At, 1, 0); PG8_STAGE(PG8_SA(0, 1), a2 + hstep, voffA);
            PG8_WAIT_L(8); PG8_BAR; PG8_WAIT_L(0); PG8_MMA(0, 0, At, B0); PG8_BAR; PG8_SCHED;
            PG8_LDB(B1, 1, 1); PG8_STAGE(PG8_SB(1, 0), b3, voffB);
            PG8_BAR; PG8_WAIT_L(0); PG8_MMA(0, 1, At, B1); PG8_BAR;
            PG8_LDA(At, 1, 1); PG8_STAGE(PG8_SA(1, 0), a3, voffA);
            PG8_BAR; PG8_WAIT_L(0); PG8_MMA(1, 0, At, B0); PG8_BAR; PG8_SCHED;
            PG8_STAGE(PG8_SB(1, 1), b3 + hstep, voffB);
            PG8_WAIT_V(6); PG8_BAR; PG8_MMA(1, 1, At, B1); PG8_BAR;
            }
        }
        if constexpr (ALIGN_EPI) { if (wr == 0) PG8_BAR; }
        if constexpr (!Epi::AFTER_DRAIN) { E(acc, cur, wr, wc, fr, fq); S.done(cur); }
        if (!has_next) break;
#pragma unroll
        for (int a = 0; a < 2; ++a)
#pragma unroll
            for (int b = 0; b < 2; ++b)
#pragma unroll
                for (int m = 0; m < 4; ++m)
#pragma unroll
                    for (int n = 0; n < 2; ++n) acc[a][b][m][n] = (f32x4){0.f, 0.f, 0.f, 0.f};
        cur = nxt; cA = nA; cB = nB; ++ui;
        if constexpr (ALIGN_EPI) { if (wr == 1) PG8_BAR; }
    }
    PG8_WAIT_V(0);
    if constexpr (!ALIGN_EPI) { if (wr == 0) PG8_BAR; }
    PG8_BAR;
    if constexpr (Epi::AFTER_DRAIN) { E.fused(acc, cur, wr, wc, fr, fq, lds, wid, lane); S.done(cur); }
#undef PG8_SA
#undef PG8_SB
#undef PG8_STAGE
#undef PG8_LDA
#undef PG8_LDB
#undef PG8_MMA
#undef PG8_WAIT_V
#undef PG8_WAIT_L
#undef PG8_BAR
#undef PG8_SCHED
}

}
namespace mk {
using pg8::bf16_t; using pg8::bf16x8; using pg8::f32x4; using pg8::u32x4; using pg8::cvt_pk_bf16;
typedef float f32x16 __attribute__((ext_vector_type(16)));
typedef float f32x2 __attribute__((ext_vector_type(2)));
typedef unsigned u32x2 __attribute__((ext_vector_type(2)));
constexpr int D = 1024, NB = 32, SEQ = 2048, M = NB * SEQ, NH = 8, DH = 64;
constexpr int RWC = 1792, GC = 2048, INC = 5376, DFF = 2816;
constexpr float RMS_EPS = 1e-6f, GN_EPS = 64e-5f;
constexpr size_t MiB = (size_t)1 << 20;
constexpr size_t O_WIN = 0, O_WSB = 11 * MiB, O_WRW = 12 * MiB, O_WO = 13 * MiB, O_WGU = 15 * MiB, O_WDN = 26 * MiB, O_WLU = 32 * MiB  , O_WLA = O_WLU + 65536, O_WLG = O_WLA + 65536;
constexpr size_t O_Q = 34 * MiB, O_K = 98 * MiB, O_VT = 162 * MiB, O_PRW = 226 * MiB, O_H = 450 * MiB, O_SI = 450 * MiB, O_G = 834 * MiB, O_SC = 898 * MiB, O_YR = 290 * MiB  ;
constexpr size_t O_OSB = 226 * MiB, O_ORW = 34 * MiB, O_T1 = 98 * MiB, O_MRG = 450 * MiB, O_TT = 34 * MiB, O_H2 = 162 * MiB, O_HID = 290 * MiB, O_FF = 34 * MiB;
constexpr size_t O_RS2 = 906 * MiB;
constexpr size_t O_X1B = 706 * MiB;
constexpr size_t WS_NEED = 1009 * MiB;
constexpr int LDS_BYTES = pg8::STAGE_BYTES + 64;
constexpr size_t O_CTL = 1008 * MiB, CTL_BYTES = 65536;
constexpr int NPH = 12;

struct Args { const float* in[24]; float* out; unsigned char* ws; int ph_lo, ph_hi; };

__device__ __forceinline__ int my_tid() { int t = threadIdx.x; asm volatile("" : "+v"(t)); return t; }
__device__ __forceinline__ float bf_lo(unsigned u) { return __uint_as_float(u << 16); }
__device__ __forceinline__ float bf_hi(unsigned u) { return __uint_as_float(u & 0xffff0000u); }
__device__ __forceinline__ float fexp(float x) { return __builtin_amdgcn_exp2f(x * 1.44269504089f); }
__device__ __forceinline__ float flog(float x) { return __builtin_amdgcn_logf(x) * 0.69314718056f; }
__device__ __forceinline__ float frcp(float x) { return __builtin_amdgcn_rcpf(x); }
__device__ __forceinline__ float fsigmoid(float x) { return frcp(1.f + fexp(-x)); }
__device__ __forceinline__ unsigned short bf1(float x) { return (unsigned short)(cvt_pk_bf16(x, x) & 0xffffu); }
__device__ __forceinline__ u32x4 pack8(const f32x4 a, const f32x4 b) { u32x4 o; o.x = cvt_pk_bf16(a[0], a[1]); o.y = cvt_pk_bf16(a[2], a[3]); o.z = cvt_pk_bf16(b[0], b[1]); o.w = cvt_pk_bf16(b[2], b[3]); return o; }
__device__ __forceinline__ float red16(float v) {
    v += __shfl_xor(v, 16); v += __shfl_xor(v, 32); return v;
}
__device__ __forceinline__ float wave_sum(float v) {
#pragma unroll
    for (int o = 1; o < 64; o <<= 1) v += __shfl_xor(v, o);
    return v;
}

__device__ __forceinline__ void tr_item(const float* __restrict__ W, int K, int N, bf16_t* WT, float* scr, int item, int lane, int mode, const float* kscale = nullptr) {
    const int nblk = N >> 5, kb = item / nblk, nb = item - kb * nblk, k0 = kb << 6, n0 = nb << 5;
#pragma unroll 8
    for (int i = 0; i < 32; ++i) { const int kk = 2 * i + (lane >> 5); float wv = W[(size_t)(k0 + kk) * N + n0 + (lane & 31)]; if (kscale) wv *= kscale[k0 + kk]; scr[kk * 33 + (lane & 31)] = wv; }
    asm volatile("s_waitcnt lgkmcnt(0)" ::: "memory"); __builtin_amdgcn_wave_barrier();
    const int c = lane & 7;
#pragma unroll
    for (int j = 0; j < 4; ++j) {
        const int n = (lane >> 3) + 8 * j; const float* s = scr + (8 * c) * 33 + n;
        u32x4 o; o.x = cvt_pk_bf16(s[0 * 33], s[1 * 33]); o.y = cvt_pk_bf16(s[2 * 33], s[3 * 33]); o.z = cvt_pk_bf16(s[4 * 33], s[5 * 33]); o.w = cvt_pk_bf16(s[6 * 33], s[7 * 33]);
        const int nn = n0 + n; int drow = nn;
        if (mode == 1) drow = ((nn >> 7) << 8) + (nn & 127); else if (mode == 2) drow = ((nn >> 7) << 8) + 128 + (nn & 127);
        *(u32x4*)(WT + (size_t)drow * K + k0 + 8 * c) = o;
    }
    asm volatile("s_waitcnt lgkmcnt(0)" ::: "memory"); __builtin_amdgcn_wave_barrier();
}

__device__ __forceinline__ void phase_prep(const Args& a, float* lds_f, int G) {
    const int tid = my_tid(); const int wave = tid >> 6, lane = tid & 63;
    const int gw = blockIdx.x * 8 + wave, NGW = G * 8;
    float* scr = lds_f + wave * (64 * 33 + 16);
    unsigned char* ws = a.ws;
    constexpr int I_IN = 16 * 168, I_SB = 8 * 32, I_O = 16 * 32, I_G = 16 * 88, I_DN = 44 * 32, I_LU = 16, I_LG = 32;
    constexpr int NIT = I_IN + 2 * I_SB + I_O + 2 * I_G + I_DN + 2 * I_LU + I_LG;
    for (int it = gw; it < NIT; it += NGW) {
        int r = it;
        if (r < I_IN) { tr_item(a.in[2], 1024, INC, (bf16_t*)(ws + O_WIN), scr, r, lane, 0); continue; } r -= I_IN;
        if (r < I_SB) { tr_item(a.in[15], 512, 1024, (bf16_t*)(ws + O_WSB), scr, r, lane, 0); continue; } r -= I_SB;
        if (r < I_SB) { tr_item(a.in[16], 512, 1024, (bf16_t*)(ws + O_WRW), scr, r, lane, 0); continue; } r -= I_SB;
        if (r < I_O) { tr_item(a.in[17], 1024, 1024, (bf16_t*)(ws + O_WO), scr, r, lane, 0); continue; } r -= I_O;
        if (r < I_G) { tr_item(a.in[20], 1024, DFF, (bf16_t*)(ws + O_WGU), scr, r, lane, 1, a.in[19]); continue; } r -= I_G;
        if (r < I_G) { tr_item(a.in[21], 1024, DFF, (bf16_t*)(ws + O_WGU), scr, r, lane, 2, a.in[19]); continue; } r -= I_G;
        if (r < I_DN) { tr_item(a.in[22], DFF, 1024, (bf16_t*)(ws + O_WDN), scr, r, lane, 0); continue; } r -= I_DN;
        if (r < I_LU) { tr_item(a.in[6], 64, 512, (bf16_t*)(ws + O_WLU), scr, r, lane, 0); continue; } r -= I_LU;
        if (r < I_LU) { tr_item(a.in[8], 64, 512, (bf16_t*)(ws + O_WLA), scr, r, lane, 0); continue; } r -= I_LU;
        tr_item(a.in[9], 128, 512, (bf16_t*)(ws + O_WLG), scr, r, lane, 0);
    }
    const float* x = a.in[0]; const float* g = a.in[1]; bf16_t* H = (bf16_t*)(ws + O_H);
    f32x4 gv[4];
#pragma unroll
    for (int j = 0; j < 4; ++j) gv[j] = ((const f32x4*)g)[lane + 64 * j];
    for (int row0 = gw; row0 < M; row0 += 2 * NGW) {
        f32x4 v[2][4];
#pragma unroll
        for (int u = 0; u < 2; ++u) { const int row = (row0 + u * NGW < M) ? row0 + u * NGW : row0; const f32x4* xr = (const f32x4*)(x + (size_t)row * D) + lane;
#pragma unroll
            for (int j = 0; j < 4; ++j) v[u][j] = xr[64 * j]; }
#pragma unroll
        for (int u = 0; u < 2; ++u) { const int row = row0 + u * NGW; float s = 0.f;
#pragma unroll
            for (int j = 0; j < 4; ++j) s += (v[u][j][0] * v[u][j][0] + v[u][j][1] * v[u][j][1]) + (v[u][j][2] * v[u][j][2] + v[u][j][3] * v[u][j][3]);
            const float rs = rsqrtf(wave_sum(s) * (1.f / D) + RMS_EPS);
            if (row < M) { u32x2* o = (u32x2*)(H + (size_t)row * D) + lane;
#pragma unroll
                for (int j = 0; j < 4; ++j) { u32x2 w; w.x = cvt_pk_bf16(v[u][j][0] * rs * gv[j][0], v[u][j][1] * rs * gv[j][1]); w.y = cvt_pk_bf16(v[u][j][2] * rs * gv[j][2], v[u][j][3] * rs * gv[j][3]); o[64 * j] = w; } }
        }
    }
}

struct Epi1 {
    static constexpr bool PERM = true, AFTER_DRAIN = false;
    bf16_t *Q, *Kb, *Vt, *Prw, *Gt; const float* bgate;
    __device__ __forceinline__ void operator()(const f32x4 (&acc)[2][2][4][2], const pg8::Unit& u, int wr, int wc, int fr, int fq) const {
        const int row0 = u.pm * 256 + wr * 64 + fr, pn = u.pn, cl = wc * 32 + 8 * fq;
        if (pn < 4) {
            bf16_t* dst = pn < 2 ? Q : Kb; const float sc = pn < 2 ? 0.125f : 1.f; const int cb = (pn & 1) * 256 + cl;
#pragma unroll
            for (int ai = 0; ai < 2; ++ai)
#pragma unroll
                for (int m = 0; m < 4; ++m) { bf16_t* rp = dst + (size_t)(row0 + ai * 128 + m * 16) * 512 + cb;
#pragma unroll
                    for (int bj = 0; bj < 2; ++bj) *(u32x4*)(rp + bj * 128) = pack8(acc[ai][bj][m][0] * sc, acc[ai][bj][m][1] * sc); }
        } else if (pn < 6) {
#pragma unroll
            for (int ai = 0; ai < 2; ++ai)
#pragma unroll
                for (int m = 0; m < 4; ++m) { const int row = row0 + ai * 128 + m * 16, b = row >> 11, s = row & 2047;
#pragma unroll
                    for (int bj = 0; bj < 2; ++bj)
#pragma unroll
                        for (int n = 0; n < 2; ++n)
#pragma unroll
                            for (int j = 0; j < 4; ++j) { const int c = (pn - 4) * 256 + bj * 128 + cl + 4 * n + j;
                                Vt[((size_t)(b * 512 + c)) * 2048 + s] = bf1(acc[ai][bj][m][n][j]); } }
        } else if (pn < 13) {
            const int cb = (pn - 6) * 256 + cl;
#pragma unroll
            for (int ai = 0; ai < 2; ++ai)
#pragma unroll
                for (int m = 0; m < 4; ++m) { bf16_t* rp = Prw + (size_t)(row0 + ai * 128 + m * 16) * RWC + cb;
#pragma unroll
                    for (int bj = 0; bj < 2; ++bj) *(u32x4*)(rp + bj * 128) = pack8(acc[ai][bj][m][0], acc[ai][bj][m][1]); }
        } else {
            const int cb = (pn - 13) * 256 + cl;
#pragma unroll
            for (int ai = 0; ai < 2; ++ai)
#pragma unroll
                for (int m = 0; m < 4; ++m) { bf16_t* rp = Gt + (size_t)(row0 + ai * 128 + m * 16) * GC + cb;
#pragma unroll
                    for (int bj = 0; bj < 2; ++bj) { f32x4 v0 = acc[ai][bj][m][0] + *(const f32x4*)(bgate + cb + bj * 128), v1 = acc[ai][bj][m][1] + *(const f32x4*)(bgate + cb + bj * 128 + 4);
#pragma unroll
                        for (int j = 0; j < 4; ++j) { v0[j] = fsigmoid(v0[j]); v1[j] = fsigmoid(v1[j]); }
                        *(u32x4*)(rp + bj * 128) = pack8(v0, v1); } }
        }
    }
};
template <int MODE> struct EpiRow {
    static constexpr bool PERM = true, AFTER_DRAIN = false;
    bf16_t* O; const bf16_t* T1; const bf16_t* Gt;
    __device__ __forceinline__ void operator()(const f32x4 (&acc)[2][2][4][2], const pg8::Unit& u, int wr, int wc, int fr, int fq) const {
        const int row0 = u.pm * 256 + wr * 64 + fr, cb = u.pn * 256 + wc * 32 + 8 * fq;
#pragma unroll
        for (int ai = 0; ai < 2; ++ai)
#pragma unroll
            for (int m = 0; m < 4; ++m) { const size_t row = (size_t)(row0 + ai * 128 + m * 16);
#pragma unroll
                for (int bj = 0; bj < 2; ++bj) { f32x4 v0 = acc[ai][bj][m][0], v1 = acc[ai][bj][m][1]; const int c = cb + bj * 128;
                    if (MODE >= 1) { const u32x4 gg = *(const u32x4*)(Gt + row * GC + (MODE == 2 ? 1024 : 0) + c);
                        v0[0] *= bf_lo(gg.x); v0[1] *= bf_hi(gg.x); v0[2] *= bf_lo(gg.y); v0[3] *= bf_hi(gg.y); v1[0] *= bf_lo(gg.z); v1[1] *= bf_hi(gg.z); v1[2] *= bf_lo(gg.w); v1[3] *= bf_hi(gg.w); }
                    if (MODE == 2) { const u32x4 tt = *(const u32x4*)(T1 + row * 1024 + c);
                        v0[0] += bf_lo(tt.x); v0[1] += bf_hi(tt.x); v0[2] += bf_lo(tt.y); v0[3] += bf_hi(tt.y); v1[0] += bf_lo(tt.z); v1[1] += bf_hi(tt.z); v1[2] += bf_lo(tt.w); v1[3] += bf_hi(tt.w); }
                    *(u32x4*)(O + row * 1024 + c) = pack8(v0, v1); } }
    }
};
struct EpiSwiGLU {
    static constexpr bool PERM = true, AFTER_DRAIN = false;
    bf16_t* Hd; const float* rs2;
    __device__ __forceinline__ void operator()(const f32x4 (&acc)[2][2][4][2], const pg8::Unit& u, int wr, int wc, int fr, int fq) const {
        const int row0 = u.pm * 256 + wr * 64 + fr, cb = u.pn * 128 + wc * 32 + 8 * fq;
#pragma unroll
        for (int ai = 0; ai < 2; ++ai)
#pragma unroll
            for (int m = 0; m < 4; ++m) { f32x4 v0, v1; const float rs = rs2[row0 + ai * 128 + m * 16];
#pragma unroll
                for (int j = 0; j < 4; ++j) { const float g0 = acc[ai][0][m][0][j] * rs, g1 = acc[ai][0][m][1][j] * rs;
                    v0[j] = g0 * fsigmoid(g0) * (acc[ai][1][m][0][j] * rs); v1[j] = g1 * fsigmoid(g1) * (acc[ai][1][m][1][j] * rs); }
                *(u32x4*)(Hd + (size_t)(row0 + ai * 128 + m * 16) * DFF + cb) = pack8(v0, v1); }
    }
};
template <class Epi> __device__ __forceinline__ void run_gemm(PG8_LAS unsigned char* lds, const bf16_t* A, const bf16_t* Bt, int N, int K, const Epi& E, int G) {
    pg8::Gemm g; g.A = A; g.Bt = Bt; g.M = M; g.N = N; g.K = K;
    pg8::StaticOrder S; S.init(M, N, G, (int)blockIdx.x);
    pg8::gemm_phase<Epi, pg8::StaticOrder, true, true>(lds, g, S, E);
}
__device__ __forceinline__ void mix8_lds(const unsigned char* cur, const unsigned char* prv, const float* mu, float (&o)[8]) {
    const u32x4 c = *(const u32x4*)cur, p = *(const u32x4*)prv;
    const f32x4 m0 = *(const f32x4*)mu, m1 = *(const f32x4*)(mu + 4);
    const float mm[8] = {m0[0], m0[1], m0[2], m0[3], m1[0], m1[1], m1[2], m1[3]};
#pragma unroll
    for (int i = 0; i < 4; ++i) { const float cl = bf_lo(c[i]), ch = bf_hi(c[i]), pl = bf_lo(p[i]), ph = bf_hi(p[i]);
        o[2 * i] = cl + (pl - cl) * mm[2 * i]; o[2 * i + 1] = ch + (ph - ch) * mm[2 * i + 1]; }
}
__device__ __forceinline__ void mix4_lds(const unsigned char* cur, const unsigned char* prv, const float* mu, float (&o)[4]) {
    const u32x2 c = *(const u32x2*)cur, p = *(const u32x2*)prv;
    const f32x4 m0 = *(const f32x4*)mu;
#pragma unroll
    for (int i = 0; i < 2; ++i) { const float cl = bf_lo(c[i]), ch = bf_hi(c[i]), pl = bf_lo(p[i]), ph = bf_hi(p[i]);
        o[2 * i] = cl + (pl - cl) * m0[2 * i]; o[2 * i + 1] = ch + (ph - ch) * m0[2 * i + 1]; }
}
__device__ __forceinline__ bf16x8 pack_frag(const float (&v)[8]) {
    u32x4 o; o.x = cvt_pk_bf16(v[0], v[1]); o.y = cvt_pk_bf16(v[2], v[3]); o.z = cvt_pk_bf16(v[4], v[5]); o.w = cvt_pk_bf16(v[6], v[7]);
    return __builtin_bit_cast(bf16x8, o);
}
__device__ __forceinline__ void phase_rwprep(const Args& a, unsigned char* lds, int G) {
    constexpr int ROWB = 3600, L_FRAG = 17 * ROWB, L_PAR = L_FRAG + 8192, NCH = 17 * 224, NT = M / 16;
    const int tid = my_tid(); const int wave = __builtin_amdgcn_readfirstlane(tid >> 6), lane = tid & 63, fr = lane & 15, fq = lane >> 4;
    unsigned char* ws = a.ws;
    const unsigned char* PRW = ws + O_PRW;
    const bf16_t* WLU = (const bf16_t*)(ws + O_WLU); const bf16_t* WLA = (const bf16_t*)(ws + O_WLA); const bf16_t* WLG = (const bf16_t*)(ws + O_WLG);
    unsigned char* SI = ws + O_SI; bf16_t* GB = (bf16_t*)(ws + O_G); float* SC = (float*)(ws + O_SC);
    float* par = (float*)(lds + L_PAR);
    for (int i = tid; i < 1792 + 5 * 512; i += 512) {
        float v;
        if (i < 1792) v = a.in[4][i]; else { const int j = i - 1792, w = j >> 9, c = j & 511; v = (w == 0 ? a.in[5] : w == 1 ? a.in[7] : w == 2 ? a.in[10] : w == 3 ? a.in[11] : a.in[12])[c]; }
        par[i] = v;
    }
    for (int tile = blockIdx.x; tile < NT; tile += G) {
        __syncthreads();
        {   u32x4 pre[8];
#pragma unroll
            for (int j = 0; j < 8; ++j) { const int c = tid + 512 * j; pre[j] = (u32x4){0u, 0u, 0u, 0u};
                if (c < NCH) { const int row = c / 224, col = c - row * 224; const bool zero = (row == 0) && (((tile * 16) & (SEQ - 1)) == 0);
                    if (!zero) pre[j] = *(const u32x4*)(PRW + ((size_t)tile * 16 + row - 1) * (RWC * 2) + col * 16); } }
#pragma unroll
            for (int j = 0; j < 8; ++j) { const int c = tid + 512 * j; if (c < NCH) { const int row = c / 224, col = c - row * 224; *(u32x4*)(lds + row * ROWB + col * 16) = pre[j]; } }
        }
        __syncthreads();
        const unsigned char* rcur = lds + (fr + 1) * ROWB; const unsigned char* rprv = lds + fr * ROWB;
        {
            const int colb = wave < 2 ? 1536 + 32 * wave : (wave < 4 ? 1600 + 32 * (wave - 2) : 1664 + 32 * (wave - 4));
            float t8[8]; mix8_lds(rcur + (colb + 8 * fq) * 2, rprv + (colb + 8 * fq) * 2, par + colb + 8 * fq, t8);
            if (wave < 2) {
#pragma unroll
                for (int i = 0; i < 8; ++i) { const float e = fexp(2.f * t8[i]); t8[i] = 1.f - 2.f * frcp(e + 1.f); } }
            else if (wave >= 4) {
#pragma unroll
                for (int i = 0; i < 8; ++i) t8[i] = fsigmoid(t8[i]); }
            *(bf16x8*)(lds + L_FRAG + wave * 1024 + lane * 16) = pack_frag(t8);
        }
        __syncthreads();
        bf16x8 Aw[2], Aa[2], Ag[4];
#pragma unroll
        for (int s = 0; s < 2; ++s) { Aw[s] = *(const bf16x8*)(lds + L_FRAG + s * 1024 + lane * 16); Aa[s] = *(const bf16x8*)(lds + L_FRAG + (2 + s) * 1024 + lane * 16); }
#pragma unroll
        for (int s = 0; s < 4; ++s) Ag[s] = *(const bf16x8*)(lds + L_FRAG + (4 + s) * 1024 + lane * 16);
        const int h = wave; const size_t m = (size_t)tile * 16 + fr;
        float kkr[16], av[16]; unsigned lk[16], rvp[16];
        float ss = 0.f, brs = 0.f, krs = 0.f, rkbs = 0.f;
#pragma unroll
        for (int n = 0; n < 4; ++n) {
            asm volatile("" ::: "memory");
            const int cb = 64 * h + 16 * n, c0 = cb + 4 * fq;
            f32x4 aw = {0.f, 0.f, 0.f, 0.f}, aa = aw, ag = aw;
#pragma unroll
            for (int s = 0; s < 2; ++s) {
                aw = __builtin_amdgcn_mfma_f32_16x16x32_bf16(*(const bf16x8*)(WLU + (size_t)(cb + fr) * 64 + 32 * s + 8 * fq), Aw[s], aw, 0, 0, 0);
                aa = __builtin_amdgcn_mfma_f32_16x16x32_bf16(*(const bf16x8*)(WLA + (size_t)(cb + fr) * 64 + 32 * s + 8 * fq), Aa[s], aa, 0, 0, 0); }
#pragma unroll
            for (int s = 0; s < 4; ++s)
                ag = __builtin_amdgcn_mfma_f32_16x16x32_bf16(*(const bf16x8*)(WLG + (size_t)(cb + fr) * 128 + 32 * s + 8 * fq), Ag[s], ag, 0, 0, 0);
            float rr[4], kr4[4], vv[4];
            mix4_lds(rcur + c0 * 2, rprv + c0 * 2, par + c0, rr); mix4_lds(rcur + (512 + c0) * 2, rprv + (512 + c0) * 2, par + 512 + c0, kr4); mix4_lds(rcur + (1024 + c0) * 2, rprv + (1024 + c0) * 2, par + 1024 + c0, vv);
            const f32x4 w0v = *(const f32x4*)(par + 1792 + c0), a0v = *(const f32x4*)(par + 2304 + c0), kkv = *(const f32x4*)(par + 2816 + c0), kav = *(const f32x4*)(par + 3328 + c0), rkv = *(const f32x4*)(par + 3840 + c0);
#pragma unroll
            for (int j = 0; j < 4; ++j) {
                const float sg = fsigmoid(w0v[j] + aw[j]);
                const float ldx = -0.60653065971f * 1.44269504089f * sg;
                const float av_ = fsigmoid(a0v[j] + aa[j]);
                const float kkraw = kr4[j] * kkv[j];
                const float k2 = kr4[j] * (1.f + (av_ - 1.f) * kav[j]);
                ss += kkraw * kkraw; brs += kkraw * av_ * rr[j]; krs += k2 * rr[j]; rkbs += rr[j] * k2 * rkv[j];
                kkr[4 * n + j] = kkraw; av[4 * n + j] = av_; lk[4 * n + j] = cvt_pk_bf16(ldx, k2); rvp[4 * n + j] = cvt_pk_bf16(rr[j], vv[j]);
            }
            u32x2 gp; gp.x = cvt_pk_bf16(ag[0], ag[1]); gp.y = cvt_pk_bf16(ag[2], ag[3]);
            *(u32x2*)(GB + m * 512 + c0) = gp;
        }
        ss = red16(ss); brs = red16(brs); krs = red16(krs); rkbs = red16(rkbs);
        const float inv = 1.f / fmaxf(sqrtf(ss), 1e-12f);
        unsigned char* rec = SI + (m * 8 + h) * 768 + fq * 16;
#pragma unroll
        for (int n = 0; n < 4; ++n) {
            unsigned dw[12];
#pragma unroll
            for (int j = 0; j < 4; ++j) { const float kk = kkr[4 * n + j] * inv;
                const unsigned kp = cvt_pk_bf16(kk * av[4 * n + j], -kk);
                dw[3 * j] = (lk[4 * n + j] & 0xffffu) | (kp & 0xffff0000u); dw[3 * j + 1] = (kp & 0xffffu) | (lk[4 * n + j] & 0xffff0000u); dw[3 * j + 2] = rvp[4 * n + j]; }
            unsigned char* dst = rec + 64 * n;
            u32x4 s0 = {dw[0], dw[3], dw[6], dw[9]}, s1 = {dw[1], dw[4], dw[7], dw[10]}, s2 = {dw[2], dw[5], dw[8], dw[11]};
            *(u32x4*)dst = s0; *(u32x4*)(dst + 256) = s1; *(u32x4*)(dst + 512) = s2;
        }
        if (fq == 0) { f32x4 scv = {brs * inv, krs, rkbs, 0.f}; *(f32x4*)(SC + (m * 8 + h) * 4) = scv; }
    }
    __syncthreads();
}

__device__ __forceinline__ float red_rows(float x) {
    float a0 = x, a1 = x;
    asm volatile("s_nop 1\n\tv_permlane16_swap_b32 %0, %1" : "+v"(a0), "+v"(a1));
    float b0 = a0 + a1, b1 = b0;
    asm volatile("s_nop 1\n\tv_permlane32_swap_b32 %0, %1" : "+v"(b0), "+v"(b1));
    return b0 + b1;
}
constexpr int SC_T = 16, SC_ROW = 1280, SC_GEND = SC_T * SC_ROW, SC_BUF = SC_GEND + 256;
struct ProdRec { unsigned d0[SC_T]; unsigned d1[4], d2[4]; };
__device__ __forceinline__ void prod_load(ProdRec& P, const unsigned char* sb, int chunk, int pw, int col) {
    const unsigned char* p = sb + (size_t)chunk * SC_T * 6144 + col * 4;
#pragma unroll
    for (int st = 0; st < SC_T; ++st) P.d0[st] = *(const unsigned*)(p + st * 6144);
#pragma unroll
    for (int q = 0; q < 4; ++q) { P.d1[q] = *(const unsigned*)(p + (4 * pw + q) * 6144 + 256); P.d2[q] = *(const unsigned*)(p + (4 * pw + q) * 6144 + 512); }
}
__device__ __forceinline__ void prod_store(const ProdRec& P, unsigned char* buf, int pw, int col) {
    float L = 0.f;
#pragma unroll
    for (int st = 0; st < SC_T; ++st) {
        const float Lp = L; L += bf_lo(P.d0[st]);
        if ((st >> 2) == pw) { const int q = st & 3; unsigned char* base = buf + st * SC_ROW + col * 4;
            const float gp = __builtin_amdgcn_exp2f(Lp), g = __builtin_amdgcn_exp2f(L), ig = __builtin_amdgcn_exp2f(-L);
            *(float*)(base) = gp * bf_hi(P.d0[st]); *(float*)(base + 256) = g * bf_lo(P.d2[q]);
            *(float*)(base + 512) = bf_lo(P.d1[q]) * ig; *(float*)(base + 768) = bf_hi(P.d1[q]) * ig; *(float*)(base + 1024) = bf_hi(P.d2[q]); }
    }
    if (pw == 0) *(float*)(buf + SC_GEND + col * 4) = __builtin_amdgcn_exp2f(L);
}
#define MK_SWAP32(a, b) asm volatile("s_nop 1\n\tv_permlane32_swap_b32 %0, %1" : "+v"(a), "+v"(b))
#define MK_SWAP16(a, b) asm volatile("s_nop 1\n\tv_permlane16_swap_b32 %0, %1" : "+v"(a), "+v"(b))
__device__ __forceinline__ void red4x8(float& A, float& B, float& C, float& D) {
    MK_SWAP32(A, B); float u = A + B;
    MK_SWAP32(C, D); float w = C + D;
    MK_SWAP16(u, w); float z = u + w;
    float z1;
    asm volatile("s_nop 1\n\tv_add_f32_dpp %0, %1, %1 row_ror:8 row_mask:0xf bank_mask:0xf" : "=&v"(z1) : "v"(z));
    float p = z1, q = z1; MK_SWAP32(p, q);
    float p2 = p; MK_SWAP16(p, p2);
    float q2 = q; MK_SWAP16(q, q2);
    A = p; C = p2; B = q; D = q2;
}
__device__ __forceinline__ void red2x8(float& A, float& B) {
    MK_SWAP32(A, B); float u = A + B;
    float uc = u; MK_SWAP16(u, uc); float z = u + uc;
    float z1;
    asm volatile("s_nop 1\n\tv_add_f32_dpp %0, %1, %1 row_ror:8 row_mask:0xf bank_mask:0xf" : "=&v"(z1) : "v"(z));
    float p = z1, q = z1; MK_SWAP32(p, q);
    A = p; B = q;
}
__device__ __forceinline__ void scan_consume(f32x2 (&S)[8], const unsigned char* buf, unsigned char* ybuf, int lane, int rb) {
    const unsigned co = (unsigned)(lane >> 3) * 32u, vo = 1024u + (unsigned)(16 * rb + (lane & 7)) * 4u;
#pragma unroll 4
    for (int st = 0; st < SC_T; ++st) {
        const unsigned char* sb = buf + st * SC_ROW;
        f32x4 n4[2], r4[2], a4[2], k4[2];
#pragma unroll
        for (int q = 0; q < 2; ++q) { n4[q] = *(const f32x4*)(sb + co + 16 * q); r4[q] = *(const f32x4*)(sb + 256 + co + 16 * q);
            a4[q] = *(const f32x4*)(sb + 512 + co + 16 * q); k4[q] = *(const f32x4*)(sb + 768 + co + 16 * q); }
        const float v0 = *(const float*)(sb + vo), v1 = *(const float*)(sb + vo + 32);
        f32x2 sa0v = {0.f, 0.f}, sa1v = sa0v, yp0v = sa0v, yp1v = sa0v;
#pragma unroll
        for (int p = 0; p < 4; ++p) { const f32x2 nn = {n4[p >> 1][2 * (p & 1)], n4[p >> 1][2 * (p & 1) + 1]}, rr2 = {r4[p >> 1][2 * (p & 1)], r4[p >> 1][2 * (p & 1) + 1]};
            sa0v += S[p] * nn; sa1v += S[4 + p] * nn; yp0v += S[p] * rr2; yp1v += S[4 + p] * rr2; }
        float sa0 = sa0v[0] + sa0v[1], sa1 = sa1v[0] + sa1v[1];
        const f32x2 ypp = {yp0v[0] + yp0v[1], yp1v[0] + yp1v[1]};
        red2x8(sa0, sa1);
        const f32x2 s0 = {sa0, sa0}, s1 = {sa1, sa1}, vv0 = {v0, v0}, vv1 = {v1, v1};
#pragma unroll
        for (int p = 0; p < 4; ++p) { const f32x2 aa = {a4[p >> 1][2 * (p & 1)], a4[p >> 1][2 * (p & 1) + 1]}; S[p] = __builtin_elementwise_fma(aa, s0, S[p]); S[4 + p] = __builtin_elementwise_fma(aa, s1, S[4 + p]); }
        asm volatile("" ::: "memory");
#pragma unroll
        for (int p = 0; p < 4; ++p) { const f32x2 kk = {k4[p >> 1][2 * (p & 1)], k4[p >> 1][2 * (p & 1) + 1]}; S[p] = __builtin_elementwise_fma(kk, vv0, S[p]); S[4 + p] = __builtin_elementwise_fma(kk, vv1, S[4 + p]); }
        *(f32x2*)(ybuf + st * 2048 + rb * 512 + lane * 8) = ypp;
        if (lane < 8) { f32x2 o = {sa0, sa1}; *(f32x2*)(ybuf + SC_T * 2048 + st * 256 + rb * 64 + lane * 8) = o; }
    }
#pragma unroll
    for (int p = 0; p < 4; ++p) { const f32x4 g4 = *(const f32x4*)(buf + SC_GEND + co + 16 * (p >> 1)); const f32x2 gg = {g4[2 * (p & 1)], g4[2 * (p & 1) + 1]}; S[p] = S[p] * gg; S[4 + p] = S[4 + p] * gg; }
}
struct FinIn { unsigned v[4]; f32x2 bk[4]; };
__device__ __forceinline__ void fin_load(FinIn& F, const unsigned char* sb, const float* scp, int chunk, int pw, int lane) {
#pragma unroll
    for (int q = 0; q < 4; ++q) { const size_t t = (size_t)chunk * SC_T + (lane >> 4) + 4 * q;
        F.v[q] = *(const unsigned short*)(sb + t * 6144 + 512 + (16 * pw + (lane & 15)) * 4 + 2); F.bk[q] = *(const f32x2*)(scp + t * 32); }
}
__device__ __forceinline__ void prod_finish(const FinIn& F, const unsigned char* ybuf, unsigned* yr, int pw, int lane) {
#pragma unroll
    for (int q = 0; q < 4; ++q) { const int st = (lane >> 4) + 4 * q, row16 = lane & 15, e = row16 >> 3, rr = row16 & 7;
        const unsigned char* yp8 = ybuf + st * 2048 + pw * 512 + rr * 8 + e * 4; float yp = 0.f;
#pragma unroll
        for (int cg = 0; cg < 8; ++cg) yp += *(const float*)(yp8 + cg * 64);
        const float sa = *(const float*)(ybuf + SC_T * 2048 + st * 256 + pw * 64 + rr * 8 + e * 4);
        const float v = __uint_as_float(F.v[q] << 16), y = yp + sa * F.bk[q][0] + v * F.bk[q][1];
        yr[(size_t)st * 512 + row16] = (unsigned)bf1(y) | (F.v[q] << 16); }
}

__device__ __forceinline__ void rwpost_local(const Args& a, int bh, int tid) {
    const float* SC = (const float*)(a.ws + O_SC);
    const unsigned* YR = (const unsigned*)(a.ws + O_YR); const bf16_t* GB = (const bf16_t*)(a.ws + O_G); bf16_t* ORW = (bf16_t*)(a.ws + O_ORW);
    const int b = bh >> 3, h = bh & 7, c = 64 * h + (tid & 15) * 4;
    const f32x4 lwv = *(const f32x4*)(a.in[13] + c), lbv = *(const f32x4*)(a.in[14] + c);
    for (int t0 = tid >> 4; t0 < SEQ; t0 += 64) {
        u32x4 yv[2]; u32x2 gb[2]; float rkb[2]; size_t mm[2];
#pragma unroll
        for (int u = 0; u < 2; ++u) { const size_t m = (size_t)b * SEQ + t0 + 32 * u; mm[u] = m;
            yv[u] = *(const u32x4*)(YR + m * 512 + c); gb[u] = *(const u32x2*)(GB + m * 512 + c); rkb[u] = SC[(m * 8 + h) * 4 + 2]; }
#pragma unroll
        for (int u = 0; u < 2; ++u) {
            float y[4] = {bf_lo(yv[u].x), bf_lo(yv[u].y), bf_lo(yv[u].z), bf_lo(yv[u].w)};
            const float v[4] = {bf_hi(yv[u].x), bf_hi(yv[u].y), bf_hi(yv[u].z), bf_hi(yv[u].w)};
            float s = (y[0] + y[1]) + (y[2] + y[3]);
#pragma unroll
            for (int o = 1; o < 16; o <<= 1) s += __shfl_xor(s, o);
            const float mean = s * (1.f / 64.f);
            float q = 0.f;
#pragma unroll
            for (int j = 0; j < 4; ++j) { y[j] -= mean; q += y[j] * y[j]; }
#pragma unroll
            for (int o = 1; o < 16; o <<= 1) q += __shfl_xor(q, o);
            const float rstd = rsqrtf(q * (1.f / 64.f) + GN_EPS);
            const float g4[4] = {bf_lo(gb[u].x), bf_hi(gb[u].x), bf_lo(gb[u].y), bf_hi(gb[u].y)};
            float o4[4];
#pragma unroll
            for (int j = 0; j < 4; ++j) o4[j] = (y[j] * rstd * lwv[j] + lbv[j] + rkb[u] * v[j]) * g4[j];
            u32x2 ob; ob.x = cvt_pk_bf16(o4[0], o4[1]); ob.y = cvt_pk_bf16(o4[2], o4[3]);
            *(u32x2*)(ORW + mm[u] * 512 + c) = ob;
        }
    }
}

struct KV { bf16x8 k[4]; bf16x8 v[2][2]; };
__device__ __forceinline__ void attn_load(KV& T, const bf16_t* Kh, const bf16_t* Vh, int k0, int n, int hf) {
    const bf16_t* kp = Kh + (size_t)(k0 + n) * 512 + 8 * hf;
#pragma unroll
    for (int s = 0; s < 4; ++s) T.k[s] = *(const bf16x8*)(kp + 16 * s);
#pragma unroll
    for (int d = 0; d < 2; ++d)
#pragma unroll
        for (int sg = 0; sg < 2; ++sg) { const bf16_t* vp = Vh + (size_t)(32 * d + n) * SEQ + k0 + 16 * sg + 4 * hf;
            const u32x2 lo = *(const u32x2*)vp, hi = *(const u32x2*)(vp + 8); u32x4 t = {lo.x, lo.y, hi.x, hi.y}; T.v[d][sg] = __builtin_bit_cast(bf16x8, t); }
}
__device__ __forceinline__ void attn_wave(const Args& a, int bh, int w4, int lane) {
    const int b = bh >> 3, h = bh & 7, n = lane & 31, hf = lane >> 5;
    const size_t m0 = (size_t)b * SEQ;
    const bf16_t* Qh = (const bf16_t*)(a.ws + O_Q) + m0 * 512 + 64 * h;
    const bf16_t* Kh = (const bf16_t*)(a.ws + O_K) + m0 * 512 + 64 * h;
    const bf16_t* Vh = (const bf16_t*)(a.ws + O_VT) + (size_t)bh * 64 * SEQ;
    bf16_t* Oh = (bf16_t*)(a.ws + O_OSB) + m0 * 512 + 64 * h;
    for (int qt = 63 - w4; qt >= 0; qt -= 8) {
        const int q0 = 32 * qt;
        bf16x8 qf[4];
#pragma unroll
        for (int s = 0; s < 4; ++s) qf[s] = *(const bf16x8*)(Qh + (size_t)(q0 + n) * 512 + 16 * s + 8 * hf);
        f32x16 o0, o1;
#pragma unroll
        for (int i = 0; i < 16; ++i) { o0[i] = 0.f; o1[i] = 0.f; }
        float carry = 0.f;
        KV cur, nxt;
        attn_load(cur, Kh, Vh, q0, n, hf);
        for (int kt = qt; kt >= 0; --kt) {
            const int ktn = kt > 0 ? kt - 1 : 0;
            attn_load(nxt, Kh, Vh, 32 * ktn, n, hf);
            f32x16 sc;
#pragma unroll
            for (int i = 0; i < 16; ++i) sc[i] = 0.f;
#pragma unroll
            for (int s = 0; s < 4; ++s) sc = __builtin_amdgcn_mfma_f32_32x32x16_bf16(cur.k[s], qf[s], sc, 0, 0, 0);
            const bool diag = (kt == qt);
            float lf[16], G4[4];
#pragma unroll
            for (int g = 0; g < 4; ++g) { G4[g] = 0.f;
#pragma unroll
                for (int i = 0; i < 4; ++i) { const int r = 4 * g + i; const float z = sc[r];
                    const bool valid = !diag || (8 * g + 4 * hf + i < n);
                    const float e = fexp(-fabsf(z));
                    const float sp = fmaxf(z, 0.f) + flog(1.f + e);
                    lf[r] = valid ? -sp : 0.f; G4[g] += lf[r]; } }
            float PG[4], T4[4];
#pragma unroll
            for (int g = 0; g < 4; ++g) { PG[g] = __shfl_xor(G4[g], 32); T4[g] = G4[g] + PG[g]; }
            const float tail3 = 0.f, tail2 = T4[3], tail1 = T4[3] + T4[2], tail0 = tail1 + T4[1], total = tail0 + T4[0];
            const float tails[4] = {tail0, tail1, tail2, tail3};
            f32x16 wv;
#pragma unroll
            for (int g = 0; g < 4; ++g) {
                float af = carry + tails[g] + (hf == 0 ? PG[g] : 0.f);
#pragma unroll
                for (int i = 3; i >= 0; --i) { const int r = 4 * g + i; const float z = sc[r];
                    const bool valid = !diag || (8 * g + 4 * hf + i < n);
                    const float wgt = fexp(lf[r] + z + af);
                    wv[r] = valid ? wgt : 0.f;
                    af += lf[r]; } }
            carry += total;
            bf16x8 wf[2];
#pragma unroll
            for (int sg = 0; sg < 2; ++sg) { u32x4 t; t.x = cvt_pk_bf16(wv[8 * sg + 0], wv[8 * sg + 1]); t.y = cvt_pk_bf16(wv[8 * sg + 2], wv[8 * sg + 3]); t.z = cvt_pk_bf16(wv[8 * sg + 4], wv[8 * sg + 5]); t.w = cvt_pk_bf16(wv[8 * sg + 6], wv[8 * sg + 7]); wf[sg] = __builtin_bit_cast(bf16x8, t); }
#pragma unroll
            for (int sg = 0; sg < 2; ++sg) { o0 = __builtin_amdgcn_mfma_f32_32x32x16_bf16(cur.v[0][sg], wf[sg], o0, 0, 0, 0); o1 = __builtin_amdgcn_mfma_f32_32x32x16_bf16(cur.v[1][sg], wf[sg], o1, 0, 0, 0); }
            cur = nxt;
#if MK_EARLY_EXIT
            if (__all(carry < -104.f)) break;
#endif
        }
        bf16_t* op = Oh + (size_t)(q0 + n) * 512 + 4 * hf;
#pragma unroll
        for (int g = 0; g < 4; ++g) {
            u32x2 t0, t1; t0.x = cvt_pk_bf16(o0[4 * g], o0[4 * g + 1]); t0.y = cvt_pk_bf16(o0[4 * g + 2], o0[4 * g + 3]); t1.x = cvt_pk_bf16(o1[4 * g], o1[4 * g + 1]); t1.y = cvt_pk_bf16(o1[4 * g + 2], o1[4 * g + 3]);
            *(u32x2*)(op + 8 * g) = t0; *(u32x2*)(op + 32 + 8 * g) = t1; }
    }
}
__device__ __forceinline__ void phase_mixer(const Args& a, unsigned char* lds, int G) {
    const int tid = my_tid(); const int wave = __builtin_amdgcn_readfirstlane(tid >> 6), lane = tid & 63;
    for (int bh = blockIdx.x; bh < NB * NH; bh += G) {
        const int b = bh >> 3, h = bh & 7; const size_t m0 = (size_t)b * SEQ;
        const unsigned char* sb = a.ws + O_SI + (m0 * 8 + h) * 768; const float* scp = (const float*)(a.ws + O_SC) + (m0 * 8 + h) * 4;
        unsigned* yrb = (unsigned*)(a.ws + O_YR) + m0 * 512 + 64 * h + 16 * (wave & 3);
        constexpr int NCH = SEQ / SC_T;
        ProdRec pr; f32x2 S[8]; const int pw = wave & 3, pcol = tid & 63;
#pragma unroll
        for (int p = 0; p < 8; ++p) S[p] = (f32x2){0.f, 0.f};
        __syncthreads();
        FinIn fin;
        if (wave >= 4) { prod_load(pr, sb, 0, pw, pcol); prod_store(pr, lds, pw, pcol); prod_load(pr, sb, 1, pw, pcol); fin_load(fin, sb, scp, 0, pw, lane); }
        __syncthreads();
        unsigned char* yring = lds + 2 * SC_BUF;
        for (int ci = 0; ci < NCH; ++ci) {
            if (wave < 4) scan_consume(S, lds + (ci & 1) * SC_BUF, yring + (ci & 1) * (SC_T * 2304), lane, wave);
            else {
                if (ci > 0) { prod_finish(fin, yring + ((ci - 1) & 1) * (SC_T * 2304), yrb + (size_t)(ci - 1) * SC_T * 512, pw, lane); fin_load(fin, sb, scp, ci, pw, lane); }
                if (ci + 1 < NCH) { prod_store(pr, lds + ((ci + 1) & 1) * SC_BUF, pw, pcol); prod_load(pr, sb, ci + 2 < NCH ? ci + 2 : ci + 1, pw, pcol); }
            }
            __syncthreads();
        }
        if (wave >= 4) prod_finish(fin, yring + ((NCH - 1) & 1) * (SC_T * 2304), yrb + (size_t)(NCH - 1) * SC_T * 512, pw, lane);
        attn_wave(a, bh, wave, lane);
        __threadfence_block(); __syncthreads();
        rwpost_local(a, bh, my_tid());
    }
}

template <int MODE> __device__ __forceinline__ void phase_rows(const Args& a, int G) {
    const int tid = my_tid(); const int wave = tid >> 6, lane = tid & 63;
    const int gw = blockIdx.x * 8 + wave, NGW = G * 8;
    const bf16_t* T = (const bf16_t*)(a.ws + (MODE == 0 ? O_TT : O_FF));
    const float* g1 = MODE == 0 ? a.in[18] : a.in[23]; const float* g2 = a.in[19];
    bf16_t* H2 = (bf16_t*)(a.ws + O_H2); bf16_t* X1B = (bf16_t*)(a.ws + O_X1B);
    f32x4 g1v[4], g2v[4];
#pragma unroll
    for (int j = 0; j < 4; ++j) { g1v[j] = ((const f32x4*)g1)[lane + 64 * j]; g2v[j] = ((const f32x4*)g2)[lane + 64 * j]; }
    for (int row0 = gw; row0 < M; row0 += 2 * NGW) {
        u32x2 tb[2][4]; f32x4 x[2][4];
#pragma unroll
        for (int u = 0; u < 2; ++u) { const int row = (row0 + u * NGW < M) ? row0 + u * NGW : row0;
            const u32x2* tr = (const u32x2*)(T + (size_t)row * D) + lane;
#pragma unroll
            for (int j = 0; j < 4; ++j) tb[u][j] = tr[64 * j];
            if (MODE == 0) { const f32x4* xr = (const f32x4*)(a.in[0] + (size_t)row * D) + lane;
#pragma unroll
                for (int j = 0; j < 4; ++j) x[u][j] = xr[64 * j]; }
            else { const u32x2* xr = (const u32x2*)(X1B + (size_t)row * D) + lane;
#pragma unroll
                for (int j = 0; j < 4; ++j) { const u32x2 xb = xr[64 * j]; x[u][j][0] = bf_lo(xb.x); x[u][j][1] = bf_hi(xb.x); x[u][j][2] = bf_lo(xb.y); x[u][j][3] = bf_hi(xb.y); } } }
#pragma unroll
        for (int u = 0; u < 2; ++u) {
            const int row = row0 + u * NGW;
            f32x4 t[4]; float s = 0.f;
#pragma unroll
            for (int j = 0; j < 4; ++j) { t[j][0] = bf_lo(tb[u][j].x); t[j][1] = bf_hi(tb[u][j].x); t[j][2] = bf_lo(tb[u][j].y); t[j][3] = bf_hi(tb[u][j].y);
                s += (t[j][0] * t[j][0] + t[j][1] * t[j][1]) + (t[j][2] * t[j][2] + t[j][3] * t[j][3]); }
            const float rs = rsqrtf(wave_sum(s) * (1.f / D) + RMS_EPS);
            float s2 = 0.f;
#pragma unroll
            for (int j = 0; j < 4; ++j)
#pragma unroll
                for (int e = 0; e < 4; ++e) { x[u][j][e] += t[j][e] * rs * g1v[j][e]; s2 += x[u][j][e] * x[u][j][e]; }
            float rs2 = 0.f;
            if (MODE == 0) rs2 = rsqrtf(wave_sum(s2) * (1.f / D) + RMS_EPS);
            if (row < M) {
                if (MODE == 0) {
                    u32x2* xo = (u32x2*)(X1B + (size_t)row * D) + lane;
#pragma unroll
                    for (int j = 0; j < 4; ++j) { u32x2 w; w.x = cvt_pk_bf16(x[u][j][0], x[u][j][1]); w.y = cvt_pk_bf16(x[u][j][2], x[u][j][3]); xo[64 * j] = w; }
                    if (lane == 0) ((float*)(a.ws + O_RS2))[row] = rs2;
                } else {
                    f32x4* orow = (f32x4*)(a.out + (size_t)row * D) + lane;
#pragma unroll
                    for (int j = 0; j < 4; ++j) orow[64 * j] = x[u][j];
                }
            }
        }
    }
}

#define XB_TMO      128
#define XB_XCNT(j)  (256  + 64 * (j))
#define XB_XSUB(j)  (1280 + 64 * (j))
#define XB_XGEN(j)  (2304 + 64 * (j))
#define XB_TOP      3328
#define XB_TOPGEN   3392
#define XCD_BAR_WORDS 3456
#define XB_SPIN_CAP (1u << 18)

__device__ __forceinline__ unsigned xb_ld(unsigned* p)              { return __hip_atomic_load(p, __ATOMIC_RELAXED, __HIP_MEMORY_SCOPE_AGENT); }
__device__ __forceinline__ unsigned xb_add(unsigned* p, unsigned v) { return __hip_atomic_fetch_add(p, v, __ATOMIC_RELAXED, __HIP_MEMORY_SCOPE_AGENT); }
__device__ __forceinline__ unsigned xb_xcc_id() { return (unsigned)__builtin_amdgcn_s_getreg((3 << 11) | 20) & 0xFu; }
#define XB_SPIN(cond, bar) do { unsigned _sp = 0; while (cond) { __builtin_amdgcn_s_sleep(1); \
    if ((++_sp & 255u) == 0u) { if (xb_ld(&(bar)[XB_TMO])) break; if (_sp > XB_SPIN_CAP) { atomicAdd(&(bar)[XB_TMO], 1u); break; } } } } while (0)

struct XcdBarrier {
    unsigned* bar; unsigned x;
    volatile __attribute__((address_space(3))) unsigned* st;
};

__device__ __forceinline__ XcdBarrier xcd_barrier_post(unsigned* bar, volatile __attribute__((address_space(3))) unsigned* st) {
    XcdBarrier b; b.bar = bar; b.x = xb_xcc_id(); b.st = st;
    if (threadIdx.x == 0) (void)xb_add(&bar[XB_XCNT(b.x)], 1u);
    return b;
}
__device__ __forceinline__ void xcd_barrier_complete(unsigned* bar, unsigned x, unsigned& nloc, unsigned& nx) {
    const unsigned G = gridDim.x * gridDim.y * gridDim.z;
    unsigned sum, cnt, mine, sp = 0u;
    for (;;) {
        sum = 0u; cnt = 0u; mine = 0u;
#pragma unroll
        for (unsigned j = 0; j < 16; ++j) { const unsigned c = xb_ld(&bar[XB_XCNT(j)]); sum += c; cnt += (c > 0u) ? 1u : 0u; mine = (j == x) ? c : mine; }
        if (sum == G) break;
        __builtin_amdgcn_s_sleep(1);
        if ((++sp & 255u) == 0u) { if (xb_ld(&bar[XB_TMO])) break; if (sp > XB_SPIN_CAP) { atomicAdd(&bar[XB_TMO], 1u); break; } }
    }
    nloc = mine > 0u ? mine : 1u; nx = cnt > 0u ? cnt : 1u;
}

__device__ __forceinline__ void xcd_barrier(const XcdBarrier& b) {
    asm volatile("s_waitcnt vmcnt(0)" ::: "memory");
    __syncthreads();
    if (threadIdx.x == 0) {
        unsigned* bar = b.bar;
        __builtin_amdgcn_s_waitcnt(0);
        unsigned nloc = b.st[0], nx = b.st[1];
        if (nloc == 0u) { xcd_barrier_complete(bar, b.x, nloc, nx); b.st[0] = nloc; b.st[1] = nx; }
        const unsigned old = xb_add(&bar[XB_XSUB(b.x)], 1u);
        const unsigned gen = old / nloc;
        if (old + 1u == (gen + 1u) * nloc) {
            __builtin_amdgcn_fence(__ATOMIC_RELEASE, "agent");
            asm volatile("s_waitcnt vmcnt(0)" ::: "memory");
            const unsigned og = xb_add(&bar[XB_TOP], 1u);
            const unsigned tg = og / nx;
            if (og + 1u == (tg + 1u) * nx) xb_add(&bar[XB_TOPGEN], 1u);
            else XB_SPIN(xb_ld(&bar[XB_TOPGEN]) == tg, bar);
            __builtin_amdgcn_fence(__ATOMIC_ACQUIRE, "agent");
            xb_add(&bar[XB_XGEN(b.x)], 1u);
            asm volatile("s_waitcnt vmcnt(0)" ::: "memory");
        } else {
            XB_SPIN(xb_ld(&bar[XB_XGEN(b.x)]) == gen, bar);
            __builtin_amdgcn_fence(__ATOMIC_ACQUIRE, "agent");
            asm volatile("s_waitcnt vmcnt(0)" ::: "memory");
        }
    }
    __syncthreads();
}

__global__ void __launch_bounds__(512, 2) mega(Args a) {
    extern __shared__ __attribute__((aligned(16))) unsigned char shm[];
    PG8_LAS unsigned char* lds = (PG8_LAS unsigned char*)shm;
    const int G = (int)gridDim.x;
    unsigned char* ws = a.ws;
    volatile __attribute__((address_space(3))) unsigned* bst = (volatile __attribute__((address_space(3))) unsigned*)(lds + pg8::STAGE_BYTES);
    if (threadIdx.x == 0) { bst[0] = 0u; bst[1] = 0u; }
    __syncthreads();
    const XcdBarrier bar = xcd_barrier_post((unsigned*)(ws + O_CTL), bst);
    cg::this_grid().sync();
    phase_prep(a, (float*)shm, G);
    xcd_barrier(bar);
    { Epi1 E; E.Q = (bf16_t*)(ws + O_Q); E.Kb = (bf16_t*)(ws + O_K); E.Vt = (bf16_t*)(ws + O_VT); E.Prw = (bf16_t*)(ws + O_PRW); E.Gt = (bf16_t*)a.out; E.bgate = a.in[3];
      run_gemm(lds, (const bf16_t*)(ws + O_H), (const bf16_t*)(ws + O_WIN), INC, 1024, E, G); }
    xcd_barrier(bar);
    phase_rwprep(a, shm, G);
    xcd_barrier(bar);
    phase_mixer(a, shm, G);
    xcd_barrier(bar);
    { EpiRow<1> E; E.O = (bf16_t*)(ws + O_T1); E.T1 = nullptr; E.Gt = (const bf16_t*)a.out;
      run_gemm(lds, (const bf16_t*)(ws + O_OSB), (const bf16_t*)(ws + O_WSB), 1024, 512, E, G); }
    { EpiRow<2> E; E.O = (bf16_t*)(ws + O_MRG); E.T1 = (const bf16_t*)(ws + O_T1); E.Gt = (const bf16_t*)a.out;
      run_gemm(lds, (const bf16_t*)(ws + O_ORW), (const bf16_t*)(ws + O_WRW), 1024, 512, E, G); }
    xcd_barrier(bar);
    { EpiRow<0> E; E.O = (bf16_t*)(ws + O_TT); E.T1 = nullptr; E.Gt = nullptr;
      run_gemm(lds, (const bf16_t*)(ws + O_MRG), (const bf16_t*)(ws + O_WO), 1024, 1024, E, G); }
    xcd_barrier(bar);
    phase_rows<0>(a, G);
    xcd_barrier(bar);
    { EpiSwiGLU E; E.Hd = (bf16_t*)(ws + O_HID); E.rs2 = (const float*)(ws + O_RS2);
      run_gemm(lds, (const bf16_t*)(ws + O_X1B), (const bf16_t*)(ws + O_WGU), 2 * DFF, 1024, E, G); }
    xcd_barrier(bar);
    { EpiRow<0> E; E.O = (bf16_t*)(ws + O_FF); E.T1 = nullptr; E.Gt = nullptr;
      run_gemm(lds, (const bf16_t*)(ws + O_HID), (const bf16_t*)(ws + O_WDN), 1024, DFF, E, G); }
    xcd_barrier(bar);
    phase_rows<1>(a, G);
}
}

extern "C" void kernel_launch(void* const* d_in, const int* in_sizes, int n_in, void* d_out, int out_size, void* d_ws, size_t ws_size, hipStream_t stream) {
    static int grid = 0;
    if (grid == 0) {
        if (n_in != 24 || in_sizes[0] != mk::M * mk::D || out_size != mk::M * mk::D || ws_size < mk::WS_NEED) {
            fprintf(stderr, "kernel_launch: unexpected shapes: n_in %d in0 %d out %d ws %zu (need %zu)\n", n_in, n_in > 0 ? in_sizes[0] : -1, out_size, ws_size, (size_t)mk::WS_NEED); grid = -1; return; }
        int dev = 0, cus = 0, per_cu = 0;
        hipGetDevice(&dev); hipDeviceGetAttribute(&cus, hipDeviceAttributeMultiprocessorCount, dev);
        if (hipFuncSetAttribute((const void*)mk::mega, hipFuncAttributeMaxDynamicSharedMemorySize, mk::LDS_BYTES) != hipSuccess) { fprintf(stderr, "kernel_launch: hipFuncSetAttribute failed\n"); grid = -1; return; }
        if (hipOccupancyMaxActiveBlocksPerMultiprocessor(&per_cu, (const void*)mk::mega, 512, mk::LDS_BYTES) != hipSuccess || per_cu < 1) { fprintf(stderr, "kernel_launch: occupancy query failed (%d)\n", per_cu); per_cu = 1; }
        (void)hipGetLastError();
        grid = cus * per_cu;
        fprintf(stderr, "kernel_launch: grid %d (cus %d x %d)\n", grid, cus, per_cu);
    }
    if (grid < 0) return;
    mk::Args a{};
    for (int i = 0; i < 24; ++i) a.in[i] = (const float*)d_in[i];
    a.out = (float*)d_out; a.ws = (unsigned char*)d_ws;
    a.ph_lo = 0; a.ph_hi = mk::NPH;
    if (hipMemsetAsync((char*)d_ws + mk::O_CTL, 0, mk::CTL_BYTES, stream) != hipSuccess) { fprintf(stderr, "kernel_launch: hipMemsetAsync failed\n"); return; }
    void* args[] = {&a};
    hipError_t e = hipLaunchCooperativeKernel((const void*)mk::mega, dim3(grid), dim3(512), args, mk::LDS_BYTES, stream);
    if (e != hipSuccess) fprintf(stderr, "kernel_launch: cooperative launch failed: %s (grid %d)\n", hipGetErrorString(e), grid);
}
```

```cpp
#include <hip/hip_runtime.h>
#include <hip/hip_cooperative_groups.h>
#include <cstdio>
#include <cstdint>
namespace cg = cooperative_groups;
#ifndef MK_SPLIT
#define MK_SPLIT 0
#endif
#ifndef MK_DIAG
#define MK_DIAG 0
#endif
#ifndef MK_REPMASK
#define MK_REPMASK 0
#endif
#ifndef MK_EARLY_EXIT
#define MK_EARLY_EXIT 1
#endif
namespace pg8 {
#define PG8_LAS __attribute__((address_space(3)))
typedef unsigned short bf16_t;
typedef short bf16x8 __attribute__((ext_vector_type(8)));
typedef float f32x4 __attribute__((ext_vector_type(4)));
typedef unsigned u32x4 __attribute__((ext_vector_type(4)));
constexpr int BM = 256, BK = 64, HALF = 128, HTB = HALF * BK * 2  , STAGE_BYTES = 8 * HTB, NXCD = 8, WGM = 8;

__host__ __device__ __forceinline__ int lds_byte(int r, int c) { const int st = (r >> 4) * 2 + (c >> 5), rr = r & 15, cc = c & 31, ob = rr * 64 + cc * 2; return st * 1024 + (ob ^ (((ob >> 9) & 1) << 5)); }
__host__ __device__ __forceinline__ void stage_rc(int b, int& R, int& C) { const int st = b / 1024, sb = b % 1024, swz = sb ^ (((sb >> 9) & 1) << 5); R = (st >> 1) * 16 + swz / 64; C = (st & 1) * 32 + (swz % 64) / 2; }
__host__ __device__ __forceinline__ int perm32(int rho) { const int n = rho >> 4, i = rho & 15; return 8 * (i >> 2) + 4 * n + (i & 3); }

struct Unit { int pm, pn; };
struct Gemm { const bf16_t* A; const bf16_t* Bt; int M, N, K; };

struct StaticOrder {
    int nM, nN, nwg, G, c;
    __host__ __device__ void init(int M, int N, int G_, int c_) { nM = M / BM; nN = N / BM; nwg = nM * nN; G = G_; c = c_; }
    __host__ __device__ bool next(int i, Unit& u) const {
        const long L = (long)i * G + c; if (L >= nwg) return false;
        int wgid = (int)L; { const int q = nwg / NXCD, r = nwg % NXCD, xcd = wgid % NXCD, off = wgid / NXCD; wgid = (xcd < r ? xcd * (q + 1) : r * (q + 1) + (xcd - r) * q) + off; }
        const int nig = WGM * nN, gid = wgid / nig, fm = gid * WGM, gsz = (nM - fm) < WGM ? (nM - fm) : WGM;
        u.pm = fm + ((wgid % nig) % gsz); u.pn = (wgid % nig) / gsz; return true;
    }
    __device__ __forceinline__ void a_ready(const Unit&) const {}
    __device__ __forceinline__ void done(const Unit&) const {}
};

typedef float cvt_f32x2 __attribute__((ext_vector_type(2)));
typedef __bf16 cvt_bf16x2 __attribute__((ext_vector_type(2)));
__device__ __forceinline__ unsigned cvt_pk_bf16(float lo, float hi) { const cvt_f32x2 v = {lo, hi}; return __builtin_bit_cast(unsigned, __builtin_convertvector(v, cvt_bf16x2)); }
typedef float f32x2 __attribute__((ext_vector_type(2)));

template <class Epi, class Sched, bool ALIGN_EPI = false, bool SP2 = false>
__device__ __forceinline__ void gemm_phase(PG8_LAS unsigned char* lds, const Gemm g, const Sched& S, const Epi& E) {
    int tid_ = threadIdx.x; asm volatile("" : "+v"(tid_)); const int tid = tid_, wid = __builtin_amdgcn_readfirstlane(tid >> 6), lane = tid & 63, wr = wid >> 2, wc = wid & 3, fr = lane & 15, fq = lane >> 4;
    const int K = g.K, nt = K / BK;
    unsigned voffA[2], voffB[2];
#pragma unroll
    for (int i = 0; i < 2; ++i) { int R, C; stage_rc(tid * 16 + i * 8192, R, C); const int Rb = Epi::PERM ? ((R & ~31) + perm32(R & 31)) : R;
        voffA[i] = (unsigned)(R * K + C) * 2u; voffB[i] = (unsigned)(Rb * K + C) * 2u; }
    const size_t kstep = (size_t)(BK * 2);
    const size_t hstep = (size_t)HALF * K * 2;
    const size_t tstep = 2 * hstep;
    const unsigned ldsw = (unsigned)wid * 1024u;
    const int aoff = lds_byte(wr * 64 + fr, fq * 8), boff = lds_byte(wc * 32 + fr, fq * 8);
#define PG8_SA(b, h) (((b) * 2 + (h)) * HTB)
#define PG8_SB(b, h) ((4 + (b) * 2 + (h)) * HTB)
#define PG8_STAGE(bufoff, gbase, voff) do { _Pragma("unroll") for (int _i = 0; _i < 2; ++_i) \
        __builtin_amdgcn_global_load_lds((const unsigned*)((const char*)(gbase) + (voff)[_i]), (PG8_LAS unsigned*)(lds + (bufoff) + ldsw + _i * 8192), 16, 0, 0); } while (0)
#define PG8_LDA(dst, b, h) do { _Pragma("unroll") for (int m = 0; m < 4; ++m) _Pragma("unroll") for (int k = 0; k < 2; ++k) dst[m][k] = *(const PG8_LAS bf16x8*)(lds + PG8_SA(b, h) + aoff + m * 2048 + k * 1024); } while (0)
#define PG8_LDB(dst, b, h) do { _Pragma("unroll") for (int n = 0; n < 2; ++n) _Pragma("unroll") for (int k = 0; k < 2; ++k) dst[n][k] = *(const PG8_LAS bf16x8*)(lds + PG8_SB(b, h) + boff + n * 2048 + k * 1024); } while (0)
#define PG8_MMA(ai, bj, At, Bt) do { __builtin_amdgcn_s_setprio(1); _Pragma("unroll") for (int m = 0; m < 4; ++m) _Pragma("unroll") for (int n = 0; n < 2; ++n) _Pragma("unroll") for (int k = 0; k < 2; ++k) \
        acc[ai][bj][m][n] = __builtin_amdgcn_mfma_f32_16x16x32_bf16(Bt[n][k], At[m][k], acc[ai][bj][m][n], 0, 0, 0); __builtin_amdgcn_s_setprio(0); } while (0)
#define PG8_WAIT_V(n) asm volatile("s_waitcnt vmcnt(" #n ")" ::: "memory")
#define PG8_WAIT_L(n) asm volatile("s_waitcnt lgkmcnt(" #n ")" ::: "memory")
#define PG8_BAR __builtin_amdgcn_s_barrier()
#define PG8_SCHED __builtin_amdgcn_sched_barrier(0)
    Unit cur, nxt; int ui = 0;
    if (!S.next(0, cur)) return;
    f32x4 acc[2][2][4][2];
#pragma unroll
    for (int a = 0; a < 2; ++a)
#pragma unroll
        for (int b = 0; b < 2; ++b)
#pragma unroll
            for (int m = 0; m < 4; ++m)
#pragma unroll
                for (int n = 0; n < 2; ++n) acc[a][b][m][n] = (f32x4){0.f, 0.f, 0.f, 0.f};
    bf16x8 At[4][2], B0[2][2], B1[2][2];
    const char* cA = (const char*)g.A + (size_t)cur.pm * tstep; const char* cB = (const char*)g.Bt + (size_t)cur.pn * tstep;
    S.a_ready(cur);
    if constexpr (SP2) {
        PG8_STAGE(PG8_SB(0, 0), cB, voffB); PG8_STAGE(PG8_SB(0, 1), cB + hstep, voffB); PG8_STAGE(PG8_SA(0, 0), cA, voffA); PG8_STAGE(PG8_SA(0, 1), cA + hstep, voffA);
        if (wr == 1) PG8_BAR;
        PG8_WAIT_V(2); PG8_BAR;
        PG8_STAGE(PG8_SB(1, 0), cB + kstep, voffB); PG8_STAGE(PG8_SA(1, 0), cA + kstep, voffA); PG8_STAGE(PG8_SB(1, 1), cB + hstep + kstep, voffB);
        PG8_WAIT_V(6); PG8_BAR;
    } else {
        PG8_STAGE(PG8_SB(0, 0), cB, voffB); PG8_STAGE(PG8_SA(0, 0), cA, voffA); PG8_STAGE(PG8_SB(0, 1), cB + hstep, voffB); PG8_STAGE(PG8_SA(0, 1), cA + hstep, voffA);
        if (wr == 1) PG8_BAR;
        PG8_WAIT_V(4); PG8_BAR;
        PG8_STAGE(PG8_SB(1, 0), cB + kstep, voffB); PG8_STAGE(PG8_SA(1, 0), cA + kstep, voffA); PG8_STAGE(PG8_SB(1, 1), cB + hstep + kstep, voffB);
        PG8_WAIT_V(6); PG8_BAR;
    }
    for (;;) {
        const bool has_next = S.next(ui + 1, nxt);
        const char* nA = has_next ? (const char*)g.A + (size_t)nxt.pm * tstep : cA; const char* nB = has_next ? (const char*)g.Bt + (size_t)nxt.pn * tstep : cB;
        for (int t = 0; t < nt; t += 2) {
            const bool last = (t == nt - 2);
            const char* a1 = cA + (size_t)(t + 1) * kstep;
            const char* a2 = last ? nA : cA + (size_t)(t + 2) * kstep; const char* b2 = last ? nB : cB + (size_t)(t + 2) * kstep;
            const char* a3 = a2 + kstep; const char* b3 = b2 + kstep;
            if (last && has_next) S.a_ready(nxt);
            if constexpr (SP2) {
            PG8_LDB(B0, 0, 0); PG8_LDB(B1, 0, 1); PG8_SCHED; PG8_LDA(At, 0, 0); PG8_STAGE(PG8_SA(1, 1), a1 + hstep, voffA);
            PG8_WAIT_V(8); PG8_WAIT_L(0); PG8_BAR; PG8_MMA(0, 0, At, B0); PG8_MMA(0, 1, At, B1); PG8_BAR; PG8_SCHED;
            PG8_LDA(At, 0, 1); PG8_STAGE(PG8_SB(0, 0), b2, voffB); PG8_STAGE(PG8_SB(0, 1), b2 + hstep, voffB); PG8_STAGE(PG8_SA(0, 0), a2, voffA);
            PG8_WAIT_V(8); PG8_WAIT_L(0); PG8_BAR; PG8_MMA(1, 0, At, B0); PG8_MMA(1, 1, At, B1); PG8_BAR; PG8_SCHED;
            PG8_LDB(B0, 1, 0); PG8_LDB(B1, 1, 1); PG8_SCHED; PG8_LDA(At, 1, 0); PG8_STAGE(PG8_SA(0, 1), a2 + hstep, voffA);
            PG8_WAIT_V(8); PG8_WAIT_L(0); PG8_BAR; PG8_MMA(0, 0, At, B0); PG8_MMA(0, 1, At, B1); PG8_BAR; PG8_SCHED;
            PG8_LDA(At, 1, 1); PG8_STAGE(PG8_SB(1, 0), b3, voffB); PG8_STAGE(PG8_SB(1, 1), b3 + hstep, voffB); PG8_STAGE(PG8_SA(1, 0), a3, voffA);
            PG8_WAIT_V(8); PG8_WAIT_L(0); PG8_BAR; PG8_MMA(1, 0, At, B0); PG8_MMA(1, 1, At, B1); PG8_BAR; PG8_SCHED;
            } else {
            PG8_LDB(B0, 0, 0); PG8_SCHED; PG8_LDA(At, 0, 0); PG8_STAGE(PG8_SA(1, 1), a1 + hstep, voffA);
            PG8_WAIT_L(8); PG8_BAR; PG8_WAIT_L(0); PG8_MMA(0, 0, At, B0); PG8_BAR; PG8_SCHED;
            PG8_LDB(B1, 0, 1); PG8_STAGE(PG8_SB(0, 0), b2, voffB);
            PG8_BAR; PG8_WAIT_L(0); PG8_MMA(0, 1, At, B1); PG8_BAR;
            PG8_LDA(At, 0, 1); PG8_STAGE(PG8_SA(0, 0), a2, voffA);
            PG8_BAR; PG8_WAIT_L(0); PG8_MMA(1, 0, At, B0); PG8_BAR; PG8_SCHED;
            PG8_STAGE(PG8_SB(0, 1), b2 + hstep, voffB);
            PG8_WAIT_V(6); PG8_BAR; PG8_MMA(1, 1, At, B1); PG8_BAR;
            PG8_LDB(B0, 1, 0); PG8_SCHED; PG8_LDA(At, 1, 0); PG8_STAGE(PG8_SA(0, 1), a2 + hstep, voffA);
            PG8_WAIT_L(8); PG8_BAR; PG8_WAIT_L(0); PG8_MMA(0, 0, At, B0); PG8_BAR; PG8_SCHED;
            PG8_LDB(B1, 1, 1); PG8_STAGE(PG8_SB(1, 0), b3, voffB);
            PG8_BAR; PG8_WAIT_L(0); PG8_MMA(0, 1, At, B1); PG8_BAR;
            PG8_LDA(At, 1, 1); PG8_STAGE(PG8_SA(1, 0), a3, voffA);
            PG8_BAR; PG8_WAIT_L(0); PG8_MMA(1, 0, At, B0); PG8_BAR; PG8_SCHED;
            PG8_STAGE(PG8_SB(1, 1), b3 + hstep, voffB);
            PG8_WAIT_V(6); PG8_BAR; PG8_MMA(1, 1, At, B1); PG8_BAR;
            }
        }
        if constexpr (ALIGN_EPI) { if (wr == 0) PG8_BAR; }
        if constexpr (!Epi::AFTER_DRAIN) { E(acc, cur, wr, wc, fr, fq); S.done(cur); }
        if (!has_next) break;
#pragma unroll
        for (int a = 0; a < 2; ++a)
#pragma unroll
            for (int b = 0; b < 2; ++b)
#pragma unroll
                for (int m = 0; m < 4; ++m)
#pragma unroll
                    for (int n = 0; n < 2; ++n) acc[a][b][m][n] = (f32x4){0.f, 0.f, 0.f, 0.f};
        cur = nxt; cA = nA; cB = nB; ++ui;
        if constexpr (ALIGN_EPI) { if (wr == 1) PG8_BAR; }
    }
    PG8_WAIT_V(0);
    if constexpr (!ALIGN_EPI) { if (wr == 0) PG8_BAR; }
    PG8_BAR;
    if constexpr (Epi::AFTER_DRAIN) { E.fused(acc, cur, wr, wc, fr, fq, lds, wid, lane); S.done(cur); }
#undef PG8_SA
#undef PG8_SB
#undef PG8_STAGE
#undef PG8_LDA
#undef PG8_LDB
#undef PG8_MMA
#undef PG8_WAIT_V
#undef PG8_WAIT_L
#undef PG8_BAR
#undef PG8_SCHED
}

}
namespace mk {
using pg8::bf16_t; using pg8::bf16x8; using pg8::f32x4; using pg8::u32x4; using pg8::cvt_pk_bf16;
typedef float f32x16 __attribute__((ext_vector_type(16)));
typedef float f32x2 __attribute__((ext_vector_type(2)));
typedef unsigned u32x2 __attribute__((ext_vector_type(2)));
constexpr int D = 1024, NB = 32, SEQ = 2048, M = NB * SEQ, NH = 8, DH = 64;
constexpr int RWC = 1792, GC = 2048, INC = 5376, DFF = 2816;
constexpr float RMS_EPS = 1e-6f, GN_EPS = 64e-5f;
constexpr size_t MiB = (size_t)1 << 20;
constexpr size_t O_WIN = 0, O_WSB = 11 * MiB, O_WRW = 12 * MiB, O_WO = 13 * MiB, O_WGU = 15 * MiB, O_WDN = 26 * MiB, O_WLU = 32 * MiB  , O_WLA = O_WLU + 65536, O_WLG = O_WLA + 65536;
constexpr size_t O_Q = 34 * MiB, O_K = 98 * MiB, O_VT = 162 * MiB, O_PRW = 226 * MiB, O_H = 450 * MiB, O_SI = 450 * MiB, O_G = 834 * MiB, O_SC = 898 * MiB, O_YR = 290 * MiB  ;
constexpr size_t O_OSB = 226 * MiB, O_ORW = 34 * MiB, O_T1 = 98 * MiB, O_MRG = 450 * MiB, O_TT = 34 * MiB, O_H2 = 162 * MiB, O_HID = 290 * MiB, O_FF = 34 * MiB;
constexpr size_t O_X1B = 706 * MiB;
constexpr size_t WS_NEED = 1009 * MiB;
constexpr int LDS_BYTES = pg8::STAGE_BYTES + 64;
constexpr size_t O_CTL = 1008 * MiB, CTL_BYTES = 65536;
constexpr int NPH = 12;

struct Args { const float* in[24]; float* out; unsigned char* ws; int ph_lo, ph_hi; };

__device__ __forceinline__ int my_tid() { int t = threadIdx.x; asm volatile("" : "+v"(t)); return t; }
__device__ __forceinline__ float bf_lo(unsigned u) { return __uint_as_float(u << 16); }
__device__ __forceinline__ float bf_hi(unsigned u) { return __uint_as_float(u & 0xffff0000u); }
__device__ __forceinline__ float fexp(float x) { return __builtin_amdgcn_exp2f(x * 1.44269504089f); }
__device__ __forceinline__ float flog(float x) { return __builtin_amdgcn_logf(x) * 0.69314718056f; }
__device__ __forceinline__ float frcp(float x) { return __builtin_amdgcn_rcpf(x); }
__device__ __forceinline__ float fsigmoid(float x) { return frcp(1.f + fexp(-x)); }
__device__ __forceinline__ unsigned short bf1(float x) { return (unsigned short)(cvt_pk_bf16(x, x) & 0xffffu); }
__device__ __forceinline__ u32x4 pack8(const f32x4 a, const f32x4 b) { u32x4 o; o.x = cvt_pk_bf16(a[0], a[1]); o.y = cvt_pk_bf16(a[2], a[3]); o.z = cvt_pk_bf16(b[0], b[1]); o.w = cvt_pk_bf16(b[2], b[3]); return o; }
__device__ __forceinline__ float red16(float v) {
    v += __shfl_xor(v, 16); v += __shfl_xor(v, 32); return v;
}
__device__ __forceinline__ float wave_sum(float v) {
#pragma unroll
    for (int o = 1; o < 64; o <<= 1) v += __shfl_xor(v, o);
    return v;
}

__device__ __forceinline__ void tr_item(const float* __restrict__ W, int K, int N, bf16_t* WT, float* scr, int item, int lane, int mode) {
    const int nblk = N >> 5, kb = item / nblk, nb = item - kb * nblk, k0 = kb << 6, n0 = nb << 5;
#pragma unroll 8
    for (int i = 0; i < 32; ++i) { const int kk = 2 * i + (lane >> 5); scr[kk * 33 + (lane & 31)] = W[(size_t)(k0 + kk) * N + n0 + (lane & 31)]; }
    asm volatile("s_waitcnt lgkmcnt(0)" ::: "memory"); __builtin_amdgcn_wave_barrier();
    const int c = lane & 7;
#pragma unroll
    for (int j = 0; j < 4; ++j) {
        const int n = (lane >> 3) + 8 * j; const float* s = scr + (8 * c) * 33 + n;
        u32x4 o; o.x = cvt_pk_bf16(s[0 * 33], s[1 * 33]); o.y = cvt_pk_bf16(s[2 * 33], s[3 * 33]); o.z = cvt_pk_bf16(s[4 * 33], s[5 * 33]); o.w = cvt_pk_bf16(s[6 * 33], s[7 * 33]);
        const int nn = n0 + n; int drow = nn;
        if (mode == 1) drow = ((nn >> 7) << 8) + (nn & 127); else if (mode == 2) drow = ((nn >> 7) << 8) + 128 + (nn & 127);
        *(u32x4*)(WT + (size_t)drow * K + k0 + 8 * c) = o;
    }
    asm volatile("s_waitcnt lgkmcnt(0)" ::: "memory"); __builtin_amdgcn_wave_barrier();
}

__device__ __forceinline__ void phase_prep(const Args& a, float* lds_f, int G) {
    const int tid = my_tid(); const int wave = tid >> 6, lane = tid & 63;
    const int gw = blockIdx.x * 8 + wave, NGW = G * 8;
    float* scr = lds_f + wave * (64 * 33 + 16);
    unsigned char* ws = a.ws;
    constexpr int I_IN = 16 * 168, I_SB = 8 * 32, I_O = 16 * 32, I_G = 16 * 88, I_DN = 44 * 32, I_LU = 16, I_LG = 32;
    constexpr int NIT = I_IN + 2 * I_SB + I_O + 2 * I_G + I_DN + 2 * I_LU + I_LG;
    for (int it = gw; it < NIT; it += NGW) {
        int r = it;
        if (r < I_IN) { tr_item(a.in[2], 1024, INC, (bf16_t*)(ws + O_WIN), scr, r, lane, 0); continue; } r -= I_IN;
        if (r < I_SB) { tr_item(a.in[15], 512, 1024, (bf16_t*)(ws + O_WSB), scr, r, lane, 0); continue; } r -= I_SB;
        if (r < I_SB) { tr_item(a.in[16], 512, 1024, (bf16_t*)(ws + O_WRW), scr, r, lane, 0); continue; } r -= I_SB;
        if (r < I_O) { tr_item(a.in[17], 1024, 1024, (bf16_t*)(ws + O_WO), scr, r, lane, 0); continue; } r -= I_O;
        if (r < I_G) { tr_item(a.in[20], 1024, DFF, (bf16_t*)(ws + O_WGU), scr, r, lane, 1); continue; } r -= I_G;
        if (r < I_G) { tr_item(a.in[21], 1024, DFF, (bf16_t*)(ws + O_WGU), scr, r, lane, 2); continue; } r -= I_G;
        if (r < I_DN) { tr_item(a.in[22], DFF, 1024, (bf16_t*)(ws + O_WDN), scr, r, lane, 0); continue; } r -= I_DN;
        if (r < I_LU) { tr_item(a.in[6], 64, 512, (bf16_t*)(ws + O_WLU), scr, r, lane, 0); continue; } r -= I_LU;
        if (r < I_LU) { tr_item(a.in[8], 64, 512, (bf16_t*)(ws + O_WLA), scr, r, lane, 0); continue; } r -= I_LU;
        tr_item(a.in[9], 128, 512, (bf16_t*)(ws + O_WLG), scr, r, lane, 0);
    }
    const float* x = a.in[0]; const float* g = a.in[1]; bf16_t* H = (bf16_t*)(ws + O_H);
    f32x4 gv[4];
#pragma unroll
    for (int j = 0; j < 4; ++j) gv[j] = ((const f32x4*)g)[lane + 64 * j];
    for (int row0 = gw; row0 < M; row0 += 2 * NGW) {
        f32x4 v[2][4];
#pragma unroll
        for (int u = 0; u < 2; ++u) { const int row = (row0 + u * NGW < M) ? row0 + u * NGW : row0; const f32x4* xr = (const f32x4*)(x + (size_t)row * D) + lane;
#pragma unroll
            for (int j = 0; j < 4; ++j) v[u][j] = __builtin_nontemporal_load(xr + 64 * j); }
#pragma unroll
        for (int u = 0; u < 2; ++u) { const int row = row0 + u * NGW; float s = 0.f;
#pragma unroll
            for (int j = 0; j < 4; ++j) s += (v[u][j][0] * v[u][j][0] + v[u][j][1] * v[u][j][1]) + (v[u][j][2] * v[u][j][2] + v[u][j][3] * v[u][j][3]);
            const float rs = rsqrtf(wave_sum(s) * (1.f / D) + RMS_EPS);
            if (row < M) { u32x2* o = (u32x2*)(H + (size_t)row * D) + lane;
#pragma unroll
                for (int j = 0; j < 4; ++j) { u32x2 w; w.x = cvt_pk_bf16(v[u][j][0] * rs * gv[j][0], v[u][j][1] * rs * gv[j][1]); w.y = cvt_pk_bf16(v[u][j][2] * rs * gv[j][2], v[u][j][3] * rs * gv[j][3]); o[64 * j] = w; } }
        }
    }
}

struct Epi1 {
    static constexpr bool PERM = true, AFTER_DRAIN = false;
    bf16_t *Q, *Kb, *Vt, *Prw, *Gt; const float* bgate;
    __device__ __forceinline__ void operator()(const f32x4 (&acc)[2][2][4][2], const pg8::Unit& u, int wr, int wc, int fr, int fq) const {
        const int row0 = u.pm * 256 + wr * 64 + fr, pn = u.pn, cl = wc * 32 + 8 * fq;
        if (pn < 4) {
            bf16_t* dst = pn < 2 ? Q : Kb; const float sc = pn < 2 ? 0.125f : 1.f; const int cb = (pn & 1) * 256 + cl;
#pragma unroll
            for (int ai = 0; ai < 2; ++ai)
#pragma unroll
                for (int m = 0; m < 4; ++m) { bf16_t* rp = dst + (size_t)(row0 + ai * 128 + m * 16) * 512 + cb;
#pragma unroll
                    for (int bj = 0; bj < 2; ++bj) *(u32x4*)(rp + bj * 128) = pack8(acc[ai][bj][m][0] * sc, acc[ai][bj][m][1] * sc); }
        } else if (pn < 6) {
#pragma unroll
            for (int ai = 0; ai < 2; ++ai)
#pragma unroll
                for (int m = 0; m < 4; ++m) { const int row = row0 + ai * 128 + m * 16, b = row >> 11, s = row & 2047;
#pragma unroll
                    for (int bj = 0; bj < 2; ++bj)
#pragma unroll
                        for (int n = 0; n < 2; ++n)
#pragma unroll
                            for (int j = 0; j < 4; ++j) { const int c = (pn - 4) * 256 + bj * 128 + cl + 4 * n + j;
                                Vt[((size_t)(b * 512 + c)) * 2048 + s] = bf1(acc[ai][bj][m][n][j]); } }
        } else if (pn < 13) {
            const int cb = (pn - 6) * 256 + cl;
#pragma unroll
            for (int ai = 0; ai < 2; ++ai)
#pragma unroll
                for (int m = 0; m < 4; ++m) { bf16_t* rp = Prw + (size_t)(row0 + ai * 128 + m * 16) * RWC + cb;
#pragma unroll
                    for (int bj = 0; bj < 2; ++bj) *(u32x4*)(rp + bj * 128) = pack8(acc[ai][bj][m][0], acc[ai][bj][m][1]); }
        } else {
            const int cb = (pn - 13) * 256 + cl;
#pragma unroll
            for (int ai = 0; ai < 2; ++ai)
#pragma unroll
                for (int m = 0; m < 4; ++m) { bf16_t* rp = Gt + (size_t)(row0 + ai * 128 + m * 16) * GC + cb;
#pragma unroll
                    for (int bj = 0; bj < 2; ++bj) { f32x4 v0 = acc[ai][bj][m][0] + *(const f32x4*)(bgate + cb + bj * 128), v1 = acc[ai][bj][m][1] + *(const f32x4*)(bgate + cb + bj * 128 + 4);
#pragma unroll
                        for (int j = 0; j < 4; ++j) { v0[j] = fsigmoid(v0[j]); v1[j] = fsigmoid(v1[j]); }
                        *(u32x4*)(rp + bj * 128) = pack8(v0, v1); } }
        }
    }
};
template <int MODE> struct EpiRow {
    static constexpr bool PERM = true, AFTER_DRAIN = false;
    bf16_t* O; const bf16_t* T1; const bf16_t* Gt;
    __device__ __forceinline__ void operator()(const f32x4 (&acc)[2][2][4][2], const pg8::Unit& u, int wr, int wc, int fr, int fq) const {
        const int row0 = u.pm * 256 + wr * 64 + fr, cb = u.pn * 256 + wc * 32 + 8 * fq;
#pragma unroll
        for (int ai = 0; ai < 2; ++ai)
#pragma unroll
            for (int m = 0; m < 4; ++m) { const size_t row = (size_t)(row0 + ai * 128 + m * 16);
#pragma unroll
                for (int bj = 0; bj < 2; ++bj) { f32x4 v0 = acc[ai][bj][m][0], v1 = acc[ai][bj][m][1]; const int c = cb + bj * 128;
                    if (MODE >= 1) { const u32x4 gg = *(const u32x4*)(Gt + row * GC + (MODE == 2 ? 1024 : 0) + c);
                        v0[0] *= bf_lo(gg.x); v0[1] *= bf_hi(gg.x); v0[2] *= bf_lo(gg.y); v0[3] *= bf_hi(gg.y); v1[0] *= bf_lo(gg.z); v1[1] *= bf_hi(gg.z); v1[2] *= bf_lo(gg.w); v1[3] *= bf_hi(gg.w); }
                    if (MODE == 2) { const u32x4 tt = *(const u32x4*)(T1 + row * 1024 + c);
                        v0[0] += bf_lo(tt.x); v0[1] += bf_hi(tt.x); v0[2] += bf_lo(tt.y); v0[3] += bf_hi(tt.y); v1[0] += bf_lo(tt.z); v1[1] += bf_hi(tt.z); v1[2] += bf_lo(tt.w); v1[3] += bf_hi(tt.w); }
                    *(u32x4*)(O + row * 1024 + c) = pack8(v0, v1); } }
    }
};
struct EpiSwiGLU {
    static constexpr bool PERM = true, AFTER_DRAIN = false;
    bf16_t* Hd;
    __device__ __forceinline__ void operator()(const f32x4 (&acc)[2][2][4][2], const pg8::Unit& u, int wr, int wc, int fr, int fq) const {
        const int row0 = u.pm * 256 + wr * 64 + fr, cb = u.pn * 128 + wc * 32 + 8 * fq;
#pragma unroll
        for (int ai = 0; ai < 2; ++ai)
#pragma unroll
            for (int m = 0; m < 4; ++m) { f32x4 v0, v1;
#pragma unroll
                for (int j = 0; j < 4; ++j) { const float g0 = acc[ai][0][m][0][j], g1 = acc[ai][0][m][1][j];
                    v0[j] = g0 * fsigmoid(g0) * acc[ai][1][m][0][j]; v1[j] = g1 * fsigmoid(g1) * acc[ai][1][m][1][j]; }
                *(u32x4*)(Hd + (size_t)(row0 + ai * 128 + m * 16) * DFF + cb) = pack8(v0, v1); }
    }
};
template <class Epi> __device__ __forceinline__ void run_gemm(PG8_LAS unsigned char* lds, const bf16_t* A, const bf16_t* Bt, int N, int K, const Epi& E, int G) {
    pg8::Gemm g; g.A = A; g.Bt = Bt; g.M = M; g.N = N; g.K = K;
    pg8::StaticOrder S; S.init(M, N, G, (int)blockIdx.x);
    pg8::gemm_phase<Epi, pg8::StaticOrder, true, true>(lds, g, S, E);
}
__device__ __forceinline__ void mix8_lds(const unsigned char* cur, const unsigned char* prv, const float* mu, float (&o)[8]) {
    const u32x4 c = *(const u32x4*)cur, p = *(const u32x4*)prv;
    const f32x4 m0 = *(const f32x4*)mu, m1 = *(const f32x4*)(mu + 4);
    const float mm[8] = {m0[0], m0[1], m0[2], m0[3], m1[0], m1[1], m1[2], m1[3]};
#pragma unroll
    for (int i = 0; i < 4; ++i) { const float cl = bf_lo(c[i]), ch = bf_hi(c[i]), pl = bf_lo(p[i]), ph = bf_hi(p[i]);
        o[2 * i] = cl + (pl - cl) * mm[2 * i]; o[2 * i + 1] = ch + (ph - ch) * mm[2 * i + 1]; }
}
__device__ __forceinline__ void mix4_lds(const unsigned char* cur, const unsigned char* prv, const float* mu, float (&o)[4]) {
    const u32x2 c = *(const u32x2*)cur, p = *(const u32x2*)prv;
    const f32x4 m0 = *(const f32x4*)mu;
#pragma unroll
    for (int i = 0; i < 2; ++i) { const float cl = bf_lo(c[i]), ch = bf_hi(c[i]), pl = bf_lo(p[i]), ph = bf_hi(p[i]);
        o[2 * i] = cl + (pl - cl) * m0[2 * i]; o[2 * i + 1] = ch + (ph - ch) * m0[2 * i + 1]; }
}
__device__ __forceinline__ bf16x8 pack_frag(const float (&v)[8]) {
    u32x4 o; o.x = cvt_pk_bf16(v[0], v[1]); o.y = cvt_pk_bf16(v[2], v[3]); o.z = cvt_pk_bf16(v[4], v[5]); o.w = cvt_pk_bf16(v[6], v[7]);
    return __builtin_bit_cast(bf16x8, o);
}
__device__ __forceinline__ void phase_rwprep(const Args& a, unsigned char* lds, int G) {
    constexpr int ROWB = 3600, L_FRAG = 17 * ROWB, L_PAR = L_FRAG + 8192, NCH = 17 * 224, NT = M / 16;
    const int tid = my_tid(); const int wave = __builtin_amdgcn_readfirstlane(tid >> 6), lane = tid & 63, fr = lane & 15, fq = lane >> 4;
    unsigned char* ws = a.ws;
    const unsigned char* PRW = ws + O_PRW;
    const bf16_t* WLU = (const bf16_t*)(ws + O_WLU); const bf16_t* WLA = (const bf16_t*)(ws + O_WLA); const bf16_t* WLG = (const bf16_t*)(ws + O_WLG);
    unsigned char* SI = ws + O_SI; bf16_t* GB = (bf16_t*)(ws + O_G); float* SC = (float*)(ws + O_SC);
    float* par = (float*)(lds + L_PAR);
    for (int i = tid; i < 1792 + 5 * 512; i += 512) {
        float v;
        if (i < 1792) v = a.in[4][i]; else { const int j = i - 1792, w = j >> 9, c = j & 511; v = (w == 0 ? a.in[5] : w == 1 ? a.in[7] : w == 2 ? a.in[10] : w == 3 ? a.in[11] : a.in[12])[c]; }
        par[i] = v;
    }
    for (int tile = blockIdx.x; tile < NT; tile += G) {
        __syncthreads();
        {   u32x4 pre[8];
#pragma unroll
            for (int j = 0; j < 8; ++j) { const int c = tid + 512 * j; pre[j] = (u32x4){0u, 0u, 0u, 0u};
                if (c < NCH) { const int row = c / 224, col = c - row * 224; const bool zero = (row == 0) && (((tile * 16) & (SEQ - 1)) == 0);
                    if (!zero) pre[j] = *(const u32x4*)(PRW + ((size_t)tile * 16 + row - 1) * (RWC * 2) + col * 16); } }
#pragma unroll
            for (int j = 0; j < 8; ++j) { const int c = tid + 512 * j; if (c < NCH) { const int row = c / 224, col = c - row * 224; *(u32x4*)(lds + row * ROWB + col * 16) = pre[j]; } }
        }
        __syncthreads();
        const unsigned char* rcur = lds + (fr + 1) * ROWB; const unsigned char* rprv = lds + fr * ROWB;
        {
            const int colb = wave < 2 ? 1536 + 32 * wave : (wave < 4 ? 1600 + 32 * (wave - 2) : 1664 + 32 * (wave - 4));
            float t8[8]; mix8_lds(rcur + (colb + 8 * fq) * 2, rprv + (colb + 8 * fq) * 2, par + colb + 8 * fq, t8);
            if (wave < 2) {
#pragma unroll
                for (int i = 0; i < 8; ++i) { const float e = fexp(2.f * t8[i]); t8[i] = 1.f - 2.f * frcp(e + 1.f); } }
            else if (wave >= 4) {
#pragma unroll
                for (int i = 0; i < 8; ++i) t8[i] = fsigmoid(t8[i]); }
            *(bf16x8*)(lds + L_FRAG + wave * 1024 + lane * 16) = pack_frag(t8);
        }
        __syncthreads();
        bf16x8 Aw[2], Aa[2], Ag[4];
#pragma unroll
        for (int s = 0; s < 2; ++s) { Aw[s] = *(const bf16x8*)(lds + L_FRAG + s * 1024 + lane * 16); Aa[s] = *(const bf16x8*)(lds + L_FRAG + (2 + s) * 1024 + lane * 16); }
#pragma unroll
        for (int s = 0; s < 4; ++s) Ag[s] = *(const bf16x8*)(lds + L_FRAG + (4 + s) * 1024 + lane * 16);
        const int h = wave; const size_t m = (size_t)tile * 16 + fr;
        float kkr[16], av[16]; unsigned lk[16], rvp[16];
        float ss = 0.f, brs = 0.f, krs = 0.f, rkbs = 0.f;
#pragma unroll
        for (int n = 0; n < 4; ++n) {
            asm volatile("" ::: "memory");
            const int cb = 64 * h + 16 * n, c0 = cb + 4 * fq;
            f32x4 aw = {0.f, 0.f, 0.f, 0.f}, aa = aw, ag = aw;
#pragma unroll
            for (int s = 0; s < 2; ++s) {
                aw = __builtin_amdgcn_mfma_f32_16x16x32_bf16(*(const bf16x8*)(WLU + (size_t)(cb + fr) * 64 + 32 * s + 8 * fq), Aw[s], aw, 0, 0, 0);
                aa = __builtin_amdgcn_mfma_f32_16x16x32_bf16(*(const bf16x8*)(WLA + (size_t)(cb + fr) * 64 + 32 * s + 8 * fq), Aa[s], aa, 0, 0, 0); }
#pragma unroll
            for (int s = 0; s < 4; ++s)
                ag = __builtin_amdgcn_mfma_f32_16x16x32_bf16(*(const bf16x8*)(WLG + (size_t)(cb + fr) * 128 + 32 * s + 8 * fq), Ag[s], ag, 0, 0, 0);
            float rr[4], kr4[4], vv[4];
            mix4_lds(rcur + c0 * 2, rprv + c0 * 2, par + c0, rr); mix4_lds(rcur + (512 + c0) * 2, rprv + (512 + c0) * 2, par + 512 + c0, kr4); mix4_lds(rcur + (1024 + c0) * 2, rprv + (1024 + c0) * 2, par + 1024 + c0, vv);
            const f32x4 w0v = *(const f32x4*)(par + 1792 + c0), a0v = *(const f32x4*)(par + 2304 + c0), kkv = *(const f32x4*)(par + 2816 + c0), kav = *(const f32x4*)(par + 3328 + c0), rkv = *(const f32x4*)(par + 3840 + c0);
#pragma unroll
            for (int j = 0; j < 4; ++j) {
                const float sg = fsigmoid(w0v[j] + aw[j]);
                const float ldx = -0.60653065971f * 1.44269504089f * sg;
                const float av_ = fsigmoid(a0v[j] + aa[j]);
                const float kkraw = kr4[j] * kkv[j];
                const float k2 = kr4[j] * (1.f + (av_ - 1.f) * kav[j]);
                ss += kkraw * kkraw; brs += kkraw * av_ * rr[j]; krs += k2 * rr[j]; rkbs += rr[j] * k2 * rkv[j];
                kkr[4 * n + j] = kkraw; av[4 * n + j] = av_; lk[4 * n + j] = cvt_pk_bf16(ldx, k2); rvp[4 * n + j] = cvt_pk_bf16(rr[j], vv[j]);
            }
            u32x2 gp; gp.x = cvt_pk_bf16(ag[0], ag[1]); gp.y = cvt_pk_bf16(ag[2], ag[3]);
            *(u32x2*)(GB + m * 512 + c0) = gp;
        }
        ss = red16(ss); brs = red16(brs); krs = red16(krs); rkbs = red16(rkbs);
        const float inv = 1.f / fmaxf(sqrtf(ss), 1e-12f);
        unsigned char* rec = SI + (m * 8 + h) * 768 + fq * 16;
#pragma unroll
        for (int n = 0; n < 4; ++n) {
            unsigned dw[12];
#pragma unroll
            for (int j = 0; j < 4; ++j) { const float kk = kkr[4 * n + j] * inv;
                const unsigned kp = cvt_pk_bf16(kk * av[4 * n + j], -kk);
                dw[3 * j] = (lk[4 * n + j] & 0xffffu) | (kp & 0xffff0000u); dw[3 * j + 1] = (kp & 0xffffu) | (lk[4 * n + j] & 0xffff0000u); dw[3 * j + 2] = rvp[4 * n + j]; }
            unsigned char* dst = rec + 64 * n;
            u32x4 s0 = {dw[0], dw[3], dw[6], dw[9]}, s1 = {dw[1], dw[4], dw[7], dw[10]}, s2 = {dw[2], dw[5], dw[8], dw[11]};
            *(u32x4*)dst = s0; *(u32x4*)(dst + 256) = s1; *(u32x4*)(dst + 512) = s2;
        }
        if (fq == 0) { f32x4 scv = {brs * inv, krs, rkbs, 0.f}; *(f32x4*)(SC + (m * 8 + h) * 4) = scv; }
    }
    __syncthreads();
}

__device__ __forceinline__ float red_rows(float x) {
    float a0 = x, a1 = x;
    asm volatile("s_nop 1\n\tv_permlane16_swap_b32 %0, %1" : "+v"(a0), "+v"(a1));
    float b0 = a0 + a1, b1 = b0;
    asm volatile("s_nop 1\n\tv_permlane32_swap_b32 %0, %1" : "+v"(b0), "+v"(b1));
    return b0 + b1;
}
constexpr int SC_T = 16, SC_ROW = 1280, SC_GEND = SC_T * SC_ROW, SC_BUF = SC_GEND + 256;
struct ProdRec { unsigned d0[SC_T]; unsigned d1[4], d2[4]; };
__device__ __forceinline__ void prod_load(ProdRec& P, const unsigned char* sb, int chunk, int pw, int col) {
    const unsigned char* p = sb + (size_t)chunk * SC_T * 6144 + col * 4;
#pragma unroll
    for (int st = 0; st < SC_T; ++st) P.d0[st] = *(const unsigned*)(p + st * 6144);
#pragma unroll
    for (int q = 0; q < 4; ++q) { P.d1[q] = *(const unsigned*)(p + (4 * pw + q) * 6144 + 256); P.d2[q] = *(const unsigned*)(p + (4 * pw + q) * 6144 + 512); }
}
__device__ __forceinline__ void prod_store(const ProdRec& P, unsigned char* buf, int pw, int col) {
    float L = 0.f;
#pragma unroll
    for (int st = 0; st < SC_T; ++st) {
        const float Lp = L; L += bf_lo(P.d0[st]);
        if ((st >> 2) == pw) { const int q = st & 3; unsigned char* base = buf + st * SC_ROW + col * 4;
            const float gp = __builtin_amdgcn_exp2f(Lp), g = __builtin_amdgcn_exp2f(L), ig = __builtin_amdgcn_exp2f(-L);
            *(float*)(base) = gp * bf_hi(P.d0[st]); *(float*)(base + 256) = g * bf_lo(P.d2[q]);
            *(float*)(base + 512) = bf_lo(P.d1[q]) * ig; *(float*)(base + 768) = bf_hi(P.d1[q]) * ig; *(float*)(base + 1024) = bf_hi(P.d2[q]); }
    }
    if (pw == 0) *(float*)(buf + SC_GEND + col * 4) = __builtin_amdgcn_exp2f(L);
}
#define MK_SWAP32(a, b) asm volatile("s_nop 1\n\tv_permlane32_swap_b32 %0, %1" : "+v"(a), "+v"(b))
#define MK_SWAP16(a, b) asm volatile("s_nop 1\n\tv_permlane16_swap_b32 %0, %1" : "+v"(a), "+v"(b))
__device__ __forceinline__ void red4x8(float& A, float& B, float& C, float& D) {
    MK_SWAP32(A, B); float u = A + B;
    MK_SWAP32(C, D); float w = C + D;
    MK_SWAP16(u, w); float z = u + w;
    float z1;
    asm volatile("s_nop 1\n\tv_add_f32_dpp %0, %1, %1 row_ror:8 row_mask:0xf bank_mask:0xf" : "=&v"(z1) : "v"(z));
    float p = z1, q = z1; MK_SWAP32(p, q);
    float p2 = p; MK_SWAP16(p, p2);
    float q2 = q; MK_SWAP16(q, q2);
    A = p; C = p2; B = q; D = q2;
}
__device__ __forceinline__ void red2x8(float& A, float& B) {
    MK_SWAP32(A, B); float u = A + B;
    float uc = u; MK_SWAP16(u, uc); float z = u + uc;
    float z1;
    asm volatile("s_nop 1\n\tv_add_f32_dpp %0, %1, %1 row_ror:8 row_mask:0xf bank_mask:0xf" : "=&v"(z1) : "v"(z));
    float p = z1, q = z1; MK_SWAP32(p, q);
    A = p; B = q;
}
__device__ __forceinline__ void scan_consume(f32x2 (&S)[8], const unsigned char* buf, unsigned char* ybuf, int lane, int rb) {
    const unsigned co = (unsigned)(lane >> 3) * 32u, vo = 1024u + (unsigned)(16 * rb + (lane & 7)) * 4u;
#pragma unroll 4
    for (int st = 0; st < SC_T; ++st) {
        const unsigned char* sb = buf + st * SC_ROW;
        f32x4 n4[2], r4[2], a4[2], k4[2];
#pragma unroll
        for (int q = 0; q < 2; ++q) { n4[q] = *(const f32x4*)(sb + co + 16 * q); r4[q] = *(const f32x4*)(sb + 256 + co + 16 * q);
            a4[q] = *(const f32x4*)(sb + 512 + co + 16 * q); k4[q] = *(const f32x4*)(sb + 768 + co + 16 * q); }
        const float v0 = *(const float*)(sb + vo), v1 = *(const float*)(sb + vo + 32);
        f32x2 sa0v = {0.f, 0.f}, sa1v = sa0v, yp0v = sa0v, yp1v = sa0v;
#pragma unroll
        for (int p = 0; p < 4; ++p) { const f32x2 nn = {n4[p >> 1][2 * (p & 1)], n4[p >> 1][2 * (p & 1) + 1]}, rr2 = {r4[p >> 1][2 * (p & 1)], r4[p >> 1][2 * (p & 1) + 1]};
            sa0v += S[p] * nn; sa1v += S[4 + p] * nn; yp0v += S[p] * rr2; yp1v += S[4 + p] * rr2; }
        float sa0 = sa0v[0] + sa0v[1], sa1 = sa1v[0] + sa1v[1];
        const f32x2 ypp = {yp0v[0] + yp0v[1], yp1v[0] + yp1v[1]};
        red2x8(sa0, sa1);
        const f32x2 s0 = {sa0, sa0}, s1 = {sa1, sa1}, vv0 = {v0, v0}, vv1 = {v1, v1};
#pragma unroll
        for (int p = 0; p < 4; ++p) { const f32x2 aa = {a4[p >> 1][2 * (p & 1)], a4[p >> 1][2 * (p & 1) + 1]}; S[p] = __builtin_elementwise_fma(aa, s0, S[p]); S[4 + p] = __builtin_elementwise_fma(aa, s1, S[4 + p]); }
        asm volatile("" ::: "memory");
#pragma unroll
        for (int p = 0; p < 4; ++p) { const f32x2 kk = {k4[p >> 1][2 * (p & 1)], k4[p >> 1][2 * (p & 1) + 1]}; S[p] = __builtin_elementwise_fma(kk, vv0, S[p]); S[4 + p] = __builtin_elementwise_fma(kk, vv1, S[4 + p]); }
        *(f32x2*)(ybuf + st * 2048 + rb * 512 + lane * 8) = ypp;
        if (lane < 8) { f32x2 o = {sa0, sa1}; *(f32x2*)(ybuf + SC_T * 2048 + st * 256 + rb * 64 + lane * 8) = o; }
    }
#pragma unroll
    for (int p = 0; p < 4; ++p) { const f32x4 g4 = *(const f32x4*)(buf + SC_GEND + co + 16 * (p >> 1)); const f32x2 gg = {g4[2 * (p & 1)], g4[2 * (p & 1) + 1]}; S[p] = S[p] * gg; S[4 + p] = S[4 + p] * gg; }
}
struct FinIn { unsigned v[4]; f32x2 bk[4]; };
__device__ __forceinline__ void fin_load(FinIn& F, const unsigned char* sb, const float* scp, int chunk, int pw, int lane) {
#pragma unroll
    for (int q = 0; q < 4; ++q) { const size_t t = (size_t)chunk * SC_T + (lane >> 4) + 4 * q;
        F.v[q] = *(const unsigned short*)(sb + t * 6144 + 512 + (16 * pw + (lane & 15)) * 4 + 2); F.bk[q] = *(const f32x2*)(scp + t * 32); }
}
__device__ __forceinline__ void prod_finish(const FinIn& F, const unsigned char* ybuf, unsigned* yr, int pw, int lane) {
#pragma unroll
    for (int q = 0; q < 4; ++q) { const int st = (lane >> 4) + 4 * q, row16 = lane & 15, e = row16 >> 3, rr = row16 & 7;
        const unsigned char* yp8 = ybuf + st * 2048 + pw * 512 + rr * 8 + e * 4; float yp = 0.f;
#pragma unroll
        for (int cg = 0; cg < 8; ++cg) yp += *(const float*)(yp8 + cg * 64);
        const float sa = *(const float*)(ybuf + SC_T * 2048 + st * 256 + pw * 64 + rr * 8 + e * 4);
        const float v = __uint_as_float(F.v[q] << 16), y = yp + sa * F.bk[q][0] + v * F.bk[q][1];
        yr[(size_t)st * 512 + row16] = (unsigned)bf1(y) | (F.v[q] << 16); }
}

__device__ __forceinline__ void rwpost_local(const Args& a, int bh, int tid) {
    const float* SC = (const float*)(a.ws + O_SC);
    const unsigned* YR = (const unsigned*)(a.ws + O_YR); const bf16_t* GB = (const bf16_t*)(a.ws + O_G); bf16_t* ORW = (bf16_t*)(a.ws + O_ORW);
    const int b = bh >> 3, h = bh & 7, c = 64 * h + (tid & 15) * 4;
    const f32x4 lwv = *(const f32x4*)(a.in[13] + c), lbv = *(const f32x4*)(a.in[14] + c);
    for (int t0 = tid >> 4; t0 < SEQ; t0 += 64) {
        u32x4 yv[2]; u32x2 gb[2]; float rkb[2]; size_t mm[2];
#pragma unroll
        for (int u = 0; u < 2; ++u) { const size_t m = (size_t)b * SEQ + t0 + 32 * u; mm[u] = m;
            yv[u] = *(const u32x4*)(YR + m * 512 + c); gb[u] = *(const u32x2*)(GB + m * 512 + c); rkb[u] = SC[(m * 8 + h) * 4 + 2]; }
#pragma unroll
        for (int u = 0; u < 2; ++u) {
            float y[4] = {bf_lo(yv[u].x), bf_lo(yv[u].y), bf_lo(yv[u].z), bf_lo(yv[u].w)};
            const float v[4] = {bf_hi(yv[u].x), bf_hi(yv[u].y), bf_hi(yv[u].z), bf_hi(yv[u].w)};
            float s = (y[0] + y[1]) + (y[2] + y[3]);
#pragma unroll
            for (int o = 1; o < 16; o <<= 1) s += __shfl_xor(s, o);
            const float mean = s * (1.f / 64.f);
            float q = 0.f;
#pragma unroll
            for (int j = 0; j < 4; ++j) { y[j] -= mean; q += y[j] * y[j]; }
#pragma unroll
            for (int o = 1; o < 16; o <<= 1) q += __shfl_xor(q, o);
            const float rstd = rsqrtf(q * (1.f / 64.f) + GN_EPS);
            const float g4[4] = {bf_lo(gb[u].x), bf_hi(gb[u].x), bf_lo(gb[u].y), bf_hi(gb[u].y)};
            float o4[4];
#pragma unroll
            for (int j = 0; j < 4; ++j) o4[j] = (y[j] * rstd * lwv[j] + lbv[j] + rkb[u] * v[j]) * g4[j];
            u32x2 ob; ob.x = cvt_pk_bf16(o4[0], o4[1]); ob.y = cvt_pk_bf16(o4[2], o4[3]);
            *(u32x2*)(ORW + mm[u] * 512 + c) = ob;
        }
    }
}

struct KV { bf16x8 k[4]; bf16x8 v[2][2]; };
__device__ __forceinline__ void attn_load(KV& T, const bf16_t* Kh, const bf16_t* Vh, int k0, int n, int hf) {
    const bf16_t* kp = Kh + (size_t)(k0 + n) * 512 + 8 * hf;
#pragma unroll
    for (int s = 0; s < 4; ++s) T.k[s] = *(const bf16x8*)(kp + 16 * s);
#pragma unroll
    for (int d = 0; d < 2; ++d)
#pragma unroll
        for (int sg = 0; sg < 2; ++sg) { const bf16_t* vp = Vh + (size_t)(32 * d + n) * SEQ + k0 + 16 * sg + 4 * hf;
            const u32x2 lo = *(const u32x2*)vp, hi = *(const u32x2*)(vp + 8); u32x4 t = {lo.x, lo.y, hi.x, hi.y}; T.v[d][sg] = __builtin_bit_cast(bf16x8, t); }
}
__device__ __forceinline__ void attn_wave(const Args& a, int bh, int w4, int lane) {
    const int b = bh >> 3, h = bh & 7, n = lane & 31, hf = lane >> 5;
    const size_t m0 = (size_t)b * SEQ;
    const bf16_t* Qh = (const bf16_t*)(a.ws + O_Q) + m0 * 512 + 64 * h;
    const bf16_t* Kh = (const bf16_t*)(a.ws + O_K) + m0 * 512 + 64 * h;
    const bf16_t* Vh = (const bf16_t*)(a.ws + O_VT) + (size_t)bh * 64 * SEQ;
    bf16_t* Oh = (bf16_t*)(a.ws + O_OSB) + m0 * 512 + 64 * h;
    for (int qt = 63 - w4; qt >= 0; qt -= 8) {
        const int q0 = 32 * qt;
        bf16x8 qf[4];
#pragma unroll
        for (int s = 0; s < 4; ++s) qf[s] = *(const bf16x8*)(Qh + (size_t)(q0 + n) * 512 + 16 * s + 8 * hf);
        f32x16 o0, o1;
#pragma unroll
        for (int i = 0; i < 16; ++i) { o0[i] = 0.f; o1[i] = 0.f; }
        float carry = 0.f;
        KV cur, nxt;
        attn_load(cur, Kh, Vh, q0, n, hf);
        for (int kt = qt; kt >= 0; --kt) {
            const int ktn = kt > 0 ? kt - 1 : 0;
            attn_load(nxt, Kh, Vh, 32 * ktn, n, hf);
            f32x16 sc;
#pragma unroll
            for (int i = 0; i < 16; ++i) sc[i] = 0.f;
#pragma unroll
            for (int s = 0; s < 4; ++s) sc = __builtin_amdgcn_mfma_f32_32x32x16_bf16(cur.k[s], qf[s], sc, 0, 0, 0);
            const bool diag = (kt == qt);
            float lf[16], G4[4];
#pragma unroll
            for (int g = 0; g < 4; ++g) { G4[g] = 0.f;
#pragma unroll
                for (int i = 0; i < 4; ++i) { const int r = 4 * g + i; const float z = sc[r];
                    const bool valid = !diag || (8 * g + 4 * hf + i < n);
                    const float e = fexp(-fabsf(z));
                    const float sp = fmaxf(z, 0.f) + flog(1.f + e);
                    lf[r] = valid ? -sp : 0.f; G4[g] += lf[r]; } }
            float PG[4], T4[4];
#pragma unroll
            for (int g = 0; g < 4; ++g) { PG[g] = __shfl_xor(G4[g], 32); T4[g] = G4[g] + PG[g]; }
            const float tail3 = 0.f, tail2 = T4[3], tail1 = T4[3] + T4[2], tail0 = tail1 + T4[1], total = tail0 + T4[0];
            const float tails[4] = {tail0, tail1, tail2, tail3};
            f32x16 wv;
#pragma unroll
            for (int g = 0; g < 4; ++g) {
                float af = carry + tails[g] + (hf == 0 ? PG[g] : 0.f);
#pragma unroll
                for (int i = 3; i >= 0; --i) { const int r = 4 * g + i; const float z = sc[r];
                    const bool valid = !diag || (8 * g + 4 * hf + i < n);
                    const float wgt = fexp(lf[r] + z + af);
                    wv[r] = valid ? wgt : 0.f;
                    af += lf[r]; } }
            carry += total;
            bf16x8 wf[2];
#pragma unroll
            for (int sg = 0; sg < 2; ++sg) { u32x4 t; t.x = cvt_pk_bf16(wv[8 * sg + 0], wv[8 * sg + 1]); t.y = cvt_pk_bf16(wv[8 * sg + 2], wv[8 * sg + 3]); t.z = cvt_pk_bf16(wv[8 * sg + 4], wv[8 * sg + 5]); t.w = cvt_pk_bf16(wv[8 * sg + 6], wv[8 * sg + 7]); wf[sg] = __builtin_bit_cast(bf16x8, t); }
#pragma unroll
            for (int sg = 0; sg < 2; ++sg) { o0 = __builtin_amdgcn_mfma_f32_32x32x16_bf16(cur.v[0][sg], wf[sg], o0, 0, 0, 0); o1 = __builtin_amdgcn_mfma_f32_32x32x16_bf16(cur.v[1][sg], wf[sg], o1, 0, 0, 0); }
            cur = nxt;
#if MK_EARLY_EXIT
            if (__all(carry < -104.f)) break;
#endif
        }
        bf16_t* op = Oh + (size_t)(q0 + n) * 512 + 4 * hf;
#pragma unroll
        for (int g = 0; g < 4; ++g) {
            u32x2 t0, t1; t0.x = cvt_pk_bf16(o0[4 * g], o0[4 * g + 1]); t0.y = cvt_pk_bf16(o0[4 * g + 2], o0[4 * g + 3]); t1.x = cvt_pk_bf16(o1[4 * g], o1[4 * g + 1]); t1.y = cvt_pk_bf16(o1[4 * g + 2], o1[4 * g + 3]);
            *(u32x2*)(op + 8 * g) = t0; *(u32x2*)(op + 32 + 8 * g) = t1; }
    }
}
__device__ __forceinline__ void phase_mixer(const Args& a, unsigned char* lds, int G) {
    const int tid = my_tid(); const int wave = __builtin_amdgcn_readfirstlane(tid >> 6), lane = tid & 63;
    for (int bh = blockIdx.x; bh < NB * NH; bh += G) {
        const int b = bh >> 3, h = bh & 7; const size_t m0 = (size_t)b * SEQ;
        const unsigned char* sb = a.ws + O_SI + (m0 * 8 + h) * 768; const float* scp = (const float*)(a.ws + O_SC) + (m0 * 8 + h) * 4;
        unsigned* yrb = (unsigned*)(a.ws + O_YR) + m0 * 512 + 64 * h + 16 * (wave & 3);
        constexpr int NCH = SEQ / SC_T;
        ProdRec pr; f32x2 S[8]; const int pw = wave & 3, pcol = tid & 63;
#pragma unroll
        for (int p = 0; p < 8; ++p) S[p] = (f32x2){0.f, 0.f};
        __syncthreads();
        FinIn fin;
        if (wave >= 4) { prod_load(pr, sb, 0, pw, pcol); prod_store(pr, lds, pw, pcol); prod_load(pr, sb, 1, pw, pcol); fin_load(fin, sb, scp, 0, pw, lane); }
        __syncthreads();
        unsigned char* yring = lds + 2 * SC_BUF;
        for (int ci = 0; ci < NCH; ++ci) {
            if (wave < 4) scan_consume(S, lds + (ci & 1) * SC_BUF, yring + (ci & 1) * (SC_T * 2304), lane, wave);
            else {
                if (ci > 0) { prod_finish(fin, yring + ((ci - 1) & 1) * (SC_T * 2304), yrb + (size_t)(ci - 1) * SC_T * 512, pw, lane); fin_load(fin, sb, scp, ci, pw, lane); }
                if (ci + 1 < NCH) { prod_store(pr, lds + ((ci + 1) & 1) * SC_BUF, pw, pcol); prod_load(pr, sb, ci + 2 < NCH ? ci + 2 : ci + 1, pw, pcol); }
            }
            __syncthreads();
        }
        if (wave >= 4) prod_finish(fin, yring + ((NCH - 1) & 1) * (SC_T * 2304), yrb + (size_t)(NCH - 1) * SC_T * 512, pw, lane);
        attn_wave(a, bh, wave, lane);
        __threadfence_block(); __syncthreads();
        rwpost_local(a, bh, my_tid());
    }
}

template <int MODE> __device__ __forceinline__ void phase_rows(const Args& a, int G) {
    const int tid = my_tid(); const int wave = tid >> 6, lane = tid & 63;
    const int gw = blockIdx.x * 8 + wave, NGW = G * 8;
    const bf16_t* T = (const bf16_t*)(a.ws + (MODE == 0 ? O_TT : O_FF));
    const float* g1 = MODE == 0 ? a.in[18] : a.in[23]; const float* g2 = a.in[19];
    bf16_t* H2 = (bf16_t*)(a.ws + O_H2); bf16_t* X1B = (bf16_t*)(a.ws + O_X1B);
    f32x4 g1v[4], g2v[4];
#pragma unroll
    for (int j = 0; j < 4; ++j) { g1v[j] = ((const f32x4*)g1)[lane + 64 * j]; g2v[j] = ((const f32x4*)g2)[lane + 64 * j]; }
    for (int row0 = gw; row0 < M; row0 += 2 * NGW) {
        u32x2 tb[2][4]; f32x4 x[2][4];
#pragma unroll
        for (int u = 0; u < 2; ++u) { const int row = (row0 + u * NGW < M) ? row0 + u * NGW : row0;
            const u32x2* tr = (const u32x2*)(T + (size_t)row * D) + lane;
#pragma unroll
            for (int j = 0; j < 4; ++j) tb[u][j] = tr[64 * j];
            if (MODE == 0) { const f32x4* xr = (const f32x4*)(a.in[0] + (size_t)row * D) + lane;
#pragma unroll
                for (int j = 0; j < 4; ++j) x[u][j] = __builtin_nontemporal_load(xr + 64 * j); }
            else { const u32x2* xr = (const u32x2*)(X1B + (size_t)row * D) + lane;
#pragma unroll
                for (int j = 0; j < 4; ++j) { const u32x2 xb = xr[64 * j]; x[u][j][0] = bf_lo(xb.x); x[u][j][1] = bf_hi(xb.x); x[u][j][2] = bf_lo(xb.y); x[u][j][3] = bf_hi(xb.y); } } }
#pragma unroll
        for (int u = 0; u < 2; ++u) {
            const int row = row0 + u * NGW;
            f32x4 t[4]; float s = 0.f;
#pragma unroll
            for (int j = 0; j < 4; ++j) { t[j][0] = bf_lo(tb[u][j].x); t[j][1] = bf_hi(tb[u][j].x); t[j][2] = bf_lo(tb[u][j].y); t[j][3] = bf_hi(tb[u][j].y);
                s += (t[j][0] * t[j][0] + t[j][1] * t[j][1]) + (t[j][2] * t[j][2] + t[j][3] * t[j][3]); }
            const float rs = rsqrtf(wave_sum(s) * (1.f / D) + RMS_EPS);
            float s2 = 0.f;
#pragma unroll
            for (int j = 0; j < 4; ++j)
#pragma unroll
                for (int e = 0; e < 4; ++e) { x[u][j][e] += t[j][e] * rs * g1v[j][e]; s2 += x[u][j][e] * x[u][j][e]; }
            float rs2 = 0.f;
            if (MODE == 0) rs2 = rsqrtf(wave_sum(s2) * (1.f / D) + RMS_EPS);
            if (row < M) {
                if (MODE == 0) {
                    u32x2* xo = (u32x2*)(X1B + (size_t)row * D) + lane; u32x2* o = (u32x2*)(H2 + (size_t)row * D) + lane;
#pragma unroll
                    for (int j = 0; j < 4; ++j) { u32x2 w; w.x = cvt_pk_bf16(x[u][j][0], x[u][j][1]); w.y = cvt_pk_bf16(x[u][j][2], x[u][j][3]); xo[64 * j] = w; }
#pragma unroll
                    for (int j = 0; j < 4; ++j) { u32x2 w; w.x = cvt_pk_bf16(x[u][j][0] * rs2 * g2v[j][0], x[u][j][1] * rs2 * g2v[j][1]); w.y = cvt_pk_bf16(x[u][j][2] * rs2 * g2v[j][2], x[u][j][3] * rs2 * g2v[j][3]); o[64 * j] = w; }
                } else {
                    f32x4* orow = (f32x4*)(a.out + (size_t)row * D) + lane;
#pragma unroll
                    for (int j = 0; j < 4; ++j) orow[64 * j] = x[u][j];
                }
            }
        }
    }
}

#define XB_TMO      128
#define XB_XCNT(j)  (256  + 64 * (j))
#define XB_XSUB(j)  (1280 + 64 * (j))
#define XB_XGEN(j)  (2304 + 64 * (j))
#define XB_TOP      3328
#define XB_TOPGEN   3392
#define XCD_BAR_WORDS 3456
#define XB_SPIN_CAP (1u << 18)

__device__ __forceinline__ unsigned xb_ld(unsigned* p)              { return __hip_atomic_load(p, __ATOMIC_RELAXED, __HIP_MEMORY_SCOPE_AGENT); }
__device__ __forceinline__ unsigned xb_add(unsigned* p, unsigned v) { return __hip_atomic_fetch_add(p, v, __ATOMIC_RELAXED, __HIP_MEMORY_SCOPE_AGENT); }
__device__ __forceinline__ unsigned xb_xcc_id() { return (unsigned)__builtin_amdgcn_s_getreg((3 << 11) | 20) & 0xFu; }
#define XB_SPIN(cond, bar) do { unsigned _sp = 0; while (cond) { __builtin_amdgcn_s_sleep(1); \
    if ((++_sp & 255u) == 0u) { if (xb_ld(&(bar)[XB_TMO])) break; if (_sp > XB_SPIN_CAP) { atomicAdd(&(bar)[XB_TMO], 1u); break; } } } } while (0)

struct XcdBarrier {
    unsigned* bar; unsigned x;
    volatile __attribute__((address_space(3))) unsigned* st;
};

__device__ __forceinline__ XcdBarrier xcd_barrier_post(unsigned* bar, volatile __attribute__((address_space(3))) unsigned* st) {
    XcdBarrier b; b.bar = bar; b.x = xb_xcc_id(); b.st = st;
    if (threadIdx.x == 0) (void)xb_add(&bar[XB_XCNT(b.x)], 1u);
    return b;
}
__device__ __forceinline__ void xcd_barrier_complete(unsigned* bar, unsigned x, unsigned& nloc, unsigned& nx) {
    const unsigned G = gridDim.x * gridDim.y * gridDim.z;
    unsigned sum, cnt, mine, sp = 0u;
    for (;;) {
        sum = 0u; cnt = 0u; mine = 0u;
#pragma unroll
        for (unsigned j = 0; j < 16; ++j) { const unsigned c = xb_ld(&bar[XB_XCNT(j)]); sum += c; cnt += (c > 0u) ? 1u : 0u; mine = (j == x) ? c : mine; }
        if (sum == G) break;
        __builtin_amdgcn_s_sleep(1);
        if ((++sp & 255u) == 0u) { if (xb_ld(&bar[XB_TMO])) break; if (sp > XB_SPIN_CAP) { atomicAdd(&bar[XB_TMO], 1u); break; } }
    }
    nloc = mine > 0u ? mine : 1u; nx = cnt > 0u ? cnt : 1u;
}

__device__ __forceinline__ void xcd_barrier(const XcdBarrier& b) {
    asm volatile("s_waitcnt vmcnt(0)" ::: "memory");
    __syncthreads();
    if (threadIdx.x == 0) {
        unsigned* bar = b.bar;
        __builtin_amdgcn_s_waitcnt(0);
        unsigned nloc = b.st[0], nx = b.st[1];
        if (nloc == 0u) { xcd_barrier_complete(bar, b.x, nloc, nx); b.st[0] = nloc; b.st[1] = nx; }
        const unsigned old = xb_add(&bar[XB_XSUB(b.x)], 1u);
        const unsigned gen = old / nloc;
        if (old + 1u == (gen + 1u) * nloc) {
            __builtin_amdgcn_fence(__ATOMIC_RELEASE, "agent");
            asm volatile("s_waitcnt vmcnt(0)" ::: "memory");
            const unsigned og = xb_add(&bar[XB_TOP], 1u);
            const unsigned tg = og / nx;
            if (og + 1u == (tg + 1u) * nx) xb_add(&bar[XB_TOPGEN], 1u);
            else XB_SPIN(xb_ld(&bar[XB_TOPGEN]) == tg, bar);
            __builtin_amdgcn_fence(__ATOMIC_ACQUIRE, "agent");
            xb_add(&bar[XB_XGEN(b.x)], 1u);
            asm volatile("s_waitcnt vmcnt(0)" ::: "memory");
        } else {
            XB_SPIN(xb_ld(&bar[XB_XGEN(b.x)]) == gen, bar);
            __builtin_amdgcn_fence(__ATOMIC_ACQUIRE, "agent");
            asm volatile("s_waitcnt vmcnt(0)" ::: "memory");
        }
    }
    __syncthreads();
}

__global__ void __launch_bounds__(512, 2) mega(Args a) {
    extern __shared__ __attribute__((aligned(16))) unsigned char shm[];
    PG8_LAS unsigned char* lds = (PG8_LAS unsigned char*)shm;
    const int G = (int)gridDim.x;
    unsigned char* ws = a.ws;
    volatile __attribute__((address_space(3))) unsigned* bst = (volatile __attribute__((address_space(3))) unsigned*)(lds + pg8::STAGE_BYTES);
    if (threadIdx.x == 0) { bst[0] = 0u; bst[1] = 0u; }
    __syncthreads();
    const XcdBarrier bar = xcd_barrier_post((unsigned*)(ws + O_CTL), bst);
    cg::this_grid().sync();
    phase_prep(a, (float*)shm, G);
    xcd_barrier(bar);
    { Epi1 E; E.Q = (bf16_t*)(ws + O_Q); E.Kb = (bf16_t*)(ws + O_K); E.Vt = (bf16_t*)(ws + O_VT); E.Prw = (bf16_t*)(ws + O_PRW); E.Gt = (bf16_t*)a.out; E.bgate = a.in[3];
      run_gemm(lds, (const bf16_t*)(ws + O_H), (const bf16_t*)(ws + O_WIN), INC, 1024, E, G); }
    xcd_barrier(bar);
    phase_rwprep(a, shm, G);
    xcd_barrier(bar);
    phase_mixer(a, shm, G);
    xcd_barrier(bar);
    { EpiRow<1> E; E.O = (bf16_t*)(ws + O_T1); E.T1 = nullptr; E.Gt = (const bf16_t*)a.out;
      run_gemm(lds, (const bf16_t*)(ws + O_OSB), (const bf16_t*)(ws + O_WSB), 1024, 512, E, G); }
    { EpiRow<2> E; E.O = (bf16_t*)(ws + O_MRG); E.T1 = (const bf16_t*)(ws + O_T1); E.Gt = (const bf16_t*)a.out;
      run_gemm(lds, (const bf16_t*)(ws + O_ORW), (const bf16_t*)(ws + O_WRW), 1024, 512, E, G); }
    xcd_barrier(bar);
    { EpiRow<0> E; E.O = (bf16_t*)(ws + O_TT); E.T1 = nullptr; E.Gt = nullptr;
      run_gemm(lds, (const bf16_t*)(ws + O_MRG), (const bf16_t*)(ws + O_WO), 1024, 1024, E, G); }
    xcd_barrier(bar);
    phase_rows<0>(a, G);
    xcd_barrier(bar);
    { EpiSwiGLU E; E.Hd = (bf16_t*)(ws + O_HID);
      run_gemm(lds, (const bf16_t*)(ws + O_H2), (const bf16_t*)(ws + O_WGU), 2 * DFF, 1024, E, G); }
    xcd_barrier(bar);
    { EpiRow<0> E; E.O = (bf16_t*)(ws + O_FF); E.T1 = nullptr; E.Gt = nullptr;
      run_gemm(lds, (const bf16_t*)(ws + O_HID), (const bf16_t*)(ws + O_WDN), 1024, DFF, E, G); }
    xcd_barrier(bar);
    phase_rows<1>(a, G);
}
}

extern "C" void kernel_launch(void* const* d_in, const int* in_sizes, int n_in, void* d_out, int out_size, void* d_ws, size_t ws_size, hipStream_t stream) {
    static int grid = 0;
    if (grid == 0) {
        if (n_in != 24 || in_sizes[0] != mk::M * mk::D || out_size != mk::M * mk::D || ws_size < mk::WS_NEED) {
            fprintf(stderr, "kernel_launch: unexpected shapes: n_in %d in0 %d out %d ws %zu (need %zu)\n", n_in, n_in > 0 ? in_sizes[0] : -1, out_size, ws_size, (size_t)mk::WS_NEED); grid = -1; return; }
        int dev = 0, cus = 0, per_cu = 0;
        hipGetDevice(&dev); hipDeviceGetAttribute(&cus, hipDeviceAttributeMultiprocessorCount, dev);
        if (hipFuncSetAttribute((const void*)mk::mega, hipFuncAttributeMaxDynamicSharedMemorySize, mk::LDS_BYTES) != hipSuccess) { fprintf(stderr, "kernel_launch: hipFuncSetAttribute failed\n"); grid = -1; return; }
        if (hipOccupancyMaxActiveBlocksPerMultiprocessor(&per_cu, (const void*)mk::mega, 512, mk::LDS_BYTES) != hipSuccess || per_cu < 1) { fprintf(stderr, "kernel_launch: occupancy query failed (%d)\n", per_cu); per_cu = 1; }
        (void)hipGetLastError();
        grid = cus * per_cu;
        fprintf(stderr, "kernel_launch: grid %d (cus %d x %d)\n", grid, cus, per_cu);
    }
    if (grid < 0) return;
    mk::Args a{};
    for (int i = 0; i < 24; ++i) a.in[i] = (const float*)d_in[i];
    a.out = (float*)d_out; a.ws = (unsigned char*)d_ws;
    a.ph_lo = 0; a.ph_hi = mk::NPH;
    if (hipMemsetAsync((char*)d_ws + mk::O_CTL, 0, mk::CTL_BYTES, stream) != hipSuccess) { fprintf(stderr, "kernel_launch: hipMemsetAsync failed\n"); return; }
    void* args[] = {&a};
    hipError_t e = hipLaunchCooperativeKernel((const void*)mk::mega, dim3(grid), dim3(512), args, mk::LDS_BYTES, stream);
    if (e != hipSuccess) fprintf(stderr, "kernel_launch: cooperative launch failed: %s (grid %d)\n", hipGetErrorString(e), grid);
}
```

```cpp
#include <hip/hip_runtime.h>
#include <hip/hip_cooperative_groups.h>
#include <cstdio>
#include <cstdint>
namespace cg = cooperative_groups;
#ifndef MK_SPLIT
#define MK_SPLIT 0
#endif
#ifndef MK_DIAG
#define MK_DIAG 0
#endif
#ifndef MK_REPMASK
#define MK_REPMASK 0
#endif
#ifndef MK_EARLY_EXIT
#define MK_EARLY_EXIT 1
#endif
namespace pg8 {
#define PG8_LAS __attribute__((address_space(3)))
typedef unsigned short bf16_t;
typedef short bf16x8 __attribute__((ext_vector_type(8)));
typedef float f32x4 __attribute__((ext_vector_type(4)));
typedef unsigned u32x4 __attribute__((ext_vector_type(4)));
constexpr int BM = 256, BK = 64, HALF = 128, HTB = HALF * BK * 2  , STAGE_BYTES = 8 * HTB, NXCD = 8, WGM = 8;

__host__ __device__ __forceinline__ int lds_byte(int r, int c) { const int st = (r >> 4) * 2 + (c >> 5), rr = r & 15, cc = c & 31, ob = rr * 64 + cc * 2; return st * 1024 + (ob ^ (((ob >> 9) & 1) << 5)); }
__host__ __device__ __forceinline__ void stage_rc(int b, int& R, int& C) { const int st = b / 1024, sb = b % 1024, swz = sb ^ (((sb >> 9) & 1) << 5); R = (st >> 1) * 16 + swz / 64; C = (st & 1) * 32 + (swz % 64) / 2; }
__host__ __device__ __forceinline__ int perm32(int rho) { const int n = rho >> 4, i = rho & 15; return 8 * (i >> 2) + 4 * n + (i & 3); }

struct Unit { int pm, pn; };
struct Gemm { const bf16_t* A; const bf16_t* Bt; int M, N, K; };

struct StaticOrder {
    int nM, nN, nwg, G, c;
    __host__ __device__ void init(int M, int N, int G_, int c_) { nM = M / BM; nN = N / BM; nwg = nM * nN; G = G_; c = c_; }
    __host__ __device__ bool next(int i, Unit& u) const {
        const long L = (long)i * G + c; if (L >= nwg) return false;
        int wgid = (int)L; { const int q = nwg / NXCD, r = nwg % NXCD, xcd = wgid % NXCD, off = wgid / NXCD; wgid = (xcd < r ? xcd * (q + 1) : r * (q + 1) + (xcd - r) * q) + off; }
        const int nig = WGM * nN, gid = wgid / nig, fm = gid * WGM, gsz = (nM - fm) < WGM ? (nM - fm) : WGM;
        u.pm = fm + ((wgid % nig) % gsz); u.pn = (wgid % nig) / gsz; return true;
    }
    __device__ __forceinline__ void a_ready(const Unit&) const {}
    __device__ __forceinline__ void done(const Unit&) const {}
};

typedef float cvt_f32x2 __attribute__((ext_vector_type(2)));
typedef __bf16 cvt_bf16x2 __attribute__((ext_vector_type(2)));
__device__ __forceinline__ unsigned cvt_pk_bf16(float lo, float hi) { const cvt_f32x2 v = {lo, hi}; return __builtin_bit_cast(unsigned, __builtin_convertvector(v, cvt_bf16x2)); }
typedef float f32x2 __attribute__((ext_vector_type(2)));

template <class Epi, class Sched, bool ALIGN_EPI = false, bool SP2 = false>
__device__ __forceinline__ void gemm_phase(PG8_LAS unsigned char* lds, const Gemm g, const Sched& S, const Epi& E) {
    int tid_ = threadIdx.x; asm volatile("" : "+v"(tid_)); const int tid = tid_, wid = __builtin_amdgcn_readfirstlane(tid >> 6), lane = tid & 63, wr = wid >> 2, wc = wid & 3, fr = lane & 15, fq = lane >> 4;
    const int K = g.K, nt = K / BK;
    unsigned voffA[2], voffB[2];
#pragma unroll
    for (int i = 0; i < 2; ++i) { int R, C; stage_rc(tid * 16 + i * 8192, R, C); const int Rb = Epi::PERM ? ((R & ~31) + perm32(R & 31)) : R;
        voffA[i] = (unsigned)(R * K + C) * 2u; voffB[i] = (unsigned)(Rb * K + C) * 2u; }
    const size_t kstep = (size_t)(BK * 2);
    const size_t hstep = (size_t)HALF * K * 2;
    const size_t tstep = 2 * hstep;
    const unsigned ldsw = (unsigned)wid * 1024u;
    const int aoff = lds_byte(wr * 64 + fr, fq * 8), boff = lds_byte(wc * 32 + fr, fq * 8);
#define PG8_SA(b, h) (((b) * 2 + (h)) * HTB)
#define PG8_SB(b, h) ((4 + (b) * 2 + (h)) * HTB)
#define PG8_STAGE(bufoff, gbase, voff) do { _Pragma("unroll") for (int _i = 0; _i < 2; ++_i) \
        __builtin_amdgcn_global_load_lds((const unsigned*)((const char*)(gbase) + (voff)[_i]), (PG8_LAS unsigned*)(lds + (bufoff) + ldsw + _i * 8192), 16, 0, 0); } while (0)
#define PG8_LDA(dst, b, h) do { _Pragma("unroll") for (int m = 0; m < 4; ++m) _Pragma("unroll") for (int k = 0; k < 2; ++k) dst[m][k] = *(const PG8_LAS bf16x8*)(lds + PG8_SA(b, h) + aoff + m * 2048 + k * 1024); } while (0)
#define PG8_LDB(dst, b, h) do { _Pragma("unroll") for (int n = 0; n < 2; ++n) _Pragma("unroll") for (int k = 0; k < 2; ++k) dst[n][k] = *(const PG8_LAS bf16x8*)(lds + PG8_SB(b, h) + boff + n * 2048 + k * 1024); } while (0)
#define PG8_MMA(ai, bj, At, Bt) do { __builtin_amdgcn_s_setprio(1); _Pragma("unroll") for (int m = 0; m < 4; ++m) _Pragma("unroll") for (int n = 0; n < 2; ++n) _Pragma("unroll") for (int k = 0; k < 2; ++k) \
        acc[ai][bj][m][n] = __builtin_amdgcn_mfma_f32_16x16x32_bf16(Bt[n][k], At[m][k], acc[ai][bj][m][n], 0, 0, 0); __builtin_amdgcn_s_setprio(0); } while (0)
#define PG8_WAIT_V(n) asm volatile("s_waitcnt vmcnt(" #n ")" ::: "memory")
#define PG8_WAIT_L(n) asm volatile("s_waitcnt lgkmcnt(" #n ")" ::: "memory")
#define PG8_BAR __builtin_amdgcn_s_barrier()
#define PG8_SCHED __builtin_amdgcn_sched_barrier(0)
    Unit cur, nxt; int ui = 0;
    if (!S.next(0, cur)) return;
    f32x4 acc[2][2][4][2];
#pragma unroll
    for (int a = 0; a < 2; ++a)
#pragma unroll
        for (int b = 0; b < 2; ++b)
#pragma unroll
            for (int m = 0; m < 4; ++m)
#pragma unroll
                for (int n = 0; n < 2; ++n) acc[a][b][m][n] = (f32x4){0.f, 0.f, 0.f, 0.f};
    bf16x8 At[4][2], B0[2][2], B1[2][2];
    const char* cA = (const char*)g.A + (size_t)cur.pm * tstep; const char* cB = (const char*)g.Bt + (size_t)cur.pn * tstep;
    S.a_ready(cur);
    if constexpr (SP2) {
        PG8_STAGE(PG8_SB(0, 0), cB, voffB); PG8_STAGE(PG8_SB(0, 1), cB + hstep, voffB); PG8_STAGE(PG8_SA(0, 0), cA, voffA); PG8_STAGE(PG8_SA(0, 1), cA + hstep, voffA);
        if (wr == 1) PG8_BAR;
        PG8_WAIT_V(2); PG8_BAR;
        PG8_STAGE(PG8_SB(1, 0), cB + kstep, voffB); PG8_STAGE(PG8_SA(1, 0), cA + kstep, voffA); PG8_STAGE(PG8_SB(1, 1), cB + hstep + kstep, voffB);
        PG8_WAIT_V(6); PG8_BAR;
    } else {
        PG8_STAGE(PG8_SB(0, 0), cB, voffB); PG8_STAGE(PG8_SA(0, 0), cA, voffA); PG8_STAGE(PG8_SB(0, 1), cB + hstep, voffB); PG8_STAGE(PG8_SA(0, 1), cA + hstep, voffA);
        if (wr == 1) PG8_BAR;
        PG8_WAIT_V(4); PG8_BAR;
        PG8_STAGE(PG8_SB(1, 0), cB + kstep, voffB); PG8_STAGE(PG8_SA(1, 0), cA + kstep, voffA); PG8_STAGE(PG8_SB(1, 1), cB + hstep + kstep, voffB);
        PG8_WAIT_V(6); PG8_BAR;
    }
    for (;;) {
        const bool has_next = S.next(ui + 1, nxt);
        const char* nA = has_next ? (const char*)g.A + (size_t)nxt.pm * tstep : cA; const char* nB = has_next ? (const char*)g.Bt + (size_t)nxt.pn * tstep : cB;
        for (int t = 0; t < nt; t += 2) {
            const bool last = (t == nt - 2);
            const char* a1 = cA + (size_t)(t + 1) * kstep;
            const char* a2 = last ? nA : cA + (size_t)(t + 2) * kstep; const char* b2 = last ? nB : cB + (size_t)(t + 2) * kstep;
            const char* a3 = a2 + kstep; const char* b3 = b2 + kstep;
            if (last && has_next) S.a_ready(nxt);
            if constexpr (SP2) {
            PG8_LDB(B0, 0, 0); PG8_LDB(B1, 0, 1); PG8_SCHED; PG8_LDA(At, 0, 0); PG8_STAGE(PG8_SA(1, 1), a1 + hstep, voffA);
            PG8_WAIT_V(8); PG8_WAIT_L(0); PG8_BAR; PG8_MMA(0, 0, At, B0); PG8_MMA(0, 1, At, B1); PG8_BAR; PG8_SCHED;
            PG8_LDA(At, 0, 1); PG8_STAGE(PG8_SB(0, 0), b2, voffB); PG8_STAGE(PG8_SB(0, 1), b2 + hstep, voffB); PG8_STAGE(PG8_SA(0, 0), a2, voffA);
            PG8_WAIT_V(8); PG8_WAIT_L(0); PG8_BAR; PG8_MMA(1, 0, At, B0); PG8_MMA(1, 1, At, B1); PG8_BAR; PG8_SCHED;
            PG8_LDB(B0, 1, 0); PG8_LDB(B1, 1, 1); PG8_SCHED; PG8_LDA(At, 1, 0); PG8_STAGE(PG8_SA(0, 1), a2 + hstep, voffA);
            PG8_WAIT_V(8); PG8_WAIT_L(0); PG8_BAR; PG8_MMA(0, 0, At, B0); PG8_MMA(0, 1, At, B1); PG8_BAR; PG8_SCHED;
            PG8_LDA(At, 1, 1); PG8_STAGE(PG8_SB(1, 0), b3, voffB); PG8_STAGE(PG8_SB(1, 1), b3 + hstep, voffB); PG8_STAGE(PG8_SA(1, 0), a3, voffA);
            PG8_WAIT_V(8); PG8_WAIT_L(0); PG8_BAR; PG8_MMA(1, 0, At, B0); PG8_MMA(1, 1, At, B1); PG8_BAR; PG8_SCHED;
            } else {
            PG8_LDB(B0, 0, 0); PG8_SCHED; PG8_LDA(At, 0, 0); PG8_STAGE(PG8_SA(1, 1), a1 + hstep, voffA);
            PG8_WAIT_L(8); PG8_BAR; PG8_WAIT_L(0); PG8_MMA(0, 0, At, B0); PG8_BAR; PG8_SCHED;
            PG8_LDB(B1, 0, 1); PG8_STAGE(PG8_SB(0, 0), b2, voffB);
            PG8_BAR; PG8_WAIT_L(0); PG8_MMA(0, 1, At, B1); PG8_BAR;
            PG8_LDA(At, 0, 1); PG8_STAGE(PG8_SA(0, 0), a2, voffA);
            PG8_BAR; PG8_WAIT_L(0); PG8_MMA(1, 0, At, B0); PG8_BAR; PG8_SCHED;
            PG8_STAGE(PG8_SB(0, 1), b2 + hstep, voffB);
            PG8_WAIT_V(6); PG8_BAR; PG8_MMA(1, 1, At, B1); PG8_BAR;
            PG8_LDB(B0, 1, 0); PG8_SCHED; PG8_LDA(At, 1, 0); PG8_STAGE(PG8_SA(0, 1), a2 + hstep, voffA);
            PG8_WAIT_L(8); PG8_BAR; PG8_WAIT_L(0); PG8_MMA(0, 0, At, B0); PG8_BAR; PG8_SCHED;
            PG8_LDB(B1, 1, 1); PG8_STAGE(PG8_SB(1, 0), b3, voffB);
            PG8_BAR; PG8_WAIT_L(0); PG8_MMA(0, 1, At, B1); PG8_BAR;
            PG8_LDA(At, 1, 1); PG8_STAGE(PG8_SA(1, 0), a3, voffA);
            PG8_BAR; PG8_WAIT_L(0); PG8_MMA(1, 0, At, B0); PG8_BAR; PG8_SCHED;
            PG8_STAGE(PG8_SB(1, 1), b3 + hstep, voffB);
            PG8_WAIT_V(6); PG8_BAR; PG8_MMA(1, 1, At, B1); PG8_BAR;
            }
        }
        if constexpr (ALIGN_EPI) { if (wr == 0) PG8_BAR; }
        if constexpr (!Epi::AFTER_DRAIN) { E(acc, cur, wr, wc, fr, fq); S.done(cur); }
        if (!has_next) break;
#pragma unroll
        for (int a = 0; a < 2; ++a)
#pragma unroll
            for (int b = 0; b < 2; ++b)
#pragma unroll
                for (int m = 0; m < 4; ++m)
#pragma unroll
                    for (int n = 0; n < 2; ++n) acc[a][b][m][n] = (f32x4){0.f, 0.f, 0.f, 0.f};
        cur = nxt; cA = nA; cB = nB; ++ui;
        if constexpr (ALIGN_EPI) { if (wr == 1) PG8_BAR; }
    }
    PG8_WAIT_V(0);
    if constexpr (!ALIGN_EPI) { if (wr == 0) PG8_BAR; }
    PG8_BAR;
    if constexpr (Epi::AFTER_DRAIN) { E.fused(acc, cur, wr, wc, fr, fq, lds, wid, lane); S.done(cur); }
#undef PG8_SA
#undef PG8_SB
#undef PG8_STAGE
#undef PG8_LDA
#undef PG8_LDB
#undef PG8_MMA
#undef PG8_WAIT_V
#undef PG8_WAIT_L
#undef PG8_BAR
#undef PG8_SCHED
}

}
namespace mk {
using pg8::bf16_t; using pg8::bf16x8; using pg8::f32x4; using pg8::u32x4; using pg8::cvt_pk_bf16;
typedef float f32x16 __attribute__((ext_vector_type(16)));
typedef float f32x2 __attribute__((ext_vector_type(2)));
typedef unsigned u32x2 __attribute__((ext_vector_type(2)));
constexpr int D = 1024, NB = 32, SEQ = 2048, M = NB * SEQ, NH = 8, DH = 64;
constexpr int RWC = 1792, GC = 2048, INC = 5376, DFF = 2816;
constexpr float RMS_EPS = 1e-6f, GN_EPS = 64e-5f;
constexpr size_t MiB = (size_t)1 << 20;
constexpr size_t O_WIN = 0, O_WSB = 11 * MiB, O_WRW = 12 * MiB, O_WO = 13 * MiB, O_WGU = 15 * MiB, O_WDN = 26 * MiB, O_WLU = 32 * MiB  , O_WLA = O_WLU + 65536, O_WLG = O_WLA + 65536;
constexpr size_t O_Q = 34 * MiB, O_K = 98 * MiB, O_VT = 162 * MiB, O_PRW = 226 * MiB, O_H = 450 * MiB, O_SI = 450 * MiB, O_G = 834 * MiB, O_SC = 898 * MiB, O_YR = 290 * MiB  ;
constexpr size_t O_OSB = 226 * MiB, O_ORW = 34 * MiB, O_T1 = 98 * MiB, O_MRG = 450 * MiB, O_TT = 34 * MiB, O_H2 = 162 * MiB, O_HID = 290 * MiB, O_FF = 34 * MiB;
constexpr size_t O_X1B = 706 * MiB;
constexpr size_t WS_NEED = 1009 * MiB;
constexpr int LDS_BYTES = pg8::STAGE_BYTES + 64;
constexpr size_t O_CTL = 1008 * MiB, CTL_BYTES = 65536;
constexpr int NPH = 12;

struct Args { const float* in[24]; float* out; unsigned char* ws; int ph_lo, ph_hi; };

__device__ __forceinline__ int my_tid() { int t = threadIdx.x; asm volatile("" : "+v"(t)); return t; }
__device__ __forceinline__ float bf_lo(unsigned u) { return __uint_as_float(u << 16); }
__device__ __forceinline__ float bf_hi(unsigned u) { return __uint_as_float(u & 0xffff0000u); }
__device__ __forceinline__ float fexp(float x) { return __builtin_amdgcn_exp2f(x * 1.44269504089f); }
__device__ __forceinline__ float flog(float x) { return __builtin_amdgcn_logf(x) * 0.69314718056f; }
__device__ __forceinline__ float frcp(float x) { return __builtin_amdgcn_rcpf(x); }
__device__ __forceinline__ float fsigmoid(float x) { return frcp(1.f + fexp(-x)); }
__device__ __forceinline__ unsigned short bf1(float x) { return (unsigned short)(cvt_pk_bf16(x, x) & 0xffffu); }
__device__ __forceinline__ u32x4 pack8(const f32x4 a, const f32x4 b) { u32x4 o; o.x = cvt_pk_bf16(a[0], a[1]); o.y = cvt_pk_bf16(a[2], a[3]); o.z = cvt_pk_bf16(b[0], b[1]); o.w = cvt_pk_bf16(b[2], b[3]); return o; }
__device__ __forceinline__ float red16(float v) {
    v += __shfl_xor(v, 16); v += __shfl_xor(v, 32); return v;
}
__device__ __forceinline__ float wave_sum(float v) {
#pragma unroll
    for (int o = 1; o < 64; o <<= 1) v += __shfl_xor(v, o);
    return v;
}

__device__ __forceinline__ void tr_item(const float* __restrict__ W, int K, int N, bf16_t* WT, float* scr, int item, int lane, int mode) {
    const int nblk = N >> 5, kb = item / nblk, nb = item - kb * nblk, k0 = kb << 6, n0 = nb << 5;
#pragma unroll 8
    for (int i = 0; i < 32; ++i) { const int kk = 2 * i + (lane >> 5); scr[kk * 33 + (lane & 31)] = W[(size_t)(k0 + kk) * N + n0 + (lane & 31)]; }
    asm volatile("s_waitcnt lgkmcnt(0)" ::: "memory"); __builtin_amdgcn_wave_barrier();
    const int c = lane & 7;
#pragma unroll
    for (int j = 0; j < 4; ++j) {
        const int n = (lane >> 3) + 8 * j; const float* s = scr + (8 * c) * 33 + n;
        u32x4 o; o.x = cvt_pk_bf16(s[0 * 33], s[1 * 33]); o.y = cvt_pk_bf16(s[2 * 33], s[3 * 33]); o.z = cvt_pk_bf16(s[4 * 33], s[5 * 33]); o.w = cvt_pk_bf16(s[6 * 33], s[7 * 33]);
        const int nn = n0 + n; int drow = nn;
        if (mode == 1) drow = ((nn >> 7) << 8) + (nn & 127); else if (mode == 2) drow = ((nn >> 7) << 8) + 128 + (nn & 127);
        *(u32x4*)(WT + (size_t)drow * K + k0 + 8 * c) = o;
    }
    asm volatile("s_waitcnt lgkmcnt(0)" ::: "memory"); __builtin_amdgcn_wave_barrier();
}

__device__ __forceinline__ void phase_prep(const Args& a, float* lds_f, int G) {
    const int tid = my_tid(); const int wave = tid >> 6, lane = tid & 63;
    const int gw = blockIdx.x * 8 + wave, NGW = G * 8;
    float* scr = lds_f + wave * (64 * 33 + 16);
    unsigned char* ws = a.ws;
    constexpr int I_IN = 16 * 168, I_SB = 8 * 32, I_O = 16 * 32, I_G = 16 * 88, I_DN = 44 * 32, I_LU = 16, I_LG = 32;
    constexpr int NIT = I_IN + 2 * I_SB + I_O + 2 * I_G + I_DN + 2 * I_LU + I_LG;
    for (int it = gw; it < NIT; it += NGW) {
        int r = it;
        if (r < I_IN) { tr_item(a.in[2], 1024, INC, (bf16_t*)(ws + O_WIN), scr, r, lane, 0); continue; } r -= I_IN;
        if (r < I_SB) { tr_item(a.in[15], 512, 1024, (bf16_t*)(ws + O_WSB), scr, r, lane, 0); continue; } r -= I_SB;
        if (r < I_SB) { tr_item(a.in[16], 512, 1024, (bf16_t*)(ws + O_WRW), scr, r, lane, 0); continue; } r -= I_SB;
        if (r < I_O) { tr_item(a.in[17], 1024, 1024, (bf16_t*)(ws + O_WO), scr, r, lane, 0); continue; } r -= I_O;
        if (r < I_G) { tr_item(a.in[20], 1024, DFF, (bf16_t*)(ws + O_WGU), scr, r, lane, 1); continue; } r -= I_G;
        if (r < I_G) { tr_item(a.in[21], 1024, DFF, (bf16_t*)(ws + O_WGU), scr, r, lane, 2); continue; } r -= I_G;
        if (r < I_DN) { tr_item(a.in[22], DFF, 1024, (bf16_t*)(ws + O_WDN), scr, r, lane, 0); continue; } r -= I_DN;
        if (r < I_LU) { tr_item(a.in[6], 64, 512, (bf16_t*)(ws + O_WLU), scr, r, lane, 0); continue; } r -= I_LU;
        if (r < I_LU) { tr_item(a.in[8], 64, 512, (bf16_t*)(ws + O_WLA), scr, r, lane, 0); continue; } r -= I_LU;
        tr_item(a.in[9], 128, 512, (bf16_t*)(ws + O_WLG), scr, r, lane, 0);
    }
    const float* x = a.in[0]; const float* g = a.in[1]; bf16_t* H = (bf16_t*)(ws + O_H);
    f32x4 gv[4];
#pragma unroll
    for (int j = 0; j < 4; ++j) gv[j] = ((const f32x4*)g)[lane + 64 * j];
    for (int row0 = gw; row0 < M; row0 += 2 * NGW) {
        f32x4 v[2][4];
#pragma unroll
        for (int u = 0; u < 2; ++u) { const int row = (row0 + u * NGW < M) ? row0 + u * NGW : row0; const f32x4* xr = (const f32x4*)(x + (size_t)row * D) + lane;
#pragma unroll
            for (int j = 0; j < 4; ++j) v[u][j] = __builtin_nontemporal_load(xr + 64 * j); }
#pragma unroll
        for (int u = 0; u < 2; ++u) { const int row = row0 + u * NGW; float s = 0.f;
#pragma unroll
            for (int j = 0; j < 4; ++j) s += (v[u][j][0] * v[u][j][0] + v[u][j][1] * v[u][j][1]) + (v[u][j][2] * v[u][j][2] + v[u][j][3] * v[u][j][3]);
            const float rs = rsqrtf(wave_sum(s) * (1.f / D) + RMS_EPS);
            if (row < M) { u32x2* o = (u32x2*)(H + (size_t)row * D) + lane;
#pragma unroll
                for (int j = 0; j < 4; ++j) { u32x2 w; w.x = cvt_pk_bf16(v[u][j][0] * rs * gv[j][0], v[u][j][1] * rs * gv[j][1]); w.y = cvt_pk_bf16(v[u][j][2] * rs * gv[j][2], v[u][j][3] * rs * gv[j][3]); o[64 * j] = w; } }
        }
    }
}

struct Epi1 {
    static constexpr bool PERM = true, AFTER_DRAIN = false;
    bf16_t *Q, *Kb, *Vt, *Prw, *Gt; const float* bgate;
    __device__ __forceinline__ void operator()(const f32x4 (&acc)[2][2][4][2], const pg8::Unit& u, int wr, int wc, int fr, int fq) const {
        const int row0 = u.pm * 256 + wr * 64 + fr, pn = u.pn, cl = wc * 32 + 8 * fq;
        if (pn < 4) {
            bf16_t* dst = pn < 2 ? Q : Kb; const float sc = pn < 2 ? 0.125f : 1.f; const int cb = (pn & 1) * 256 + cl;
#pragma unroll
            for (int ai = 0; ai < 2; ++ai)
#pragma unroll
                for (int m = 0; m < 4; ++m) { bf16_t* rp = dst + (size_t)(row0 + ai * 128 + m * 16) * 512 + cb;
#pragma unroll
                    for (int bj = 0; bj < 2; ++bj) *(u32x4*)(rp + bj * 128) = pack8(acc[ai][bj][m][0] * sc, acc[ai][bj][m][1] * sc); }
        } else if (pn < 6) {
#pragma unroll
            for (int ai = 0; ai < 2; ++ai)
#pragma unroll
                for (int m = 0; m < 4; ++m) { const int row = row0 + ai * 128 + m * 16, b = row >> 11, s = row & 2047;
#pragma unroll
                    for (int bj = 0; bj < 2; ++bj)
#pragma unroll
                        for (int n = 0; n < 2; ++n)
#pragma unroll
                            for (int j = 0; j < 4; ++j) { const int c = (pn - 4) * 256 + bj * 128 + cl + 4 * n + j;
                                Vt[((size_t)(b * 512 + c)) * 2048 + s] = bf1(acc[ai][bj][m][n][j]); } }
        } else if (pn < 13) {
            const int cb = (pn - 6) * 256 + cl;
#pragma unroll
            for (int ai = 0; ai < 2; ++ai)
#pragma unroll
                for (int m = 0; m < 4; ++m) { bf16_t* rp = Prw + (size_t)(row0 + ai * 128 + m * 16) * RWC + cb;
#pragma unroll
                    for (int bj = 0; bj < 2; ++bj) *(u32x4*)(rp + bj * 128) = pack8(acc[ai][bj][m][0], acc[ai][bj][m][1]); }
        } else {
            const int cb = (pn - 13) * 256 + cl;
#pragma unroll
            for (int ai = 0; ai < 2; ++ai)
#pragma unroll
                for (int m = 0; m < 4; ++m) { bf16_t* rp = Gt + (size_t)(row0 + ai * 128 + m * 16) * GC + cb;
#pragma unroll
                    for (int bj = 0; bj < 2; ++bj) { f32x4 v0 = acc[ai][bj][m][0] + *(const f32x4*)(bgate + cb + bj * 128), v1 = acc[ai][bj][m][1] + *(const f32x4*)(bgate + cb + bj * 128 + 4);
#pragma unroll
                        for (int j = 0; j < 4; ++j) { v0[j] = fsigmoid(v0[j]); v1[j] = fsigmoid(v1[j]); }
                        *(u32x4*)(rp + bj * 128) = pack8(v0, v1); } }
        }
    }
};
template <int MODE> struct EpiRow {
    static constexpr bool PERM = true, AFTER_DRAIN = false;
    bf16_t* O; const bf16_t* T1; const bf16_t* Gt;
    __device__ __forceinline__ void operator()(const f32x4 (&acc)[2][2][4][2], const pg8::Unit& u, int wr, int wc, int fr, int fq) const {
        const int row0 = u.pm * 256 + wr * 64 + fr, cb = u.pn * 256 + wc * 32 + 8 * fq;
#pragma unroll
        for (int ai = 0; ai < 2; ++ai)
#pragma unroll
            for (int m = 0; m < 4; ++m) { const size_t row = (size_t)(row0 + ai * 128 + m * 16);
#pragma unroll
                for (int bj = 0; bj < 2; ++bj) { f32x4 v0 = acc[ai][bj][m][0], v1 = acc[ai][bj][m][1]; const int c = cb + bj * 128;
                    if (MODE >= 1) { const u32x4 gg = *(const u32x4*)(Gt + row * GC + (MODE == 2 ? 1024 : 0) + c);
                        v0[0] *= bf_lo(gg.x); v0[1] *= bf_hi(gg.x); v0[2] *= bf_lo(gg.y); v0[3] *= bf_hi(gg.y); v1[0] *= bf_lo(gg.z); v1[1] *= bf_hi(gg.z); v1[2] *= bf_lo(gg.w); v1[3] *= bf_hi(gg.w); }
                    if (MODE == 2) { const u32x4 tt = *(const u32x4*)(T1 + row * 1024 + c);
                        v0[0] += bf_lo(tt.x); v0[1] += bf_hi(tt.x); v0[2] += bf_lo(tt.y); v0[3] += bf_hi(tt.y); v1[0] += bf_lo(tt.z); v1[1] += bf_hi(tt.z); v1[2] += bf_lo(tt.w); v1[3] += bf_hi(tt.w); }
                    *(u32x4*)(O + row * 1024 + c) = pack8(v0, v1); } }
    }
};
struct EpiSwiGLU {
    static constexpr bool PERM = true, AFTER_DRAIN = false;
    bf16_t* Hd;
    __device__ __forceinline__ void operator()(const f32x4 (&acc)[2][2][4][2], const pg8::Unit& u, int wr, int wc, int fr, int fq) const {
        const int row0 = u.pm * 256 + wr * 64 + fr, cb = u.pn * 128 + wc * 32 + 8 * fq;
#pragma unroll
        for (int ai = 0; ai < 2; ++ai)
#pragma unroll
            for (int m = 0; m < 4; ++m) { f32x4 v0, v1;
#pragma unroll
                for (int j = 0; j < 4; ++j) { const float g0 = acc[ai][0][m][0][j], g1 = acc[ai][0][m][1][j];
                    v0[j] = g0 * fsigmoid(g0) * acc[ai][1][m][0][j]; v1[j] = g1 * fsigmoid(g1) * acc[ai][1][m][1][j]; }
                *(u32x4*)(Hd + (size_t)(row0 + ai * 128 + m * 16) * DFF + cb) = pack8(v0, v1); }
    }
};
template <class Epi> __device__ __forceinline__ void run_gemm(PG8_LAS unsigned char* lds, const bf16_t* A, const bf16_t* Bt, int N, int K, const Epi& E, int G) {
    pg8::Gemm g; g.A = A; g.Bt = Bt; g.M = M; g.N = N; g.K = K;
    pg8::StaticOrder S; S.init(M, N, G, (int)blockIdx.x);
    pg8::gemm_phase<Epi, pg8::StaticOrder, true, true>(lds, g, S, E);
}
__device__ __forceinline__ void mix8_lds(const unsigned char* cur, const unsigned char* prv, const float* mu, float (&o)[8]) {
    const u32x4 c = *(const u32x4*)cur, p = *(const u32x4*)prv;
    const f32x4 m0 = *(const f32x4*)mu, m1 = *(const f32x4*)(mu + 4);
    const float mm[8] = {m0[0], m0[1], m0[2], m0[3], m1[0], m1[1], m1[2], m1[3]};
#pragma unroll
    for (int i = 0; i < 4; ++i) { const float cl = bf_lo(c[i]), ch = bf_hi(c[i]), pl = bf_lo(p[i]), ph = bf_hi(p[i]);
        o[2 * i] = cl + (pl - cl) * mm[2 * i]; o[2 * i + 1] = ch + (ph - ch) * mm[2 * i + 1]; }
}
__device__ __forceinline__ void mix4_lds(const unsigned char* cur, const unsigned char* prv, const float* mu, float (&o)[4]) {
    const u32x2 c = *(const u32x2*)cur, p = *(const u32x2*)prv;
    const f32x4 m0 = *(const f32x4*)mu;
#pragma unroll
    for (int i = 0; i < 2; ++i) { const float cl = bf_lo(c[i]), ch = bf_hi(c[i]), pl = bf_lo(p[i]), ph = bf_hi(p[i]);
        o[2 * i] = cl + (pl - cl) * m0[2 * i]; o[2 * i + 1] = ch + (ph - ch) * m0[2 * i + 1]; }
}
__device__ __forceinline__ bf16x8 pack_frag(const float (&v)[8]) {
    u32x4 o; o.x = cvt_pk_bf16(v[0], v[1]); o.y = cvt_pk_bf16(v[2], v[3]); o.z = cvt_pk_bf16(v[4], v[5]); o.w = cvt_pk_bf16(v[6], v[7]);
    return __builtin_bit_cast(bf16x8, o);
}
__device__ __forceinline__ void phase_rwprep(const Args& a, unsigned char* lds, int G) {
    constexpr int ROWB = 3600, L_FRAG = 17 * ROWB, L_PAR = L_FRAG + 8192, NCH = 17 * 224, NT = M / 16;
    const int tid = my_tid(); const int wave = __builtin_amdgcn_readfirstlane(tid >> 6), lane = tid & 63, fr = lane & 15, fq = lane >> 4;
    unsigned char* ws = a.ws;
    const unsigned char* PRW = ws + O_PRW;
    const bf16_t* WLU = (const bf16_t*)(ws + O_WLU); const bf16_t* WLA = (const bf16_t*)(ws + O_WLA); const bf16_t* WLG = (const bf16_t*)(ws + O_WLG);
    unsigned char* SI = ws + O_SI; bf16_t* GB = (bf16_t*)(ws + O_G); float* SC = (float*)(ws + O_SC);
    float* par = (float*)(lds + L_PAR);
    for (int i = tid; i < 1792 + 5 * 512; i += 512) {
        float v;
        if (i < 1792) v = a.in[4][i]; else { const int j = i - 1792, w = j >> 9, c = j & 511; v = (w == 0 ? a.in[5] : w == 1 ? a.in[7] : w == 2 ? a.in[10] : w == 3 ? a.in[11] : a.in[12])[c]; }
        par[i] = v;
    }
    for (int tile = blockIdx.x; tile < NT; tile += G) {
        __syncthreads();
        {   u32x4 pre[8];
#pragma unroll
            for (int j = 0; j < 8; ++j) { const int c = tid + 512 * j; pre[j] = (u32x4){0u, 0u, 0u, 0u};
                if (c < NCH) { const int row = c / 224, col = c - row * 224; const bool zero = (row == 0) && (((tile * 16) & (SEQ - 1)) == 0);
                    if (!zero) pre[j] = __builtin_nontemporal_load((const u32x4*)(PRW + ((size_t)tile * 16 + row - 1) * (RWC * 2) + col * 16)); } }
#pragma unroll
            for (int j = 0; j < 8; ++j) { const int c = tid + 512 * j; if (c < NCH) { const int row = c / 224, col = c - row * 224; *(u32x4*)(lds + row * ROWB + col * 16) = pre[j]; } }
        }
        __syncthreads();
        const unsigned char* rcur = lds + (fr + 1) * ROWB; const unsigned char* rprv = lds + fr * ROWB;
        {
            const int colb = wave < 2 ? 1536 + 32 * wave : (wave < 4 ? 1600 + 32 * (wave - 2) : 1664 + 32 * (wave - 4));
            float t8[8]; mix8_lds(rcur + (colb + 8 * fq) * 2, rprv + (colb + 8 * fq) * 2, par + colb + 8 * fq, t8);
            if (wave < 2) {
#pragma unroll
                for (int i = 0; i < 8; ++i) { const float e = fexp(2.f * t8[i]); t8[i] = 1.f - 2.f * frcp(e + 1.f); } }
            else if (wave >= 4) {
#pragma unroll
                for (int i = 0; i < 8; ++i) t8[i] = fsigmoid(t8[i]); }
            *(bf16x8*)(lds + L_FRAG + wave * 1024 + lane * 16) = pack_frag(t8);
        }
        __syncthreads();
        bf16x8 Aw[2], Aa[2], Ag[4];
#pragma unroll
        for (int s = 0; s < 2; ++s) { Aw[s] = *(const bf16x8*)(lds + L_FRAG + s * 1024 + lane * 16); Aa[s] = *(const bf16x8*)(lds + L_FRAG + (2 + s) * 1024 + lane * 16); }
#pragma unroll
        for (int s = 0; s < 4; ++s) Ag[s] = *(const bf16x8*)(lds + L_FRAG + (4 + s) * 1024 + lane * 16);
        const int h = wave; const size_t m = (size_t)tile * 16 + fr;
        float kkr[16], av[16]; unsigned lk[16], rvp[16];
        float ss = 0.f, brs = 0.f, krs = 0.f, rkbs = 0.f;
#pragma unroll
        for (int n = 0; n < 4; ++n) {
            asm volatile("" ::: "memory");
            const int cb = 64 * h + 16 * n, c0 = cb + 4 * fq;
            f32x4 aw = {0.f, 0.f, 0.f, 0.f}, aa = aw, ag = aw;
#pragma unroll
            for (int s = 0; s < 2; ++s) {
                aw = __builtin_amdgcn_mfma_f32_16x16x32_bf16(*(const bf16x8*)(WLU + (size_t)(cb + fr) * 64 + 32 * s + 8 * fq), Aw[s], aw, 0, 0, 0);
                aa = __builtin_amdgcn_mfma_f32_16x16x32_bf16(*(const bf16x8*)(WLA + (size_t)(cb + fr) * 64 + 32 * s + 8 * fq), Aa[s], aa, 0, 0, 0); }
#pragma unroll
            for (int s = 0; s < 4; ++s)
                ag = __builtin_amdgcn_mfma_f32_16x16x32_bf16(*(const bf16x8*)(WLG + (size_t)(cb + fr) * 128 + 32 * s + 8 * fq), Ag[s], ag, 0, 0, 0);
            float rr[4], kr4[4], vv[4];
            mix4_lds(rcur + c0 * 2, rprv + c0 * 2, par + c0, rr); mix4_lds(rcur + (512 + c0) * 2, rprv + (512 + c0) * 2, par + 512 + c0, kr4); mix4_lds(rcur + (1024 + c0) * 2, rprv + (1024 + c0) * 2, par + 1024 + c0, vv);
            const f32x4 w0v = *(const f32x4*)(par + 1792 + c0), a0v = *(const f32x4*)(par + 2304 + c0), kkv = *(const f32x4*)(par + 2816 + c0), kav = *(const f32x4*)(par + 3328 + c0), rkv = *(const f32x4*)(par + 3840 + c0);
#pragma unroll
            for (int j = 0; j < 4; ++j) {
                const float sg = fsigmoid(w0v[j] + aw[j]);
                const float ldx = -0.60653065971f * 1.44269504089f * sg;
                const float av_ = fsigmoid(a0v[j] + aa[j]);
                const float kkraw = kr4[j] * kkv[j];
                const float k2 = kr4[j] * (1.f + (av_ - 1.f) * kav[j]);
                ss += kkraw * kkraw; brs += kkraw * av_ * rr[j]; krs += k2 * rr[j]; rkbs += rr[j] * k2 * rkv[j];
                kkr[4 * n + j] = kkraw; av[4 * n + j] = av_; lk[4 * n + j] = cvt_pk_bf16(ldx, k2); rvp[4 * n + j] = cvt_pk_bf16(rr[j], vv[j]);
            }
            u32x2 gp; gp.x = cvt_pk_bf16(ag[0], ag[1]); gp.y = cvt_pk_bf16(ag[2], ag[3]);
            *(u32x2*)(GB + m * 512 + c0) = gp;
        }
        ss = red16(ss); brs = red16(brs); krs = red16(krs); rkbs = red16(rkbs);
        const float inv = 1.f / fmaxf(sqrtf(ss), 1e-12f);
        unsigned char* rec = SI + (m * 8 + h) * 768 + fq * 16;
#pragma unroll
        for (int n = 0; n < 4; ++n) {
            unsigned dw[12];
#pragma unroll
            for (int j = 0; j < 4; ++j) { const float kk = kkr[4 * n + j] * inv;
                const unsigned kp = cvt_pk_bf16(kk * av[4 * n + j], -kk);
                dw[3 * j] = (lk[4 * n + j] & 0xffffu) | (kp & 0xffff0000u); dw[3 * j + 1] = (kp & 0xffffu) | (lk[4 * n + j] & 0xffff0000u); dw[3 * j + 2] = rvp[4 * n + j]; }
            unsigned char* dst = rec + 64 * n;
            u32x4 s0 = {dw[0], dw[3], dw[6], dw[9]}, s1 = {dw[1], dw[4], dw[7], dw[10]}, s2 = {dw[2], dw[5], dw[8], dw[11]};
            *(u32x4*)dst = s0; *(u32x4*)(dst + 256) = s1; *(u32x4*)(dst + 512) = s2;
        }
        if (fq == 0) { f32x4 scv = {brs * inv, krs, rkbs, 0.f}; *(f32x4*)(SC + (m * 8 + h) * 4) = scv; }
    }
    __syncthreads();
}

__device__ __forceinline__ float red_rows(float x) {
    float a0 = x, a1 = x;
    asm volatile("s_nop 1\n\tv_permlane16_swap_b32 %0, %1" : "+v"(a0), "+v"(a1));
    float b0 = a0 + a1, b1 = b0;
    asm volatile("s_nop 1\n\tv_permlane32_swap_b32 %0, %1" : "+v"(b0), "+v"(b1));
    return b0 + b1;
}
constexpr int SC_T = 16, SC_ROW = 1280, SC_GEND = SC_T * SC_ROW, SC_BUF = SC_GEND + 256;
struct ProdRec { unsigned d0[SC_T]; unsigned d1[4], d2[4]; };
__device__ __forceinline__ void prod_load(ProdRec& P, const unsigned char* sb, int chunk, int pw, int col) {
    const unsigned char* p = sb + (size_t)chunk * SC_T * 6144 + col * 4;
#pragma unroll
    for (int st = 0; st < SC_T; ++st) P.d0[st] = *(const unsigned*)(p + st * 6144);
#pragma unroll
    for (int q = 0; q < 4; ++q) { P.d1[q] = *(const unsigned*)(p + (4 * pw + q) * 6144 + 256); P.d2[q] = *(const unsigned*)(p + (4 * pw + q) * 6144 + 512); }
}
__device__ __forceinline__ void prod_store(const ProdRec& P, unsigned char* buf, int pw, int col) {
    float L = 0.f;
#pragma unroll
    for (int st = 0; st < SC_T; ++st) {
        const float Lp = L; L += bf_lo(P.d0[st]);
        if ((st >> 2) == pw) { const int q = st & 3; unsigned char* base = buf + st * SC_ROW + col * 4;
            const float gp = __builtin_amdgcn_exp2f(Lp), g = __builtin_amdgcn_exp2f(L), ig = __builtin_amdgcn_exp2f(-L);
            *(float*)(base) = gp * bf_hi(P.d0[st]); *(float*)(base + 256) = g * bf_lo(P.d2[q]);
            *(float*)(base + 512) = bf_lo(P.d1[q]) * ig; *(float*)(base + 768) = bf_hi(P.d1[q]) * ig; *(float*)(base + 1024) = bf_hi(P.d2[q]); }
    }
    if (pw == 0) *(float*)(buf + SC_GEND + col * 4) = __builtin_amdgcn_exp2f(L);
}
#define MK_SWAP32(a, b) asm volatile("s_nop 1\n\tv_permlane32_swap_b32 %0, %1" : "+v"(a), "+v"(b))
#define MK_SWAP16(a, b) asm volatile("s_nop 1\n\tv_permlane16_swap_b32 %0, %1" : "+v"(a), "+v"(b))
__device__ __forceinline__ void red4x8(float& A, float& B, float& C, float& D) {
    MK_SWAP32(A, B); float u = A + B;
    MK_SWAP32(C, D); float w = C + D;
    MK_SWAP16(u, w); float z = u + w;
    float z1;
    asm volatile("s_nop 1\n\tv_add_f32_dpp %0, %1, %1 row_ror:8 row_mask:0xf bank_mask:0xf" : "=&v"(z1) : "v"(z));
    float p = z1, q = z1; MK_SWAP32(p, q);
    float p2 = p; MK_SWAP16(p, p2);
    float q2 = q; MK_SWAP16(q, q2);
    A = p; C = p2; B = q; D = q2;
}
__device__ __forceinline__ void red2x8(float& A, float& B) {
    MK_SWAP32(A, B); float u = A + B;
    float uc = u; MK_SWAP16(u, uc); float z = u + uc;
    float z1;
    asm volatile("s_nop 1\n\tv_add_f32_dpp %0, %1, %1 row_ror:8 row_mask:0xf bank_mask:0xf" : "=&v"(z1) : "v"(z));
    float p = z1, q = z1; MK_SWAP32(p, q);
    A = p; B = q;
}
__device__ __forceinline__ void scan_consume(f32x2 (&S)[8], const unsigned char* buf, unsigned char* ybuf, int lane, int rb) {
    const unsigned co = (unsigned)(lane >> 3) * 32u, vo = 1024u + (unsigned)(16 * rb + (lane & 7)) * 4u;
#pragma unroll 4
    for (int st = 0; st < SC_T; ++st) {
        const unsigned char* sb = buf + st * SC_ROW;
        f32x4 n4[2], r4[2], a4[2], k4[2];
#pragma unroll
        for (int q = 0; q < 2; ++q) { n4[q] = *(const f32x4*)(sb + co + 16 * q); r4[q] = *(const f32x4*)(sb + 256 + co + 16 * q);
            a4[q] = *(const f32x4*)(sb + 512 + co + 16 * q); k4[q] = *(const f32x4*)(sb + 768 + co + 16 * q); }
        const float v0 = *(const float*)(sb + vo), v1 = *(const float*)(sb + vo + 32);
        f32x2 sa0v = {0.f, 0.f}, sa1v = sa0v, yp0v = sa0v, yp1v = sa0v;
#pragma unroll
        for (int p = 0; p < 4; ++p) { const f32x2 nn = {n4[p >> 1][2 * (p & 1)], n4[p >> 1][2 * (p & 1) + 1]}, rr2 = {r4[p >> 1][2 * (p & 1)], r4[p >> 1][2 * (p & 1) + 1]};
            sa0v += S[p] * nn; sa1v += S[4 + p] * nn; yp0v += S[p] * rr2; yp1v += S[4 + p] * rr2; }
        float sa0 = sa0v[0] + sa0v[1], sa1 = sa1v[0] + sa1v[1];
        const f32x2 ypp = {yp0v[0] + yp0v[1], yp1v[0] + yp1v[1]};
        red2x8(sa0, sa1);
        const f32x2 s0 = {sa0, sa0}, s1 = {sa1, sa1}, vv0 = {v0, v0}, vv1 = {v1, v1};
#pragma unroll
        for (int p = 0; p < 4; ++p) { const f32x2 aa = {a4[p >> 1][2 * (p & 1)], a4[p >> 1][2 * (p & 1) + 1]}; S[p] = __builtin_elementwise_fma(aa, s0, S[p]); S[4 + p] = __builtin_elementwise_fma(aa, s1, S[4 + p]); }
        asm volatile("" ::: "memory");
#pragma unroll
        for (int p = 0; p < 4; ++p) { const f32x2 kk = {k4[p >> 1][2 * (p & 1)], k4[p >> 1][2 * (p & 1) + 1]}; S[p] = __builtin_elementwise_fma(kk, vv0, S[p]); S[4 + p] = __builtin_elementwise_fma(kk, vv1, S[4 + p]); }
        *(f32x2*)(ybuf + st * 2048 + rb * 512 + lane * 8) = ypp;
        if (lane < 8) { f32x2 o = {sa0, sa1}; *(f32x2*)(ybuf + SC_T * 2048 + st * 256 + rb * 64 + lane * 8) = o; }
    }
#pragma unroll
    for (int p = 0; p < 4; ++p) { const f32x4 g4 = *(const f32x4*)(buf + SC_GEND + co + 16 * (p >> 1)); const f32x2 gg = {g4[2 * (p & 1)], g4[2 * (p & 1) + 1]}; S[p] = S[p] * gg; S[4 + p] = S[4 + p] * gg; }
}
struct FinIn { unsigned v[4]; f32x2 bk[4]; };
__device__ __forceinline__ void fin_load(FinIn& F, const unsigned char* sb, const float* scp, int chunk, int pw, int lane) {
#pragma unroll
    for (int q = 0; q < 4; ++q) { const size_t t = (size_t)chunk * SC_T + (lane >> 4) + 4 * q;
        F.v[q] = *(const unsigned short*)(sb + t * 6144 + 512 + (16 * pw + (lane & 15)) * 4 + 2); F.bk[q] = *(const f32x2*)(scp + t * 32); }
}
__device__ __forceinline__ void prod_finish(const FinIn& F, const unsigned char* ybuf, unsigned* yr, int pw, int lane) {
#pragma unroll
    for (int q = 0; q < 4; ++q) { const int st = (lane >> 4) + 4 * q, row16 = lane & 15, e = row16 >> 3, rr = row16 & 7;
        const unsigned char* yp8 = ybuf + st * 2048 + pw * 512 + rr * 8 + e * 4; float yp = 0.f;
#pragma unroll
        for (int cg = 0; cg < 8; ++cg) yp += *(const float*)(yp8 + cg * 64);
        const float sa = *(const float*)(ybuf + SC_T * 2048 + st * 256 + pw * 64 + rr * 8 + e * 4);
        const float v = __uint_as_float(F.v[q] << 16), y = yp + sa * F.bk[q][0] + v * F.bk[q][1];
        yr[(size_t)st * 512 + row16] = (unsigned)bf1(y) | (F.v[q] << 16); }
}

__device__ __forceinline__ void rwpost_local(const Args& a, int bh, int tid) {
    const float* SC = (const float*)(a.ws + O_SC);
    const unsigned* YR = (const unsigned*)(a.ws + O_YR); const bf16_t* GB = (const bf16_t*)(a.ws + O_G); bf16_t* ORW = (bf16_t*)(a.ws + O_ORW);
    const int b = bh >> 3, h = bh & 7, c = 64 * h + (tid & 15) * 4;
    const f32x4 lwv = *(const f32x4*)(a.in[13] + c), lbv = *(const f32x4*)(a.in[14] + c);
    for (int t0 = tid >> 4; t0 < SEQ; t0 += 64) {
        u32x4 yv[2]; u32x2 gb[2]; float rkb[2]; size_t mm[2];
#pragma unroll
        for (int u = 0; u < 2; ++u) { const size_t m = (size_t)b * SEQ + t0 + 32 * u; mm[u] = m;
            yv[u] = __builtin_nontemporal_load((const u32x4*)(YR + m * 512 + c)); gb[u] = __builtin_nontemporal_load((const u32x2*)(GB + m * 512 + c)); rkb[u] = SC[(m * 8 + h) * 4 + 2]; }
#pragma unroll
        for (int u = 0; u < 2; ++u) {
            float y[4] = {bf_lo(yv[u].x), bf_lo(yv[u].y), bf_lo(yv[u].z), bf_lo(yv[u].w)};
            const float v[4] = {bf_hi(yv[u].x), bf_hi(yv[u].y), bf_hi(yv[u].z), bf_hi(yv[u].w)};
            float s = (y[0] + y[1]) + (y[2] + y[3]);
#pragma unroll
            for (int o = 1; o < 16; o <<= 1) s += __shfl_xor(s, o);
            const float mean = s * (1.f / 64.f);
            float q = 0.f;
#pragma unroll
            for (int j = 0; j < 4; ++j) { y[j] -= mean; q += y[j] * y[j]; }
#pragma unroll
            for (int o = 1; o < 16; o <<= 1) q += __shfl_xor(q, o);
            const float rstd = rsqrtf(q * (1.f / 64.f) + GN_EPS);
            const float g4[4] = {bf_lo(gb[u].x), bf_hi(gb[u].x), bf_lo(gb[u].y), bf_hi(gb[u].y)};
            float o4[4];
#pragma unroll
            for (int j = 0; j < 4; ++j) o4[j] = (y[j] * rstd * lwv[j] + lbv[j] + rkb[u] * v[j]) * g4[j];
            u32x2 ob; ob.x = cvt_pk_bf16(o4[0], o4[1]); ob.y = cvt_pk_bf16(o4[2], o4[3]);
            *(u32x2*)(ORW + mm[u] * 512 + c) = ob;
        }
    }
}

struct KV { bf16x8 k[4]; bf16x8 v[2][2]; };
__device__ __forceinline__ void attn_load(KV& T, const bf16_t* Kh, const bf16_t* Vh, int k0, int n, int hf) {
    const bf16_t* kp = Kh + (size_t)(k0 + n) * 512 + 8 * hf;
#pragma unroll
    for (int s = 0; s < 4; ++s) T.k[s] = *(const bf16x8*)(kp + 16 * s);
#pragma unroll
    for (int d = 0; d < 2; ++d)
#pragma unroll
        for (int sg = 0; sg < 2; ++sg) { const bf16_t* vp = Vh + (size_t)(32 * d + n) * SEQ + k0 + 16 * sg + 4 * hf;
            const u32x2 lo = *(const u32x2*)vp, hi = *(const u32x2*)(vp + 8); u32x4 t = {lo.x, lo.y, hi.x, hi.y}; T.v[d][sg] = __builtin_bit_cast(bf16x8, t); }
}
__device__ __forceinline__ void attn_wave(const Args& a, int bh, int w4, int lane) {
    const int b = bh >> 3, h = bh & 7, n = lane & 31, hf = lane >> 5;
    const size_t m0 = (size_t)b * SEQ;
    const bf16_t* Qh = (const bf16_t*)(a.ws + O_Q) + m0 * 512 + 64 * h;
    const bf16_t* Kh = (const bf16_t*)(a.ws + O_K) + m0 * 512 + 64 * h;
    const bf16_t* Vh = (const bf16_t*)(a.ws + O_VT) + (size_t)bh * 64 * SEQ;
    bf16_t* Oh = (bf16_t*)(a.ws + O_OSB) + m0 * 512 + 64 * h;
    for (int qt = 63 - w4; qt >= 0; qt -= 8) {
        const int q0 = 32 * qt;
        bf16x8 qf[4];
#pragma unroll
        for (int s = 0; s < 4; ++s) qf[s] = *(const bf16x8*)(Qh + (size_t)(q0 + n) * 512 + 16 * s + 8 * hf);
        f32x16 o0, o1;
#pragma unroll
        for (int i = 0; i < 16; ++i) { o0[i] = 0.f; o1[i] = 0.f; }
        float carry = 0.f;
        KV cur, nxt;
        attn_load(cur, Kh, Vh, q0, n, hf);
        for (int kt = qt; kt >= 0; --kt) {
            const int ktn = kt > 0 ? kt - 1 : 0;
            attn_load(nxt, Kh, Vh, 32 * ktn, n, hf);
            f32x16 sc;
#pragma unroll
            for (int i = 0; i < 16; ++i) sc[i] = 0.f;
#pragma unroll
            for (int s = 0; s < 4; ++s) sc = __builtin_amdgcn_mfma_f32_32x32x16_bf16(cur.k[s], qf[s], sc, 0, 0, 0);
            const bool diag = (kt == qt);
            float lf[16], G4[4];
#pragma unroll
            for (int g = 0; g < 4; ++g) { G4[g] = 0.f;
#pragma unroll
                for (int i = 0; i < 4; ++i) { const int r = 4 * g + i; const float z = sc[r];
                    const bool valid = !diag || (8 * g + 4 * hf + i < n);
                    const float e = fexp(-fabsf(z));
                    const float sp = fmaxf(z, 0.f) + flog(1.f + e);
                    lf[r] = valid ? -sp : 0.f; G4[g] += lf[r]; } }
            float PG[4], T4[4];
#pragma unroll
            for (int g = 0; g < 4; ++g) { PG[g] = __shfl_xor(G4[g], 32); T4[g] = G4[g] + PG[g]; }
            const float tail3 = 0.f, tail2 = T4[3], tail1 = T4[3] + T4[2], tail0 = tail1 + T4[1], total = tail0 + T4[0];
            const float tails[4] = {tail0, tail1, tail2, tail3};
            f32x16 wv;
#pragma unroll
            for (int g = 0; g < 4; ++g) {
                float af = carry + tails[g] + (hf == 0 ? PG[g] : 0.f);
#pragma unroll
                for (int i = 3; i >= 0; --i) { const int r = 4 * g + i; const float z = sc[r];
                    const bool valid = !diag || (8 * g + 4 * hf + i < n);
                    const float wgt = fexp(lf[r] + z + af);
                    wv[r] = valid ? wgt : 0.f;
                    af += lf[r]; } }
            carry += total;
            bf16x8 wf[2];
#pragma unroll
            for (int sg = 0; sg < 2; ++sg) { u32x4 t; t.x = cvt_pk_bf16(wv[8 * sg + 0], wv[8 * sg + 1]); t.y = cvt_pk_bf16(wv[8 * sg + 2], wv[8 * sg + 3]); t.z = cvt_pk_bf16(wv[8 * sg + 4], wv[8 * sg + 5]); t.w = cvt_pk_bf16(wv[8 * sg + 6], wv[8 * sg + 7]); wf[sg] = __builtin_bit_cast(bf16x8, t); }
#pragma unroll
            for (int sg = 0; sg < 2; ++sg) { o0 = __builtin_amdgcn_mfma_f32_32x32x16_bf16(cur.v[0][sg], wf[sg], o0, 0, 0, 0); o1 = __builtin_amdgcn_mfma_f32_32x32x16_bf16(cur.v[1][sg], wf[sg], o1, 0, 0, 0); }
            cur = nxt;
#if MK_EARLY_EXIT
            if (__all(carry < -104.f)) break;
#endif
        }
        bf16_t* op = Oh + (size_t)(q0 + n) * 512 + 4 * hf;
#pragma unroll
        for (int g = 0; g < 4; ++g) {
            u32x2 t0, t1; t0.x = cvt_pk_bf16(o0[4 * g], o0[4 * g + 1]); t0.y = cvt_pk_bf16(o0[4 * g + 2], o0[4 * g + 3]); t1.x = cvt_pk_bf16(o1[4 * g], o1[4 * g + 1]); t1.y = cvt_pk_bf16(o1[4 * g + 2], o1[4 * g + 3]);
            *(u32x2*)(op + 8 * g) = t0; *(u32x2*)(op + 32 + 8 * g) = t1; }
    }
}
__device__ __forceinline__ void phase_mixer(const Args& a, unsigned char* lds, int G) {
    const int tid = my_tid(); const int wave = __builtin_amdgcn_readfirstlane(tid >> 6), lane = tid & 63;
    for (int bh = blockIdx.x; bh < NB * NH; bh += G) {
        const int b = bh >> 3, h = bh & 7; const size_t m0 = (size_t)b * SEQ;
        const unsigned char* sb = a.ws + O_SI + (m0 * 8 + h) * 768; const float* scp = (const float*)(a.ws + O_SC) + (m0 * 8 + h) * 4;
        unsigned* yrb = (unsigned*)(a.ws + O_YR) + m0 * 512 + 64 * h + 16 * (wave & 3);
        constexpr int NCH = SEQ / SC_T;
        ProdRec pr; f32x2 S[8]; const int pw = wave & 3, pcol = tid & 63;
#pragma unroll
        for (int p = 0; p < 8; ++p) S[p] = (f32x2){0.f, 0.f};
        __syncthreads();
        FinIn fin;
        if (wave >= 4) { prod_load(pr, sb, 0, pw, pcol); prod_store(pr, lds, pw, pcol); prod_load(pr, sb, 1, pw, pcol); fin_load(fin, sb, scp, 0, pw, lane); }
        __syncthreads();
        unsigned char* yring = lds + 2 * SC_BUF;
        for (int ci = 0; ci < NCH; ++ci) {
            if (wave < 4) scan_consume(S, lds + (ci & 1) * SC_BUF, yring + (ci & 1) * (SC_T * 2304), lane, wave);
            else {
                if (ci > 0) { prod_finish(fin, yring + ((ci - 1) & 1) * (SC_T * 2304), yrb + (size_t)(ci - 1) * SC_T * 512, pw, lane); fin_load(fin, sb, scp, ci, pw, lane); }
                if (ci + 1 < NCH) { prod_store(pr, lds + ((ci + 1) & 1) * SC_BUF, pw, pcol); prod_load(pr, sb, ci + 2 < NCH ? ci + 2 : ci + 1, pw, pcol); }
            }
            __syncthreads();
        }
        if (wave >= 4) prod_finish(fin, yring + ((NCH - 1) & 1) * (SC_T * 2304), yrb + (size_t)(NCH - 1) * SC_T * 512, pw, lane);
        attn_wave(a, bh, wave, lane);
        __threadfence_block(); __syncthreads();
        rwpost_local(a, bh, my_tid());
    }
}

template <int MODE> __device__ __forceinline__ void phase_rows(const Args& a, int G) {
    const int tid = my_tid(); const int wave = tid >> 6, lane = tid & 63;
    const int gw = blockIdx.x * 8 + wave, NGW = G * 8;
    const bf16_t* T = (const bf16_t*)(a.ws + (MODE == 0 ? O_TT : O_FF));
    const float* g1 = MODE == 0 ? a.in[18] : a.in[23]; const float* g2 = a.in[19];
    bf16_t* H2 = (bf16_t*)(a.ws + O_H2); bf16_t* X1B = (bf16_t*)(a.ws + O_X1B);
    f32x4 g1v[4], g2v[4];
#pragma unroll
    for (int j = 0; j < 4; ++j) { g1v[j] = ((const f32x4*)g1)[lane + 64 * j]; g2v[j] = ((const f32x4*)g2)[lane + 64 * j]; }
    for (int row0 = gw; row0 < M; row0 += 2 * NGW) {
        u32x2 tb[2][4]; f32x4 x[2][4];
#pragma unroll
        for (int u = 0; u < 2; ++u) { const int row = (row0 + u * NGW < M) ? row0 + u * NGW : row0;
            const u32x2* tr = (const u32x2*)(T + (size_t)row * D) + lane;
#pragma unroll
            for (int j = 0; j < 4; ++j) tb[u][j] = __builtin_nontemporal_load(tr + 64 * j);
            if (MODE == 0) { const f32x4* xr = (const f32x4*)(a.in[0] + (size_t)row * D) + lane;
#pragma unroll
                for (int j = 0; j < 4; ++j) x[u][j] = __builtin_nontemporal_load(xr + 64 * j); }
            else { const u32x2* xr = (const u32x2*)(X1B + (size_t)row * D) + lane;
#pragma unroll
                for (int j = 0; j < 4; ++j) { const u32x2 xb = __builtin_nontemporal_load(xr + 64 * j); x[u][j][0] = bf_lo(xb.x); x[u][j][1] = bf_hi(xb.x); x[u][j][2] = bf_lo(xb.y); x[u][j][3] = bf_hi(xb.y); } } }
#pragma unroll
        for (int u = 0; u < 2; ++u) {
            const int row = row0 + u * NGW;
            f32x4 t[4]; float s = 0.f;
#pragma unroll
            for (int j = 0; j < 4; ++j) { t[j][0] = bf_lo(tb[u][j].x); t[j][1] = bf_hi(tb[u][j].x); t[j][2] = bf_lo(tb[u][j].y); t[j][3] = bf_hi(tb[u][j].y);
                s += (t[j][0] * t[j][0] + t[j][1] * t[j][1]) + (t[j][2] * t[j][2] + t[j][3] * t[j][3]); }
            const float rs = rsqrtf(wave_sum(s) * (1.f / D) + RMS_EPS);
            float s2 = 0.f;
#pragma unroll
            for (int j = 0; j < 4; ++j)
#pragma unroll
                for (int e = 0; e < 4; ++e) { x[u][j][e] += t[j][e] * rs * g1v[j][e]; s2 += x[u][j][e] * x[u][j][e]; }
            float rs2 = 0.f;
            if (MODE == 0) rs2 = rsqrtf(wave_sum(s2) * (1.f / D) + RMS_EPS);
            if (row < M) {
                if (MODE == 0) {
                    u32x2* xo = (u32x2*)(X1B + (size_t)row * D) + lane; u32x2* o = (u32x2*)(H2 + (size_t)row * D) + lane;
#pragma unroll
                    for (int j = 0; j < 4; ++j) { u32x2 w; w.x = cvt_pk_bf16(x[u][j][0], x[u][j][1]); w.y = cvt_pk_bf16(x[u][j][2], x[u][j][3]); xo[64 * j] = w; }
#pragma unroll
                    for (int j = 0; j < 4; ++j) { u32x2 w; w.x = cvt_pk_bf16(x[u][j][0] * rs2 * g2v[j][0], x[u][j][1] * rs2 * g2v[j][1]); w.y = cvt_pk_bf16(x[u][j][2] * rs2 * g2v[j][2], x[u][j][3] * rs2 * g2v[j][3]); o[64 * j] = w; }
                } else {
                    f32x4* orow = (f32x4*)(a.out + (size_t)row * D) + lane;
#pragma unroll
                    for (int j = 0; j < 4; ++j) __builtin_nontemporal_store(x[u][j], orow + 64 * j);
                }
            }
        }
    }
}

#define XB_TMO      128
#define XB_XCNT(j)  (256  + 64 * (j))
#define XB_XSUB(j)  (1280 + 64 * (j))
#define XB_XGEN(j)  (2304 + 64 * (j))
#define XB_TOP      3328
#define XB_TOPGEN   3392
#define XCD_BAR_WORDS 3456
#define XB_SPIN_CAP (1u << 18)

__device__ __forceinline__ unsigned xb_ld(unsigned* p)              { return __hip_atomic_load(p, __ATOMIC_RELAXED, __HIP_MEMORY_SCOPE_AGENT); }
__device__ __forceinline__ unsigned xb_add(unsigned* p, unsigned v) { return __hip_atomic_fetch_add(p, v, __ATOMIC_RELAXED, __HIP_MEMORY_SCOPE_AGENT); }
__device__ __forceinline__ unsigned xb_xcc_id() { return (unsigned)__builtin_amdgcn_s_getreg((3 << 11) | 20) & 0xFu; }
#define XB_SPIN(cond, bar) do { unsigned _sp = 0; while (cond) { __builtin_amdgcn_s_sleep(1); \
    if ((++_sp & 255u) == 0u) { if (xb_ld(&(bar)[XB_TMO])) break; if (_sp > XB_SPIN_CAP) { atomicAdd(&(bar)[XB_TMO], 1u); break; } } } } while (0)

struct XcdBarrier {
    unsigned* bar; unsigned x;
    volatile __attribute__((address_space(3))) unsigned* st;
};

__device__ __forceinline__ XcdBarrier xcd_barrier_post(unsigned* bar, volatile __attribute__((address_space(3))) unsigned* st) {
    XcdBarrier b; b.bar = bar; b.x = xb_xcc_id(); b.st = st;
    if (threadIdx.x == 0) (void)xb_add(&bar[XB_XCNT(b.x)], 1u);
    return b;
}
__device__ __forceinline__ void xcd_barrier_complete(unsigned* bar, unsigned x, unsigned& nloc, unsigned& nx) {
    const unsigned G = gridDim.x * gridDim.y * gridDim.z;
    unsigned sum, cnt, mine, sp = 0u;
    for (;;) {
        sum = 0u; cnt = 0u; mine = 0u;
#pragma unroll
        for (unsigned j = 0; j < 16; ++j) { const unsigned c = xb_ld(&bar[XB_XCNT(j)]); sum += c; cnt += (c > 0u) ? 1u : 0u; mine = (j == x) ? c : mine; }
        if (sum == G) break;
        __builtin_amdgcn_s_sleep(1);
        if ((++sp & 255u) == 0u) { if (xb_ld(&bar[XB_TMO])) break; if (sp > XB_SPIN_CAP) { atomicAdd(&bar[XB_TMO], 1u); break; } }
    }
    nloc = mine > 0u ? mine : 1u; nx = cnt > 0u ? cnt : 1u;
}

__device__ __forceinline__ void xcd_barrier(const XcdBarrier& b) {
    asm volatile("s_waitcnt vmcnt(0)" ::: "memory");
    __syncthreads();
    if (threadIdx.x == 0) {
        unsigned* bar = b.bar;
        __builtin_amdgcn_s_waitcnt(0);
        unsigned nloc = b.st[0], nx = b.st[1];
        if (nloc == 0u) { xcd_barrier_complete(bar, b.x, nloc, nx); b.st[0] = nloc; b.st[1] = nx; }
        const unsigned old = xb_add(&bar[XB_XSUB(b.x)], 1u);
        const unsigned gen = old / nloc;
        if (old + 1u == (gen + 1u) * nloc) {
            __builtin_amdgcn_fence(__ATOMIC_RELEASE, "agent");
            asm volatile("s_waitcnt vmcnt(0)" ::: "memory");
            const unsigned og = xb_add(&bar[XB_TOP], 1u);
            const unsigned tg = og / nx;
            if (og + 1u == (tg + 1u) * nx) xb_add(&bar[XB_TOPGEN], 1u);
            else XB_SPIN(xb_ld(&bar[XB_TOPGEN]) == tg, bar);
            __builtin_amdgcn_fence(__ATOMIC_ACQUIRE, "agent");
            xb_add(&bar[XB_XGEN(b.x)], 1u);
            asm volatile("s_waitcnt vmcnt(0)" ::: "memory");
        } else {
            XB_SPIN(xb_ld(&bar[XB_XGEN(b.x)]) == gen, bar);
            __builtin_amdgcn_fence(__ATOMIC_ACQUIRE, "agent");
            asm volatile("s_waitcnt vmcnt(0)" ::: "memory");
        }
    }
    __syncthreads();
}

__global__ void __launch_bounds__(512, 2) mega(Args a) {
    extern __shared__ __attribute__((aligned(16))) unsigned char shm[];
    PG8_LAS unsigned char* lds = (PG8_LAS unsigned char*)shm;
    const int G = (int)gridDim.x;
    unsigned char* ws = a.ws;
    volatile __attribute__((address_space(3))) unsigned* bst = (volatile __attribute__((address_space(3))) unsigned*)(lds + pg8::STAGE_BYTES);
    if (threadIdx.x == 0) { bst[0] = 0u; bst[1] = 0u; }
    __syncthreads();
    const XcdBarrier bar = xcd_barrier_post((unsigned*)(ws + O_CTL), bst);
    cg::this_grid().sync();
    phase_prep(a, (float*)shm, G);
    xcd_barrier(bar);
    { Epi1 E; E.Q = (bf16_t*)(ws + O_Q); E.Kb = (bf16_t*)(ws + O_K); E.Vt = (bf16_t*)(ws + O_VT); E.Prw = (bf16_t*)(ws + O_PRW); E.Gt = (bf16_t*)a.out; E.bgate = a.in[3];
      run_gemm(lds, (const bf16_t*)(ws + O_H), (const bf16_t*)(ws + O_WIN), INC, 1024, E, G); }
    xcd_barrier(bar);
    phase_rwprep(a, shm, G);
    xcd_barrier(bar);
    phase_mixer(a, shm, G);
    xcd_barrier(bar);
    { EpiRow<1> E; E.O = (bf16_t*)(ws + O_T1); E.T1 = nullptr; E.Gt = (const bf16_t*)a.out;
      run_gemm(lds, (const bf16_t*)(ws + O_OSB), (const bf16_t*)(ws + O_WSB), 1024, 512, E, G); }
    { EpiRow<2> E; E.O = (bf16_t*)(ws + O_MRG); E.T1 = (const bf16_t*)(ws + O_T1); E.Gt = (const bf16_t*)a.out;
      run_gemm(lds, (const bf16_t*)(ws + O_ORW), (const bf16_t*)(ws + O_WRW), 1024, 512, E, G); }
    xcd_barrier(bar);
    { EpiRow<0> E; E.O = (bf16_t*)(ws + O_TT); E.T1 = nullptr; E.Gt = nullptr;
      run_gemm(lds, (const bf16_t*)(ws + O_MRG), (const bf16_t*)(ws + O_WO), 1024, 1024, E, G); }
    xcd_barrier(bar);
    phase_rows<0>(a, G);
    xcd_barrier(bar);
    { EpiSwiGLU E; E.Hd = (bf16_t*)(ws + O_HID);
      run_gemm(lds, (const bf16_t*)(ws + O_H2), (const bf16_t*)(ws + O_WGU), 2 * DFF, 1024, E, G); }
    xcd_barrier(bar);
    { EpiRow<0> E; E.O = (bf16_t*)(ws + O_FF); E.T1 = nullptr; E.Gt = nullptr;
      run_gemm(lds, (const bf16_t*)(ws + O_HID), (const bf16_t*)(ws + O_WDN), 1024, DFF, E, G); }
    xcd_barrier(bar);
    phase_rows<1>(a, G);
}
}

extern "C" void kernel_launch(void* const* d_in, const int* in_sizes, int n_in, void* d_out, int out_size, void* d_ws, size_t ws_size, hipStream_t stream) {
    static int grid = 0;
    if (grid == 0) {
        if (n_in != 24 || in_sizes[0] != mk::M * mk::D || out_size != mk::M * mk::D || ws_size < mk::WS_NEED) {
            fprintf(stderr, "kernel_launch: unexpected shapes: n_in %d in0 %d out %d ws %zu (need %zu)\n", n_in, n_in > 0 ? in_sizes[0] : -1, out_size, ws_size, (size_t)mk::WS_NEED); grid = -1; return; }
        int dev = 0, cus = 0, per_cu = 0;
        hipGetDevice(&dev); hipDeviceGetAttribute(&cus, hipDeviceAttributeMultiprocessorCount, dev);
        if (hipFuncSetAttribute((const void*)mk::mega, hipFuncAttributeMaxDynamicSharedMemorySize, mk::LDS_BYTES) != hipSuccess) { fprintf(stderr, "kernel_launch: hipFuncSetAttribute failed\n"); grid = -1; return; }
        if (hipOccupancyMaxActiveBlocksPerMultiprocessor(&per_cu, (const void*)mk::mega, 512, mk::LDS_BYTES) != hipSuccess || per_cu < 1) { fprintf(stderr, "kernel_launch: occupancy query failed (%d)\n", per_cu); per_cu = 1; }
        (void)hipGetLastError();
        grid = cus * per_cu;
        fprintf(stderr, "kernel_launch: grid %d (cus %d x %d)\n", grid, cus, per_cu);
    }
    if (grid < 0) return;
    mk::Args a{};
    for (int i = 0; i < 24; ++i) a.in[i] = (const float*)d_in[i];
    a.out = (float*)d_out; a.ws = (unsigned char*)d_ws;
    a.ph_lo = 0; a.ph_hi = mk::NPH;
    if (hipMemsetAsync((char*)d_ws + mk::O_CTL, 0, mk::CTL_BYTES, stream) != hipSuccess) { fprintf(stderr, "kernel_launch: hipMemsetAsync failed\n"); return; }
    void* args[] = {&a};
    hipError_t e = hipLaunchCooperativeKernel((const void*)mk::mega, dim3(grid), dim3(512), args, mk::LDS_BYTES, stream);
    if (e != hipSuccess) fprintf(stderr, "kernel_launch: cooperative launch failed: %s (grid %d)\n", hipGetErrorString(e), grid);
}
```

```cpp
#include <hip/hip_runtime.h>
#include <hip/hip_cooperative_groups.h>
#include <cstdio>
#include <cstdint>
namespace cg = cooperative_groups;
#ifndef MK_SPLIT
#define MK_SPLIT 0
#endif
#ifndef MK_DIAG
#define MK_DIAG 0
#endif
#ifndef MK_REPMASK
#define MK_REPMASK 0
#endif
#ifndef MK_EARLY_EXIT
#define MK_EARLY_EXIT 1
#endif
namespace pg8 {
#define PG8_LAS __attribute__((address_space(3)))
typedef unsigned short bf16_t;
typedef short bf16x8 __attribute__((ext_vector_type(8)));
typedef float f32x4 __attribute__((ext_vector_type(4)));
typedef unsigned u32x4 __attribute__((ext_vector_type(4)));
constexpr int BM = 256, BK = 64, HALF = 128, HTB = HALF * BK * 2  , STAGE_BYTES = 8 * HTB, NXCD = 8, WGM = 8;

__host__ __device__ __forceinline__ int lds_byte(int r, int c) { const int st = (r >> 4) * 2 + (c >> 5), rr = r & 15, cc = c & 31, ob = rr * 64 + cc * 2; return st * 1024 + (ob ^ (((ob >> 9) & 1) << 5)); }
__host__ __device__ __forceinline__ void stage_rc(int b, int& R, int& C) { const int st = b / 1024, sb = b % 1024, swz = sb ^ (((sb >> 9) & 1) << 5); R = (st >> 1) * 16 + swz / 64; C = (st & 1) * 32 + (swz % 64) / 2; }
__host__ __device__ __forceinline__ int perm32(int rho) { const int n = rho >> 4, i = rho & 15; return 8 * (i >> 2) + 4 * n + (i & 3); }

struct Unit { int pm, pn; };
struct Gemm { const bf16_t* A; const bf16_t* Bt; int M, N, K; };

struct StaticOrder {
    int nM, nN, nwg, G, c;
    __host__ __device__ void init(int M, int N, int G_, int c_) { nM = M / BM; nN = N / BM; nwg = nM * nN; G = G_; c = c_; }
    __host__ __device__ bool next(int i, Unit& u) const {
        const long L = (long)i * G + c; if (L >= nwg) return false;
        int wgid = (int)L; { const int q = nwg / NXCD, r = nwg % NXCD, xcd = wgid % NXCD, off = wgid / NXCD; wgid = (xcd < r ? xcd * (q + 1) : r * (q + 1) + (xcd - r) * q) + off; }
        const int nig = WGM * nN, gid = wgid / nig, fm = gid * WGM, gsz = (nM - fm) < WGM ? (nM - fm) : WGM;
        u.pm = fm + ((wgid % nig) % gsz); u.pn = (wgid % nig) / gsz; return true;
    }
    __device__ __forceinline__ void a_ready(const Unit&) const {}
    __device__ __forceinline__ void done(const Unit&) const {}
};

typedef float cvt_f32x2 __attribute__((ext_vector_type(2)));
typedef __bf16 cvt_bf16x2 __attribute__((ext_vector_type(2)));
__device__ __forceinline__ unsigned cvt_pk_bf16(float lo, float hi) { const cvt_f32x2 v = {lo, hi}; return __builtin_bit_cast(unsigned, __builtin_convertvector(v, cvt_bf16x2)); }
typedef float f32x2 __attribute__((ext_vector_type(2)));

template <class Epi, class Sched, bool ALIGN_EPI = false, bool SP2 = false>
__device__ __forceinline__ void gemm_phase(PG8_LAS unsigned char* lds, const Gemm g, const Sched& S, const Epi& E) {
    int tid_ = threadIdx.x; asm volatile("" : "+v"(tid_)); const int tid = tid_, wid = __builtin_amdgcn_readfirstlane(tid >> 6), lane = tid & 63, wr = wid >> 2, wc = wid & 3, fr = lane & 15, fq = lane >> 4;
    const int K = g.K, nt = K / BK;
    unsigned voffA[2], voffB[2];
#pragma unroll
    for (int i = 0; i < 2; ++i) { int R, C; stage_rc(tid * 16 + i * 8192, R, C); const int Rb = Epi::PERM ? ((R & ~31) + perm32(R & 31)) : R;
        voffA[i] = (unsigned)(R * K + C) * 2u; voffB[i] = (unsigned)(Rb * K + C) * 2u; }
    const size_t kstep = (size_t)(BK * 2);
    const size_t hstep = (size_t)HALF * K * 2;
    const size_t tstep = 2 * hstep;
    const unsigned ldsw = (unsigned)wid * 1024u;
    const int aoff = lds_byte(wr * 64 + fr, fq * 8), boff = lds_byte(wc * 32 + fr, fq * 8);
#define PG8_SA(b, h) (((b) * 2 + (h)) * HTB)
#define PG8_SB(b, h) ((4 + (b) * 2 + (h)) * HTB)
#define PG8_STAGE(bufoff, gbase, voff) do { _Pragma("unroll") for (int _i = 0; _i < 2; ++_i) \
        __builtin_amdgcn_global_load_lds((const unsigned*)((const char*)(gbase) + (voff)[_i]), (PG8_LAS unsigned*)(lds + (bufoff) + ldsw + _i * 8192), 16, 0, 0); } while (0)
#define PG8_LDA(dst, b, h) do { _Pragma("unroll") for (int m = 0; m < 4; ++m) _Pragma("unroll") for (int k = 0; k < 2; ++k) dst[m][k] = *(const PG8_LAS bf16x8*)(lds + PG8_SA(b, h) + aoff + m * 2048 + k * 1024); } while (0)
#define PG8_LDB(dst, b, h) do { _Pragma("unroll") for (int n = 0; n < 2; ++n) _Pragma("unroll") for (int k = 0; k < 2; ++k) dst[n][k] = *(const PG8_LAS bf16x8*)(lds + PG8_SB(b, h) + boff + n * 2048 + k * 1024); } while (0)
#define PG8_MMA(ai, bj, At, Bt) do { __builtin_amdgcn_s_setprio(1); _Pragma("unroll") for (int m = 0; m < 4; ++m) _Pragma("unroll") for (int n = 0; n < 2; ++n) _Pragma("unroll") for (int k = 0; k < 2; ++k) \
        acc[ai][bj][m][n] = __builtin_amdgcn_mfma_f32_16x16x32_bf16(Bt[n][k], At[m][k], acc[ai][bj][m][n], 0, 0, 0); __builtin_amdgcn_s_setprio(0); } while (0)
#define PG8_WAIT_V(n) asm volatile("s_waitcnt vmcnt(" #n ")" ::: "memory")
#define PG8_WAIT_L(n) asm volatile("s_waitcnt lgkmcnt(" #n ")" ::: "memory")
#define PG8_BAR __builtin_amdgcn_s_barrier()
#define PG8_SCHED __builtin_amdgcn_sched_barrier(0)
    Unit cur, nxt; int ui = 0;
    if (!S.next(0, cur)) return;
    f32x4 acc[2][2][4][2];
#pragma unroll
    for (int a = 0; a < 2; ++a)
#pragma unroll
        for (int b = 0; b < 2; ++b)
#pragma unroll
            for (int m = 0; m < 4; ++m)
#pragma unroll
                for (int n = 0; n < 2; ++n) acc[a][b][m][n] = (f32x4){0.f, 0.f, 0.f, 0.f};
    bf16x8 At[4][2], B0[2][2], B1[2][2];
    const char* cA = (const char*)g.A + (size_t)cur.pm * tstep; const char* cB = (const char*)g.Bt + (size_t)cur.pn * tstep;
    S.a_ready(cur);
    if constexpr (SP2) {
        PG8_STAGE(PG8_SB(0, 0), cB, voffB); PG8_STAGE(PG8_SB(0, 1), cB + hstep, voffB); PG8_STAGE(PG8_SA(0, 0), cA, voffA); PG8_STAGE(PG8_SA(0, 1), cA + hstep, voffA);
        if (wr == 1) PG8_BAR;
        PG8_WAIT_V(2); PG8_BAR;
        PG8_STAGE(PG8_SB(1, 0), cB + kstep, voffB); PG8_STAGE(PG8_SA(1, 0), cA + kstep, voffA); PG8_STAGE(PG8_SB(1, 1), cB + hstep + kstep, voffB);
        PG8_WAIT_V(6); PG8_BAR;
    } else {
        PG8_STAGE(PG8_SB(0, 0), cB, voffB); PG8_STAGE(PG8_SA(0, 0), cA, voffA); PG8_STAGE(PG8_SB(0, 1), cB + hstep, voffB); PG8_STAGE(PG8_SA(0, 1), cA + hstep, voffA);
        if (wr == 1) PG8_BAR;
        PG8_WAIT_V(4); PG8_BAR;
        PG8_STAGE(PG8_SB(1, 0), cB + kstep, voffB); PG8_STAGE(PG8_SA(1, 0), cA + kstep, voffA); PG8_STAGE(PG8_SB(1, 1), cB + hstep + kstep, voffB);
        PG8_WAIT_V(6); PG8_BAR;
    }
    for (;;) {
        const bool has_next = S.next(ui + 1, nxt);
        const char* nA = has_next ? (const char*)g.A + (size_t)nxt.pm * tstep : cA; const char* nB = has_next ? (const char*)g.Bt + (size_t)nxt.pn * tstep : cB;
        for (int t = 0; t < nt; t += 2) {
            const bool last = (t == nt - 2);
            const char* a1 = cA + (size_t)(t + 1) * kstep;
            const char* a2 = last ? nA : cA + (size_t)(t + 2) * kstep; const char* b2 = last ? nB : cB + (size_t)(t + 2) * kstep;
            const char* a3 = a2 + kstep; const char* b3 = b2 + kstep;
            if (last && has_next) S.a_ready(nxt);
            if constexpr (SP2) {
            PG8_LDB(B0, 0, 0); PG8_LDB(B1, 0, 1); PG8_SCHED; PG8_LDA(At, 0, 0); PG8_STAGE(PG8_SA(1, 1), a1 + hstep, voffA);
            PG8_WAIT_V(8); PG8_WAIT_L(0); PG8_BAR; PG8_MMA(0, 0, At, B0); PG8_MMA(0, 1, At, B1); PG8_BAR; PG8_SCHED;
            PG8_LDA(At, 0, 1); PG8_STAGE(PG8_SB(0, 0), b2, voffB); PG8_STAGE(PG8_SB(0, 1), b2 + hstep, voffB); PG8_STAGE(PG8_SA(0, 0), a2, voffA);
            PG8_WAIT_V(8); PG8_WAIT_L(0); PG8_BAR; PG8_MMA(1, 0, At, B0); PG8_MMA(1, 1, At, B1); PG8_BAR; PG8_SCHED;
            PG8_LDB(B0, 1, 0); PG8_LDB(B1, 1, 1); PG8_SCHED; PG8_LDA(At, 1, 0); PG8_STAGE(PG8_SA(0, 1), a2 + hstep, voffA);
            PG8_WAIT_V(8); PG8_WAIT_L(0); PG8_BAR; PG8_MMA(0, 0, At, B0); PG8_MMA(0, 1, At, B1); PG8_BAR; PG8_SCHED;
            PG8_LDA(At, 1, 1); PG8_STAGE(PG8_SB(1, 0), b3, voffB); PG8_STAGE(PG8_SB(1, 1), b3 + hstep, voffB); PG8_STAGE(PG8_SA(1, 0), a3, voffA);
            PG8_WAIT_V(8); PG8_WAIT_L(0); PG8_BAR; PG8_MMA(1, 0, At, B0); PG8_MMA(1, 1, At, B1); PG8_BAR; PG8_SCHED;
            } else {
            PG8_LDB(B0, 0, 0); PG8_SCHED; PG8_LDA(At, 0, 0); PG8_STAGE(PG8_SA(1, 1), a1 + hstep, voffA);
            PG8_WAIT_L(8); PG8_BAR; PG8_WAIT_L(0); PG8_MMA(0, 0, At, B0); PG8_BAR; PG8_SCHED;
            PG8_LDB(B1, 0, 1); PG8_STAGE(PG8_SB(0, 0), b2, voffB);
            PG8_BAR; PG8_WAIT_L(0); PG8_MMA(0, 1, At, B1); PG8_BAR;
            PG8_LDA(At, 0, 1); PG8_STAGE(PG8_SA(0, 0), a2, voffA);
            PG8_BAR; PG8_WAIT_L(0); PG8_MMA(1, 0, At, B0); PG8_BAR; PG8_SCHED;
            PG8_STAGE(PG8_SB(0, 1), b2 + hstep, voffB);
            PG8_WAIT_V(6); PG8_BAR; PG8_MMA(1, 1, At, B1); PG8_BAR;
            PG8_LDB(B0, 1, 0); PG8_SCHED; PG8_LDA(At, 1, 0); PG8_STAGE(PG8_SA(0, 1), a2 + hstep, voffA);
            PG8_WAIT_L(8); PG8_BAR; PG8_WAIT_L(0); PG8_MMA(0, 0, At, B0); PG8_BAR; PG8_SCHED;
            PG8_LDB(B1, 1, 1); PG8_STAGE(PG8_SB(1, 0), b3, voffB);
            PG8_BAR; PG8_WAIT_L(0); PG8_MMA(0, 1, At, B1); PG8_BAR;
            PG8_LDA(At, 1, 1); PG8_STAGE(PG8_SA(1, 0), a3, voffA);
            PG8_BAR; PG8_WAIT_L(0); PG8_MMA(1, 0, At, B0); PG8_BAR; PG8_SCHED;
            PG8_STAGE(PG8_SB(1, 1), b3 + hstep, voffB);
            PG8_WAIT_V(6); PG8_BAR; PG8_MMA(1, 1, At, B1); PG8_BAR;
            }
        }
        if constexpr (ALIGN_EPI) { if (wr == 0) PG8_BAR; }
        if constexpr (!Epi::AFTER_DRAIN) { E(acc, cur, wr, wc, fr, fq); S.done(cur); }
        if (!has_next) break;
#pragma unroll
        for (int a = 0; a < 2; ++a)
#pragma unroll
            for (int b = 0; b < 2; ++b)
#pragma unroll
                for (int m = 0; m < 4; ++m)
#pragma unroll
                    for (int n = 0; n < 2; ++n) acc[a][b][m][n] = (f32x4){0.f, 0.f, 0.f, 0.f};
        cur = nxt; cA = nA; cB = nB; ++ui;
        if constexpr (ALIGN_EPI) { if (wr == 1) PG8_BAR; }
    }
    PG8_WAIT_V(0);
    if constexpr (!ALIGN_EPI) { if (wr == 0) PG8_BAR; }
    PG8_BAR;
    if constexpr (Epi::AFTER_DRAIN) { E.fused(acc, cur, wr, wc, fr, fq, lds, wid, lane); S.done(cur); }
#undef PG8_SA
#undef PG8_SB
#undef PG8_STAGE
#undef PG8_LDA
#undef PG8_LDB
#undef PG8_MMA
#undef PG8_WAIT_V
#undef PG8_WAIT_L
#undef PG8_BAR
#undef PG8_SCHED
}

}
namespace mk {
using pg8::bf16_t; using pg8::bf16x8; using pg8::f32x4; using pg8::u32x4; using pg8::cvt_pk_bf16;
typedef float f32x16 __attribute__((ext_vector_type(16)));
typedef float f32x2 __attribute__((ext_vector_type(2)));
typedef unsigned u32x2 __attribute__((ext_vector_type(2)));
constexpr int D = 1024, NB = 32, SEQ = 2048, M = NB * SEQ, NH = 8, DH = 64;
constexpr int RWC = 1792, GC = 2048, INC = 5376, DFF = 2816;
constexpr float RMS_EPS = 1e-6f, GN_EPS = 64e-5f;
constexpr size_t MiB = (size_t)1 << 20;
constexpr size_t O_WIN = 0, O_WSB = 11 * MiB, O_WRW = 12 * MiB, O_WO = 13 * MiB, O_WGU = 15 * MiB, O_WDN = 26 * MiB, O_WLU = 32 * MiB  , O_WLA = O_WLU + 65536, O_WLG = O_WLA + 65536;
constexpr size_t O_Q = 34 * MiB, O_K = 98 * MiB, O_VT = 162 * MiB, O_PRW = 226 * MiB, O_H = 450 * MiB, O_SI = 450 * MiB, O_G = 834 * MiB, O_SC = 898 * MiB, O_YR = 290 * MiB  ;
constexpr size_t O_OSB = 226 * MiB, O_ORW = 34 * MiB, O_T1 = 98 * MiB, O_MRG = 450 * MiB, O_TT = 34 * MiB, O_H2 = 162 * MiB, O_HID = 290 * MiB, O_FF = 34 * MiB;
constexpr size_t O_X1B = 706 * MiB;
constexpr size_t WS_NEED = 1009 * MiB;
constexpr int LDS_BYTES = pg8::STAGE_BYTES + 64;
constexpr size_t O_CTL = 1008 * MiB, CTL_BYTES = 65536;
constexpr int NPH = 12;

struct Args { const float* in[24]; float* out; unsigned char* ws; int ph_lo, ph_hi; };

__device__ __forceinline__ int my_tid() { int t = threadIdx.x; asm volatile("" : "+v"(t)); return t; }
__device__ __forceinline__ float bf_lo(unsigned u) { return __uint_as_float(u << 16); }
__device__ __forceinline__ float bf_hi(unsigned u) { return __uint_as_float(u & 0xffff0000u); }
__device__ __forceinline__ float fexp(float x) { return __builtin_amdgcn_exp2f(x * 1.44269504089f); }
__device__ __forceinline__ float flog(float x) { return __builtin_amdgcn_logf(x) * 0.69314718056f; }
__device__ __forceinline__ float frcp(float x) { return __builtin_amdgcn_rcpf(x); }
__device__ __forceinline__ float fsigmoid(float x) { return frcp(1.f + fexp(-x)); }
__device__ __forceinline__ unsigned short bf1(float x) { return (unsigned short)(cvt_pk_bf16(x, x) & 0xffffu); }
__device__ __forceinline__ u32x4 pack8(const f32x4 a, const f32x4 b) { u32x4 o; o.x = cvt_pk_bf16(a[0], a[1]); o.y = cvt_pk_bf16(a[2], a[3]); o.z = cvt_pk_bf16(b[0], b[1]); o.w = cvt_pk_bf16(b[2], b[3]); return o; }
__device__ __forceinline__ float red16(float v) {
    v += __shfl_xor(v, 16); v += __shfl_xor(v, 32); return v;
}
__device__ __forceinline__ float wave_sum(float v) {
#pragma unroll
    for (int o = 1; o < 64; o <<= 1) v += __shfl_xor(v, o);
    return v;
}

__device__ __forceinline__ void tr_item(const float* __restrict__ W, int K, int N, bf16_t* WT, float* scr, int item, int lane, int mode) {
    const int nblk = N >> 5, kb = item / nblk, nb = item - kb * nblk, k0 = kb << 6, n0 = nb << 5;
#pragma unroll 8
    for (int i = 0; i < 32; ++i) { const int kk = 2 * i + (lane >> 5); scr[kk * 33 + (lane & 31)] = __builtin_nontemporal_load(W + (size_t)(k0 + kk) * N + n0 + (lane & 31)); }
    asm volatile("s_waitcnt lgkmcnt(0)" ::: "memory"); __builtin_amdgcn_wave_barrier();
    const int c = lane & 7;
#pragma unroll
    for (int j = 0; j < 4; ++j) {
        const int n = (lane >> 3) + 8 * j; const float* s = scr + (8 * c) * 33 + n;
        u32x4 o; o.x = cvt_pk_bf16(s[0 * 33], s[1 * 33]); o.y = cvt_pk_bf16(s[2 * 33], s[3 * 33]); o.z = cvt_pk_bf16(s[4 * 33], s[5 * 33]); o.w = cvt_pk_bf16(s[6 * 33], s[7 * 33]);
        const int nn = n0 + n; int drow = nn;
        if (mode == 1) drow = ((nn >> 7) << 8) + (nn & 127); else if (mode == 2) drow = ((nn >> 7) << 8) + 128 + (nn & 127);
        *(u32x4*)(WT + (size_t)drow * K + k0 + 8 * c) = o;
    }
    asm volatile("s_waitcnt lgkmcnt(0)" ::: "memory"); __builtin_amdgcn_wave_barrier();
}

__device__ __forceinline__ void phase_prep(const Args& a, float* lds_f, int G) {
    const int tid = my_tid(); const int wave = tid >> 6, lane = tid & 63;
    const int gw = blockIdx.x * 8 + wave, NGW = G * 8;
    float* scr = lds_f + wave * (64 * 33 + 16);
    unsigned char* ws = a.ws;
    constexpr int I_IN = 16 * 168, I_SB = 8 * 32, I_O = 16 * 32, I_G = 16 * 88, I_DN = 44 * 32, I_LU = 16, I_LG = 32;
    constexpr int NIT = I_IN + 2 * I_SB + I_O + 2 * I_G + I_DN + 2 * I_LU + I_LG;
    for (int it = gw; it < NIT; it += NGW) {
        int r = it;
        if (r < I_IN) { tr_item(a.in[2], 1024, INC, (bf16_t*)(ws + O_WIN), scr, r, lane, 0); continue; } r -= I_IN;
        if (r < I_SB) { tr_item(a.in[15], 512, 1024, (bf16_t*)(ws + O_WSB), scr, r, lane, 0); continue; } r -= I_SB;
        if (r < I_SB) { tr_item(a.in[16], 512, 1024, (bf16_t*)(ws + O_WRW), scr, r, lane, 0); continue; } r -= I_SB;
        if (r < I_O) { tr_item(a.in[17], 1024, 1024, (bf16_t*)(ws + O_WO), scr, r, lane, 0); continue; } r -= I_O;
        if (r < I_G) { tr_item(a.in[20], 1024, DFF, (bf16_t*)(ws + O_WGU), scr, r, lane, 1); continue; } r -= I_G;
        if (r < I_G) { tr_item(a.in[21], 1024, DFF, (bf16_t*)(ws + O_WGU), scr, r, lane, 2); continue; } r -= I_G;
        if (r < I_DN) { tr_item(a.in[22], DFF, 1024, (bf16_t*)(ws + O_WDN), scr, r, lane, 0); continue; } r -= I_DN;
        if (r < I_LU) { tr_item(a.in[6], 64, 512, (bf16_t*)(ws + O_WLU), scr, r, lane, 0); continue; } r -= I_LU;
        if (r < I_LU) { tr_item(a.in[8], 64, 512, (bf16_t*)(ws + O_WLA), scr, r, lane, 0); continue; } r -= I_LU;
        tr_item(a.in[9], 128, 512, (bf16_t*)(ws + O_WLG), scr, r, lane, 0);
    }
    const float* x = a.in[0]; const float* g = a.in[1]; bf16_t* H = (bf16_t*)(ws + O_H);
    f32x4 gv[4];
#pragma unroll
    for (int j = 0; j < 4; ++j) gv[j] = ((const f32x4*)g)[lane + 64 * j];
    for (int row0 = gw; row0 < M; row0 += 2 * NGW) {
        f32x4 v[2][4];
#pragma unroll
        for (int u = 0; u < 2; ++u) { const int row = (row0 + u * NGW < M) ? row0 + u * NGW : row0; const f32x4* xr = (const f32x4*)(x + (size_t)row * D) + lane;
#pragma unroll
            for (int j = 0; j < 4; ++j) v[u][j] = __builtin_nontemporal_load(xr + 64 * j); }
#pragma unroll
        for (int u = 0; u < 2; ++u) { const int row = row0 + u * NGW; float s = 0.f;
#pragma unroll
            for (int j = 0; j < 4; ++j) s += (v[u][j][0] * v[u][j][0] + v[u][j][1] * v[u][j][1]) + (v[u][j][2] * v[u][j][2] + v[u][j][3] * v[u][j][3]);
            const float rs = rsqrtf(wave_sum(s) * (1.f / D) + RMS_EPS);
            if (row < M) { u32x2* o = (u32x2*)(H + (size_t)row * D) + lane;
#pragma unroll
                for (int j = 0; j < 4; ++j) { u32x2 w; w.x = cvt_pk_bf16(v[u][j][0] * rs * gv[j][0], v[u][j][1] * rs * gv[j][1]); w.y = cvt_pk_bf16(v[u][j][2] * rs * gv[j][2], v[u][j][3] * rs * gv[j][3]); o[64 * j] = w; } }
        }
    }
}

struct Epi1 {
    static constexpr bool PERM = true, AFTER_DRAIN = false;
    bf16_t *Q, *Kb, *Vt, *Prw, *Gt; const float* bgate;
    __device__ __forceinline__ void operator()(const f32x4 (&acc)[2][2][4][2], const pg8::Unit& u, int wr, int wc, int fr, int fq) const {
        const int row0 = u.pm * 256 + wr * 64 + fr, pn = u.pn, cl = wc * 32 + 8 * fq;
        if (pn < 4) {
            bf16_t* dst = pn < 2 ? Q : Kb; const float sc = pn < 2 ? 0.125f : 1.f; const int cb = (pn & 1) * 256 + cl;
#pragma unroll
            for (int ai = 0; ai < 2; ++ai)
#pragma unroll
                for (int m = 0; m < 4; ++m) { bf16_t* rp = dst + (size_t)(row0 + ai * 128 + m * 16) * 512 + cb;
#pragma unroll
                    for (int bj = 0; bj < 2; ++bj) *(u32x4*)(rp + bj * 128) = pack8(acc[ai][bj][m][0] * sc, acc[ai][bj][m][1] * sc); }
        } else if (pn < 6) {
#pragma unroll
            for (int ai = 0; ai < 2; ++ai)
#pragma unroll
                for (int m = 0; m < 4; ++m) { const int row = row0 + ai * 128 + m * 16, b = row >> 11, s = row & 2047;
#pragma unroll
                    for (int bj = 0; bj < 2; ++bj)
#pragma unroll
                        for (int n = 0; n < 2; ++n)
#pragma unroll
                            for (int j = 0; j < 4; ++j) { const int c = (pn - 4) * 256 + bj * 128 + cl + 4 * n + j;
                                Vt[((size_t)(b * 512 + c)) * 2048 + s] = bf1(acc[ai][bj][m][n][j]); } }
        } else if (pn < 13) {
            const int cb = (pn - 6) * 256 + cl;
#pragma unroll
            for (int ai = 0; ai < 2; ++ai)
#pragma unroll
                for (int m = 0; m < 4; ++m) { bf16_t* rp = Prw + (size_t)(row0 + ai * 128 + m * 16) * RWC + cb;
#pragma unroll
                    for (int bj = 0; bj < 2; ++bj) *(u32x4*)(rp + bj * 128) = pack8(acc[ai][bj][m][0], acc[ai][bj][m][1]); }
        } else {
            const int cb = (pn - 13) * 256 + cl;
#pragma unroll
            for (int ai = 0; ai < 2; ++ai)
#pragma unroll
                for (int m = 0; m < 4; ++m) { bf16_t* rp = Gt + (size_t)(row0 + ai * 128 + m * 16) * GC + cb;
#pragma unroll
                    for (int bj = 0; bj < 2; ++bj) { f32x4 v0 = acc[ai][bj][m][0] + *(const f32x4*)(bgate + cb + bj * 128), v1 = acc[ai][bj][m][1] + *(const f32x4*)(bgate + cb + bj * 128 + 4);
#pragma unroll
                        for (int j = 0; j < 4; ++j) { v0[j] = fsigmoid(v0[j]); v1[j] = fsigmoid(v1[j]); }
                        *(u32x4*)(rp + bj * 128) = pack8(v0, v1); } }
        }
    }
};
template <int MODE> struct EpiRow {
    static constexpr bool PERM = true, AFTER_DRAIN = false;
    bf16_t* O; const bf16_t* T1; const bf16_t* Gt;
    __device__ __forceinline__ void operator()(const f32x4 (&acc)[2][2][4][2], const pg8::Unit& u, int wr, int wc, int fr, int fq) const {
        const int row0 = u.pm * 256 + wr * 64 + fr, cb = u.pn * 256 + wc * 32 + 8 * fq;
#pragma unroll
        for (int ai = 0; ai < 2; ++ai)
#pragma unroll
            for (int m = 0; m < 4; ++m) { const size_t row = (size_t)(row0 + ai * 128 + m * 16);
#pragma unroll
                for (int bj = 0; bj < 2; ++bj) { f32x4 v0 = acc[ai][bj][m][0], v1 = acc[ai][bj][m][1]; const int c = cb + bj * 128;
                    if (MODE >= 1) { const u32x4 gg = *(const u32x4*)(Gt + row * GC + (MODE == 2 ? 1024 : 0) + c);
                        v0[0] *= bf_lo(gg.x); v0[1] *= bf_hi(gg.x); v0[2] *= bf_lo(gg.y); v0[3] *= bf_hi(gg.y); v1[0] *= bf_lo(gg.z); v1[1] *= bf_hi(gg.z); v1[2] *= bf_lo(gg.w); v1[3] *= bf_hi(gg.w); }
                    if (MODE == 2) { const u32x4 tt = *(const u32x4*)(T1 + row * 1024 + c);
                        v0[0] += bf_lo(tt.x); v0[1] += bf_hi(tt.x); v0[2] += bf_lo(tt.y); v0[3] += bf_hi(tt.y); v1[0] += bf_lo(tt.z); v1[1] += bf_hi(tt.z); v1[2] += bf_lo(tt.w); v1[3] += bf_hi(tt.w); }
                    *(u32x4*)(O + row * 1024 + c) = pack8(v0, v1); } }
    }
};
struct EpiSwiGLU {
    static constexpr bool PERM = true, AFTER_DRAIN = false;
    bf16_t* Hd;
    __device__ __forceinline__ void operator()(const f32x4 (&acc)[2][2][4][2], const pg8::Unit& u, int wr, int wc, int fr, int fq) const {
        const int row0 = u.pm * 256 + wr * 64 + fr, cb = u.pn * 128 + wc * 32 + 8 * fq;
#pragma unroll
        for (int ai = 0; ai < 2; ++ai)
#pragma unroll
            for (int m = 0; m < 4; ++m) { f32x4 v0, v1;
#pragma unroll
                for (int j = 0; j < 4; ++j) { const float g0 = acc[ai][0][m][0][j], g1 = acc[ai][0][m][1][j];
                    v0[j] = g0 * fsigmoid(g0) * acc[ai][1][m][0][j]; v1[j] = g1 * fsigmoid(g1) * acc[ai][1][m][1][j]; }
                *(u32x4*)(Hd + (size_t)(row0 + ai * 128 + m * 16) * DFF + cb) = pack8(v0, v1); }
    }
};
template <class Epi> __device__ __forceinline__ void run_gemm(PG8_LAS unsigned char* lds, const bf16_t* A, const bf16_t* Bt, int N, int K, const Epi& E, int G) {
    pg8::Gemm g; g.A = A; g.Bt = Bt; g.M = M; g.N = N; g.K = K;
    pg8::StaticOrder S; S.init(M, N, G, (int)blockIdx.x);
    pg8::gemm_phase<Epi, pg8::StaticOrder, true, true>(lds, g, S, E);
}
__device__ __forceinline__ void mix8_lds(const unsigned char* cur, const unsigned char* prv, const float* mu, float (&o)[8]) {
    const u32x4 c = *(const u32x4*)cur, p = *(const u32x4*)prv;
    const f32x4 m0 = *(const f32x4*)mu, m1 = *(const f32x4*)(mu + 4);
    const float mm[8] = {m0[0], m0[1], m0[2], m0[3], m1[0], m1[1], m1[2], m1[3]};
#pragma unroll
    for (int i = 0; i < 4; ++i) { const float cl = bf_lo(c[i]), ch = bf_hi(c[i]), pl = bf_lo(p[i]), ph = bf_hi(p[i]);
        o[2 * i] = cl + (pl - cl) * mm[2 * i]; o[2 * i + 1] = ch + (ph - ch) * mm[2 * i + 1]; }
}
__device__ __forceinline__ void mix4_lds(const unsigned char* cur, const unsigned char* prv, const float* mu, float (&o)[4]) {
    const u32x2 c = *(const u32x2*)cur, p = *(const u32x2*)prv;
    const f32x4 m0 = *(const f32x4*)mu;
#pragma unroll
    for (int i = 0; i < 2; ++i) { const float cl = bf_lo(c[i]), ch = bf_hi(c[i]), pl = bf_lo(p[i]), ph = bf_hi(p[i]);
        o[2 * i] = cl + (pl - cl) * m0[2 * i]; o[2 * i + 1] = ch + (ph - ch) * m0[2 * i + 1]; }
}
__device__ __forceinline__ bf16x8 pack_frag(const float (&v)[8]) {
    u32x4 o; o.x = cvt_pk_bf16(v[0], v[1]); o.y = cvt_pk_bf16(v[2], v[3]); o.z = cvt_pk_bf16(v[4], v[5]); o.w = cvt_pk_bf16(v[6], v[7]);
    return __builtin_bit_cast(bf16x8, o);
}
__device__ __forceinline__ void phase_rwprep(const Args& a, unsigned char* lds, int G) {
    constexpr int ROWB = 3600, L_FRAG = 17 * ROWB, L_PAR = L_FRAG + 8192, NCH = 17 * 224, NT = M / 16;
    const int tid = my_tid(); const int wave = __builtin_amdgcn_readfirstlane(tid >> 6), lane = tid & 63, fr = lane & 15, fq = lane >> 4;
    unsigned char* ws = a.ws;
    const unsigned char* PRW = ws + O_PRW;
    const bf16_t* WLU = (const bf16_t*)(ws + O_WLU); const bf16_t* WLA = (const bf16_t*)(ws + O_WLA); const bf16_t* WLG = (const bf16_t*)(ws + O_WLG);
    unsigned char* SI = ws + O_SI; bf16_t* GB = (bf16_t*)(ws + O_G); float* SC = (float*)(ws + O_SC);
    float* par = (float*)(lds + L_PAR);
    for (int i = tid; i < 1792 + 5 * 512; i += 512) {
        float v;
        if (i < 1792) v = a.in[4][i]; else { const int j = i - 1792, w = j >> 9, c = j & 511; v = (w == 0 ? a.in[5] : w == 1 ? a.in[7] : w == 2 ? a.in[10] : w == 3 ? a.in[11] : a.in[12])[c]; }
        par[i] = v;
    }
    for (int tile = blockIdx.x; tile < NT; tile += G) {
        __syncthreads();
        {   u32x4 pre[8];
#pragma unroll
            for (int j = 0; j < 8; ++j) { const int c = tid + 512 * j; pre[j] = (u32x4){0u, 0u, 0u, 0u};
                if (c < NCH) { const int row = c / 224, col = c - row * 224; const bool zero = (row == 0) && (((tile * 16) & (SEQ - 1)) == 0);
                    if (!zero) pre[j] = __builtin_nontemporal_load((const u32x4*)(PRW + ((size_t)tile * 16 + row - 1) * (RWC * 2) + col * 16)); } }
#pragma unroll
            for (int j = 0; j < 8; ++j) { const int c = tid + 512 * j; if (c < NCH) { const int row = c / 224, col = c - row * 224; *(u32x4*)(lds + row * ROWB + col * 16) = pre[j]; } }
        }
        __syncthreads();
        const unsigned char* rcur = lds + (fr + 1) * ROWB; const unsigned char* rprv = lds + fr * ROWB;
        {
            const int colb = wave < 2 ? 1536 + 32 * wave : (wave < 4 ? 1600 + 32 * (wave - 2) : 1664 + 32 * (wave - 4));
            float t8[8]; mix8_lds(rcur + (colb + 8 * fq) * 2, rprv + (colb + 8 * fq) * 2, par + colb + 8 * fq, t8);
            if (wave < 2) {
#pragma unroll
                for (int i = 0; i < 8; ++i) { const float e = fexp(2.f * t8[i]); t8[i] = 1.f - 2.f * frcp(e + 1.f); } }
            else if (wave >= 4) {
#pragma unroll
                for (int i = 0; i < 8; ++i) t8[i] = fsigmoid(t8[i]); }
            *(bf16x8*)(lds + L_FRAG + wave * 1024 + lane * 16) = pack_frag(t8);
        }
        __syncthreads();
        bf16x8 Aw[2], Aa[2], Ag[4];
#pragma unroll
        for (int s = 0; s < 2; ++s) { Aw[s] = *(const bf16x8*)(lds + L_FRAG + s * 1024 + lane * 16); Aa[s] = *(const bf16x8*)(lds + L_FRAG + (2 + s) * 1024 + lane * 16); }
#pragma unroll
        for (int s = 0; s < 4; ++s) Ag[s] = *(const bf16x8*)(lds + L_FRAG + (4 + s) * 1024 + lane * 16);
        const int h = wave; const size_t m = (size_t)tile * 16 + fr;
        float kkr[16], av[16]; unsigned lk[16], rvp[16];
        float ss = 0.f, brs = 0.f, krs = 0.f, rkbs = 0.f;
#pragma unroll
        for (int n = 0; n < 4; ++n) {
            asm volatile("" ::: "memory");
            const int cb = 64 * h + 16 * n, c0 = cb + 4 * fq;
            f32x4 aw = {0.f, 0.f, 0.f, 0.f}, aa = aw, ag = aw;
#pragma unroll
            for (int s = 0; s < 2; ++s) {
                aw = __builtin_amdgcn_mfma_f32_16x16x32_bf16(*(const bf16x8*)(WLU + (size_t)(cb + fr) * 64 + 32 * s + 8 * fq), Aw[s], aw, 0, 0, 0);
                aa = __builtin_amdgcn_mfma_f32_16x16x32_bf16(*(const bf16x8*)(WLA + (size_t)(cb + fr) * 64 + 32 * s + 8 * fq), Aa[s], aa, 0, 0, 0); }
#pragma unroll
            for (int s = 0; s < 4; ++s)
                ag = __builtin_amdgcn_mfma_f32_16x16x32_bf16(*(const bf16x8*)(WLG + (size_t)(cb + fr) * 128 + 32 * s + 8 * fq), Ag[s], ag, 0, 0, 0);
            float rr[4], kr4[4], vv[4];
            mix4_lds(rcur + c0 * 2, rprv + c0 * 2, par + c0, rr); mix4_lds(rcur + (512 + c0) * 2, rprv + (512 + c0) * 2, par + 512 + c0, kr4); mix4_lds(rcur + (1024 + c0) * 2, rprv + (1024 + c0) * 2, par + 1024 + c0, vv);
            const f32x4 w0v = *(const f32x4*)(par + 1792 + c0), a0v = *(const f32x4*)(par + 2304 + c0), kkv = *(const f32x4*)(par + 2816 + c0), kav = *(const f32x4*)(par + 3328 + c0), rkv = *(const f32x4*)(par + 3840 + c0);
#pragma unroll
            for (int j = 0; j < 4; ++j) {
                const float sg = fsigmoid(w0v[j] + aw[j]);
                const float ldx = -0.60653065971f * 1.44269504089f * sg;
                const float av_ = fsigmoid(a0v[j] + aa[j]);
                const float kkraw = kr4[j] * kkv[j];
                const float k2 = kr4[j] * (1.f + (av_ - 1.f) * kav[j]);
                ss += kkraw * kkraw; brs += kkraw * av_ * rr[j]; krs += k2 * rr[j]; rkbs += rr[j] * k2 * rkv[j];
                kkr[4 * n + j] = kkraw; av[4 * n + j] = av_; lk[4 * n + j] = cvt_pk_bf16(ldx, k2); rvp[4 * n + j] = cvt_pk_bf16(rr[j], vv[j]);
            }
            u32x2 gp; gp.x = cvt_pk_bf16(ag[0], ag[1]); gp.y = cvt_pk_bf16(ag[2], ag[3]);
            *(u32x2*)(GB + m * 512 + c0) = gp;
        }
        ss = red16(ss); brs = red16(brs); krs = red16(krs); rkbs = red16(rkbs);
        const float inv = 1.f / fmaxf(sqrtf(ss), 1e-12f);
        unsigned char* rec = SI + (m * 8 + h) * 768 + fq * 16;
#pragma unroll
        for (int n = 0; n < 4; ++n) {
            unsigned dw[12];
#pragma unroll
            for (int j = 0; j < 4; ++j) { const float kk = kkr[4 * n + j] * inv;
                const unsigned kp = cvt_pk_bf16(kk * av[4 * n + j], -kk);
                dw[3 * j] = (lk[4 * n + j] & 0xffffu) | (kp & 0xffff0000u); dw[3 * j + 1] = (kp & 0xffffu) | (lk[4 * n + j] & 0xffff0000u); dw[3 * j + 2] = rvp[4 * n + j]; }
            unsigned char* dst = rec + 64 * n;
            u32x4 s0 = {dw[0], dw[3], dw[6], dw[9]}, s1 = {dw[1], dw[4], dw[7], dw[10]}, s2 = {dw[2], dw[5], dw[8], dw[11]};
            *(u32x4*)dst = s0; *(u32x4*)(dst + 256) = s1; *(u32x4*)(dst + 512) = s2;
        }
        if (fq == 0) { f32x4 scv = {brs * inv, krs, rkbs, 0.f}; *(f32x4*)(SC + (m * 8 + h) * 4) = scv; }
    }
    __syncthreads();
}

__device__ __forceinline__ float red_rows(float x) {
    float a0 = x, a1 = x;
    asm volatile("s_nop 1\n\tv_permlane16_swap_b32 %0, %1" : "+v"(a0), "+v"(a1));
    float b0 = a0 + a1, b1 = b0;
    asm volatile("s_nop 1\n\tv_permlane32_swap_b32 %0, %1" : "+v"(b0), "+v"(b1));
    return b0 + b1;
}
constexpr int SC_T = 16, SC_ROW = 1280, SC_GEND = SC_T * SC_ROW, SC_BUF = SC_GEND + 256;
struct ProdRec { unsigned d0[SC_T]; unsigned d1[4], d2[4]; };
__device__ __forceinline__ void prod_load(ProdRec& P, const unsigned char* sb, int chunk, int pw, int col) {
    const unsigned char* p = sb + (size_t)chunk * SC_T * 6144 + col * 4;
#pragma unroll
    for (int st = 0; st < SC_T; ++st) P.d0[st] = *(const unsigned*)(p + st * 6144);
#pragma unroll
    for (int q = 0; q < 4; ++q) { P.d1[q] = *(const unsigned*)(p + (4 * pw + q) * 6144 + 256); P.d2[q] = *(const unsigned*)(p + (4 * pw + q) * 6144 + 512); }
}
__device__ __forceinline__ void prod_store(const ProdRec& P, unsigned char* buf, int pw, int col) {
    float L = 0.f;
#pragma unroll
    for (int st = 0; st < SC_T; ++st) {
        const float Lp = L; L += bf_lo(P.d0[st]);
        if ((st >> 2) == pw) { const int q = st & 3; unsigned char* base = buf + st * SC_ROW + col * 4;
            const float gp = __builtin_amdgcn_exp2f(Lp), g = __builtin_amdgcn_exp2f(L), ig = __builtin_amdgcn_exp2f(-L);
            *(float*)(base) = gp * bf_hi(P.d0[st]); *(float*)(base + 256) = g * bf_lo(P.d2[q]);
            *(float*)(base + 512) = bf_lo(P.d1[q]) * ig; *(float*)(base + 768) = bf_hi(P.d1[q]) * ig; *(float*)(base + 1024) = bf_hi(P.d2[q]); }
    }
    if (pw == 0) *(float*)(buf + SC_GEND + col * 4) = __builtin_amdgcn_exp2f(L);
}
#define MK_SWAP32(a, b) asm volatile("s_nop 1\n\tv_permlane32_swap_b32 %0, %1" : "+v"(a), "+v"(b))
#define MK_SWAP16(a, b) asm volatile("s_nop 1\n\tv_permlane16_swap_b32 %0, %1" : "+v"(a), "+v"(b))
__device__ __forceinline__ void red4x8(float& A, float& B, float& C, float& D) {
    MK_SWAP32(A, B); float u = A + B;
    MK_SWAP32(C, D); float w = C + D;
    MK_SWAP16(u, w); float z = u + w;
    float z1;
    asm volatile("s_nop 1\n\tv_add_f32_dpp %0, %1, %1 row_ror:8 row_mask:0xf bank_mask:0xf" : "=&v"(z1) : "v"(z));
    float p = z1, q = z1; MK_SWAP32(p, q);
    float p2 = p; MK_SWAP16(p, p2);
    float q2 = q; MK_SWAP16(q, q2);
    A = p; C = p2; B = q; D = q2;
}
__device__ __forceinline__ void red2x8(float& A, float& B) {
    MK_SWAP32(A, B); float u = A + B;
    float uc = u; MK_SWAP16(u, uc); float z = u + uc;
    float z1;
    asm volatile("s_nop 1\n\tv_add_f32_dpp %0, %1, %1 row_ror:8 row_mask:0xf bank_mask:0xf" : "=&v"(z1) : "v"(z));
    float p = z1, q = z1; MK_SWAP32(p, q);
    A = p; B = q;
}
__device__ __forceinline__ void scan_consume(f32x2 (&S)[8], const unsigned char* buf, unsigned char* ybuf, int lane, int rb) {
    const unsigned co = (unsigned)(lane >> 3) * 32u, vo = 1024u + (unsigned)(16 * rb + (lane & 7)) * 4u;
#pragma unroll 4
    for (int st = 0; st < SC_T; ++st) {
        const unsigned char* sb = buf + st * SC_ROW;
        f32x4 n4[2], r4[2], a4[2], k4[2];
#pragma unroll
        for (int q = 0; q < 2; ++q) { n4[q] = *(const f32x4*)(sb + co + 16 * q); r4[q] = *(const f32x4*)(sb + 256 + co + 16 * q);
            a4[q] = *(const f32x4*)(sb + 512 + co + 16 * q); k4[q] = *(const f32x4*)(sb + 768 + co + 16 * q); }
        const float v0 = *(const float*)(sb + vo), v1 = *(const float*)(sb + vo + 32);
        f32x2 sa0v = {0.f, 0.f}, sa1v = sa0v, yp0v = sa0v, yp1v = sa0v;
#pragma unroll
        for (int p = 0; p < 4; ++p) { const f32x2 nn = {n4[p >> 1][2 * (p & 1)], n4[p >> 1][2 * (p & 1) + 1]}, rr2 = {r4[p >> 1][2 * (p & 1)], r4[p >> 1][2 * (p & 1) + 1]};
            sa0v += S[p] * nn; sa1v += S[4 + p] * nn; yp0v += S[p] * rr2; yp1v += S[4 + p] * rr2; }
        float sa0 = sa0v[0] + sa0v[1], sa1 = sa1v[0] + sa1v[1];
        const f32x2 ypp = {yp0v[0] + yp0v[1], yp1v[0] + yp1v[1]};
        red2x8(sa0, sa1);
        const f32x2 s0 = {sa0, sa0}, s1 = {sa1, sa1}, vv0 = {v0, v0}, vv1 = {v1, v1};
#pragma unroll
        for (int p = 0; p < 4; ++p) { const f32x2 aa = {a4[p >> 1][2 * (p & 1)], a4[p >> 1][2 * (p & 1) + 1]}; S[p] = __builtin_elementwise_fma(aa, s0, S[p]); S[4 + p] = __builtin_elementwise_fma(aa, s1, S[4 + p]); }
        asm volatile("" ::: "memory");
#pragma unroll
        for (int p = 0; p < 4; ++p) { const f32x2 kk = {k4[p >> 1][2 * (p & 1)], k4[p >> 1][2 * (p & 1) + 1]}; S[p] = __builtin_elementwise_fma(kk, vv0, S[p]); S[4 + p] = __builtin_elementwise_fma(kk, vv1, S[4 + p]); }
        *(f32x2*)(ybuf + st * 2048 + rb * 512 + lane * 8) = ypp;
        if (lane < 8) { f32x2 o = {sa0, sa1}; *(f32x2*)(ybuf + SC_T * 2048 + st * 256 + rb * 64 + lane * 8) = o; }
    }
#pragma unroll
    for (int p = 0; p < 4; ++p) { const f32x4 g4 = *(const f32x4*)(buf + SC_GEND + co + 16 * (p >> 1)); const f32x2 gg = {g4[2 * (p & 1)], g4[2 * (p & 1) + 1]}; S[p] = S[p] * gg; S[4 + p] = S[4 + p] * gg; }
}
struct FinIn { unsigned v[4]; f32x2 bk[4]; };
__device__ __forceinline__ void fin_load(FinIn& F, const unsigned char* sb, const float* scp, int chunk, int pw, int lane) {
#pragma unroll
    for (int q = 0; q < 4; ++q) { const size_t t = (size_t)chunk * SC_T + (lane >> 4) + 4 * q;
        F.v[q] = *(const unsigned short*)(sb + t * 6144 + 512 + (16 * pw + (lane & 15)) * 4 + 2); F.bk[q] = *(const f32x2*)(scp + t * 32); }
}
__device__ __forceinline__ void prod_finish(const FinIn& F, const unsigned char* ybuf, unsigned* yr, int pw, int lane) {
#pragma unroll
    for (int q = 0; q < 4; ++q) { const int st = (lane >> 4) + 4 * q, row16 = lane & 15, e = row16 >> 3, rr = row16 & 7;
        const unsigned char* yp8 = ybuf + st * 2048 + pw * 512 + rr * 8 + e * 4; float yp = 0.f;
#pragma unroll
        for (int cg = 0; cg < 8; ++cg) yp += *(const float*)(yp8 + cg * 64);
        const float sa = *(const float*)(ybuf + SC_T * 2048 + st * 256 + pw * 64 + rr * 8 + e * 4);
        const float v = __uint_as_float(F.v[q] << 16), y = yp + sa * F.bk[q][0] + v * F.bk[q][1];
        yr[(size_t)st * 512 + row16] = (unsigned)bf1(y) | (F.v[q] << 16); }
}

__device__ __forceinline__ void rwpost_local(const Args& a, int bh, int tid) {
    const float* SC = (const float*)(a.ws + O_SC);
    const unsigned* YR = (const unsigned*)(a.ws + O_YR); const bf16_t* GB = (const bf16_t*)(a.ws + O_G); bf16_t* ORW = (bf16_t*)(a.ws + O_ORW);
    const int b = bh >> 3, h = bh & 7, c = 64 * h + (tid & 15) * 4;
    const f32x4 lwv = *(const f32x4*)(a.in[13] + c), lbv = *(const f32x4*)(a.in[14] + c);
    for (int t0 = tid >> 4; t0 < SEQ; t0 += 64) {
        u32x4 yv[2]; u32x2 gb[2]; float rkb[2]; size_t mm[2];
#pragma unroll
        for (int u = 0; u < 2; ++u) { const size_t m = (size_t)b * SEQ + t0 + 32 * u; mm[u] = m;
            yv[u] = __builtin_nontemporal_load((const u32x4*)(YR + m * 512 + c)); gb[u] = __builtin_nontemporal_load((const u32x2*)(GB + m * 512 + c)); rkb[u] = SC[(m * 8 + h) * 4 + 2]; }
#pragma unroll
        for (int u = 0; u < 2; ++u) {
            float y[4] = {bf_lo(yv[u].x), bf_lo(yv[u].y), bf_lo(yv[u].z), bf_lo(yv[u].w)};
            const float v[4] = {bf_hi(yv[u].x), bf_hi(yv[u].y), bf_hi(yv[u].z), bf_hi(yv[u].w)};
            float s = (y[0] + y[1]) + (y[2] + y[3]);
#pragma unroll
            for (int o = 1; o < 16; o <<= 1) s += __shfl_xor(s, o);
            const float mean = s * (1.f / 64.f);
            float q = 0.f;
#pragma unroll
            for (int j = 0; j < 4; ++j) { y[j] -= mean; q += y[j] * y[j]; }
#pragma unroll
            for (int o = 1; o < 16; o <<= 1) q += __shfl_xor(q, o);
            const float rstd = rsqrtf(q * (1.f / 64.f) + GN_EPS);
            const float g4[4] = {bf_lo(gb[u].x), bf_hi(gb[u].x), bf_lo(gb[u].y), bf_hi(gb[u].y)};
            float o4[4];
#pragma unroll
            for (int j = 0; j < 4; ++j) o4[j] = (y[j] * rstd * lwv[j] + lbv[j] + rkb[u] * v[j]) * g4[j];
            u32x2 ob; ob.x = cvt_pk_bf16(o4[0], o4[1]); ob.y = cvt_pk_bf16(o4[2], o4[3]);
            *(u32x2*)(ORW + mm[u] * 512 + c) = ob;
        }
    }
}

struct KV { bf16x8 k[4]; bf16x8 v[2][2]; };
__device__ __forceinline__ void attn_load(KV& T, const bf16_t* Kh, const bf16_t* Vh, int k0, int n, int hf) {
    const bf16_t* kp = Kh + (size_t)(k0 + n) * 512 + 8 * hf;
#pragma unroll
    for (int s = 0; s < 4; ++s) T.k[s] = *(const bf16x8*)(kp + 16 * s);
#pragma unroll
    for (int d = 0; d < 2; ++d)
#pragma unroll
        for (int sg = 0; sg < 2; ++sg) { const bf16_t* vp = Vh + (size_t)(32 * d + n) * SEQ + k0 + 16 * sg + 4 * hf;
            const u32x2 lo = *(const u32x2*)vp, hi = *(const u32x2*)(vp + 8); u32x4 t = {lo.x, lo.y, hi.x, hi.y}; T.v[d][sg] = __builtin_bit_cast(bf16x8, t); }
}
__device__ __forceinline__ void attn_wave(const Args& a, int bh, int w4, int lane) {
    const int b = bh >> 3, h = bh & 7, n = lane & 31, hf = lane >> 5;
    const size_t m0 = (size_t)b * SEQ;
    const bf16_t* Qh = (const bf16_t*)(a.ws + O_Q) + m0 * 512 + 64 * h;
    const bf16_t* Kh = (const bf16_t*)(a.ws + O_K) + m0 * 512 + 64 * h;
    const bf16_t* Vh = (const bf16_t*)(a.ws + O_VT) + (size_t)bh * 64 * SEQ;
    bf16_t* Oh = (bf16_t*)(a.ws + O_OSB) + m0 * 512 + 64 * h;
    for (int qt = 63 - w4; qt >= 0; qt -= 8) {
        const int q0 = 32 * qt;
        bf16x8 qf[4];
#pragma unroll
        for (int s = 0; s < 4; ++s) qf[s] = *(const bf16x8*)(Qh + (size_t)(q0 + n) * 512 + 16 * s + 8 * hf);
        f32x16 o0, o1;
#pragma unroll
        for (int i = 0; i < 16; ++i) { o0[i] = 0.f; o1[i] = 0.f; }
        float carry = 0.f;
        KV cur, nxt;
        attn_load(cur, Kh, Vh, q0, n, hf);
        for (int kt = qt; kt >= 0; --kt) {
            const int ktn = kt > 0 ? kt - 1 : 0;
            attn_load(nxt, Kh, Vh, 32 * ktn, n, hf);
            f32x16 sc;
#pragma unroll
            for (int i = 0; i < 16; ++i) sc[i] = 0.f;
#pragma unroll
            for (int s = 0; s < 4; ++s) sc = __builtin_amdgcn_mfma_f32_32x32x16_bf16(cur.k[s], qf[s], sc, 0, 0, 0);
            const bool diag = (kt == qt);
            float lf[16], G4[4];
#pragma unroll
            for (int g = 0; g < 4; ++g) { G4[g] = 0.f;
#pragma unroll
                for (int i = 0; i < 4; ++i) { const int r = 4 * g + i; const float z = sc[r];
                    const bool valid = !diag || (8 * g + 4 * hf + i < n);
                    const float e = fexp(-fabsf(z));
                    const float sp = fmaxf(z, 0.f) + flog(1.f + e);
                    lf[r] = valid ? -sp : 0.f; G4[g] += lf[r]; } }
            float PG[4], T4[4];
#pragma unroll
            for (int g = 0; g < 4; ++g) { PG[g] = __shfl_xor(G4[g], 32); T4[g] = G4[g] + PG[g]; }
            const float tail3 = 0.f, tail2 = T4[3], tail1 = T4[3] + T4[2], tail0 = tail1 + T4[1], total = tail0 + T4[0];
            const float tails[4] = {tail0, tail1, tail2, tail3};
            f32x16 wv;
#pragma unroll
            for (int g = 0; g < 4; ++g) {
                float af = carry + tails[g] + (hf == 0 ? PG[g] : 0.f);
#pragma unroll
                for (int i = 3; i >= 0; --i) { const int r = 4 * g + i; const float z = sc[r];
                    const bool valid = !diag || (8 * g + 4 * hf + i < n);
                    const float wgt = fexp(lf[r] + z + af);
                    wv[r] = valid ? wgt : 0.f;
                    af += lf[r]; } }
            carry += total;
            bf16x8 wf[2];
#pragma unroll
            for (int sg = 0; sg < 2; ++sg) { u32x4 t; t.x = cvt_pk_bf16(wv[8 * sg + 0], wv[8 * sg + 1]); t.y = cvt_pk_bf16(wv[8 * sg + 2], wv[8 * sg + 3]); t.z = cvt_pk_bf16(wv[8 * sg + 4], wv[8 * sg + 5]); t.w = cvt_pk_bf16(wv[8 * sg + 6], wv[8 * sg + 7]); wf[sg] = __builtin_bit_cast(bf16x8, t); }
#pragma unroll
            for (int sg = 0; sg < 2; ++sg) { o0 = __builtin_amdgcn_mfma_f32_32x32x16_bf16(cur.v[0][sg], wf[sg], o0, 0, 0, 0); o1 = __builtin_amdgcn_mfma_f32_32x32x16_bf16(cur.v[1][sg], wf[sg], o1, 0, 0, 0); }
            cur = nxt;
#if MK_EARLY_EXIT
            if (__all(carry < -104.f)) break;
#endif
        }
        bf16_t* op = Oh + (size_t)(q0 + n) * 512 + 4 * hf;
#pragma unroll
        for (int g = 0; g < 4; ++g) {
            u32x2 t0, t1; t0.x = cvt_pk_bf16(o0[4 * g], o0[4 * g + 1]); t0.y = cvt_pk_bf16(o0[4 * g + 2], o0[4 * g + 3]); t1.x = cvt_pk_bf16(o1[4 * g], o1[4 * g + 1]); t1.y = cvt_pk_bf16(o1[4 * g + 2], o1[4 * g + 3]);
            *(u32x2*)(op + 8 * g) = t0; *(u32x2*)(op + 32 + 8 * g) = t1; }
    }
}
__device__ __forceinline__ void phase_mixer(const Args& a, unsigned char* lds, int G) {
    const int tid = my_tid(); const int wave = __builtin_amdgcn_readfirstlane(tid >> 6), lane = tid & 63;
    for (int bh = blockIdx.x; bh < NB * NH; bh += G) {
        const int b = bh >> 3, h = bh & 7; const size_t m0 = (size_t)b * SEQ;
        const unsigned char* sb = a.ws + O_SI + (m0 * 8 + h) * 768; const float* scp = (const float*)(a.ws + O_SC) + (m0 * 8 + h) * 4;
        unsigned* yrb = (unsigned*)(a.ws + O_YR) + m0 * 512 + 64 * h + 16 * (wave & 3);
        constexpr int NCH = SEQ / SC_T;
        ProdRec pr; f32x2 S[8]; const int pw = wave & 3, pcol = tid & 63;
#pragma unroll
        for (int p = 0; p < 8; ++p) S[p] = (f32x2){0.f, 0.f};
        __syncthreads();
        FinIn fin;
        if (wave >= 4) { prod_load(pr, sb, 0, pw, pcol); prod_store(pr, lds, pw, pcol); prod_load(pr, sb, 1, pw, pcol); fin_load(fin, sb, scp, 0, pw, lane); }
        __syncthreads();
        unsigned char* yring = lds + 2 * SC_BUF;
        for (int ci = 0; ci < NCH; ++ci) {
            if (wave < 4) scan_consume(S, lds + (ci & 1) * SC_BUF, yring + (ci & 1) * (SC_T * 2304), lane, wave);
            else {
                if (ci > 0) { prod_finish(fin, yring + ((ci - 1) & 1) * (SC_T * 2304), yrb + (size_t)(ci - 1) * SC_T * 512, pw, lane); fin_load(fin, sb, scp, ci, pw, lane); }
                if (ci + 1 < NCH) { prod_store(pr, lds + ((ci + 1) & 1) * SC_BUF, pw, pcol); prod_load(pr, sb, ci + 2 < NCH ? ci + 2 : ci + 1, pw, pcol); }
            }
            __syncthreads();
        }
        if (wave >= 4) prod_finish(fin, yring + ((NCH - 1) & 1) * (SC_T * 2304), yrb + (size_t)(NCH - 1) * SC_T * 512, pw, lane);
        attn_wave(a, bh, wave, lane);
        __threadfence_block(); __syncthreads();
        rwpost_local(a, bh, my_tid());
    }
}

template <int MODE> __device__ __forceinline__ void phase_rows(const Args& a, int G) {
    const int tid = my_tid(); const int wave = tid >> 6, lane = tid & 63;
    const int gw = blockIdx.x * 8 + wave, NGW = G * 8;
    const bf16_t* T = (const bf16_t*)(a.ws + (MODE == 0 ? O_TT : O_FF));
    const float* g1 = MODE == 0 ? a.in[18] : a.in[23]; const float* g2 = a.in[19];
    bf16_t* H2 = (bf16_t*)(a.ws + O_H2); bf16_t* X1B = (bf16_t*)(a.ws + O_X1B);
    f32x4 g1v[4], g2v[4];
#pragma unroll
    for (int j = 0; j < 4; ++j) { g1v[j] = ((const f32x4*)g1)[lane + 64 * j]; g2v[j] = ((const f32x4*)g2)[lane + 64 * j]; }
    for (int row0 = gw; row0 < M; row0 += 2 * NGW) {
        u32x2 tb[2][4]; f32x4 x[2][4];
#pragma unroll
        for (int u = 0; u < 2; ++u) { const int row = (row0 + u * NGW < M) ? row0 + u * NGW : row0;
            const u32x2* tr = (const u32x2*)(T + (size_t)row * D) + lane;
#pragma unroll
            for (int j = 0; j < 4; ++j) tb[u][j] = __builtin_nontemporal_load(tr + 64 * j);
            if (MODE == 0) { const f32x4* xr = (const f32x4*)(a.in[0] + (size_t)row * D) + lane;
#pragma unroll
                for (int j = 0; j < 4; ++j) x[u][j] = __builtin_nontemporal_load(xr + 64 * j); }
            else { const u32x2* xr = (const u32x2*)(X1B + (size_t)row * D) + lane;
#pragma unroll
                for (int j = 0; j < 4; ++j) { const u32x2 xb = __builtin_nontemporal_load(xr + 64 * j); x[u][j][0] = bf_lo(xb.x); x[u][j][1] = bf_hi(xb.x); x[u][j][2] = bf_lo(xb.y); x[u][j][3] = bf_hi(xb.y); } } }
#pragma unroll
        for (int u = 0; u < 2; ++u) {
            const int row = row0 + u * NGW;
            f32x4 t[4]; float s = 0.f;
#pragma unroll
            for (int j = 0; j < 4; ++j) { t[j][0] = bf_lo(tb[u][j].x); t[j][1] = bf_hi(tb[u][j].x); t[j][2] = bf_lo(tb[u][j].y); t[j][3] = bf_hi(tb[u][j].y);
                s += (t[j][0] * t[j][0] + t[j][1] * t[j][1]) + (t[j][2] * t[j][2] + t[j][3] * t[j][3]); }
            const float rs = rsqrtf(wave_sum(s) * (1.f / D) + RMS_EPS);
            float s2 = 0.f;
#pragma unroll
            for (int j = 0; j < 4; ++j)
#pragma unroll
                for (int e = 0; e < 4; ++e) { x[u][j][e] += t[j][e] * rs * g1v[j][e]; s2 += x[u][j][e] * x[u][j][e]; }
            float rs2 = 0.f;
            if (MODE == 0) rs2 = rsqrtf(wave_sum(s2) * (1.f / D) + RMS_EPS);
            if (row < M) {
                if (MODE == 0) {
                    u32x2* xo = (u32x2*)(X1B + (size_t)row * D) + lane; u32x2* o = (u32x2*)(H2 + (size_t)row * D) + lane;
#pragma unroll
                    for (int j = 0; j < 4; ++j) { u32x2 w; w.x = cvt_pk_bf16(x[u][j][0], x[u][j][1]); w.y = cvt_pk_bf16(x[u][j][2], x[u][j][3]); xo[64 * j] = w; }
#pragma unroll
                    for (int j = 0; j < 4; ++j) { u32x2 w; w.x = cvt_pk_bf16(x[u][j][0] * rs2 * g2v[j][0], x[u][j][1] * rs2 * g2v[j][1]); w.y = cvt_pk_bf16(x[u][j][2] * rs2 * g2v[j][2], x[u][j][3] * rs2 * g2v[j][3]); o[64 * j] = w; }
                } else {
                    f32x4* orow = (f32x4*)(a.out + (size_t)row * D) + lane;
#pragma unroll
                    for (int j = 0; j < 4; ++j) __builtin_nontemporal_store(x[u][j], orow + 64 * j);
                }
            }
        }
    }
}

#define XB_TMO      128
#define XB_XCNT(j)  (256  + 64 * (j))
#define XB_XSUB(j)  (1280 + 64 * (j))
#define XB_XGEN(j)  (2304 + 64 * (j))
#define XB_TOP      3328
#define XB_TOPGEN   3392
#define XCD_BAR_WORDS 3456
#define XB_SPIN_CAP (1u << 18)

__device__ __forceinline__ unsigned xb_ld(unsigned* p)              { return __hip_atomic_load(p, __ATOMIC_RELAXED, __HIP_MEMORY_SCOPE_AGENT); }
__device__ __forceinline__ unsigned xb_add(unsigned* p, unsigned v) { return __hip_atomic_fetch_add(p, v, __ATOMIC_RELAXED, __HIP_MEMORY_SCOPE_AGENT); }
__device__ __forceinline__ unsigned xb_xcc_id() { return (unsigned)__builtin_amdgcn_s_getreg((3 << 11) | 20) & 0xFu; }
#define XB_SPIN(cond, bar) do { unsigned _sp = 0; while (cond) { __builtin_amdgcn_s_sleep(1); \
    if ((++_sp & 255u) == 0u) { if (xb_ld(&(bar)[XB_TMO])) break; if (_sp > XB_SPIN_CAP) { atomicAdd(&(bar)[XB_TMO], 1u); break; } } } } while (0)

struct XcdBarrier {
    unsigned* bar; unsigned x;
    volatile __attribute__((address_space(3))) unsigned* st;
};

__device__ __forceinline__ XcdBarrier xcd_barrier_post(unsigned* bar, volatile __attribute__((address_space(3))) unsigned* st) {
    XcdBarrier b; b.bar = bar; b.x = xb_xcc_id(); b.st = st;
    if (threadIdx.x == 0) (void)xb_add(&bar[XB_XCNT(b.x)], 1u);
    return b;
}
__device__ __forceinline__ void xcd_barrier_complete(unsigned* bar, unsigned x, unsigned& nloc, unsigned& nx) {
    const unsigned G = gridDim.x * gridDim.y * gridDim.z;
    unsigned sum, cnt, mine, sp = 0u;
    for (;;) {
        sum = 0u; cnt = 0u; mine = 0u;
#pragma unroll
        for (unsigned j = 0; j < 16; ++j) { const unsigned c = xb_ld(&bar[XB_XCNT(j)]); sum += c; cnt += (c > 0u) ? 1u : 0u; mine = (j == x) ? c : mine; }
        if (sum == G) break;
        __builtin_amdgcn_s_sleep(1);
        if ((++sp & 255u) == 0u) { if (xb_ld(&bar[XB_TMO])) break; if (sp > XB_SPIN_CAP) { atomicAdd(&bar[XB_TMO], 1u); break; } }
    }
    nloc = mine > 0u ? mine : 1u; nx = cnt > 0u ? cnt : 1u;
}

__device__ __forceinline__ void xcd_barrier(const XcdBarrier& b) {
    asm volatile("s_waitcnt vmcnt(0)" ::: "memory");
    __syncthreads();
    if (threadIdx.x == 0) {
        unsigned* bar = b.bar;
        __builtin_amdgcn_s_waitcnt(0);
        unsigned nloc = b.st[0], nx = b.st[1];
        if (nloc == 0u) { xcd_barrier_complete(bar, b.x, nloc, nx); b.st[0] = nloc; b.st[1] = nx; }
        const unsigned old = xb_add(&bar[XB_XSUB(b.x)], 1u);
        const unsigned gen = old / nloc;
        if (old + 1u == (gen + 1u) * nloc) {
            __builtin_amdgcn_fence(__ATOMIC_RELEASE, "agent");
            asm volatile("s_waitcnt vmcnt(0)" ::: "memory");
            const unsigned og = xb_add(&bar[XB_TOP], 1u);
            const unsigned tg = og / nx;
            if (og + 1u == (tg + 1u) * nx) xb_add(&bar[XB_TOPGEN], 1u);
            else XB_SPIN(xb_ld(&bar[XB_TOPGEN]) == tg, bar);
            __builtin_amdgcn_fence(__ATOMIC_ACQUIRE, "agent");
            xb_add(&bar[XB_XGEN(b.x)], 1u);
            asm volatile("s_waitcnt vmcnt(0)" ::: "memory");
        } else {
            XB_SPIN(xb_ld(&bar[XB_XGEN(b.x)]) == gen, bar);
            __builtin_amdgcn_fence(__ATOMIC_ACQUIRE, "agent");
            asm volatile("s_waitcnt vmcnt(0)" ::: "memory");
        }
    }
    __syncthreads();
}

__global__ void __launch_bounds__(512, 2) mega(Args a) {
    extern __shared__ __attribute__((aligned(16))) unsigned char shm[];
    PG8_LAS unsigned char* lds = (PG8_LAS unsigned char*)shm;
    const int G = (int)gridDim.x;
    unsigned char* ws = a.ws;
    volatile __attribute__((address_space(3))) unsigned* bst = (volatile __attribute__((address_space(3))) unsigned*)(lds + pg8::STAGE_BYTES);
    if (threadIdx.x == 0) { bst[0] = 0u; bst[1] = 0u; }
    __syncthreads();
    const XcdBarrier bar = xcd_barrier_post((unsigned*)(ws + O_CTL), bst);
    cg::this_grid().sync();
    phase_prep(a, (float*)shm, G);
    xcd_barrier(bar);
    { Epi1 E; E.Q = (bf16_t*)(ws + O_Q); E.Kb = (bf16_t*)(ws + O_K); E.Vt = (bf16_t*)(ws + O_VT); E.Prw = (bf16_t*)(ws + O_PRW); E.Gt = (bf16_t*)a.out; E.bgate = a.in[3];
      run_gemm(lds, (const bf16_t*)(ws + O_H), (const bf16_t*)(ws + O_WIN), INC, 1024, E, G); }
    xcd_barrier(bar);
    phase_rwprep(a, shm, G);
    xcd_barrier(bar);
    phase_mixer(a, shm, G);
    xcd_barrier(bar);
    { EpiRow<1> E; E.O = (bf16_t*)(ws + O_T1); E.T1 = nullptr; E.Gt = (const bf16_t*)a.out;
      run_gemm(lds, (const bf16_t*)(ws + O_OSB), (const bf16_t*)(ws + O_WSB), 1024, 512, E, G); }
    { EpiRow<2> E; E.O = (bf16_t*)(ws + O_MRG); E.T1 = (const bf16_t*)(ws + O_T1); E.Gt = (const bf16_t*)a.out;
      run_gemm(lds, (const bf16_t*)(ws + O_ORW), (const bf16_t*)(ws + O_WRW), 1024, 512, E, G); }
    xcd_barrier(bar);
    { EpiRow<0> E; E.O = (bf16_t*)(ws + O_TT); E.T1 = nullptr; E.Gt = nullptr;
      run_gemm(lds, (const bf16_t*)(ws + O_MRG), (const bf16_t*)(ws + O_WO), 1024, 1024, E, G); }
    xcd_barrier(bar);
    phase_rows<0>(a, G);
    xcd_barrier(bar);
    { EpiSwiGLU E; E.Hd = (bf16_t*)(ws + O_HID);
      run_gemm(lds, (const bf16_t*)(ws + O_H2), (const bf16_t*)(ws + O_WGU), 2 * DFF, 1024, E, G); }
    xcd_barrier(bar);
    { EpiRow<0> E; E.O = (bf16_t*)(ws + O_FF); E.T1 = nullptr; E.Gt = nullptr;
      run_gemm(lds, (const bf16_t*)(ws + O_HID), (const bf16_t*)(ws + O_WDN), 1024, DFF, E, G); }
    xcd_barrier(bar);
    phase_rows<1>(a, G);
}
}

extern "C" void kernel_launch(void* const* d_in, const int* in_sizes, int n_in, void* d_out, int out_size, void* d_ws, size_t ws_size, hipStream_t stream) {
    static int grid = 0;
    if (grid == 0) {
        if (n_in != 24 || in_sizes[0] != mk::M * mk::D || out_size != mk::M * mk::D || ws_size < mk::WS_NEED) {
            fprintf(stderr, "kernel_launch: unexpected shapes: n_in %d in0 %d out %d ws %zu (need %zu)\n", n_in, n_in > 0 ? in_sizes[0] : -1, out_size, ws_size, (size_t)mk::WS_NEED); grid = -1; return; }
        int dev = 0, cus = 0, per_cu = 0;
        hipGetDevice(&dev); hipDeviceGetAttribute(&cus, hipDeviceAttributeMultiprocessorCount, dev);
        if (hipFuncSetAttribute((const void*)mk::mega, hipFuncAttributeMaxDynamicSharedMemorySize, mk::LDS_BYTES) != hipSuccess) { fprintf(stderr, "kernel_launch: hipFuncSetAttribute failed\n"); grid = -1; return; }
        if (hipOccupancyMaxActiveBlocksPerMultiprocessor(&per_cu, (const void*)mk::mega, 512, mk::LDS_BYTES) != hipSuccess || per_cu < 1) { fprintf(stderr, "kernel_launch: occupancy query failed (%d)\n", per_cu); per_cu = 1; }
        (void)hipGetLastError();
        grid = cus * per_cu;
        fprintf(stderr, "kernel_launch: grid %d (cus %d x %d)\n", grid, cus, per_cu);
    }
    if (grid < 0) return;
    mk::Args a{};
    for (int i = 0; i < 24; ++i) a.in[i] = (const float*)d_in[i];
    a.out = (float*)d_out; a.ws = (unsigned char*)d_ws;
    a.ph_lo = 0; a.ph_hi = mk::NPH;
    if (hipMemsetAsync((char*)d_ws + mk::O_CTL, 0, mk::CTL_BYTES, stream) != hipSuccess) { fprintf(stderr, "kernel_launch: hipMemsetAsync failed\n"); return; }
    void* args[] = {&a};
    hipError_t e = hipLaunchCooperativeKernel((const void*)mk::mega, dim3(grid), dim3(512), args, mk::LDS_BYTES, stream);
    if (e != hipSuccess) fprintf(stderr, "kernel_launch: cooperative launch failed: %s (grid %d)\n", hipGetErrorString(e), grid);
}
```

```cpp
#include <hip/hip_runtime.h>
#include <hip/hip_cooperative_groups.h>
#include <cstdio>
#include <cstdint>
namespace cg = cooperative_groups;
#ifndef MK_SPLIT
#define MK_SPLIT 0
#endif
#ifndef MK_DIAG
#define MK_DIAG 0
#endif
#ifndef MK_REPMASK
#define MK_REPMASK 0
#endif
#ifndef MK_EARLY_EXIT
#define MK_EARLY_EXIT 1
#endif
namespace pg8 {
#define PG8_LAS __attribute__((address_space(3)))
typedef unsigned short bf16_t;
typedef short bf16x8 __attribute__((ext_vector_type(8)));
typedef float f32x4 __attribute__((ext_vector_type(4)));
typedef unsigned u32x4 __attribute__((ext_vector_type(4)));
constexpr int BM = 256, BK = 64, HALF = 128, HTB = HALF * BK * 2  , STAGE_BYTES = 8 * HTB, NXCD = 8, WGM = 8;

__host__ __device__ __forceinline__ int lds_byte(int r, int c) { const int st = (r >> 4) * 2 + (c >> 5), rr = r & 15, cc = c & 31, ob = rr * 64 + cc * 2; return st * 1024 + (ob ^ (((ob >> 9) & 1) << 5)); }
__host__ __device__ __forceinline__ void stage_rc(int b, int& R, int& C) { const int st = b / 1024, sb = b % 1024, swz = sb ^ (((sb >> 9) & 1) << 5); R = (st >> 1) * 16 + swz / 64; C = (st & 1) * 32 + (swz % 64) / 2; }
__host__ __device__ __forceinline__ int perm32(int rho) { const int n = rho >> 4, i = rho & 15; return 8 * (i >> 2) + 4 * n + (i & 3); }

struct Unit { int pm, pn; };
struct Gemm { const bf16_t* A; const bf16_t* Bt; int M, N, K; };

struct StaticOrder {
    int nM, nN, nwg, G, c;
    __host__ __device__ void init(int M, int N, int G_, int c_) { nM = M / BM; nN = N / BM; nwg = nM * nN; G = G_; c = c_; }
    __host__ __device__ bool next(int i, Unit& u) const {
        const long L = (long)i * G + c; if (L >= nwg) return false;
        int wgid = (int)L; { const int q = nwg / NXCD, r = nwg % NXCD, xcd = wgid % NXCD, off = wgid / NXCD; wgid = (xcd < r ? xcd * (q + 1) : r * (q + 1) + (xcd - r) * q) + off; }
        const int nig = WGM * nN, gid = wgid / nig, fm = gid * WGM, gsz = (nM - fm) < WGM ? (nM - fm) : WGM;
        u.pm = fm + ((wgid % nig) % gsz); u.pn = (wgid % nig) / gsz; return true;
    }
    __device__ __forceinline__ void a_ready(const Unit&) const {}
    __device__ __forceinline__ void done(const Unit&) const {}
};

typedef float cvt_f32x2 __attribute__((ext_vector_type(2)));
typedef __bf16 cvt_bf16x2 __attribute__((ext_vector_type(2)));
__device__ __forceinline__ unsigned cvt_pk_bf16(float lo, float hi) { const cvt_f32x2 v = {lo, hi}; return __builtin_bit_cast(unsigned, __builtin_convertvector(v, cvt_bf16x2)); }
typedef float f32x2 __attribute__((ext_vector_type(2)));

template <class Epi, class Sched, bool ALIGN_EPI = false, bool SP2 = false>
__device__ __forceinline__ void gemm_phase(PG8_LAS unsigned char* lds, const Gemm g, const Sched& S, const Epi& E) {
    int tid_ = threadIdx.x; asm volatile("" : "+v"(tid_)); const int tid = tid_, wid = __builtin_amdgcn_readfirstlane(tid >> 6), lane = tid & 63, wr = wid >> 2, wc = wid & 3, fr = lane & 15, fq = lane >> 4;
    const int K = g.K, nt = K / BK;
    unsigned voffA[2], voffB[2];
#pragma unroll
    for (int i = 0; i < 2; ++i) { int R, C; stage_rc(tid * 16 + i * 8192, R, C); const int Rb = Epi::PERM ? ((R & ~31) + perm32(R & 31)) : R;
        voffA[i] = (unsigned)(R * K + C) * 2u; voffB[i] = (unsigned)(Rb * K + C) * 2u; }
    const size_t kstep = (size_t)(BK * 2);
    const size_t hstep = (size_t)HALF * K * 2;
    const size_t tstep = 2 * hstep;
    const unsigned ldsw = (unsigned)wid * 1024u;
    const int aoff = lds_byte(wr * 64 + fr, fq * 8), boff = lds_byte(wc * 32 + fr, fq * 8);
#define PG8_SA(b, h) (((b) * 2 + (h)) * HTB)
#define PG8_SB(b, h) ((4 + (b) * 2 + (h)) * HTB)
#define PG8_STAGE(bufoff, gbase, voff) do { _Pragma("unroll") for (int _i = 0; _i < 2; ++_i) \
        __builtin_amdgcn_global_load_lds((const unsigned*)((const char*)(gbase) + (voff)[_i]), (PG8_LAS unsigned*)(lds + (bufoff) + ldsw + _i * 8192), 16, 0, 0); } while (0)
#define PG8_LDA(dst, b, h) do { _Pragma("unroll") for (int m = 0; m < 4; ++m) _Pragma("unroll") for (int k = 0; k < 2; ++k) dst[m][k] = *(const PG8_LAS bf16x8*)(lds + PG8_SA(b, h) + aoff + m * 2048 + k * 1024); } while (0)
#define PG8_LDB(dst, b, h) do { _Pragma("unroll") for (int n = 0; n < 2; ++n) _Pragma("unroll") for (int k = 0; k < 2; ++k) dst[n][k] = *(const PG8_LAS bf16x8*)(lds + PG8_SB(b, h) + boff + n * 2048 + k * 1024); } while (0)
#define PG8_MMA(ai, bj, At, Bt) do { __builtin_amdgcn_s_setprio(1); _Pragma("unroll") for (int m = 0; m < 4; ++m) _Pragma("unroll") for (int n = 0; n < 2; ++n) _Pragma("unroll") for (int k = 0; k < 2; ++k) \
        acc[ai][bj][m][n] = __builtin_amdgcn_mfma_f32_16x16x32_bf16(Bt[n][k], At[m][k], acc[ai][bj][m][n], 0, 0, 0); __builtin_amdgcn_s_setprio(0); } while (0)
#define PG8_WAIT_V(n) asm volatile("s_waitcnt vmcnt(" #n ")" ::: "memory")
#define PG8_WAIT_L(n) asm volatile("s_waitcnt lgkmcnt(" #n ")" ::: "memory")
#define PG8_BAR __builtin_amdgcn_s_barrier()
#define PG8_SCHED __builtin_amdgcn_sched_barrier(0)
    Unit cur, nxt; int ui = 0;
    if (!S.next(0, cur)) return;
    f32x4 acc[2][2][4][2];
#pragma unroll
    for (int a = 0; a < 2; ++a)
#pragma unroll
        for (int b = 0; b < 2; ++b)
#pragma unroll
            for (int m = 0; m < 4; ++m)
#pragma unroll
                for (int n = 0; n < 2; ++n) acc[a][b][m][n] = (f32x4){0.f, 0.f, 0.f, 0.f};
    bf16x8 At[4][2], B0[2][2], B1[2][2];
    const char* cA = (const char*)g.A + (size_t)cur.pm * tstep; const char* cB = (const char*)g.Bt + (size_t)cur.pn * tstep;
    S.a_ready(cur);
    if constexpr (SP2) {
        PG8_STAGE(PG8_SB(0, 0), cB, voffB); PG8_STAGE(PG8_SB(0, 1), cB + hstep, voffB); PG8_STAGE(PG8_SA(0, 0), cA, voffA); PG8_STAGE(PG8_SA(0, 1), cA + hstep, voffA);
        if (wr == 1) PG8_BAR;
        PG8_WAIT_V(2); PG8_BAR;
        PG8_STAGE(PG8_SB(1, 0), cB + kstep, voffB); PG8_STAGE(PG8_SA(1, 0), cA + kstep, voffA); PG8_STAGE(PG8_SB(1, 1), cB + hstep + kstep, voffB);
        PG8_WAIT_V(6); PG8_BAR;
    } else {
        PG8_STAGE(PG8_SB(0, 0), cB, voffB); PG8_STAGE(PG8_SA(0, 0), cA, voffA); PG8_STAGE(PG8_SB(0, 1), cB + hstep, voffB); PG8_STAGE(PG8_SA(0, 1), cA + hstep, voffA);
        if (wr == 1) PG8_BAR;
        PG8_WAIT_V(4); PG8_BAR;
        PG8_STAGE(PG8_SB(1, 0), cB + kstep, voffB); PG8_STAGE(PG8_SA(1, 0), cA + kstep, voffA); PG8_STAGE(PG8_SB(1, 1), cB + hstep + kstep, voffB);
        PG8_WAIT_V(6); PG8_BAR;
    }
    for (;;) {
        const bool has_next = S.next(ui + 1, nxt);
        const char* nA = has_next ? (const char*)g.A + (size_t)nxt.pm * tstep : cA; const char* nB = has_next ? (const char*)g.Bt + (size_t)nxt.pn * tstep : cB;
        for (int t = 0; t < nt; t += 2) {
            const bool last = (t == nt - 2);
            const char* a1 = cA + (size_t)(t + 1) * kstep;
            const char* a2 = last ? nA : cA + (size_t)(t + 2) * kstep; const char* b2 = last ? nB : cB + (size_t)(t + 2) * kstep;
            const char* a3 = a2 + kstep; const char* b3 = b2 + kstep;
            if (last && has_next) S.a_ready(nxt);
            if constexpr (SP2) {
            PG8_LDB(B0, 0, 0); PG8_LDB(B1, 0, 1); PG8_SCHED; PG8_LDA(At, 0, 0); PG8_STAGE(PG8_SA(1, 1), a1 + hstep, voffA);
            PG8_WAIT_V(8); PG8_WAIT_L(0); PG8_BAR; PG8_MMA(0, 0, At, B0); PG8_MMA(0, 1, At, B1); PG8_BAR; PG8_SCHED;
            PG8_LDA(At, 0, 1); PG8_STAGE(PG8_SB(0, 0), b2, voffB); PG8_STAGE(PG8_SB(0, 1), b2 + hstep, voffB); PG8_STAGE(PG8_SA(0, 0), a2, voffA);
            PG8_WAIT_V(8); PG8_WAIT_L(0); PG8_BAR; PG8_MMA(1, 0, At, B0); PG8_MMA(1, 1, At, B1); PG8_BAR; PG8_SCHED;
            PG8_LDB(B0, 1, 0); PG8_LDB(B1, 1, 1); PG8_SCHED; PG8_LDA(At, 1, 0); PG8_STAGE(PG8_SA(0, 1), a2 + hstep, voffA);
            PG8_WAIT_V(8); PG8_WAIT_L(0); PG8_BAR; PG8_MMA(0, 0, At, B0); PG8_MMA(0, 1, At, B1); PG8_BAR; PG8_SCHED;
            PG8_LDA(At, 1, 1); PG8_STAGE(PG8_SB(1, 0), b3, voffB); PG8_STAGE(PG8_SB(1, 1), b3 + hstep, voffB); PG8_STAGE(PG8_SA(1, 0), a3, voffA);
            PG8_WAIT_V(8); PG8_WAIT_L(0); PG8_BAR; PG8_MMA(1, 0, At, B0); PG8_MMA(1, 1, At, B1); PG8_BAR; PG8_SCHED;
            } else {
            PG8_LDB(B0, 0, 0); PG8_SCHED; PG8_LDA(At, 0, 0); PG8_STAGE(PG8_SA(1, 1), a1 + hstep, voffA);
            PG8_WAIT_L(8); PG8_BAR; PG8_WAIT_L(0); PG8_MMA(0, 0, At, B0); PG8_BAR; PG8_SCHED;
            PG8_LDB(B1, 0, 1); PG8_STAGE(PG8_SB(0, 0), b2, voffB);
            PG8_BAR; PG8_WAIT_L(0); PG8_MMA(0, 1, At, B1); PG8_BAR;
            PG8_LDA(At, 0, 1); PG8_STAGE(PG8_SA(0, 0), a2, voffA);
            PG8_BAR; PG8_WAIT_L(0); PG8_MMA(1, 0, At, B0); PG8_BAR; PG8_SCHED;
            PG8_STAGE(PG8_SB(0, 1), b2 + hstep, voffB);
            PG8_WAIT_V(6); PG8_BAR; PG8_MMA(1, 1, At, B1); PG8_BAR;
            PG8_LDB(B0, 1, 0); PG8_SCHED; PG8_LDA(At, 1, 0); PG8_STAGE(PG8_SA(0, 1), a2 + hstep, voffA);
            PG8_WAIT_L(8); PG8_BAR; PG8_WAIT_L(0); PG8_MMA(0, 0, At, B0); PG8_BAR; PG8_SCHED;
            PG8_LDB(B1, 1, 1); PG8_STAGE(PG8_SB(1, 0), b3, voffB);
            PG8_BAR; PG8_WAIT_L(0); PG8_MMA(0, 1, At, B1); PG8_BAR;
            PG8_LDA(At, 1, 1); PG8_STAGE(PG8_SA(1, 0), a3, voffA);
            PG8_BAR; PG8_WAIT_L(0); PG8_MMA(1, 0, At, B0); PG8_BAR; PG8_SCHED;
            PG8_STAGE(PG8_SB(1, 1), b3 + hstep, voffB);
            PG8_WAIT_V(6); PG8_BAR; PG8_MMA(1, 1, At, B1); PG8_BAR;
            }
        }
        if constexpr (ALIGN_EPI) { if (wr == 0) PG8_BAR; }
        if constexpr (!Epi::AFTER_DRAIN) { E(acc, cur, wr, wc, fr, fq); S.done(cur); }
        if (!has_next) break;
#pragma unroll
        for (int a = 0; a < 2; ++a)
#pragma unroll
            for (int b = 0; b < 2; ++b)
#pragma unroll
                for (int m = 0; m < 4; ++m)
#pragma unroll
                    for (int n = 0; n < 2; ++n) acc[a][b][m][n] = (f32x4){0.f, 0.f, 0.f, 0.f};
        cur = nxt; cA = nA; cB = nB; ++ui;
        if constexpr (ALIGN_EPI) { if (wr == 1) PG8_BAR; }
    }
    PG8_WAIT_V(0);
    if constexpr (!ALIGN_EPI) { if (wr == 0) PG8_BAR; }
    PG8_BAR;
    if constexpr (Epi::AFTER_DRAIN) { E.fused(acc, cur, wr, wc, fr, fq, lds, wid, lane); S.done(cur); }
#undef PG8_SA
#undef PG8_SB
#undef PG8_STAGE
#undef PG8_LDA
#undef PG8_LDB
#undef PG8_MMA
#undef PG8_WAIT_V
#undef PG8_WAIT_L
#undef PG8_BAR
#undef PG8_SCHED
}

}
namespace mk {
using pg8::bf16_t; using pg8::bf16x8; using pg8::f32x4; using pg8::u32x4; using pg8::cvt_pk_bf16;
typedef float f32x16 __attribute__((ext_vector_type(16)));
typedef float f32x2 __attribute__((ext_vector_type(2)));
typedef unsigned u32x2 __attribute__((ext_vector_type(2)));
constexpr int D = 1024, NB = 32, SEQ = 2048, M = NB * SEQ, NH = 8, DH = 64;
constexpr int RWC = 1792, GC = 2048, INC = 5376, DFF = 2816;
constexpr float RMS_EPS = 1e-6f, GN_EPS = 64e-5f;
constexpr size_t MiB = (size_t)1 << 20;
constexpr size_t O_WIN = 0, O_WSB = 11 * MiB, O_WRW = 12 * MiB, O_WO = 13 * MiB, O_WGU = 15 * MiB, O_WDN = 26 * MiB, O_WLU = 32 * MiB  , O_WLA = O_WLU + 65536, O_WLG = O_WLA + 65536;
constexpr size_t O_Q = 34 * MiB, O_K = 98 * MiB, O_VT = 162 * MiB, O_PRW = 226 * MiB, O_H = 450 * MiB, O_SI = 450 * MiB, O_G = 834 * MiB, O_SC = 898 * MiB, O_YR = 290 * MiB  ;
constexpr size_t O_OSB = 226 * MiB, O_ORW = 34 * MiB, O_T1 = 98 * MiB, O_MRG = 450 * MiB, O_TT = 34 * MiB, O_H2 = 162 * MiB, O_HID = 290 * MiB, O_FF = 34 * MiB;
constexpr size_t O_X1B = 706 * MiB;
constexpr size_t WS_NEED = 1009 * MiB;
constexpr int LDS_BYTES = pg8::STAGE_BYTES + 64;
constexpr size_t O_CTL = 1008 * MiB, CTL_BYTES = 65536;
constexpr int NPH = 12;

struct Args { const float* in[24]; float* out; unsigned char* ws; int ph_lo, ph_hi; };

__device__ __forceinline__ int my_tid() { int t = threadIdx.x; asm volatile("" : "+v"(t)); return t; }
__device__ __forceinline__ float bf_lo(unsigned u) { return __uint_as_float(u << 16); }
__device__ __forceinline__ float bf_hi(unsigned u) { return __uint_as_float(u & 0xffff0000u); }
__device__ __forceinline__ float fexp(float x) { return __builtin_amdgcn_exp2f(x * 1.44269504089f); }
__device__ __forceinline__ float flog(float x) { return __builtin_amdgcn_logf(x) * 0.69314718056f; }
__device__ __forceinline__ float frcp(float x) { return __builtin_amdgcn_rcpf(x); }
__device__ __forceinline__ float fsigmoid(float x) { return frcp(1.f + fexp(-x)); }
__device__ __forceinline__ unsigned short bf1(float x) { return (unsigned short)(cvt_pk_bf16(x, x) & 0xffffu); }
__device__ __forceinline__ u32x4 pack8(const f32x4 a, const f32x4 b) { u32x4 o; o.x = cvt_pk_bf16(a[0], a[1]); o.y = cvt_pk_bf16(a[2], a[3]); o.z = cvt_pk_bf16(b[0], b[1]); o.w = cvt_pk_bf16(b[2], b[3]); return o; }
__device__ __forceinline__ float red16(float v) {
    v += __shfl_xor(v, 16); v += __shfl_xor(v, 32); return v;
}
__device__ __forceinline__ float wave_sum(float v) {
#pragma unroll
    for (int o = 1; o < 64; o <<= 1) v += __shfl_xor(v, o);
    return v;
}

__device__ __forceinline__ void tr_item(const float* __restrict__ W, int K, int N, bf16_t* WT, float* scr, int item, int lane, int mode) {
    const int nblk = N >> 5, kb = item / nblk, nb = item - kb * nblk, k0 = kb << 6, n0 = nb << 5;
#pragma unroll 8
    for (int i = 0; i < 32; ++i) { const int kk = 2 * i + (lane >> 5); scr[kk * 33 + (lane & 31)] = __builtin_nontemporal_load(W + (size_t)(k0 + kk) * N + n0 + (lane & 31)); }
    asm volatile("s_waitcnt lgkmcnt(0)" ::: "memory"); __builtin_amdgcn_wave_barrier();
    const int c = lane & 7;
#pragma unroll
    for (int j = 0; j < 4; ++j) {
        const int n = (lane >> 3) + 8 * j; const float* s = scr + (8 * c) * 33 + n;
        u32x4 o; o.x = cvt_pk_bf16(s[0 * 33], s[1 * 33]); o.y = cvt_pk_bf16(s[2 * 33], s[3 * 33]); o.z = cvt_pk_bf16(s[4 * 33], s[5 * 33]); o.w = cvt_pk_bf16(s[6 * 33], s[7 * 33]);
        const int nn = n0 + n; int drow = nn;
        if (mode == 1) drow = ((nn >> 7) << 8) + (nn & 127); else if (mode == 2) drow = ((nn >> 7) << 8) + 128 + (nn & 127);
        *(u32x4*)(WT + (size_t)drow * K + k0 + 8 * c) = o;
    }
    asm volatile("s_waitcnt lgkmcnt(0)" ::: "memory"); __builtin_amdgcn_wave_barrier();
}

__device__ __forceinline__ void phase_prep(const Args& a, float* lds_f, int G) {
    const int tid = my_tid(); const int wave = tid >> 6, lane = tid & 63;
    const int gw = blockIdx.x * 8 + wave, NGW = G * 8;
    float* scr = lds_f + wave * (64 * 33 + 16);
    unsigned char* ws = a.ws;
    constexpr int I_IN = 16 * 168, I_SB = 8 * 32, I_O = 16 * 32, I_G = 16 * 88, I_DN = 44 * 32, I_LU = 16, I_LG = 32;
    constexpr int NIT = I_IN + 2 * I_SB + I_O + 2 * I_G + I_DN + 2 * I_LU + I_LG;
    for (int it = gw; it < NIT; it += NGW) {
        int r = it;
        if (r < I_IN) { tr_item(a.in[2], 1024, INC, (bf16_t*)(ws + O_WIN), scr, r, lane, 0); continue; } r -= I_IN;
        if (r < I_SB) { tr_item(a.in[15], 512, 1024, (bf16_t*)(ws + O_WSB), scr, r, lane, 0); continue; } r -= I_SB;
        if (r < I_SB) { tr_item(a.in[16], 512, 1024, (bf16_t*)(ws + O_WRW), scr, r, lane, 0); continue; } r -= I_SB;
        if (r < I_O) { tr_item(a.in[17], 1024, 1024, (bf16_t*)(ws + O_WO), scr, r, lane, 0); continue; } r -= I_O;
        if (r < I_G) { tr_item(a.in[20], 1024, DFF, (bf16_t*)(ws + O_WGU), scr, r, lane, 1); continue; } r -= I_G;
        if (r < I_G) { tr_item(a.in[21], 1024, DFF, (bf16_t*)(ws + O_WGU), scr, r, lane, 2); continue; } r -= I_G;
        if (r < I_DN) { tr_item(a.in[22], DFF, 1024, (bf16_t*)(ws + O_WDN), scr, r, lane, 0); continue; } r -= I_DN;
        if (r < I_LU) { tr_item(a.in[6], 64, 512, (bf16_t*)(ws + O_WLU), scr, r, lane, 0); continue; } r -= I_LU;
        if (r < I_LU) { tr_item(a.in[8], 64, 512, (bf16_t*)(ws + O_WLA), scr, r, lane, 0); continue; } r -= I_LU;
        tr_item(a.in[9], 128, 512, (bf16_t*)(ws + O_WLG), scr, r, lane, 0);
    }
    const float* x = a.in[0]; const float* g = a.in[1]; bf16_t* H = (bf16_t*)(ws + O_H);
    f32x4 gv[4];
#pragma unroll
    for (int j = 0; j < 4; ++j) gv[j] = ((const f32x4*)g)[lane + 64 * j];
    for (int row0 = gw; row0 < M; row0 += 2 * NGW) {
        f32x4 v[2][4];
#pragma unroll
        for (int u = 0; u < 2; ++u) { const int row = (row0 + u * NGW < M) ? row0 + u * NGW : row0; const f32x4* xr = (const f32x4*)(x + (size_t)row * D) + lane;
#pragma unroll
            for (int j = 0; j < 4; ++j) v[u][j] = __builtin_nontemporal_load(xr + 64 * j); }
#pragma unroll
        for (int u = 0; u < 2; ++u) { const int row = row0 + u * NGW; float s = 0.f;
#pragma unroll
            for (int j = 0; j < 4; ++j) s += (v[u][j][0] * v[u][j][0] + v[u][j][1] * v[u][j][1]) + (v[u][j][2] * v[u][j][2] + v[u][j][3] * v[u][j][3]);
            const float rs = rsqrtf(wave_sum(s) * (1.f / D) + RMS_EPS);
            if (row < M) { u32x2* o = (u32x2*)(H + (size_t)row * D) + lane;
#pragma unroll
                for (int j = 0; j < 4; ++j) { u32x2 w; w.x = cvt_pk_bf16(v[u][j][0] * rs * gv[j][0], v[u][j][1] * rs * gv[j][1]); w.y = cvt_pk_bf16(v[u][j][2] * rs * gv[j][2], v[u][j][3] * rs * gv[j][3]); o[64 * j] = w; } }
        }
    }
}

struct Epi1 {
    static constexpr bool PERM = true, AFTER_DRAIN = false;
    bf16_t *Q, *Kb, *Vt, *Prw, *Gt; const float* bgate;
    __device__ __forceinline__ void operator()(const f32x4 (&acc)[2][2][4][2], const pg8::Unit& u, int wr, int wc, int fr, int fq) const {
        const int row0 = u.pm * 256 + wr * 64 + fr, pn = u.pn, cl = wc * 32 + 8 * fq;
        if (pn < 4) {
            bf16_t* dst = pn < 2 ? Q : Kb; const float sc = pn < 2 ? 0.125f : 1.f; const int cb = (pn & 1) * 256 + cl;
#pragma unroll
            for (int ai = 0; ai < 2; ++ai)
#pragma unroll
                for (int m = 0; m < 4; ++m) { bf16_t* rp = dst + (size_t)(row0 + ai * 128 + m * 16) * 512 + cb;
#pragma unroll
                    for (int bj = 0; bj < 2; ++bj) *(u32x4*)(rp + bj * 128) = pack8(acc[ai][bj][m][0] * sc, acc[ai][bj][m][1] * sc); }
        } else if (pn < 6) {
#pragma unroll
            for (int ai = 0; ai < 2; ++ai)
#pragma unroll
                for (int m = 0; m < 4; ++m) { const int row = row0 + ai * 128 + m * 16, b = row >> 11, s = row & 2047;
#pragma unroll
                    for (int bj = 0; bj < 2; ++bj)
#pragma unroll
                        for (int n = 0; n < 2; ++n)
#pragma unroll
                            for (int j = 0; j < 4; ++j) { const int c = (pn - 4) * 256 + bj * 128 + cl + 4 * n + j;
                                Vt[((size_t)(b * 512 + c)) * 2048 + s] = bf1(acc[ai][bj][m][n][j]); } }
        } else if (pn < 13) {
            const int cb = (pn - 6) * 256 + cl;
#pragma unroll
            for (int ai = 0; ai < 2; ++ai)
#pragma unroll
                for (int m = 0; m < 4; ++m) { bf16_t* rp = Prw + (size_t)(row0 + ai * 128 + m * 16) * RWC + cb;
#pragma unroll
                    for (int bj = 0; bj < 2; ++bj) *(u32x4*)(rp + bj * 128) = pack8(acc[ai][bj][m][0], acc[ai][bj][m][1]); }
        } else {
            const int cb = (pn - 13) * 256 + cl;
#pragma unroll
            for (int ai = 0; ai < 2; ++ai)
#pragma unroll
                for (int m = 0; m < 4; ++m) { bf16_t* rp = Gt + (size_t)(row0 + ai * 128 + m * 16) * GC + cb;
#pragma unroll
                    for (int bj = 0; bj < 2; ++bj) { f32x4 v0 = acc[ai][bj][m][0] + *(const f32x4*)(bgate + cb + bj * 128), v1 = acc[ai][bj][m][1] + *(const f32x4*)(bgate + cb + bj * 128 + 4);
#pragma unroll
                        for (int j = 0; j < 4; ++j) { v0[j] = fsigmoid(v0[j]); v1[j] = fsigmoid(v1[j]); }
                        *(u32x4*)(rp + bj * 128) = pack8(v0, v1); } }
        }
    }
};
template <int MODE> struct EpiRow {
    static constexpr bool PERM = true, AFTER_DRAIN = false;
    bf16_t* O; const bf16_t* T1; const bf16_t* Gt;
    __device__ __forceinline__ void operator()(const f32x4 (&acc)[2][2][4][2], const pg8::Unit& u, int wr, int wc, int fr, int fq) const {
        const int row0 = u.pm * 256 + wr * 64 + fr, cb = u.pn * 256 + wc * 32 + 8 * fq;
#pragma unroll
        for (int ai = 0; ai < 2; ++ai)
#pragma unroll
            for (int m = 0; m < 4; ++m) { const size_t row = (size_t)(row0 + ai * 128 + m * 16);
#pragma unroll
                for (int bj = 0; bj < 2; ++bj) { f32x4 v0 = acc[ai][bj][m][0], v1 = acc[ai][bj][m][1]; const int c = cb + bj * 128;
                    if (MODE >= 1) { const u32x4 gg = *(const u32x4*)(Gt + row * GC + (MODE == 2 ? 1024 : 0) + c);
                        v0[0] *= bf_lo(gg.x); v0[1] *= bf_hi(gg.x); v0[2] *= bf_lo(gg.y); v0[3] *= bf_hi(gg.y); v1[0] *= bf_lo(gg.z); v1[1] *= bf_hi(gg.z); v1[2] *= bf_lo(gg.w); v1[3] *= bf_hi(gg.w); }
                    if (MODE == 2) { const u32x4 tt = *(const u32x4*)(T1 + row * 1024 + c);
                        v0[0] += bf_lo(tt.x); v0[1] += bf_hi(tt.x); v0[2] += bf_lo(tt.y); v0[3] += bf_hi(tt.y); v1[0] += bf_lo(tt.z); v1[1] += bf_hi(tt.z); v1[2] += bf_lo(tt.w); v1[3] += bf_hi(tt.w); }
                    *(u32x4*)(O + row * 1024 + c) = pack8(v0, v1); } }
    }
};
struct EpiSwiGLU {
    static constexpr bool PERM = true, AFTER_DRAIN = false;
    bf16_t* Hd;
    __device__ __forceinline__ void operator()(const f32x4 (&acc)[2][2][4][2], const pg8::Unit& u, int wr, int wc, int fr, int fq) const {
        const int row0 = u.pm * 256 + wr * 64 + fr, cb = u.pn * 128 + wc * 32 + 8 * fq;
#pragma unroll
        for (int ai = 0; ai < 2; ++ai)
#pragma unroll
            for (int m = 0; m < 4; ++m) { f32x4 v0, v1;
#pragma unroll
                for (int j = 0; j < 4; ++j) { const float g0 = acc[ai][0][m][0][j], g1 = acc[ai][0][m][1][j];
                    v0[j] = g0 * fsigmoid(g0) * acc[ai][1][m][0][j]; v1[j] = g1 * fsigmoid(g1) * acc[ai][1][m][1][j]; }
                *(u32x4*)(Hd + (size_t)(row0 + ai * 128 + m * 16) * DFF + cb) = pack8(v0, v1); }
    }
};
template <class Epi> __device__ __forceinline__ void run_gemm(PG8_LAS unsigned char* lds, const bf16_t* A, const bf16_t* Bt, int N, int K, const Epi& E, int G) {
    pg8::Gemm g; g.A = A; g.Bt = Bt; g.M = M; g.N = N; g.K = K;
    pg8::StaticOrder S; S.init(M, N, G, (int)blockIdx.x);
    pg8::gemm_phase<Epi, pg8::StaticOrder, true, true>(lds, g, S, E);
}
__device__ __forceinline__ void mix8_lds(const unsigned char* cur, const unsigned char* prv, const float* mu, float (&o)[8]) {
    const u32x4 c = *(const u32x4*)cur, p = *(const u32x4*)prv;
    const f32x4 m0 = *(const f32x4*)mu, m1 = *(const f32x4*)(mu + 4);
    const float mm[8] = {m0[0], m0[1], m0[2], m0[3], m1[0], m1[1], m1[2], m1[3]};
#pragma unroll
    for (int i = 0; i < 4; ++i) { const float cl = bf_lo(c[i]), ch = bf_hi(c[i]), pl = bf_lo(p[i]), ph = bf_hi(p[i]);
        o[2 * i] = cl + (pl - cl) * mm[2 * i]; o[2 * i + 1] = ch + (ph - ch) * mm[2 * i + 1]; }
}
__device__ __forceinline__ void mix4_lds(const unsigned char* cur, const unsigned char* prv, const float* mu, float (&o)[4]) {
    const u32x2 c = *(const u32x2*)cur, p = *(const u32x2*)prv;
    const f32x4 m0 = *(const f32x4*)mu;
#pragma unroll
    for (int i = 0; i < 2; ++i) { const float cl = bf_lo(c[i]), ch = bf_hi(c[i]), pl = bf_lo(p[i]), ph = bf_hi(p[i]);
        o[2 * i] = cl + (pl - cl) * m0[2 * i]; o[2 * i + 1] = ch + (ph - ch) * m0[2 * i + 1]; }
}
__device__ __forceinline__ bf16x8 pack_frag(const float (&v)[8]) {
    u32x4 o; o.x = cvt_pk_bf16(v[0], v[1]); o.y = cvt_pk_bf16(v[2], v[3]); o.z = cvt_pk_bf16(v[4], v[5]); o.w = cvt_pk_bf16(v[6], v[7]);
    return __builtin_bit_cast(bf16x8, o);
}
__device__ __forceinline__ void phase_rwprep(const Args& a, unsigned char* lds, int G) {
    constexpr int ROWB = 3600, L_FRAG = 17 * ROWB, L_PAR = L_FRAG + 8192, NCH = 17 * 224, NT = M / 16;
    const int tid = my_tid(); const int wave = __builtin_amdgcn_readfirstlane(tid >> 6), lane = tid & 63, fr = lane & 15, fq = lane >> 4;
    unsigned char* ws = a.ws;
    const unsigned char* PRW = ws + O_PRW;
    const bf16_t* WLU = (const bf16_t*)(ws + O_WLU); const bf16_t* WLA = (const bf16_t*)(ws + O_WLA); const bf16_t* WLG = (const bf16_t*)(ws + O_WLG);
    unsigned char* SI = ws + O_SI; bf16_t* GB = (bf16_t*)(ws + O_G); float* SC = (float*)(ws + O_SC);
    float* par = (float*)(lds + L_PAR);
    for (int i = tid; i < 1792 + 5 * 512; i += 512) {
        float v;
        if (i < 1792) v = a.in[4][i]; else { const int j = i - 1792, w = j >> 9, c = j & 511; v = (w == 0 ? a.in[5] : w == 1 ? a.in[7] : w == 2 ? a.in[10] : w == 3 ? a.in[11] : a.in[12])[c]; }
        par[i] = v;
    }
    for (int tile = blockIdx.x; tile < NT; tile += G) {
        __syncthreads();
        {   u32x4 pre[8];
#pragma unroll
            for (int j = 0; j < 8; ++j) { const int c = tid + 512 * j; pre[j] = (u32x4){0u, 0u, 0u, 0u};
                if (c < NCH) { const int row = c / 224, col = c - row * 224; const bool zero = (row == 0) && (((tile * 16) & (SEQ - 1)) == 0);
                    if (!zero) pre[j] = __builtin_nontemporal_load((const u32x4*)(PRW + ((size_t)tile * 16 + row - 1) * (RWC * 2) + col * 16)); } }
#pragma unroll
            for (int j = 0; j < 8; ++j) { const int c = tid + 512 * j; if (c < NCH) { const int row = c / 224, col = c - row * 224; *(u32x4*)(lds + row * ROWB + col * 16) = pre[j]; } }
        }
        __syncthreads();
        const unsigned char* rcur = lds + (fr + 1) * ROWB; const unsigned char* rprv = lds + fr * ROWB;
        {
            const int colb = wave < 2 ? 1536 + 32 * wave : (wave < 4 ? 1600 + 32 * (wave - 2) : 1664 + 32 * (wave - 4));
            float t8[8]; mix8_lds(rcur + (colb + 8 * fq) * 2, rprv + (colb + 8 * fq) * 2, par + colb + 8 * fq, t8);
            if (wave < 2) {
#pragma unroll
                for (int i = 0; i < 8; ++i) { const float e = fexp(2.f * t8[i]); t8[i] = 1.f - 2.f * frcp(e + 1.f); } }
            else if (wave >= 4) {
#pragma unroll
                for (int i = 0; i < 8; ++i) t8[i] = fsigmoid(t8[i]); }
            *(bf16x8*)(lds + L_FRAG + wave * 1024 + lane * 16) = pack_frag(t8);
        }
        __syncthreads();
        bf16x8 Aw[2], Aa[2], Ag[4];
#pragma unroll
        for (int s = 0; s < 2; ++s) { Aw[s] = *(const bf16x8*)(lds + L_FRAG + s * 1024 + lane * 16); Aa[s] = *(const bf16x8*)(lds + L_FRAG + (2 + s) * 1024 + lane * 16); }
#pragma unroll
        for (int s = 0; s < 4; ++s) Ag[s] = *(const bf16x8*)(lds + L_FRAG + (4 + s) * 1024 + lane * 16);
        const int h = wave; const size_t m = (size_t)tile * 16 + fr;
        float kkr[16], av[16]; unsigned lk[16], rvp[16];
        float ss = 0.f, brs = 0.f, krs = 0.f, rkbs = 0.f;
#pragma unroll
        for (int n = 0; n < 4; ++n) {
            asm volatile("" ::: "memory");
            const int cb = 64 * h + 16 * n, c0 = cb + 4 * fq;
            f32x4 aw = {0.f, 0.f, 0.f, 0.f}, aa = aw, ag = aw;
#pragma unroll
            for (int s = 0; s < 2; ++s) {
                aw = __builtin_amdgcn_mfma_f32_16x16x32_bf16(*(const bf16x8*)(WLU + (size_t)(cb + fr) * 64 + 32 * s + 8 * fq), Aw[s], aw, 0, 0, 0);
                aa = __builtin_amdgcn_mfma_f32_16x16x32_bf16(*(const bf16x8*)(WLA + (size_t)(cb + fr) * 64 + 32 * s + 8 * fq), Aa[s], aa, 0, 0, 0); }
#pragma unroll
            for (int s = 0; s < 4; ++s)
                ag = __builtin_amdgcn_mfma_f32_16x16x32_bf16(*(const bf16x8*)(WLG + (size_t)(cb + fr) * 128 + 32 * s + 8 * fq), Ag[s], ag, 0, 0, 0);
            float rr[4], kr4[4], vv[4];
            mix4_lds(rcur + c0 * 2, rprv + c0 * 2, par + c0, rr); mix4_lds(rcur + (512 + c0) * 2, rprv + (512 + c0) * 2, par + 512 + c0, kr4); mix4_lds(rcur + (1024 + c0) * 2, rprv + (1024 + c0) * 2, par + 1024 + c0, vv);
            const f32x4 w0v = *(const f32x4*)(par + 1792 + c0), a0v = *(const f32x4*)(par + 2304 + c0), kkv = *(const f32x4*)(par + 2816 + c0), kav = *(const f32x4*)(par + 3328 + c0), rkv = *(const f32x4*)(par + 3840 + c0);
#pragma unroll
            for (int j = 0; j < 4; ++j) {
                const float sg = fsigmoid(w0v[j] + aw[j]);
                const float ldx = -0.60653065971f * 1.44269504089f * sg;
                const float av_ = fsigmoid(a0v[j] + aa[j]);
                const float kkraw = kr4[j] * kkv[j];
                const float k2 = kr4[j] * (1.f + (av_ - 1.f) * kav[j]);
                ss += kkraw * kkraw; brs += kkraw * av_ * rr[j]; krs += k2 * rr[j]; rkbs += rr[j] * k2 * rkv[j];
                kkr[4 * n + j] = kkraw; av[4 * n + j] = av_; lk[4 * n + j] = cvt_pk_bf16(ldx, k2); rvp[4 * n + j] = cvt_pk_bf16(rr[j], vv[j]);
            }
            u32x2 gp; gp.x = cvt_pk_bf16(ag[0], ag[1]); gp.y = cvt_pk_bf16(ag[2], ag[3]);
            *(u32x2*)(GB + m * 512 + c0) = gp;
        }
        ss = red16(ss); brs = red16(brs); krs = red16(krs); rkbs = red16(rkbs);
        const float inv = 1.f / fmaxf(sqrtf(ss), 1e-12f);
        unsigned char* rec = SI + (m * 8 + h) * 768 + fq * 16;
#pragma unroll
        for (int n = 0; n < 4; ++n) {
            unsigned dw[12];
#pragma unroll
            for (int j = 0; j < 4; ++j) { const float kk = kkr[4 * n + j] * inv;
                const unsigned kp = cvt_pk_bf16(kk * av[4 * n + j], -kk);
                dw[3 * j] = (lk[4 * n + j] & 0xffffu) | (kp & 0xffff0000u); dw[3 * j + 1] = (kp & 0xffffu) | (lk[4 * n + j] & 0xffff0000u); dw[3 * j + 2] = rvp[4 * n + j]; }
            unsigned char* dst = rec + 64 * n;
            u32x4 s0 = {dw[0], dw[3], dw[6], dw[9]}, s1 = {dw[1], dw[4], dw[7], dw[10]}, s2 = {dw[2], dw[5], dw[8], dw[11]};
            *(u32x4*)dst = s0; *(u32x4*)(dst + 256) = s1; *(u32x4*)(dst + 512) = s2;
        }
        if (fq == 0) { f32x4 scv = {brs * inv, krs, rkbs, 0.f}; *(f32x4*)(SC + (m * 8 + h) * 4) = scv; }
    }
    __syncthreads();
}

__device__ __forceinline__ float red_rows(float x) {
    float a0 = x, a1 = x;
    asm volatile("s_nop 1\n\tv_permlane16_swap_b32 %0, %1" : "+v"(a0), "+v"(a1));
    float b0 = a0 + a1, b1 = b0;
    asm volatile("s_nop 1\n\tv_permlane32_swap_b32 %0, %1" : "+v"(b0), "+v"(b1));
    return b0 + b1;
}
constexpr int SC_T = 16, SC_ROW = 1280, SC_GEND = SC_T * SC_ROW, SC_BUF = SC_GEND + 256;
struct ProdRec { unsigned d0[SC_T]; unsigned d1[4], d2[4]; };
__device__ __forceinline__ void prod_load(ProdRec& P, const unsigned char* sb, int chunk, int pw, int col) {
    const unsigned char* p = sb + (size_t)chunk * SC_T * 6144 + col * 4;
#pragma unroll
    for (int st = 0; st < SC_T; ++st) P.d0[st] = *(const unsigned*)(p + st * 6144);
#pragma unroll
    for (int q = 0; q < 4; ++q) { P.d1[q] = *(const unsigned*)(p + (4 * pw + q) * 6144 + 256); P.d2[q] = *(const unsigned*)(p + (4 * pw + q) * 6144 + 512); }
}
__device__ __forceinline__ void prod_store(const ProdRec& P, unsigned char* buf, int pw, int col) {
    float L = 0.f;
#pragma unroll
    for (int st = 0; st < SC_T; ++st) {
        const float Lp = L; L += bf_lo(P.d0[st]);
        if ((st >> 2) == pw) { const int q = st & 3; unsigned char* base = buf + st * SC_ROW + col * 4;
            const float gp = __builtin_amdgcn_exp2f(Lp), g = __builtin_amdgcn_exp2f(L), ig = __builtin_amdgcn_exp2f(-L);
            *(float*)(base) = gp * bf_hi(P.d0[st]); *(float*)(base + 256) = g * bf_lo(P.d2[q]);
            *(float*)(base + 512) = bf_lo(P.d1[q]) * ig; *(float*)(base + 768) = bf_hi(P.d1[q]) * ig; *(float*)(base + 1024) = bf_hi(P.d2[q]); }
    }
    if (pw == 0) *(float*)(buf + SC_GEND + col * 4) = __builtin_amdgcn_exp2f(L);
}
#define MK_SWAP32(a, b) asm volatile("s_nop 1\n\tv_permlane32_swap_b32 %0, %1" : "+v"(a), "+v"(b))
#define MK_SWAP16(a, b) asm volatile("s_nop 1\n\tv_permlane16_swap_b32 %0, %1" : "+v"(a), "+v"(b))
__device__ __forceinline__ void red4x8(float& A, float& B, float& C, float& D) {
    MK_SWAP32(A, B); float u = A + B;
    MK_SWAP32(C, D); float w = C + D;
    MK_SWAP16(u, w); float z = u + w;
    float z1;
    asm volatile("s_nop 1\n\tv_add_f32_dpp %0, %1, %1 row_ror:8 row_mask:0xf bank_mask:0xf" : "=&v"(z1) : "v"(z));
    float p = z1, q = z1; MK_SWAP32(p, q);
    float p2 = p; MK_SWAP16(p, p2);
    float q2 = q; MK_SWAP16(q, q2);
    A = p; C = p2; B = q; D = q2;
}
__device__ __forceinline__ void red2x8(float& A, float& B) {
    MK_SWAP32(A, B); float u = A + B;
    float uc = u; MK_SWAP16(u, uc); float z = u + uc;
    float z1;
    asm volatile("s_nop 1\n\tv_add_f32_dpp %0, %1, %1 row_ror:8 row_mask:0xf bank_mask:0xf" : "=&v"(z1) : "v"(z));
    float p = z1, q = z1; MK_SWAP32(p, q);
    A = p; B = q;
}
__device__ __forceinline__ void scan_consume(f32x2 (&S)[8], const unsigned char* buf, unsigned char* ybuf, int lane, int rb) {
    const unsigned co = (unsigned)(lane >> 3) * 32u, vo = 1024u + (unsigned)(16 * rb + (lane & 7)) * 4u;
#pragma unroll 4
    for (int st = 0; st < SC_T; ++st) {
        const unsigned char* sb = buf + st * SC_ROW;
        f32x4 n4[2], r4[2], a4[2], k4[2];
#pragma unroll
        for (int q = 0; q < 2; ++q) { n4[q] = *(const f32x4*)(sb + co + 16 * q); r4[q] = *(const f32x4*)(sb + 256 + co + 16 * q);
            a4[q] = *(const f32x4*)(sb + 512 + co + 16 * q); k4[q] = *(const f32x4*)(sb + 768 + co + 16 * q); }
        const float v0 = *(const float*)(sb + vo), v1 = *(const float*)(sb + vo + 32);
        f32x2 sa0v = {0.f, 0.f}, sa1v = sa0v, yp0v = sa0v, yp1v = sa0v;
#pragma unroll
        for (int p = 0; p < 4; ++p) { const f32x2 nn = {n4[p >> 1][2 * (p & 1)], n4[p >> 1][2 * (p & 1) + 1]}, rr2 = {r4[p >> 1][2 * (p & 1)], r4[p >> 1][2 * (p & 1) + 1]};
            sa0v += S[p] * nn; sa1v += S[4 + p] * nn; yp0v += S[p] * rr2; yp1v += S[4 + p] * rr2; }
        float sa0 = sa0v[0] + sa0v[1], sa1 = sa1v[0] + sa1v[1];
        const f32x2 ypp = {yp0v[0] + yp0v[1], yp1v[0] + yp1v[1]};
        red2x8(sa0, sa1);
        const f32x2 s0 = {sa0, sa0}, s1 = {sa1, sa1}, vv0 = {v0, v0}, vv1 = {v1, v1};
#pragma unroll
        for (int p = 0; p < 4; ++p) { const f32x2 aa = {a4[p >> 1][2 * (p & 1)], a4[p >> 1][2 * (p & 1) + 1]}; S[p] = __builtin_elementwise_fma(aa, s0, S[p]); S[4 + p] = __builtin_elementwise_fma(aa, s1, S[4 + p]); }
        asm volatile("" ::: "memory");
#pragma unroll
        for (int p = 0; p < 4; ++p) { const f32x2 kk = {k4[p >> 1][2 * (p & 1)], k4[p >> 1][2 * (p & 1) + 1]}; S[p] = __builtin_elementwise_fma(kk, vv0, S[p]); S[4 + p] = __builtin_elementwise_fma(kk, vv1, S[4 + p]); }
        *(f32x2*)(ybuf + st * 2048 + rb * 512 + lane * 8) = ypp;
        if (lane < 8) { f32x2 o = {sa0, sa1}; *(f32x2*)(ybuf + SC_T * 2048 + st * 256 + rb * 64 + lane * 8) = o; }
    }
#pragma unroll
    for (int p = 0; p < 4; ++p) { const f32x4 g4 = *(const f32x4*)(buf + SC_GEND + co + 16 * (p >> 1)); const f32x2 gg = {g4[2 * (p & 1)], g4[2 * (p & 1) + 1]}; S[p] = S[p] * gg; S[4 + p] = S[4 + p] * gg; }
}
struct FinIn { unsigned v[4]; f32x2 bk[4]; };
__device__ __forceinline__ void fin_load(FinIn& F, const unsigned char* sb, const float* scp, int chunk, int pw, int lane) {
#pragma unroll
    for (int q = 0; q < 4; ++q) { const size_t t = (size_t)chunk * SC_T + (lane >> 4) + 4 * q;
        F.v[q] = *(const unsigned short*)(sb + t * 6144 + 512 + (16 * pw + (lane & 15)) * 4 + 2); F.bk[q] = *(const f32x2*)(scp + t * 32); }
}
__device__ __forceinline__ void prod_finish(const FinIn& F, const unsigned char* ybuf, unsigned* yr, int pw, int lane) {
#pragma unroll
    for (int q = 0; q < 4; ++q) { const int st = (lane >> 4) + 4 * q, row16 = lane & 15, e = row16 >> 3, rr = row16 & 7;
        const unsigned char* yp8 = ybuf + st * 2048 + pw * 512 + rr * 8 + e * 4; float yp = 0.f;
#pragma unroll
        for (int cg = 0; cg < 8; ++cg) yp += *(const float*)(yp8 + cg * 64);
        const float sa = *(const float*)(ybuf + SC_T * 2048 + st * 256 + pw * 64 + rr * 8 + e * 4);
        const float v = __uint_as_float(F.v[q] << 16), y = yp + sa * F.bk[q][0] + v * F.bk[q][1];
        yr[(size_t)st * 512 + row16] = (unsigned)bf1(y) | (F.v[q] << 16); }
}

__device__ __forceinline__ void rwpost_local(const Args& a, int bh, int tid) {
    const float* SC = (const float*)(a.ws + O_SC);
    const unsigned* YR = (const unsigned*)(a.ws + O_YR); const bf16_t* GB = (const bf16_t*)(a.ws + O_G); bf16_t* ORW = (bf16_t*)(a.ws + O_ORW);
    const int b = bh >> 3, h = bh & 7, c = 64 * h + (tid & 15) * 4;
    const f32x4 lwv = *(const f32x4*)(a.in[13] + c), lbv = *(const f32x4*)(a.in[14] + c);
    for (int t0 = tid >> 4; t0 < SEQ; t0 += 64) {
        u32x4 yv[2]; u32x2 gb[2]; float rkb[2]; size_t mm[2];
#pragma unroll
        for (int u = 0; u < 2; ++u) { const size_t m = (size_t)b * SEQ + t0 + 32 * u; mm[u] = m;
            yv[u] = __builtin_nontemporal_load((const u32x4*)(YR + m * 512 + c)); gb[u] = __builtin_nontemporal_load((const u32x2*)(GB + m * 512 + c)); rkb[u] = SC[(m * 8 + h) * 4 + 2]; }
#pragma unroll
        for (int u = 0; u < 2; ++u) {
            float y[4] = {bf_lo(yv[u].x), bf_lo(yv[u].y), bf_lo(yv[u].z), bf_lo(yv[u].w)};
            const float v[4] = {bf_hi(yv[u].x), bf_hi(yv[u].y), bf_hi(yv[u].z), bf_hi(yv[u].w)};
            float s = (y[0] + y[1]) + (y[2] + y[3]);
#pragma unroll
            for (int o = 1; o < 16; o <<= 1) s += __shfl_xor(s, o);
            const float mean = s * (1.f / 64.f);
            float q = 0.f;
#pragma unroll
            for (int j = 0; j < 4; ++j) { y[j] -= mean; q += y[j] * y[j]; }
#pragma unroll
            for (int o = 1; o < 16; o <<= 1) q += __shfl_xor(q, o);
            const float rstd = rsqrtf(q * (1.f / 64.f) + GN_EPS);
            const float g4[4] = {bf_lo(gb[u].x), bf_hi(gb[u].x), bf_lo(gb[u].y), bf_hi(gb[u].y)};
            float o4[4];
#pragma unroll
            for (int j = 0; j < 4; ++j) o4[j] = (y[j] * rstd * lwv[j] + lbv[j] + rkb[u] * v[j]) * g4[j];
            u32x2 ob; ob.x = cvt_pk_bf16(o4[0], o4[1]); ob.y = cvt_pk_bf16(o4[2], o4[3]);
            *(u32x2*)(ORW + mm[u] * 512 + c) = ob;
        }
    }
}

struct KV { bf16x8 k[4]; bf16x8 v[2][2]; };
__device__ __forceinline__ void attn_load(KV& T, const bf16_t* Kh, const bf16_t* Vh, int k0, int n, int hf) {
    const bf16_t* kp = Kh + (size_t)(k0 + n) * 512 + 8 * hf;
#pragma unroll
    for (int s = 0; s < 4; ++s) T.k[s] = *(const bf16x8*)(kp + 16 * s);
#pragma unroll
    for (int d = 0; d < 2; ++d)
#pragma unroll
        for (int sg = 0; sg < 2; ++sg) { const bf16_t* vp = Vh + (size_t)(32 * d + n) * SEQ + k0 + 16 * sg + 4 * hf;
            const u32x2 lo = *(const u32x2*)vp, hi = *(const u32x2*)(vp + 8); u32x4 t = {lo.x, lo.y, hi.x, hi.y}; T.v[d][sg] = __builtin_bit_cast(bf16x8, t); }
}
__device__ __forceinline__ void attn_wave(const Args& a, int bh, int w4, int lane) {
    const int b = bh >> 3, h = bh & 7, n = lane & 31, hf = lane >> 5;
    const size_t m0 = (size_t)b * SEQ;
    const bf16_t* Qh = (const bf16_t*)(a.ws + O_Q) + m0 * 512 + 64 * h;
    const bf16_t* Kh = (const bf16_t*)(a.ws + O_K) + m0 * 512 + 64 * h;
    const bf16_t* Vh = (const bf16_t*)(a.ws + O_VT) + (size_t)bh * 64 * SEQ;
    bf16_t* Oh = (bf16_t*)(a.ws + O_OSB) + m0 * 512 + 64 * h;
    for (int qt = 63 - w4; qt >= 0; qt -= 8) {
        const int q0 = 32 * qt;
        bf16x8 qf[4];
#pragma unroll
        for (int s = 0; s < 4; ++s) qf[s] = __builtin_nontemporal_load((const bf16x8*)(Qh + (size_t)(q0 + n) * 512 + 16 * s + 8 * hf));
        f32x16 o0, o1;
#pragma unroll
        for (int i = 0; i < 16; ++i) { o0[i] = 0.f; o1[i] = 0.f; }
        float carry = 0.f;
        KV cur, nxt;
        attn_load(cur, Kh, Vh, q0, n, hf);
        for (int kt = qt; kt >= 0; --kt) {
            const int ktn = kt > 0 ? kt - 1 : 0;
            attn_load(nxt, Kh, Vh, 32 * ktn, n, hf);
            f32x16 sc;
#pragma unroll
            for (int i = 0; i < 16; ++i) sc[i] = 0.f;
#pragma unroll
            for (int s = 0; s < 4; ++s) sc = __builtin_amdgcn_mfma_f32_32x32x16_bf16(cur.k[s], qf[s], sc, 0, 0, 0);
            const bool diag = (kt == qt);
            float lf[16], G4[4];
#pragma unroll
            for (int g = 0; g < 4; ++g) { G4[g] = 0.f;
#pragma unroll
                for (int i = 0; i < 4; ++i) { const int r = 4 * g + i; const float z = sc[r];
                    const bool valid = !diag || (8 * g + 4 * hf + i < n);
                    const float e = fexp(-fabsf(z));
                    const float sp = fmaxf(z, 0.f) + flog(1.f + e);
                    lf[r] = valid ? -sp : 0.f; G4[g] += lf[r]; } }
            float PG[4], T4[4];
#pragma unroll
            for (int g = 0; g < 4; ++g) { PG[g] = __shfl_xor(G4[g], 32); T4[g] = G4[g] + PG[g]; }
            const float tail3 = 0.f, tail2 = T4[3], tail1 = T4[3] + T4[2], tail0 = tail1 + T4[1], total = tail0 + T4[0];
            const float tails[4] = {tail0, tail1, tail2, tail3};
            f32x16 wv;
#pragma unroll
            for (int g = 0; g < 4; ++g) {
                float af = carry + tails[g] + (hf == 0 ? PG[g] : 0.f);
#pragma unroll
                for (int i = 3; i >= 0; --i) { const int r = 4 * g + i; const float z = sc[r];
                    const bool valid = !diag || (8 * g + 4 * hf + i < n);
                    const float wgt = fexp(lf[r] + z + af);
                    wv[r] = valid ? wgt : 0.f;
                    af += lf[r]; } }
            carry += total;
            bf16x8 wf[2];
#pragma unroll
            for (int sg = 0; sg < 2; ++sg) { u32x4 t; t.x = cvt_pk_bf16(wv[8 * sg + 0], wv[8 * sg + 1]); t.y = cvt_pk_bf16(wv[8 * sg + 2], wv[8 * sg + 3]); t.z = cvt_pk_bf16(wv[8 * sg + 4], wv[8 * sg + 5]); t.w = cvt_pk_bf16(wv[8 * sg + 6], wv[8 * sg + 7]); wf[sg] = __builtin_bit_cast(bf16x8, t); }
#pragma unroll
            for (int sg = 0; sg < 2; ++sg) { o0 = __builtin_amdgcn_mfma_f32_32x32x16_bf16(cur.v[0][sg], wf[sg], o0, 0, 0, 0); o1 = __builtin_amdgcn_mfma_f32_32x32x16_bf16(cur.v[1][sg], wf[sg], o1, 0, 0, 0); }
            cur = nxt;
#if MK_EARLY_EXIT
            if (__all(carry < -104.f)) break;
#endif
        }
        bf16_t* op = Oh + (size_t)(q0 + n) * 512 + 4 * hf;
#pragma unroll
        for (int g = 0; g < 4; ++g) {
            u32x2 t0, t1; t0.x = cvt_pk_bf16(o0[4 * g], o0[4 * g + 1]); t0.y = cvt_pk_bf16(o0[4 * g + 2], o0[4 * g + 3]); t1.x = cvt_pk_bf16(o1[4 * g], o1[4 * g + 1]); t1.y = cvt_pk_bf16(o1[4 * g + 2], o1[4 * g + 3]);
            *(u32x2*)(op + 8 * g) = t0; *(u32x2*)(op + 32 + 8 * g) = t1; }
    }
}
__device__ __forceinline__ void phase_mixer(const Args& a, unsigned char* lds, int G) {
    const int tid = my_tid(); const int wave = __builtin_amdgcn_readfirstlane(tid >> 6), lane = tid & 63;
    for (int bh = blockIdx.x; bh < NB * NH; bh += G) {
        const int b = bh >> 3, h = bh & 7; const size_t m0 = (size_t)b * SEQ;
        const unsigned char* sb = a.ws + O_SI + (m0 * 8 + h) * 768; const float* scp = (const float*)(a.ws + O_SC) + (m0 * 8 + h) * 4;
        unsigned* yrb = (unsigned*)(a.ws + O_YR) + m0 * 512 + 64 * h + 16 * (wave & 3);
        constexpr int NCH = SEQ / SC_T;
        ProdRec pr; f32x2 S[8]; const int pw = wave & 3, pcol = tid & 63;
#pragma unroll
        for (int p = 0; p < 8; ++p) S[p] = (f32x2){0.f, 0.f};
        __syncthreads();
        FinIn fin;
        if (wave >= 4) { prod_load(pr, sb, 0, pw, pcol); prod_store(pr, lds, pw, pcol); prod_load(pr, sb, 1, pw, pcol); fin_load(fin, sb, scp, 0, pw, lane); }
        __syncthreads();
        unsigned char* yring = lds + 2 * SC_BUF;
        for (int ci = 0; ci < NCH; ++ci) {
            if (wave < 4) scan_consume(S, lds + (ci & 1) * SC_BUF, yring + (ci & 1) * (SC_T * 2304), lane, wave);
            else {
                if (ci > 0) { prod_finish(fin, yring + ((ci - 1) & 1) * (SC_T * 2304), yrb + (size_t)(ci - 1) * SC_T * 512, pw, lane); fin_load(fin, sb, scp, ci, pw, lane); }
                if (ci + 1 < NCH) { prod_store(pr, lds + ((ci + 1) & 1) * SC_BUF, pw, pcol); prod_load(pr, sb, ci + 2 < NCH ? ci + 2 : ci + 1, pw, pcol); }
            }
            __syncthreads();
        }
        if (wave >= 4) prod_finish(fin, yring + ((NCH - 1) & 1) * (SC_T * 2304), yrb + (size_t)(NCH - 1) * SC_T * 512, pw, lane);
        attn_wave(a, bh, wave, lane);
        __threadfence_block(); __syncthreads();
        rwpost_local(a, bh, my_tid());
    }
}

template <int MODE> __device__ __forceinline__ void phase_rows(const Args& a, int G) {
    const int tid = my_tid(); const int wave = tid >> 6, lane = tid & 63;
    const int gw = blockIdx.x * 8 + wave, NGW = G * 8;
    const bf16_t* T = (const bf16_t*)(a.ws + (MODE == 0 ? O_TT : O_FF));
    const float* g1 = MODE == 0 ? a.in[18] : a.in[23]; const float* g2 = a.in[19];
    bf16_t* H2 = (bf16_t*)(a.ws + O_H2); bf16_t* X1B = (bf16_t*)(a.ws + O_X1B);
    f32x4 g1v[4], g2v[4];
#pragma unroll
    for (int j = 0; j < 4; ++j) { g1v[j] = ((const f32x4*)g1)[lane + 64 * j]; g2v[j] = ((const f32x4*)g2)[lane + 64 * j]; }
    for (int row0 = gw; row0 < M; row0 += 2 * NGW) {
        u32x2 tb[2][4]; f32x4 x[2][4];
#pragma unroll
        for (int u = 0; u < 2; ++u) { const int row = (row0 + u * NGW < M) ? row0 + u * NGW : row0;
            const u32x2* tr = (const u32x2*)(T + (size_t)row * D) + lane;
#pragma unroll
            for (int j = 0; j < 4; ++j) tb[u][j] = __builtin_nontemporal_load(tr + 64 * j);
            if (MODE == 0) { const f32x4* xr = (const f32x4*)(a.in[0] + (size_t)row * D) + lane;
#pragma unroll
                for (int j = 0; j < 4; ++j) x[u][j] = __builtin_nontemporal_load(xr + 64 * j); }
            else { const u32x2* xr = (const u32x2*)(X1B + (size_t)row * D) + lane;
#pragma unroll
                for (int j = 0; j < 4; ++j) { const u32x2 xb = __builtin_nontemporal_load(xr + 64 * j); x[u][j][0] = bf_lo(xb.x); x[u][j][1] = bf_hi(xb.x); x[u][j][2] = bf_lo(xb.y); x[u][j][3] = bf_hi(xb.y); } } }
#pragma unroll
        for (int u = 0; u < 2; ++u) {
            const int row = row0 + u * NGW;
            f32x4 t[4]; float s = 0.f;
#pragma unroll
            for (int j = 0; j < 4; ++j) { t[j][0] = bf_lo(tb[u][j].x); t[j][1] = bf_hi(tb[u][j].x); t[j][2] = bf_lo(tb[u][j].y); t[j][3] = bf_hi(tb[u][j].y);
                s += (t[j][0] * t[j][0] + t[j][1] * t[j][1]) + (t[j][2] * t[j][2] + t[j][3] * t[j][3]); }
            const float rs = rsqrtf(wave_sum(s) * (1.f / D) + RMS_EPS);
            float s2 = 0.f;
#pragma unroll
            for (int j = 0; j < 4; ++j)
#pragma unroll
                for (int e = 0; e < 4; ++e) { x[u][j][e] += t[j][e] * rs * g1v[j][e]; s2 += x[u][j][e] * x[u][j][e]; }
            float rs2 = 0.f;
            if (MODE == 0) rs2 = rsqrtf(wave_sum(s2) * (1.f / D) + RMS_EPS);
            if (row < M) {
                if (MODE == 0) {
                    u32x2* xo = (u32x2*)(X1B + (size_t)row * D) + lane; u32x2* o = (u32x2*)(H2 + (size_t)row * D) + lane;
#pragma unroll
                    for (int j = 0; j < 4; ++j) { u32x2 w; w.x = cvt_pk_bf16(x[u][j][0], x[u][j][1]); w.y = cvt_pk_bf16(x[u][j][2], x[u][j][3]); xo[64 * j] = w; }
#pragma unroll
                    for (int j = 0; j < 4; ++j) { u32x2 w; w.x = cvt_pk_bf16(x[u][j][0] * rs2 * g2v[j][0], x[u][j][1] * rs2 * g2v[j][1]); w.y = cvt_pk_bf16(x[u][j][2] * rs2 * g2v[j][2], x[u][j][3] * rs2 * g2v[j][3]); o[64 * j] = w; }
                } else {
                    f32x4* orow = (f32x4*)(a.out + (size_t)row * D) + lane;
#pragma unroll
                    for (int j = 0; j < 4; ++j) __builtin_nontemporal_store(x[u][j], orow + 64 * j);
                }
            }
        }
    }
}

#define XB_TMO      128
#define XB_XCNT(j)  (256  + 64 * (j))
#define XB_XSUB(j)  (1280 + 64 * (j))
#define XB_XGEN(j)  (2304 + 64 * (j))
#define XB_TOP      3328
#define XB_TOPGEN   3392
#define XCD_BAR_WORDS 3456
#define XB_SPIN_CAP (1u << 18)

__device__ __forceinline__ unsigned xb_ld(unsigned* p)              { return __hip_atomic_load(p, __ATOMIC_RELAXED, __HIP_MEMORY_SCOPE_AGENT); }
__device__ __forceinline__ unsigned xb_add(unsigned* p, unsigned v) { return __hip_atomic_fetch_add(p, v, __ATOMIC_RELAXED, __HIP_MEMORY_SCOPE_AGENT); }
__device__ __forceinline__ unsigned xb_xcc_id() { return (unsigned)__builtin_amdgcn_s_getreg((3 << 11) | 20) & 0xFu; }
#define XB_SPIN(cond, bar) do { unsigned _sp = 0; while (cond) { __builtin_amdgcn_s_sleep(1); \
    if ((++_sp & 255u) == 0u) { if (xb_ld(&(bar)[XB_TMO])) break; if (_sp > XB_SPIN_CAP) { atomicAdd(&(bar)[XB_TMO], 1u); break; } } } } while (0)

struct XcdBarrier {
    unsigned* bar; unsigned x;
    volatile __attribute__((address_space(3))) unsigned* st;
};

__device__ __forceinline__ XcdBarrier xcd_barrier_post(unsigned* bar, volatile __attribute__((address_space(3))) unsigned* st) {
    XcdBarrier b; b.bar = bar; b.x = xb_xcc_id(); b.st = st;
    if (threadIdx.x == 0) (void)xb_add(&bar[XB_XCNT(b.x)], 1u);
    return b;
}
__device__ __forceinline__ void xcd_barrier_complete(unsigned* bar, unsigned x, unsigned& nloc, unsigned& nx) {
    const unsigned G = gridDim.x * gridDim.y * gridDim.z;
    unsigned sum, cnt, mine, sp = 0u;
    for (;;) {
        sum = 0u; cnt = 0u; mine = 0u;
#pragma unroll
        for (unsigned j = 0; j < 16; ++j) { const unsigned c = xb_ld(&bar[XB_XCNT(j)]); sum += c; cnt += (c > 0u) ? 1u : 0u; mine = (j == x) ? c : mine; }
        if (sum == G) break;
        __builtin_amdgcn_s_sleep(1);
        if ((++sp & 255u) == 0u) { if (xb_ld(&bar[XB_TMO])) break; if (sp > XB_SPIN_CAP) { atomicAdd(&bar[XB_TMO], 1u); break; } }
    }
    nloc = mine > 0u ? mine : 1u; nx = cnt > 0u ? cnt : 1u;
}

__device__ __forceinline__ void xcd_barrier(const XcdBarrier& b) {
    asm volatile("s_waitcnt vmcnt(0)" ::: "memory");
    __syncthreads();
    if (threadIdx.x == 0) {
        unsigned* bar = b.bar;
        __builtin_amdgcn_s_waitcnt(0);
        unsigned nloc = b.st[0], nx = b.st[1];
        if (nloc == 0u) { xcd_barrier_complete(bar, b.x, nloc, nx); b.st[0] = nloc; b.st[1] = nx; }
        const unsigned old = xb_add(&bar[XB_XSUB(b.x)], 1u);
        const unsigned gen = old / nloc;
        if (old + 1u == (gen + 1u) * nloc) {
            __builtin_amdgcn_fence(__ATOMIC_RELEASE, "agent");
            asm volatile("s_waitcnt vmcnt(0)" ::: "memory");
            const unsigned og = xb_add(&bar[XB_TOP], 1u);
            const unsigned tg = og / nx;
            if (og + 1u == (tg + 1u) * nx) xb_add(&bar[XB_TOPGEN], 1u);
            else XB_SPIN(xb_ld(&bar[XB_TOPGEN]) == tg, bar);
            __builtin_amdgcn_fence(__ATOMIC_ACQUIRE, "agent");
            xb_add(&bar[XB_XGEN(b.x)], 1u);
            asm volatile("s_waitcnt vmcnt(0)" ::: "memory");
        } else {
            XB_SPIN(xb_ld(&bar[XB_XGEN(b.x)]) == gen, bar);
            __builtin_amdgcn_fence(__ATOMIC_ACQUIRE, "agent");
            asm volatile("s_waitcnt vmcnt(0)" ::: "memory");
        }
    }
    __syncthreads();
}

__global__ void __launch_bounds__(512, 2) mega(Args a) {
    extern __shared__ __attribute__((aligned(16))) unsigned char shm[];
    PG8_LAS unsigned char* lds = (PG8_LAS unsigned char*)shm;
    const int G = (int)gridDim.x;
    unsigned char* ws = a.ws;
    volatile __attribute__((address_space(3))) unsigned* bst = (volatile __attribute__((address_space(3))) unsigned*)(lds + pg8::STAGE_BYTES);
    if (threadIdx.x == 0) { bst[0] = 0u; bst[1] = 0u; }
    __syncthreads();
    const XcdBarrier bar = xcd_barrier_post((unsigned*)(ws + O_CTL), bst);
    cg::this_grid().sync();
    phase_prep(a, (float*)shm, G);
    xcd_barrier(bar);
    { Epi1 E; E.Q = (bf16_t*)(ws + O_Q); E.Kb = (bf16_t*)(ws + O_K); E.Vt = (bf16_t*)(ws + O_VT); E.Prw = (bf16_t*)(ws + O_PRW); E.Gt = (bf16_t*)a.out; E.bgate = a.in[3];
      run_gemm(lds, (const bf16_t*)(ws + O_H), (const bf16_t*)(ws + O_WIN), INC, 1024, E, G); }
    xcd_barrier(bar);
    phase_rwprep(a, shm, G);
    xcd_barrier(bar);
    phase_mixer(a, shm, G);
    xcd_barrier(bar);
    { EpiRow<1> E; E.O = (bf16_t*)(ws + O_T1); E.T1 = nullptr; E.Gt = (const bf16_t*)a.out;
      run_gemm(lds, (const bf16_t*)(ws + O_OSB), (const bf16_t*)(ws + O_WSB), 1024, 512, E, G); }
    { EpiRow<2> E; E.O = (bf16_t*)(ws + O_MRG); E.T1 = (const bf16_t*)(ws + O_T1); E.Gt = (const bf16_t*)a.out;
      run_gemm(lds, (const bf16_t*)(ws + O_ORW), (const bf16_t*)(ws + O_WRW), 1024, 512, E, G); }
    xcd_barrier(bar);
    { EpiRow<0> E; E.O = (bf16_t*)(ws + O_TT); E.T1 = nullptr; E.Gt = nullptr;
      run_gemm(lds, (const bf16_t*)(ws + O_MRG), (const bf16_t*)(ws + O_WO), 1024, 1024, E, G); }
    xcd_barrier(bar);
    phase_rows<0>(a, G);
    xcd_barrier(bar);
    { EpiSwiGLU E; E.Hd = (bf16_t*)(ws + O_HID);
      run_gemm(lds, (const bf16_t*)(ws + O_H2), (const bf16_t*)(ws + O_WGU), 2 * DFF, 1024, E, G); }
    xcd_barrier(bar);
    { EpiRow<0> E; E.O = (bf16_t*)(ws + O_FF); E.T1 = nullptr; E.Gt = nullptr;
      run_gemm(lds, (const bf16_t*)(ws + O_HID), (const bf16_t*)(ws + O_WDN), 1024, DFF, E, G); }
    xcd_barrier(bar);
    phase_rows<1>(a, G);
}
}

extern "C" void kernel_launch(void* const* d_in, const int* in_sizes, int n_in, void* d_out, int out_size, void* d_ws, size_t ws_size, hipStream_t stream) {
    static int grid = 0;
    if (grid == 0) {
        if (n_in != 24 || in_sizes[0] != mk::M * mk::D || out_size != mk::M * mk::D || ws_size < mk::WS_NEED) {
            fprintf(stderr, "kernel_launch: unexpected shapes: n_in %d in0 %d out %d ws %zu (need %zu)\n", n_in, n_in > 0 ? in_sizes[0] : -1, out_size, ws_size, (size_t)mk::WS_NEED); grid = -1; return; }
        int dev = 0, cus = 0, per_cu = 0;
        hipGetDevice(&dev); hipDeviceGetAttribute(&cus, hipDeviceAttributeMultiprocessorCount, dev);
        if (hipFuncSetAttribute((const void*)mk::mega, hipFuncAttributeMaxDynamicSharedMemorySize, mk::LDS_BYTES) != hipSuccess) { fprintf(stderr, "kernel_launch: hipFuncSetAttribute failed\n"); grid = -1; return; }
        if (hipOccupancyMaxActiveBlocksPerMultiprocessor(&per_cu, (const void*)mk::mega, 512, mk::LDS_BYTES) != hipSuccess || per_cu < 1) { fprintf(stderr, "kernel_launch: occupancy query failed (%d)\n", per_cu); per_cu = 1; }
        (void)hipGetLastError();
        grid = cus * per_cu;
        fprintf(stderr, "kernel_launch: grid %d (cus %d x %d)\n", grid, cus, per_cu);
    }
    if (grid < 0) return;
    mk::Args a{};
    for (int i = 0; i < 24; ++i) a.in[i] = (const float*)d_in[i];
    a.out = (float*)d_out; a.ws = (unsigned char*)d_ws;
    a.ph_lo = 0; a.ph_hi = mk::NPH;
    if (hipMemsetAsync((char*)d_ws + mk::O_CTL, 0, mk::CTL_BYTES, stream) != hipSuccess) { fprintf(stderr, "kernel_launch: hipMemsetAsync failed\n"); return; }
    void* args[] = {&a};
    hipError_t e = hipLaunchCooperativeKernel((const void*)mk::mega, dim3(grid), dim3(512), args, mk::LDS_BYTES, stream);
    if (e != hipSuccess) fprintf(stderr, "kernel_launch: cooperative launch failed: %s (grid %d)\n", hipGetErrorString(e), grid);
}
```
